# Optimizing an MI355X kernel written in HIP

```python
import jax, jax.numpy as jnp
from jax import lax
import numpy as np

D_MODEL = 1024
BATCH = 32
SEQ = 2048
DEPTH = 2

GRID_W = 64
CTX_LEN = 256
EPS = 1e-6
ROPE_THETA = 10000.0
Q_BLOCK = 128
CHUNK = 128
SGU_GROUPS = 4
SGU_GROUP_CH = 128
SGU_WIDTH = SGU_GROUPS * SGU_GROUP_CH
GQA_HEADS = 4
GQA_KV_HEADS = 2
GQA_GROUP = GQA_HEADS // GQA_KV_HEADS
HEAD_DIM = 128
GQA_Q_W = GQA_HEADS * HEAD_DIM
GQA_KV_W = GQA_KV_HEADS * HEAD_DIM
A_END = 2 * SGU_WIDTH
K_OFF = A_END + GQA_Q_W
V_OFF = K_OFF + GQA_KV_W
AB_IN_W = V_OFF + GQA_KV_W
AB_MIX_W = SGU_WIDTH + GQA_Q_W
MLA_HEADS = 8
MLA_Q_LORA = 512
MLA_KV_LORA = 256
MLA_NOPE = 128
MLA_ROPE = 64
MLA_V = 128
MLA_QK = MLA_NOPE + MLA_ROPE
MLA_IN_W = MLA_Q_LORA + MLA_KV_LORA + MLA_ROPE
N_EXPERTS = 32
TOP_K = 4
D_EXPERT = 1024
SWIGLU_LIMIT = 7.0
SWIGLU_ALPHA = 1.702
MOE_BLOCK = 128

kernel_name = "hybrid_gmlp_gqa_mla_moe_dit"


def rms_norm(x, g):
    xf = x.astype(jnp.float32)
    y = xf * lax.rsqrt(jnp.mean(xf * xf, axis=-1, keepdims=True) + EPS)
    return (y * g).astype(x.dtype)


def grid_angles(rows, rot_dim):
    t = jnp.arange(rows * GRID_W, dtype=jnp.int32)
    row = (t // GRID_W).astype(jnp.float32)
    col = (t % GRID_W).astype(jnp.float32)
    axis_dim = rot_dim // 2
    inv_freq = ROPE_THETA ** (-jnp.arange(0, axis_dim, 2, dtype=jnp.float32) / axis_dim)
    return row[:, None] * inv_freq, col[:, None] * inv_freq


def rope_1d(x, ang):
    x1, x2 = jnp.split(x, 2, axis=-1)
    cos = jnp.cos(ang)[:, None, :]
    sin = jnp.sin(ang)[:, None, :]
    return jnp.concatenate([x1 * cos - x2 * sin, x2 * cos + x1 * sin], axis=-1)


def rope_2d(x, ang_r, ang_c):
    xf = x.astype(jnp.float32)
    xr, xc = jnp.split(xf, 2, axis=-1)
    return jnp.concatenate([rope_1d(xr, ang_r), rope_1d(xc, ang_c)], axis=-1).astype(x.dtype)


def blocked_attention(q, k, v):
    Bn, Hk, G, Tq, dk = q.shape
    nb = Tq // Q_BLOCK
    qb = jnp.moveaxis(q.reshape(Bn, Hk, G, nb, Q_BLOCK, dk), 3, 0)
    scale = dk ** -0.5

    def one_block(qblk):
        s = jnp.einsum('bhgqd,bhkd->bhgqk', qblk, k, preferred_element_type=jnp.float32) * scale
        p = jax.nn.softmax(s, axis=-1).astype(v.dtype)
        return jnp.einsum('bhgqk,bhkd->bhgqd', p, v)

    out = lax.map(one_block, qb)
    return jnp.moveaxis(out, 0, 3).reshape(Bn, Hk, G, Tq, v.shape[-1])


def chunk_gating(a_uv, g_norm, w_s, b_s):
    Bn, T, _ = a_uv.shape
    z = jax.nn.gelu(a_uv)
    u, v = jnp.split(z, 2, axis=-1)
    v = v.reshape(Bn, T // CHUNK, CHUNK, SGU_GROUPS, SGU_GROUP_CH)
    v = rms_norm(v, g_norm.reshape(SGU_GROUPS, SGU_GROUP_CH))
    v = jnp.einsum('gpq,bnqgc->bnpgc', w_s, v) + jnp.transpose(b_s)[:, :, None]
    return u * v.reshape(Bn, T, SGU_WIDTH)


def gqa_heads(q, k, v):
    Bn, Tq = q.shape[:2]
    qt = q.reshape(Bn, Tq, GQA_KV_HEADS, GQA_GROUP, HEAD_DIM).transpose(0, 2, 3, 1, 4)
    o = blocked_attention(qt, k.transpose(0, 2, 1, 3), v.transpose(0, 2, 1, 3))
    return o.transpose(0, 3, 1, 2, 4).reshape(Bn, Tq, GQA_Q_W)


def ab_mixer(h, hc, w_in, sgu_g, sgu_w, sgu_b, q_g, k_g, w_out, ang, ctx_out):
    Bn, S, _ = h.shape
    L = hc.shape[1]
    p = h @ w_in
    out_a = chunk_gating(p[..., :A_END], sgu_g, sgu_w, sgu_b)
    q = rope_2d(rms_norm(p[..., A_END:K_OFF].reshape(Bn, S, GQA_HEADS, HEAD_DIM), q_g), *ang)
    k = rope_2d(rms_norm(p[..., K_OFF:V_OFF].reshape(Bn, S, GQA_KV_HEADS, HEAD_DIM), k_g), *ang)
    v = p[..., V_OFF:].reshape(Bn, S, GQA_KV_HEADS, HEAD_DIM)
    pc = hc @ (w_in if ctx_out else w_in[:, K_OFF:])
    pc_kv = pc[..., K_OFF:] if ctx_out else pc
    kc = rms_norm(pc_kv[..., :GQA_KV_W].reshape(Bn, L, GQA_KV_HEADS, HEAD_DIM), k_g)
    vc = pc_kv[..., GQA_KV_W:].reshape(Bn, L, GQA_KV_HEADS, HEAD_DIM)
    out_b = gqa_heads(q, jnp.concatenate([kc, k], axis=1), jnp.concatenate([vc, v], axis=1))
    y = jnp.concatenate([out_a, out_b], axis=-1) @ w_out
    if not ctx_out:
        return y, None
    out_ac = chunk_gating(pc[..., :A_END], sgu_g, sgu_w, sgu_b)
    qc = rms_norm(pc[..., A_END:K_OFF].reshape(Bn, L, GQA_HEADS, HEAD_DIM), q_g)
    out_bc = gqa_heads(qc, kc, vc)
    yc = jnp.concatenate([out_ac, out_bc], axis=-1) @ w_out
    return y, yc


def mla_query(cq, q_g, w_uq, ang):
    Bn, T, _ = cq.shape
    q = (rms_norm(cq, q_g) @ w_uq).reshape(Bn, T, MLA_HEADS, MLA_QK)
    if ang is None:
        return q
    return jnp.concatenate([q[..., :MLA_NOPE], rope_2d(q[..., MLA_NOPE:], *ang)], axis=-1)


def mla_kv(ck, kv_g, w_ukv, ang):
    Bn, T, _ = ck.shape
    kv = (rms_norm(ck[..., :MLA_KV_LORA], kv_g) @ w_ukv).reshape(Bn, T, MLA_HEADS, MLA_NOPE + MLA_V)
    k_nope, v = kv[..., :MLA_NOPE], kv[..., MLA_NOPE:]
    kr = ck[..., MLA_KV_LORA:][:, :, None, :]
    if ang is not None:
        kr = rope_2d(kr, *ang)
    k = jnp.concatenate([k_nope, jnp.broadcast_to(kr, (Bn, T, MLA_HEADS, MLA_ROPE))], axis=-1)
    return k, v


def mla_heads(q, k, v):
    Bn, Tq = q.shape[:2]
    o = blocked_attention(q.transpose(0, 2, 1, 3)[:, :, None], k.transpose(0, 2, 1, 3), v.transpose(0, 2, 1, 3))
    return o[:, :, 0].transpose(0, 2, 1, 3).reshape(Bn, Tq, MLA_HEADS * MLA_V)


def mla_mixer(h, hc, w_in, q_g, kv_g, w_uq, w_ukv, w_out, ang, ctx_out):
    p = h @ w_in
    q = mla_query(p[..., :MLA_Q_LORA], q_g, w_uq, ang)
    k, v = mla_kv(p[..., MLA_Q_LORA:], kv_g, w_ukv, ang)
    pc = hc @ (w_in if ctx_out else w_in[:, MLA_Q_LORA:])
    pc_kv = pc[..., MLA_Q_LORA:] if ctx_out else pc
    kc, vc = mla_kv(pc_kv, kv_g, w_ukv, None)
    y = mla_heads(q, jnp.concatenate([kc, k], axis=1), jnp.concatenate([vc, v], axis=1)) @ w_out
    if not ctx_out:
        return y, None
    qc = mla_query(pc[..., :MLA_Q_LORA], q_g, w_uq, None)
    yc = mla_heads(qc, kc, vc) @ w_out
    return y, yc


def moe_ffn(h, router_w, router_b, w1, b1, w2, b2):
    T, D = h.shape
    logits = (h @ router_w + router_b).astype(jnp.float32)
    top_logit, top_idx = lax.top_k(logits, TOP_K)
    gate = jax.nn.softmax(top_logit, axis=-1)
    flat_e = top_idx.reshape(-1)
    order = jnp.argsort(flat_e)
    e_sorted = flat_e[order]
    tok_sorted = order // TOP_K
    counts = jnp.bincount(flat_e, length=N_EXPERTS)
    padded = (counts + MOE_BLOCK - 1) // MOE_BLOCK * MOE_BLOCK
    pad_end = jnp.cumsum(padded)
    pad_start = pad_end - padded
    start = jnp.cumsum(counts) - counts
    dest = pad_start[e_sorted] + jnp.arange(T * TOP_K, dtype=jnp.int32) - start[e_sorted]
    n_rows = T * TOP_K + N_EXPERTS * MOE_BLOCK
    n_blocks = n_rows // MOE_BLOCK
    row_tok = jnp.full((n_rows,), T, dtype=jnp.int32).at[dest].set(tok_sorted)
    h_pad = jnp.concatenate([h, jnp.zeros((1, D), h.dtype)], axis=0)
    xs = h_pad[row_tok].reshape(n_blocks, MOE_BLOCK, D)
    blk_start = jnp.arange(n_blocks, dtype=jnp.int32) * MOE_BLOCK
    blk_e = jnp.minimum(jnp.searchsorted(pad_end, blk_start, side='right'), N_EXPERTS - 1)

    def expert_block(args):
        xb, e = args
        hid = xb @ w1[e] + b1[e]
        g, lin = jnp.split(hid, 2, axis=-1)
        g = jnp.minimum(g, SWIGLU_LIMIT)
        lin = jnp.clip(lin, -SWIGLU_LIMIT, SWIGLU_LIMIT)
        act = g * jax.nn.sigmoid(SWIGLU_ALPHA * g) * (lin + 1.0)
        return act @ w2[e] + b2[e]

    ys = lax.map(expert_block, (xs, blk_e)).reshape(n_rows, D)
    y_assign = ys[dest] * gate.reshape(-1)[order][:, None].astype(ys.dtype)
    return jnp.zeros((T, D), h.dtype).at[tok_sorted].add(y_assign)


def setup_inputs(seed: int = 0) -> dict:
    key = jax.random.key(seed)
    ks = jax.random.split(key, 32)
    n_even = (DEPTH + 1) // 2
    n_odd = DEPTH // 2
    f32 = jnp.float32

    def nrm(k, shape, fan_in):
        return jax.random.normal(k, shape, f32) * fan_in ** -0.5

    def gain(k, shape):
        return 1.0 + 0.02 * jax.random.normal(k, shape, f32)

    def small(k, shape):
        return 0.01 * jax.random.normal(k, shape, f32)

    D = D_MODEL
    return {
        "x": jax.random.normal(ks[0], (BATCH, SEQ, D), f32),
        "c": jax.random.normal(ks[1], (BATCH, D), f32),
        "ctx": jax.random.normal(ks[2], (BATCH, CTX_LEN, D), f32),
        "c_ctx": jax.random.normal(ks[3], (D,), f32),
        "ada_w": nrm(ks[4], (DEPTH, D, 6 * D), D),
        "ada_b": small(ks[5], (DEPTH, 6 * D)),
        "norm_mix_g": gain(ks[6], (DEPTH, D)),
        "norm_ffn_g": gain(ks[7], (DEPTH, D)),
        "ab_w_in": nrm(ks[8], (n_even, D, AB_IN_W), D),
        "sgu_norm_g": gain(ks[9], (n_even, SGU_WIDTH)),
        "sgu_w": nrm(ks[10], (n_even, SGU_GROUPS, CHUNK, CHUNK), CHUNK),
        "sgu_b": gain(ks[11], (n_even, SGU_GROUPS, CHUNK)),
        "gqa_q_norm_g": gain(ks[12], (n_even, HEAD_DIM)),
        "gqa_k_norm_g": gain(ks[13], (n_even, HEAD_DIM)),
        "ab_w_out": nrm(ks[14], (n_even, AB_MIX_W, D), AB_MIX_W),
        "mla_w_in": nrm(ks[15], (n_odd, D, MLA_IN_W), D),
        "mla_q_norm_g": gain(ks[16], (n_odd, MLA_Q_LORA)),
        "mla_kv_norm_g": gain(ks[17], (n_odd, MLA_KV_LORA)),
        "mla_w_uq": nrm(ks[18], (n_odd, MLA_Q_LORA, MLA_HEADS * MLA_QK), MLA_Q_LORA),
        "mla_w_ukv": nrm(ks[19], (n_odd, MLA_KV_LORA, MLA_HEADS * (MLA_NOPE + MLA_V)), MLA_KV_LORA),
        "mla_w_out": nrm(ks[20], (n_odd, MLA_HEADS * MLA_V, D), MLA_HEADS * MLA_V),
        "router_w": nrm(ks[21], (DEPTH, D, N_EXPERTS), D),
        "router_b": small(ks[22], (DEPTH, N_EXPERTS)),
        "moe_w1": nrm(ks[23], (DEPTH, N_EXPERTS, D, 2 * D_EXPERT), D),
        "moe_b1": small(ks[24], (DEPTH, N_EXPERTS, 2 * D_EXPERT)),
        "moe_w2": nrm(ks[25], (DEPTH, N_EXPERTS, D_EXPERT, D), D_EXPERT),
        "moe_b2": small(ks[26], (DEPTH, N_EXPERTS, D)),
        "final_norm_g": gain(ks[27], (D,)),
    }


def reference(x, c, ctx, c_ctx, ada_w, ada_b, norm_mix_g, norm_ffn_g, ab_w_in, sgu_norm_g, sgu_w, sgu_b,
              gqa_q_norm_g, gqa_k_norm_g, ab_w_out, mla_w_in, mla_q_norm_g, mla_kv_norm_g, mla_w_uq, mla_w_ukv,
              mla_w_out, router_w, router_b, moe_w1, moe_b1, moe_w2, moe_b2, final_norm_g):
    Bn, S, D = x.shape
    L = ctx.shape[1]
    ROWS = S // GRID_W
    ang_gqa = grid_angles(ROWS, HEAD_DIM)
    ang_mla = grid_angles(ROWS, MLA_ROPE)
    silu_c = jax.nn.silu(c)
    silu_cc = jax.nn.silu(c_ctx)
    xc = ctx
    for i in range(DEPTH):
        ctx_out = i < DEPTH - 1
        j = i // 2
        mod = (silu_c @ ada_w[i] + ada_b[i])[:, None, :]
        modc = silu_cc @ ada_w[i] + ada_b[i]
        sh1, sc1, g1, sh2, sc2, g2 = jnp.split(mod, 6, axis=-1)
        sh1c, sc1c, g1c, sh2c, sc2c, g2c = jnp.split(modc, 6, axis=-1)
        h = rms_norm(x, norm_mix_g[i]) * (1.0 + sc1) + sh1
        hc = rms_norm(xc, norm_mix_g[i]) * (1.0 + sc1c) + sh1c
        if i % 2 == 0:
            y, yc = ab_mixer(h, hc, ab_w_in[j], sgu_norm_g[j], sgu_w[j], sgu_b[j], gqa_q_norm_g[j],
                             gqa_k_norm_g[j], ab_w_out[j], ang_gqa, ctx_out)
        else:
            y, yc = mla_mixer(h, hc, mla_w_in[j], mla_q_norm_g[j], mla_kv_norm_g[j], mla_w_uq[j],
                              mla_w_ukv[j], mla_w_out[j], ang_mla, ctx_out)
        x = x + g1 * y
        h2 = (rms_norm(x, norm_ffn_g[i]) * (1.0 + sc2) + sh2).reshape(Bn * S, D)
        if ctx_out:
            xc = xc + g1c * yc
            h2c = (rms_norm(xc, norm_ffn_g[i]) * (1.0 + sc2c) + sh2c).reshape(Bn * L, D)
            f = moe_ffn(jnp.concatenate([h2, h2c], axis=0), router_w[i], router_b[i],
                        moe_w1[i], moe_b1[i], moe_w2[i], moe_b2[i])
            x = x + g2 * f[:Bn * S].reshape(Bn, S, D)
            xc = xc + g2c * f[Bn * S:].reshape(Bn, L, D)
        else:
            f = moe_ffn(h2, router_w[i], router_b[i], moe_w1[i], moe_b1[i], moe_w2[i], moe_b2[i])
            x = x + g2 * f.reshape(Bn, S, D)
    return rms_norm(x, final_norm_g)
```

```cpp
#include <hip/hip_runtime.h>
#include <cstdio>
#include <cstdint>

#ifndef MK_ONE_LAUNCH
#define MK_ONE_LAUNCH 1
#endif

#define LAS __attribute__((address_space(3)))
typedef unsigned short bf16_t;
typedef unsigned char uchar;
typedef short bf16x8 __attribute__((ext_vector_type(8)));
typedef short s16x4 __attribute__((ext_vector_type(4)));
typedef float f32x2 __attribute__((ext_vector_type(2)));
typedef float f32x4 __attribute__((ext_vector_type(4)));
typedef float f32x16 __attribute__((ext_vector_type(16)));
typedef unsigned u32x2 __attribute__((ext_vector_type(2)));
typedef unsigned u32x4 __attribute__((ext_vector_type(4)));

constexpr int DM = 1024, NBATCH = 32, SEQ = 2048, CTXL = 256, TPB = SEQ + CTXL, NTOK = NBATCH * TPB, NPAN = NTOK / 256;
constexpr int NEXP = 32, TOPK = 4, ROWCAP = NTOK;
constexpr float EPS = 1e-6f;
constexpr int NPHASE = 19;

constexpr size_t MiB = 1u << 20;
constexpr size_t WS_CTL = 0, CTL_BYTES = 1 * MiB;
constexpr size_t WS_MOD = 1 * MiB;
constexpr size_t WS_TABG = 3 * MiB;
constexpr size_t WS_TABM = WS_TABG + 32768;
constexpr size_t WS_WRT = WS_TABG + 65536;
constexpr size_t WS_SGUW = WS_WRT + 262144;
constexpr size_t WS_WIN0 = 4 * MiB, WS_WOUT0 = 8 * MiB, WS_WIN1 = 10 * MiB, WS_WUQ = 12 * MiB, WS_WUKV = 14 * MiB, WS_WOUT1 = 15 * MiB;
constexpr size_t WS_W1 = 17 * MiB;
constexpr size_t WS_W2 = 273 * MiB;
constexpr size_t WS_ROWL = 401 * MiB;
constexpr size_t WS_TOKI = 410 * MiB;
constexpr size_t WS_XR = 413 * MiB;
constexpr size_t WS_H = 701 * MiB;
constexpr size_t WS_SCR = 845 * MiB;
constexpr size_t WS_PBUF = WS_SCR;
constexpr size_t WS_MIX0 = WS_SCR + 288 * MiB;
constexpr size_t WS_QB = WS_SCR + 144 * MiB;
constexpr size_t WS_KVB = WS_SCR + 360 * MiB;
constexpr size_t WS_KRB = WS_SCR + 648 * MiB;
constexpr size_t WS_MIX1 = WS_SCR + 660 * MiB;
constexpr size_t WS_ACT = WS_SCR;
constexpr size_t WS_Y = WS_SCR + 592 * MiB;
constexpr size_t WS_END = WS_SCR + 1184 * MiB;
constexpr int CW_BAR = 1024;
constexpr int CW_CNT = 8192;
constexpr int CW_DBG = 16384;

constexpr int RING_BYTES = 131072;
constexpr int XTRA_OFF = RING_BYTES, XTRA_BYTES = 20480;
constexpr int MISC_OFF = XTRA_OFF + XTRA_BYTES;
constexpr int LDS_BYTES = MISC_OFF + 512;
constexpr int X_PB = 0;
constexpr int X_CNT = 256;
constexpr int X_HIST = 512;
constexpr int X_BASE = 768;
constexpr int X_SEL = 1024;

#define LDS_WAIT() asm volatile("s_waitcnt lgkmcnt(0)" ::: "memory")
#define VM_WAIT() asm volatile("s_waitcnt vmcnt(0)" ::: "memory")
#define SBAR() __builtin_amdgcn_sched_barrier(0)
__device__ __forceinline__ unsigned cvtpk(float lo, float hi) { unsigned r; asm volatile("v_cvt_pk_bf16_f32 %0, %1, %2" : "=v"(r) : "v"(lo), "v"(hi)); return r; }
__device__ __forceinline__ float bf2f(unsigned short b) { return __uint_as_float(((unsigned)b) << 16); }
__device__ __forceinline__ float bflo(unsigned w) { return __uint_as_float(w << 16); }
__device__ __forceinline__ float bfhi(unsigned w) { return __uint_as_float(w & 0xffff0000u); }
__device__ __forceinline__ unsigned short f2bf(float f) { return (unsigned short)(cvtpk(f, 0.f) & 0xffffu); }
__device__ __forceinline__ float wave_sum(float v) {
#pragma unroll
    for (int o = 1; o < 64; o <<= 1) v += __shfl_xor(v, o);
    return v;
}
__device__ __forceinline__ float silu_f(float x) { return x / (1.f + __expf(-x)); }
__device__ __forceinline__ float gelu_tanh_f(float x) {
    const float u = x * (1.5957691216057308f + 0.07135481627260025f * x * x);
    const float e = __builtin_amdgcn_exp2f(-1.4426950408889634f * u);
    return x * __builtin_amdgcn_rcpf(1.f + e);
}

#define XB_TMO      128
#define XB_XCNT(j)  (256  + 64 * (j))
#define XB_XSUB(j)  (1280 + 64 * (j))
#define XB_XGEN(j)  (2304 + 64 * (j))
#define XB_TOP      3328
#define XB_TOPGEN   3392
#define XCD_BAR_WORDS 3456
#define XB_SPIN_CAP (1u << 20)
__device__ __forceinline__ unsigned xb_ld(unsigned* p)              { return __hip_atomic_load(p, __ATOMIC_RELAXED, __HIP_MEMORY_SCOPE_AGENT); }
__device__ __forceinline__ unsigned xb_add(unsigned* p, unsigned v) { return __hip_atomic_fetch_add(p, v, __ATOMIC_RELAXED, __HIP_MEMORY_SCOPE_AGENT); }
__device__ __forceinline__ unsigned xb_xcc_id() { return (unsigned)__builtin_amdgcn_s_getreg((3 << 11) | 20) & 0xFu; }
#define XB_SPIN(cond, bar) do { unsigned _sp = 0; while (cond) { __builtin_amdgcn_s_sleep(1); \
    if ((++_sp & 255u) == 0u) { if (xb_ld(&(bar)[XB_TMO])) break; if (_sp > XB_SPIN_CAP) { atomicAdd(&(bar)[XB_TMO], 1u); break; } } } } while (0)
struct XcdBarrier { unsigned* bar; unsigned x; volatile LAS unsigned* st; };
__device__ __forceinline__ XcdBarrier xcd_barrier_post(unsigned* bar, volatile LAS unsigned* st) {
    XcdBarrier b; b.bar = bar; b.x = xb_xcc_id(); b.st = st;
    if (threadIdx.x == 0) (void)xb_add(&bar[XB_XCNT(b.x)], 1u);
    return b;
}
__device__ __forceinline__ void xcd_barrier_complete(unsigned* bar, unsigned x, unsigned& nloc, unsigned& nx) {
    const unsigned G = gridDim.x * gridDim.y * gridDim.z;
    unsigned sum, cnt, mine, sp = 0u;
    for (;;) {
        sum = 0u; cnt = 0u; mine = 0u;
#pragma unroll
        for (unsigned j = 0; j < 16; ++j) { const unsigned c = xb_ld(&bar[XB_XCNT(j)]); sum += c; cnt += (c > 0u) ? 1u : 0u; mine = (j == x) ? c : mine; }
        if (sum == G) break;
        __builtin_amdgcn_s_sleep(1);
        if ((++sp & 255u) == 0u) { if (xb_ld(&bar[XB_TMO])) break; if (sp > XB_SPIN_CAP) { atomicAdd(&bar[XB_TMO], 1u); break; } }
    }
    nloc = mine > 0u ? mine : 1u; nx = cnt > 0u ? cnt : 1u;
}
__device__ __forceinline__ void xcd_barrier(const XcdBarrier& b) {
    asm volatile("s_waitcnt vmcnt(0)" ::: "memory");
    __syncthreads();
    if (threadIdx.x == 0) {
        unsigned* bar = b.bar;
        __builtin_amdgcn_s_waitcnt(0);
        unsigned nloc = b.st[0], nx = b.st[1];
        if (nloc == 0u) { xcd_barrier_complete(bar, b.x, nloc, nx); b.st[0] = nloc; b.st[1] = nx; }
        const unsigned old = xb_add(&bar[XB_XSUB(b.x)], 1u);
        const unsigned gen = old / nloc;
        if (old + 1u == (gen + 1u) * nloc) {
            __builtin_amdgcn_fence(__ATOMIC_RELEASE, "agent");
            asm volatile("s_waitcnt vmcnt(0)" ::: "memory");
            const unsigned og = xb_add(&bar[XB_TOP], 1u);
            const unsigned tg = og / nx;
            if (og + 1u == (tg + 1u) * nx) xb_add(&bar[XB_TOPGEN], 1u);
            else XB_SPIN(xb_ld(&bar[XB_TOPGEN]) == tg, bar);
            __builtin_amdgcn_fence(__ATOMIC_ACQUIRE, "agent");
            xb_add(&bar[XB_XGEN(b.x)], 1u);
            asm volatile("s_waitcnt vmcnt(0)" ::: "memory");
        } else {
            XB_SPIN(xb_ld(&bar[XB_XGEN(b.x)]) == gen, bar);
            __builtin_amdgcn_fence(__ATOMIC_ACQUIRE, "agent");
            asm volatile("s_waitcnt vmcnt(0)" ::: "memory");
        }
    }
    __syncthreads();
}

struct Args { const float* in[28]; float* out; uchar* ws; int ph_lo, ph_hi; };
enum { I_X = 0, I_C, I_CTX, I_CCTX, I_ADAW, I_ADAB, I_NMIXG, I_NFFNG, I_ABWIN, I_SGUNG, I_SGUW, I_SGUB, I_GQG, I_GKG, I_ABWOUT, I_MLAWIN, I_MLAQG, I_MLAKVG, I_MLAWUQ, I_MLAWUKV, I_MLAWOUT,
       I_RW, I_RB, I_W1, I_B1, I_W2, I_B2, I_FNG };
struct Frame {
    LAS uchar* lds; int tid, lane, wave, G, bid;
    uchar* ws; float* out;
};
__device__ __forceinline__ const float* INP(int i) {
    const __attribute__((address_space(4))) char* ka = (const __attribute__((address_space(4))) char*)__builtin_amdgcn_kernarg_segment_ptr();
    return *(const float* const volatile __attribute__((address_space(4)))*)(ka + i * 8);
}

namespace pg8 {
constexpr int BM = 256, BK = 64, HALF = 128, HTB = HALF * BK * 2, NXCD = 8, WGM = 8;
__device__ __forceinline__ int lds_byte(int r, int c) { const int st = (r >> 4) * 2 + (c >> 5), rr = r & 15, cc = c & 31, ob = rr * 64 + cc * 2; return st * 1024 + (ob ^ (((ob >> 9) & 1) << 5)); }
__device__ __forceinline__ void stage_rc(int b, int& R, int& C) { const int st = b / 1024, sb = b % 1024, swz = sb ^ (((sb >> 9) & 1) << 5); R = (st >> 1) * 16 + swz / 64; C = (st & 1) * 32 + (swz % 64) / 2; }
__device__ __forceinline__ int perm32(int rho) { const int n = rho >> 4, i = rho & 15; return 8 * (i >> 2) + 4 * n + (i & 3); }
struct Unit { int pm, pn, e, rb; };
struct StaticOrder {
    int nM, nN, nwg;
    __device__ void init(int nM_, int nN_) { nM = nM_; nN = nN_; nwg = nM * nN; }
    __device__ bool map(long L, int& pm, int& pn) const {
        if (L >= nwg) return false;
        int wgid = (int)L; { const int q = nwg / NXCD, r = nwg % NXCD, xcd = wgid % NXCD, off = wgid / NXCD; wgid = (xcd < r ? xcd * (q + 1) : r * (q + 1) + (xcd - r) * q) + off; }
        const int nig = WGM * nN, gid = wgid / nig, fm = gid * WGM, gsz = (nM - fm) < WGM ? (nM - fm) : WGM;
        pm = fm + ((wgid % nig) % gsz); pn = (wgid % nig) / gsz; return true;
    }
};
typedef f32x4 Acc[2][2][4][2];
template <class P>
__device__ __forceinline__ void gemm_phase(LAS uchar* lds, const P& p) {
    const int tid = threadIdx.x, wid = __builtin_amdgcn_readfirstlane(tid >> 6), lane = tid & 63, wr = wid >> 2, wc = wid & 3, fr = lane & 15, fq = lane >> 4;
    const int K = p.K, nt = K / BK;
    unsigned voffA[2][2], voffB[2];
#pragma unroll
    for (int i = 0; i < 2; ++i) { int R, C; stage_rc(tid * 16 + i * 8192, R, C); const int Rb = P::PERM ? ((R & ~31) + perm32(R & 31)) : R;
        voffA[0][i] = (unsigned)(R * p.lda + C) * 2u; voffA[1][i] = (unsigned)((R + HALF) * p.lda + C) * 2u; voffB[i] = (unsigned)(Rb * K + C) * 2u; }
    const size_t kstep = (size_t)(BK * 2);
    const size_t hstepB = (size_t)HALF * K * 2;
    const unsigned ldsw = (unsigned)wid * 1024u;
    const int aoff = lds_byte(wr * 64 + fr, fq * 8), boff = lds_byte(wc * 32 + fr, fq * 8);
#define PG8_SA(b, h) (((b) * 2 + (h)) * HTB)
#define PG8_SB(b, h) ((4 + (b) * 2 + (h)) * HTB)
#define PG8_STAGE(bufoff, gbase, voff) do { _Pragma("unroll") for (int _i = 0; _i < 2; ++_i) \
        __builtin_amdgcn_global_load_lds((const unsigned*)((const char*)(gbase) + (voff)[_i]), (LAS unsigned*)(lds + (bufoff) + ldsw + _i * 8192), 16, 0, 0); } while (0)
#define PG8_LDA(dst, b, h) do { _Pragma("unroll") for (int m = 0; m < 4; ++m) _Pragma("unroll") for (int k = 0; k < 2; ++k) dst[m][k] = *(const LAS bf16x8*)(lds + PG8_SA(b, h) + aoff + m * 2048 + k * 1024); } while (0)
#define PG8_LDB(dst, b, h) do { _Pragma("unroll") for (int n = 0; n < 2; ++n) _Pragma("unroll") for (int k = 0; k < 2; ++k) dst[n][k] = *(const LAS bf16x8*)(lds + PG8_SB(b, h) + boff + n * 2048 + k * 1024); } while (0)
#define PG8_MMA(ai, bj, At, Bt) do { __builtin_amdgcn_s_setprio(1); _Pragma("unroll") for (int m = 0; m < 4; ++m) _Pragma("unroll") for (int n = 0; n < 2; ++n) _Pragma("unroll") for (int k = 0; k < 2; ++k) \
        acc[ai][bj][m][n] = __builtin_amdgcn_mfma_f32_16x16x32_bf16(Bt[n][k], At[m][k], acc[ai][bj][m][n], 0, 0, 0); __builtin_amdgcn_s_setprio(0); } while (0)
#define PG8_WAIT_V(n) asm volatile("s_waitcnt vmcnt(" #n ")" ::: "memory")
#define PG8_WAIT_L(n) asm volatile("s_waitcnt lgkmcnt(" #n ")" ::: "memory")
#define PG8_BAR __builtin_amdgcn_s_barrier()
#define PG8_SCHED __builtin_amdgcn_sched_barrier(0)
    Unit cur, nxt; int ui = 0;
    if (!p.next(0, cur)) return;
    Acc acc;
#pragma unroll
    for (int a = 0; a < 2; ++a)
#pragma unroll
        for (int b = 0; b < 2; ++b)
#pragma unroll
            for (int m = 0; m < 4; ++m)
#pragma unroll
                for (int n = 0; n < 2; ++n) acc[a][b][m][n] = (f32x4){0.f, 0.f, 0.f, 0.f};
    bf16x8 At[4][2], B0[2][2], B1[2][2];
    const char* cA = p.a_base(cur); const char* cB = p.b_base(cur);
    if constexpr (P::GATHER) { p.a_voff(cur, voffA); }
    PG8_STAGE(PG8_SB(0, 0), cB, voffB); PG8_STAGE(PG8_SB(0, 1), cB + hstepB, voffB); PG8_STAGE(PG8_SA(0, 0), cA, voffA[0]); PG8_STAGE(PG8_SA(0, 1), cA, voffA[1]);
    if (wr == 1) PG8_BAR;
    PG8_WAIT_V(2); PG8_BAR;
    PG8_STAGE(PG8_SB(1, 0), cB + kstep, voffB); PG8_STAGE(PG8_SA(1, 0), cA + kstep, voffA[0]); PG8_STAGE(PG8_SB(1, 1), cB + hstepB + kstep, voffB);
    PG8_WAIT_V(6); PG8_BAR;
    for (;;) {
        const bool has_next = p.next(ui + 1, nxt);
        const char* nA = has_next ? p.a_base(nxt) : cA; const char* nB = has_next ? p.b_base(nxt) : cB;
        for (int t = 0; t < nt; t += 2) {
            const bool last = (t == nt - 2);
            const char* a1 = cA + (size_t)(t + 1) * kstep;
            const char* a2 = last ? nA : cA + (size_t)(t + 2) * kstep; const char* b2 = last ? nB : cB + (size_t)(t + 2) * kstep;
            const char* a3 = a2 + kstep; const char* b3 = b2 + kstep;
            PG8_LDB(B0, 0, 0); PG8_LDB(B1, 0, 1); PG8_SCHED; PG8_LDA(At, 0, 0); PG8_STAGE(PG8_SA(1, 1), a1, voffA[1]);
            if constexpr (P::GATHER) { if (last && has_next) p.a_voff(nxt, voffA); }
            PG8_WAIT_V(8); PG8_WAIT_L(0); PG8_BAR; PG8_MMA(0, 0, At, B0); PG8_MMA(0, 1, At, B1); PG8_BAR; PG8_SCHED;
            PG8_LDA(At, 0, 1); PG8_STAGE(PG8_SB(0, 0), b2, voffB); PG8_STAGE(PG8_SB(0, 1), b2 + hstepB, voffB); PG8_STAGE(PG8_SA(0, 0), a2, voffA[0]);
            PG8_WAIT_V(8); PG8_WAIT_L(0); PG8_BAR; PG8_MMA(1, 0, At, B0); PG8_MMA(1, 1, At, B1); PG8_BAR; PG8_SCHED;
            PG8_LDB(B0, 1, 0); PG8_LDB(B1, 1, 1); PG8_SCHED; PG8_LDA(At, 1, 0); PG8_STAGE(PG8_SA(0, 1), a2, voffA[1]);
            PG8_WAIT_V(8); PG8_WAIT_L(0); PG8_BAR; PG8_MMA(0, 0, At, B0); PG8_MMA(0, 1, At, B1); PG8_BAR; PG8_SCHED;
            PG8_LDA(At, 1, 1); PG8_STAGE(PG8_SB(1, 0), b3, voffB); PG8_STAGE(PG8_SB(1, 1), b3 + hstepB, voffB); PG8_STAGE(PG8_SA(1, 0), a3, voffA[0]);
            PG8_WAIT_V(8); PG8_WAIT_L(0); PG8_BAR; PG8_MMA(1, 0, At, B0); PG8_MMA(1, 1, At, B1); PG8_BAR; PG8_SCHED;
        }
        if (wr == 0) PG8_BAR;
        p.epi(acc, cur, wr, wc, fr, fq);
        if (!has_next) break;
#pragma unroll
        for (int a = 0; a < 2; ++a)
#pragma unroll
            for (int b = 0; b < 2; ++b)
#pragma unroll
                for (int m = 0; m < 4; ++m)
#pragma unroll
                    for (int n = 0; n < 2; ++n) acc[a][b][m][n] = (f32x4){0.f, 0.f, 0.f, 0.f};
        cur = nxt; cA = nA; cB = nB; ++ui;
        if (wr == 1) PG8_BAR;
    }
    PG8_WAIT_V(0);
    PG8_BAR;
#undef PG8_SA
#undef PG8_SB
#undef PG8_STAGE
#undef PG8_LDA
#undef PG8_LDB
#undef PG8_MMA
#undef PG8_WAIT_V
#undef PG8_WAIT_L
#undef PG8_BAR
#undef PG8_SCHED
}

template <bool GELU>
__device__ __forceinline__ void epi_store_bf16(const Acc& acc, bf16_t* dst  , int ldc, const float* bias  , int wr, int wc, int fr, int fq) {
    const int row0 = wr * 64 + fr, col0 = wc * 32 + 8 * fq;
    f32x4 bv[2][2];
#pragma unroll
    for (int bj = 0; bj < 2; ++bj)
#pragma unroll
        for (int n = 0; n < 2; ++n) bv[bj][n] = bias ? *(const f32x4*)(bias + col0 + bj * HALF + 4 * n) : (f32x4){0.f, 0.f, 0.f, 0.f};
#pragma unroll
    for (int ai = 0; ai < 2; ++ai)
#pragma unroll
        for (int m = 0; m < 4; ++m) { bf16_t* rowp = dst + (size_t)(row0 + ai * HALF + m * 16) * ldc + col0;
#pragma unroll
            for (int bj = 0; bj < 2; ++bj) { f32x4 v0 = acc[ai][bj][m][0] + bv[bj][0], v1 = acc[ai][bj][m][1] + bv[bj][1];
                if (GELU) {
#pragma unroll
                    for (int j = 0; j < 4; ++j) { v0[j] = gelu_tanh_f(v0[j]); v1[j] = gelu_tanh_f(v1[j]); } }
                u32x4 w; w.x = cvtpk(v0[0], v0[1]); w.y = cvtpk(v0[2], v0[3]); w.z = cvtpk(v1[0], v1[1]); w.w = cvtpk(v1[2], v1[3]);
                *(u32x4*)(rowp + bj * HALF) = w; } }
}
}

namespace att {
constexpr int NW = 8, QBLK = 32, KVBLK = 64;
constexpr int SHM_V = KVBLK * 128 * 2;
constexpr float THR = 8.f;
__device__ __forceinline__ int crow(int r, int hi) { return (r & 3) + 8 * (r >> 2) + 4 * hi; }
template <int DQK> struct Cfg { static constexpr float SCALE = (DQK == 128) ? 0.088388347648318440f : 0.072168783648703220f; static constexpr int KP = DQK * 2, SHM_K = KVBLK * DQK * 2, ND = DQK / 16; };
#define KSWZ(PITCH, row, colB) ((row) * (PITCH) + ((colB) ^ (((row) & 7) << 4)))
template <int DQK> __device__ __forceinline__ void partialSM(f32x16& p0, f32x16& p1, float& m_reg, float& mn, float& alpha) {
    constexpr float SCALE = Cfg<DQK>::SCALE, C = SCALE * 1.4426950408889634f;
    float pmax = p0[0];
#pragma unroll
    for (int r = 1; r < 16; ++r) pmax = fmaxf(pmax, p0[r]);
#pragma unroll
    for (int r = 0; r < 16; ++r) pmax = fmaxf(pmax, p1[r]);
    { auto rr = __builtin_amdgcn_permlane32_swap(__float_as_uint(pmax), __float_as_uint(pmax), false, false);
      pmax = fmaxf(__uint_as_float(rr[0]), __uint_as_float(rr[1])); }
    if (__builtin_expect(__all(pmax - m_reg <= THR / SCALE), 1)) { mn = m_reg; alpha = 1.f; }
    else { mn = fmaxf(m_reg, pmax); alpha = __builtin_amdgcn_exp2f((m_reg - mn) * C); m_reg = mn; }
    const float mnC = -mn * C;
#pragma unroll
    for (int r = 0; r < 16; ++r) p0[r] = fmaf(p0[r], C, mnC);
#pragma unroll
    for (int r = 0; r < 16; ++r) p1[r] = fmaf(p1[r], C, mnC);
#pragma unroll
    for (int r = 0; r < 16; ++r) p0[r] = __builtin_amdgcn_exp2f(p0[r]);
}
__device__ __forceinline__ void finishSM(f32x16& p0, f32x16& p1, float alpha, float& l_reg, bf16x8& pa0, bf16x8& pa1, bf16x8& pa2, bf16x8& pa3) {
#pragma unroll
    for (int r = 0; r < 16; ++r) p1[r] = __builtin_amdgcn_exp2f(p1[r]);
    float ps = 0;
#pragma unroll
    for (int r = 0; r < 16; ++r) ps += p0[r];
#pragma unroll
    for (int r = 0; r < 16; ++r) ps += p1[r];
    { auto rr = __builtin_amdgcn_permlane32_swap(__float_as_uint(ps), __float_as_uint(ps), false, false);
      ps = __uint_as_float(rr[0]) + __uint_as_float(rr[1]); }
    l_reg = l_reg * alpha + ps;
#define PK4(P, BASE, OUT) do { unsigned a0 = cvtpk(P[BASE + 0], P[BASE + 1]), a1 = cvtpk(P[BASE + 2], P[BASE + 3]);   \
    unsigned b0 = cvtpk(P[BASE + 4], P[BASE + 5]), b1 = cvtpk(P[BASE + 6], P[BASE + 7]);                              \
    auto r0 = __builtin_amdgcn_permlane32_swap(a0, b0, false, false); auto r1 = __builtin_amdgcn_permlane32_swap(a1, b1, false, false); \
    u32x4 w = {r0[0], r1[0], r0[1], r1[1]}; OUT = *reinterpret_cast<bf16x8*>(&w); } while (0)
    PK4(p0, 0, pa0); PK4(p0, 8, pa1); PK4(p1, 0, pa2); PK4(p1, 8, pa3);
#undef PK4
}
template <int DQK> __device__ __forceinline__ void qkt(f32x16& p0, f32x16& p1, const LAS char* Ks, const bf16x8* qr, int r32, int hi) {
    constexpr int KP = Cfg<DQK>::KP, ND = Cfg<DQK>::ND;
    p0 = f32x16{}; p1 = f32x16{};
#pragma unroll
    for (int d0 = 0; d0 < ND; ++d0) { const int cb = (d0 * 16 + hi * 8) * 2;
        bf16x8 b0 = *reinterpret_cast<const LAS bf16x8*>(Ks + KSWZ(KP, r32, cb));
        bf16x8 b1 = *reinterpret_cast<const LAS bf16x8*>(Ks + KSWZ(KP, 32 + r32, cb));
        p0 = __builtin_amdgcn_mfma_f32_32x32x16_bf16(b0, qr[d0], p0, 0, 0, 0);
        p1 = __builtin_amdgcn_mfma_f32_32x32x16_bf16(b1, qr[d0], p1, 0, 0, 0); }
}
__device__ __forceinline__ int v_st(int k, int c) { const int kk = (k & ~0xC) | ((k & 4) << 1) | ((k & 8) >> 1); return ((kk >> 3) * 4 + (c >> 5)) * 512 + ((kk & 7) * 32 + (c & 31)) * 2; }
__device__ __forceinline__ int v_rd_base(int lane) { return ((lane & 3) << 3) | (((lane >> 2) & 3) << 6) | (((lane >> 4) & 1) << 5) | (((lane >> 5) & 1) << 8); }
constexpr int v_rd_off(int d0, int ks, int half) { return d0 * 512 + ks * 4096 + half * 2048; }
template <int OFF> __device__ __forceinline__ s16x4 tr_read(int vb) {
    s16x4 r; asm volatile("ds_read_b64_tr_b16 %0, %1 offset:%2" : "=&v"(r) : "v"(vb), "i"(OFF) : "memory"); return r;
}
template <int D0> __device__ __forceinline__ void pv_one(f32x16& od, int vb, bf16x8 pa0, bf16x8 pa1, bf16x8 pa2, bf16x8 pa3) {
    const s16x4 l0 = tr_read<v_rd_off(D0, 0, 0)>(vb), h0 = tr_read<v_rd_off(D0, 0, 1)>(vb), l1 = tr_read<v_rd_off(D0, 1, 0)>(vb), h1 = tr_read<v_rd_off(D0, 1, 1)>(vb);
    const s16x4 l2 = tr_read<v_rd_off(D0, 2, 0)>(vb), h2 = tr_read<v_rd_off(D0, 2, 1)>(vb), l3 = tr_read<v_rd_off(D0, 3, 0)>(vb), h3 = tr_read<v_rd_off(D0, 3, 1)>(vb);
    asm volatile("s_waitcnt lgkmcnt(0)" ::: "memory"); SBAR();
#define PK(L, H) (bf16x8){L[0], L[1], L[2], L[3], H[0], H[1], H[2], H[3]}
    od = __builtin_amdgcn_mfma_f32_32x32x16_bf16(pa0, PK(l0, h0), od, 0, 0, 0);
    od = __builtin_amdgcn_mfma_f32_32x32x16_bf16(pa1, PK(l1, h1), od, 0, 0, 0);
    od = __builtin_amdgcn_mfma_f32_32x32x16_bf16(pa2, PK(l2, h2), od, 0, 0, 0);
    od = __builtin_amdgcn_mfma_f32_32x32x16_bf16(pa3, PK(l3, h3), od, 0, 0, 0);
#undef PK
}
__device__ __forceinline__ void pv_d0(f32x16* o, int vb, bf16x8 pa0, bf16x8 pa1, bf16x8 pa2, bf16x8 pa3) {
    pv_one<0>(o[0], vb, pa0, pa1, pa2, pa3); pv_one<1>(o[1], vb, pa0, pa1, pa2, pa3); pv_one<2>(o[2], vb, pa0, pa1, pa2, pa3); pv_one<3>(o[3], vb, pa0, pa1, pa2, pa3);
}
__device__ __forceinline__ bf16x8 ld8(const bf16_t* p) { return *reinterpret_cast<const bf16x8*>(p); }
__device__ __forceinline__ void rope_frag(bf16x8& a, bf16x8& b, const f32x2* tab) {
    u32x4 wa = *reinterpret_cast<u32x4*>(&a), wb = *reinterpret_cast<u32x4*>(&b), oa, ob;
#pragma unroll
    for (int q = 0; q < 4; ++q) {
        const float x1l = bflo(wa[q]), x1h = bfhi(wa[q]), x2l = bflo(wb[q]), x2h = bfhi(wb[q]);
        const f32x2 t0 = tab[2 * q], t1 = tab[2 * q + 1];
        oa[q] = cvtpk(x1l * t0.x - x2l * t0.y, x1h * t1.x - x2h * t1.y);
        ob[q] = cvtpk(x2l * t0.x + x1l * t0.y, x2h * t1.x + x1h * t1.y);
    }
    a = *reinterpret_cast<bf16x8*>(&oa); b = *reinterpret_cast<bf16x8*>(&ob);
}
template <int DQK, int SDEPTH, bool MLA, int ldq, int ldkv, int ldo>
__device__ __forceinline__ void attn_unit(const bf16_t* __restrict__ Qb, const bf16_t* __restrict__ Kh, const bf16_t* __restrict__ KRh, const bf16_t* __restrict__ Vh,
                                          bf16_t* __restrict__ Ob, int seq, LAS char* lds, const f32x2* __restrict__ tabm, int qt0) {
    constexpr int KP = Cfg<DQK>::KP, SHM_K = Cfg<DQK>::SHM_K, ND = Cfg<DQK>::ND;
    const int tid = threadIdx.x, wid = tid >> 6, lane = tid & 63, r32 = lane & 31, hi = lane >> 5;
    LAS char* V_lds = lds; LAS char* K_lds = lds + 2 * SHM_V;
    LAS float* wsl = (LAS float*)(lds + 2 * SHM_V + 2 * SHM_K) + wid * 64; LAS float* li_l = wsl; LAS float* al_l = wsl + 32;
    float m_reg = -1e30f, l_reg = 0; f32x16 o[4] = {}; bf16x8 qr[ND];
    const bf16_t* Qw = Qb + (long)(wid * QBLK + r32) * ldq + hi * 8;
#pragma unroll
    for (int d0 = 0; d0 < ND; ++d0) qr[d0] = ld8(Qw + d0 * 16);
    if constexpr (MLA) {
        const int t = qt0 + wid * QBLK + r32, prow = t >> 6, pcol = t & 63;
        rope_frag(qr[8], qr[9], tabm + prow * 16 + hi * 8);
        rope_frag(qr[10], qr[11], tabm + pcol * 16 + hi * 8);
    }
    const int sr = tid >> 4, sc = (tid & 15) * 8, vst0 = v_st(sr, sc), vst1 = v_st(32 + sr, sc);
    const int krr = tid >> 3, krc = (tid & 7) * 8;
    const int vb0 = (int)(unsigned)(uintptr_t)V_lds + v_rd_base(lane);
    struct { bf16x8 vs0, vs1, ks0, ks1, kr; } sr_[SDEPTH];
#define SLOAD(i, k0) do { sr_[i].vs0 = ld8(&Vh[(long)((k0) + sr) * ldkv + sc]); sr_[i].vs1 = ld8(&Vh[(long)((k0) + 32 + sr) * ldkv + sc]); \
    sr_[i].ks0 = ld8(&Kh[(long)((k0) + sr) * ldkv + sc]); sr_[i].ks1 = ld8(&Kh[(long)((k0) + 32 + sr) * ldkv + sc]); \
    if constexpr (MLA) sr_[i].kr = ld8(&KRh[(long)((k0) + krr) * 64 + krc]); } while (0)
#define SWRITE(b, i) do { *(LAS bf16x8*)(V_lds + (b) * SHM_V + vst0) = sr_[i].vs0;          \
    *(LAS bf16x8*)(V_lds + (b) * SHM_V + vst1) = sr_[i].vs1; const int kc = sc * 2;               \
    *(LAS bf16x8*)(K_lds + (b) * SHM_K + KSWZ(KP, sr, kc)) = sr_[i].ks0;                       \
    *(LAS bf16x8*)(K_lds + (b) * SHM_K + KSWZ(KP, 32 + sr, kc)) = sr_[i].ks1;                  \
    if constexpr (MLA) *(LAS bf16x8*)(K_lds + (b) * SHM_K + KSWZ(KP, krr, 256 + krc * 2)) = sr_[i].kr; } while (0)
#define SWAIT() do { if constexpr (SDEPTH == 2) { if constexpr (MLA) asm volatile("s_waitcnt vmcnt(5)" ::: "memory"); else asm volatile("s_waitcnt vmcnt(4)" ::: "memory"); } else asm volatile("s_waitcnt vmcnt(0)" ::: "memory"); } while (0)
#define RESC(a) do { if (__any((a) < 1.f)) { if (hi == 0) al_l[r32] = (a); asm volatile("s_waitcnt lgkmcnt(0)" ::: "memory"); \
    _Pragma("unroll") for (int d = 0; d < 4; ++d) _Pragma("unroll") for (int r = 0; r < 16; ++r) o[d][r] *= al_l[crow(r, hi)]; } } while (0)
    bf16x8 pa0, pa1, pa2, pa3; const int NT = seq / KVBLK;
    if constexpr (MLA) {
        f32x16 p0, p1; float mn, al;
        SLOAD(0, 0); asm volatile("s_waitcnt vmcnt(0)" ::: "memory"); SWRITE(0, 0); SLOAD(0, KVBLK); __syncthreads();
        for (int j = 0; j < NT; ++j) {
            const int cb = j & 1;
            if (j + 1 < NT) { asm volatile("s_waitcnt vmcnt(0)" ::: "memory"); SWRITE(cb ^ 1, 0); if (j + 2 < NT) SLOAD(0, (j + 2) * KVBLK); }
            SBAR(); qkt<DQK>(p0, p1, K_lds + cb * SHM_K, qr, r32, hi);
            partialSM<DQK>(p0, p1, m_reg, mn, al); RESC(al);
            finishSM(p0, p1, al, l_reg, pa0, pa1, pa2, pa3); SBAR();
            pv_d0(o, vb0 + cb * SHM_V, pa0, pa1, pa2, pa3);
            __syncthreads();
        }
    } else {
    f32x16 pA0, pA1, pB0, pB1; float mnA, mnB, alA, alB;
    constexpr int SE = 0, SO = SDEPTH - 1;
    SLOAD(SE, 0); asm volatile("s_waitcnt vmcnt(0)" ::: "memory"); SWRITE(0, SE); __syncthreads();
    qkt<DQK>(pA0, pA1, K_lds, qr, r32, hi); partialSM<DQK>(pA0, pA1, m_reg, mnA, alA);
    SLOAD(SO, KVBLK); if constexpr (SDEPTH == 2) { if (2 < NT) SLOAD(SE, 2 * KVBLK); }
    SWAIT(); SWRITE(1, SO); __syncthreads();
    for (int j = 1; j + 1 < NT; j += 2) {
        SBAR(); qkt<DQK>(pB0, pB1, K_lds + SHM_K, qr, r32, hi);
        finishSM(pA0, pA1, alA, l_reg, pa0, pa1, pa2, pa3); SBAR();
        SLOAD(SO, (j + SDEPTH) * KVBLK); SBAR();
        pv_d0(o, vb0, pa0, pa1, pa2, pa3); partialSM<DQK>(pB0, pB1, m_reg, mnB, alB);
        __syncthreads(); SWAIT(); SWRITE(0, SE);
        RESC(alB); __syncthreads();
        SBAR(); qkt<DQK>(pA0, pA1, K_lds, qr, r32, hi);
        finishSM(pB0, pB1, alB, l_reg, pa0, pa1, pa2, pa3); SBAR();
        if (SDEPTH == 1 || j + 3 < NT) SLOAD(SE, (j + 1 + SDEPTH) * KVBLK); SBAR();
        pv_d0(o, vb0 + SHM_V, pa0, pa1, pa2, pa3); partialSM<DQK>(pA0, pA1, m_reg, mnA, alA);
        __syncthreads(); SWAIT(); SWRITE(1, SO);
        RESC(alA); __syncthreads();
    }
    SBAR(); qkt<DQK>(pB0, pB1, K_lds + SHM_K, qr, r32, hi);
    finishSM(pA0, pA1, alA, l_reg, pa0, pa1, pa2, pa3); SBAR();
    pv_d0(o, vb0, pa0, pa1, pa2, pa3); partialSM<DQK>(pB0, pB1, m_reg, mnB, alB);
    __syncthreads(); RESC(alB);
    finishSM(pB0, pB1, alB, l_reg, pa0, pa1, pa2, pa3); SBAR();
    pv_d0(o, vb0 + SHM_V, pa0, pa1, pa2, pa3);
    }
    if (hi == 0) li_l[r32] = l_reg; asm volatile("s_waitcnt lgkmcnt(0)" ::: "memory");
    float rli[16];
#pragma unroll
    for (int r = 0; r < 16; ++r) rli[r] = __builtin_amdgcn_rcpf(li_l[crow(r, hi)]);
    bf16_t* Ow = Ob + (long)(wid * QBLK) * ldo;
#pragma unroll
    for (int r = 0; r < 16; ++r) { const int orow = crow(r, hi);
#pragma unroll
        for (int d0 = 0; d0 < 4; ++d0) Ow[(long)orow * ldo + d0 * 32 + r32] = f2bf(o[d0][r] * rli[r]); }
    __syncthreads();
#undef SLOAD
#undef SWRITE
#undef SWAIT
#undef RESC
}
}

template <int MODE> __device__ __forceinline__ int dst_row(int n) {
    if (MODE == 1) { const int half = n >> 10, c = n & 1023; return ((c >> 7) << 8) + (half << 7) + (c & 127); }
    if (MODE == 2) { const int h = n >> 8, j = n & 255; return j < 128 ? (h << 7) + j : 1024 + (h << 7) + (j - 128); }
    return n;
}
template <int MODE> __device__ __forceinline__ void p0_transpose_item(const float* W, int K, int N, bf16_t* WT, LAS float* scr, int item, int lane) {
    const int nblk = N / 32, kb = item / nblk, nb = item % nblk, k0 = 64 * kb, n0 = 32 * nb;
#pragma unroll 8
    for (int i = 0; i < 32; ++i) { const int kk = 2 * i + (lane >> 5); scr[kk * 33 + (lane & 31)] = W[(size_t)(k0 + kk) * N + n0 + (lane & 31)]; }
    LDS_WAIT(); asm volatile("" ::: "memory");
    const int c = lane & 7;
#pragma unroll
    for (int j = 0; j < 4; ++j) { const int n = (lane >> 3) + 8 * j; const LAS float* s = scr + (8 * c) * 33 + n;
        u32x4 o; o.x = cvtpk(s[0 * 33], s[1 * 33]); o.y = cvtpk(s[2 * 33], s[3 * 33]); o.z = cvtpk(s[4 * 33], s[5 * 33]); o.w = cvtpk(s[6 * 33], s[7 * 33]);
        *(u32x4*)(WT + (size_t)dst_row<MODE>(n0 + n) * K + k0 + 8 * c) = o; }
    LDS_WAIT(); asm volatile("" ::: "memory");
}
__device__ __forceinline__ void p0_prologue(Frame& F) {
    uchar* ws = F.ws;
    {
        LAS float* S = (LAS float*)F.lds;
        const float* pC = INP(I_C); const float* pCC = INP(I_CCTX); const float* pAW = INP(I_ADAW); const float* pAB = INP(I_ADAB); const float* pNM = INP(I_NMIXG); const float* pNF = INP(I_NFFNG);
        float* MOD = (float*)(ws + WS_MOD);
        for (int item = F.bid; item < 192; item += F.G) {
            const int layer = item / 96, n0 = (item % 96) * 64;
            __syncthreads();
            for (int u = F.tid; u < 33 * 1024; u += 512) { const int j = u >> 10, k = u & 1023; const float c = j < 32 ? pC[j * 1024 + k] : pCC[k]; S[u] = silu_f(c); }
            __syncthreads();
            float acc[33];
#pragma unroll
            for (int j = 0; j < 33; ++j) acc[j] = 0.f;
            const float* wp = pAW + (size_t)layer * 1024 * 6144 + n0 + F.lane;
            const int kbeg = F.wave * 128;
            for (int k = kbeg; k < kbeg + 128; k += 4) {
                const float w0 = wp[(size_t)k * 6144], w1 = wp[(size_t)(k + 1) * 6144], w2 = wp[(size_t)(k + 2) * 6144], w3 = wp[(size_t)(k + 3) * 6144];
#pragma unroll
                for (int j = 0; j < 33; ++j) { const f32x4 s = *(const LAS f32x4*)(S + j * 1024 + k); acc[j] += s.x * w0 + s.y * w1 + s.z * w2 + s.w * w3; }
            }
            __syncthreads();
#pragma unroll
            for (int j = 0; j < 33; ++j) S[(F.wave * 33 + j) * 64 + F.lane] = acc[j];
            __syncthreads();
            for (int u = F.tid; u < 33 * 64; u += 512) { const int j = u >> 6, cl = u & 63; float s = 0.f;
#pragma unroll
                for (int w = 0; w < 8; ++w) s += S[(w * 33 + j) * 64 + cl];
                const int n = n0 + cl, part = n >> 10, col = n & 1023;
                s += pAB[layer * 6144 + n];
                if (part == 1) s = pNM[layer * 1024 + col] * (1.f + s);
                if (part == 4) s = pNF[layer * 1024 + col] * (1.f + s);
                MOD[((size_t)(layer * 33 + j) * 6 + part) * 1024 + col] = s; }
        }
        __syncthreads();
    }
    {
        const int gt = F.bid * 512 + F.tid, NT = F.G * 512;
        f32x2* tg = (f32x2*)(ws + WS_TABG); f32x2* tm = (f32x2*)(ws + WS_TABM);
        for (int u = gt; u < 64 * 32; u += NT) { const int pos = u >> 5, i = u & 31; const float inv = powf(10000.f, -(float)(2 * i) / 64.f); const float a = (float)pos * inv; tg[u] = (f32x2){cosf(a), sinf(a)}; }
        for (int u = gt; u < 64 * 16; u += NT) { const int pos = u >> 4, i = u & 15; const float inv = powf(10000.f, -(float)(2 * i) / 32.f); const float a = (float)pos * inv; tm[u] = (f32x2){cosf(a), sinf(a)}; }
        float* wrt = (float*)(ws + WS_WRT); const float* pRW = INP(I_RW); const float* pSW = INP(I_SGUW);
        for (int u = gt; u < 2 * 32 * 1024; u += NT) { const int l = u >> 15, e = (u >> 10) & 31, k = u & 1023; wrt[u] = pRW[((size_t)l * 1024 + k) * 32 + e]; }
        bf16_t* sw = (bf16_t*)(ws + WS_SGUW);
        for (int u = gt; u < 4 * 128 * 128; u += NT) sw[u] = f2bf(pSW[u]);
        u32x4* z = (u32x4*)(ws + WS_WIN1 + (size_t)832 * 1024 * 2);
        for (int u = gt; u < 192 * 1024 * 2 / 16; u += NT) z[u] = (u32x4){0u, 0u, 0u, 0u};
    }
    {
        LAS float* scr = (LAS float*)(F.lds + F.wave * 16384);
        const int gw = F.bid * 8 + F.wave, NGW = F.G * 8; const float* pW1 = INP(I_W1); const float* pW2 = INP(I_W2);
        constexpr int J0 = 16 * 64, J1 = 16 * 32, J2 = 16 * 26, J3 = 8 * 48, J4 = 4 * 64, J5 = 16 * 32, JW1 = 64 * 1024, JW2 = 64 * 512;
        constexpr int NITEMS = J0 + J1 + J2 + J3 + J4 + J5 + JW1 + JW2;
        for (int it = gw; it < NITEMS; it += NGW) {
            int r = it;
            if (r < JW1) { const int le = r >> 10; p0_transpose_item<1>(pW1 + (size_t)le * 1024 * 2048, 1024, 2048, (bf16_t*)(ws + WS_W1) + (size_t)le * 2048 * 1024, scr, r & 1023, F.lane); continue; } r -= JW1;
            if (r < JW2) { const int le = r >> 9; p0_transpose_item<0>(pW2 + (size_t)le * 1024 * 1024, 1024, 1024, (bf16_t*)(ws + WS_W2) + (size_t)le * 1024 * 1024, scr, r & 511, F.lane); continue; } r -= JW2;
            if (r < J0) { p0_transpose_item<0>(INP(I_ABWIN), 1024, 2048, (bf16_t*)(ws + WS_WIN0), scr, r, F.lane); continue; } r -= J0;
            if (r < J1) { p0_transpose_item<0>(INP(I_ABWOUT), 1024, 1024, (bf16_t*)(ws + WS_WOUT0), scr, r, F.lane); continue; } r -= J1;
            if (r < J2) { p0_transpose_item<0>(INP(I_MLAWIN), 1024, 832, (bf16_t*)(ws + WS_WIN1), scr, r, F.lane); continue; } r -= J2;
            if (r < J3) { p0_transpose_item<0>(INP(I_MLAWUQ), 512, 1536, (bf16_t*)(ws + WS_WUQ), scr, r, F.lane); continue; } r -= J3;
            if (r < J4) { p0_transpose_item<2>(INP(I_MLAWUKV), 256, 2048, (bf16_t*)(ws + WS_WUKV), scr, r, F.lane); continue; } r -= J4;
            p0_transpose_item<0>(INP(I_MLAWOUT), 1024, 1024, (bf16_t*)(ws + WS_WOUT1), scr, r, F.lane);
        }
    }
}

__device__ __forceinline__ void row_src_ptr(const float* px, const float* pctx, int r, const float*& src, int& mj) {
    const int b = r / TPB, pos = r - b * TPB;
    if (pos < CTXL) { src = pctx + ((size_t)b * CTXL + pos) * DM; mj = 32; } else { src = px + ((size_t)b * SEQ + (pos - CTXL)) * DM; mj = b; }
}
__device__ __forceinline__ void store_h_row(bf16_t* hrow, int lane, const f32x4 (&h)[4]) {
    unsigned long long* o8 = (unsigned long long*)hrow + lane;
#pragma unroll
    for (int j = 0; j < 4; ++j) o8[64 * j] = (unsigned long long)cvtpk(h[j].x, h[j].y) | ((unsigned long long)cvtpk(h[j].z, h[j].w) << 32);
}
__device__ __forceinline__ void p_norm0(Frame& F) {
    const float* MOD = (const float*)(F.ws + WS_MOD); bf16_t* H = (bf16_t*)(F.ws + WS_H);
    const int gw = F.bid * 8 + F.wave, NGW = F.G * 8; const float* px = INP(I_X); const float* pctx = INP(I_CTX);
    for (int r = gw; r < NTOK; r += NGW) {
        const float* src; int mj; row_src_ptr(px, pctx, r, src, mj);
        const f32x4* xr = (const f32x4*)src + F.lane; f32x4 v[4]; float ss = 0.f;
#pragma unroll
        for (int j = 0; j < 4; ++j) { v[j] = xr[64 * j]; ss += (v[j].x * v[j].x + v[j].y * v[j].y) + (v[j].z * v[j].z + v[j].w * v[j].w); }
        const float rstd = rsqrtf(wave_sum(ss) * (1.f / DM) + EPS);
        const f32x4* sh = (const f32x4*)(MOD + ((size_t)(0 * 33 + mj) * 6 + 0) * 1024) + F.lane; const f32x4* A = (const f32x4*)(MOD + ((size_t)(0 * 33 + mj) * 6 + 1) * 1024) + F.lane;
        f32x4 h[4];
#pragma unroll
        for (int j = 0; j < 4; ++j) h[j] = v[j] * rstd * A[64 * j] + sh[64 * j];
        store_h_row(H + (size_t)r * DM, F.lane, h);
    }
}
__device__ __forceinline__ void moe_prefix(Frame& F, int layer) {
    LAS int* pb = (LAS int*)(F.lds + XTRA_OFF + X_PB); LAS int* cn = (LAS int*)(F.lds + XTRA_OFF + X_CNT);
    const unsigned* gc = (const unsigned*)(F.ws + WS_CTL) + CW_CNT + layer * 64;
    __syncthreads();
    if (F.tid == 0) { int s = 0; for (int e = 0; e < 32; ++e) { const int c = (int)__hip_atomic_load(gc + e, __ATOMIC_RELAXED, __HIP_MEMORY_SCOPE_AGENT); cn[e] = c; pb[e] = s; s += (c + 255) >> 8; } pb[32] = s; }
    __syncthreads();
}
__device__ __forceinline__ void moe_gather_row(const Frame& F, int r, f32x4 (&f)[4]) {
    const LAS int* pb = (const LAS int*)(F.lds + XTRA_OFF + X_PB);
    const u32x2* ti = (const u32x2*)(F.ws + WS_TOKI) + (size_t)r * 4; const bf16_t* Y = (const bf16_t*)(F.ws + WS_Y);
#pragma unroll
    for (int j = 0; j < 4; ++j) f[j] = (f32x4){0.f, 0.f, 0.f, 0.f};
#pragma unroll
    for (int k = 0; k < 4; ++k) {
        const u32x2 t = ti[k]; const int e = (int)(t.x >> 20), pos = (int)(t.x & 0xfffffu); const float g = __uint_as_float(t.y);
        const size_t yrow = (size_t)pb[e] * 256 + pos; const u32x2* yp = (const u32x2*)(Y + yrow * DM) + F.lane;
#pragma unroll
        for (int j = 0; j < 4; ++j) { const u32x2 w = yp[64 * j]; f[j].x += g * bflo(w.x); f[j].y += g * bfhi(w.x); f[j].z += g * bflo(w.y); f[j].w += g * bfhi(w.y); }
    }
}
__device__ __forceinline__ void p_combine_norm(Frame& F) {
    moe_prefix(F, 0);
    const float* MOD = (const float*)(F.ws + WS_MOD); bf16_t* H = (bf16_t*)(F.ws + WS_H); float* XR = (float*)(F.ws + WS_XR);
    const int gw = F.bid * 8 + F.wave, NGW = F.G * 8;
    for (int r = gw; r < NTOK; r += NGW) {
        const int b = r / TPB, pos = r - b * TPB, mj = pos < CTXL ? 32 : b;
        f32x4 f[4]; moe_gather_row(F, r, f);
        f32x4* xr = (f32x4*)(XR + (size_t)r * DM) + F.lane; const f32x4* g2 = (const f32x4*)(MOD + ((size_t)(0 * 33 + mj) * 6 + 5) * 1024) + F.lane;
        f32x4 v[4]; float ss = 0.f;
#pragma unroll
        for (int j = 0; j < 4; ++j) { v[j] = xr[64 * j] + g2[64 * j] * f[j]; xr[64 * j] = v[j]; ss += (v[j].x * v[j].x + v[j].y * v[j].y) + (v[j].z * v[j].z + v[j].w * v[j].w); }
        const float rstd = rsqrtf(wave_sum(ss) * (1.f / DM) + EPS);
        const f32x4* sh = (const f32x4*)(MOD + ((size_t)(1 * 33 + mj) * 6 + 0) * 1024) + F.lane; const f32x4* A = (const f32x4*)(MOD + ((size_t)(1 * 33 + mj) * 6 + 1) * 1024) + F.lane;
        f32x4 h[4];
#pragma unroll
        for (int j = 0; j < 4; ++j) h[j] = v[j] * rstd * A[64 * j] + sh[64 * j];
        store_h_row(H + (size_t)r * DM, F.lane, h);
    }
}
__device__ __forceinline__ void p_final(Frame& F) {
    moe_prefix(F, 1);
    const float* MOD = (const float*)(F.ws + WS_MOD); const float* XR = (const float*)(F.ws + WS_XR);
    const int gw = F.bid * 8 + F.wave, NGW = F.G * 8; const float* pfg = INP(I_FNG);
    for (int q = gw; q < NBATCH * SEQ; q += NGW) {
        const int b = q >> 11, t = q & 2047, r = b * TPB + CTXL + t;
        f32x4 f[4]; moe_gather_row(F, r, f);
        const f32x4* xr = (const f32x4*)(XR + (size_t)r * DM) + F.lane; const f32x4* g2 = (const f32x4*)(MOD + ((size_t)(1 * 33 + b) * 6 + 5) * 1024) + F.lane;
        f32x4 v[4]; float ss = 0.f;
#pragma unroll
        for (int j = 0; j < 4; ++j) { v[j] = xr[64 * j] + g2[64 * j] * f[j]; ss += (v[j].x * v[j].x + v[j].y * v[j].y) + (v[j].z * v[j].z + v[j].w * v[j].w); }
        const float rstd = rsqrtf(wave_sum(ss) * (1.f / DM) + EPS);
        const f32x4* fg = (const f32x4*)pfg + F.lane; f32x4* op = (f32x4*)(F.out + (size_t)q * DM) + F.lane;
#pragma unroll
        for (int j = 0; j < 4; ++j) op[64 * j] = v[j] * rstd * fg[64 * j];
    }
}
template <int LAYER> __device__ __forceinline__ void p_norm_router(Frame& F) {
    const float* MOD = (const float*)(F.ws + WS_MOD); bf16_t* H = (bf16_t*)(F.ws + WS_H); const float* XR = (const float*)(F.ws + WS_XR);
    LAS float* WL = (LAS float*)F.lds;
    LAS int* hist = (LAS int*)(F.lds + XTRA_OFF + X_HIST); LAS int* base = (LAS int*)(F.lds + XTRA_OFF + X_BASE); LAS u32x4* sel = (LAS u32x4*)(F.lds + XTRA_OFF + X_SEL);
    unsigned* gcnt = (unsigned*)(F.ws + WS_CTL) + CW_CNT + LAYER * 64;
    int* rowl = (int*)(F.ws + WS_ROWL); u32x2* toki = (u32x2*)(F.ws + WS_TOKI);
    __syncthreads();
    { const f32x4* src = (const f32x4*)(F.ws + WS_WRT + (size_t)LAYER * 32 * 1024 * 4); for (int u = F.tid; u < 8192; u += 512) ((LAS f32x4*)WL)[u] = src[u]; }
    if (F.tid < 32) hist[F.tid] = 0;
    __syncthreads();
    const int lane = F.lane; const float* prb = INP(I_RB);
    constexpr int NP = LAYER == 0 ? NPAN : 256;
    for (int pi = F.bid; pi < NP; pi += F.G) {
        const int pan = LAYER == 0 ? pi : pi + pi / 8 + 1;
        const int b = pan / 9, mj = (pan % 9 == 0) ? 32 : b;
        const f32x4* shp = (const f32x4*)(MOD + ((size_t)(LAYER * 33 + mj) * 6 + 3) * 1024) + lane; const f32x4* Ap = (const f32x4*)(MOD + ((size_t)(LAYER * 33 + mj) * 6 + 4) * 1024) + lane;
        for (int g8 = 0; g8 < 8; ++g8) {
            const int rl0 = F.wave * 32 + g8 * 4, r0 = pan * 256 + rl0;
            f32x4 hv[4][4];
#pragma unroll
            for (int rr = 0; rr < 4; ++rr) { const f32x4* xr = (const f32x4*)(XR + (size_t)(r0 + rr) * DM) + lane; float ss = 0.f;
#pragma unroll
                for (int j = 0; j < 4; ++j) { hv[rr][j] = xr[64 * j]; ss += (hv[rr][j].x * hv[rr][j].x + hv[rr][j].y * hv[rr][j].y) + (hv[rr][j].z * hv[rr][j].z + hv[rr][j].w * hv[rr][j].w); }
                const float rstd = rsqrtf(wave_sum(ss) * (1.f / DM) + EPS);
#pragma unroll
                for (int j = 0; j < 4; ++j) hv[rr][j] = hv[rr][j] * rstd * Ap[64 * j] + shp[64 * j];
                store_h_row(H + (size_t)(r0 + rr) * DM, lane, hv[rr]);
            }
            const int e3 = ((lane >> 5) & 1) * 4 + ((lane >> 4) & 1) * 2 + ((lane >> 3) & 1);
            const int myidx = (lane & 3) * 8 + e3; float myv[4] = {0.f, 0.f, 0.f, 0.f};
#pragma unroll 1
            for (int q = 0; q < 4; ++q) {
                float acc[4][8];
#pragma unroll
                for (int rr = 0; rr < 4; ++rr)
#pragma unroll
                    for (int e = 0; e < 8; ++e) acc[rr][e] = 0.f;
                const LAS float* wq = WL + q * 8 * 1024 + 4 * lane;
#pragma unroll
                for (int e = 0; e < 8; ++e)
#pragma unroll
                    for (int j = 0; j < 4; ++j) { const f32x4 w = *(const LAS f32x4*)(wq + e * 1024 + 256 * j);
#pragma unroll
                        for (int rr = 0; rr < 4; ++rr) acc[rr][e] += (hv[rr][j].x * w.x + hv[rr][j].y * w.y) + (hv[rr][j].z * w.z + hv[rr][j].w * w.w); }
                const float rbq = prb[LAYER * 32 + q * 8 + e3];
#pragma unroll
                for (int rr = 0; rr < 4; ++rr) {
                    float v4[4], v2[2], v1;
                    { const bool up = (lane >> 5) & 1;
#pragma unroll
                      for (int e = 0; e < 4; ++e) { const float keep = up ? acc[rr][e + 4] : acc[rr][e], send = up ? acc[rr][e] : acc[rr][e + 4]; v4[e] = keep + __shfl_xor(send, 32); } }
                    { const bool up = (lane >> 4) & 1;
#pragma unroll
                      for (int e = 0; e < 2; ++e) { const float keep = up ? v4[e + 2] : v4[e], send = up ? v4[e] : v4[e + 2]; v2[e] = keep + __shfl_xor(send, 16); } }
                    { const bool up = (lane >> 3) & 1; const float keep = up ? v2[1] : v2[0], send = up ? v2[0] : v2[1]; v1 = keep + __shfl_xor(send, 8); }
                    v1 += __shfl_xor(v1, 4); v1 += __shfl_xor(v1, 2); v1 += __shfl_xor(v1, 1);
                    myv[rr] = ((lane & 3) == q) ? v1 + rbq : myv[rr];
                }
            }
#pragma unroll
            for (int rr = 0; rr < 4; ++rr) {
                float mv = myv[rr], t0 = 0.f, myt = 0.f, esum = 0.f; int mye = 0;
#pragma unroll
                for (int k = 0; k < 4; ++k) {
                    const unsigned ub = __float_as_uint(mv); const unsigned ord = (ub & 0x80000000u) ? ~ub : (ub | 0x80000000u);
                    unsigned kv = ord, ki = (unsigned)(31 - myidx);
#pragma unroll
                    for (int o = 1; o < 64; o <<= 1) { const unsigned ov = (unsigned)__shfl_xor((int)kv, o), oi = (unsigned)__shfl_xor((int)ki, o); const bool tk = (ov > kv) || (ov == kv && oi > ki); kv = tk ? ov : kv; ki = tk ? oi : ki; }
                    const int widx = 31 - (int)ki;
                    const unsigned wo = kv; const unsigned wb = (wo & 0x80000000u) ? (wo & 0x7fffffffu) : ~wo; const float tvk = __uint_as_float(wb);
                    if (k == 0) t0 = tvk;
                    esum += __expf(tvk - t0);
                    mye = (lane == k) ? widx : mye; myt = (lane == k) ? tvk : myt;
                    asm volatile("" : "+v"(mye), "+v"(myt));
                    if (myidx == widx) mv = -3.0e38f;
                }
                if (lane < 4) { const int e = mye; const float g = __expf(myt - t0) / esum;
                    const int rank = __hip_atomic_fetch_add(hist + e, 1, __ATOMIC_RELAXED, __HIP_MEMORY_SCOPE_WORKGROUP);
                    sel[(rl0 + rr) * 4 + lane] = (u32x4){(unsigned)e, (unsigned)rank, __float_as_uint(g), 0u}; }
            }
        }
        __syncthreads();
        if (F.tid < 32) { const int c = hist[F.tid]; base[F.tid] = c ? (int)__hip_atomic_fetch_add(gcnt + F.tid, (unsigned)c, __ATOMIC_RELAXED, __HIP_MEMORY_SCOPE_AGENT) : 0; }
        __syncthreads();
        for (int u = F.tid; u < 1024; u += 512) { const u32x4 s = sel[u]; const int e = (int)s.x, pos = base[e] + (int)s.y, r = pan * 256 + (u >> 2);
            rowl[(size_t)e * ROWCAP + pos] = r; toki[(size_t)r * 4 + (u & 3)] = (u32x2){((unsigned)e << 20) | (unsigned)pos, s.z}; }
        __syncthreads();
        if (F.tid < 32) hist[F.tid] = 0;
        __syncthreads();
    }
}

__device__ __forceinline__ void p_qk_prep(Frame& F) {
    bf16_t* P = (bf16_t*)(F.ws + WS_PBUF); const f32x2* tab = (const f32x2*)(F.ws + WS_TABG);
    const int gw = F.bid * 8 + F.wave, NGW = F.G * 8, lane = F.lane, half = lane >> 5, i = lane & 31, d1 = 64 * half + i, d2 = d1 + 32;
    const float gq1 = INP(I_GQG)[d1], gq2 = INP(I_GQG)[d2], gk1 = INP(I_GKG)[d1], gk2 = INP(I_GKG)[d2];
    for (int r = gw; r < NTOK; r += NGW) {
        const int b = r / TPB, pos = r - b * TPB; const bool lat = pos >= CTXL; const int t = pos - CTXL, pp = half ? (t & 63) : (t >> 6);
        f32x2 cs = (f32x2){1.f, 0.f}; if (lat) cs = tab[pp * 32 + i];
        bf16_t* base = P + (size_t)r * 2048 + 1024;
        float x1[6], x2[6];
#pragma unroll
        for (int s = 0; s < 6; ++s) { x1[s] = bf2f(base[s * 128 + d1]); x2[s] = bf2f(base[s * 128 + d2]); }
#pragma unroll
        for (int s = 0; s < 6; ++s) {
            const float rstd = rsqrtf(wave_sum(x1[s] * x1[s] + x2[s] * x2[s]) * (1.f / 128.f) + EPS);
            const float y1 = x1[s] * rstd * (s < 4 ? gq1 : gk1), y2 = x2[s] * rstd * (s < 4 ? gq2 : gk2);
            base[s * 128 + d1] = f2bf(y1 * cs.x - y2 * cs.y); base[s * 128 + d2] = f2bf(y2 * cs.x + y1 * cs.y);
        }
    }
}
__device__ __forceinline__ void p_mla_prep(Frame& F) {
    bf16_t* P = (bf16_t*)(F.ws + WS_PBUF); bf16_t* KR = (bf16_t*)(F.ws + WS_KRB); const f32x2* tab = (const f32x2*)(F.ws + WS_TABM);
    const int gw = F.bid * 8 + F.wave, NGW = F.G * 8, lane = F.lane;
    float qg[8], kg[4];
#pragma unroll
    for (int j = 0; j < 8; ++j) qg[j] = INP(I_MLAQG)[8 * lane + j];
#pragma unroll
    for (int j = 0; j < 4; ++j) kg[j] = INP(I_MLAKVG)[4 * lane + j];
    for (int r = gw; r < NTOK; r += NGW) {
        const int b = r / TPB, pos = r - b * TPB; const bool lat = pos >= CTXL; const int t = pos - CTXL;
        bf16_t* base = P + (size_t)r * 1024;
        if (lat) {
            u32x4 w = *(const u32x4*)(base + 8 * lane); float x[8];
#pragma unroll
            for (int q = 0; q < 4; ++q) { x[2 * q] = bflo(w[q]); x[2 * q + 1] = bfhi(w[q]); }
            float ss = 0.f;
#pragma unroll
            for (int j = 0; j < 8; ++j) ss += x[j] * x[j];
            const float rstd = rsqrtf(wave_sum(ss) * (1.f / 512.f) + EPS);
#pragma unroll
            for (int q = 0; q < 4; ++q) w[q] = cvtpk(x[2 * q] * rstd * qg[2 * q], x[2 * q + 1] * rstd * qg[2 * q + 1]);
            *(u32x4*)(base + 8 * lane) = w;
        }
        {
            u32x2 w = *(const u32x2*)(base + 512 + 4 * lane); float x[4] = {bflo(w.x), bfhi(w.x), bflo(w.y), bfhi(w.y)};
            const float ss = (x[0] * x[0] + x[1] * x[1]) + (x[2] * x[2] + x[3] * x[3]);
            const float rstd = rsqrtf(wave_sum(ss) * (1.f / 256.f) + EPS);
            w.x = cvtpk(x[0] * rstd * kg[0], x[1] * rstd * kg[1]); w.y = cvtpk(x[2] * rstd * kg[2], x[3] * rstd * kg[3]);
            *(u32x2*)(base + 512 + 4 * lane) = w;
        }
        if (lane < 32) {
            const int half = lane >> 4, i = lane & 15, d1 = 32 * half + i, d2 = d1 + 16;
            const float x1 = bf2f(base[768 + d1]), x2 = bf2f(base[768 + d2]);
            f32x2 cs = (f32x2){1.f, 0.f}; if (lat) cs = tab[(half ? (t & 63) : (t >> 6)) * 16 + i];
            KR[(size_t)r * 64 + d1] = f2bf(x1 * cs.x - x2 * cs.y); KR[(size_t)r * 64 + d2] = f2bf(x2 * cs.x + x1 * cs.y);
        }
    }
}
__device__ __forceinline__ void p_sgu(Frame& F) {
    const bf16_t* P = (const bf16_t*)(F.ws + WS_PBUF); bf16_t* MIX = (bf16_t*)(F.ws + WS_MIX0); const bf16_t* SW = (const bf16_t*)(F.ws + WS_SGUW);
    const int tid = F.tid, lane = F.lane, wid = F.wave, hw = wid >> 2, w4 = wid & 3, th = tid & 255, r32 = lane & 31, hi = lane >> 5;
    LAS char* Vl = (LAS char*)F.lds + hw * 32768;
    const int sr = th >> 4, sc = (th & 15) * 8;
    const int vb0 = (int)(unsigned)(uintptr_t)Vl + att::v_rd_base(lane);
    const float* psg = INP(I_SGUNG); const float* psb = INP(I_SGUB);
    for (int U = F.bid; U < (NTOK / 128) * 2; U += F.G) {
        const int chunk = U >> 1, g = (U & 1) * 2 + hw; const size_t row0 = (size_t)chunk * 128;
        float gn[8];
#pragma unroll
        for (int j = 0; j < 8; ++j) gn[j] = psg[g * 128 + sc + j];
        __syncthreads();
#pragma unroll
        for (int i = 0; i < 8; ++i) {
            const int q = sr + 16 * i;
            u32x4 w = *(const u32x4*)(P + (row0 + q) * 2048 + 512 + g * 128 + sc); float x[8];
#pragma unroll
            for (int k = 0; k < 4; ++k) { x[2 * k] = bflo(w[k]); x[2 * k + 1] = bfhi(w[k]); }
            float ss = 0.f;
#pragma unroll
            for (int j = 0; j < 8; ++j) ss += x[j] * x[j];
            ss += __shfl_xor(ss, 1); ss += __shfl_xor(ss, 2); ss += __shfl_xor(ss, 4); ss += __shfl_xor(ss, 8);
            const float rstd = rsqrtf(ss * (1.f / 128.f) + EPS);
#pragma unroll
            for (int k = 0; k < 4; ++k) w[k] = cvtpk(x[2 * k] * rstd * gn[2 * k], x[2 * k + 1] * rstd * gn[2 * k + 1]);
            *(LAS u32x4*)(Vl + (q >> 6) * 16384 + att::v_st(q & 63, sc)) = w;
        }
        bf16x8 pa[8];
        const bf16_t* wrow = SW + ((size_t)g * 128 + 32 * w4 + r32) * 128 + 8 * hi;
#pragma unroll
        for (int k = 0; k < 8; ++k) pa[k] = *(const bf16x8*)(wrow + 16 * k);
        __syncthreads();
        f32x16 o[4] = {};
        att::pv_d0(o, vb0, pa[0], pa[1], pa[2], pa[3]);
        att::pv_d0(o, vb0 + 16384, pa[4], pa[5], pa[6], pa[7]);
#pragma unroll
        for (int r = 0; r < 16; ++r) { const int p = 32 * w4 + att::crow(r, hi); const float bs = psb[g * 128 + p];
#pragma unroll
            for (int d0 = 0; d0 < 4; ++d0) { const int c = d0 * 32 + r32; const float zu = bf2f(P[(row0 + p) * 2048 + g * 128 + c]);
                MIX[(row0 + p) * 1024 + g * 128 + c] = f2bf((o[d0][r] + bs) * zu); } }
    }
    __syncthreads();
}

using pg8::Unit; using pg8::Acc;
struct ProbIn0 {
    static constexpr bool PERM = true, GATHER = false; int K, lda; const bf16_t* A; const bf16_t* Bt; bf16_t* O; pg8::StaticOrder so; int G, c;
    __device__ bool next(int i, Unit& u) const { return so.map((long)i * G + c, u.pm, u.pn); }
    __device__ const char* a_base(const Unit& u) const { return (const char*)(A + (size_t)u.pm * 256 * lda); }
    __device__ const char* b_base(const Unit& u) const { return (const char*)(Bt + (size_t)u.pn * 256 * K); }
    __device__ void a_voff(const Unit&, unsigned (&)[2][2]) const {}
    __device__ void epi(const Acc& acc, const Unit& u, int wr, int wc, int fr, int fq) const {
        bf16_t* dst = O + (size_t)u.pm * 256 * 2048 + u.pn * 256;
        if (u.pn < 4) pg8::epi_store_bf16<true>(acc, dst, 2048, nullptr, wr, wc, fr, fq); else pg8::epi_store_bf16<false>(acc, dst, 2048, nullptr, wr, wc, fr, fq);
    }
};
template <bool LATONLY> struct ProbPlain {
    static constexpr bool PERM = true, GATHER = false; int K, lda; const bf16_t* A; const bf16_t* Bt; bf16_t* O; int ldc; pg8::StaticOrder so; int G, c;
    __device__ bool next(int i, Unit& u) const { int pm; if (!so.map((long)i * G + c, pm, u.pn)) return false; u.pm = LATONLY ? pm + pm / 8 + 1 : pm; return true; }
    __device__ const char* a_base(const Unit& u) const { return (const char*)(A + (size_t)u.pm * 256 * lda); }
    __device__ const char* b_base(const Unit& u) const { return (const char*)(Bt + (size_t)u.pn * 256 * K); }
    __device__ void a_voff(const Unit&, unsigned (&)[2][2]) const {}
    __device__ void epi(const Acc& acc, const Unit& u, int wr, int wc, int fr, int fq) const {
        pg8::epi_store_bf16<false>(acc, O + (size_t)u.pm * 256 * ldc + u.pn * 256, ldc, nullptr, wr, wc, fr, fq);
    }
};
struct ProbIn1 {
    static constexpr bool PERM = true, GATHER = false; int K, lda; const bf16_t* A; const bf16_t* Bt; bf16_t* O; pg8::StaticOrder so; int G, c;
    __device__ bool next(int i, Unit& u) const {
        const long L = (long)i * G + c;
        if (L < 1024) { int pm; so.map(L, pm, u.pn); u.pm = pm + pm / 8 + 1; return true; }
        if (L < 1024 + 64) { const int q = (int)(L - 1024); u.pm = (q >> 1) * 9; u.pn = 2 + (q & 1); return true; }
        return false;
    }
    __device__ const char* a_base(const Unit& u) const { return (const char*)(A + (size_t)u.pm * 256 * lda); }
    __device__ const char* b_base(const Unit& u) const { return (const char*)(Bt + (size_t)u.pn * 256 * K); }
    __device__ void a_voff(const Unit&, unsigned (&)[2][2]) const {}
    __device__ void epi(const Acc& acc, const Unit& u, int wr, int wc, int fr, int fq) const {
        pg8::epi_store_bf16<false>(acc, O + (size_t)u.pm * 256 * 1024 + u.pn * 256, 1024, nullptr, wr, wc, fr, fq);
    }
};
template <int LAYER> struct ProbOut {
    static constexpr bool PERM = false, GATHER = false; int K, lda; const bf16_t* A; const bf16_t* Bt; float* XR; const float* MOD; const float* xin; const float* cin; pg8::StaticOrder so; int G, c;
    __device__ bool next(int i, Unit& u) const { int pm; if (!so.map((long)i * G + c, pm, u.pn)) return false; u.pm = LAYER ? pm + pm / 8 + 1 : pm; return true; }
    __device__ const char* a_base(const Unit& u) const { return (const char*)(A + (size_t)u.pm * 256 * lda); }
    __device__ const char* b_base(const Unit& u) const { return (const char*)(Bt + (size_t)u.pn * 256 * K); }
    __device__ void a_voff(const Unit&, unsigned (&)[2][2]) const {}
    __device__ void epi(const Acc& acc, const Unit& u, int wr, int wc, int fr, int fq) const {
        const int b = u.pm / 9, jj = u.pm % 9, mj = jj == 0 ? 32 : b;
        const float* base = LAYER ? XR + (size_t)u.pm * 256 * DM : (jj == 0 ? cin + (size_t)b * CTXL * DM : xin + ((size_t)b * SEQ + (jj - 1) * 256) * DM);
        float* dst = XR + (size_t)u.pm * 256 * DM; const float* gate = MOD + ((size_t)(LAYER * 33 + mj) * 6 + 2) * 1024;
        const int row0 = wr * 64 + fr, col0 = u.pn * 256 + wc * 32 + 4 * fq;
        f32x4 gv[2][2];
#pragma unroll
        for (int bj = 0; bj < 2; ++bj)
#pragma unroll
            for (int n = 0; n < 2; ++n) gv[bj][n] = *(const f32x4*)(gate + col0 + bj * 128 + n * 16);
#pragma unroll
        for (int ai = 0; ai < 2; ++ai)
#pragma unroll
            for (int m = 0; m < 4; ++m) { const size_t off = (size_t)(row0 + ai * 128 + m * 16) * DM + col0;
#pragma unroll
                for (int bj = 0; bj < 2; ++bj)
#pragma unroll
                    for (int n = 0; n < 2; ++n) { const f32x4 bs = *(const f32x4*)(base + off + bj * 128 + n * 16); *(f32x4*)(dst + off + bj * 128 + n * 16) = bs + gv[bj][n] * acc[ai][bj][m][n]; } }
    }
};
struct MoeSched {
    const LAS int* pb; int NTN, G, c;
    __device__ bool map(int i, Unit& u) const {
        const long L = (long)i * G + c; const int blk = (int)(L / NTN); u.pn = (int)(L % NTN);
        if (blk >= __builtin_amdgcn_readfirstlane(pb[32])) return false;
        int lo = 0;
#pragma unroll
        for (int st = 16; st >= 1; st >>= 1) { if (__builtin_amdgcn_readfirstlane(pb[lo + st]) <= blk) lo += st; }
        u.e = lo; u.rb = blk - __builtin_amdgcn_readfirstlane(pb[lo]); u.pm = blk; return true;
    }
};
struct ProbMoe1 {
    static constexpr bool PERM = true, GATHER = true; int K, lda; const bf16_t* H; const bf16_t* W1; const float* B1; bf16_t* ACT; const int* rowl; const LAS int* cnt; MoeSched ms;
    __device__ bool next(int i, Unit& u) const { return ms.map(i, u); }
    __device__ const char* a_base(const Unit&) const { return (const char*)H; }
    __device__ const char* b_base(const Unit& u) const { return (const char*)(W1 + ((size_t)u.e * 2048 + (size_t)u.pn * 256) * 1024); }
    __device__ void a_voff(const Unit& u, unsigned (&vo)[2][2]) const {
        const int n = cnt[u.e]; const int* rl = rowl + (size_t)u.e * ROWCAP + u.rb * 256;
#pragma unroll
        for (int i = 0; i < 2; ++i) { int R, C; pg8::stage_rc((int)threadIdx.x * 16 + i * 8192, R, C);
#pragma unroll
            for (int h = 0; h < 2; ++h) { const int ri = h * 128 + R; const int tok = (u.rb * 256 + ri < n) ? rl[ri] : 0; vo[h][i] = (unsigned)tok * 2048u + (unsigned)C * 2u; } }
    }
    __device__ void epi(const Acc& acc, const Unit& u, int wr, int wc, int fr, int fq) const {
        const int row0 = wr * 64 + fr, col0 = u.pn * 128 + wc * 32 + 8 * fq;
        const float* bg = B1 + (size_t)u.e * 2048 + col0; const float* bl = bg + 1024;
        f32x4 bgv[2], blv[2];
#pragma unroll
        for (int n = 0; n < 2; ++n) { bgv[n] = *(const f32x4*)(bg + 4 * n); blv[n] = *(const f32x4*)(bl + 4 * n); }
        bf16_t* dst = ACT + (size_t)u.pm * 256 * 1024 + col0;
#pragma unroll
        for (int ai = 0; ai < 2; ++ai)
#pragma unroll
            for (int m = 0; m < 4; ++m) { float a[8];
#pragma unroll
                for (int n = 0; n < 2; ++n) { const f32x4 g = acc[ai][0][m][n] + bgv[n], l = acc[ai][1][m][n] + blv[n];
#pragma unroll
                    for (int j = 0; j < 4; ++j) { const float gg = fminf(g[j], 7.f), ll = fminf(fmaxf(l[j], -7.f), 7.f);
                        a[4 * n + j] = gg * __builtin_amdgcn_rcpf(1.f + __builtin_amdgcn_exp2f(-1.702f * 1.4426950408889634f * gg)) * (ll + 1.f); } }
                u32x4 w; w.x = cvtpk(a[0], a[1]); w.y = cvtpk(a[2], a[3]); w.z = cvtpk(a[4], a[5]); w.w = cvtpk(a[6], a[7]);
                *(u32x4*)(dst + (size_t)(row0 + ai * 128 + m * 16) * 1024) = w; }
    }
};
struct ProbMoe2 {
    static constexpr bool PERM = true, GATHER = false; int K, lda; const bf16_t* ACT; const bf16_t* W2; const float* B2; bf16_t* Y; MoeSched ms;
    __device__ bool next(int i, Unit& u) const { return ms.map(i, u); }
    __device__ const char* a_base(const Unit& u) const { return (const char*)(ACT + (size_t)u.pm * 256 * 1024); }
    __device__ const char* b_base(const Unit& u) const { return (const char*)(W2 + ((size_t)u.e * 1024 + (size_t)u.pn * 256) * 1024); }
    __device__ void a_voff(const Unit&, unsigned (&)[2][2]) const {}
    __device__ void epi(const Acc& acc, const Unit& u, int wr, int wc, int fr, int fq) const {
        pg8::epi_store_bf16<false>(acc, Y + (size_t)u.pm * 256 * 1024 + u.pn * 256, 1024, B2 + (size_t)u.e * 1024 + u.pn * 256, wr, wc, fr, fq);
    }
};

__global__ void __launch_bounds__(512, 2) fwd_kernel(Args args) {
    extern __shared__ __attribute__((aligned(16))) uchar lds_raw[];
    Frame F; F.lds = (LAS uchar*)lds_raw; F.tid = threadIdx.x; F.lane = F.tid & 63; F.wave = __builtin_amdgcn_readfirstlane(F.tid >> 6); F.G = gridDim.x; F.bid = blockIdx.x;
    F.ws = args.ws; F.out = args.out;
    volatile LAS unsigned* MISC = (volatile LAS unsigned*)(F.lds + MISC_OFF);
    if (F.tid < 64) MISC[F.tid] = 0u;
    __syncthreads();
    unsigned* ctl = (unsigned*)(F.ws + WS_CTL);
    XcdBarrier bar; bar.bar = ctl + CW_BAR; bar.x = 0; bar.st = nullptr;
    const int lo = args.ph_lo, hi = args.ph_hi;
    if (hi - lo > 1) bar = xcd_barrier_post(ctl + CW_BAR, MISC + 8);
#ifndef PHMASK
#define PHMASK 0x7ffff
#endif
#define IN(k) (((PHMASK >> (k)) & 1) && lo <= (k) && (k) < hi)
#define SEAM(k) do { if (IN(k) && IN((k) + 1)) xcd_barrier(bar); } while (0)
    uchar* ws = F.ws;
    bf16_t* H = (bf16_t*)(ws + WS_H); float* XR = (float*)(ws + WS_XR); const float* MOD = (const float*)(ws + WS_MOD);

    if (IN(0)) { p0_prologue(F); } SEAM(0);
    if (IN(1)) { p_norm0(F); } SEAM(1);
    if (IN(2)) { ProbIn0 p; p.K = 1024; p.lda = 1024; p.A = H; p.Bt = (const bf16_t*)(ws + WS_WIN0); p.O = (bf16_t*)(ws + WS_PBUF); p.so.init(NPAN, 8); p.G = F.G; p.c = F.bid; pg8::gemm_phase(F.lds, p); } SEAM(2);
    if (IN(3)) { p_qk_prep(F); } SEAM(3);
    if (IN(4)) {
        const bf16_t* P = (const bf16_t*)(ws + WS_PBUF); bf16_t* MIX = (bf16_t*)(ws + WS_MIX0);
        for (int u = F.bid; u < 1024 + 128; u += F.G) {
            if (u < 1024) { const int qb = u & 7, g = (u >> 3) & 1, kvh = (u >> 4) & 1, b = u >> 5, h = kvh * 2 + g; const size_t kr0 = (size_t)b * TPB, qr0 = kr0 + CTXL + qb * 256;
                att::attn_unit<128, 2, false, 2048, 2048, 1024>(P + qr0 * 2048 + 1024 + h * 128, P + kr0 * 2048 + 1536 + kvh * 128, nullptr, P + kr0 * 2048 + 1792 + kvh * 128, MIX + qr0 * 1024 + 512 + h * 128, TPB, (LAS char*)F.lds, nullptr, 0);
            } else { const int v = u - 1024, h = v & 3, b = v >> 2, kvh = h >> 1; const size_t kr0 = (size_t)b * TPB;
                att::attn_unit<128, 2, false, 2048, 2048, 1024>(P + kr0 * 2048 + 1024 + h * 128, P + kr0 * 2048 + 1536 + kvh * 128, nullptr, P + kr0 * 2048 + 1792 + kvh * 128, MIX + kr0 * 1024 + 512 + h * 128, CTXL, (LAS char*)F.lds, nullptr, 0); }
        }
        p_sgu(F);
    } SEAM(4);
    if (IN(5)) { ProbOut<0> p; p.K = 1024; p.lda = 1024; p.A = (const bf16_t*)(ws + WS_MIX0); p.Bt = (const bf16_t*)(ws + WS_WOUT0); p.XR = XR; p.MOD = MOD; p.xin = INP(I_X); p.cin = INP(I_CTX); p.so.init(NPAN, 4); p.G = F.G; p.c = F.bid; pg8::gemm_phase(F.lds, p); } SEAM(5);
    if (IN(6)) { p_norm_router<0>(F); } SEAM(6);
    if (IN(7)) { moe_prefix(F, 0); ProbMoe1 p; p.K = 1024; p.lda = 1024; p.H = H; p.W1 = (const bf16_t*)(ws + WS_W1); p.B1 = INP(I_B1); p.ACT = (bf16_t*)(ws + WS_ACT); p.rowl = (const int*)(ws + WS_ROWL);
        p.cnt = (const LAS int*)(F.lds + XTRA_OFF + X_CNT); p.ms.pb = (const LAS int*)(F.lds + XTRA_OFF + X_PB); p.ms.NTN = 8; p.ms.G = F.G; p.ms.c = F.bid; pg8::gemm_phase(F.lds, p); } SEAM(7);
    if (IN(8)) { moe_prefix(F, 0); ProbMoe2 p; p.K = 1024; p.lda = 1024; p.ACT = (const bf16_t*)(ws + WS_ACT); p.W2 = (const bf16_t*)(ws + WS_W2); p.B2 = INP(I_B2); p.Y = (bf16_t*)(ws + WS_Y);
        p.ms.pb = (const LAS int*)(F.lds + XTRA_OFF + X_PB); p.ms.NTN = 4; p.ms.G = F.G; p.ms.c = F.bid; pg8::gemm_phase(F.lds, p); } SEAM(8);
    if (IN(9)) { p_combine_norm(F); } SEAM(9);
    if (IN(10)) { ProbIn1 p; p.K = 1024; p.lda = 1024; p.A = H; p.Bt = (const bf16_t*)(ws + WS_WIN1); p.O = (bf16_t*)(ws + WS_PBUF); p.so.init(256, 4); p.G = F.G; p.c = F.bid; pg8::gemm_phase(F.lds, p); } SEAM(10);
    if (IN(11)) { p_mla_prep(F); } SEAM(11);
    if (IN(12)) {
        { ProbPlain<true> p; p.K = 512; p.lda = 1024; p.A = (const bf16_t*)(ws + WS_PBUF); p.Bt = (const bf16_t*)(ws + WS_WUQ); p.O = (bf16_t*)(ws + WS_QB); p.ldc = 1536; p.so.init(256, 6); p.G = F.G; p.c = F.bid; pg8::gemm_phase(F.lds, p); }
        { ProbPlain<false> p; p.K = 256; p.lda = 1024; p.A = (const bf16_t*)(ws + WS_PBUF) + 512; p.Bt = (const bf16_t*)(ws + WS_WUKV); p.O = (bf16_t*)(ws + WS_KVB); p.ldc = 2048; p.so.init(NPAN, 8); p.G = F.G; p.c = F.bid; pg8::gemm_phase(F.lds, p); }
    } SEAM(12);
    if (IN(13)) {
        const bf16_t* Q = (const bf16_t*)(ws + WS_QB); const bf16_t* KV = (const bf16_t*)(ws + WS_KVB); const bf16_t* KR = (const bf16_t*)(ws + WS_KRB); bf16_t* MIX = (bf16_t*)(ws + WS_MIX1);
        for (int u = F.bid; u < 2048; u += F.G) { const int qb = u & 7, h = (u >> 3) & 7, b = u >> 6; const size_t kr0 = (size_t)b * TPB, qr0 = kr0 + CTXL + qb * 256;
            att::attn_unit<192, 1, true, 1536, 2048, 1024>(Q + qr0 * 1536 + h * 192, KV + kr0 * 2048 + h * 128, KR + kr0 * 64, KV + kr0 * 2048 + 1024 + h * 128, MIX + qr0 * 1024 + h * 128, TPB, (LAS char*)F.lds, (const f32x2*)(ws + WS_TABM), qb * 256); }
    } SEAM(13);
    if (IN(14)) { ProbOut<1> p; p.K = 1024; p.lda = 1024; p.A = (const bf16_t*)(ws + WS_MIX1); p.Bt = (const bf16_t*)(ws + WS_WOUT1); p.XR = XR; p.MOD = MOD; p.xin = nullptr; p.cin = nullptr; p.so.init(256, 4); p.G = F.G; p.c = F.bid; pg8::gemm_phase(F.lds, p); } SEAM(14);
    if (IN(15)) { p_norm_router<1>(F); } SEAM(15);
    if (IN(16)) { moe_prefix(F, 1); ProbMoe1 p; p.K = 1024; p.lda = 1024; p.H = H; p.W1 = (const bf16_t*)(ws + WS_W1) + (size_t)32 * 2048 * 1024; p.B1 = INP(I_B1) + 32 * 2048; p.ACT = (bf16_t*)(ws + WS_ACT); p.rowl = (const int*)(ws + WS_ROWL);
        p.cnt = (const LAS int*)(F.lds + XTRA_OFF + X_CNT); p.ms.pb = (const LAS int*)(F.lds + XTRA_OFF + X_PB); p.ms.NTN = 8; p.ms.G = F.G; p.ms.c = F.bid; pg8::gemm_phase(F.lds, p); } SEAM(16);
    if (IN(17)) { moe_prefix(F, 1); ProbMoe2 p; p.K = 1024; p.lda = 1024; p.ACT = (const bf16_t*)(ws + WS_ACT); p.W2 = (const bf16_t*)(ws + WS_W2) + (size_t)32 * 1024 * 1024; p.B2 = INP(I_B2) + 32 * 1024; p.Y = (bf16_t*)(ws + WS_Y);
        p.ms.pb = (const LAS int*)(F.lds + XTRA_OFF + X_PB); p.ms.NTN = 4; p.ms.G = F.G; p.ms.c = F.bid; pg8::gemm_phase(F.lds, p); } SEAM(17);
    if (IN(18)) { p_final(F); }
#undef IN
#undef SEAM
}

extern "C" void kernel_launch(void* const* d_in, const int* in_sizes, int n_in, void* d_out, int out_size, void* d_ws, size_t ws_size, hipStream_t stream) {
    static int grid = 0;
    if (grid == 0) {
        if (n_in != 28 || out_size != NBATCH * SEQ * DM || ws_size < WS_END) { fprintf(stderr, "kernel_launch: unexpected shapes (n_in %d out %d ws %zu, need ws >= %zu)\n", n_in, out_size, ws_size, (size_t)WS_END); grid = -1; return; }
        int dev = 0, cus = 0, per_cu = 0;
        if (hipGetDevice(&dev) != hipSuccess || hipDeviceGetAttribute(&cus, hipDeviceAttributeMultiprocessorCount, dev) != hipSuccess) { grid = -1; return; }
        if (hipFuncSetAttribute((const void*)fwd_kernel, hipFuncAttributeMaxDynamicSharedMemorySize, LDS_BYTES) != hipSuccess) { fprintf(stderr, "kernel_launch: hipFuncSetAttribute failed\n"); grid = -1; return; }
        if (hipOccupancyMaxActiveBlocksPerMultiprocessor(&per_cu, (const void*)fwd_kernel, 512, LDS_BYTES) != hipSuccess || per_cu < 1) { fprintf(stderr, "kernel_launch: occupancy query says %d blocks/CU\n", per_cu); }
        (void)hipGetLastError();
        grid = cus;
    }
    if (grid < 0) return;
    (void)hipMemsetAsync((char*)d_ws + WS_CTL, 0, CTL_BYTES, stream);
    Args a{};
    for (int i = 0; i < 28; ++i) a.in[i] = (const float*)d_in[i];
    a.out = (float*)d_out; a.ws = (uchar*)d_ws;
#if MK_ONE_LAUNCH
    a.ph_lo = 0; a.ph_hi = NPHASE;
    hipLaunchKernelGGL(fwd_kernel, dim3(grid), dim3(512), LDS_BYTES, stream, a);
#else
    for (int ph = 0; ph < NPHASE; ++ph) { a.ph_lo = ph; a.ph_hi = ph + 1; hipLaunchKernelGGL(fwd_kernel, dim3(grid), dim3(512), LDS_BYTES, stream, a); }
#endif
}
```

```cpp
#include <hip/hip_runtime.h>
#include <cstdio>
#include <cstdint>

#ifndef MK_ONE_LAUNCH
#define MK_ONE_LAUNCH 1
#endif
#define REPEAT_MASK 0
#define USE_BUFFER_LDS 1
#ifndef MOE_FP8
#define MOE_FP8 1
#endif

#define LAS __attribute__((address_space(3)))
typedef unsigned short bf16_t;
typedef unsigned char uchar;
typedef short bf16x8 __attribute__((ext_vector_type(8)));
typedef short s16x4 __attribute__((ext_vector_type(4)));
typedef float f32x2 __attribute__((ext_vector_type(2)));
typedef float f32x4 __attribute__((ext_vector_type(4)));
typedef float f32x16 __attribute__((ext_vector_type(16)));
typedef unsigned u32x2 __attribute__((ext_vector_type(2)));
typedef unsigned u32x4 __attribute__((ext_vector_type(4)));
typedef int i32x4 __attribute__((ext_vector_type(4)));
typedef int i32x8 __attribute__((ext_vector_type(8)));

constexpr int DM = 1024, NBATCH = 32, SEQ = 2048, CTXL = 256, TPB = SEQ + CTXL, NTOK = NBATCH * TPB, NPAN = NTOK / 256;
constexpr int NEXP = 32, TOPK = 4, ROWCAP = NTOK;
constexpr float EPS = 1e-6f;
constexpr int NPHASE = 19;

constexpr size_t MiB = 1u << 20;
constexpr size_t WS_CTL = 0, CTL_BYTES = 1 * MiB;
constexpr size_t WS_MOD = 1 * MiB;
constexpr size_t WS_TABG = 3 * MiB;
constexpr size_t WS_TABM = WS_TABG + 32768;
constexpr size_t WS_WRT = WS_TABG + 65536;
constexpr size_t WS_SGUW = WS_WRT + 262144;
constexpr size_t WS_WIN0 = 4 * MiB, WS_WOUT0 = 8 * MiB, WS_WIN1 = 10 * MiB, WS_WUQ = 12 * MiB, WS_WUKV = 14 * MiB, WS_WOUT1 = 15 * MiB;
constexpr size_t WS_W1 = 17 * MiB;
constexpr size_t WS_W2 = 273 * MiB;
constexpr size_t WS_ROWL = 401 * MiB;
constexpr size_t WS_TOKI = 410 * MiB;
constexpr size_t WS_XR = 413 * MiB;
constexpr size_t WS_H = 701 * MiB;
constexpr size_t WS_SCR = 845 * MiB;
constexpr size_t WS_PBUF = WS_SCR;
constexpr size_t WS_MIX0 = WS_SCR + 288 * MiB;
constexpr size_t WS_QB = WS_SCR + 144 * MiB;
constexpr size_t WS_KVB = WS_SCR + 360 * MiB;
constexpr size_t WS_KRB = WS_SCR + 648 * MiB;
constexpr size_t WS_MIX1 = WS_SCR + 660 * MiB;
constexpr size_t WS_ACT = WS_SCR;
constexpr size_t WS_Y = WS_SCR + 592 * MiB;
constexpr size_t WS_END = WS_SCR + 1184 * MiB;
constexpr int CW_BAR = 1024;
constexpr int CW_CNT = 8192;
constexpr int CW_DBG = 16384;

constexpr int RING_BYTES = 131072;
constexpr int XTRA_OFF = RING_BYTES, XTRA_BYTES = 20480;
constexpr int MISC_OFF = XTRA_OFF + XTRA_BYTES;
constexpr int LDS_BYTES = MISC_OFF + 512;
constexpr int X_PB = 0;
constexpr int X_CNT = 256;
constexpr int X_HIST = 512;
constexpr int X_BASE = 768;
constexpr int X_SEL = 1024;

#define LDS_WAIT() asm volatile("s_waitcnt lgkmcnt(0)" ::: "memory")
#define VM_WAIT() asm volatile("s_waitcnt vmcnt(0)" ::: "memory")
#define SBAR() __builtin_amdgcn_sched_barrier(0)
__device__ __forceinline__ unsigned cvtpk(float lo, float hi) { unsigned r; asm volatile("v_cvt_pk_bf16_f32 %0, %1, %2" : "=v"(r) : "v"(lo), "v"(hi)); return r; }
__device__ __forceinline__ float bf2f(unsigned short b) { return __uint_as_float(((unsigned)b) << 16); }
__device__ __forceinline__ float bflo(unsigned w) { return __uint_as_float(w << 16); }
__device__ __forceinline__ float bfhi(unsigned w) { return __uint_as_float(w & 0xffff0000u); }
__device__ __forceinline__ unsigned short f2bf(float f) { return (unsigned short)(cvtpk(f, 0.f) & 0xffffu); }
__device__ __forceinline__ unsigned pk4_fp8(float a, float b, float c, float d) {
    a = fminf(fmaxf(a, -448.f), 448.f); b = fminf(fmaxf(b, -448.f), 448.f); c = fminf(fmaxf(c, -448.f), 448.f); d = fminf(fmaxf(d, -448.f), 448.f);
    unsigned w = 0; w = __builtin_amdgcn_cvt_pk_fp8_f32(a, b, w, false); w = __builtin_amdgcn_cvt_pk_fp8_f32(c, d, w, true); return w;
}
__device__ __forceinline__ int tid_fresh(int wave_s) { int l; asm volatile("v_mbcnt_lo_u32_b32 %0, -1, 0\n\tv_mbcnt_hi_u32_b32 %0, -1, %0" : "=v"(l)); return wave_s * 64 + l; }
__device__ __forceinline__ float wave_sum(float v) {
#pragma unroll
    for (int o = 1; o < 64; o <<= 1) v += __shfl_xor(v, o);
    return v;
}
__device__ __forceinline__ float silu_f(float x) { return x / (1.f + __expf(-x)); }
__device__ __forceinline__ float gelu_tanh_f(float x) {
    const float u = x * (1.5957691216057308f + 0.07135481627260025f * x * x);
    const float e = __builtin_amdgcn_exp2f(-1.4426950408889634f * u);
    return x * __builtin_amdgcn_rcpf(1.f + e);
}

#define XB_TMO      128
#define XB_XCNT(j)  (256  + 64 * (j))
#define XB_XSUB(j)  (1280 + 64 * (j))
#define XB_XGEN(j)  (2304 + 64 * (j))
#define XB_TOP      3328
#define XB_TOPGEN   3392
#define XCD_BAR_WORDS 3456
#define XB_SPIN_CAP (1u << 20)
__device__ __forceinline__ unsigned xb_ld(unsigned* p)              { return __hip_atomic_load(p, __ATOMIC_RELAXED, __HIP_MEMORY_SCOPE_AGENT); }
__device__ __forceinline__ unsigned xb_add(unsigned* p, unsigned v) { return __hip_atomic_fetch_add(p, v, __ATOMIC_RELAXED, __HIP_MEMORY_SCOPE_AGENT); }
__device__ __forceinline__ unsigned xb_xcc_id() { return (unsigned)__builtin_amdgcn_s_getreg((3 << 11) | 20) & 0xFu; }
#define XB_SPIN(cond, bar) do { unsigned _sp = 0; while (cond) { __builtin_amdgcn_s_sleep(1); \
    if ((++_sp & 255u) == 0u) { if (xb_ld(&(bar)[XB_TMO])) break; if (_sp > XB_SPIN_CAP) { atomicAdd(&(bar)[XB_TMO], 1u); break; } } } } while (0)
struct XcdBarrier { unsigned* bar; unsigned x; volatile LAS unsigned* st; };
__device__ __forceinline__ XcdBarrier xcd_barrier_post(unsigned* bar, volatile LAS unsigned* st, bool t0) {
    XcdBarrier b; b.bar = bar; b.x = xb_xcc_id(); b.st = st;
    if (t0) (void)xb_add(&bar[XB_XCNT(b.x)], 1u);
    return b;
}
__device__ __forceinline__ void xcd_barrier_complete(unsigned* bar, unsigned x, unsigned& nloc, unsigned& nx) {
    const unsigned G = gridDim.x * gridDim.y * gridDim.z;
    unsigned sum, cnt, mine, sp = 0u;
    for (;;) {
        sum = 0u; cnt = 0u; mine = 0u;
#pragma unroll
        for (unsigned j = 0; j < 16; ++j) { const unsigned c = xb_ld(&bar[XB_XCNT(j)]); sum += c; cnt += (c > 0u) ? 1u : 0u; mine = (j == x) ? c : mine; }
        if (sum == G) break;
        __builtin_amdgcn_s_sleep(1);
        if ((++sp & 255u) == 0u) { if (xb_ld(&bar[XB_TMO])) break; if (sp > XB_SPIN_CAP) { atomicAdd(&bar[XB_TMO], 1u); break; } }
    }
    nloc = mine > 0u ? mine : 1u; nx = cnt > 0u ? cnt : 1u;
}
__device__ __forceinline__ void xcd_barrier(const XcdBarrier& b, bool t0) {
    asm volatile("s_waitcnt vmcnt(0)" ::: "memory");
    __syncthreads();
    if (t0) {
        unsigned* bar = b.bar;
        __builtin_amdgcn_s_waitcnt(0);
        unsigned nloc = b.st[0], nx = b.st[1];
        if (nloc == 0u) { xcd_barrier_complete(bar, b.x, nloc, nx); b.st[0] = nloc; b.st[1] = nx; }
        const unsigned old = xb_add(&bar[XB_XSUB(b.x)], 1u);
        const unsigned gen = old / nloc;
        if (old + 1u == (gen + 1u) * nloc) {
            __builtin_amdgcn_fence(__ATOMIC_RELEASE, "agent");
            asm volatile("s_waitcnt vmcnt(0)" ::: "memory");
            const unsigned og = xb_add(&bar[XB_TOP], 1u);
            const unsigned tg = og / nx;
            if (og + 1u == (tg + 1u) * nx) xb_add(&bar[XB_TOPGEN], 1u);
            else XB_SPIN(xb_ld(&bar[XB_TOPGEN]) == tg, bar);
            __builtin_amdgcn_fence(__ATOMIC_ACQUIRE, "agent");
            xb_add(&bar[XB_XGEN(b.x)], 1u);
            asm volatile("s_waitcnt vmcnt(0)" ::: "memory");
        } else {
            XB_SPIN(xb_ld(&bar[XB_XGEN(b.x)]) == gen, bar);
            __builtin_amdgcn_fence(__ATOMIC_ACQUIRE, "agent");
            asm volatile("s_waitcnt vmcnt(0)" ::: "memory");
        }
    }
    __syncthreads();
}

struct Args { const float* in[28]; float* out; uchar* ws; int ph_lo, ph_hi; };
enum { I_X = 0, I_C, I_CTX, I_CCTX, I_ADAW, I_ADAB, I_NMIXG, I_NFFNG, I_ABWIN, I_SGUNG, I_SGUW, I_SGUB, I_GQG, I_GKG, I_ABWOUT, I_MLAWIN, I_MLAQG, I_MLAKVG, I_MLAWUQ, I_MLAWUKV, I_MLAWOUT,
       I_RW, I_RB, I_W1, I_B1, I_W2, I_B2, I_FNG };
struct Frame {
    LAS uchar* lds; int tid, lane, wave, G, bid;
    uchar* ws; float* out;
};
__device__ __forceinline__ const float* INP(int i) {
    const __attribute__((address_space(4))) char* ka = (const __attribute__((address_space(4))) char*)__builtin_amdgcn_kernarg_segment_ptr();
    return *(const float* const volatile __attribute__((address_space(4)))*)(ka + i * 8);
}

namespace pg8 {
constexpr int BM = 256, BK = 64, HALF = 128, HTB = HALF * BK * 2, NXCD = 8, WGM = 8;
__device__ __forceinline__ int lds_byte(int r, int c) { const int st = (r >> 4) * 2 + (c >> 5), rr = r & 15, cc = c & 31, ob = rr * 64 + cc * 2; return st * 1024 + (ob ^ (((ob >> 9) & 1) << 5)); }
__device__ __forceinline__ void stage_rc(int b, int& R, int& C) { const int st = b / 1024, sb = b % 1024, swz = sb ^ (((sb >> 9) & 1) << 5); R = (st >> 1) * 16 + swz / 64; C = (st & 1) * 32 + (swz % 64) / 2; }
__device__ __forceinline__ int perm32(int rho) { const int n = rho >> 4, i = rho & 15; return 8 * (i >> 2) + 4 * n + (i & 3); }
struct Unit { int pm, pn, e, rb; };
struct StaticOrder {
    int nM, nN, nwg;
    __device__ void init(int nM_, int nN_) { nM = nM_; nN = nN_; nwg = nM * nN; }
    __device__ bool map(long L, int& pm, int& pn) const {
        if (L >= nwg) return false;
        int wgid = (int)L; { const int q = nwg / NXCD, r = nwg % NXCD, xcd = wgid % NXCD, off = wgid / NXCD; wgid = (xcd < r ? xcd * (q + 1) : r * (q + 1) + (xcd - r) * q) + off; }
        const int nig = WGM * nN, gid = wgid / nig, fm = gid * WGM, gsz = (nM - fm) < WGM ? (nM - fm) : WGM;
        pm = fm + ((wgid % nig) % gsz); pn = (wgid % nig) / gsz; return true;
    }
};
typedef f32x4 Acc[2][2][4][2];
template <class P>
__device__ __forceinline__ void gemm_phase(LAS uchar* lds, const P& p, int wave_s) {
    const int tid = tid_fresh(wave_s), wid = __builtin_amdgcn_readfirstlane(tid >> 6), lane = tid & 63, wr = wid >> 2, wc = wid & 3, fr = lane & 15, fq = lane >> 4;
    const int K = p.K, nt = K / BK;
    unsigned voffA[2][2], voffB[2];
#pragma unroll
    for (int i = 0; i < 2; ++i) { int R, C; stage_rc(tid * 16 + i * 8192, R, C); const int Rb = P::PERM ? ((R & ~31) + perm32(R & 31)) : R;
        voffA[0][i] = (unsigned)(R * p.lda + C) * 2u; voffA[1][i] = voffA[0][i]; voffB[i] = (unsigned)(Rb * K + C) * 2u; }
    const unsigned kstep = (unsigned)(BK * 2);
    const unsigned hstepB = (unsigned)HALF * K * 2;
    const unsigned hstepA = P::GATHER ? 0u : (unsigned)HALF * p.lda * 2;
#define PG8_VA1 voffA[P::GATHER ? 1 : 0]
    const __amdgpu_buffer_rsrc_t rsA = __builtin_amdgcn_make_buffer_rsrc((void*)p.a_mat(), 0, 0xffffffffu, 0x00020000);
    const __amdgpu_buffer_rsrc_t rsB = __builtin_amdgcn_make_buffer_rsrc((void*)p.b_mat(), 0, 0xffffffffu, 0x00020000);
    const char* gpA = (const char*)p.a_mat(); const char* gpB = (const char*)p.b_mat(); (void)gpA; (void)gpB; (void)rsA; (void)rsB;
    const unsigned ldsw = (unsigned)wid * 1024u;
    const int aoff = lds_byte(wr * 64 + fr, fq * 8), boff = lds_byte(wc * 32 + fr, fq * 8);
#define PG8_SA(b, h) (((b) * 2 + (h)) * HTB)
#define PG8_SB(b, h) ((4 + (b) * 2 + (h)) * HTB)
#if USE_BUFFER_LDS
#define PG8_STAGE_R(bufoff, rs, gp, soff, voff) do { _Pragma("unroll") for (int _i = 0; _i < 2; ++_i) \
        __builtin_amdgcn_raw_ptr_buffer_load_lds(rs, (LAS unsigned*)(lds + (bufoff) + ldsw + _i * 8192), 16, (int)(voff)[_i], (int)(soff), 0, 0); } while (0)
#else
#define PG8_STAGE_R(bufoff, rs, gp, soff, voff) do { _Pragma("unroll") for (int _i = 0; _i < 2; ++_i) \
        __builtin_amdgcn_global_load_lds((const unsigned*)((const char*)(gp) + (size_t)(soff) + (voff)[_i]), (LAS unsigned*)(lds + (bufoff) + ldsw + _i * 8192), 16, 0, 0); } while (0)
#endif
#define PG8_STAGE_A(bufoff, soff, voff) PG8_STAGE_R(bufoff, rsA, gpA, soff, voff)
#define PG8_STAGE_B(bufoff, soff, voff) PG8_STAGE_R(bufoff, rsB, gpB, soff, voff)
#define PG8_LDA(dst, b, h) do { _Pragma("unroll") for (int m = 0; m < 4; ++m) _Pragma("unroll") for (int k = 0; k < 2; ++k) dst[m][k] = *(const LAS i32x4*)(lds + PG8_SA(b, h) + aoff + m * 2048 + k * 1024); } while (0)
#define PG8_LDB(dst, b, h) do { _Pragma("unroll") for (int n = 0; n < 2; ++n) _Pragma("unroll") for (int k = 0; k < 2; ++k) dst[n][k] = *(const LAS i32x4*)(lds + PG8_SB(b, h) + boff + n * 2048 + k * 1024); } while (0)
#define PG8_CAT(x) __builtin_shufflevector((x)[0], (x)[1], 0, 1, 2, 3, 4, 5, 6, 7)
#define PG8_MMA(ai, bj, At, Bt) do { __builtin_amdgcn_s_setprio(1); \
        if constexpr (P::FP8) { _Pragma("unroll") for (int m = 0; m < 4; ++m) _Pragma("unroll") for (int n = 0; n < 2; ++n) \
            acc[ai][bj][m][n] = __builtin_amdgcn_mfma_scale_f32_16x16x128_f8f6f4(PG8_CAT(Bt[n]), PG8_CAT(At[m]), acc[ai][bj][m][n], 0, 0, 0, 0x7F7F7F7F, 0, 0x7F7F7F7F); } \
        else { _Pragma("unroll") for (int m = 0; m < 4; ++m) _Pragma("unroll") for (int n = 0; n < 2; ++n) _Pragma("unroll") for (int k = 0; k < 2; ++k) \
            acc[ai][bj][m][n] = __builtin_amdgcn_mfma_f32_16x16x32_bf16(__builtin_bit_cast(bf16x8, Bt[n][k]), __builtin_bit_cast(bf16x8, At[m][k]), acc[ai][bj][m][n], 0, 0, 0); } \
        __builtin_amdgcn_s_setprio(0); } while (0)
#define PG8_WAIT_V(n) asm volatile("s_waitcnt vmcnt(" #n ")" ::: "memory")
#define PG8_WAIT_L(n) asm volatile("s_waitcnt lgkmcnt(" #n ")" ::: "memory")
#define PG8_BAR __builtin_amdgcn_s_barrier()
#define PG8_SCHED __builtin_amdgcn_sched_barrier(0)
    Unit cur, nxt; int ui = 0;
    if (!p.next(0, cur)) return;
    Acc acc;
#pragma unroll
    for (int a = 0; a < 2; ++a)
#pragma unroll
        for (int b = 0; b < 2; ++b)
#pragma unroll
            for (int m = 0; m < 4; ++m)
#pragma unroll
                for (int n = 0; n < 2; ++n) acc[a][b][m][n] = (f32x4){0.f, 0.f, 0.f, 0.f};
    i32x4 At[4][2], B0[2][2], B1[2][2];
    unsigned cA = p.a_off(cur), cB = p.b_off(cur);
    if constexpr (P::GATHER) { p.a_voff(cur, voffA); }
    PG8_STAGE_B(PG8_SB(0, 0), cB, voffB); PG8_STAGE_B(PG8_SB(0, 1), cB + hstepB, voffB); PG8_STAGE_A(PG8_SA(0, 0), cA, voffA[0]); PG8_STAGE_A(PG8_SA(0, 1), cA + hstepA, PG8_VA1);
    if (wr == 1) PG8_BAR;
    PG8_WAIT_V(2); PG8_BAR;
    PG8_STAGE_B(PG8_SB(1, 0), cB + kstep, voffB); PG8_STAGE_A(PG8_SA(1, 0), cA + kstep, voffA[0]); PG8_STAGE_B(PG8_SB(1, 1), cB + hstepB + kstep, voffB);
    PG8_WAIT_V(6); PG8_BAR;
    for (;;) {
        const bool has_next = p.next(ui + 1, nxt);
        const unsigned nA = has_next ? p.a_off(nxt) : cA, nB = has_next ? p.b_off(nxt) : cB;
        for (int t = 0; t < nt; t += 2) {
            const bool last = (t == nt - 2);
            const unsigned a1 = cA + (unsigned)(t + 1) * kstep;
            const unsigned a2 = last ? nA : cA + (unsigned)(t + 2) * kstep, b2 = last ? nB : cB + (unsigned)(t + 2) * kstep;
            const unsigned a3 = a2 + kstep, b3 = b2 + kstep;
            PG8_LDB(B0, 0, 0); PG8_LDB(B1, 0, 1); PG8_SCHED; PG8_LDA(At, 0, 0); PG8_STAGE_A(PG8_SA(1, 1), a1 + hstepA, PG8_VA1);
            if constexpr (P::GATHER) { if (last && has_next) p.a_voff(nxt, voffA); }
            PG8_WAIT_V(8); PG8_WAIT_L(0); PG8_BAR; PG8_MMA(0, 0, At, B0); PG8_MMA(0, 1, At, B1); PG8_BAR; PG8_SCHED;
            PG8_LDA(At, 0, 1); PG8_STAGE_B(PG8_SB(0, 0), b2, voffB); PG8_STAGE_B(PG8_SB(0, 1), b2 + hstepB, voffB); PG8_STAGE_A(PG8_SA(0, 0), a2, voffA[0]);
            PG8_WAIT_V(8); PG8_WAIT_L(0); PG8_BAR; PG8_MMA(1, 0, At, B0); PG8_MMA(1, 1, At, B1); PG8_BAR; PG8_SCHED;
            PG8_LDB(B0, 1, 0); PG8_LDB(B1, 1, 1); PG8_SCHED; PG8_LDA(At, 1, 0); PG8_STAGE_A(PG8_SA(0, 1), a2 + hstepA, PG8_VA1);
            PG8_WAIT_V(8); PG8_WAIT_L(0); PG8_BAR; PG8_MMA(0, 0, At, B0); PG8_MMA(0, 1, At, B1); PG8_BAR; PG8_SCHED;
            PG8_LDA(At, 1, 1); PG8_STAGE_B(PG8_SB(1, 0), b3, voffB); PG8_STAGE_B(PG8_SB(1, 1), b3 + hstepB, voffB); PG8_STAGE_A(PG8_SA(1, 0), a3, voffA[0]);
            PG8_WAIT_V(8); PG8_WAIT_L(0); PG8_BAR; PG8_MMA(1, 0, At, B0); PG8_MMA(1, 1, At, B1); PG8_BAR; PG8_SCHED;
        }
        if (wr == 0) PG8_BAR;
        p.epi(acc, cur, wr, wc, fr, fq);
        if (!has_next) break;
#pragma unroll
        for (int a = 0; a < 2; ++a)
#pragma unroll
            for (int b = 0; b < 2; ++b)
#pragma unroll
                for (int m = 0; m < 4; ++m)
#pragma unroll
                    for (int n = 0; n < 2; ++n) acc[a][b][m][n] = (f32x4){0.f, 0.f, 0.f, 0.f};
        cur = nxt; cA = nA; cB = nB; ++ui;
        if (wr == 1) PG8_BAR;
    }
    PG8_WAIT_V(0);
    PG8_BAR;
#undef PG8_SA
#undef PG8_VA1
#undef PG8_SB
#undef PG8_STAGE_R
#undef PG8_STAGE_A
#undef PG8_STAGE_B
#undef PG8_LDA
#undef PG8_LDB
#undef PG8_MMA
#undef PG8_CAT
#undef PG8_WAIT_V
#undef PG8_WAIT_L
#undef PG8_BAR
#undef PG8_SCHED
}

template <bool GELU>
__device__ __forceinline__ void epi_store_bf16(const Acc& acc, bf16_t* dst  , int ldc, const float* bias  , int wr, int wc, int fr, int fq, float sc = 1.f) {
    const int row0 = wr * 64 + fr, col0 = wc * 32 + 8 * fq;
    f32x4 bv[2][2];
#pragma unroll
    for (int bj = 0; bj < 2; ++bj)
#pragma unroll
        for (int n = 0; n < 2; ++n) bv[bj][n] = bias ? *(const f32x4*)(bias + col0 + bj * HALF + 4 * n) : (f32x4){0.f, 0.f, 0.f, 0.f};
    const unsigned lane_off = (unsigned)(row0 * ldc + col0) * 2u;
#pragma unroll
    for (int ai = 0; ai < 2; ++ai)
#pragma unroll
        for (int m = 0; m < 4; ++m) { char* rowb = (char*)dst + (size_t)((ai * HALF + m * 16) * ldc) * 2;
#pragma unroll
            for (int bj = 0; bj < 2; ++bj) { f32x4 v0 = acc[ai][bj][m][0] * sc + bv[bj][0], v1 = acc[ai][bj][m][1] * sc + bv[bj][1];
                if (GELU) {
#pragma unroll
                    for (int j = 0; j < 4; ++j) { v0[j] = gelu_tanh_f(v0[j]); v1[j] = gelu_tanh_f(v1[j]); } }
                u32x4 w; w.x = cvtpk(v0[0], v0[1]); w.y = cvtpk(v0[2], v0[3]); w.z = cvtpk(v1[0], v1[1]); w.w = cvtpk(v1[2], v1[3]);
                *(u32x4*)(rowb + lane_off + bj * HALF * 2) = w; } }
}
}

namespace att {
constexpr int NW = 8, QBLK = 32, KVBLK = 64;
constexpr int SHM_V = KVBLK * 128 * 2;
constexpr float THR = 8.f;
__device__ __forceinline__ int crow(int r, int hi) { return (r & 3) + 8 * (r >> 2) + 4 * hi; }
template <int DQK> struct Cfg { static constexpr float SCALE = (DQK == 128) ? 0.088388347648318440f : 0.072168783648703220f; static constexpr int KP = DQK * 2, SHM_K = KVBLK * DQK * 2, ND = DQK / 16; };
#define KSWZ(PITCH, row, colB) ((row) * (PITCH) + ((colB) ^ (((row) & 7) << 4)))
template <int DQK> __device__ __forceinline__ void partialSM(f32x16& p0, f32x16& p1, float& m_reg, float& mn, float& alpha) {
    constexpr float SCALE = Cfg<DQK>::SCALE, C = SCALE * 1.4426950408889634f;
    float pmax = p0[0];
#pragma unroll
    for (int r = 1; r < 16; ++r) pmax = fmaxf(pmax, p0[r]);
#pragma unroll
    for (int r = 0; r < 16; ++r) pmax = fmaxf(pmax, p1[r]);
    { auto rr = __builtin_amdgcn_permlane32_swap(__float_as_uint(pmax), __float_as_uint(pmax), false, false);
      pmax = fmaxf(__uint_as_float(rr[0]), __uint_as_float(rr[1])); }
    if (__builtin_expect(__all(pmax - m_reg <= THR / SCALE), 1)) { mn = m_reg; alpha = 1.f; }
    else { mn = fmaxf(m_reg, pmax); alpha = __builtin_amdgcn_exp2f((m_reg - mn) * C); m_reg = mn; }
    const float mnC = -mn * C;
#pragma unroll
    for (int r = 0; r < 16; ++r) p0[r] = fmaf(p0[r], C, mnC);
#pragma unroll
    for (int r = 0; r < 16; ++r) p1[r] = fmaf(p1[r], C, mnC);
#pragma unroll
    for (int r = 0; r < 16; ++r) p0[r] = __builtin_amdgcn_exp2f(p0[r]);
}
__device__ __forceinline__ void finishSM(f32x16& p0, f32x16& p1, float alpha, float& l_reg, bf16x8& pa0, bf16x8& pa1, bf16x8& pa2, bf16x8& pa3) {
#pragma unroll
    for (int r = 0; r < 16; ++r) p1[r] = __builtin_amdgcn_exp2f(p1[r]);
    float ps = 0;
#pragma unroll
    for (int r = 0; r < 16; ++r) ps += p0[r];
#pragma unroll
    for (int r = 0; r < 16; ++r) ps += p1[r];
    { auto rr = __builtin_amdgcn_permlane32_swap(__float_as_uint(ps), __float_as_uint(ps), false, false);
      ps = __uint_as_float(rr[0]) + __uint_as_float(rr[1]); }
    l_reg = l_reg * alpha + ps;
#define PK4(P, BASE, OUT) do { unsigned a0 = cvtpk(P[BASE + 0], P[BASE + 1]), a1 = cvtpk(P[BASE + 2], P[BASE + 3]);   \
    unsigned b0 = cvtpk(P[BASE + 4], P[BASE + 5]), b1 = cvtpk(P[BASE + 6], P[BASE + 7]);                              \
    auto r0 = __builtin_amdgcn_permlane32_swap(a0, b0, false, false); auto r1 = __builtin_amdgcn_permlane32_swap(a1, b1, false, false); \
    u32x4 w = {r0[0], r1[0], r0[1], r1[1]}; OUT = *reinterpret_cast<bf16x8*>(&w); } while (0)
    PK4(p0, 0, pa0); PK4(p0, 8, pa1); PK4(p1, 0, pa2); PK4(p1, 8, pa3);
#undef PK4
}
template <int DQK> __device__ __forceinline__ void qkt(f32x16& p0, f32x16& p1, const LAS char* Ks, const bf16x8* qr, int r32, int hi) {
    constexpr int KP = Cfg<DQK>::KP, ND = Cfg<DQK>::ND;
    p0 = f32x16{}; p1 = f32x16{};
#pragma unroll
    for (int d0 = 0; d0 < ND; ++d0) { const int cb = (d0 * 16 + hi * 8) * 2;
        bf16x8 b0 = *reinterpret_cast<const LAS bf16x8*>(Ks + KSWZ(KP, r32, cb));
        bf16x8 b1 = *reinterpret_cast<const LAS bf16x8*>(Ks + KSWZ(KP, 32 + r32, cb));
        p0 = __builtin_amdgcn_mfma_f32_32x32x16_bf16(b0, qr[d0], p0, 0, 0, 0);
        p1 = __builtin_amdgcn_mfma_f32_32x32x16_bf16(b1, qr[d0], p1, 0, 0, 0); }
}
__device__ __forceinline__ int v_st(int k, int c) { const int kk = (k & ~0xC) | ((k & 4) << 1) | ((k & 8) >> 1); return ((kk >> 3) * 4 + (c >> 5)) * 512 + ((kk & 7) * 32 + (c & 31)) * 2; }
__device__ __forceinline__ int v_rd_base(int lane) { return ((lane & 3) << 3) | (((lane >> 2) & 3) << 6) | (((lane >> 4) & 1) << 5) | (((lane >> 5) & 1) << 8); }
constexpr int v_rd_off(int d0, int ks, int half) { return d0 * 512 + ks * 4096 + half * 2048; }
template <int OFF> __device__ __forceinline__ s16x4 tr_read(int vb) {
    s16x4 r; asm volatile("ds_read_b64_tr_b16 %0, %1 offset:%2" : "=&v"(r) : "v"(vb), "i"(OFF) : "memory"); return r;
}
template <int D0> __device__ __forceinline__ void pv_one(f32x16& od, int vb, bf16x8 pa0, bf16x8 pa1, bf16x8 pa2, bf16x8 pa3) {
    const s16x4 l0 = tr_read<v_rd_off(D0, 0, 0)>(vb), h0 = tr_read<v_rd_off(D0, 0, 1)>(vb), l1 = tr_read<v_rd_off(D0, 1, 0)>(vb), h1 = tr_read<v_rd_off(D0, 1, 1)>(vb);
    const s16x4 l2 = tr_read<v_rd_off(D0, 2, 0)>(vb), h2 = tr_read<v_rd_off(D0, 2, 1)>(vb), l3 = tr_read<v_rd_off(D0, 3, 0)>(vb), h3 = tr_read<v_rd_off(D0, 3, 1)>(vb);
    asm volatile("s_waitcnt lgkmcnt(0)" ::: "memory"); SBAR();
#define PK(L, H) (bf16x8){L[0], L[1], L[2], L[3], H[0], H[1], H[2], H[3]}
    od = __builtin_amdgcn_mfma_f32_32x32x16_bf16(pa0, PK(l0, h0), od, 0, 0, 0);
    od = __builtin_amdgcn_mfma_f32_32x32x16_bf16(pa1, PK(l1, h1), od, 0, 0, 0);
    od = __builtin_amdgcn_mfma_f32_32x32x16_bf16(pa2, PK(l2, h2), od, 0, 0, 0);
    od = __builtin_amdgcn_mfma_f32_32x32x16_bf16(pa3, PK(l3, h3), od, 0, 0, 0);
#undef PK
}
__device__ __forceinline__ void pv_d0(f32x16* o, int vb, bf16x8 pa0, bf16x8 pa1, bf16x8 pa2, bf16x8 pa3) {
    pv_one<0>(o[0], vb, pa0, pa1, pa2, pa3); pv_one<1>(o[1], vb, pa0, pa1, pa2, pa3); pv_one<2>(o[2], vb, pa0, pa1, pa2, pa3); pv_one<3>(o[3], vb, pa0, pa1, pa2, pa3);
}
__device__ __forceinline__ bf16x8 ld8(const bf16_t* p) { return *reinterpret_cast<const bf16x8*>(p); }
__device__ __forceinline__ void rope_frag(bf16x8& a, bf16x8& b, const f32x2* tab) {
    u32x4 wa = *reinterpret_cast<u32x4*>(&a), wb = *reinterpret_cast<u32x4*>(&b), oa, ob;
#pragma unroll
    for (int q = 0; q < 4; ++q) {
        const float x1l = bflo(wa[q]), x1h = bfhi(wa[q]), x2l = bflo(wb[q]), x2h = bfhi(wb[q]);
        const f32x2 t0 = tab[2 * q], t1 = tab[2 * q + 1];
        oa[q] = cvtpk(x1l * t0.x - x2l * t0.y, x1h * t1.x - x2h * t1.y);
        ob[q] = cvtpk(x2l * t0.x + x1l * t0.y, x2h * t1.x + x1h * t1.y);
    }
    a = *reinterpret_cast<bf16x8*>(&oa); b = *reinterpret_cast<bf16x8*>(&ob);
}
template <int DQK, int SDEPTH, bool MLA, int ldq, int ldkv, int ldo>
__device__ __forceinline__ void attn_unit(const bf16_t* __restrict__ Qb, const bf16_t* __restrict__ Kh, const bf16_t* __restrict__ KRh, const bf16_t* __restrict__ Vh,
                                          bf16_t* __restrict__ Ob, int seq, LAS char* lds, const f32x2* __restrict__ tabm, int qt0, int wave_s) {
    constexpr int KP = Cfg<DQK>::KP, SHM_K = Cfg<DQK>::SHM_K, ND = Cfg<DQK>::ND;
    const int tid = tid_fresh(wave_s), wid = tid >> 6, lane = tid & 63, r32 = lane & 31, hi = lane >> 5;
    LAS char* V_lds = lds; LAS char* K_lds = lds + 2 * SHM_V;
    LAS float* wsl = (LAS float*)(lds + 2 * SHM_V + 2 * SHM_K) + wid * 64; LAS float* li_l = wsl; LAS float* al_l = wsl + 32;
    float m_reg = -1e30f, l_reg = 0; f32x16 o[4] = {}; bf16x8 qr[ND];
    const bf16_t* Qw = Qb + (long)(wid * QBLK + r32) * ldq + hi * 8;
#pragma unroll
    for (int d0 = 0; d0 < ND; ++d0) qr[d0] = ld8(Qw + d0 * 16);
    if constexpr (MLA) {
        const int t = qt0 + wid * QBLK + r32, prow = t >> 6, pcol = t & 63;
        rope_frag(qr[8], qr[9], tabm + prow * 16 + hi * 8);
        rope_frag(qr[10], qr[11], tabm + pcol * 16 + hi * 8);
    }
    const int sr = tid >> 4, sc = (tid & 15) * 8, vst0 = v_st(sr, sc), vst1 = v_st(32 + sr, sc);
    const int krr = tid >> 3, krc = (tid & 7) * 8;
    const int vb0 = (int)(unsigned)(uintptr_t)V_lds + v_rd_base(lane);
    struct { bf16x8 vs0, vs1, ks0, ks1, kr; } sr_[SDEPTH];
#define SLOAD(i, k0) do { sr_[i].vs0 = ld8(&Vh[(long)((k0) + sr) * ldkv + sc]); sr_[i].vs1 = ld8(&Vh[(long)((k0) + 32 + sr) * ldkv + sc]); \
    sr_[i].ks0 = ld8(&Kh[(long)((k0) + sr) * ldkv + sc]); sr_[i].ks1 = ld8(&Kh[(long)((k0) + 32 + sr) * ldkv + sc]); \
    if constexpr (MLA) sr_[i].kr = ld8(&KRh[(long)((k0) + krr) * 64 + krc]); } while (0)
#define SWRITE(b, i) do { *(LAS bf16x8*)(V_lds + (b) * SHM_V + vst0) = sr_[i].vs0;          \
    *(LAS bf16x8*)(V_lds + (b) * SHM_V + vst1) = sr_[i].vs1; const int kc = sc * 2;               \
    *(LAS bf16x8*)(K_lds + (b) * SHM_K + KSWZ(KP, sr, kc)) = sr_[i].ks0;                       \
    *(LAS bf16x8*)(K_lds + (b) * SHM_K + KSWZ(KP, 32 + sr, kc)) = sr_[i].ks1;                  \
    if constexpr (MLA) *(LAS bf16x8*)(K_lds + (b) * SHM_K + KSWZ(KP, krr, 256 + krc * 2)) = sr_[i].kr; } while (0)
#define SWAIT() do { if constexpr (SDEPTH == 2) { if constexpr (MLA) asm volatile("s_waitcnt vmcnt(5)" ::: "memory"); else asm volatile("s_waitcnt vmcnt(4)" ::: "memory"); } else asm volatile("s_waitcnt vmcnt(0)" ::: "memory"); } while (0)
#define RESC(a) do { if (__any((a) < 1.f)) { if (hi == 0) al_l[r32] = (a); asm volatile("s_waitcnt lgkmcnt(0)" ::: "memory"); \
    _Pragma("unroll") for (int d = 0; d < 4; ++d) _Pragma("unroll") for (int r = 0; r < 16; ++r) o[d][r] *= al_l[crow(r, hi)]; } } while (0)
    bf16x8 pa0, pa1, pa2, pa3; const int NT = seq / KVBLK;
    if constexpr (MLA) {
        f32x16 p0, p1; float mn, al;
        SLOAD(0, 0); asm volatile("s_waitcnt vmcnt(0)" ::: "memory"); SWRITE(0, 0); SLOAD(0, KVBLK); __syncthreads();
        for (int j = 0; j < NT; ++j) {
            const int cb = j & 1;
            if (j + 1 < NT) { asm volatile("s_waitcnt vmcnt(0)" ::: "memory"); SWRITE(cb ^ 1, 0); if (j + 2 < NT) SLOAD(0, (j + 2) * KVBLK); }
            SBAR(); qkt<DQK>(p0, p1, K_lds + cb * SHM_K, qr, r32, hi);
            partialSM<DQK>(p0, p1, m_reg, mn, al); RESC(al);
            finishSM(p0, p1, al, l_reg, pa0, pa1, pa2, pa3); SBAR();
            pv_d0(o, vb0 + cb * SHM_V, pa0, pa1, pa2, pa3);
            __syncthreads();
        }
    } else {
    f32x16 pA0, pA1, pB0, pB1; float mnA, mnB, alA, alB;
    constexpr int SE = 0, SO = SDEPTH - 1;
    SLOAD(SE, 0); asm volatile("s_waitcnt vmcnt(0)" ::: "memory"); SWRITE(0, SE); __syncthreads();
    qkt<DQK>(pA0, pA1, K_lds, qr, r32, hi); partialSM<DQK>(pA0, pA1, m_reg, mnA, alA);
    SLOAD(SO, KVBLK); if constexpr (SDEPTH == 2) { if (2 < NT) SLOAD(SE, 2 * KVBLK); }
    SWAIT(); SWRITE(1, SO); __syncthreads();
    for (int j = 1; j + 1 < NT; j += 2) {
        SBAR(); qkt<DQK>(pB0, pB1, K_lds + SHM_K, qr, r32, hi);
        finishSM(pA0, pA1, alA, l_reg, pa0, pa1, pa2, pa3); SBAR();
        SLOAD(SO, (j + SDEPTH) * KVBLK); SBAR();
        pv_d0(o, vb0, pa0, pa1, pa2, pa3); partialSM<DQK>(pB0, pB1, m_reg, mnB, alB);
        __syncthreads(); SWAIT(); SWRITE(0, SE);
        RESC(alB); __syncthreads();
        SBAR(); qkt<DQK>(pA0, pA1, K_lds, qr, r32, hi);
        finishSM(pB0, pB1, alB, l_reg, pa0, pa1, pa2, pa3); SBAR();
        if (SDEPTH == 1 || j + 3 < NT) SLOAD(SE, (j + 1 + SDEPTH) * KVBLK); SBAR();
        pv_d0(o, vb0 + SHM_V, pa0, pa1, pa2, pa3); partialSM<DQK>(pA0, pA1, m_reg, mnA, alA);
        __syncthreads(); SWAIT(); SWRITE(1, SO);
        RESC(alA); __syncthreads();
    }
    SBAR(); qkt<DQK>(pB0, pB1, K_lds + SHM_K, qr, r32, hi);
    finishSM(pA0, pA1, alA, l_reg, pa0, pa1, pa2, pa3); SBAR();
    pv_d0(o, vb0, pa0, pa1, pa2, pa3); partialSM<DQK>(pB0, pB1, m_reg, mnB, alB);
    __syncthreads(); RESC(alB);
    finishSM(pB0, pB1, alB, l_reg, pa0, pa1, pa2, pa3); SBAR();
    pv_d0(o, vb0 + SHM_V, pa0, pa1, pa2, pa3);
    }
    if (hi == 0) li_l[r32] = l_reg; asm volatile("s_waitcnt lgkmcnt(0)" ::: "memory");
    float rli[16];
#pragma unroll
    for (int r = 0; r < 16; ++r) rli[r] = __builtin_amdgcn_rcpf(li_l[crow(r, hi)]);
    bf16_t* Ow = Ob + (long)(wid * QBLK) * ldo;
#pragma unroll
    for (int r = 0; r < 16; ++r) { const int orow = crow(r, hi);
#pragma unroll
        for (int d0 = 0; d0 < 4; ++d0) Ow[(long)orow * ldo + d0 * 32 + r32] = f2bf(o[d0][r] * rli[r]); }
    __syncthreads();
#undef SLOAD
#undef SWRITE
#undef SWAIT
#undef RESC
}
}

template <int MODE> __device__ __forceinline__ int dst_row(int n) {
    if (MODE == 1) { const int half = n >> 10, c = n & 1023; return ((c >> 7) << 8) + (half << 7) + (c & 127); }
    if (MODE == 2) { const int h = n >> 8, j = n & 255; return j < 128 ? (h << 7) + j : 1024 + (h << 7) + (j - 128); }
    return n;
}
template <int MODE> __device__ __forceinline__ void p0_transpose_item_fp8(const float* W, int K, int N, unsigned char* WT, LAS float* scr, int item, int lane) {
    const int nblk = N / 32, kb = item / nblk, nb = item % nblk, k0 = 64 * kb, n0 = 32 * nb;
#pragma unroll 8
    for (int i = 0; i < 32; ++i) { const int kk = 2 * i + (lane >> 5); scr[kk * 33 + (lane & 31)] = W[(size_t)(k0 + kk) * N + n0 + (lane & 31)]; }
    LDS_WAIT(); asm volatile("" ::: "memory");
    const int c = lane & 7;
#pragma unroll
    for (int j = 0; j < 4; ++j) { const int n = (lane >> 3) + 8 * j; const LAS float* s = scr + (8 * c) * 33 + n;
        u32x2 o; o.x = pk4_fp8(s[0 * 33] * 64.f, s[1 * 33] * 64.f, s[2 * 33] * 64.f, s[3 * 33] * 64.f); o.y = pk4_fp8(s[4 * 33] * 64.f, s[5 * 33] * 64.f, s[6 * 33] * 64.f, s[7 * 33] * 64.f);
        *(u32x2*)(WT + (size_t)dst_row<MODE>(n0 + n) * K + k0 + 8 * c) = o; }
    LDS_WAIT(); asm volatile("" ::: "memory");
}
template <int MODE> __device__ __forceinline__ void p0_transpose_item(const float* W, int K, int N, bf16_t* WT, LAS float* scr, int item, int lane) {
    const int nblk = N / 32, kb = item / nblk, nb = item % nblk, k0 = 64 * kb, n0 = 32 * nb;
#pragma unroll 8
    for (int i = 0; i < 32; ++i) { const int kk = 2 * i + (lane >> 5); scr[kk * 33 + (lane & 31)] = W[(size_t)(k0 + kk) * N + n0 + (lane & 31)]; }
    LDS_WAIT(); asm volatile("" ::: "memory");
    const int c = lane & 7;
#pragma unroll
    for (int j = 0; j < 4; ++j) { const int n = (lane >> 3) + 8 * j; const LAS float* s = scr + (8 * c) * 33 + n;
        u32x4 o; o.x = cvtpk(s[0 * 33], s[1 * 33]); o.y = cvtpk(s[2 * 33], s[3 * 33]); o.z = cvtpk(s[4 * 33], s[5 * 33]); o.w = cvtpk(s[6 * 33], s[7 * 33]);
        *(u32x4*)(WT + (size_t)dst_row<MODE>(n0 + n) * K + k0 + 8 * c) = o; }
    LDS_WAIT(); asm volatile("" ::: "memory");
}
__device__ __forceinline__ void p0_prologue(Frame& F) {
    uchar* ws = F.ws;
    {
        LAS float* S = (LAS float*)F.lds;
        const float* pC = INP(I_C); const float* pCC = INP(I_CCTX); const float* pAW = INP(I_ADAW); const float* pAB = INP(I_ADAB); const float* pNM = INP(I_NMIXG); const float* pNF = INP(I_NFFNG);
        float* MOD = (float*)(ws + WS_MOD);
        for (int item = F.bid; item < 192; item += F.G) {
            const int layer = item / 96, n0 = (item % 96) * 64;
            __syncthreads();
            for (int u = F.tid; u < 33 * 1024; u += 512) { const int j = u >> 10, k = u & 1023; const float c = j < 32 ? pC[j * 1024 + k] : pCC[k]; S[u] = silu_f(c); }
            __syncthreads();
            float acc[33];
#pragma unroll
            for (int j = 0; j < 33; ++j) acc[j] = 0.f;
            const float* wp = pAW + (size_t)layer * 1024 * 6144 + n0 + F.lane;
            const int kbeg = F.wave * 128;
            for (int k = kbeg; k < kbeg + 128; k += 4) {
                const float w0 = wp[(size_t)k * 6144], w1 = wp[(size_t)(k + 1) * 6144], w2 = wp[(size_t)(k + 2) * 6144], w3 = wp[(size_t)(k + 3) * 6144];
#pragma unroll
                for (int j = 0; j < 33; ++j) { const f32x4 s = *(const LAS f32x4*)(S + j * 1024 + k); acc[j] += s.x * w0 + s.y * w1 + s.z * w2 + s.w * w3; }
            }
            __syncthreads();
#pragma unroll
            for (int j = 0; j < 33; ++j) S[(F.wave * 33 + j) * 64 + F.lane] = acc[j];
            __syncthreads();
            for (int u = F.tid; u < 33 * 64; u += 512) { const int j = u >> 6, cl = u & 63; float s = 0.f;
#pragma unroll
                for (int w = 0; w < 8; ++w) s += S[(w * 33 + j) * 64 + cl];
                const int n = n0 + cl, part = n >> 10, col = n & 1023;
                s += pAB[layer * 6144 + n];
                if (part == 1) s = pNM[layer * 1024 + col] * (1.f + s);
                if (part == 4) s = pNF[layer * 1024 + col] * (1.f + s);
                MOD[((size_t)(layer * 33 + j) * 6 + part) * 1024 + col] = s; }
        }
        __syncthreads();
    }
    {
        const int gt = F.bid * 512 + F.tid, NT = F.G * 512;
        f32x2* tg = (f32x2*)(ws + WS_TABG); f32x2* tm = (f32x2*)(ws + WS_TABM);
        for (int u = gt; u < 64 * 32; u += NT) { const int pos = u >> 5, i = u & 31; const float inv = powf(10000.f, -(float)(2 * i) / 64.f); const float a = (float)pos * inv; tg[u] = (f32x2){cosf(a), sinf(a)}; }
        for (int u = gt; u < 64 * 16; u += NT) { const int pos = u >> 4, i = u & 15; const float inv = powf(10000.f, -(float)(2 * i) / 32.f); const float a = (float)pos * inv; tm[u] = (f32x2){cosf(a), sinf(a)}; }
        float* wrt = (float*)(ws + WS_WRT); const float* pRW = INP(I_RW); const float* pSW = INP(I_SGUW);
        for (int u = gt; u < 2 * 32 * 1024; u += NT) { const int l = u >> 15, e = (u >> 10) & 31, k = u & 1023; wrt[u] = pRW[((size_t)l * 1024 + k) * 32 + e]; }
        bf16_t* sw = (bf16_t*)(ws + WS_SGUW);
        for (int u = gt; u < 4 * 128 * 128; u += NT) sw[u] = f2bf(pSW[u]);
        u32x4* z = (u32x4*)(ws + WS_WIN1 + (size_t)832 * 1024 * 2);
        for (int u = gt; u < 192 * 1024 * 2 / 16; u += NT) z[u] = (u32x4){0u, 0u, 0u, 0u};
    }
    {
        LAS float* scr = (LAS float*)(F.lds + F.wave * 16384);
        const int gw = F.bid * 8 + F.wave, NGW = F.G * 8; const float* pW1 = INP(I_W1); const float* pW2 = INP(I_W2);
        constexpr int J0 = 16 * 64, J1 = 16 * 32, J2 = 16 * 26, J3 = 8 * 48, J4 = 4 * 64, J5 = 16 * 32, JW1 = 64 * 1024, JW2 = 64 * 512;
        constexpr int NITEMS = J0 + J1 + J2 + J3 + J4 + J5 + JW1 + JW2;
        for (int it = gw; it < NITEMS; it += NGW) {
            int r = it;
#if MOE_FP8
            if (r < JW1) { const int le = r >> 10; p0_transpose_item_fp8<1>(pW1 + (size_t)le * 1024 * 2048, 1024, 2048, (unsigned char*)(ws + WS_W1) + (size_t)le * 2048 * 1024, scr, r & 1023, F.lane); continue; } r -= JW1;
            if (r < JW2) { const int le = r >> 9; p0_transpose_item_fp8<0>(pW2 + (size_t)le * 1024 * 1024, 1024, 1024, (unsigned char*)(ws + WS_W2) + (size_t)le * 1024 * 1024, scr, r & 511, F.lane); continue; } r -= JW2;
#else
            if (r < JW1) { const int le = r >> 10; p0_transpose_item<1>(pW1 + (size_t)le * 1024 * 2048, 1024, 2048, (bf16_t*)(ws + WS_W1) + (size_t)le * 2048 * 1024, scr, r & 1023, F.lane); continue; } r -= JW1;
            if (r < JW2) { const int le = r >> 9; p0_transpose_item<0>(pW2 + (size_t)le * 1024 * 1024, 1024, 1024, (bf16_t*)(ws + WS_W2) + (size_t)le * 1024 * 1024, scr, r & 511, F.lane); continue; } r -= JW2;
#endif
            if (r < J0) { p0_transpose_item<0>(INP(I_ABWIN), 1024, 2048, (bf16_t*)(ws + WS_WIN0), scr, r, F.lane); continue; } r -= J0;
            if (r < J1) { p0_transpose_item<0>(INP(I_ABWOUT), 1024, 1024, (bf16_t*)(ws + WS_WOUT0), scr, r, F.lane); continue; } r -= J1;
            if (r < J2) { p0_transpose_item<0>(INP(I_MLAWIN), 1024, 832, (bf16_t*)(ws + WS_WIN1), scr, r, F.lane); continue; } r -= J2;
            if (r < J3) { p0_transpose_item<0>(INP(I_MLAWUQ), 512, 1536, (bf16_t*)(ws + WS_WUQ), scr, r, F.lane); continue; } r -= J3;
            if (r < J4) { p0_transpose_item<2>(INP(I_MLAWUKV), 256, 2048, (bf16_t*)(ws + WS_WUKV), scr, r, F.lane); continue; } r -= J4;
            p0_transpose_item<0>(INP(I_MLAWOUT), 1024, 1024, (bf16_t*)(ws + WS_WOUT1), scr, r, F.lane);
        }
    }
}

__device__ __forceinline__ void row_src_ptr(const float* px, const float* pctx, int r, const float*& src, int& mj) {
    const int b = r / TPB, pos = r - b * TPB;
    if (pos < CTXL) { src = pctx + ((size_t)b * CTXL + pos) * DM; mj = 32; } else { src = px + ((size_t)b * SEQ + (pos - CTXL)) * DM; mj = b; }
}
__device__ __forceinline__ void store_h_row(bf16_t* hrow, int lane, const f32x4 (&h)[4]) {
    unsigned long long* o8 = (unsigned long long*)hrow + lane;
#pragma unroll
    for (int j = 0; j < 4; ++j) o8[64 * j] = (unsigned long long)cvtpk(h[j].x, h[j].y) | ((unsigned long long)cvtpk(h[j].z, h[j].w) << 32);
}
__device__ __forceinline__ void p_norm0(Frame& F) {
    const float* MOD = (const float*)(F.ws + WS_MOD); bf16_t* H = (bf16_t*)(F.ws + WS_H);
    const int gw = F.bid * 8 + F.wave, NGW = F.G * 8; const float* px = INP(I_X); const float* pctx = INP(I_CTX);
    for (int r = gw; r < NTOK; r += NGW) {
        const float* src; int mj; row_src_ptr(px, pctx, r, src, mj);
        const f32x4* xr = (const f32x4*)src + F.lane; f32x4 v[4]; float ss = 0.f;
#pragma unroll
        for (int j = 0; j < 4; ++j) { v[j] = xr[64 * j]; ss += (v[j].x * v[j].x + v[j].y * v[j].y) + (v[j].z * v[j].z + v[j].w * v[j].w); }
        const float rstd = rsqrtf(wave_sum(ss) * (1.f / DM) + EPS);
        const f32x4* sh = (const f32x4*)(MOD + ((size_t)(0 * 33 + mj) * 6 + 0) * 1024) + F.lane; const f32x4* A = (const f32x4*)(MOD + ((size_t)(0 * 33 + mj) * 6 + 1) * 1024) + F.lane;
        f32x4 h[4];
#pragma unroll
        for (int j = 0; j < 4; ++j) h[j] = v[j] * rstd * A[64 * j] + sh[64 * j];
        store_h_row(H + (size_t)r * DM, F.lane, h);
    }
}
__device__ __forceinline__ void moe_prefix(Frame& F, int layer) {
    LAS int* pb = (LAS int*)(F.lds + XTRA_OFF + X_PB); LAS int* cn = (LAS int*)(F.lds + XTRA_OFF + X_CNT);
    const unsigned* gc = (const unsigned*)(F.ws + WS_CTL) + CW_CNT + layer * 64;
    __syncthreads();
    if (F.tid == 0) { int s = 0; for (int e = 0; e < 32; ++e) { const int c = (int)__hip_atomic_load(gc + e, __ATOMIC_RELAXED, __HIP_MEMORY_SCOPE_AGENT); cn[e] = c; pb[e] = s; s += (c + 255) >> 8; } pb[32] = s; }
    __syncthreads();
}
__device__ __forceinline__ void moe_gather_row(const Frame& F, int r, f32x4 (&f)[4]) {
    const LAS int* pb = (const LAS int*)(F.lds + XTRA_OFF + X_PB);
    const u32x2* ti = (const u32x2*)(F.ws + WS_TOKI) + (size_t)r * 4; const bf16_t* Y = (const bf16_t*)(F.ws + WS_Y);
#pragma unroll
    for (int j = 0; j < 4; ++j) f[j] = (f32x4){0.f, 0.f, 0.f, 0.f};
#pragma unroll
    for (int k = 0; k < 4; ++k) {
        const u32x2 t = ti[k]; const int e = (int)(t.x >> 20), pos = (int)(t.x & 0xfffffu); const float g = __uint_as_float(t.y);
        const size_t yrow = (size_t)pb[e] * 256 + pos; const u32x2* yp = (const u32x2*)(Y + yrow * DM) + F.lane;
#pragma unroll
        for (int j = 0; j < 4; ++j) { const u32x2 w = yp[64 * j]; f[j].x += g * bflo(w.x); f[j].y += g * bfhi(w.x); f[j].z += g * bflo(w.y); f[j].w += g * bfhi(w.y); }
    }
}
__device__ __forceinline__ void p_combine_norm(Frame& F) {
    moe_prefix(F, 0);
    const float* MOD = (const float*)(F.ws + WS_MOD); bf16_t* H = (bf16_t*)(F.ws + WS_H); float* XR = (float*)(F.ws + WS_XR);
    const int gw = F.bid * 8 + F.wave, NGW = F.G * 8;
    for (int r = gw; r < NTOK; r += NGW) {
        const int b = r / TPB, pos = r - b * TPB, mj = pos < CTXL ? 32 : b;
        f32x4 f[4]; moe_gather_row(F, r, f);
        f32x4* xr = (f32x4*)(XR + (size_t)r * DM) + F.lane; const f32x4* g2 = (const f32x4*)(MOD + ((size_t)(0 * 33 + mj) * 6 + 5) * 1024) + F.lane;
        f32x4 v[4]; float ss = 0.f;
#pragma unroll
        for (int j = 0; j < 4; ++j) { v[j] = xr[64 * j] + g2[64 * j] * f[j]; xr[64 * j] = v[j]; ss += (v[j].x * v[j].x + v[j].y * v[j].y) + (v[j].z * v[j].z + v[j].w * v[j].w); }
        const float rstd = rsqrtf(wave_sum(ss) * (1.f / DM) + EPS);
        const f32x4* sh = (const f32x4*)(MOD + ((size_t)(1 * 33 + mj) * 6 + 0) * 1024) + F.lane; const f32x4* A = (const f32x4*)(MOD + ((size_t)(1 * 33 + mj) * 6 + 1) * 1024) + F.lane;
        f32x4 h[4];
#pragma unroll
        for (int j = 0; j < 4; ++j) h[j] = v[j] * rstd * A[64 * j] + sh[64 * j];
        store_h_row(H + (size_t)r * DM, F.lane, h);
    }
}
__device__ __forceinline__ void p_final(Frame& F) {
    moe_prefix(F, 1);
    const float* MOD = (const float*)(F.ws + WS_MOD); const float* XR = (const float*)(F.ws + WS_XR);
    const int gw = F.bid * 8 + F.wave, NGW = F.G * 8; const float* pfg = INP(I_FNG);
    for (int q = gw; q < NBATCH * SEQ; q += NGW) {
        const int b = q >> 11, t = q & 2047, r = b * TPB + CTXL + t;
        f32x4 f[4]; moe_gather_row(F, r, f);
        const f32x4* xr = (const f32x4*)(XR + (size_t)r * DM) + F.lane; const f32x4* g2 = (const f32x4*)(MOD + ((size_t)(1 * 33 + b) * 6 + 5) * 1024) + F.lane;
        f32x4 v[4]; float ss = 0.f;
#pragma unroll
        for (int j = 0; j < 4; ++j) { v[j] = xr[64 * j] + g2[64 * j] * f[j]; ss += (v[j].x * v[j].x + v[j].y * v[j].y) + (v[j].z * v[j].z + v[j].w * v[j].w); }
        const float rstd = rsqrtf(wave_sum(ss) * (1.f / DM) + EPS);
        const f32x4* fg = (const f32x4*)pfg + F.lane; f32x4* op = (f32x4*)(F.out + (size_t)q * DM) + F.lane;
#pragma unroll
        for (int j = 0; j < 4; ++j) op[64 * j] = v[j] * rstd * fg[64 * j];
    }
}
template <int LAYER> __device__ __forceinline__ void p_norm_router(Frame& F) {
    const float* MOD = (const float*)(F.ws + WS_MOD); bf16_t* H = (bf16_t*)(F.ws + WS_H); const float* XR = (const float*)(F.ws + WS_XR);
    LAS float* WL = (LAS float*)F.lds;
    LAS int* hist = (LAS int*)(F.lds + XTRA_OFF + X_HIST); LAS int* base = (LAS int*)(F.lds + XTRA_OFF + X_BASE); LAS u32x4* sel = (LAS u32x4*)(F.lds + XTRA_OFF + X_SEL);
    unsigned* gcnt = (unsigned*)(F.ws + WS_CTL) + CW_CNT + LAYER * 64;
    int* rowl = (int*)(F.ws + WS_ROWL); u32x2* toki = (u32x2*)(F.ws + WS_TOKI);
    __syncthreads();
    { const f32x4* src = (const f32x4*)(F.ws + WS_WRT + (size_t)LAYER * 32 * 1024 * 4); for (int u = F.tid; u < 8192; u += 512) ((LAS f32x4*)WL)[u] = src[u]; }
    if (F.tid < 32) hist[F.tid] = 0;
    __syncthreads();
    const int lane = F.lane; const float* prb = INP(I_RB);
    constexpr int NP = LAYER == 0 ? NPAN : 256;
    for (int pi = F.bid; pi < NP; pi += F.G) {
        const int pan = LAYER == 0 ? pi : pi + pi / 8 + 1;
        const int b = pan / 9, mj = (pan % 9 == 0) ? 32 : b;
        const f32x4* shp = (const f32x4*)(MOD + ((size_t)(LAYER * 33 + mj) * 6 + 3) * 1024) + lane; const f32x4* Ap = (const f32x4*)(MOD + ((size_t)(LAYER * 33 + mj) * 6 + 4) * 1024) + lane;
        for (int g8 = 0; g8 < 8; ++g8) {
            const int rl0 = F.wave * 32 + g8 * 4, r0 = pan * 256 + rl0;
            f32x4 hv[4][4];
#pragma unroll
            for (int rr = 0; rr < 4; ++rr) { const f32x4* xr = (const f32x4*)(XR + (size_t)(r0 + rr) * DM) + lane; float ss = 0.f;
#pragma unroll
                for (int j = 0; j < 4; ++j) { hv[rr][j] = xr[64 * j]; ss += (hv[rr][j].x * hv[rr][j].x + hv[rr][j].y * hv[rr][j].y) + (hv[rr][j].z * hv[rr][j].z + hv[rr][j].w * hv[rr][j].w); }
                const float rstd = rsqrtf(wave_sum(ss) * (1.f / DM) + EPS);
#pragma unroll
                for (int j = 0; j < 4; ++j) hv[rr][j] = hv[rr][j] * rstd * Ap[64 * j] + shp[64 * j];
                if constexpr (MOE_FP8 != 0) { unsigned* o4 = (unsigned*)((unsigned char*)H + (size_t)(r0 + rr) * DM) + lane;
#pragma unroll
                    for (int j = 0; j < 4; ++j) o4[64 * j] = pk4_fp8(hv[rr][j].x * 4.f, hv[rr][j].y * 4.f, hv[rr][j].z * 4.f, hv[rr][j].w * 4.f); }
                else store_h_row(H + (size_t)(r0 + rr) * DM, lane, hv[rr]);
            }
            const int e3 = ((lane >> 5) & 1) * 4 + ((lane >> 4) & 1) * 2 + ((lane >> 3) & 1);
            const int myidx = (lane & 3) * 8 + e3; float myv[4] = {0.f, 0.f, 0.f, 0.f};
#pragma unroll 1
            for (int q = 0; q < 4; ++q) {
                float acc[4][8];
#pragma unroll
                for (int rr = 0; rr < 4; ++rr)
#pragma unroll
                    for (int e = 0; e < 8; ++e) acc[rr][e] = 0.f;
                const LAS float* wq = WL + q * 8 * 1024 + 4 * lane;
#pragma unroll
                for (int e = 0; e < 8; ++e)
#pragma unroll
                    for (int j = 0; j < 4; ++j) { const f32x4 w = *(const LAS f32x4*)(wq + e * 1024 + 256 * j);
#pragma unroll
                        for (int rr = 0; rr < 4; ++rr) acc[rr][e] += (hv[rr][j].x * w.x + hv[rr][j].y * w.y) + (hv[rr][j].z * w.z + hv[rr][j].w * w.w); }
                const float rbq = prb[LAYER * 32 + q * 8 + e3];
#pragma unroll
                for (int rr = 0; rr < 4; ++rr) {
                    float v4[4], v2[2], v1;
                    { const bool up = (lane >> 5) & 1;
#pragma unroll
                      for (int e = 0; e < 4; ++e) { const float keep = up ? acc[rr][e + 4] : acc[rr][e], send = up ? acc[rr][e] : acc[rr][e + 4]; v4[e] = keep + __shfl_xor(send, 32); } }
                    { const bool up = (lane >> 4) & 1;
#pragma unroll
                      for (int e = 0; e < 2; ++e) { const float keep = up ? v4[e + 2] : v4[e], send = up ? v4[e] : v4[e + 2]; v2[e] = keep + __shfl_xor(send, 16); } }
                    { const bool up = (lane >> 3) & 1; const float keep = up ? v2[1] : v2[0], send = up ? v2[0] : v2[1]; v1 = keep + __shfl_xor(send, 8); }
                    v1 += __shfl_xor(v1, 4); v1 += __shfl_xor(v1, 2); v1 += __shfl_xor(v1, 1);
                    myv[rr] = ((lane & 3) == q) ? v1 + rbq : myv[rr];
                }
            }
#pragma unroll
            for (int rr = 0; rr < 4; ++rr) {
                float mv = myv[rr], t0 = 0.f, myt = 0.f, esum = 0.f; int mye = 0;
#pragma unroll
                for (int k = 0; k < 4; ++k) {
                    const unsigned ub = __float_as_uint(mv); const unsigned ord = (ub & 0x80000000u) ? ~ub : (ub | 0x80000000u);
                    unsigned kv = ord, ki = (unsigned)(31 - myidx);
#pragma unroll
                    for (int o = 1; o < 64; o <<= 1) { const unsigned ov = (unsigned)__shfl_xor((int)kv, o), oi = (unsigned)__shfl_xor((int)ki, o); const bool tk = (ov > kv) || (ov == kv && oi > ki); kv = tk ? ov : kv; ki = tk ? oi : ki; }
                    const int widx = 31 - (int)ki;
                    const unsigned wo = kv; const unsigned wb = (wo & 0x80000000u) ? (wo & 0x7fffffffu) : ~wo; const float tvk = __uint_as_float(wb);
                    if (k == 0) t0 = tvk;
                    esum += __expf(tvk - t0);
                    mye = (lane == k) ? widx : mye; myt = (lane == k) ? tvk : myt;
                    asm volatile("" : "+v"(mye), "+v"(myt));
                    if (myidx == widx) mv = -3.0e38f;
                }
                if (lane < 4) { const int e = mye; const float g = __expf(myt - t0) / esum;
                    const int rank = __hip_atomic_fetch_add(hist + e, 1, __ATOMIC_RELAXED, __HIP_MEMORY_SCOPE_WORKGROUP);
                    sel[(rl0 + rr) * 4 + lane] = (u32x4){(unsigned)e, (unsigned)rank, __float_as_uint(g), 0u}; }
            }
        }
        __syncthreads();
        if (F.tid < 32) { const int c = hist[F.tid]; base[F.tid] = c ? (int)__hip_atomic_fetch_add(gcnt + F.tid, (unsigned)c, __ATOMIC_RELAXED, __HIP_MEMORY_SCOPE_AGENT) : 0; }
        __syncthreads();
        for (int u = F.tid; u < 1024; u += 512) { const u32x4 s = sel[u]; const int e = (int)s.x, pos = base[e] + (int)s.y, r = pan * 256 + (u >> 2);
            rowl[(size_t)e * ROWCAP + pos] = r; toki[(size_t)r * 4 + (u & 3)] = (u32x2){((unsigned)e << 20) | (unsigned)pos, s.z}; }
        __syncthreads();
        if (F.tid < 32) hist[F.tid] = 0;
        __syncthreads();
    }
}

__device__ __forceinline__ void p_qk_prep(Frame& F) {
    bf16_t* P = (bf16_t*)(F.ws + WS_PBUF); const f32x2* tab = (const f32x2*)(F.ws + WS_TABG);
    const int gw = F.bid * 8 + F.wave, NGW = F.G * 8, lane = F.lane, half = lane >> 5, i = lane & 31, d1 = 64 * half + i, d2 = d1 + 32;
    const float gq1 = INP(I_GQG)[d1], gq2 = INP(I_GQG)[d2], gk1 = INP(I_GKG)[d1], gk2 = INP(I_GKG)[d2];
    for (int r = gw; r < NTOK; r += NGW) {
        const int b = r / TPB, pos = r - b * TPB; const bool lat = pos >= CTXL; const int t = pos - CTXL, pp = half ? (t & 63) : (t >> 6);
        f32x2 cs = (f32x2){1.f, 0.f}; if (lat) cs = tab[pp * 32 + i];
        bf16_t* base = P + (size_t)r * 2048 + 1024;
        float x1[6], x2[6];
#pragma unroll
        for (int s = 0; s < 6; ++s) { x1[s] = bf2f(base[s * 128 + d1]); x2[s] = bf2f(base[s * 128 + d2]); }
#pragma unroll
        for (int s = 0; s < 6; ++s) {
            const float rstd = rsqrtf(wave_sum(x1[s] * x1[s] + x2[s] * x2[s]) * (1.f / 128.f) + EPS);
            const float y1 = x1[s] * rstd * (s < 4 ? gq1 : gk1), y2 = x2[s] * rstd * (s < 4 ? gq2 : gk2);
            base[s * 128 + d1] = f2bf(y1 * cs.x - y2 * cs.y); base[s * 128 + d2] = f2bf(y2 * cs.x + y1 * cs.y);
        }
    }
}
__device__ __forceinline__ void p_mla_prep(Frame& F) {
    bf16_t* P = (bf16_t*)(F.ws + WS_PBUF); bf16_t* KR = (bf16_t*)(F.ws + WS_KRB); const f32x2* tab = (const f32x2*)(F.ws + WS_TABM);
    const int gw = F.bid * 8 + F.wave, NGW = F.G * 8, lane = F.lane;
    float qg[8], kg[4];
#pragma unroll
    for (int j = 0; j < 8; ++j) qg[j] = INP(I_MLAQG)[8 * lane + j];
#pragma unroll
    for (int j = 0; j < 4; ++j) kg[j] = INP(I_MLAKVG)[4 * lane + j];
    for (int r = gw; r < NTOK; r += NGW) {
        const int b = r / TPB, pos = r - b * TPB; const bool lat = pos >= CTXL; const int t = pos - CTXL;
        bf16_t* base = P + (size_t)r * 1024;
        if (lat) {
            u32x4 w = *(const u32x4*)(base + 8 * lane); float x[8];
#pragma unroll
            for (int q = 0; q < 4; ++q) { x[2 * q] = bflo(w[q]); x[2 * q + 1] = bfhi(w[q]); }
            float ss = 0.f;
#pragma unroll
            for (int j = 0; j < 8; ++j) ss += x[j] * x[j];
            const float rstd = rsqrtf(wave_sum(ss) * (1.f / 512.f) + EPS);
#pragma unroll
            for (int q = 0; q < 4; ++q) w[q] = cvtpk(x[2 * q] * rstd * qg[2 * q], x[2 * q + 1] * rstd * qg[2 * q + 1]);
            *(u32x4*)(base + 8 * lane) = w;
        }
        {
            u32x2 w = *(const u32x2*)(base + 512 + 4 * lane); float x[4] = {bflo(w.x), bfhi(w.x), bflo(w.y), bfhi(w.y)};
            const float ss = (x[0] * x[0] + x[1] * x[1]) + (x[2] * x[2] + x[3] * x[3]);
            const float rstd = rsqrtf(wave_sum(ss) * (1.f / 256.f) + EPS);
            w.x = cvtpk(x[0] * rstd * kg[0], x[1] * rstd * kg[1]); w.y = cvtpk(x[2] * rstd * kg[2], x[3] * rstd * kg[3]);
            *(u32x2*)(base + 512 + 4 * lane) = w;
        }
        if (lane < 32) {
            const int half = lane >> 4, i = lane & 15, d1 = 32 * half + i, d2 = d1 + 16;
            const float x1 = bf2f(base[768 + d1]), x2 = bf2f(base[768 + d2]);
            f32x2 cs = (f32x2){1.f, 0.f}; if (lat) cs = tab[(half ? (t & 63) : (t >> 6)) * 16 + i];
            KR[(size_t)r * 64 + d1] = f2bf(x1 * cs.x - x2 * cs.y); KR[(size_t)r * 64 + d2] = f2bf(x2 * cs.x + x1 * cs.y);
        }
    }
}
__device__ __forceinline__ void p_sgu(Frame& F) {
    const bf16_t* P = (const bf16_t*)(F.ws + WS_PBUF); bf16_t* MIX = (bf16_t*)(F.ws + WS_MIX0); const bf16_t* SW = (const bf16_t*)(F.ws + WS_SGUW);
    const int tid = F.tid, lane = F.lane, wid = F.wave, hw = wid >> 2, w4 = wid & 3, th = tid & 255, r32 = lane & 31, hi = lane >> 5;
    LAS char* Vl = (LAS char*)F.lds + hw * 32768;
    const int sr = th >> 4, sc = (th & 15) * 8;
    const int vb0 = (int)(unsigned)(uintptr_t)Vl + att::v_rd_base(lane);
    const float* psg = INP(I_SGUNG); const float* psb = INP(I_SGUB);
    for (int U = F.bid; U < (NTOK / 128) * 2; U += F.G) {
        const int chunk = U >> 1, g = (U & 1) * 2 + hw; const size_t row0 = (size_t)chunk * 128;
        float gn[8];
#pragma unroll
        for (int j = 0; j < 8; ++j) gn[j] = psg[g * 128 + sc + j];
        __syncthreads();
#pragma unroll
        for (int i = 0; i < 8; ++i) {
            const int q = sr + 16 * i;
            u32x4 w = *(const u32x4*)(P + (row0 + q) * 2048 + 512 + g * 128 + sc); float x[8];
#pragma unroll
            for (int k = 0; k < 4; ++k) { x[2 * k] = bflo(w[k]); x[2 * k + 1] = bfhi(w[k]); }
            float ss = 0.f;
#pragma unroll
            for (int j = 0; j < 8; ++j) ss += x[j] * x[j];
            ss += __shfl_xor(ss, 1); ss += __shfl_xor(ss, 2); ss += __shfl_xor(ss, 4); ss += __shfl_xor(ss, 8);
            const float rstd = rsqrtf(ss * (1.f / 128.f) + EPS);
#pragma unroll
            for (int k = 0; k < 4; ++k) w[k] = cvtpk(x[2 * k] * rstd * gn[2 * k], x[2 * k + 1] * rstd * gn[2 * k + 1]);
            *(LAS u32x4*)(Vl + (q >> 6) * 16384 + att::v_st(q & 63, sc)) = w;
        }
        bf16x8 pa[8];
        const bf16_t* wrow = SW + ((size_t)g * 128 + 32 * w4 + r32) * 128 + 8 * hi;
#pragma unroll
        for (int k = 0; k < 8; ++k) pa[k] = *(const bf16x8*)(wrow + 16 * k);
        __syncthreads();
        f32x16 o[4] = {};
        att::pv_d0(o, vb0, pa[0], pa[1], pa[2], pa[3]);
        att::pv_d0(o, vb0 + 16384, pa[4], pa[5], pa[6], pa[7]);
#pragma unroll
        for (int r = 0; r < 16; ++r) { const int p = 32 * w4 + att::crow(r, hi); const float bs = psb[g * 128 + p];
#pragma unroll
            for (int d0 = 0; d0 < 4; ++d0) { const int c = d0 * 32 + r32; const float zu = bf2f(P[(row0 + p) * 2048 + g * 128 + c]);
                MIX[(row0 + p) * 1024 + g * 128 + c] = f2bf((o[d0][r] + bs) * zu); } }
    }
    __syncthreads();
}

using pg8::Unit; using pg8::Acc;
struct ProbIn0 {
    static constexpr bool PERM = true, GATHER = false, FP8 = false; int K, lda; const bf16_t* A; const bf16_t* Bt; bf16_t* O; pg8::StaticOrder so; int G, c;
    __device__ bool next(int i, Unit& u) const { return so.map((long)i * G + c, u.pm, u.pn); }
    __device__ const void* a_mat() const { return A; } __device__ const void* b_mat() const { return Bt; }
    __device__ unsigned a_off(const Unit& u) const { return (unsigned)u.pm * 256u * (unsigned)lda * 2u; }
    __device__ unsigned b_off(const Unit& u) const { return (unsigned)u.pn * 256u * (unsigned)K * 2u; }
    __device__ void a_voff(const Unit&, unsigned (&)[2][2]) const {}
    __device__ void epi(const Acc& acc, const Unit& u, int wr, int wc, int fr, int fq) const {
        bf16_t* dst = O + (size_t)u.pm * 256 * 2048 + u.pn * 256;
        if (u.pn < 4) pg8::epi_store_bf16<true>(acc, dst, 2048, nullptr, wr, wc, fr, fq); else pg8::epi_store_bf16<false>(acc, dst, 2048, nullptr, wr, wc, fr, fq);
    }
};
template <bool LATONLY> struct ProbPlain {
    static constexpr bool PERM = true, GATHER = false, FP8 = false; int K, lda; const bf16_t* A; const bf16_t* Bt; bf16_t* O; int ldc; pg8::StaticOrder so; int G, c;
    __device__ bool next(int i, Unit& u) const { int pm; if (!so.map((long)i * G + c, pm, u.pn)) return false; u.pm = LATONLY ? pm + pm / 8 + 1 : pm; return true; }
    __device__ const void* a_mat() const { return A; } __device__ const void* b_mat() const { return Bt; }
    __device__ unsigned a_off(const Unit& u) const { return (unsigned)u.pm * 256u * (unsigned)lda * 2u; }
    __device__ unsigned b_off(const Unit& u) const { return (unsigned)u.pn * 256u * (unsigned)K * 2u; }
    __device__ void a_voff(const Unit&, unsigned (&)[2][2]) const {}
    __device__ void epi(const Acc& acc, const Unit& u, int wr, int wc, int fr, int fq) const {
        pg8::epi_store_bf16<false>(acc, O + (size_t)u.pm * 256 * ldc + u.pn * 256, ldc, nullptr, wr, wc, fr, fq);
    }
};
struct ProbIn1 {
    static constexpr bool PERM = true, GATHER = false, FP8 = false; int K, lda; const bf16_t* A; const bf16_t* Bt; bf16_t* O; pg8::StaticOrder so; int G, c;
    __device__ bool next(int i, Unit& u) const {
        const long L = (long)i * G + c;
        if (L < 1024) { int pm; so.map(L, pm, u.pn); u.pm = pm + pm / 8 + 1; return true; }
        if (L < 1024 + 64) { const int q = (int)(L - 1024); u.pm = (q >> 1) * 9; u.pn = 2 + (q & 1); return true; }
        return false;
    }
    __device__ const void* a_mat() const { return A; } __device__ const void* b_mat() const { return Bt; }
    __device__ unsigned a_off(const Unit& u) const { return (unsigned)u.pm * 256u * (unsigned)lda * 2u; }
    __device__ unsigned b_off(const Unit& u) const { return (unsigned)u.pn * 256u * (unsigned)K * 2u; }
    __device__ void a_voff(const Unit&, unsigned (&)[2][2]) const {}
    __device__ void epi(const Acc& acc, const Unit& u, int wr, int wc, int fr, int fq) const {
        pg8::epi_store_bf16<false>(acc, O + (size_t)u.pm * 256 * 1024 + u.pn * 256, 1024, nullptr, wr, wc, fr, fq);
    }
};
template <int LAYER> struct ProbOut {
    static constexpr bool PERM = false, GATHER = false, FP8 = false; int K, lda; const bf16_t* A; const bf16_t* Bt; float* XR; const float* MOD; const float* xin; const float* cin; pg8::StaticOrder so; int G, c;
    __device__ bool next(int i, Unit& u) const { int pm; if (!so.map((long)i * G + c, pm, u.pn)) return false; u.pm = LAYER ? pm + pm / 8 + 1 : pm; return true; }
    __device__ const void* a_mat() const { return A; } __device__ const void* b_mat() const { return Bt; }
    __device__ unsigned a_off(const Unit& u) const { return (unsigned)u.pm * 256u * (unsigned)lda * 2u; }
    __device__ unsigned b_off(const Unit& u) const { return (unsigned)u.pn * 256u * (unsigned)K * 2u; }
    __device__ void a_voff(const Unit&, unsigned (&)[2][2]) const {}
    __device__ void epi(const Acc& acc, const Unit& u, int wr, int wc, int fr, int fq) const {
        const int b = u.pm / 9, jj = u.pm % 9, mj = jj == 0 ? 32 : b;
        const float* base = LAYER ? XR + (size_t)u.pm * 256 * DM : (jj == 0 ? cin + (size_t)b * CTXL * DM : xin + ((size_t)b * SEQ + (jj - 1) * 256) * DM);
        float* dst = XR + (size_t)u.pm * 256 * DM; const float* gate = MOD + ((size_t)(LAYER * 33 + mj) * 6 + 2) * 1024;
        const int row0 = wr * 64 + fr, col0 = u.pn * 256 + wc * 32 + 4 * fq;
        f32x4 gv[2][2];
#pragma unroll
        for (int bj = 0; bj < 2; ++bj)
#pragma unroll
            for (int n = 0; n < 2; ++n) gv[bj][n] = *(const f32x4*)(gate + col0 + bj * 128 + n * 16);
#pragma unroll
        for (int ai = 0; ai < 2; ++ai)
#pragma unroll
            for (int m = 0; m < 4; ++m) { const size_t off = (size_t)(row0 + ai * 128 + m * 16) * DM + col0;
#pragma unroll
                for (int bj = 0; bj < 2; ++bj)
#pragma unroll
                    for (int n = 0; n < 2; ++n) { const f32x4 bs = *(const f32x4*)(base + off + bj * 128 + n * 16); *(f32x4*)(dst + off + bj * 128 + n * 16) = bs + gv[bj][n] * acc[ai][bj][m][n]; } }
    }
};
struct MoeSched {
    const LAS int* pb; int NTN, G, c;
    __device__ bool map(int i, Unit& u) const {
        const long L = (long)i * G + c; const int blk = (int)(L / NTN); u.pn = (int)(L % NTN);
        if (blk >= __builtin_amdgcn_readfirstlane(pb[32])) return false;
        int lo = 0;
#pragma unroll
        for (int st = 16; st >= 1; st >>= 1) { if (__builtin_amdgcn_readfirstlane(pb[lo + st]) <= blk) lo += st; }
        u.e = lo; u.rb = blk - __builtin_amdgcn_readfirstlane(pb[lo]); u.pm = blk; return true;
    }
};
struct ProbMoe1 {
    static constexpr bool PERM = true, GATHER = true, FP8 = MOE_FP8 != 0; int K, lda; const bf16_t* H; const bf16_t* W1; const float* B1; bf16_t* ACT; const int* rowl; const LAS int* cnt; MoeSched ms; int wave_s;
    __device__ bool next(int i, Unit& u) const { return ms.map(i, u); }
    __device__ const void* a_mat() const { return H; } __device__ const void* b_mat() const { return W1; }
    __device__ unsigned a_off(const Unit&) const { return 0u; }
    __device__ unsigned b_off(const Unit& u) const { return ((unsigned)u.e * 2048u + (unsigned)u.pn * 256u) * 1024u * (FP8 ? 1u : 2u); }
    __device__ void a_voff(const Unit& u, unsigned (&vo)[2][2]) const {
        const int n = cnt[u.e]; const int* rl = rowl + (size_t)u.e * ROWCAP + u.rb * 256;
        const int tidg = tid_fresh(wave_s);
#pragma unroll
        for (int i = 0; i < 2; ++i) { int R, C; pg8::stage_rc(tidg * 16 + i * 8192, R, C);
#pragma unroll
            for (int h = 0; h < 2; ++h) { const int ri = h * 128 + R; const int tok = (u.rb * 256 + ri < n) ? rl[ri] : 0; vo[h][i] = (unsigned)tok * (FP8 ? 1024u : 2048u) + (unsigned)C * 2u; } }
    }
    __device__ void epi(const Acc& acc, const Unit& u, int wr, int wc, int fr, int fq) const {
        const int row0 = wr * 64 + fr, col0 = u.pn * 128 + wc * 32 + 8 * fq;
        const float* bg = B1 + (size_t)u.e * 2048 + col0; const float* bl = bg + 1024;
        f32x4 bgv[2], blv[2];
#pragma unroll
        for (int n = 0; n < 2; ++n) { bgv[n] = *(const f32x4*)(bg + 4 * n); blv[n] = *(const f32x4*)(bl + 4 * n); }
        constexpr float SC = FP8 ? (1.f / 256.f) : 1.f;
        bf16_t* dst = ACT + (size_t)u.pm * 256 * 1024 + col0; unsigned char* dst8 = (unsigned char*)ACT + (size_t)u.pm * 256 * 1024 + col0;
#pragma unroll
        for (int ai = 0; ai < 2; ++ai)
#pragma unroll
            for (int m = 0; m < 4; ++m) { float a[8];
#pragma unroll
                for (int n = 0; n < 2; ++n) { const f32x4 g = acc[ai][0][m][n] * SC + bgv[n], l = acc[ai][1][m][n] * SC + blv[n];
#pragma unroll
                    for (int j = 0; j < 4; ++j) { const float gg = fminf(g[j], 7.f), ll = fminf(fmaxf(l[j], -7.f), 7.f);
                        a[4 * n + j] = gg * __builtin_amdgcn_rcpf(1.f + __builtin_amdgcn_exp2f(-1.702f * 1.4426950408889634f * gg)) * (ll + 1.f); } }
                if constexpr (FP8) { u32x2 w; w.x = pk4_fp8(a[0] * 8.f, a[1] * 8.f, a[2] * 8.f, a[3] * 8.f); w.y = pk4_fp8(a[4] * 8.f, a[5] * 8.f, a[6] * 8.f, a[7] * 8.f);
                    *(u32x2*)(dst8 + (size_t)(row0 + ai * 128 + m * 16) * 1024) = w; }
                else { u32x4 w; w.x = cvtpk(a[0], a[1]); w.y = cvtpk(a[2], a[3]); w.z = cvtpk(a[4], a[5]); w.w = cvtpk(a[6], a[7]);
                    *(u32x4*)(dst + (size_t)(row0 + ai * 128 + m * 16) * 1024) = w; } }
    }
};
struct ProbMoe2 {
    static constexpr bool PERM = true, GATHER = false, FP8 = MOE_FP8 != 0; int K, lda; const bf16_t* ACT; const bf16_t* W2; const float* B2; bf16_t* Y; MoeSched ms;
    __device__ bool next(int i, Unit& u) const { return ms.map(i, u); }
    __device__ const void* a_mat() const { return ACT; } __device__ const void* b_mat() const { return W2; }
    __device__ unsigned a_off(const Unit& u) const { return (unsigned)u.pm * 256u * 1024u * (FP8 ? 1u : 2u); }
    __device__ unsigned b_off(const Unit& u) const { return ((unsigned)u.e * 1024u + (unsigned)u.pn * 256u) * 1024u * (FP8 ? 1u : 2u); }
    __device__ void a_voff(const Unit&, unsigned (&)[2][2]) const {}
    __device__ void epi(const Acc& acc, const Unit& u, int wr, int wc, int fr, int fq) const {
        pg8::epi_store_bf16<false>(acc, Y + (size_t)u.pm * 256 * 1024 + u.pn * 256, 1024, B2 + (size_t)u.e * 1024 + u.pn * 256, wr, wc, fr, fq, FP8 ? (1.f / 512.f) : 1.f);
    }
};

__global__ void __launch_bounds__(512, 2) fwd_kernel(Args args) {
    extern __shared__ __attribute__((aligned(16))) uchar lds_raw[];
    const int wave_s = __builtin_amdgcn_readfirstlane((int)threadIdx.x >> 6);
    Frame F; F.lds = (LAS uchar*)lds_raw; F.tid = tid_fresh(wave_s); F.lane = F.tid & 63; F.wave = wave_s; F.G = gridDim.x; F.bid = blockIdx.x;
    F.ws = args.ws; F.out = args.out;
    volatile LAS unsigned* MISC = (volatile LAS unsigned*)(F.lds + MISC_OFF);
    if (F.tid < 64) MISC[F.tid] = 0u;
    __syncthreads();
    unsigned* ctl = (unsigned*)(F.ws + WS_CTL);
    XcdBarrier bar; bar.bar = ctl + CW_BAR; bar.x = 0; bar.st = nullptr;
    const int lo = args.ph_lo, hi = args.ph_hi;
    if (hi - lo > 1) bar = xcd_barrier_post(ctl + CW_BAR, MISC + 8, F.tid == 0);
#ifndef PHMASK
#define PHMASK 0x7ffff
#endif
#define REFRAME() do { F.tid = tid_fresh(wave_s); F.lane = F.tid & 63; F.wave = wave_s; } while (0)
#define IN(k) (((PHMASK >> (k)) & 1) && lo <= (k) && (k) < hi)
#define SEAM(k) do { if (IN(k) && IN((k) + 1)) { const int t_ = tid_fresh(wave_s); xcd_barrier(bar, t_ == 0); } } while (0)
    uchar* ws = F.ws;
    bf16_t* H = (bf16_t*)(ws + WS_H); float* XR = (float*)(ws + WS_XR); const float* MOD = (const float*)(ws + WS_MOD);

    if (IN(0)) { REFRAME(); p0_prologue(F); } SEAM(0);
    if (IN(1)) { REFRAME(); p_norm0(F); } SEAM(1);
    if (IN(2)) { REFRAME(); ProbIn0 p; p.K = 1024; p.lda = 1024; p.A = H; p.Bt = (const bf16_t*)(ws + WS_WIN0); p.O = (bf16_t*)(ws + WS_PBUF); p.so.init(NPAN, 8); p.G = F.G; p.c = F.bid; pg8::gemm_phase(F.lds, p, wave_s); } SEAM(2);
    if (IN(3)) { REFRAME(); p_qk_prep(F); } SEAM(3);
    if (IN(4)) { REFRAME();
        const bf16_t* P = (const bf16_t*)(ws + WS_PBUF); bf16_t* MIX = (bf16_t*)(ws + WS_MIX0);
        for (int u = F.bid; u < 1024 + 128; u += F.G) {
            if (u < 1024) { const int qb = u & 7, g = (u >> 3) & 1, kvh = (u >> 4) & 1, b = u >> 5, h = kvh * 2 + g; const size_t kr0 = (size_t)b * TPB, qr0 = kr0 + CTXL + qb * 256;
                att::attn_unit<128, 2, false, 2048, 2048, 1024>(P + qr0 * 2048 + 1024 + h * 128, P + kr0 * 2048 + 1536 + kvh * 128, nullptr, P + kr0 * 2048 + 1792 + kvh * 128, MIX + qr0 * 1024 + 512 + h * 128, TPB, (LAS char*)F.lds, nullptr, 0, wave_s);
            } else { const int v = u - 1024, h = v & 3, b = v >> 2, kvh = h >> 1; const size_t kr0 = (size_t)b * TPB;
                att::attn_unit<128, 2, false, 2048, 2048, 1024>(P + kr0 * 2048 + 1024 + h * 128, P + kr0 * 2048 + 1536 + kvh * 128, nullptr, P + kr0 * 2048 + 1792 + kvh * 128, MIX + kr0 * 1024 + 512 + h * 128, CTXL, (LAS char*)F.lds, nullptr, 0, wave_s); }
        }
        REFRAME(); p_sgu(F);
    } SEAM(4);
    if (IN(5)) { REFRAME(); ProbOut<0> p; p.K = 1024; p.lda = 1024; p.A = (const bf16_t*)(ws + WS_MIX0); p.Bt = (const bf16_t*)(ws + WS_WOUT0); p.XR = XR; p.MOD = MOD; p.xin = INP(I_X); p.cin = INP(I_CTX); p.so.init(NPAN, 4); p.G = F.G; p.c = F.bid; pg8::gemm_phase(F.lds, p, wave_s); } SEAM(5);
    if (IN(6)) { REFRAME(); p_norm_router<0>(F); } SEAM(6);
    if (IN(7)) { REFRAME(); moe_prefix(F, 0); ProbMoe1 p; p.K = MOE_FP8 ? 512 : 1024; p.lda = p.K; p.H = H; p.W1 = (const bf16_t*)(ws + WS_W1); p.B1 = INP(I_B1); p.ACT = (bf16_t*)(ws + WS_ACT); p.rowl = (const int*)(ws + WS_ROWL);
        p.cnt = (const LAS int*)(F.lds + XTRA_OFF + X_CNT); p.wave_s = wave_s; p.ms.pb = (const LAS int*)(F.lds + XTRA_OFF + X_PB); p.ms.NTN = 8; p.ms.G = F.G; p.ms.c = F.bid; pg8::gemm_phase(F.lds, p, wave_s); } SEAM(7);
    if (IN(8)) { REFRAME(); moe_prefix(F, 0); ProbMoe2 p; p.K = MOE_FP8 ? 512 : 1024; p.lda = p.K; p.ACT = (const bf16_t*)(ws + WS_ACT); p.W2 = (const bf16_t*)(ws + WS_W2); p.B2 = INP(I_B2); p.Y = (bf16_t*)(ws + WS_Y);
        p.ms.pb = (const LAS int*)(F.lds + XTRA_OFF + X_PB); p.ms.NTN = 4; p.ms.G = F.G; p.ms.c = F.bid; pg8::gemm_phase(F.lds, p, wave_s); } SEAM(8);
    if (IN(9)) { REFRAME(); p_combine_norm(F); } SEAM(9);
    if (IN(10)) { REFRAME(); ProbIn1 p; p.K = 1024; p.lda = 1024; p.A = H; p.Bt = (const bf16_t*)(ws + WS_WIN1); p.O = (bf16_t*)(ws + WS_PBUF); p.so.init(256, 4); p.G = F.G; p.c = F.bid; pg8::gemm_phase(F.lds, p, wave_s); } SEAM(10);
    if (IN(11)) { REFRAME(); p_mla_prep(F); } SEAM(11);
    if (IN(12)) { REFRAME();
        { ProbPlain<true> p; p.K = 512; p.lda = 1024; p.A = (const bf16_t*)(ws + WS_PBUF); p.Bt = (const bf16_t*)(ws + WS_WUQ); p.O = (bf16_t*)(ws + WS_QB); p.ldc = 1536; p.so.init(256, 6); p.G = F.G; p.c = F.bid; pg8::gemm_phase(F.lds, p, wave_s); }
        { ProbPlain<false> p; p.K = 256; p.lda = 1024; p.A = (const bf16_t*)(ws + WS_PBUF) + 512; p.Bt = (const bf16_t*)(ws + WS_WUKV); p.O = (bf16_t*)(ws + WS_KVB); p.ldc = 2048; p.so.init(NPAN, 8); p.G = F.G; p.c = F.bid; pg8::gemm_phase(F.lds, p, wave_s); }
    } SEAM(12);
    if (IN(13)) { REFRAME();
        const bf16_t* Q = (const bf16_t*)(ws + WS_QB); const bf16_t* KV = (const bf16_t*)(ws + WS_KVB); const bf16_t* KR = (const bf16_t*)(ws + WS_KRB); bf16_t* MIX = (bf16_t*)(ws + WS_MIX1);
        for (int u = F.bid; u < 2048; u += F.G) { const int qb = u & 7, h = (u >> 3) & 7, b = u >> 6; const size_t kr0 = (size_t)b * TPB, qr0 = kr0 + CTXL + qb * 256;
            att::attn_unit<192, 1, true, 1536, 2048, 1024>(Q + qr0 * 1536 + h * 192, KV + kr0 * 2048 + h * 128, KR + kr0 * 64, KV + kr0 * 2048 + 1024 + h * 128, MIX + qr0 * 1024 + h * 128, TPB, (LAS char*)F.lds, (const f32x2*)(ws + WS_TABM), qb * 256, wave_s); }
    } SEAM(13);
    if (IN(14)) { REFRAME(); ProbOut<1> p; p.K = 1024; p.lda = 1024; p.A = (const bf16_t*)(ws + WS_MIX1); p.Bt = (const bf16_t*)(ws + WS_WOUT1); p.XR = XR; p.MOD = MOD; p.xin = nullptr; p.cin = nullptr; p.so.init(256, 4); p.G = F.G; p.c = F.bid; pg8::gemm_phase(F.lds, p, wave_s); } SEAM(14);
    if (IN(15)) { REFRAME(); p_norm_router<1>(F); } SEAM(15);
    if (IN(16)) { REFRAME(); moe_prefix(F, 1); ProbMoe1 p; p.K = MOE_FP8 ? 512 : 1024; p.lda = p.K; p.H = H; p.W1 = (const bf16_t*)(ws + WS_W1 + (size_t)32 * 2048 * 1024 * (MOE_FP8 ? 1 : 2)); p.B1 = INP(I_B1) + 32 * 2048; p.ACT = (bf16_t*)(ws + WS_ACT); p.rowl = (const int*)(ws + WS_ROWL);
        p.cnt = (const LAS int*)(F.lds + XTRA_OFF + X_CNT); p.wave_s = wave_s; p.ms.pb = (const LAS int*)(F.lds + XTRA_OFF + X_PB); p.ms.NTN = 8; p.ms.G = F.G; p.ms.c = F.bid; pg8::gemm_phase(F.lds, p, wave_s); } SEAM(16);
    if (IN(17)) { REFRAME(); moe_prefix(F, 1); ProbMoe2 p; p.K = MOE_FP8 ? 512 : 1024; p.lda = p.K; p.ACT = (const bf16_t*)(ws + WS_ACT); p.W2 = (const bf16_t*)(ws + WS_W2 + (size_t)32 * 1024 * 1024 * (MOE_FP8 ? 1 : 2)); p.B2 = INP(I_B2) + 32 * 1024; p.Y = (bf16_t*)(ws + WS_Y);
        p.ms.pb = (const LAS int*)(F.lds + XTRA_OFF + X_PB); p.ms.NTN = 4; p.ms.G = F.G; p.ms.c = F.bid; pg8::gemm_phase(F.lds, p, wave_s); } SEAM(17);
    if (IN(18)) { REFRAME(); p_final(F); }
#undef IN
#undef SEAM
}

extern "C" void kernel_launch(void* const* d_in, const int* in_sizes, int n_in, void* d_out, int out_size, void* d_ws, size_t ws_size, hipStream_t stream) {
    static int grid = 0;
    if (grid == 0) {
        if (n_in != 28 || out_size != NBATCH * SEQ * DM || ws_size < WS_END) { fprintf(stderr, "kernel_launch: unexpected shapes (n_in %d out %d ws %zu, need ws >= %zu)\n", n_in, out_size, ws_size, (size_t)WS_END); grid = -1; return; }
        int dev = 0, cus = 0, per_cu = 0;
        if (hipGetDevice(&dev) != hipSuccess || hipDeviceGetAttribute(&cus, hipDeviceAttributeMultiprocessorCount, dev) != hipSuccess) { grid = -1; return; }
        if (hipFuncSetAttribute((const void*)fwd_kernel, hipFuncAttributeMaxDynamicSharedMemorySize, LDS_BYTES) != hipSuccess) { fprintf(stderr, "kernel_launch: hipFuncSetAttribute failed\n"); grid = -1; return; }
        if (hipOccupancyMaxActiveBlocksPerMultiprocessor(&per_cu, (const void*)fwd_kernel, 512, LDS_BYTES) != hipSuccess || per_cu < 1) { fprintf(stderr, "kernel_launch: occupancy query says %d blocks/CU\n", per_cu); }
        (void)hipGetLastError();
        grid = cus;
    }
    if (grid < 0) return;
    (void)hipMemsetAsync((char*)d_ws + WS_CTL, 0, CTL_BYTES, stream);
    Args a{};
    for (int i = 0; i < 28; ++i) a.in[i] = (const float*)d_in[i];
    a.out = (float*)d_out; a.ws = (uchar*)d_ws;
#if MK_ONE_LAUNCH
    a.ph_lo = 0; a.ph_hi = NPHASE;
    hipLaunchKernelGGL(fwd_kernel, dim3(grid), dim3(512), LDS_BYTES, stream, a);
#else
    for (int ph = 0; ph < NPHASE; ++ph) { a.ph_lo = ph; a.ph_hi = ph + 1; for (int rep = 0; rep < 1 + ((REPEAT_MASK >> ph) & 1); ++rep) hipLaunchKernelGGL(fwd_kernel, dim3(grid), dim3(512), LDS_BYTES, stream, a); }
#endif
}
```

```cpp
#include <hip/hip_runtime.h>
#include <cstdio>
#include <cstdint>

#ifndef MK_ONE_LAUNCH
#define MK_ONE_LAUNCH 1
#endif
#define REPEAT_MASK 0
#define USE_BUFFER_LDS 1
#ifndef MOE_FP8
#define MOE_FP8 1
#endif

#define LAS __attribute__((address_space(3)))
typedef unsigned short bf16_t;
typedef unsigned char uchar;
typedef short bf16x8 __attribute__((ext_vector_type(8)));
typedef short s16x4 __attribute__((ext_vector_type(4)));
typedef float f32x2 __attribute__((ext_vector_type(2)));
typedef float f32x4 __attribute__((ext_vector_type(4)));
typedef float f32x16 __attribute__((ext_vector_type(16)));
typedef unsigned u32x2 __attribute__((ext_vector_type(2)));
typedef unsigned u32x4 __attribute__((ext_vector_type(4)));
typedef int i32x4 __attribute__((ext_vector_type(4)));
typedef int i32x8 __attribute__((ext_vector_type(8)));

constexpr int DM = 1024, NBATCH = 32, SEQ = 2048, CTXL = 256, TPB = SEQ + CTXL, NTOK = NBATCH * TPB, NPAN = NTOK / 256;
constexpr int NEXP = 32, TOPK = 4, ROWCAP = NTOK;
constexpr float EPS = 1e-6f;
constexpr int NPHASE = 19;

constexpr size_t MiB = 1u << 20;
constexpr size_t WS_CTL = 0, CTL_BYTES = 1 * MiB;
constexpr size_t WS_MOD = 1 * MiB;
constexpr size_t WS_TABG = 3 * MiB;
constexpr size_t WS_TABM = WS_TABG + 32768;
constexpr size_t WS_WRT = WS_TABG + 65536;
constexpr size_t WS_SGUW = WS_WRT + 262144;
constexpr size_t WS_WIN0 = 4 * MiB, WS_WOUT0 = 8 * MiB, WS_WIN1 = 10 * MiB, WS_WUQ = 12 * MiB, WS_WUKV = 14 * MiB, WS_WOUT1 = 15 * MiB;
constexpr size_t WS_W1 = 17 * MiB;
constexpr size_t WS_W2 = 273 * MiB;
constexpr size_t WS_ROWL = 401 * MiB;
constexpr size_t WS_TOKI = 410 * MiB;
constexpr size_t WS_XR = 413 * MiB;
constexpr size_t WS_H = 701 * MiB;
constexpr size_t WS_SCR = 845 * MiB;
constexpr size_t WS_PBUF = WS_SCR;
constexpr size_t WS_MIX0 = WS_SCR + 288 * MiB;
constexpr size_t WS_QB = WS_SCR + 144 * MiB;
constexpr size_t WS_KVB = WS_SCR + 360 * MiB;
constexpr size_t WS_KRB = WS_SCR + 648 * MiB;
constexpr size_t WS_MIX1 = WS_SCR + 660 * MiB;
constexpr size_t WS_ACT = WS_SCR;
constexpr size_t WS_Y = WS_SCR + 592 * MiB;
constexpr size_t WS_END = WS_SCR + 1184 * MiB;
constexpr int CW_BAR = 1024;
constexpr int CW_CNT = 8192;
constexpr int CW_DBG = 16384;

constexpr int RING_BYTES = 131072;
constexpr int XTRA_OFF = RING_BYTES, XTRA_BYTES = 20480;
constexpr int MISC_OFF = XTRA_OFF + XTRA_BYTES;
constexpr int LDS_BYTES = MISC_OFF + 512;
constexpr int X_PB = 0;
constexpr int X_CNT = 256;
constexpr int X_HIST = 512;
constexpr int X_BASE = 768;
constexpr int X_SEL = 1024;
constexpr int X_A2 = 9216;
constexpr int X_CB = 13312;
constexpr int X_RS = 13440;

#define LDS_WAIT() asm volatile("s_waitcnt lgkmcnt(0)" ::: "memory")
#define VM_WAIT() asm volatile("s_waitcnt vmcnt(0)" ::: "memory")
#define SBAR() __builtin_amdgcn_sched_barrier(0)
__device__ __forceinline__ unsigned cvtpk(float lo, float hi) { unsigned r; asm volatile("v_cvt_pk_bf16_f32 %0, %1, %2" : "=v"(r) : "v"(lo), "v"(hi)); return r; }
__device__ __forceinline__ float bf2f(unsigned short b) { return __uint_as_float(((unsigned)b) << 16); }
__device__ __forceinline__ float bflo(unsigned w) { return __uint_as_float(w << 16); }
__device__ __forceinline__ float bfhi(unsigned w) { return __uint_as_float(w & 0xffff0000u); }
__device__ __forceinline__ unsigned short f2bf(float f) { return (unsigned short)(cvtpk(f, 0.f) & 0xffffu); }
__device__ __forceinline__ unsigned pk4_fp8(float a, float b, float c, float d) {
    a = fminf(fmaxf(a, -448.f), 448.f); b = fminf(fmaxf(b, -448.f), 448.f); c = fminf(fmaxf(c, -448.f), 448.f); d = fminf(fmaxf(d, -448.f), 448.f);
    unsigned w = 0; w = __builtin_amdgcn_cvt_pk_fp8_f32(a, b, w, false); w = __builtin_amdgcn_cvt_pk_fp8_f32(c, d, w, true); return w;
}
__device__ __forceinline__ int tid_fresh(int wave_s) { int l; asm volatile("v_mbcnt_lo_u32_b32 %0, -1, 0\n\tv_mbcnt_hi_u32_b32 %0, -1, %0" : "=v"(l)); return wave_s * 64 + l; }
template <int CTRL, int BANK> __device__ __forceinline__ int dpp_i(int old, int x) { return __builtin_amdgcn_update_dpp(old, x, CTRL, 0xF, BANK, false); }
__device__ __forceinline__ int xs1(int x) { return dpp_i<0xB1, 0xF>(x, x); }
__device__ __forceinline__ int xs2(int x) { return dpp_i<0x4E, 0xF>(x, x); }
__device__ __forceinline__ int xs4(int x) { const int t = dpp_i<0x114, 0xA>(x, x); return dpp_i<0x104, 0x5>(t, x); }
__device__ __forceinline__ int xs8(int x) { return dpp_i<0x128, 0xF>(x, x); }
__device__ __forceinline__ float xf1(float x) { return __int_as_float(xs1(__float_as_int(x))); }
__device__ __forceinline__ float xf2(float x) { return __int_as_float(xs2(__float_as_int(x))); }
__device__ __forceinline__ float xf4(float x) { return __int_as_float(xs4(__float_as_int(x))); }
__device__ __forceinline__ float xf8(float x) { return __int_as_float(xs8(__float_as_int(x))); }
__device__ __forceinline__ float sum16(float a, float b) { auto r = __builtin_amdgcn_permlane16_swap(__float_as_uint(a), __float_as_uint(b), false, false); return __uint_as_float(r[0]) + __uint_as_float(r[1]); }
__device__ __forceinline__ float sum32(float a, float b) { auto r = __builtin_amdgcn_permlane32_swap(__float_as_uint(a), __float_as_uint(b), false, false); return __uint_as_float(r[0]) + __uint_as_float(r[1]); }
__device__ __forceinline__ unsigned xu16(unsigned x, int lane) { auto r = __builtin_amdgcn_permlane16_swap(x, x, false, false); return (lane & 16) ? r[0] : r[1]; }
__device__ __forceinline__ unsigned xu32(unsigned x, int lane) { auto r = __builtin_amdgcn_permlane32_swap(x, x, false, false); return (lane & 32) ? r[0] : r[1]; }
__device__ __forceinline__ float wave_sum(float v) {
    v += xf1(v); v += xf2(v); v += xf4(v); v += xf8(v); v = sum16(v, v); v = sum32(v, v);
    return v;
}
__device__ __forceinline__ float silu_f(float x) { return x / (1.f + __expf(-x)); }
__device__ __forceinline__ float gelu_tanh_f(float x) {
    const float u = x * (1.5957691216057308f + 0.07135481627260025f * x * x);
    const float e = __builtin_amdgcn_exp2f(-1.4426950408889634f * u);
    return x * __builtin_amdgcn_rcpf(1.f + e);
}

#define XB_TMO      128
#define XB_XCNT(j)  (256  + 64 * (j))
#define XB_XSUB(j)  (1280 + 64 * (j))
#define XB_XGEN(j)  (2304 + 64 * (j))
#define XB_TOP      3328
#define XB_TOPGEN   3392
#define XCD_BAR_WORDS 3456
#define XB_SPIN_CAP (1u << 20)
__device__ __forceinline__ unsigned xb_ld(unsigned* p)              { return __hip_atomic_load(p, __ATOMIC_RELAXED, __HIP_MEMORY_SCOPE_AGENT); }
__device__ __forceinline__ unsigned xb_add(unsigned* p, unsigned v) { return __hip_atomic_fetch_add(p, v, __ATOMIC_RELAXED, __HIP_MEMORY_SCOPE_AGENT); }
__device__ __forceinline__ unsigned xb_xcc_id() { return (unsigned)__builtin_amdgcn_s_getreg((3 << 11) | 20) & 0xFu; }
#define XB_SPIN(cond, bar) do { unsigned _sp = 0; while (cond) { __builtin_amdgcn_s_sleep(1); \
    if ((++_sp & 255u) == 0u) { if (xb_ld(&(bar)[XB_TMO])) break; if (_sp > XB_SPIN_CAP) { atomicAdd(&(bar)[XB_TMO], 1u); break; } } } } while (0)
struct XcdBarrier { unsigned* bar; unsigned x; volatile LAS unsigned* st; };
__device__ __forceinline__ XcdBarrier xcd_barrier_post(unsigned* bar, volatile LAS unsigned* st, bool t0) {
    XcdBarrier b; b.bar = bar; b.x = xb_xcc_id(); b.st = st;
    if (t0) (void)xb_add(&bar[XB_XCNT(b.x)], 1u);
    return b;
}
__device__ __forceinline__ void xcd_barrier_complete(unsigned* bar, unsigned x, unsigned& nloc, unsigned& nx) {
    const unsigned G = gridDim.x * gridDim.y * gridDim.z;
    unsigned sum, cnt, mine, sp = 0u;
    for (;;) {
        sum = 0u; cnt = 0u; mine = 0u;
#pragma unroll
        for (unsigned j = 0; j < 16; ++j) { const unsigned c = xb_ld(&bar[XB_XCNT(j)]); sum += c; cnt += (c > 0u) ? 1u : 0u; mine = (j == x) ? c : mine; }
        if (sum == G) break;
        __builtin_amdgcn_s_sleep(1);
        if ((++sp & 255u) == 0u) { if (xb_ld(&bar[XB_TMO])) break; if (sp > XB_SPIN_CAP) { atomicAdd(&bar[XB_TMO], 1u); break; } }
    }
    nloc = mine > 0u ? mine : 1u; nx = cnt > 0u ? cnt : 1u;
}
__device__ __forceinline__ void xcd_barrier(const XcdBarrier& b, bool t0) {
    asm volatile("s_waitcnt vmcnt(0)" ::: "memory");
    __syncthreads();
    if (t0) {
        unsigned* bar = b.bar;
        __builtin_amdgcn_s_waitcnt(0);
        unsigned nloc = b.st[0], nx = b.st[1];
        if (nloc == 0u) { xcd_barrier_complete(bar, b.x, nloc, nx); b.st[0] = nloc; b.st[1] = nx; }
        const unsigned old = xb_add(&bar[XB_XSUB(b.x)], 1u);
        const unsigned gen = old / nloc;
        if (old + 1u == (gen + 1u) * nloc) {
            __builtin_amdgcn_fence(__ATOMIC_RELEASE, "agent");
            asm volatile("s_waitcnt vmcnt(0)" ::: "memory");
            const unsigned og = xb_add(&bar[XB_TOP], 1u);
            const unsigned tg = og / nx;
            if (og + 1u == (tg + 1u) * nx) xb_add(&bar[XB_TOPGEN], 1u);
            else XB_SPIN(xb_ld(&bar[XB_TOPGEN]) == tg, bar);
            __builtin_amdgcn_fence(__ATOMIC_ACQUIRE, "agent");
            xb_add(&bar[XB_XGEN(b.x)], 1u);
            asm volatile("s_waitcnt vmcnt(0)" ::: "memory");
        } else {
            XB_SPIN(xb_ld(&bar[XB_XGEN(b.x)]) == gen, bar);
            __builtin_amdgcn_fence(__ATOMIC_ACQUIRE, "agent");
            asm volatile("s_waitcnt vmcnt(0)" ::: "memory");
        }
    }
    __syncthreads();
}

struct Args { const float* in[28]; float* out; uchar* ws; int ph_lo, ph_hi, dry, pad; };
enum { I_X = 0, I_C, I_CTX, I_CCTX, I_ADAW, I_ADAB, I_NMIXG, I_NFFNG, I_ABWIN, I_SGUNG, I_SGUW, I_SGUB, I_GQG, I_GKG, I_ABWOUT, I_MLAWIN, I_MLAQG, I_MLAKVG, I_MLAWUQ, I_MLAWUKV, I_MLAWOUT,
       I_RW, I_RB, I_W1, I_B1, I_W2, I_B2, I_FNG };
struct Frame {
    LAS uchar* lds; int tid, lane, wave, G, bid;
    uchar* ws; float* out;
};
__device__ __forceinline__ const float* INP(int i) {
    const __attribute__((address_space(4))) char* ka = (const __attribute__((address_space(4))) char*)__builtin_amdgcn_kernarg_segment_ptr();
    return *(const float* const volatile __attribute__((address_space(4)))*)(ka + i * 8);
}

namespace pg8 {
constexpr int BM = 256, BK = 64, HALF = 128, HTB = HALF * BK * 2, NXCD = 8, WGM = 8;
__device__ __forceinline__ int lds_byte(int r, int c) { const int st = (r >> 4) * 2 + (c >> 5), rr = r & 15, cc = c & 31, ob = rr * 64 + cc * 2; return st * 1024 + (ob ^ (((ob >> 9) & 1) << 5)); }
__device__ __forceinline__ void stage_rc(int b, int& R, int& C) { const int st = b / 1024, sb = b % 1024, swz = sb ^ (((sb >> 9) & 1) << 5); R = (st >> 1) * 16 + swz / 64; C = (st & 1) * 32 + (swz % 64) / 2; }
__device__ __forceinline__ int perm32(int rho) { const int n = rho >> 4, i = rho & 15; return 8 * (i >> 2) + 4 * n + (i & 3); }
struct Unit { int pm, pn, e, rb; };
struct StaticOrder {
    int nM, nN, nwg;
    __device__ void init(int nM_, int nN_) { nM = nM_; nN = nN_; nwg = nM * nN; }
    __device__ bool map(long L, int& pm, int& pn) const {
        if (L >= nwg) return false;
        int wgid = (int)L; { const int q = nwg / NXCD, r = nwg % NXCD, xcd = wgid % NXCD, off = wgid / NXCD; wgid = (xcd < r ? xcd * (q + 1) : r * (q + 1) + (xcd - r) * q) + off; }
        const int nig = WGM * nN, gid = wgid / nig, fm = gid * WGM, gsz = (nM - fm) < WGM ? (nM - fm) : WGM;
        pm = fm + ((wgid % nig) % gsz); pn = (wgid % nig) / gsz; return true;
    }
};
typedef f32x4 Acc[2][2][4][2];
template <class P>
__device__ __forceinline__ void gemm_phase(LAS uchar* lds, const P& p, int wave_s) {
    const int tid = tid_fresh(wave_s), wid = __builtin_amdgcn_readfirstlane(tid >> 6), lane = tid & 63, wr = wid >> 2, wc = wid & 3, fr = lane & 15, fq = lane >> 4;
    const int K = p.K, nt = K / BK;
    unsigned voffA[2][2], voffB[2];
#pragma unroll
    for (int i = 0; i < 2; ++i) { int R, C; stage_rc(tid * 16 + i * 8192, R, C); const int Rb = P::PERM ? ((R & ~31) + perm32(R & 31)) : R;
        voffA[0][i] = (unsigned)(R * p.lda + C) * 2u; voffA[1][i] = voffA[0][i]; voffB[i] = (unsigned)(Rb * K + C) * 2u; }
    const unsigned kstep = (unsigned)(BK * 2);
    const unsigned hstepB = (unsigned)HALF * K * 2;
    const unsigned hstepA = P::GATHER ? 0u : (unsigned)HALF * p.lda * 2;
#define PG8_VA1 voffA[P::GATHER ? 1 : 0]
    const __amdgpu_buffer_rsrc_t rsA = __builtin_amdgcn_make_buffer_rsrc((void*)p.a_mat(), 0, 0xffffffffu, 0x00020000);
    const __amdgpu_buffer_rsrc_t rsB = __builtin_amdgcn_make_buffer_rsrc((void*)p.b_mat(), 0, 0xffffffffu, 0x00020000);
    const char* gpA = (const char*)p.a_mat(); const char* gpB = (const char*)p.b_mat(); (void)gpA; (void)gpB; (void)rsA; (void)rsB;
    const unsigned ldsw = (unsigned)wid * 1024u;
    const int aoff = lds_byte(wr * 64 + fr, fq * 8), boff = lds_byte(wc * 32 + fr, fq * 8);
#define PG8_SA(b, h) (((b) * 2 + (h)) * HTB)
#define PG8_SB(b, h) ((4 + (b) * 2 + (h)) * HTB)
#if USE_BUFFER_LDS
#define PG8_STAGE_R(bufoff, rs, gp, soff, voff) do { _Pragma("unroll") for (int _i = 0; _i < 2; ++_i) \
        __builtin_amdgcn_raw_ptr_buffer_load_lds(rs, (LAS unsigned*)(lds + (bufoff) + ldsw + _i * 8192), 16, (int)(voff)[_i], (int)(soff), 0, 0); } while (0)
#else
#define PG8_STAGE_R(bufoff, rs, gp, soff, voff) do { _Pragma("unroll") for (int _i = 0; _i < 2; ++_i) \
        __builtin_amdgcn_global_load_lds((const unsigned*)((const char*)(gp) + (size_t)(soff) + (voff)[_i]), (LAS unsigned*)(lds + (bufoff) + ldsw + _i * 8192), 16, 0, 0); } while (0)
#endif
#define PG8_STAGE_A(bufoff, soff, voff) PG8_STAGE_R(bufoff, rsA, gpA, soff, voff)
#define PG8_STAGE_B(bufoff, soff, voff) PG8_STAGE_R(bufoff, rsB, gpB, soff, voff)
#define PG8_LDA(dst, b, h) do { _Pragma("unroll") for (int m = 0; m < 4; ++m) _Pragma("unroll") for (int k = 0; k < 2; ++k) dst[m][k] = *(const LAS i32x4*)(lds + PG8_SA(b, h) + aoff + m * 2048 + k * 1024); } while (0)
#define PG8_LDB(dst, b, h) do { _Pragma("unroll") for (int n = 0; n < 2; ++n) _Pragma("unroll") for (int k = 0; k < 2; ++k) dst[n][k] = *(const LAS i32x4*)(lds + PG8_SB(b, h) + boff + n * 2048 + k * 1024); } while (0)
#define PG8_CAT(x) __builtin_shufflevector((x)[0], (x)[1], 0, 1, 2, 3, 4, 5, 6, 7)
#define PG8_MMA(ai, bj, At, Bt) do { __builtin_amdgcn_s_setprio(1); \
        if constexpr (P::FP8) { _Pragma("unroll") for (int m = 0; m < 4; ++m) _Pragma("unroll") for (int n = 0; n < 2; ++n) \
            acc[ai][bj][m][n] = __builtin_amdgcn_mfma_scale_f32_16x16x128_f8f6f4(PG8_CAT(Bt[n]), PG8_CAT(At[m]), acc[ai][bj][m][n], 0, 0, 0, 0x7F7F7F7F, 0, 0x7F7F7F7F); } \
        else { _Pragma("unroll") for (int m = 0; m < 4; ++m) _Pragma("unroll") for (int n = 0; n < 2; ++n) _Pragma("unroll") for (int k = 0; k < 2; ++k) \
            acc[ai][bj][m][n] = __builtin_amdgcn_mfma_f32_16x16x32_bf16(__builtin_bit_cast(bf16x8, Bt[n][k]), __builtin_bit_cast(bf16x8, At[m][k]), acc[ai][bj][m][n], 0, 0, 0); } \
        __builtin_amdgcn_s_setprio(0); } while (0)
#define PG8_WAIT_V(n) asm volatile("s_waitcnt vmcnt(" #n ")" ::: "memory")
#define PG8_WAIT_L(n) asm volatile("s_waitcnt lgkmcnt(" #n ")" ::: "memory")
#define PG8_BAR __builtin_amdgcn_s_barrier()
#define PG8_SCHED __builtin_amdgcn_sched_barrier(0)
    Unit cur, nxt; int ui = 0;
    if (!p.next(0, cur)) return;
    Acc acc;
#pragma unroll
    for (int a = 0; a < 2; ++a)
#pragma unroll
        for (int b = 0; b < 2; ++b)
#pragma unroll
            for (int m = 0; m < 4; ++m)
#pragma unroll
                for (int n = 0; n < 2; ++n) acc[a][b][m][n] = (f32x4){0.f, 0.f, 0.f, 0.f};
    i32x4 At[4][2], B0[2][2], B1[2][2];
    unsigned cA = p.a_off(cur), cB = p.b_off(cur);
    if constexpr (P::GATHER) { p.a_voff(cur, voffA); }
    PG8_STAGE_B(PG8_SB(0, 0), cB, voffB); PG8_STAGE_B(PG8_SB(0, 1), cB + hstepB, voffB); PG8_STAGE_A(PG8_SA(0, 0), cA, voffA[0]); PG8_STAGE_A(PG8_SA(0, 1), cA + hstepA, PG8_VA1);
    if (wr == 1) PG8_BAR;
    PG8_WAIT_V(2); PG8_BAR;
    PG8_STAGE_B(PG8_SB(1, 0), cB + kstep, voffB); PG8_STAGE_A(PG8_SA(1, 0), cA + kstep, voffA[0]); PG8_STAGE_B(PG8_SB(1, 1), cB + hstepB + kstep, voffB);
    PG8_WAIT_V(6); PG8_BAR;
    for (;;) {
        const bool has_next = p.next(ui + 1, nxt);
        const unsigned nA = has_next ? p.a_off(nxt) : cA, nB = has_next ? p.b_off(nxt) : cB;
        for (int t = 0; t < nt; t += 2) {
            const bool last = (t == nt - 2);
            const unsigned a1 = cA + (unsigned)(t + 1) * kstep;
            const unsigned a2 = last ? nA : cA + (unsigned)(t + 2) * kstep, b2 = last ? nB : cB + (unsigned)(t + 2) * kstep;
            const unsigned a3 = a2 + kstep, b3 = b2 + kstep;
            PG8_LDB(B0, 0, 0); PG8_LDB(B1, 0, 1); PG8_SCHED; PG8_LDA(At, 0, 0); PG8_STAGE_A(PG8_SA(1, 1), a1 + hstepA, PG8_VA1);
            if constexpr (P::GATHER) { if (last && has_next) p.a_voff(nxt, voffA); }
            PG8_WAIT_V(8); PG8_WAIT_L(0); PG8_BAR; PG8_MMA(0, 0, At, B0); PG8_MMA(0, 1, At, B1); PG8_BAR; PG8_SCHED;
            PG8_LDA(At, 0, 1); PG8_STAGE_B(PG8_SB(0, 0), b2, voffB); PG8_STAGE_B(PG8_SB(0, 1), b2 + hstepB, voffB); PG8_STAGE_A(PG8_SA(0, 0), a2, voffA[0]);
            PG8_WAIT_V(8); PG8_WAIT_L(0); PG8_BAR; PG8_MMA(1, 0, At, B0); PG8_MMA(1, 1, At, B1); PG8_BAR; PG8_SCHED;
            PG8_LDB(B0, 1, 0); PG8_LDB(B1, 1, 1); PG8_SCHED; PG8_LDA(At, 1, 0); PG8_STAGE_A(PG8_SA(0, 1), a2 + hstepA, PG8_VA1);
            PG8_WAIT_V(8); PG8_WAIT_L(0); PG8_BAR; PG8_MMA(0, 0, At, B0); PG8_MMA(0, 1, At, B1); PG8_BAR; PG8_SCHED;
            PG8_LDA(At, 1, 1); PG8_STAGE_B(PG8_SB(1, 0), b3, voffB); PG8_STAGE_B(PG8_SB(1, 1), b3 + hstepB, voffB); PG8_STAGE_A(PG8_SA(1, 0), a3, voffA[0]);
            PG8_WAIT_V(8); PG8_WAIT_L(0); PG8_BAR; PG8_MMA(1, 0, At, B0); PG8_MMA(1, 1, At, B1); PG8_BAR; PG8_SCHED;
        }
        if (wr == 0) PG8_BAR;
        p.epi(acc, cur, wr, wc, fr, fq);
        if (!has_next) break;
#pragma unroll
        for (int a = 0; a < 2; ++a)
#pragma unroll
            for (int b = 0; b < 2; ++b)
#pragma unroll
                for (int m = 0; m < 4; ++m)
#pragma unroll
                    for (int n = 0; n < 2; ++n) acc[a][b][m][n] = (f32x4){0.f, 0.f, 0.f, 0.f};
        cur = nxt; cA = nA; cB = nB; ++ui;
        if (wr == 1) PG8_BAR;
    }
    PG8_WAIT_V(0);
    PG8_BAR;
#undef PG8_SA
#undef PG8_VA1
#undef PG8_SB
#undef PG8_STAGE_R
#undef PG8_STAGE_A
#undef PG8_STAGE_B
#undef PG8_LDA
#undef PG8_LDB
#undef PG8_MMA
#undef PG8_CAT
#undef PG8_WAIT_V
#undef PG8_WAIT_L
#undef PG8_BAR
#undef PG8_SCHED
}

template <bool GELU>
__device__ __forceinline__ void epi_store_bf16(const Acc& acc, bf16_t* dst  , int ldc, const float* bias  , int wr, int wc, int fr, int fq, float sc = 1.f) {
    const int row0 = wr * 64 + fr, col0 = wc * 32 + 8 * fq;
    f32x4 bv[2][2];
#pragma unroll
    for (int bj = 0; bj < 2; ++bj)
#pragma unroll
        for (int n = 0; n < 2; ++n) bv[bj][n] = bias ? *(const f32x4*)(bias + col0 + bj * HALF + 4 * n) : (f32x4){0.f, 0.f, 0.f, 0.f};
    const unsigned lane_off = (unsigned)(row0 * ldc + col0) * 2u;
#pragma unroll
    for (int ai = 0; ai < 2; ++ai)
#pragma unroll
        for (int m = 0; m < 4; ++m) { char* rowb = (char*)dst + (size_t)((ai * HALF + m * 16) * ldc) * 2;
#pragma unroll
            for (int bj = 0; bj < 2; ++bj) { f32x4 v0 = acc[ai][bj][m][0] * sc + bv[bj][0], v1 = acc[ai][bj][m][1] * sc + bv[bj][1];
                if (GELU) {
#pragma unroll
                    for (int j = 0; j < 4; ++j) { v0[j] = gelu_tanh_f(v0[j]); v1[j] = gelu_tanh_f(v1[j]); } }
                u32x4 w; w.x = cvtpk(v0[0], v0[1]); w.y = cvtpk(v0[2], v0[3]); w.z = cvtpk(v1[0], v1[1]); w.w = cvtpk(v1[2], v1[3]);
                *(u32x4*)(rowb + lane_off + bj * HALF * 2) = w; } }
}
}

namespace att {
constexpr int NW = 8, QBLK = 32, KVBLK = 64;
constexpr int SHM_V = KVBLK * 128 * 2;
constexpr float THR = 8.f;
__device__ __forceinline__ int crow(int r, int hi) { return (r & 3) + 8 * (r >> 2) + 4 * hi; }
template <int DQK> struct Cfg { static constexpr float SCALE = (DQK == 128) ? 0.088388347648318440f : 0.072168783648703220f; static constexpr int KP = DQK * 2, SHM_K = KVBLK * DQK * 2, ND = DQK / 16; };
#define KSWZ(PITCH, row, colB) ((row) * (PITCH) + ((colB) ^ (((row) & 7) << 4)))
template <int DQK> __device__ __forceinline__ void partialSM(f32x16& p0, f32x16& p1, float& m_reg, float& mn, float& alpha) {
    constexpr float SCALE = Cfg<DQK>::SCALE, C = SCALE * 1.4426950408889634f;
    float pmax = p0[0];
#pragma unroll
    for (int r = 1; r < 16; ++r) pmax = fmaxf(pmax, p0[r]);
#pragma unroll
    for (int r = 0; r < 16; ++r) pmax = fmaxf(pmax, p1[r]);
    { auto rr = __builtin_amdgcn_permlane32_swap(__float_as_uint(pmax), __float_as_uint(pmax), false, false);
      pmax = fmaxf(__uint_as_float(rr[0]), __uint_as_float(rr[1])); }
    if (__builtin_expect(__all(pmax - m_reg <= THR / SCALE), 1)) { mn = m_reg; alpha = 1.f; }
    else { mn = fmaxf(m_reg, pmax); alpha = __builtin_amdgcn_exp2f((m_reg - mn) * C); m_reg = mn; }
    const float mnC = -mn * C;
#pragma unroll
    for (int r = 0; r < 16; ++r) p0[r] = fmaf(p0[r], C, mnC);
#pragma unroll
    for (int r = 0; r < 16; ++r) p1[r] = fmaf(p1[r], C, mnC);
#pragma unroll
    for (int r = 0; r < 16; ++r) p0[r] = __builtin_amdgcn_exp2f(p0[r]);
}
__device__ __forceinline__ void finishSM(f32x16& p0, f32x16& p1, float alpha, float& l_reg, bf16x8& pa0, bf16x8& pa1, bf16x8& pa2, bf16x8& pa3) {
#pragma unroll
    for (int r = 0; r < 16; ++r) p1[r] = __builtin_amdgcn_exp2f(p1[r]);
    float ps = 0;
#pragma unroll
    for (int r = 0; r < 16; ++r) ps += p0[r];
#pragma unroll
    for (int r = 0; r < 16; ++r) ps += p1[r];
    { auto rr = __builtin_amdgcn_permlane32_swap(__float_as_uint(ps), __float_as_uint(ps), false, false);
      ps = __uint_as_float(rr[0]) + __uint_as_float(rr[1]); }
    l_reg = l_reg * alpha + ps;
#define PK4(P, BASE, OUT) do { unsigned a0 = cvtpk(P[BASE + 0], P[BASE + 1]), a1 = cvtpk(P[BASE + 2], P[BASE + 3]);   \
    unsigned b0 = cvtpk(P[BASE + 4], P[BASE + 5]), b1 = cvtpk(P[BASE + 6], P[BASE + 7]);                              \
    auto r0 = __builtin_amdgcn_permlane32_swap(a0, b0, false, false); auto r1 = __builtin_amdgcn_permlane32_swap(a1, b1, false, false); \
    u32x4 w = {r0[0], r1[0], r0[1], r1[1]}; OUT = *reinterpret_cast<bf16x8*>(&w); } while (0)
    PK4(p0, 0, pa0); PK4(p0, 8, pa1); PK4(p1, 0, pa2); PK4(p1, 8, pa3);
#undef PK4
}
template <int DQK> __device__ __forceinline__ void qkt(f32x16& p0, f32x16& p1, const LAS char* Ks, const bf16x8* qr, int r32, int hi) {
    constexpr int KP = Cfg<DQK>::KP, ND = Cfg<DQK>::ND;
    p0 = f32x16{}; p1 = f32x16{};
#pragma unroll
    for (int d0 = 0; d0 < ND; ++d0) { const int cb = (d0 * 16 + hi * 8) * 2;
        bf16x8 b0 = *reinterpret_cast<const LAS bf16x8*>(Ks + KSWZ(KP, r32, cb));
        bf16x8 b1 = *reinterpret_cast<const LAS bf16x8*>(Ks + KSWZ(KP, 32 + r32, cb));
        p0 = __builtin_amdgcn_mfma_f32_32x32x16_bf16(b0, qr[d0], p0, 0, 0, 0);
        p1 = __builtin_amdgcn_mfma_f32_32x32x16_bf16(b1, qr[d0], p1, 0, 0, 0); }
}
__device__ __forceinline__ int v_st(int k, int c) { const int kk = (k & ~0xC) | ((k & 4) << 1) | ((k & 8) >> 1); return ((kk >> 3) * 4 + (c >> 5)) * 512 + ((kk & 7) * 32 + (c & 31)) * 2; }
__device__ __forceinline__ int v_rd_base(int lane) { return ((lane & 3) << 3) | (((lane >> 2) & 3) << 6) | (((lane >> 4) & 1) << 5) | (((lane >> 5) & 1) << 8); }
constexpr int v_rd_off(int d0, int ks, int half) { return d0 * 512 + ks * 4096 + half * 2048; }
template <int OFF> __device__ __forceinline__ s16x4 tr_read(int vb) {
    s16x4 r; asm volatile("ds_read_b64_tr_b16 %0, %1 offset:%2" : "=&v"(r) : "v"(vb), "i"(OFF) : "memory"); return r;
}
template <int D0> __device__ __forceinline__ void pv_one(f32x16& od, int vb, bf16x8 pa0, bf16x8 pa1, bf16x8 pa2, bf16x8 pa3) {
    const s16x4 l0 = tr_read<v_rd_off(D0, 0, 0)>(vb), h0 = tr_read<v_rd_off(D0, 0, 1)>(vb), l1 = tr_read<v_rd_off(D0, 1, 0)>(vb), h1 = tr_read<v_rd_off(D0, 1, 1)>(vb);
    const s16x4 l2 = tr_read<v_rd_off(D0, 2, 0)>(vb), h2 = tr_read<v_rd_off(D0, 2, 1)>(vb), l3 = tr_read<v_rd_off(D0, 3, 0)>(vb), h3 = tr_read<v_rd_off(D0, 3, 1)>(vb);
    asm volatile("s_waitcnt lgkmcnt(0)" ::: "memory"); SBAR();
#define PK(L, H) (bf16x8){L[0], L[1], L[2], L[3], H[0], H[1], H[2], H[3]}
    od = __builtin_amdgcn_mfma_f32_32x32x16_bf16(pa0, PK(l0, h0), od, 0, 0, 0);
    od = __builtin_amdgcn_mfma_f32_32x32x16_bf16(pa1, PK(l1, h1), od, 0, 0, 0);
    od = __builtin_amdgcn_mfma_f32_32x32x16_bf16(pa2, PK(l2, h2), od, 0, 0, 0);
    od = __builtin_amdgcn_mfma_f32_32x32x16_bf16(pa3, PK(l3, h3), od, 0, 0, 0);
#undef PK
}
__device__ __forceinline__ void pv_d0(f32x16* o, int vb, bf16x8 pa0, bf16x8 pa1, bf16x8 pa2, bf16x8 pa3) {
    pv_one<0>(o[0], vb, pa0, pa1, pa2, pa3); pv_one<1>(o[1], vb, pa0, pa1, pa2, pa3); pv_one<2>(o[2], vb, pa0, pa1, pa2, pa3); pv_one<3>(o[3], vb, pa0, pa1, pa2, pa3);
}
__device__ __forceinline__ bf16x8 ld8(const bf16_t* p) { return *reinterpret_cast<const bf16x8*>(p); }
__device__ __forceinline__ void rope_frag(bf16x8& a, bf16x8& b, const f32x2* tab) {
    u32x4 wa = *reinterpret_cast<u32x4*>(&a), wb = *reinterpret_cast<u32x4*>(&b), oa, ob;
#pragma unroll
    for (int q = 0; q < 4; ++q) {
        const float x1l = bflo(wa[q]), x1h = bfhi(wa[q]), x2l = bflo(wb[q]), x2h = bfhi(wb[q]);
        const f32x2 t0 = tab[2 * q], t1 = tab[2 * q + 1];
        oa[q] = cvtpk(x1l * t0.x - x2l * t0.y, x1h * t1.x - x2h * t1.y);
        ob[q] = cvtpk(x2l * t0.x + x1l * t0.y, x2h * t1.x + x1h * t1.y);
    }
    a = *reinterpret_cast<bf16x8*>(&oa); b = *reinterpret_cast<bf16x8*>(&ob);
}
template <int DQK, int SDEPTH, bool MLA, int ldq, int ldkv, int ldo>
__device__ __forceinline__ void attn_unit(const bf16_t* __restrict__ Qb, const bf16_t* __restrict__ Kh, const bf16_t* __restrict__ KRh, const bf16_t* __restrict__ Vh,
                                          bf16_t* __restrict__ Ob, int seq, LAS char* lds, const f32x2* __restrict__ tabm, int qt0, int wave_s) {
    constexpr int KP = Cfg<DQK>::KP, SHM_K = Cfg<DQK>::SHM_K, ND = Cfg<DQK>::ND;
    const int tid = tid_fresh(wave_s), wid = tid >> 6, lane = tid & 63, r32 = lane & 31, hi = lane >> 5;
    LAS char* V_lds = lds; LAS char* K_lds = lds + 2 * SHM_V;
    LAS float* wsl = (LAS float*)(lds + 2 * SHM_V + 2 * SHM_K) + wid * 64; LAS float* li_l = wsl; LAS float* al_l = wsl + 32;
    float m_reg = -1e30f, l_reg = 0; f32x16 o[4] = {}; bf16x8 qr[ND];
    const bf16_t* Qw = Qb + (long)(wid * QBLK + r32) * ldq + hi * 8;
#pragma unroll
    for (int d0 = 0; d0 < ND; ++d0) qr[d0] = ld8(Qw + d0 * 16);
    if constexpr (MLA) {
        const int t = qt0 + wid * QBLK + r32, prow = t >> 6, pcol = t & 63;
        rope_frag(qr[8], qr[9], tabm + prow * 16 + hi * 8);
        rope_frag(qr[10], qr[11], tabm + pcol * 16 + hi * 8);
    }
    const int sr = tid >> 4, sc = (tid & 15) * 8, vst0 = v_st(sr, sc), vst1 = v_st(32 + sr, sc);
    const int krr = tid >> 3, krc = (tid & 7) * 8;
    const int vb0 = (int)(unsigned)(uintptr_t)V_lds + v_rd_base(lane);
    struct { bf16x8 vs0, vs1, ks0, ks1, kr; } sr_[SDEPTH];
#define SLOAD(i, k0) do { sr_[i].vs0 = ld8(&Vh[(long)((k0) + sr) * ldkv + sc]); sr_[i].vs1 = ld8(&Vh[(long)((k0) + 32 + sr) * ldkv + sc]); \
    sr_[i].ks0 = ld8(&Kh[(long)((k0) + sr) * ldkv + sc]); sr_[i].ks1 = ld8(&Kh[(long)((k0) + 32 + sr) * ldkv + sc]); \
    if constexpr (MLA) sr_[i].kr = ld8(&KRh[(long)((k0) + krr) * 64 + krc]); } while (0)
#define SWRITE(b, i) do { *(LAS bf16x8*)(V_lds + (b) * SHM_V + vst0) = sr_[i].vs0;          \
    *(LAS bf16x8*)(V_lds + (b) * SHM_V + vst1) = sr_[i].vs1; const int kc = sc * 2;               \
    *(LAS bf16x8*)(K_lds + (b) * SHM_K + KSWZ(KP, sr, kc)) = sr_[i].ks0;                       \
    *(LAS bf16x8*)(K_lds + (b) * SHM_K + KSWZ(KP, 32 + sr, kc)) = sr_[i].ks1;                  \
    if constexpr (MLA) *(LAS bf16x8*)(K_lds + (b) * SHM_K + KSWZ(KP, krr, 256 + krc * 2)) = sr_[i].kr; } while (0)
#define SWAIT() do { if constexpr (SDEPTH == 2) { if constexpr (MLA) asm volatile("s_waitcnt vmcnt(5)" ::: "memory"); else asm volatile("s_waitcnt vmcnt(4)" ::: "memory"); } else asm volatile("s_waitcnt vmcnt(0)" ::: "memory"); } while (0)
#define RESC(a) do { if (__any((a) < 1.f)) { if (hi == 0) al_l[r32] = (a); asm volatile("s_waitcnt lgkmcnt(0)" ::: "memory"); \
    _Pragma("unroll") for (int d = 0; d < 4; ++d) _Pragma("unroll") for (int r = 0; r < 16; ++r) o[d][r] *= al_l[crow(r, hi)]; } } while (0)
    bf16x8 pa0, pa1, pa2, pa3; const int NT = seq / KVBLK;
    if constexpr (MLA) {
        f32x16 p0, p1; float mn, al;
        SLOAD(0, 0); asm volatile("s_waitcnt vmcnt(0)" ::: "memory"); SWRITE(0, 0); SLOAD(0, KVBLK); __syncthreads();
        for (int j = 0; j < NT; ++j) {
            const int cb = j & 1;
            if (j + 1 < NT) { asm volatile("s_waitcnt vmcnt(0)" ::: "memory"); SWRITE(cb ^ 1, 0); if (j + 2 < NT) SLOAD(0, (j + 2) * KVBLK); }
            SBAR(); qkt<DQK>(p0, p1, K_lds + cb * SHM_K, qr, r32, hi);
            partialSM<DQK>(p0, p1, m_reg, mn, al); RESC(al);
            finishSM(p0, p1, al, l_reg, pa0, pa1, pa2, pa3); SBAR();
            pv_d0(o, vb0 + cb * SHM_V, pa0, pa1, pa2, pa3);
            __syncthreads();
        }
    } else {
    f32x16 pA0, pA1, pB0, pB1; float mnA, mnB, alA, alB;
    constexpr int SE = 0, SO = SDEPTH - 1;
    SLOAD(SE, 0); asm volatile("s_waitcnt vmcnt(0)" ::: "memory"); SWRITE(0, SE); __syncthreads();
    qkt<DQK>(pA0, pA1, K_lds, qr, r32, hi); partialSM<DQK>(pA0, pA1, m_reg, mnA, alA);
    SLOAD(SO, KVBLK); if constexpr (SDEPTH == 2) { if (2 < NT) SLOAD(SE, 2 * KVBLK); }
    SWAIT(); SWRITE(1, SO); __syncthreads();
    for (int j = 1; j + 1 < NT; j += 2) {
        SBAR(); qkt<DQK>(pB0, pB1, K_lds + SHM_K, qr, r32, hi);
        finishSM(pA0, pA1, alA, l_reg, pa0, pa1, pa2, pa3); SBAR();
        SLOAD(SO, (j + SDEPTH) * KVBLK); SBAR();
        pv_d0(o, vb0, pa0, pa1, pa2, pa3); partialSM<DQK>(pB0, pB1, m_reg, mnB, alB);
        __syncthreads(); SWAIT(); SWRITE(0, SE);
        RESC(alB); __syncthreads();
        SBAR(); qkt<DQK>(pA0, pA1, K_lds, qr, r32, hi);
        finishSM(pB0, pB1, alB, l_reg, pa0, pa1, pa2, pa3); SBAR();
        if (SDEPTH == 1 || j + 3 < NT) SLOAD(SE, (j + 1 + SDEPTH) * KVBLK); SBAR();
        pv_d0(o, vb0 + SHM_V, pa0, pa1, pa2, pa3); partialSM<DQK>(pA0, pA1, m_reg, mnA, alA);
        __syncthreads(); SWAIT(); SWRITE(1, SO);
        RESC(alA); __syncthreads();
    }
    SBAR(); qkt<DQK>(pB0, pB1, K_lds + SHM_K, qr, r32, hi);
    finishSM(pA0, pA1, alA, l_reg, pa0, pa1, pa2, pa3); SBAR();
    pv_d0(o, vb0, pa0, pa1, pa2, pa3); partialSM<DQK>(pB0, pB1, m_reg, mnB, alB);
    __syncthreads(); RESC(alB);
    finishSM(pB0, pB1, alB, l_reg, pa0, pa1, pa2, pa3); SBAR();
    pv_d0(o, vb0 + SHM_V, pa0, pa1, pa2, pa3);
    }
    if (hi == 0) li_l[r32] = l_reg; asm volatile("s_waitcnt lgkmcnt(0)" ::: "memory");
    float rli[16];
#pragma unroll
    for (int r = 0; r < 16; ++r) rli[r] = __builtin_amdgcn_rcpf(li_l[crow(r, hi)]);
    bf16_t* Ow = Ob + (long)(wid * QBLK) * ldo;
#pragma unroll
    for (int r = 0; r < 16; ++r) { const int orow = crow(r, hi);
#pragma unroll
        for (int d0 = 0; d0 < 4; ++d0) Ow[(long)orow * ldo + d0 * 32 + r32] = f2bf(o[d0][r] * rli[r]); }
    __syncthreads();
#undef SLOAD
#undef SWRITE
#undef SWAIT
#undef RESC
}
}

template <int MODE> __device__ __forceinline__ int dst_row(int n) {
    if (MODE == 1) { const int half = n >> 10, c = n & 1023; return ((c >> 7) << 8) + (half << 7) + (c & 127); }
    if (MODE == 2) { const int h = n >> 8, j = n & 255; return j < 128 ? (h << 7) + j : 1024 + (h << 7) + (j - 128); }
    return n;
}
template <int MODE> __device__ __forceinline__ void p0_transpose_item_fp8(const float* W, int K, int N, unsigned char* WT, LAS float* scr, int item, int lane) {
    const int nblk = N / 32, kb = item / nblk, nb = item % nblk, k0 = 64 * kb, n0 = 32 * nb;
#pragma unroll 8
    for (int i = 0; i < 32; ++i) { const int kk = 2 * i + (lane >> 5); scr[kk * 33 + (lane & 31)] = W[(size_t)(k0 + kk) * N + n0 + (lane & 31)]; }
    LDS_WAIT(); asm volatile("" ::: "memory");
    const int c = lane & 7;
#pragma unroll
    for (int j = 0; j < 4; ++j) { const int n = (lane >> 3) + 8 * j; const LAS float* s = scr + (8 * c) * 33 + n;
        u32x2 o; o.x = pk4_fp8(s[0 * 33] * 64.f, s[1 * 33] * 64.f, s[2 * 33] * 64.f, s[3 * 33] * 64.f); o.y = pk4_fp8(s[4 * 33] * 64.f, s[5 * 33] * 64.f, s[6 * 33] * 64.f, s[7 * 33] * 64.f);
        *(u32x2*)(WT + (size_t)dst_row<MODE>(n0 + n) * K + k0 + 8 * c) = o; }
    LDS_WAIT(); asm volatile("" ::: "memory");
}
template <int MODE> __device__ __forceinline__ void p0_transpose_item(const float* W, int K, int N, bf16_t* WT, LAS float* scr, int item, int lane) {
    const int nblk = N / 32, kb = item / nblk, nb = item % nblk, k0 = 64 * kb, n0 = 32 * nb;
#pragma unroll 8
    for (int i = 0; i < 32; ++i) { const int kk = 2 * i + (lane >> 5); scr[kk * 33 + (lane & 31)] = W[(size_t)(k0 + kk) * N + n0 + (lane & 31)]; }
    LDS_WAIT(); asm volatile("" ::: "memory");
    const int c = lane & 7;
#pragma unroll
    for (int j = 0; j < 4; ++j) { const int n = (lane >> 3) + 8 * j; const LAS float* s = scr + (8 * c) * 33 + n;
        u32x4 o; o.x = cvtpk(s[0 * 33], s[1 * 33]); o.y = cvtpk(s[2 * 33], s[3 * 33]); o.z = cvtpk(s[4 * 33], s[5 * 33]); o.w = cvtpk(s[6 * 33], s[7 * 33]);
        *(u32x4*)(WT + (size_t)dst_row<MODE>(n0 + n) * K + k0 + 8 * c) = o; }
    LDS_WAIT(); asm volatile("" ::: "memory");
}
__device__ __forceinline__ void p0_prologue(Frame& F) {
    uchar* ws = F.ws;
    {
        LAS float* S = (LAS float*)F.lds;
        const float* pC = INP(I_C); const float* pCC = INP(I_CCTX); const float* pAW = INP(I_ADAW); const float* pAB = INP(I_ADAB); const float* pNM = INP(I_NMIXG); const float* pNF = INP(I_NFFNG);
        float* MOD = (float*)(ws + WS_MOD);
        for (int item = F.bid; item < 192; item += F.G) {
            const int layer = item / 96, n0 = (item % 96) * 64;
            __syncthreads();
            for (int u = F.tid; u < 33 * 1024; u += 512) { const int j = u >> 10, k = u & 1023; const float c = j < 32 ? pC[j * 1024 + k] : pCC[k]; S[u] = silu_f(c); }
            __syncthreads();
            float acc[33];
#pragma unroll
            for (int j = 0; j < 33; ++j) acc[j] = 0.f;
            const float* wp = pAW + (size_t)layer * 1024 * 6144 + n0 + F.lane;
            const int kbeg = F.wave * 128;
            for (int k = kbeg; k < kbeg + 128; k += 4) {
                const float w0 = wp[(size_t)k * 6144], w1 = wp[(size_t)(k + 1) * 6144], w2 = wp[(size_t)(k + 2) * 6144], w3 = wp[(size_t)(k + 3) * 6144];
#pragma unroll
                for (int j = 0; j < 33; ++j) { const f32x4 s = *(const LAS f32x4*)(S + j * 1024 + k); acc[j] += s.x * w0 + s.y * w1 + s.z * w2 + s.w * w3; }
            }
            __syncthreads();
#pragma unroll
            for (int j = 0; j < 33; ++j) S[(F.wave * 33 + j) * 64 + F.lane] = acc[j];
            __syncthreads();
            for (int u = F.tid; u < 33 * 64; u += 512) { const int j = u >> 6, cl = u & 63; float s = 0.f;
#pragma unroll
                for (int w = 0; w < 8; ++w) s += S[(w * 33 + j) * 64 + cl];
                const int n = n0 + cl, part = n >> 10, col = n & 1023;
                s += pAB[layer * 6144 + n];
                if (part == 1) s = pNM[layer * 1024 + col] * (1.f + s);
                if (part == 4) s = pNF[layer * 1024 + col] * (1.f + s);
                MOD[((size_t)(layer * 33 + j) * 6 + part) * 1024 + col] = s; }
        }
        __syncthreads();
    }
    {
        const int gt = F.bid * 512 + F.tid, NT = F.G * 512;
        f32x2* tg = (f32x2*)(ws + WS_TABG); f32x2* tm = (f32x2*)(ws + WS_TABM);
        for (int u = gt; u < 64 * 32; u += NT) { const int pos = u >> 5, i = u & 31; const float inv = powf(10000.f, -(float)(2 * i) / 64.f); const float a = (float)pos * inv; tg[u] = (f32x2){cosf(a), sinf(a)}; }
        for (int u = gt; u < 64 * 16; u += NT) { const int pos = u >> 4, i = u & 15; const float inv = powf(10000.f, -(float)(2 * i) / 32.f); const float a = (float)pos * inv; tm[u] = (f32x2){cosf(a), sinf(a)}; }
        float* wrt = (float*)(ws + WS_WRT); const float* pRW = INP(I_RW); const float* pSW = INP(I_SGUW);
        for (int u = gt; u < 2 * 32 * 1024; u += NT) { const int l = u >> 15, e = (u >> 10) & 31, k = u & 1023; wrt[u] = pRW[((size_t)l * 1024 + k) * 32 + e]; }
        bf16_t* sw = (bf16_t*)(ws + WS_SGUW);
        for (int u = gt; u < 4 * 128 * 128; u += NT) sw[u] = f2bf(pSW[u]);
        u32x4* z = (u32x4*)(ws + WS_WIN1 + (size_t)832 * 1024 * 2);
        for (int u = gt; u < 192 * 1024 * 2 / 16; u += NT) z[u] = (u32x4){0u, 0u, 0u, 0u};
    }
    {
        LAS float* scr = (LAS float*)(F.lds + F.wave * 16384);
        const int gw = F.bid * 8 + F.wave, NGW = F.G * 8; const float* pW1 = INP(I_W1); const float* pW2 = INP(I_W2);
        constexpr int J0 = 16 * 64, J1 = 16 * 32, J2 = 16 * 26, J3 = 8 * 48, J4 = 4 * 64, J5 = 16 * 32, JW1 = 64 * 1024, JW2 = 64 * 512;
        constexpr int NITEMS = J0 + J1 + J2 + J3 + J4 + J5 + JW1 + JW2;
        for (int it = gw; it < NITEMS; it += NGW) {
            int r = it;
#if MOE_FP8
            if (r < JW1) { const int le = r >> 10; p0_transpose_item_fp8<1>(pW1 + (size_t)le * 1024 * 2048, 1024, 2048, (unsigned char*)(ws + WS_W1) + (size_t)le * 2048 * 1024, scr, r & 1023, F.lane); continue; } r -= JW1;
            if (r < JW2) { const int le = r >> 9; p0_transpose_item_fp8<0>(pW2 + (size_t)le * 1024 * 1024, 1024, 1024, (unsigned char*)(ws + WS_W2) + (size_t)le * 1024 * 1024, scr, r & 511, F.lane); continue; } r -= JW2;
#else
            if (r < JW1) { const int le = r >> 10; p0_transpose_item<1>(pW1 + (size_t)le * 1024 * 2048, 1024, 2048, (bf16_t*)(ws + WS_W1) + (size_t)le * 2048 * 1024, scr, r & 1023, F.lane); continue; } r -= JW1;
            if (r < JW2) { const int le = r >> 9; p0_transpose_item<0>(pW2 + (size_t)le * 1024 * 1024, 1024, 1024, (bf16_t*)(ws + WS_W2) + (size_t)le * 1024 * 1024, scr, r & 511, F.lane); continue; } r -= JW2;
#endif
            if (r < J0) { p0_transpose_item<0>(INP(I_ABWIN), 1024, 2048, (bf16_t*)(ws + WS_WIN0), scr, r, F.lane); continue; } r -= J0;
            if (r < J1) { p0_transpose_item<0>(INP(I_ABWOUT), 1024, 1024, (bf16_t*)(ws + WS_WOUT0), scr, r, F.lane); continue; } r -= J1;
            if (r < J2) { p0_transpose_item<0>(INP(I_MLAWIN), 1024, 832, (bf16_t*)(ws + WS_WIN1), scr, r, F.lane); continue; } r -= J2;
            if (r < J3) { p0_transpose_item<0>(INP(I_MLAWUQ), 512, 1536, (bf16_t*)(ws + WS_WUQ), scr, r, F.lane); continue; } r -= J3;
            if (r < J4) { p0_transpose_item<2>(INP(I_MLAWUKV), 256, 2048, (bf16_t*)(ws + WS_WUKV), scr, r, F.lane); continue; } r -= J4;
            p0_transpose_item<0>(INP(I_MLAWOUT), 1024, 1024, (bf16_t*)(ws + WS_WOUT1), scr, r, F.lane);
        }
    }
}

__device__ __forceinline__ void row_src_ptr(const float* px, const float* pctx, int r, const float*& src, int& mj) {
    const int b = r / TPB, pos = r - b * TPB;
    if (pos < CTXL) { src = pctx + ((size_t)b * CTXL + pos) * DM; mj = 32; } else { src = px + ((size_t)b * SEQ + (pos - CTXL)) * DM; mj = b; }
}
__device__ __forceinline__ void store_h_row(bf16_t* hrow, int lane, const f32x4 (&h)[4]) {
    unsigned long long* o8 = (unsigned long long*)hrow + lane;
#pragma unroll
    for (int j = 0; j < 4; ++j) o8[64 * j] = (unsigned long long)cvtpk(h[j].x, h[j].y) | ((unsigned long long)cvtpk(h[j].z, h[j].w) << 32);
}
__device__ __forceinline__ void p_norm0(Frame& F) {
    const float* MOD = (const float*)(F.ws + WS_MOD); bf16_t* H = (bf16_t*)(F.ws + WS_H);
    const int gw = F.bid * 8 + F.wave, NGW = F.G * 8; const float* px = INP(I_X); const float* pctx = INP(I_CTX);
    for (int r = gw; r < NTOK; r += NGW) {
        const float* src; int mj; row_src_ptr(px, pctx, r, src, mj);
        const f32x4* xr = (const f32x4*)src + F.lane; f32x4 v[4]; float ss = 0.f;
#pragma unroll
        for (int j = 0; j < 4; ++j) { v[j] = xr[64 * j]; ss += (v[j].x * v[j].x + v[j].y * v[j].y) + (v[j].z * v[j].z + v[j].w * v[j].w); }
        const float rstd = rsqrtf(wave_sum(ss) * (1.f / DM) + EPS);
        const f32x4* sh = (const f32x4*)(MOD + ((size_t)(0 * 33 + mj) * 6 + 0) * 1024) + F.lane; const f32x4* A = (const f32x4*)(MOD + ((size_t)(0 * 33 + mj) * 6 + 1) * 1024) + F.lane;
        f32x4 h[4];
#pragma unroll
        for (int j = 0; j < 4; ++j) h[j] = v[j] * rstd * A[64 * j] + sh[64 * j];
        store_h_row(H + (size_t)r * DM, F.lane, h);
    }
}
__device__ __forceinline__ void moe_prefix(Frame& F, int layer) {
    LAS int* pb = (LAS int*)(F.lds + XTRA_OFF + X_PB); LAS int* cn = (LAS int*)(F.lds + XTRA_OFF + X_CNT);
    const unsigned* gc = (const unsigned*)(F.ws + WS_CTL) + CW_CNT + layer * 64;
    __syncthreads();
    if (F.tid == 0) { int s = 0; for (int e = 0; e < 32; ++e) { const int c = (int)__hip_atomic_load(gc + e, __ATOMIC_RELAXED, __HIP_MEMORY_SCOPE_AGENT); cn[e] = c; pb[e] = s; s += (c + 255) >> 8; } pb[32] = s; }
    __syncthreads();
}
__device__ __forceinline__ void moe_gather_row(const Frame& F, int r, f32x4 (&f)[4]) {
    const LAS int* pb = (const LAS int*)(F.lds + XTRA_OFF + X_PB);
    const u32x2* ti = (const u32x2*)(F.ws + WS_TOKI) + (size_t)r * 4; const bf16_t* Y = (const bf16_t*)(F.ws + WS_Y);
#pragma unroll
    for (int j = 0; j < 4; ++j) f[j] = (f32x4){0.f, 0.f, 0.f, 0.f};
#pragma unroll
    for (int k = 0; k < 4; ++k) {
        const u32x2 t = ti[k]; const int e = (int)(t.x >> 20), pos = (int)(t.x & 0xfffffu); const float g = __uint_as_float(t.y);
        const size_t yrow = (size_t)pb[e] * 256 + pos; const u32x2* yp = (const u32x2*)(Y + yrow * DM) + F.lane;
#pragma unroll
        for (int j = 0; j < 4; ++j) { const u32x2 w = yp[64 * j]; f[j].x += g * bflo(w.x); f[j].y += g * bfhi(w.x); f[j].z += g * bflo(w.y); f[j].w += g * bfhi(w.y); }
    }
}
__device__ __forceinline__ void p_combine_norm(Frame& F, int dry) {
    moe_prefix(F, 0);
    const float* MOD = (const float*)(F.ws + WS_MOD); bf16_t* H = (bf16_t*)(F.ws + (dry ? WS_SCR + 288 * MiB : WS_H)); float* XR = (float*)(F.ws + WS_XR); float* XW = dry ? (float*)(F.ws + WS_SCR) : XR;
    const int gw = F.bid * 8 + F.wave, NGW = F.G * 8;
    for (int r = gw; r < NTOK; r += NGW) {
        const int b = r / TPB, pos = r - b * TPB, mj = pos < CTXL ? 32 : b;
        f32x4 f[4]; moe_gather_row(F, r, f);
        const f32x4* xr = (const f32x4*)(XR + (size_t)r * DM) + F.lane; f32x4* xw = (f32x4*)(XW + (size_t)r * DM) + F.lane; const f32x4* g2 = (const f32x4*)(MOD + ((size_t)(0 * 33 + mj) * 6 + 5) * 1024) + F.lane;
        f32x4 v[4]; float ss = 0.f;
#pragma unroll
        for (int j = 0; j < 4; ++j) { v[j] = xr[64 * j] + g2[64 * j] * f[j]; xw[64 * j] = v[j]; ss += (v[j].x * v[j].x + v[j].y * v[j].y) + (v[j].z * v[j].z + v[j].w * v[j].w); }
        const float rstd = rsqrtf(wave_sum(ss) * (1.f / DM) + EPS);
        const f32x4* sh = (const f32x4*)(MOD + ((size_t)(1 * 33 + mj) * 6 + 0) * 1024) + F.lane; const f32x4* A = (const f32x4*)(MOD + ((size_t)(1 * 33 + mj) * 6 + 1) * 1024) + F.lane;
        f32x4 h[4];
#pragma unroll
        for (int j = 0; j < 4; ++j) h[j] = v[j] * rstd * A[64 * j] + sh[64 * j];
        store_h_row(H + (size_t)r * DM, F.lane, h);
    }
}
__device__ __forceinline__ void p_final(Frame& F) {
    moe_prefix(F, 1);
    const float* MOD = (const float*)(F.ws + WS_MOD); const float* XR = (const float*)(F.ws + WS_XR);
    const int gw = F.bid * 8 + F.wave, NGW = F.G * 8; const float* pfg = INP(I_FNG);
    for (int q = gw; q < NBATCH * SEQ; q += NGW) {
        const int b = q >> 11, t = q & 2047, r = b * TPB + CTXL + t;
        f32x4 f[4]; moe_gather_row(F, r, f);
        const f32x4* xr = (const f32x4*)(XR + (size_t)r * DM) + F.lane; const f32x4* g2 = (const f32x4*)(MOD + ((size_t)(1 * 33 + b) * 6 + 5) * 1024) + F.lane;
        f32x4 v[4]; float ss = 0.f;
#pragma unroll
        for (int j = 0; j < 4; ++j) { v[j] = xr[64 * j] + g2[64 * j] * f[j]; ss += (v[j].x * v[j].x + v[j].y * v[j].y) + (v[j].z * v[j].z + v[j].w * v[j].w); }
        const float rstd = rsqrtf(wave_sum(ss) * (1.f / DM) + EPS);
        const f32x4* fg = (const f32x4*)pfg + F.lane; f32x4* op = (f32x4*)(F.out + (size_t)q * DM) + F.lane;
#pragma unroll
        for (int j = 0; j < 4; ++j) op[64 * j] = v[j] * rstd * fg[64 * j];
    }
}
__device__ __forceinline__ void top4_of16(float (&v)[16], int hi, float (&tv)[4], int (&te)[4]) {
#pragma unroll
    for (int k = 0; k < 4; ++k) { float best = v[0]; int bi = 0;
#pragma unroll
        for (int r = 1; r < 16; ++r) { const bool bt = v[r] > best; best = bt ? v[r] : best; bi = bt ? r : bi; }
        tv[k] = best; te[k] = (bi & 3) + 8 * (bi >> 2) + 4 * hi;
#pragma unroll
        for (int r = 0; r < 16; ++r) v[r] = (r == bi) ? -3.0e38f : v[r]; }
}
template <int LAYER> __device__ __forceinline__ void p_norm_router(Frame& F, int dry) {
    const float* MOD = (const float*)(F.ws + WS_MOD); bf16_t* H = (bf16_t*)(F.ws + WS_H); const float* XR = (const float*)(F.ws + WS_XR);
    LAS f32x4* WL4 = (LAS f32x4*)F.lds;
    LAS int* hist = (LAS int*)(F.lds + XTRA_OFF + X_HIST); LAS int* base = (LAS int*)(F.lds + XTRA_OFF + X_BASE); LAS u32x2* sel = (LAS u32x2*)(F.lds + XTRA_OFF + X_SEL);
    LAS f32x4* A2L4 = (LAS f32x4*)(F.lds + XTRA_OFF + X_A2); LAS float* CBL = (LAS float*)(F.lds + XTRA_OFF + X_CB); LAS float* RSL = (LAS float*)(F.lds + XTRA_OFF + X_RS);
    unsigned* gcnt = (unsigned*)(F.ws + WS_CTL) + CW_CNT + LAYER * 64 + (dry ? 128 : 0);
    int* rowl = (int*)(F.ws + WS_ROWL); u32x2* toki = (u32x2*)(F.ws + WS_TOKI);
    const f32x4* wsrc = (const f32x4*)(F.ws + WS_WRT + (size_t)LAYER * 32 * 1024 * 4);
    __syncthreads();
    for (int u = F.tid; u < 8192; u += 512) { const int e = u >> 8, k4 = u & 255; WL4[e * 256 + (k4 ^ (e & 15))] = wsrc[u]; }
    if (F.tid < 32) hist[F.tid] = 0;
    const int lane = F.lane, r32 = lane & 31, hi = lane >> 5; const float* prb = INP(I_RB);
    constexpr int NP = LAYER == 0 ? NPAN : 256;
    for (int pi = F.bid; pi < NP; pi += F.G) {
        const int pan = LAYER == 0 ? pi : pi + pi / 8 + 1;
        const int b = pan / 9, mj = (pan % 9 == 0) ? 32 : b;
        const f32x4* shp = (const f32x4*)(MOD + ((size_t)(LAYER * 33 + mj) * 6 + 3) * 1024); const f32x4* Ap = (const f32x4*)(MOD + ((size_t)(LAYER * 33 + mj) * 6 + 4) * 1024);
        __syncthreads();
        if (F.tid < 256) A2L4[F.tid] = Ap[F.tid];
        {
            const int e = F.tid >> 4, part = F.tid & 15; float sum = 0.f;
#pragma unroll 4
            for (int q = 0; q < 16; ++q) { const f32x4 a = shp[part * 16 + q], w = wsrc[e * 256 + part * 16 + q]; sum += (a.x * w.x + a.y * w.y) + (a.z * w.z + a.w * w.w); }
            sum += xf1(sum); sum += xf2(sum); sum += xf4(sum); sum += xf8(sum);
            if (part == 0) CBL[e] = sum + prb[LAYER * 32 + e];
        }
        __syncthreads();
        const int row = pan * 256 + F.wave * 32 + r32;
        const f32x4* xp = (const f32x4*)(XR + (size_t)row * DM) + hi;
        const LAS f32x4* wrow = WL4 + r32 * 256; const int swz = r32 & 15;
        f32x16 acc = {}; float ssq = 0.f;
#pragma unroll 1
        for (int m0 = 0; m0 < 128; m0 += 8) {
            f32x4 x4[8];
#pragma unroll
            for (int u = 0; u < 8; ++u) x4[u] = xp[2 * (m0 + u)];
#pragma unroll
            for (int u = 0; u < 8; ++u) { const int k4 = 2 * (m0 + u) + hi; const f32x4 a4 = A2L4[k4], w4 = wrow[k4 ^ swz]; const f32x4 x = x4[u];
                ssq += (x.x * x.x + x.y * x.y) + (x.z * x.z + x.w * x.w);
                acc = __builtin_amdgcn_mfma_f32_32x32x2f32(w4.x, x.x * a4.x, acc, 0, 0, 0); acc = __builtin_amdgcn_mfma_f32_32x32x2f32(w4.y, x.y * a4.y, acc, 0, 0, 0);
                acc = __builtin_amdgcn_mfma_f32_32x32x2f32(w4.z, x.z * a4.z, acc, 0, 0, 0); acc = __builtin_amdgcn_mfma_f32_32x32x2f32(w4.w, x.w * a4.w, acc, 0, 0, 0); }
        }
        const float rstd = rsqrtf(sum32(ssq, ssq) * (1.f / DM) + EPS);
        float lg[16];
#pragma unroll
        for (int r = 0; r < 16; ++r) lg[r] = acc[r] * rstd + CBL[(r & 3) + 8 * (r >> 2) + 4 * hi];
        float tv[4], pv[4]; int te[4], pe[4];
        top4_of16(lg, hi, tv, te);
#pragma unroll
        for (int k = 0; k < 4; ++k) { pv[k] = __uint_as_float(xu32(__float_as_uint(tv[k]), lane)); pe[k] = (int)xu32((unsigned)te[k], lane); }
        float cv[8] = {tv[0], tv[1], tv[2], tv[3], pv[0], pv[1], pv[2], pv[3]}; int ce[8] = {te[0], te[1], te[2], te[3], pe[0], pe[1], pe[2], pe[3]};
        float gv[4]; int ge[4];
#pragma unroll
        for (int k = 0; k < 4; ++k) { float best = cv[0]; int be = ce[0];
#pragma unroll
            for (int c = 1; c < 8; ++c) { const bool bt = cv[c] > best || (cv[c] == best && ce[c] < be); best = bt ? cv[c] : best; be = bt ? ce[c] : be; }
            gv[k] = best; ge[k] = be;
#pragma unroll
            for (int c = 0; c < 8; ++c) cv[c] = (ce[c] == be) ? -3.0e38f : cv[c]; }
        const float x1 = __expf(gv[1] - gv[0]), x2 = __expf(gv[2] - gv[0]), x3 = __expf(gv[3] - gv[0]); const float inv = 1.f / (1.f + x1 + x2 + x3);
        {
            const int ea = hi ? ge[2] : ge[0], eb = hi ? ge[3] : ge[1]; const float ga = hi ? x2 * inv : inv, gb = hi ? x3 * inv : x1 * inv;
            const int ra = __hip_atomic_fetch_add(hist + ea, 1, __ATOMIC_RELAXED, __HIP_MEMORY_SCOPE_WORKGROUP), rb2 = __hip_atomic_fetch_add(hist + eb, 1, __ATOMIC_RELAXED, __HIP_MEMORY_SCOPE_WORKGROUP);
            const int rl = F.wave * 32 + r32;
            sel[rl * 4 + 2 * hi] = (u32x2){(unsigned)ea | ((unsigned)ra << 8), __float_as_uint(ga)}; sel[rl * 4 + 2 * hi + 1] = (u32x2){(unsigned)eb | ((unsigned)rb2 << 8), __float_as_uint(gb)};
            if (hi == 0) RSL[rl] = rstd;
        }
        {
            f32x4 Ar[4], Sr[4];
#pragma unroll
            for (int j = 0; j < 4; ++j) { Ar[j] = Ap[lane + 64 * j]; Sr[j] = shp[lane + 64 * j]; }
            for (int rr = 0; rr < 32; rr += 2) {
                const int rw = pan * 256 + F.wave * 32 + rr; f32x4 v[2][4];
#pragma unroll
                for (int t = 0; t < 2; ++t) { const f32x4* xr = (const f32x4*)(XR + (size_t)(rw + t) * DM) + lane;
#pragma unroll
                    for (int j = 0; j < 4; ++j) v[t][j] = xr[64 * j]; }
#pragma unroll
                for (int t = 0; t < 2; ++t) { const float rs = RSL[F.wave * 32 + rr + t]; f32x4 h[4];
#pragma unroll
                    for (int j = 0; j < 4; ++j) h[j] = v[t][j] * rs * Ar[j] + Sr[j];
                    if constexpr (MOE_FP8 != 0) { unsigned* o4 = (unsigned*)((unsigned char*)H + (size_t)(rw + t) * DM) + lane;
#pragma unroll
                        for (int j = 0; j < 4; ++j) o4[64 * j] = pk4_fp8(h[j].x * 4.f, h[j].y * 4.f, h[j].z * 4.f, h[j].w * 4.f); }
                    else store_h_row(H + (size_t)(rw + t) * DM, lane, h); }
            }
        }
        __syncthreads();
        if (F.tid < 32) { const int c = hist[F.tid]; base[F.tid] = c ? (int)__hip_atomic_fetch_add(gcnt + F.tid, (unsigned)c, __ATOMIC_RELAXED, __HIP_MEMORY_SCOPE_AGENT) : 0; }
        __syncthreads();
        for (int u = F.tid; u < 1024; u += 512) { const u32x2 sv = sel[u]; const int e = (int)(sv.x & 0xffu), pos = base[e] + (int)(sv.x >> 8), r = pan * 256 + (u >> 2);
            rowl[(size_t)e * ROWCAP + pos] = r; toki[(size_t)r * 4 + (u & 3)] = (u32x2){((unsigned)e << 20) | (unsigned)pos, sv.y}; }
        __syncthreads();
        if (F.tid < 32) hist[F.tid] = 0;
    }
    __syncthreads();
}

__device__ __forceinline__ void p_qk_prep(Frame& F) {
    bf16_t* P = (bf16_t*)(F.ws + WS_PBUF); const f32x2* tab = (const f32x2*)(F.ws + WS_TABG);
    const int lane = F.lane, sub = lane >> 4, a = lane & 15, gw = F.bid * 8 + F.wave, NGW = F.G * 8;
    const float* pq = INP(I_GQG); const float* pk = INP(I_GKG);
    float gq[8], gk[8], gqp[8], gkp[8];
#pragma unroll
    for (int j = 0; j < 8; ++j) { gq[j] = pq[8 * a + j]; gk[j] = pk[8 * a + j]; gqp[j] = pq[8 * (a ^ 4) + j]; gkp[j] = pk[8 * (a ^ 4) + j]; }
    const bool isx2 = (a & 4) != 0; const int fi = 8 * (a & 3);
    for (int rp = gw; rp < NTOK / 2; rp += NGW) {
#pragma unroll
        for (int g = 0; g < 3; ++g) {
            const int it = g * 4 + sub, hi6 = it >= 6 ? 1 : 0, r = rp * 2 + hi6, s = it - 6 * hi6;
            const int b = r / TPB, pos = r - b * TPB; const bool lat = pos >= CTXL; const int t = pos - CTXL;
            bf16_t* ptr = P + (size_t)r * 2048 + 1024 + s * 128 + 8 * a;
            const u32x4 w = *(const u32x4*)ptr; u32x4 wp;
#pragma unroll
            for (int q = 0; q < 4; ++q) wp[q] = (unsigned)__shfl_xor((int)w[q], 4);
            float x[8], xp[8];
#pragma unroll
            for (int q = 0; q < 4; ++q) { x[2 * q] = bflo(w[q]); x[2 * q + 1] = bfhi(w[q]); xp[2 * q] = bflo(wp[q]); xp[2 * q + 1] = bfhi(wp[q]); }
            float ss = 0.f;
#pragma unroll
            for (int j = 0; j < 8; ++j) ss += x[j] * x[j];
            ss += __shfl_xor(ss, 1); ss += __shfl_xor(ss, 2); ss += __shfl_xor(ss, 4); ss += __shfl_xor(ss, 8);
            const float rstd = rsqrtf(ss * (1.f / 128.f) + EPS); const bool isq = s < 4;
            float o[8];
#pragma unroll
            for (int j = 0; j < 8; ++j) { o[j] = x[j] * rstd * (isq ? gq[j] : gk[j]); xp[j] = xp[j] * rstd * (isq ? gqp[j] : gkp[j]); }
            if (lat) {
                const int pp = (a & 8) ? (t & 63) : (t >> 6); const f32x4* tp = (const f32x4*)(tab + pp * 32 + fi);
#pragma unroll
                for (int q = 0; q < 4; ++q) { const f32x4 cs = tp[q];
                    const float s0 = isx2 ? cs.y : -cs.y, s1 = isx2 ? cs.w : -cs.w;
                    o[2 * q] = o[2 * q] * cs.x + xp[2 * q] * s0; o[2 * q + 1] = o[2 * q + 1] * cs.z + xp[2 * q + 1] * s1; }
            }
            u32x4 wo; wo.x = cvtpk(o[0], o[1]); wo.y = cvtpk(o[2], o[3]); wo.z = cvtpk(o[4], o[5]); wo.w = cvtpk(o[6], o[7]);
            *(u32x4*)ptr = wo;
        }
    }
}
__device__ __forceinline__ void p_mla_prep(Frame& F) {
    bf16_t* P = (bf16_t*)(F.ws + WS_PBUF); bf16_t* KR = (bf16_t*)(F.ws + WS_KRB); const f32x2* tab = (const f32x2*)(F.ws + WS_TABM);
    const int gw = F.bid * 8 + F.wave, NGW = F.G * 8, lane = F.lane;
    const float* pqg = INP(I_MLAQG); const float* pkg = INP(I_MLAKVG);
    float qg[8], kg[4];
#pragma unroll
    for (int j = 0; j < 8; ++j) qg[j] = pqg[8 * lane + j];
#pragma unroll
    for (int j = 0; j < 4; ++j) kg[j] = pkg[4 * lane + j];
    const int krow = (lane >> 3) & 3, ka = lane & 7; const bool kx2 = (ka & 2) != 0; const int kfi = 8 * (ka & 1);
    for (int r0 = gw * 4; r0 < NTOK; r0 += NGW * 4) {
        const int b = r0 / TPB, pos0 = r0 - b * TPB; const bool lat = pos0 >= CTXL;
        u32x4 wq[4]; u32x2 wk[4];
#pragma unroll
        for (int rr = 0; rr < 4; ++rr) { const bf16_t* base = P + (size_t)(r0 + rr) * 1024; wk[rr] = *(const u32x2*)(base + 512 + 4 * lane); if (lat) wq[rr] = *(const u32x4*)(base + 8 * lane); }
        u32x4 wr = (u32x4){0u, 0u, 0u, 0u};
        if (lane < 32) wr = *(const u32x4*)(P + (size_t)(r0 + krow) * 1024 + 768 + 8 * ka);
        if (lat) {
#pragma unroll
            for (int rr = 0; rr < 4; ++rr) { float x[8];
#pragma unroll
                for (int q = 0; q < 4; ++q) { x[2 * q] = bflo(wq[rr][q]); x[2 * q + 1] = bfhi(wq[rr][q]); }
                float ss = 0.f;
#pragma unroll
                for (int j = 0; j < 8; ++j) ss += x[j] * x[j];
                const float rstd = rsqrtf(wave_sum(ss) * (1.f / 512.f) + EPS);
                u32x4 w;
#pragma unroll
                for (int q = 0; q < 4; ++q) w[q] = cvtpk(x[2 * q] * rstd * qg[2 * q], x[2 * q + 1] * rstd * qg[2 * q + 1]);
                *(u32x4*)(P + (size_t)(r0 + rr) * 1024 + 8 * lane) = w; }
        }
#pragma unroll
        for (int rr = 0; rr < 4; ++rr) { const float x0 = bflo(wk[rr].x), x1 = bfhi(wk[rr].x), x2 = bflo(wk[rr].y), x3 = bfhi(wk[rr].y);
            const float rstd = rsqrtf(wave_sum((x0 * x0 + x1 * x1) + (x2 * x2 + x3 * x3)) * (1.f / 256.f) + EPS);
            u32x2 w; w.x = cvtpk(x0 * rstd * kg[0], x1 * rstd * kg[1]); w.y = cvtpk(x2 * rstd * kg[2], x3 * rstd * kg[3]);
            *(u32x2*)(P + (size_t)(r0 + rr) * 1024 + 512 + 4 * lane) = w; }
        {
            u32x4 wp;
#pragma unroll
            for (int q = 0; q < 4; ++q) wp[q] = (unsigned)__shfl_xor((int)wr[q], 2);
            float o[8], xp[8];
#pragma unroll
            for (int q = 0; q < 4; ++q) { o[2 * q] = bflo(wr[q]); o[2 * q + 1] = bfhi(wr[q]); xp[2 * q] = bflo(wp[q]); xp[2 * q + 1] = bfhi(wp[q]); }
            if (lat) { const int t = pos0 + krow - CTXL, pp = (ka & 4) ? (t & 63) : (t >> 6); const f32x4* tp = (const f32x4*)(tab + pp * 16 + kfi);
#pragma unroll
                for (int q = 0; q < 4; ++q) { const f32x4 cs = tp[q]; const float s0 = kx2 ? cs.y : -cs.y, s1 = kx2 ? cs.w : -cs.w;
                    o[2 * q] = o[2 * q] * cs.x + xp[2 * q] * s0; o[2 * q + 1] = o[2 * q + 1] * cs.z + xp[2 * q + 1] * s1; } }
            u32x4 wo; wo.x = cvtpk(o[0], o[1]); wo.y = cvtpk(o[2], o[3]); wo.z = cvtpk(o[4], o[5]); wo.w = cvtpk(o[6], o[7]);
            if (lane < 32) *(u32x4*)(KR + (size_t)(r0 + krow) * 64 + 8 * ka) = wo;
        }
    }
}
__device__ __forceinline__ void p_sgu(Frame& F) {
    const bf16_t* P = (const bf16_t*)(F.ws + WS_PBUF); bf16_t* MIX = (bf16_t*)(F.ws + WS_MIX0); const bf16_t* SW = (const bf16_t*)(F.ws + WS_SGUW);
    const int tid = F.tid, lane = F.lane, wid = F.wave, hw = wid >> 2, w4 = wid & 3, th = tid & 255, r32 = lane & 31, hi = lane >> 5;
    LAS char* Vl = (LAS char*)F.lds + hw * 32768;
    const int sr = th >> 4, sc = (th & 15) * 8;
    const int vb0 = (int)(unsigned)(uintptr_t)Vl + att::v_rd_base(lane);
    const float* psg = INP(I_SGUNG); const float* psb = INP(I_SGUB);
    for (int U = F.bid; U < (NTOK / 128) * 2; U += F.G) {
        const int chunk = U >> 1, g = (U & 1) * 2 + hw; const size_t row0 = (size_t)chunk * 128;
        float gn[8];
#pragma unroll
        for (int j = 0; j < 8; ++j) gn[j] = psg[g * 128 + sc + j];
        __syncthreads();
#pragma unroll
        for (int i = 0; i < 8; ++i) {
            const int q = sr + 16 * i;
            u32x4 w = *(const u32x4*)(P + (row0 + q) * 2048 + 512 + g * 128 + sc); float x[8];
#pragma unroll
            for (int k = 0; k < 4; ++k) { x[2 * k] = bflo(w[k]); x[2 * k + 1] = bfhi(w[k]); }
            float ss = 0.f;
#pragma unroll
            for (int j = 0; j < 8; ++j) ss += x[j] * x[j];
            ss += __shfl_xor(ss, 1); ss += __shfl_xor(ss, 2); ss += __shfl_xor(ss, 4); ss += __shfl_xor(ss, 8);
            const float rstd = rsqrtf(ss * (1.f / 128.f) + EPS);
#pragma unroll
            for (int k = 0; k < 4; ++k) w[k] = cvtpk(x[2 * k] * rstd * gn[2 * k], x[2 * k + 1] * rstd * gn[2 * k + 1]);
            *(LAS u32x4*)(Vl + (q >> 6) * 16384 + att::v_st(q & 63, sc)) = w;
        }
        bf16x8 pa[8];
        const bf16_t* wrow = SW + ((size_t)g * 128 + 32 * w4 + r32) * 128 + 8 * hi;
#pragma unroll
        for (int k = 0; k < 8; ++k) pa[k] = *(const bf16x8*)(wrow + 16 * k);
        __syncthreads();
        f32x16 o[4] = {};
        att::pv_d0(o, vb0, pa[0], pa[1], pa[2], pa[3]);
        att::pv_d0(o, vb0 + 16384, pa[4], pa[5], pa[6], pa[7]);
#pragma unroll
        for (int r = 0; r < 16; ++r) { const int p = 32 * w4 + att::crow(r, hi); const float bs = psb[g * 128 + p];
#pragma unroll
            for (int d0 = 0; d0 < 4; ++d0) { const int c = d0 * 32 + r32; const float zu = bf2f(P[(row0 + p) * 2048 + g * 128 + c]);
                MIX[(row0 + p) * 1024 + g * 128 + c] = f2bf((o[d0][r] + bs) * zu); } }
    }
    __syncthreads();
}

using pg8::Unit; using pg8::Acc;
struct ProbIn0 {
    static constexpr bool PERM = true, GATHER = false, FP8 = false; int K, lda; const bf16_t* A; const bf16_t* Bt; bf16_t* O; pg8::StaticOrder so; int G, c;
    __device__ bool next(int i, Unit& u) const { return so.map((long)i * G + c, u.pm, u.pn); }
    __device__ const void* a_mat() const { return A; } __device__ const void* b_mat() const { return Bt; }
    __device__ unsigned a_off(const Unit& u) const { return (unsigned)u.pm * 256u * (unsigned)lda * 2u; }
    __device__ unsigned b_off(const Unit& u) const { return (unsigned)u.pn * 256u * (unsigned)K * 2u; }
    __device__ void a_voff(const Unit&, unsigned (&)[2][2]) const {}
    __device__ void epi(const Acc& acc, const Unit& u, int wr, int wc, int fr, int fq) const {
        bf16_t* dst = O + (size_t)u.pm * 256 * 2048 + u.pn * 256;
        if (u.pn < 4) pg8::epi_store_bf16<true>(acc, dst, 2048, nullptr, wr, wc, fr, fq); else pg8::epi_store_bf16<false>(acc, dst, 2048, nullptr, wr, wc, fr, fq);
    }
};
template <bool LATONLY> struct ProbPlain {
    static constexpr bool PERM = true, GATHER = false, FP8 = false; int K, lda; const bf16_t* A; const bf16_t* Bt; bf16_t* O; int ldc; pg8::StaticOrder so; int G, c;
    __device__ bool next(int i, Unit& u) const { int pm; if (!so.map((long)i * G + c, pm, u.pn)) return false; u.pm = LATONLY ? pm + pm / 8 + 1 : pm; return true; }
    __device__ const void* a_mat() const { return A; } __device__ const void* b_mat() const { return Bt; }
    __device__ unsigned a_off(const Unit& u) const { return (unsigned)u.pm * 256u * (unsigned)lda * 2u; }
    __device__ unsigned b_off(const Unit& u) const { return (unsigned)u.pn * 256u * (unsigned)K * 2u; }
    __device__ void a_voff(const Unit&, unsigned (&)[2][2]) const {}
    __device__ void epi(const Acc& acc, const Unit& u, int wr, int wc, int fr, int fq) const {
        pg8::epi_store_bf16<false>(acc, O + (size_t)u.pm * 256 * ldc + u.pn * 256, ldc, nullptr, wr, wc, fr, fq);
    }
};
struct ProbIn1 {
    static constexpr bool PERM = true, GATHER = false, FP8 = false; int K, lda; const bf16_t* A; const bf16_t* Bt; bf16_t* O; pg8::StaticOrder so; int G, c;
    __device__ bool next(int i, Unit& u) const {
        const long L = (long)i * G + c;
        if (L < 1024) { int pm; so.map(L, pm, u.pn); u.pm = pm + pm / 8 + 1; return true; }
        if (L < 1024 + 64) { const int q = (int)(L - 1024); u.pm = (q >> 1) * 9; u.pn = 2 + (q & 1); return true; }
        return false;
    }
    __device__ const void* a_mat() const { return A; } __device__ const void* b_mat() const { return Bt; }
    __device__ unsigned a_off(const Unit& u) const { return (unsigned)u.pm * 256u * (unsigned)lda * 2u; }
    __device__ unsigned b_off(const Unit& u) const { return (unsigned)u.pn * 256u * (unsigned)K * 2u; }
    __device__ void a_voff(const Unit&, unsigned (&)[2][2]) const {}
    __device__ void epi(const Acc& acc, const Unit& u, int wr, int wc, int fr, int fq) const {
        pg8::epi_store_bf16<false>(acc, O + (size_t)u.pm * 256 * 1024 + u.pn * 256, 1024, nullptr, wr, wc, fr, fq);
    }
};
template <int LAYER> struct ProbOut {
    static constexpr bool PERM = false, GATHER = false, FP8 = false; int K, lda; const bf16_t* A; const bf16_t* Bt; float* XR; const float* MOD; const float* xin; const float* cin; pg8::StaticOrder so; int G, c; float* dryout;
    __device__ bool next(int i, Unit& u) const { int pm; if (!so.map((long)i * G + c, pm, u.pn)) return false; u.pm = LAYER ? pm + pm / 8 + 1 : pm; return true; }
    __device__ const void* a_mat() const { return A; } __device__ const void* b_mat() const { return Bt; }
    __device__ unsigned a_off(const Unit& u) const { return (unsigned)u.pm * 256u * (unsigned)lda * 2u; }
    __device__ unsigned b_off(const Unit& u) const { return (unsigned)u.pn * 256u * (unsigned)K * 2u; }
    __device__ void a_voff(const Unit&, unsigned (&)[2][2]) const {}
    __device__ void epi(const Acc& acc, const Unit& u, int wr, int wc, int fr, int fq) const {
        const int b = u.pm / 9, jj = u.pm % 9, mj = jj == 0 ? 32 : b;
        const float* base = LAYER ? XR + (size_t)u.pm * 256 * DM : (jj == 0 ? cin + (size_t)b * CTXL * DM : xin + ((size_t)b * SEQ + (jj - 1) * 256) * DM);
        float* dst = (LAYER && dryout) ? dryout + ((size_t)b * SEQ + (jj - 1) * 256) * DM : XR + (size_t)u.pm * 256 * DM; const float* gate = MOD + ((size_t)(LAYER * 33 + mj) * 6 + 2) * 1024;
        const int row0 = wr * 64 + fr, col0 = u.pn * 256 + wc * 32 + 4 * fq;
        f32x4 gv[2][2];
#pragma unroll
        for (int bj = 0; bj < 2; ++bj)
#pragma unroll
            for (int n = 0; n < 2; ++n) gv[bj][n] = *(const f32x4*)(gate + col0 + bj * 128 + n * 16);
#pragma unroll
        for (int ai = 0; ai < 2; ++ai)
#pragma unroll
            for (int m = 0; m < 4; ++m) { const size_t off = (size_t)(row0 + ai * 128 + m * 16) * DM + col0;
#pragma unroll
                for (int bj = 0; bj < 2; ++bj)
#pragma unroll
                    for (int n = 0; n < 2; ++n) { const f32x4 bs = *(const f32x4*)(base + off + bj * 128 + n * 16); *(f32x4*)(dst + off + bj * 128 + n * 16) = bs + gv[bj][n] * acc[ai][bj][m][n]; } }
    }
};
struct MoeSched {
    const LAS int* pb; int NTN, G, c;
    __device__ bool map(int i, Unit& u) const {
        const long L = (long)i * G + c; const int blk = (int)(L / NTN); u.pn = (int)(L % NTN);
        if (blk >= __builtin_amdgcn_readfirstlane(pb[32])) return false;
        int lo = 0;
#pragma unroll
        for (int st = 16; st >= 1; st >>= 1) { if (__builtin_amdgcn_readfirstlane(pb[lo + st]) <= blk) lo += st; }
        u.e = lo; u.rb = blk - __builtin_amdgcn_readfirstlane(pb[lo]); u.pm = blk; return true;
    }
};
struct ProbMoe1 {
    static constexpr bool PERM = true, GATHER = true, FP8 = MOE_FP8 != 0; int K, lda; const bf16_t* H; const bf16_t* W1; const float* B1; bf16_t* ACT; const int* rowl; const LAS int* cnt; MoeSched ms; int wave_s;
    __device__ bool next(int i, Unit& u) const { return ms.map(i, u); }
    __device__ const void* a_mat() const { return H; } __device__ const void* b_mat() const { return W1; }
    __device__ unsigned a_off(const Unit&) const { return 0u; }
    __device__ unsigned b_off(const Unit& u) const { return ((unsigned)u.e * 2048u + (unsigned)u.pn * 256u) * 1024u * (FP8 ? 1u : 2u); }
    __device__ void a_voff(const Unit& u, unsigned (&vo)[2][2]) const {
        const int n = cnt[u.e]; const int* rl = rowl + (size_t)u.e * ROWCAP + u.rb * 256;
        const int tidg = tid_fresh(wave_s);
#pragma unroll
        for (int i = 0; i < 2; ++i) { int R, C; pg8::stage_rc(tidg * 16 + i * 8192, R, C);
#pragma unroll
            for (int h = 0; h < 2; ++h) { const int ri = h * 128 + R; const int tok = (u.rb * 256 + ri < n) ? rl[ri] : 0; vo[h][i] = (unsigned)tok * (FP8 ? 1024u : 2048u) + (unsigned)C * 2u; } }
    }
    __device__ void epi(const Acc& acc, const Unit& u, int wr, int wc, int fr, int fq) const {
        const int row0 = wr * 64 + fr, col0 = u.pn * 128 + wc * 32 + 8 * fq;
        const float* bg = B1 + (size_t)u.e * 2048 + col0; const float* bl = bg + 1024;
        f32x4 bgv[2], blv[2];
#pragma unroll
        for (int n = 0; n < 2; ++n) { bgv[n] = *(const f32x4*)(bg + 4 * n); blv[n] = *(const f32x4*)(bl + 4 * n); }
        constexpr float SC = FP8 ? (1.f / 256.f) : 1.f;
        bf16_t* dst = ACT + (size_t)u.pm * 256 * 1024 + col0; unsigned char* dst8 = (unsigned char*)ACT + (size_t)u.pm * 256 * 1024 + col0;
#pragma unroll
        for (int ai = 0; ai < 2; ++ai)
#pragma unroll
            for (int m = 0; m < 4; ++m) { float a[8];
#pragma unroll
                for (int n = 0; n < 2; ++n) { const f32x4 g = acc[ai][0][m][n] * SC + bgv[n], l = acc[ai][1][m][n] * SC + blv[n];
#pragma unroll
                    for (int j = 0; j < 4; ++j) { const float gg = fminf(g[j], 7.f), ll = fminf(fmaxf(l[j], -7.f), 7.f);
                        a[4 * n + j] = gg * __builtin_amdgcn_rcpf(1.f + __builtin_amdgcn_exp2f(-1.702f * 1.4426950408889634f * gg)) * (ll + 1.f); } }
                if constexpr (FP8) { u32x2 w; w.x = pk4_fp8(a[0] * 8.f, a[1] * 8.f, a[2] * 8.f, a[3] * 8.f); w.y = pk4_fp8(a[4] * 8.f, a[5] * 8.f, a[6] * 8.f, a[7] * 8.f);
                    *(u32x2*)(dst8 + (size_t)(row0 + ai * 128 + m * 16) * 1024) = w; }
                else { u32x4 w; w.x = cvtpk(a[0], a[1]); w.y = cvtpk(a[2], a[3]); w.z = cvtpk(a[4], a[5]); w.w = cvtpk(a[6], a[7]);
                    *(u32x4*)(dst + (size_t)(row0 + ai * 128 + m * 16) * 1024) = w; } }
    }
};
struct ProbMoe2 {
    static constexpr bool PERM = true, GATHER = false, FP8 = MOE_FP8 != 0; int K, lda; const bf16_t* ACT; const bf16_t* W2; const float* B2; bf16_t* Y; MoeSched ms;
    __device__ bool next(int i, Unit& u) const { return ms.map(i, u); }
    __device__ const void* a_mat() const { return ACT; } __device__ const void* b_mat() const { return W2; }
    __device__ unsigned a_off(const Unit& u) const { return (unsigned)u.pm * 256u * 1024u * (FP8 ? 1u : 2u); }
    __device__ unsigned b_off(const Unit& u) const { return ((unsigned)u.e * 1024u + (unsigned)u.pn * 256u) * 1024u * (FP8 ? 1u : 2u); }
    __device__ void a_voff(const Unit&, unsigned (&)[2][2]) const {}
    __device__ void epi(const Acc& acc, const Unit& u, int wr, int wc, int fr, int fq) const {
        pg8::epi_store_bf16<false>(acc, Y + (size_t)u.pm * 256 * 1024 + u.pn * 256, 1024, B2 + (size_t)u.e * 1024 + u.pn * 256, wr, wc, fr, fq, FP8 ? (1.f / 512.f) : 1.f);
    }
};

__global__ void __launch_bounds__(512, 2) fwd_kernel(Args args) {
    extern __shared__ __attribute__((aligned(16))) uchar lds_raw[];
    const int wave_s = __builtin_amdgcn_readfirstlane((int)threadIdx.x >> 6);
    Frame F; F.lds = (LAS uchar*)lds_raw; F.tid = tid_fresh(wave_s); F.lane = F.tid & 63; F.wave = wave_s; F.G = gridDim.x; F.bid = blockIdx.x;
    F.ws = args.ws; F.out = args.out;
    volatile LAS unsigned* MISC = (volatile LAS unsigned*)(F.lds + MISC_OFF);
    if (F.tid < 64) MISC[F.tid] = 0u;
    __syncthreads();
    unsigned* ctl = (unsigned*)(F.ws + WS_CTL);
    XcdBarrier bar; bar.bar = ctl + CW_BAR; bar.x = 0; bar.st = nullptr;
    const int lo = args.ph_lo, hi = args.ph_hi;
    if (hi - lo > 1) bar = xcd_barrier_post(ctl + CW_BAR, MISC + 8, F.tid == 0);
#ifndef PHMASK
#define PHMASK 0x7ffff
#endif
#define REFRAME() do { F.tid = tid_fresh(wave_s); F.lane = F.tid & 63; F.wave = wave_s; } while (0)
#define IN(k) (((PHMASK >> (k)) & 1) && lo <= (k) && (k) < hi)
#define SEAM(k) do { if (IN(k) && IN((k) + 1)) { const int t_ = tid_fresh(wave_s); xcd_barrier(bar, t_ == 0); } } while (0)
    uchar* ws = F.ws;
    bf16_t* H = (bf16_t*)(ws + WS_H); float* XR = (float*)(ws + WS_XR); const float* MOD = (const float*)(ws + WS_MOD);

    if (IN(0)) { REFRAME(); p0_prologue(F); } SEAM(0);
    if (IN(1)) { REFRAME(); p_norm0(F); } SEAM(1);
    if (IN(2)) { REFRAME(); ProbIn0 p; p.K = 1024; p.lda = 1024; p.A = H; p.Bt = (const bf16_t*)(ws + WS_WIN0); p.O = (bf16_t*)(ws + WS_PBUF); p.so.init(NPAN, 8); p.G = F.G; p.c = F.bid; pg8::gemm_phase(F.lds, p, wave_s); } SEAM(2);
    if (IN(3)) { REFRAME(); p_qk_prep(F); } SEAM(3);
    if (IN(4)) { REFRAME();
        const bf16_t* P = (const bf16_t*)(ws + WS_PBUF); bf16_t* MIX = (bf16_t*)(ws + WS_MIX0);
        for (int u = F.bid; u < 1024 + 128; u += F.G) {
            if (u < 1024) { const int qb = u & 7, g = (u >> 3) & 1, kvh = (u >> 4) & 1, b = u >> 5, h = kvh * 2 + g; const size_t kr0 = (size_t)b * TPB, qr0 = kr0 + CTXL + qb * 256;
                att::attn_unit<128, 2, false, 2048, 2048, 1024>(P + qr0 * 2048 + 1024 + h * 128, P + kr0 * 2048 + 1536 + kvh * 128, nullptr, P + kr0 * 2048 + 1792 + kvh * 128, MIX + qr0 * 1024 + 512 + h * 128, TPB, (LAS char*)F.lds, nullptr, 0, wave_s);
            } else { const int v = u - 1024, h = v & 3, b = v >> 2, kvh = h >> 1; const size_t kr0 = (size_t)b * TPB;
                att::attn_unit<128, 2, false, 2048, 2048, 1024>(P + kr0 * 2048 + 1024 + h * 128, P + kr0 * 2048 + 1536 + kvh * 128, nullptr, P + kr0 * 2048 + 1792 + kvh * 128, MIX + kr0 * 1024 + 512 + h * 128, CTXL, (LAS char*)F.lds, nullptr, 0, wave_s); }
        }
        REFRAME(); p_sgu(F);
    } SEAM(4);
    if (IN(5)) { REFRAME(); ProbOut<0> p; p.K = 1024; p.lda = 1024; p.A = (const bf16_t*)(ws + WS_MIX0); p.Bt = (const bf16_t*)(ws + WS_WOUT0); p.XR = XR; p.MOD = MOD; p.xin = INP(I_X); p.cin = INP(I_CTX); p.dryout = nullptr; p.so.init(NPAN, 4); p.G = F.G; p.c = F.bid; pg8::gemm_phase(F.lds, p, wave_s); } SEAM(5);
    if (IN(6)) { REFRAME(); p_norm_router<0>(F, args.dry); } SEAM(6);
    if (IN(7)) { REFRAME(); moe_prefix(F, 0); ProbMoe1 p; p.K = MOE_FP8 ? 512 : 1024; p.lda = p.K; p.H = H; p.W1 = (const bf16_t*)(ws + WS_W1); p.B1 = INP(I_B1); p.ACT = (bf16_t*)(ws + WS_ACT); p.rowl = (const int*)(ws + WS_ROWL);
        p.cnt = (const LAS int*)(F.lds + XTRA_OFF + X_CNT); p.wave_s = wave_s; p.ms.pb = (const LAS int*)(F.lds + XTRA_OFF + X_PB); p.ms.NTN = 8; p.ms.G = F.G; p.ms.c = F.bid; pg8::gemm_phase(F.lds, p, wave_s); } SEAM(7);
    if (IN(8)) { REFRAME(); moe_prefix(F, 0); ProbMoe2 p; p.K = MOE_FP8 ? 512 : 1024; p.lda = p.K; p.ACT = (const bf16_t*)(ws + WS_ACT); p.W2 = (const bf16_t*)(ws + WS_W2); p.B2 = INP(I_B2); p.Y = (bf16_t*)(ws + WS_Y);
        p.ms.pb = (const LAS int*)(F.lds + XTRA_OFF + X_PB); p.ms.NTN = 4; p.ms.G = F.G; p.ms.c = F.bid; pg8::gemm_phase(F.lds, p, wave_s); } SEAM(8);
    if (IN(9)) { REFRAME(); p_combine_norm(F, args.dry); } SEAM(9);
    if (IN(10)) { REFRAME(); ProbIn1 p; p.K = 1024; p.lda = 1024; p.A = H; p.Bt = (const bf16_t*)(ws + WS_WIN1); p.O = (bf16_t*)(ws + WS_PBUF); p.so.init(256, 4); p.G = F.G; p.c = F.bid; pg8::gemm_phase(F.lds, p, wave_s); } SEAM(10);
    if (IN(11)) { REFRAME(); p_mla_prep(F); } SEAM(11);
    if (IN(12)) { REFRAME();
        { ProbPlain<true> p; p.K = 512; p.lda = 1024; p.A = (const bf16_t*)(ws + WS_PBUF); p.Bt = (const bf16_t*)(ws + WS_WUQ); p.O = (bf16_t*)(ws + WS_QB); p.ldc = 1536; p.so.init(256, 6); p.G = F.G; p.c = F.bid; pg8::gemm_phase(F.lds, p, wave_s); }
        { ProbPlain<false> p; p.K = 256; p.lda = 1024; p.A = (const bf16_t*)(ws + WS_PBUF) + 512; p.Bt = (const bf16_t*)(ws + WS_WUKV); p.O = (bf16_t*)(ws + WS_KVB); p.ldc = 2048; p.so.init(NPAN, 8); p.G = F.G; p.c = F.bid; pg8::gemm_phase(F.lds, p, wave_s); }
    } SEAM(12);
    if (IN(13)) { REFRAME();
        const bf16_t* Q = (const bf16_t*)(ws + WS_QB); const bf16_t* KV = (const bf16_t*)(ws + WS_KVB); const bf16_t* KR = (const bf16_t*)(ws + WS_KRB); bf16_t* MIX = (bf16_t*)(ws + WS_MIX1);
        for (int u = F.bid; u < 2048; u += F.G) { const int qb = u & 7, h = (u >> 3) & 7, b = u >> 6; const size_t kr0 = (size_t)b * TPB, qr0 = kr0 + CTXL + qb * 256;
            att::attn_unit<192, 1, true, 1536, 2048, 1024>(Q + qr0 * 1536 + h * 192, KV + kr0 * 2048 + h * 128, KR + kr0 * 64, KV + kr0 * 2048 + 1024 + h * 128, MIX + qr0 * 1024 + h * 128, TPB, (LAS char*)F.lds, (const f32x2*)(ws + WS_TABM), qb * 256, wave_s); }
    } SEAM(13);
    if (IN(14)) { REFRAME(); ProbOut<1> p; p.K = 1024; p.lda = 1024; p.A = (const bf16_t*)(ws + WS_MIX1); p.Bt = (const bf16_t*)(ws + WS_WOUT1); p.XR = XR; p.MOD = MOD; p.xin = nullptr; p.cin = nullptr; p.dryout = args.dry ? F.out : nullptr; p.so.init(256, 4); p.G = F.G; p.c = F.bid; pg8::gemm_phase(F.lds, p, wave_s); } SEAM(14);
    if (IN(15)) { REFRAME(); p_norm_router<1>(F, args.dry); } SEAM(15);
    if (IN(16)) { REFRAME(); moe_prefix(F, 1); ProbMoe1 p; p.K = MOE_FP8 ? 512 : 1024; p.lda = p.K; p.H = H; p.W1 = (const bf16_t*)(ws + WS_W1 + (size_t)32 * 2048 * 1024 * (MOE_FP8 ? 1 : 2)); p.B1 = INP(I_B1) + 32 * 2048; p.ACT = (bf16_t*)(ws + WS_ACT); p.rowl = (const int*)(ws + WS_ROWL);
        p.cnt = (const LAS int*)(F.lds + XTRA_OFF + X_CNT); p.wave_s = wave_s; p.ms.pb = (const LAS int*)(F.lds + XTRA_OFF + X_PB); p.ms.NTN = 8; p.ms.G = F.G; p.ms.c = F.bid; pg8::gemm_phase(F.lds, p, wave_s); } SEAM(16);
    if (IN(17)) { REFRAME(); moe_prefix(F, 1); ProbMoe2 p; p.K = MOE_FP8 ? 512 : 1024; p.lda = p.K; p.ACT = (const bf16_t*)(ws + WS_ACT); p.W2 = (const bf16_t*)(ws + WS_W2 + (size_t)32 * 1024 * 1024 * (MOE_FP8 ? 1 : 2)); p.B2 = INP(I_B2) + 32 * 1024; p.Y = (bf16_t*)(ws + WS_Y);
        p.ms.pb = (const LAS int*)(F.lds + XTRA_OFF + X_PB); p.ms.NTN = 4; p.ms.G = F.G; p.ms.c = F.bid; pg8::gemm_phase(F.lds, p, wave_s); } SEAM(17);
    if (IN(18)) { REFRAME(); p_final(F); }
#undef IN
#undef SEAM
}

extern "C" void kernel_launch(void* const* d_in, const int* in_sizes, int n_in, void* d_out, int out_size, void* d_ws, size_t ws_size, hipStream_t stream) {
    static int grid = 0;
    if (grid == 0) {
        if (n_in != 28 || out_size != NBATCH * SEQ * DM || ws_size < WS_END) { fprintf(stderr, "kernel_launch: unexpected shapes (n_in %d out %d ws %zu, need ws >= %zu)\n", n_in, out_size, ws_size, (size_t)WS_END); grid = -1; return; }
        int dev = 0, cus = 0, per_cu = 0;
        if (hipGetDevice(&dev) != hipSuccess || hipDeviceGetAttribute(&cus, hipDeviceAttributeMultiprocessorCount, dev) != hipSuccess) { grid = -1; return; }
        if (hipFuncSetAttribute((const void*)fwd_kernel, hipFuncAttributeMaxDynamicSharedMemorySize, LDS_BYTES) != hipSuccess) { fprintf(stderr, "kernel_launch: hipFuncSetAttribute failed\n"); grid = -1; return; }
        if (hipOccupancyMaxActiveBlocksPerMultiprocessor(&per_cu, (const void*)fwd_kernel, 512, LDS_BYTES) != hipSuccess || per_cu < 1) { fprintf(stderr, "kernel_launch: occupancy query says %d blocks/CU\n", per_cu); }
        (void)hipGetLastError();
        grid = cus;
    }
    if (grid < 0) return;
    (void)hipMemsetAsync((char*)d_ws + WS_CTL, 0, CTL_BYTES, stream);
    Args a{};
    for (int i = 0; i < 28; ++i) a.in[i] = (const float*)d_in[i];
    a.out = (float*)d_out; a.ws = (uchar*)d_ws;
#if MK_ONE_LAUNCH
    a.ph_lo = 0; a.ph_hi = NPHASE;
    hipLaunchKernelGGL(fwd_kernel, dim3(grid), dim3(512), LDS_BYTES, stream, a);
#else
    for (int ph = 0; ph < NPHASE; ++ph) { a.ph_lo = ph; a.ph_hi = ph + 1; const int nrep = 1 + ((REPEAT_MASK >> ph) & 1); for (int rep = 0; rep < nrep; ++rep) { a.dry = (rep + 1 < nrep) ? 1 : 0; hipLaunchKernelGGL(fwd_kernel, dim3(grid), dim3(512), LDS_BYTES, stream, a); } }
#endif
}
```

```cpp
#include <hip/hip_runtime.h>
#include <cstdio>
#include <cstdint>

#ifndef MK_ONE_LAUNCH
#define MK_ONE_LAUNCH 1
#endif
#define REPEAT_MASK 0
#define USE_BUFFER_LDS 1
#define Y_FP8 1
#ifndef MOE_FP8
#define MOE_FP8 1
#endif

#define LAS __attribute__((address_space(3)))
typedef unsigned short bf16_t;
typedef unsigned char uchar;
typedef short bf16x8 __attribute__((ext_vector_type(8)));
typedef short s16x4 __attribute__((ext_vector_type(4)));
typedef float f32x2 __attribute__((ext_vector_type(2)));
typedef float f32x4 __attribute__((ext_vector_type(4)));
typedef float f32x16 __attribute__((ext_vector_type(16)));
typedef unsigned u32x2 __attribute__((ext_vector_type(2)));
typedef unsigned u32x4 __attribute__((ext_vector_type(4)));
typedef int i32x4 __attribute__((ext_vector_type(4)));
typedef int i32x8 __attribute__((ext_vector_type(8)));

constexpr int DM = 1024, NBATCH = 32, SEQ = 2048, CTXL = 256, TPB = SEQ + CTXL, NTOK = NBATCH * TPB, NPAN = NTOK / 256;
constexpr int NEXP = 32, TOPK = 4, ROWCAP = NTOK;
constexpr float EPS = 1e-6f;
constexpr int NPHASE = 19;

constexpr size_t MiB = 1u << 20;
constexpr size_t WS_CTL = 0, CTL_BYTES = 1 * MiB;
constexpr size_t WS_MOD = 1 * MiB;
constexpr size_t WS_TABG = 3 * MiB;
constexpr size_t WS_TABM = WS_TABG + 32768;
constexpr size_t WS_WRT = WS_TABG + 65536;
constexpr size_t WS_SGUW = WS_WRT + 262144;
constexpr size_t WS_WIN0 = 4 * MiB, WS_WOUT0 = 8 * MiB, WS_WIN1 = 10 * MiB, WS_WUQ = 12 * MiB, WS_WUKV = 14 * MiB, WS_WOUT1 = 15 * MiB;
constexpr size_t WS_W1 = 17 * MiB;
constexpr size_t WS_W2 = 273 * MiB;
constexpr size_t WS_ROWL = 401 * MiB;
constexpr size_t WS_TOKI = 410 * MiB;
constexpr size_t WS_XR = 413 * MiB;
constexpr size_t WS_H = 701 * MiB;
constexpr size_t WS_SCR = 845 * MiB;
constexpr size_t WS_PBUF = WS_SCR;
constexpr size_t WS_MIX0 = WS_SCR + 288 * MiB;
constexpr size_t WS_QB = WS_SCR + 144 * MiB;
constexpr size_t WS_KVB = WS_SCR + 360 * MiB;
constexpr size_t WS_KRB = WS_SCR + 648 * MiB;
constexpr size_t WS_MIX1 = WS_SCR + 660 * MiB;
constexpr size_t WS_ACT = WS_SCR;
constexpr size_t WS_Y = WS_SCR + 592 * MiB;
constexpr size_t WS_END = WS_SCR + 1184 * MiB;
constexpr int CW_BAR = 1024;
constexpr int CW_CNT = 8192;
constexpr int CW_DBG = 16384;

constexpr int RING_BYTES = 131072;
constexpr int XTRA_OFF = RING_BYTES, XTRA_BYTES = 20480;
constexpr int MISC_OFF = XTRA_OFF + XTRA_BYTES;
constexpr int LDS_BYTES = MISC_OFF + 512;
constexpr int X_PB = 0;
constexpr int X_CNT = 256;
constexpr int X_HIST = 512;
constexpr int X_BASE = 768;
constexpr int X_SEL = 1024;
constexpr int X_A2 = 9216;
constexpr int X_CB = 13312;
constexpr int X_RS = 13440;

#define LDS_WAIT() asm volatile("s_waitcnt lgkmcnt(0)" ::: "memory")
#define VM_WAIT() asm volatile("s_waitcnt vmcnt(0)" ::: "memory")
#define SBAR() __builtin_amdgcn_sched_barrier(0)
__device__ __forceinline__ unsigned cvtpk(float lo, float hi) { unsigned r; asm volatile("v_cvt_pk_bf16_f32 %0, %1, %2" : "=v"(r) : "v"(lo), "v"(hi)); return r; }
__device__ __forceinline__ float bf2f(unsigned short b) { return __uint_as_float(((unsigned)b) << 16); }
__device__ __forceinline__ float bflo(unsigned w) { return __uint_as_float(w << 16); }
__device__ __forceinline__ float bfhi(unsigned w) { return __uint_as_float(w & 0xffff0000u); }
__device__ __forceinline__ unsigned short f2bf(float f) { return (unsigned short)(cvtpk(f, 0.f) & 0xffffu); }
__device__ __forceinline__ unsigned pk4_fp8(float a, float b, float c, float d) {
    a = fminf(fmaxf(a, -448.f), 448.f); b = fminf(fmaxf(b, -448.f), 448.f); c = fminf(fmaxf(c, -448.f), 448.f); d = fminf(fmaxf(d, -448.f), 448.f);
    unsigned w = 0; w = __builtin_amdgcn_cvt_pk_fp8_f32(a, b, w, false); w = __builtin_amdgcn_cvt_pk_fp8_f32(c, d, w, true); return w;
}
__device__ __forceinline__ int tid_fresh(int wave_s) { int l; asm volatile("v_mbcnt_lo_u32_b32 %0, -1, 0\n\tv_mbcnt_hi_u32_b32 %0, -1, %0" : "=v"(l)); return wave_s * 64 + l; }
template <int CTRL, int BANK> __device__ __forceinline__ int dpp_i(int old, int x) { return __builtin_amdgcn_update_dpp(old, x, CTRL, 0xF, BANK, false); }
__device__ __forceinline__ int xs1(int x) { return dpp_i<0xB1, 0xF>(x, x); }
__device__ __forceinline__ int xs2(int x) { return dpp_i<0x4E, 0xF>(x, x); }
__device__ __forceinline__ int xs4(int x) { const int t = dpp_i<0x114, 0xA>(x, x); return dpp_i<0x104, 0x5>(t, x); }
__device__ __forceinline__ int xs8(int x) { return dpp_i<0x128, 0xF>(x, x); }
__device__ __forceinline__ float xf1(float x) { return __int_as_float(xs1(__float_as_int(x))); }
__device__ __forceinline__ float xf2(float x) { return __int_as_float(xs2(__float_as_int(x))); }
__device__ __forceinline__ float xf4(float x) { return __int_as_float(xs4(__float_as_int(x))); }
__device__ __forceinline__ float xf8(float x) { return __int_as_float(xs8(__float_as_int(x))); }
__device__ __forceinline__ float sum16(float a, float b) { auto r = __builtin_amdgcn_permlane16_swap(__float_as_uint(a), __float_as_uint(b), false, false); return __uint_as_float(r[0]) + __uint_as_float(r[1]); }
__device__ __forceinline__ float sum32(float a, float b) { auto r = __builtin_amdgcn_permlane32_swap(__float_as_uint(a), __float_as_uint(b), false, false); return __uint_as_float(r[0]) + __uint_as_float(r[1]); }
__device__ __forceinline__ unsigned xu16(unsigned x, int lane) { auto r = __builtin_amdgcn_permlane16_swap(x, x, false, false); return (lane & 16) ? r[0] : r[1]; }
__device__ __forceinline__ unsigned xu32(unsigned x, int lane) { auto r = __builtin_amdgcn_permlane32_swap(x, x, false, false); return (lane & 32) ? r[0] : r[1]; }
__device__ __forceinline__ float wave_sum(float v) {
    v += xf1(v); v += xf2(v); v += xf4(v); v += xf8(v); v = sum16(v, v); v = sum32(v, v);
    return v;
}
__device__ __forceinline__ float silu_f(float x) { return x / (1.f + __expf(-x)); }
__device__ __forceinline__ float gelu_tanh_f(float x) {
    const float u = x * (1.5957691216057308f + 0.07135481627260025f * x * x);
    const float e = __builtin_amdgcn_exp2f(-1.4426950408889634f * u);
    return x * __builtin_amdgcn_rcpf(1.f + e);
}

#define XB_TMO      128
#define XB_XCNT(j)  (256  + 64 * (j))
#define XB_XSUB(j)  (1280 + 64 * (j))
#define XB_XGEN(j)  (2304 + 64 * (j))
#define XB_TOP      3328
#define XB_TOPGEN   3392
#define XCD_BAR_WORDS 3456
#define XB_SPIN_CAP (1u << 20)
__device__ __forceinline__ unsigned xb_ld(unsigned* p)              { return __hip_atomic_load(p, __ATOMIC_RELAXED, __HIP_MEMORY_SCOPE_AGENT); }
__device__ __forceinline__ unsigned xb_add(unsigned* p, unsigned v) { return __hip_atomic_fetch_add(p, v, __ATOMIC_RELAXED, __HIP_MEMORY_SCOPE_AGENT); }
__device__ __forceinline__ unsigned xb_xcc_id() { return (unsigned)__builtin_amdgcn_s_getreg((3 << 11) | 20) & 0xFu; }
#define XB_SPIN(cond, bar) do { unsigned _sp = 0; while (cond) { __builtin_amdgcn_s_sleep(1); \
    if ((++_sp & 255u) == 0u) { if (xb_ld(&(bar)[XB_TMO])) break; if (_sp > XB_SPIN_CAP) { atomicAdd(&(bar)[XB_TMO], 1u); break; } } } } while (0)
struct XcdBarrier { unsigned* bar; unsigned x; volatile LAS unsigned* st; };
__device__ __forceinline__ XcdBarrier xcd_barrier_post(unsigned* bar, volatile LAS unsigned* st, bool t0) {
    XcdBarrier b; b.bar = bar; b.x = xb_xcc_id(); b.st = st;
    if (t0) (void)xb_add(&bar[XB_XCNT(b.x)], 1u);
    return b;
}
__device__ __forceinline__ void xcd_barrier_complete(unsigned* bar, unsigned x, unsigned& nloc, unsigned& nx) {
    const unsigned G = gridDim.x * gridDim.y * gridDim.z;
    unsigned sum, cnt, mine, sp = 0u;
    for (;;) {
        sum = 0u; cnt = 0u; mine = 0u;
#pragma unroll
        for (unsigned j = 0; j < 16; ++j) { const unsigned c = xb_ld(&bar[XB_XCNT(j)]); sum += c; cnt += (c > 0u) ? 1u : 0u; mine = (j == x) ? c : mine; }
        if (sum == G) break;
        __builtin_amdgcn_s_sleep(1);
        if ((++sp & 255u) == 0u) { if (xb_ld(&bar[XB_TMO])) break; if (sp > XB_SPIN_CAP) { atomicAdd(&bar[XB_TMO], 1u); break; } }
    }
    nloc = mine > 0u ? mine : 1u; nx = cnt > 0u ? cnt : 1u;
}
__device__ __forceinline__ void xcd_barrier(const XcdBarrier& b, bool t0) {
    asm volatile("s_waitcnt vmcnt(0)" ::: "memory");
    __syncthreads();
    if (t0) {
        unsigned* bar = b.bar;
        __builtin_amdgcn_s_waitcnt(0);
        unsigned nloc = b.st[0], nx = b.st[1];
        if (nloc == 0u) { xcd_barrier_complete(bar, b.x, nloc, nx); b.st[0] = nloc; b.st[1] = nx; }
        const unsigned old = xb_add(&bar[XB_XSUB(b.x)], 1u);
        const unsigned gen = old / nloc;
        if (old + 1u == (gen + 1u) * nloc) {
            __builtin_amdgcn_fence(__ATOMIC_RELEASE, "agent");
            asm volatile("s_waitcnt vmcnt(0)" ::: "memory");
            const unsigned og = xb_add(&bar[XB_TOP], 1u);
            const unsigned tg = og / nx;
            if (og + 1u == (tg + 1u) * nx) xb_add(&bar[XB_TOPGEN], 1u);
            else XB_SPIN(xb_ld(&bar[XB_TOPGEN]) == tg, bar);
            __builtin_amdgcn_fence(__ATOMIC_ACQUIRE, "agent");
            xb_add(&bar[XB_XGEN(b.x)], 1u);
            asm volatile("s_waitcnt vmcnt(0)" ::: "memory");
        } else {
            XB_SPIN(xb_ld(&bar[XB_XGEN(b.x)]) == gen, bar);
            __builtin_amdgcn_fence(__ATOMIC_ACQUIRE, "agent");
            asm volatile("s_waitcnt vmcnt(0)" ::: "memory");
        }
    }
    __syncthreads();
}

struct Args { const float* in[28]; float* out; uchar* ws; int ph_lo, ph_hi, dry, pad; };
enum { I_X = 0, I_C, I_CTX, I_CCTX, I_ADAW, I_ADAB, I_NMIXG, I_NFFNG, I_ABWIN, I_SGUNG, I_SGUW, I_SGUB, I_GQG, I_GKG, I_ABWOUT, I_MLAWIN, I_MLAQG, I_MLAKVG, I_MLAWUQ, I_MLAWUKV, I_MLAWOUT,
       I_RW, I_RB, I_W1, I_B1, I_W2, I_B2, I_FNG };
struct Frame {
    LAS uchar* lds; int tid, lane, wave, G, bid;
    uchar* ws; float* out;
};
__device__ __forceinline__ const float* INP(int i) {
    const __attribute__((address_space(4))) char* ka = (const __attribute__((address_space(4))) char*)__builtin_amdgcn_kernarg_segment_ptr();
    return *(const float* const volatile __attribute__((address_space(4)))*)(ka + i * 8);
}

namespace pg8 {
constexpr int BM = 256, BK = 64, HALF = 128, HTB = HALF * BK * 2, NXCD = 8, WGM = 8;
__device__ __forceinline__ int lds_byte(int r, int c) { const int st = (r >> 4) * 2 + (c >> 5), rr = r & 15, cc = c & 31, ob = rr * 64 + cc * 2; return st * 1024 + (ob ^ (((ob >> 9) & 1) << 5)); }
__device__ __forceinline__ void stage_rc(int b, int& R, int& C) { const int st = b / 1024, sb = b % 1024, swz = sb ^ (((sb >> 9) & 1) << 5); R = (st >> 1) * 16 + swz / 64; C = (st & 1) * 32 + (swz % 64) / 2; }
__device__ __forceinline__ int perm32(int rho) { const int n = rho >> 4, i = rho & 15; return 8 * (i >> 2) + 4 * n + (i & 3); }
struct Unit { int pm, pn, e, rb; };
struct StaticOrder {
    int nM, nN, nwg;
    __device__ void init(int nM_, int nN_) { nM = nM_; nN = nN_; nwg = nM * nN; }
    __device__ bool map(long L, int& pm, int& pn) const {
        if (L >= nwg) return false;
        int wgid = (int)L; { const int q = nwg / NXCD, r = nwg % NXCD, xcd = wgid % NXCD, off = wgid / NXCD; wgid = (xcd < r ? xcd * (q + 1) : r * (q + 1) + (xcd - r) * q) + off; }
        const int nig = WGM * nN, gid = wgid / nig, fm = gid * WGM, gsz = (nM - fm) < WGM ? (nM - fm) : WGM;
        pm = fm + ((wgid % nig) % gsz); pn = (wgid % nig) / gsz; return true;
    }
};
typedef f32x4 Acc[2][2][4][2];
template <class P>
__device__ __forceinline__ void gemm_phase(LAS uchar* lds, const P& p, int wave_s) {
    const int tid = tid_fresh(wave_s), wid = __builtin_amdgcn_readfirstlane(tid >> 6), lane = tid & 63, wr = wid >> 2, wc = wid & 3, fr = lane & 15, fq = lane >> 4;
    const int K = p.K, nt = K / BK;
    unsigned voffA[2][2], voffB[2];
#pragma unroll
    for (int i = 0; i < 2; ++i) { int R, C; stage_rc(tid * 16 + i * 8192, R, C); const int Rb = P::PERM ? ((R & ~31) + perm32(R & 31)) : R;
        voffA[0][i] = (unsigned)(R * p.lda + C) * 2u; voffA[1][i] = voffA[0][i]; voffB[i] = (unsigned)(Rb * K + C) * 2u; }
    const unsigned kstep = (unsigned)(BK * 2);
    const unsigned hstepB = (unsigned)HALF * K * 2;
    const unsigned hstepA = P::GATHER ? 0u : (unsigned)HALF * p.lda * 2;
#define PG8_VA1 voffA[P::GATHER ? 1 : 0]
    const __amdgpu_buffer_rsrc_t rsA = __builtin_amdgcn_make_buffer_rsrc((void*)p.a_mat(), 0, 0xffffffffu, 0x00020000);
    const __amdgpu_buffer_rsrc_t rsB = __builtin_amdgcn_make_buffer_rsrc((void*)p.b_mat(), 0, 0xffffffffu, 0x00020000);
    const char* gpA = (const char*)p.a_mat(); const char* gpB = (const char*)p.b_mat(); (void)gpA; (void)gpB; (void)rsA; (void)rsB;
    const unsigned ldsw = (unsigned)wid * 1024u;
    const int aoff = lds_byte(wr * 64 + fr, fq * 8), boff = lds_byte(wc * 32 + fr, fq * 8);
#define PG8_SA(b, h) (((b) * 2 + (h)) * HTB)
#define PG8_SB(b, h) ((4 + (b) * 2 + (h)) * HTB)
#if USE_BUFFER_LDS
#define PG8_STAGE_R(bufoff, rs, gp, soff, voff) do { _Pragma("unroll") for (int _i = 0; _i < 2; ++_i) \
        __builtin_amdgcn_raw_ptr_buffer_load_lds(rs, (LAS unsigned*)(lds + (bufoff) + ldsw + _i * 8192), 16, (int)(voff)[_i], (int)(soff), 0, 0); } while (0)
#else
#define PG8_STAGE_R(bufoff, rs, gp, soff, voff) do { _Pragma("unroll") for (int _i = 0; _i < 2; ++_i) \
        __builtin_amdgcn_global_load_lds((const unsigned*)((const char*)(gp) + (size_t)(soff) + (voff)[_i]), (LAS unsigned*)(lds + (bufoff) + ldsw + _i * 8192), 16, 0, 0); } while (0)
#endif
#define PG8_STAGE_A(bufoff, soff, voff) PG8_STAGE_R(bufoff, rsA, gpA, soff, voff)
#define PG8_STAGE_B(bufoff, soff, voff) PG8_STAGE_R(bufoff, rsB, gpB, soff, voff)
#define PG8_LDA(dst, b, h) do { _Pragma("unroll") for (int m = 0; m < 4; ++m) _Pragma("unroll") for (int k = 0; k < 2; ++k) dst[m][k] = *(const LAS i32x4*)(lds + PG8_SA(b, h) + aoff + m * 2048 + k * 1024); } while (0)
#define PG8_LDB(dst, b, h) do { _Pragma("unroll") for (int n = 0; n < 2; ++n) _Pragma("unroll") for (int k = 0; k < 2; ++k) dst[n][k] = *(const LAS i32x4*)(lds + PG8_SB(b, h) + boff + n * 2048 + k * 1024); } while (0)
#define PG8_CAT(x) __builtin_shufflevector((x)[0], (x)[1], 0, 1, 2, 3, 4, 5, 6, 7)
#define PG8_MMA(ai, bj, At, Bt) do { __builtin_amdgcn_s_setprio(1); \
        if constexpr (P::FP8) { _Pragma("unroll") for (int m = 0; m < 4; ++m) _Pragma("unroll") for (int n = 0; n < 2; ++n) \
            acc[ai][bj][m][n] = __builtin_amdgcn_mfma_scale_f32_16x16x128_f8f6f4(PG8_CAT(Bt[n]), PG8_CAT(At[m]), acc[ai][bj][m][n], 0, 0, 0, 0x7F7F7F7F, 0, 0x7F7F7F7F); } \
        else { _Pragma("unroll") for (int m = 0; m < 4; ++m) _Pragma("unroll") for (int n = 0; n < 2; ++n) _Pragma("unroll") for (int k = 0; k < 2; ++k) \
            acc[ai][bj][m][n] = __builtin_amdgcn_mfma_f32_16x16x32_bf16(__builtin_bit_cast(bf16x8, Bt[n][k]), __builtin_bit_cast(bf16x8, At[m][k]), acc[ai][bj][m][n], 0, 0, 0); } \
        __builtin_amdgcn_s_setprio(0); } while (0)
#define PG8_WAIT_V(n) asm volatile("s_waitcnt vmcnt(" #n ")" ::: "memory")
#define PG8_WAIT_L(n) asm volatile("s_waitcnt lgkmcnt(" #n ")" ::: "memory")
#define PG8_BAR __builtin_amdgcn_s_barrier()
#define PG8_SCHED __builtin_amdgcn_sched_barrier(0)
    Unit cur, nxt; int ui = 0;
    if (!p.next(0, cur)) return;
    Acc acc;
#pragma unroll
    for (int a = 0; a < 2; ++a)
#pragma unroll
        for (int b = 0; b < 2; ++b)
#pragma unroll
            for (int m = 0; m < 4; ++m)
#pragma unroll
                for (int n = 0; n < 2; ++n) acc[a][b][m][n] = (f32x4){0.f, 0.f, 0.f, 0.f};
    i32x4 At[4][2], B0[2][2], B1[2][2];
    unsigned cA = p.a_off(cur), cB = p.b_off(cur);
    if constexpr (P::GATHER) { p.a_voff(cur, voffA); }
    PG8_STAGE_B(PG8_SB(0, 0), cB, voffB); PG8_STAGE_B(PG8_SB(0, 1), cB + hstepB, voffB); PG8_STAGE_A(PG8_SA(0, 0), cA, voffA[0]); PG8_STAGE_A(PG8_SA(0, 1), cA + hstepA, PG8_VA1);
    if (wr == 1) PG8_BAR;
    PG8_WAIT_V(2); PG8_BAR;
    PG8_STAGE_B(PG8_SB(1, 0), cB + kstep, voffB); PG8_STAGE_A(PG8_SA(1, 0), cA + kstep, voffA[0]); PG8_STAGE_B(PG8_SB(1, 1), cB + hstepB + kstep, voffB);
    PG8_WAIT_V(6); PG8_BAR;
    for (;;) {
        const bool has_next = p.next(ui + 1, nxt);
        const unsigned nA = has_next ? p.a_off(nxt) : cA, nB = has_next ? p.b_off(nxt) : cB;
        for (int t = 0; t < nt; t += 2) {
            const bool last = (t == nt - 2);
            const unsigned a1 = cA + (unsigned)(t + 1) * kstep;
            const unsigned a2 = last ? nA : cA + (unsigned)(t + 2) * kstep, b2 = last ? nB : cB + (unsigned)(t + 2) * kstep;
            const unsigned a3 = a2 + kstep, b3 = b2 + kstep;
            PG8_LDB(B0, 0, 0); PG8_LDB(B1, 0, 1); PG8_SCHED; PG8_LDA(At, 0, 0); PG8_STAGE_A(PG8_SA(1, 1), a1 + hstepA, PG8_VA1);
            if constexpr (P::GATHER) { if (last && has_next) p.a_voff(nxt, voffA); }
            PG8_WAIT_V(8); PG8_WAIT_L(0); PG8_BAR; PG8_MMA(0, 0, At, B0); PG8_MMA(0, 1, At, B1); PG8_BAR; PG8_SCHED;
            PG8_LDA(At, 0, 1); PG8_STAGE_B(PG8_SB(0, 0), b2, voffB); PG8_STAGE_B(PG8_SB(0, 1), b2 + hstepB, voffB); PG8_STAGE_A(PG8_SA(0, 0), a2, voffA[0]);
            PG8_WAIT_V(8); PG8_WAIT_L(0); PG8_BAR; PG8_MMA(1, 0, At, B0); PG8_MMA(1, 1, At, B1); PG8_BAR; PG8_SCHED;
            PG8_LDB(B0, 1, 0); PG8_LDB(B1, 1, 1); PG8_SCHED; PG8_LDA(At, 1, 0); PG8_STAGE_A(PG8_SA(0, 1), a2 + hstepA, PG8_VA1);
            PG8_WAIT_V(8); PG8_WAIT_L(0); PG8_BAR; PG8_MMA(0, 0, At, B0); PG8_MMA(0, 1, At, B1); PG8_BAR; PG8_SCHED;
            PG8_LDA(At, 1, 1); PG8_STAGE_B(PG8_SB(1, 0), b3, voffB); PG8_STAGE_B(PG8_SB(1, 1), b3 + hstepB, voffB); PG8_STAGE_A(PG8_SA(1, 0), a3, voffA[0]);
            PG8_WAIT_V(8); PG8_WAIT_L(0); PG8_BAR; PG8_MMA(1, 0, At, B0); PG8_MMA(1, 1, At, B1); PG8_BAR; PG8_SCHED;
        }
        if (wr == 0) PG8_BAR;
        p.epi(acc, cur, wr, wc, fr, fq);
        if (!has_next) break;
#pragma unroll
        for (int a = 0; a < 2; ++a)
#pragma unroll
            for (int b = 0; b < 2; ++b)
#pragma unroll
                for (int m = 0; m < 4; ++m)
#pragma unroll
                    for (int n = 0; n < 2; ++n) acc[a][b][m][n] = (f32x4){0.f, 0.f, 0.f, 0.f};
        cur = nxt; cA = nA; cB = nB; ++ui;
        if (wr == 1) PG8_BAR;
    }
    PG8_WAIT_V(0);
    PG8_BAR;
#undef PG8_SA
#undef PG8_VA1
#undef PG8_SB
#undef PG8_STAGE_R
#undef PG8_STAGE_A
#undef PG8_STAGE_B
#undef PG8_LDA
#undef PG8_LDB
#undef PG8_MMA
#undef PG8_CAT
#undef PG8_WAIT_V
#undef PG8_WAIT_L
#undef PG8_BAR
#undef PG8_SCHED
}

template <bool GELU>
__device__ __forceinline__ void epi_store_bf16(const Acc& acc, bf16_t* dst  , int ldc, const float* bias  , int wr, int wc, int fr, int fq, float sc = 1.f) {
    const int row0 = wr * 64 + fr, col0 = wc * 32 + 8 * fq;
    f32x4 bv[2][2];
#pragma unroll
    for (int bj = 0; bj < 2; ++bj)
#pragma unroll
        for (int n = 0; n < 2; ++n) bv[bj][n] = bias ? *(const f32x4*)(bias + col0 + bj * HALF + 4 * n) : (f32x4){0.f, 0.f, 0.f, 0.f};
    const unsigned lane_off = (unsigned)(row0 * ldc + col0) * 2u;
#pragma unroll
    for (int ai = 0; ai < 2; ++ai)
#pragma unroll
        for (int m = 0; m < 4; ++m) { char* rowb = (char*)dst + (size_t)((ai * HALF + m * 16) * ldc) * 2;
#pragma unroll
            for (int bj = 0; bj < 2; ++bj) { f32x4 v0 = acc[ai][bj][m][0] * sc + bv[bj][0], v1 = acc[ai][bj][m][1] * sc + bv[bj][1];
                if (GELU) {
#pragma unroll
                    for (int j = 0; j < 4; ++j) { v0[j] = gelu_tanh_f(v0[j]); v1[j] = gelu_tanh_f(v1[j]); } }
                u32x4 w; w.x = cvtpk(v0[0], v0[1]); w.y = cvtpk(v0[2], v0[3]); w.z = cvtpk(v1[0], v1[1]); w.w = cvtpk(v1[2], v1[3]);
                *(u32x4*)(rowb + lane_off + bj * HALF * 2) = w; } }
}
}

namespace att {
constexpr int NW = 8, QBLK = 32, KVBLK = 64;
constexpr int SHM_V = KVBLK * 128 * 2;
constexpr float THR = 8.f;
__device__ __forceinline__ int crow(int r, int hi) { return (r & 3) + 8 * (r >> 2) + 4 * hi; }
template <int DQK> struct Cfg { static constexpr float SCALE = (DQK == 128) ? 0.088388347648318440f : 0.072168783648703220f; static constexpr int KP = DQK * 2, SHM_K = KVBLK * DQK * 2, ND = DQK / 16; };
#define KSWZ(PITCH, row, colB) ((row) * (PITCH) + ((colB) ^ (((row) & 7) << 4)))
template <int DQK> __device__ __forceinline__ void partialSM(f32x16& p0, f32x16& p1, float& m_reg, float& mn, float& alpha) {
    constexpr float SCALE = Cfg<DQK>::SCALE, C = SCALE * 1.4426950408889634f;
    float pmax = p0[0];
#pragma unroll
    for (int r = 1; r < 16; ++r) pmax = fmaxf(pmax, p0[r]);
#pragma unroll
    for (int r = 0; r < 16; ++r) pmax = fmaxf(pmax, p1[r]);
    { auto rr = __builtin_amdgcn_permlane32_swap(__float_as_uint(pmax), __float_as_uint(pmax), false, false);
      pmax = fmaxf(__uint_as_float(rr[0]), __uint_as_float(rr[1])); }
    if (__builtin_expect(__all(pmax - m_reg <= THR / SCALE), 1)) { mn = m_reg; alpha = 1.f; }
    else { mn = fmaxf(m_reg, pmax); alpha = __builtin_amdgcn_exp2f((m_reg - mn) * C); m_reg = mn; }
    const float mnC = -mn * C;
#pragma unroll
    for (int r = 0; r < 16; ++r) p0[r] = fmaf(p0[r], C, mnC);
#pragma unroll
    for (int r = 0; r < 16; ++r) p1[r] = fmaf(p1[r], C, mnC);
#pragma unroll
    for (int r = 0; r < 16; ++r) p0[r] = __builtin_amdgcn_exp2f(p0[r]);
}
__device__ __forceinline__ void finishSM(f32x16& p0, f32x16& p1, float alpha, float& l_reg, bf16x8& pa0, bf16x8& pa1, bf16x8& pa2, bf16x8& pa3) {
#pragma unroll
    for (int r = 0; r < 16; ++r) p1[r] = __builtin_amdgcn_exp2f(p1[r]);
    float ps = 0;
#pragma unroll
    for (int r = 0; r < 16; ++r) ps += p0[r];
#pragma unroll
    for (int r = 0; r < 16; ++r) ps += p1[r];
    { auto rr = __builtin_amdgcn_permlane32_swap(__float_as_uint(ps), __float_as_uint(ps), false, false);
      ps = __uint_as_float(rr[0]) + __uint_as_float(rr[1]); }
    l_reg = l_reg * alpha + ps;
#define PK4(P, BASE, OUT) do { unsigned a0 = cvtpk(P[BASE + 0], P[BASE + 1]), a1 = cvtpk(P[BASE + 2], P[BASE + 3]);   \
    unsigned b0 = cvtpk(P[BASE + 4], P[BASE + 5]), b1 = cvtpk(P[BASE + 6], P[BASE + 7]);                              \
    auto r0 = __builtin_amdgcn_permlane32_swap(a0, b0, false, false); auto r1 = __builtin_amdgcn_permlane32_swap(a1, b1, false, false); \
    u32x4 w = {r0[0], r1[0], r0[1], r1[1]}; OUT = *reinterpret_cast<bf16x8*>(&w); } while (0)
    PK4(p0, 0, pa0); PK4(p0, 8, pa1); PK4(p1, 0, pa2); PK4(p1, 8, pa3);
#undef PK4
}
template <int DQK> __device__ __forceinline__ void qkt(f32x16& p0, f32x16& p1, const LAS char* Ks, const bf16x8* qr, int r32, int hi) {
    constexpr int KP = Cfg<DQK>::KP, ND = Cfg<DQK>::ND;
    p0 = f32x16{}; p1 = f32x16{};
#pragma unroll
    for (int d0 = 0; d0 < ND; ++d0) { const int cb = (d0 * 16 + hi * 8) * 2;
        bf16x8 b0 = *reinterpret_cast<const LAS bf16x8*>(Ks + KSWZ(KP, r32, cb));
        bf16x8 b1 = *reinterpret_cast<const LAS bf16x8*>(Ks + KSWZ(KP, 32 + r32, cb));
        p0 = __builtin_amdgcn_mfma_f32_32x32x16_bf16(b0, qr[d0], p0, 0, 0, 0);
        p1 = __builtin_amdgcn_mfma_f32_32x32x16_bf16(b1, qr[d0], p1, 0, 0, 0); }
}
__device__ __forceinline__ int v_st(int k, int c) { const int kk = (k & ~0xC) | ((k & 4) << 1) | ((k & 8) >> 1); return ((kk >> 3) * 4 + (c >> 5)) * 512 + ((kk & 7) * 32 + (c & 31)) * 2; }
__device__ __forceinline__ int v_rd_base(int lane) { return ((lane & 3) << 3) | (((lane >> 2) & 3) << 6) | (((lane >> 4) & 1) << 5) | (((lane >> 5) & 1) << 8); }
constexpr int v_rd_off(int d0, int ks, int half) { return d0 * 512 + ks * 4096 + half * 2048; }
template <int OFF> __device__ __forceinline__ s16x4 tr_read(int vb) {
    s16x4 r; asm volatile("ds_read_b64_tr_b16 %0, %1 offset:%2" : "=&v"(r) : "v"(vb), "i"(OFF) : "memory"); return r;
}
template <int D0> __device__ __forceinline__ void pv_one(f32x16& od, int vb, bf16x8 pa0, bf16x8 pa1, bf16x8 pa2, bf16x8 pa3) {
    const s16x4 l0 = tr_read<v_rd_off(D0, 0, 0)>(vb), h0 = tr_read<v_rd_off(D0, 0, 1)>(vb), l1 = tr_read<v_rd_off(D0, 1, 0)>(vb), h1 = tr_read<v_rd_off(D0, 1, 1)>(vb);
    const s16x4 l2 = tr_read<v_rd_off(D0, 2, 0)>(vb), h2 = tr_read<v_rd_off(D0, 2, 1)>(vb), l3 = tr_read<v_rd_off(D0, 3, 0)>(vb), h3 = tr_read<v_rd_off(D0, 3, 1)>(vb);
    asm volatile("s_waitcnt lgkmcnt(0)" ::: "memory"); SBAR();
#define PK(L, H) (bf16x8){L[0], L[1], L[2], L[3], H[0], H[1], H[2], H[3]}
    od = __builtin_amdgcn_mfma_f32_32x32x16_bf16(pa0, PK(l0, h0), od, 0, 0, 0);
    od = __builtin_amdgcn_mfma_f32_32x32x16_bf16(pa1, PK(l1, h1), od, 0, 0, 0);
    od = __builtin_amdgcn_mfma_f32_32x32x16_bf16(pa2, PK(l2, h2), od, 0, 0, 0);
    od = __builtin_amdgcn_mfma_f32_32x32x16_bf16(pa3, PK(l3, h3), od, 0, 0, 0);
#undef PK
}
__device__ __forceinline__ void pv_d0(f32x16* o, int vb, bf16x8 pa0, bf16x8 pa1, bf16x8 pa2, bf16x8 pa3) {
    pv_one<0>(o[0], vb, pa0, pa1, pa2, pa3); pv_one<1>(o[1], vb, pa0, pa1, pa2, pa3); pv_one<2>(o[2], vb, pa0, pa1, pa2, pa3); pv_one<3>(o[3], vb, pa0, pa1, pa2, pa3);
}
__device__ __forceinline__ bf16x8 ld8(const bf16_t* p) { return *reinterpret_cast<const bf16x8*>(p); }
__device__ __forceinline__ void rope_frag(bf16x8& a, bf16x8& b, const f32x2* tab) {
    u32x4 wa = *reinterpret_cast<u32x4*>(&a), wb = *reinterpret_cast<u32x4*>(&b), oa, ob;
#pragma unroll
    for (int q = 0; q < 4; ++q) {
        const float x1l = bflo(wa[q]), x1h = bfhi(wa[q]), x2l = bflo(wb[q]), x2h = bfhi(wb[q]);
        const f32x2 t0 = tab[2 * q], t1 = tab[2 * q + 1];
        oa[q] = cvtpk(x1l * t0.x - x2l * t0.y, x1h * t1.x - x2h * t1.y);
        ob[q] = cvtpk(x2l * t0.x + x1l * t0.y, x2h * t1.x + x1h * t1.y);
    }
    a = *reinterpret_cast<bf16x8*>(&oa); b = *reinterpret_cast<bf16x8*>(&ob);
}
template <int DQK, int SDEPTH, bool MLA, int ldq, int ldkv, int ldo>
__device__ __forceinline__ void attn_unit(const bf16_t* __restrict__ Qb, const bf16_t* __restrict__ Kh, const bf16_t* __restrict__ KRh, const bf16_t* __restrict__ Vh,
                                          bf16_t* __restrict__ Ob, int seq, LAS char* lds, const f32x2* __restrict__ tabm, int qt0, int wave_s) {
    constexpr int KP = Cfg<DQK>::KP, SHM_K = Cfg<DQK>::SHM_K, ND = Cfg<DQK>::ND;
    const int tid = tid_fresh(wave_s), wid = tid >> 6, lane = tid & 63, r32 = lane & 31, hi = lane >> 5;
    LAS char* V_lds = lds; LAS char* K_lds = lds + 2 * SHM_V;
    LAS float* wsl = (LAS float*)(lds + 2 * SHM_V + 2 * SHM_K) + wid * 64; LAS float* li_l = wsl; LAS float* al_l = wsl + 32;
    float m_reg = -1e30f, l_reg = 0; f32x16 o[4] = {}; bf16x8 qr[ND];
    const bf16_t* Qw = Qb + (long)(wid * QBLK + r32) * ldq + hi * 8;
#pragma unroll
    for (int d0 = 0; d0 < ND; ++d0) qr[d0] = ld8(Qw + d0 * 16);
    if constexpr (MLA) {
        const int t = qt0 + wid * QBLK + r32, prow = t >> 6, pcol = t & 63;
        rope_frag(qr[8], qr[9], tabm + prow * 16 + hi * 8);
        rope_frag(qr[10], qr[11], tabm + pcol * 16 + hi * 8);
    }
    const int sr = tid >> 4, sc = (tid & 15) * 8, vst0 = v_st(sr, sc), vst1 = v_st(32 + sr, sc);
    const int krr = tid >> 3, krc = (tid & 7) * 8;
    const int vb0 = (int)(unsigned)(uintptr_t)V_lds + v_rd_base(lane);
    struct { bf16x8 vs0, vs1, ks0, ks1, kr; } sr_[SDEPTH];
#define SLOAD(i, k0) do { sr_[i].vs0 = ld8(&Vh[(long)((k0) + sr) * ldkv + sc]); sr_[i].vs1 = ld8(&Vh[(long)((k0) + 32 + sr) * ldkv + sc]); \
    sr_[i].ks0 = ld8(&Kh[(long)((k0) + sr) * ldkv + sc]); sr_[i].ks1 = ld8(&Kh[(long)((k0) + 32 + sr) * ldkv + sc]); \
    if constexpr (MLA) sr_[i].kr = ld8(&KRh[(long)((k0) + krr) * 64 + krc]); } while (0)
#define SWRITE(b, i) do { *(LAS bf16x8*)(V_lds + (b) * SHM_V + vst0) = sr_[i].vs0;          \
    *(LAS bf16x8*)(V_lds + (b) * SHM_V + vst1) = sr_[i].vs1; const int kc = sc * 2;               \
    *(LAS bf16x8*)(K_lds + (b) * SHM_K + KSWZ(KP, sr, kc)) = sr_[i].ks0;                       \
    *(LAS bf16x8*)(K_lds + (b) * SHM_K + KSWZ(KP, 32 + sr, kc)) = sr_[i].ks1;                  \
    if constexpr (MLA) *(LAS bf16x8*)(K_lds + (b) * SHM_K + KSWZ(KP, krr, 256 + krc * 2)) = sr_[i].kr; } while (0)
#define SWAIT() do { if constexpr (SDEPTH == 2) { if constexpr (MLA) asm volatile("s_waitcnt vmcnt(5)" ::: "memory"); else asm volatile("s_waitcnt vmcnt(4)" ::: "memory"); } else asm volatile("s_waitcnt vmcnt(0)" ::: "memory"); } while (0)
#define RESC(a) do { if (__any((a) < 1.f)) { if (hi == 0) al_l[r32] = (a); asm volatile("s_waitcnt lgkmcnt(0)" ::: "memory"); \
    _Pragma("unroll") for (int d = 0; d < 4; ++d) _Pragma("unroll") for (int r = 0; r < 16; ++r) o[d][r] *= al_l[crow(r, hi)]; } } while (0)
    bf16x8 pa0, pa1, pa2, pa3; const int NT = seq / KVBLK;
    if constexpr (MLA) {
        f32x16 p0, p1; float mn, al;
        SLOAD(0, 0); asm volatile("s_waitcnt vmcnt(0)" ::: "memory"); SWRITE(0, 0); SLOAD(0, KVBLK); __syncthreads();
        for (int j = 0; j < NT; ++j) {
            const int cb = j & 1;
            if (j + 1 < NT) { asm volatile("s_waitcnt vmcnt(0)" ::: "memory"); SWRITE(cb ^ 1, 0); if (j + 2 < NT) SLOAD(0, (j + 2) * KVBLK); }
            SBAR(); qkt<DQK>(p0, p1, K_lds + cb * SHM_K, qr, r32, hi);
            partialSM<DQK>(p0, p1, m_reg, mn, al); RESC(al);
            finishSM(p0, p1, al, l_reg, pa0, pa1, pa2, pa3); SBAR();
            pv_d0(o, vb0 + cb * SHM_V, pa0, pa1, pa2, pa3);
            __syncthreads();
        }
    } else {
    f32x16 pA0, pA1, pB0, pB1; float mnA, mnB, alA, alB;
    constexpr int SE = 0, SO = SDEPTH - 1;
    SLOAD(SE, 0); asm volatile("s_waitcnt vmcnt(0)" ::: "memory"); SWRITE(0, SE); __syncthreads();
    qkt<DQK>(pA0, pA1, K_lds, qr, r32, hi); partialSM<DQK>(pA0, pA1, m_reg, mnA, alA);
    SLOAD(SO, KVBLK); if constexpr (SDEPTH == 2) { if (2 < NT) SLOAD(SE, 2 * KVBLK); }
    SWAIT(); SWRITE(1, SO); __syncthreads();
    for (int j = 1; j + 1 < NT; j += 2) {
        SBAR(); qkt<DQK>(pB0, pB1, K_lds + SHM_K, qr, r32, hi);
        finishSM(pA0, pA1, alA, l_reg, pa0, pa1, pa2, pa3); SBAR();
        SLOAD(SO, (j + SDEPTH) * KVBLK); SBAR();
        pv_d0(o, vb0, pa0, pa1, pa2, pa3); partialSM<DQK>(pB0, pB1, m_reg, mnB, alB);
        __syncthreads(); SWAIT(); SWRITE(0, SE);
        RESC(alB); __syncthreads();
        SBAR(); qkt<DQK>(pA0, pA1, K_lds, qr, r32, hi);
        finishSM(pB0, pB1, alB, l_reg, pa0, pa1, pa2, pa3); SBAR();
        if (SDEPTH == 1 || j + 3 < NT) SLOAD(SE, (j + 1 + SDEPTH) * KVBLK); SBAR();
        pv_d0(o, vb0 + SHM_V, pa0, pa1, pa2, pa3); partialSM<DQK>(pA0, pA1, m_reg, mnA, alA);
        __syncthreads(); SWAIT(); SWRITE(1, SO);
        RESC(alA); __syncthreads();
    }
    SBAR(); qkt<DQK>(pB0, pB1, K_lds + SHM_K, qr, r32, hi);
    finishSM(pA0, pA1, alA, l_reg, pa0, pa1, pa2, pa3); SBAR();
    pv_d0(o, vb0, pa0, pa1, pa2, pa3); partialSM<DQK>(pB0, pB1, m_reg, mnB, alB);
    __syncthreads(); RESC(alB);
    finishSM(pB0, pB1, alB, l_reg, pa0, pa1, pa2, pa3); SBAR();
    pv_d0(o, vb0 + SHM_V, pa0, pa1, pa2, pa3);
    }
    if (hi == 0) li_l[r32] = l_reg; asm volatile("s_waitcnt lgkmcnt(0)" ::: "memory");
    float rli[16];
#pragma unroll
    for (int r = 0; r < 16; ++r) rli[r] = __builtin_amdgcn_rcpf(li_l[crow(r, hi)]);
    bf16_t* Ow = Ob + (long)(wid * QBLK) * ldo;
#pragma unroll
    for (int r = 0; r < 16; ++r) { const int orow = crow(r, hi);
#pragma unroll
        for (int d0 = 0; d0 < 4; ++d0) Ow[(long)orow * ldo + d0 * 32 + r32] = f2bf(o[d0][r] * rli[r]); }
    __syncthreads();
#undef SLOAD
#undef SWRITE
#undef SWAIT
#undef RESC
}
}

template <int MODE> __device__ __forceinline__ int dst_row(int n) {
    if (MODE == 1) { const int half = n >> 10, c = n & 1023; return ((c >> 7) << 8) + (half << 7) + (c & 127); }
    if (MODE == 2) { const int h = n >> 8, j = n & 255; return j < 128 ? (h << 7) + j : 1024 + (h << 7) + (j - 128); }
    return n;
}
template <int MODE> __device__ __forceinline__ void p0_transpose_item_fp8(const float* W, int K, int N, unsigned char* WT, LAS float* scr, int item, int lane) {
    const int nblk = N / 32, kb = item / nblk, nb = item % nblk, k0 = 64 * kb, n0 = 32 * nb;
#pragma unroll 8
    for (int i = 0; i < 32; ++i) { const int kk = 2 * i + (lane >> 5); scr[kk * 33 + (lane & 31)] = W[(size_t)(k0 + kk) * N + n0 + (lane & 31)]; }
    LDS_WAIT(); asm volatile("" ::: "memory");
    const int c = lane & 7;
#pragma unroll
    for (int j = 0; j < 4; ++j) { const int n = (lane >> 3) + 8 * j; const LAS float* s = scr + (8 * c) * 33 + n;
        u32x2 o; o.x = pk4_fp8(s[0 * 33] * 64.f, s[1 * 33] * 64.f, s[2 * 33] * 64.f, s[3 * 33] * 64.f); o.y = pk4_fp8(s[4 * 33] * 64.f, s[5 * 33] * 64.f, s[6 * 33] * 64.f, s[7 * 33] * 64.f);
        *(u32x2*)(WT + (size_t)dst_row<MODE>(n0 + n) * K + k0 + 8 * c) = o; }
    LDS_WAIT(); asm volatile("" ::: "memory");
}
template <int MODE> __device__ __forceinline__ void p0_transpose_item(const float* W, int K, int N, bf16_t* WT, LAS float* scr, int item, int lane) {
    const int nblk = N / 32, kb = item / nblk, nb = item % nblk, k0 = 64 * kb, n0 = 32 * nb;
#pragma unroll 8
    for (int i = 0; i < 32; ++i) { const int kk = 2 * i + (lane >> 5); scr[kk * 33 + (lane & 31)] = W[(size_t)(k0 + kk) * N + n0 + (lane & 31)]; }
    LDS_WAIT(); asm volatile("" ::: "memory");
    const int c = lane & 7;
#pragma unroll
    for (int j = 0; j < 4; ++j) { const int n = (lane >> 3) + 8 * j; const LAS float* s = scr + (8 * c) * 33 + n;
        u32x4 o; o.x = cvtpk(s[0 * 33], s[1 * 33]); o.y = cvtpk(s[2 * 33], s[3 * 33]); o.z = cvtpk(s[4 * 33], s[5 * 33]); o.w = cvtpk(s[6 * 33], s[7 * 33]);
        *(u32x4*)(WT + (size_t)dst_row<MODE>(n0 + n) * K + k0 + 8 * c) = o; }
    LDS_WAIT(); asm volatile("" ::: "memory");
}
__device__ __forceinline__ void p0_prologue(Frame& F) {
    uchar* ws = F.ws;
    {
        LAS float* S = (LAS float*)F.lds;
        const float* pC = INP(I_C); const float* pCC = INP(I_CCTX); const float* pAW = INP(I_ADAW); const float* pAB = INP(I_ADAB); const float* pNM = INP(I_NMIXG); const float* pNF = INP(I_NFFNG);
        float* MOD = (float*)(ws + WS_MOD);
        for (int item = F.bid; item < 192; item += F.G) {
            const int layer = item / 96, n0 = (item % 96) * 64;
            __syncthreads();
            for (int u = F.tid; u < 33 * 1024; u += 512) { const int j = u >> 10, k = u & 1023; const float c = j < 32 ? pC[j * 1024 + k] : pCC[k]; S[u] = silu_f(c); }
            __syncthreads();
            float acc[33];
#pragma unroll
            for (int j = 0; j < 33; ++j) acc[j] = 0.f;
            const float* wp = pAW + (size_t)layer * 1024 * 6144 + n0 + F.lane;
            const int kbeg = F.wave * 128;
            for (int k = kbeg; k < kbeg + 128; k += 4) {
                const float w0 = wp[(size_t)k * 6144], w1 = wp[(size_t)(k + 1) * 6144], w2 = wp[(size_t)(k + 2) * 6144], w3 = wp[(size_t)(k + 3) * 6144];
#pragma unroll
                for (int j = 0; j < 33; ++j) { const f32x4 s = *(const LAS f32x4*)(S + j * 1024 + k); acc[j] += s.x * w0 + s.y * w1 + s.z * w2 + s.w * w3; }
            }
            __syncthreads();
#pragma unroll
            for (int j = 0; j < 33; ++j) S[(F.wave * 33 + j) * 64 + F.lane] = acc[j];
            __syncthreads();
            for (int u = F.tid; u < 33 * 64; u += 512) { const int j = u >> 6, cl = u & 63; float s = 0.f;
#pragma unroll
                for (int w = 0; w < 8; ++w) s += S[(w * 33 + j) * 64 + cl];
                const int n = n0 + cl, part = n >> 10, col = n & 1023;
                s += pAB[layer * 6144 + n];
                if (part == 1) s = pNM[layer * 1024 + col] * (1.f + s);
                if (part == 4) s = pNF[layer * 1024 + col] * (1.f + s);
                MOD[((size_t)(layer * 33 + j) * 6 + part) * 1024 + col] = s; }
        }
        __syncthreads();
    }
    {
        const int gt = F.bid * 512 + F.tid, NT = F.G * 512;
        f32x2* tg = (f32x2*)(ws + WS_TABG); f32x2* tm = (f32x2*)(ws + WS_TABM);
        for (int u = gt; u < 64 * 32; u += NT) { const int pos = u >> 5, i = u & 31; const float inv = powf(10000.f, -(float)(2 * i) / 64.f); const float a = (float)pos * inv; tg[u] = (f32x2){cosf(a), sinf(a)}; }
        for (int u = gt; u < 64 * 16; u += NT) { const int pos = u >> 4, i = u & 15; const float inv = powf(10000.f, -(float)(2 * i) / 32.f); const float a = (float)pos * inv; tm[u] = (f32x2){cosf(a), sinf(a)}; }
        float* wrt = (float*)(ws + WS_WRT); const float* pRW = INP(I_RW); const float* pSW = INP(I_SGUW);
        for (int u = gt; u < 2 * 32 * 1024; u += NT) { const int l = u >> 15, e = (u >> 10) & 31, k = u & 1023; wrt[u] = pRW[((size_t)l * 1024 + k) * 32 + e]; }
        bf16_t* sw = (bf16_t*)(ws + WS_SGUW);
        for (int u = gt; u < 4 * 128 * 128; u += NT) sw[u] = f2bf(pSW[u]);
        u32x4* z = (u32x4*)(ws + WS_WIN1 + (size_t)832 * 1024 * 2);
        for (int u = gt; u < 192 * 1024 * 2 / 16; u += NT) z[u] = (u32x4){0u, 0u, 0u, 0u};
    }
    {
        LAS float* scr = (LAS float*)(F.lds + F.wave * 16384);
        const int gw = F.bid * 8 + F.wave, NGW = F.G * 8; const float* pW1 = INP(I_W1); const float* pW2 = INP(I_W2);
        constexpr int J0 = 16 * 64, J1 = 16 * 32, J2 = 16 * 26, J3 = 8 * 48, J4 = 4 * 64, J5 = 16 * 32, JW1 = 64 * 1024, JW2 = 64 * 512;
        constexpr int NITEMS = J0 + J1 + J2 + J3 + J4 + J5 + JW1 + JW2;
        for (int it = gw; it < NITEMS; it += NGW) {
            int r = it;
#if MOE_FP8
            if (r < JW1) { const int le = r >> 10; p0_transpose_item_fp8<1>(pW1 + (size_t)le * 1024 * 2048, 1024, 2048, (unsigned char*)(ws + WS_W1) + (size_t)le * 2048 * 1024, scr, r & 1023, F.lane); continue; } r -= JW1;
            if (r < JW2) { const int le = r >> 9; p0_transpose_item_fp8<0>(pW2 + (size_t)le * 1024 * 1024, 1024, 1024, (unsigned char*)(ws + WS_W2) + (size_t)le * 1024 * 1024, scr, r & 511, F.lane); continue; } r -= JW2;
#else
            if (r < JW1) { const int le = r >> 10; p0_transpose_item<1>(pW1 + (size_t)le * 1024 * 2048, 1024, 2048, (bf16_t*)(ws + WS_W1) + (size_t)le * 2048 * 1024, scr, r & 1023, F.lane); continue; } r -= JW1;
            if (r < JW2) { const int le = r >> 9; p0_transpose_item<0>(pW2 + (size_t)le * 1024 * 1024, 1024, 1024, (bf16_t*)(ws + WS_W2) + (size_t)le * 1024 * 1024, scr, r & 511, F.lane); continue; } r -= JW2;
#endif
            if (r < J0) { p0_transpose_item<0>(INP(I_ABWIN), 1024, 2048, (bf16_t*)(ws + WS_WIN0), scr, r, F.lane); continue; } r -= J0;
            if (r < J1) { p0_transpose_item<0>(INP(I_ABWOUT), 1024, 1024, (bf16_t*)(ws + WS_WOUT0), scr, r, F.lane); continue; } r -= J1;
            if (r < J2) { p0_transpose_item<0>(INP(I_MLAWIN), 1024, 832, (bf16_t*)(ws + WS_WIN1), scr, r, F.lane); continue; } r -= J2;
            if (r < J3) { p0_transpose_item<0>(INP(I_MLAWUQ), 512, 1536, (bf16_t*)(ws + WS_WUQ), scr, r, F.lane); continue; } r -= J3;
            if (r < J4) { p0_transpose_item<2>(INP(I_MLAWUKV), 256, 2048, (bf16_t*)(ws + WS_WUKV), scr, r, F.lane); continue; } r -= J4;
            p0_transpose_item<0>(INP(I_MLAWOUT), 1024, 1024, (bf16_t*)(ws + WS_WOUT1), scr, r, F.lane);
        }
    }
}

__device__ __forceinline__ void row_src_ptr(const float* px, const float* pctx, int r, const float*& src, int& mj) {
    const int b = r / TPB, pos = r - b * TPB;
    if (pos < CTXL) { src = pctx + ((size_t)b * CTXL + pos) * DM; mj = 32; } else { src = px + ((size_t)b * SEQ + (pos - CTXL)) * DM; mj = b; }
}
__device__ __forceinline__ void store_h_row(bf16_t* hrow, int lane, const f32x4 (&h)[4]) {
    unsigned long long* o8 = (unsigned long long*)hrow + lane;
#pragma unroll
    for (int j = 0; j < 4; ++j) o8[64 * j] = (unsigned long long)cvtpk(h[j].x, h[j].y) | ((unsigned long long)cvtpk(h[j].z, h[j].w) << 32);
}
__device__ __forceinline__ void p_norm0(Frame& F) {
    const float* MOD = (const float*)(F.ws + WS_MOD); bf16_t* H = (bf16_t*)(F.ws + WS_H);
    const int gw = F.bid * 8 + F.wave, NGW = F.G * 8; const float* px = INP(I_X); const float* pctx = INP(I_CTX);
    for (int r = gw; r < NTOK; r += NGW) {
        const float* src; int mj; row_src_ptr(px, pctx, r, src, mj);
        const f32x4* xr = (const f32x4*)src + F.lane; f32x4 v[4]; float ss = 0.f;
#pragma unroll
        for (int j = 0; j < 4; ++j) { v[j] = xr[64 * j]; ss += (v[j].x * v[j].x + v[j].y * v[j].y) + (v[j].z * v[j].z + v[j].w * v[j].w); }
        const float rstd = rsqrtf(wave_sum(ss) * (1.f / DM) + EPS);
        const f32x4* sh = (const f32x4*)(MOD + ((size_t)(0 * 33 + mj) * 6 + 0) * 1024) + F.lane; const f32x4* A = (const f32x4*)(MOD + ((size_t)(0 * 33 + mj) * 6 + 1) * 1024) + F.lane;
        f32x4 h[4];
#pragma unroll
        for (int j = 0; j < 4; ++j) h[j] = v[j] * rstd * A[64 * j] + sh[64 * j];
        store_h_row(H + (size_t)r * DM, F.lane, h);
    }
}
__device__ __forceinline__ void moe_prefix(Frame& F, int layer) {
    LAS int* pb = (LAS int*)(F.lds + XTRA_OFF + X_PB); LAS int* cn = (LAS int*)(F.lds + XTRA_OFF + X_CNT);
    const unsigned* gc = (const unsigned*)(F.ws + WS_CTL) + CW_CNT + layer * 64;
    __syncthreads();
    if (F.tid == 0) { int s = 0; for (int e = 0; e < 32; ++e) { const int c = (int)__hip_atomic_load(gc + e, __ATOMIC_RELAXED, __HIP_MEMORY_SCOPE_AGENT); cn[e] = c; pb[e] = s; s += (c + 255) >> 8; } pb[32] = s; }
    __syncthreads();
}
__device__ __forceinline__ void moe_gather_row(const Frame& F, int r, f32x4 (&f)[4]) {
    const LAS int* pb = (const LAS int*)(F.lds + XTRA_OFF + X_PB);
    const u32x2* ti = (const u32x2*)(F.ws + WS_TOKI) + (size_t)r * 4; const bf16_t* Y = (const bf16_t*)(F.ws + WS_Y);
#pragma unroll
    for (int j = 0; j < 4; ++j) f[j] = (f32x4){0.f, 0.f, 0.f, 0.f};
#pragma unroll
    for (int k = 0; k < 4; ++k) {
        const u32x2 t = ti[k]; const int e = (int)(t.x >> 20), pos = (int)(t.x & 0xfffffu); const float g = __uint_as_float(t.y);
        const size_t yrow = (size_t)pb[e] * 256 + pos;
#if Y_FP8
        const unsigned* yp = (const unsigned*)((const unsigned char*)Y + yrow * DM) + F.lane; const float g16 = g * (1.f / 16.f);
#pragma unroll
        for (int j = 0; j < 4; ++j) { const unsigned w = yp[64 * j]; const f32x2 lo = __builtin_amdgcn_cvt_pk_f32_fp8(w, false), hi2 = __builtin_amdgcn_cvt_pk_f32_fp8(w, true);
            f[j].x += g16 * lo.x; f[j].y += g16 * lo.y; f[j].z += g16 * hi2.x; f[j].w += g16 * hi2.y; }
#else
        const u32x2* yp = (const u32x2*)(Y + yrow * DM) + F.lane;
#pragma unroll
        for (int j = 0; j < 4; ++j) { const u32x2 w = yp[64 * j]; f[j].x += g * bflo(w.x); f[j].y += g * bfhi(w.x); f[j].z += g * bflo(w.y); f[j].w += g * bfhi(w.y); }
#endif
    }
}
__device__ __forceinline__ void p_combine_norm(Frame& F, int dry) {
    moe_prefix(F, 0);
    const float* MOD = (const float*)(F.ws + WS_MOD); bf16_t* H = (bf16_t*)(F.ws + (dry ? WS_SCR + 288 * MiB : WS_H)); float* XR = (float*)(F.ws + WS_XR); float* XW = dry ? (float*)(F.ws + WS_SCR) : XR;
    const int gw = F.bid * 8 + F.wave, NGW = F.G * 8;
    for (int r = gw; r < NTOK; r += NGW) {
        const int b = r / TPB, pos = r - b * TPB, mj = pos < CTXL ? 32 : b;
        f32x4 f[4]; moe_gather_row(F, r, f);
        const f32x4* xr = (const f32x4*)(XR + (size_t)r * DM) + F.lane; f32x4* xw = (f32x4*)(XW + (size_t)r * DM) + F.lane; const f32x4* g2 = (const f32x4*)(MOD + ((size_t)(0 * 33 + mj) * 6 + 5) * 1024) + F.lane;
        f32x4 v[4]; float ss = 0.f;
#pragma unroll
        for (int j = 0; j < 4; ++j) { v[j] = xr[64 * j] + g2[64 * j] * f[j]; xw[64 * j] = v[j]; ss += (v[j].x * v[j].x + v[j].y * v[j].y) + (v[j].z * v[j].z + v[j].w * v[j].w); }
        const float rstd = rsqrtf(wave_sum(ss) * (1.f / DM) + EPS);
        const f32x4* sh = (const f32x4*)(MOD + ((size_t)(1 * 33 + mj) * 6 + 0) * 1024) + F.lane; const f32x4* A = (const f32x4*)(MOD + ((size_t)(1 * 33 + mj) * 6 + 1) * 1024) + F.lane;
        f32x4 h[4];
#pragma unroll
        for (int j = 0; j < 4; ++j) h[j] = v[j] * rstd * A[64 * j] + sh[64 * j];
        store_h_row(H + (size_t)r * DM, F.lane, h);
    }
}
__device__ __forceinline__ void p_final(Frame& F) {
    moe_prefix(F, 1);
    const float* MOD = (const float*)(F.ws + WS_MOD); const float* XR = (const float*)(F.ws + WS_XR);
    const int gw = F.bid * 8 + F.wave, NGW = F.G * 8; const float* pfg = INP(I_FNG);
    for (int q = gw; q < NBATCH * SEQ; q += NGW) {
        const int b = q >> 11, t = q & 2047, r = b * TPB + CTXL + t;
        f32x4 f[4]; moe_gather_row(F, r, f);
        const f32x4* xr = (const f32x4*)(XR + (size_t)r * DM) + F.lane; const f32x4* g2 = (const f32x4*)(MOD + ((size_t)(1 * 33 + b) * 6 + 5) * 1024) + F.lane;
        f32x4 v[4]; float ss = 0.f;
#pragma unroll
        for (int j = 0; j < 4; ++j) { v[j] = xr[64 * j] + g2[64 * j] * f[j]; ss += (v[j].x * v[j].x + v[j].y * v[j].y) + (v[j].z * v[j].z + v[j].w * v[j].w); }
        const float rstd = rsqrtf(wave_sum(ss) * (1.f / DM) + EPS);
        const f32x4* fg = (const f32x4*)pfg + F.lane; f32x4* op = (f32x4*)(F.out + (size_t)q * DM) + F.lane;
#pragma unroll
        for (int j = 0; j < 4; ++j) op[64 * j] = v[j] * rstd * fg[64 * j];
    }
}
__device__ __forceinline__ void top4_of16(float (&v)[16], int hi, float (&tv)[4], int (&te)[4]) {
#pragma unroll
    for (int k = 0; k < 4; ++k) { float best = v[0]; int bi = 0;
#pragma unroll
        for (int r = 1; r < 16; ++r) { const bool bt = v[r] > best; best = bt ? v[r] : best; bi = bt ? r : bi; }
        tv[k] = best; te[k] = (bi & 3) + 8 * (bi >> 2) + 4 * hi;
#pragma unroll
        for (int r = 0; r < 16; ++r) v[r] = (r == bi) ? -3.0e38f : v[r]; }
}
template <int LAYER> __device__ __forceinline__ void p_norm_router(Frame& F, int dry) {
    const float* MOD = (const float*)(F.ws + WS_MOD); bf16_t* H = (bf16_t*)(F.ws + WS_H); const float* XR = (const float*)(F.ws + WS_XR);
    LAS f32x4* WL4 = (LAS f32x4*)F.lds;
    LAS int* hist = (LAS int*)(F.lds + XTRA_OFF + X_HIST); LAS int* base = (LAS int*)(F.lds + XTRA_OFF + X_BASE); LAS u32x2* sel = (LAS u32x2*)(F.lds + XTRA_OFF + X_SEL);
    LAS f32x4* A2L4 = (LAS f32x4*)(F.lds + XTRA_OFF + X_A2); LAS float* CBL = (LAS float*)(F.lds + XTRA_OFF + X_CB); LAS float* RSL = (LAS float*)(F.lds + XTRA_OFF + X_RS);
    unsigned* gcnt = (unsigned*)(F.ws + WS_CTL) + CW_CNT + LAYER * 64 + (dry ? 128 : 0);
    int* rowl = (int*)(F.ws + WS_ROWL); u32x2* toki = (u32x2*)(F.ws + WS_TOKI);
    const f32x4* wsrc = (const f32x4*)(F.ws + WS_WRT + (size_t)LAYER * 32 * 1024 * 4);
    __syncthreads();
    for (int u = F.tid; u < 8192; u += 512) { const int e = u >> 8, k4 = u & 255; WL4[e * 256 + (k4 ^ (e & 15))] = wsrc[u]; }
    if (F.tid < 32) hist[F.tid] = 0;
    const int lane = F.lane, r32 = lane & 31, hi = lane >> 5; const float* prb = INP(I_RB);
    constexpr int NP = LAYER == 0 ? NPAN : 256;
    for (int pi = F.bid; pi < NP; pi += F.G) {
        const int pan = LAYER == 0 ? pi : pi + pi / 8 + 1;
        const int b = pan / 9, mj = (pan % 9 == 0) ? 32 : b;
        const f32x4* shp = (const f32x4*)(MOD + ((size_t)(LAYER * 33 + mj) * 6 + 3) * 1024); const f32x4* Ap = (const f32x4*)(MOD + ((size_t)(LAYER * 33 + mj) * 6 + 4) * 1024);
        __syncthreads();
        if (F.tid < 256) A2L4[F.tid] = Ap[F.tid];
        {
            const int e = F.tid >> 4, part = F.tid & 15; float sum = 0.f;
#pragma unroll 4
            for (int q = 0; q < 16; ++q) { const f32x4 a = shp[part * 16 + q], w = wsrc[e * 256 + part * 16 + q]; sum += (a.x * w.x + a.y * w.y) + (a.z * w.z + a.w * w.w); }
            sum += xf1(sum); sum += xf2(sum); sum += xf4(sum); sum += xf8(sum);
            if (part == 0) CBL[e] = sum + prb[LAYER * 32 + e];
        }
        __syncthreads();
        const int row = pan * 256 + F.wave * 32 + r32;
        const f32x4* xp = (const f32x4*)(XR + (size_t)row * DM) + hi;
        const LAS f32x4* wrow = WL4 + r32 * 256; const int swz = r32 & 15;
        f32x16 acc = {}; float ssq = 0.f;
#define RT_LOAD(dst, mb) do { _Pragma("unroll") for (int u = 0; u < 8; ++u) dst[u] = xp[2 * ((mb) + u)]; } while (0)
#define RT_COMP(src, mb) do { _Pragma("unroll") for (int u = 0; u < 8; ++u) { const int k4 = 2 * ((mb) + u) + hi; const f32x4 a4 = A2L4[k4], w4 = wrow[k4 ^ swz]; const f32x4 x = src[u]; \
                ssq += (x.x * x.x + x.y * x.y) + (x.z * x.z + x.w * x.w); \
                acc = __builtin_amdgcn_mfma_f32_32x32x2f32(w4.x, x.x * a4.x, acc, 0, 0, 0); acc = __builtin_amdgcn_mfma_f32_32x32x2f32(w4.y, x.y * a4.y, acc, 0, 0, 0); \
                acc = __builtin_amdgcn_mfma_f32_32x32x2f32(w4.z, x.z * a4.z, acc, 0, 0, 0); acc = __builtin_amdgcn_mfma_f32_32x32x2f32(w4.w, x.w * a4.w, acc, 0, 0, 0); } } while (0)
        f32x4 xa[8], xb[8];
        RT_LOAD(xa, 0);
#pragma unroll 1
        for (int m0 = 0; m0 < 128; m0 += 16) {
            RT_LOAD(xb, m0 + 8); SBAR();
            RT_COMP(xa, m0); SBAR();
            if (m0 + 16 < 128) RT_LOAD(xa, m0 + 16);
            SBAR(); RT_COMP(xb, m0 + 8); SBAR();
        }
#undef RT_LOAD
#undef RT_COMP
        const float rstd = rsqrtf(sum32(ssq, ssq) * (1.f / DM) + EPS);
        float lg[16];
#pragma unroll
        for (int r = 0; r < 16; ++r) lg[r] = acc[r] * rstd + CBL[(r & 3) + 8 * (r >> 2) + 4 * hi];
        float tv[4], pv[4]; int te[4], pe[4];
        top4_of16(lg, hi, tv, te);
#pragma unroll
        for (int k = 0; k < 4; ++k) { pv[k] = __uint_as_float(xu32(__float_as_uint(tv[k]), lane)); pe[k] = (int)xu32((unsigned)te[k], lane); }
        float cv[8] = {tv[0], tv[1], tv[2], tv[3], pv[0], pv[1], pv[2], pv[3]}; int ce[8] = {te[0], te[1], te[2], te[3], pe[0], pe[1], pe[2], pe[3]};
        float gv[4]; int ge[4];
#pragma unroll
        for (int k = 0; k < 4; ++k) { float best = cv[0]; int be = ce[0];
#pragma unroll
            for (int c = 1; c < 8; ++c) { const bool bt = cv[c] > best || (cv[c] == best && ce[c] < be); best = bt ? cv[c] : best; be = bt ? ce[c] : be; }
            gv[k] = best; ge[k] = be;
#pragma unroll
            for (int c = 0; c < 8; ++c) cv[c] = (ce[c] == be) ? -3.0e38f : cv[c]; }
        const float x1 = __expf(gv[1] - gv[0]), x2 = __expf(gv[2] - gv[0]), x3 = __expf(gv[3] - gv[0]); const float inv = 1.f / (1.f + x1 + x2 + x3);
        {
            const int ea = hi ? ge[2] : ge[0], eb = hi ? ge[3] : ge[1]; const float ga = hi ? x2 * inv : inv, gb = hi ? x3 * inv : x1 * inv;
            const int ra = __hip_atomic_fetch_add(hist + ea, 1, __ATOMIC_RELAXED, __HIP_MEMORY_SCOPE_WORKGROUP), rb2 = __hip_atomic_fetch_add(hist + eb, 1, __ATOMIC_RELAXED, __HIP_MEMORY_SCOPE_WORKGROUP);
            const int rl = F.wave * 32 + r32;
            sel[rl * 4 + 2 * hi] = (u32x2){(unsigned)ea | ((unsigned)ra << 8), __float_as_uint(ga)}; sel[rl * 4 + 2 * hi + 1] = (u32x2){(unsigned)eb | ((unsigned)rb2 << 8), __float_as_uint(gb)};
            if (hi == 0) RSL[rl] = rstd;
        }
        {
            f32x4 Ar[4], Sr[4];
#pragma unroll
            for (int j = 0; j < 4; ++j) { Ar[j] = Ap[lane + 64 * j]; Sr[j] = shp[lane + 64 * j]; }
            for (int rr = 0; rr < 32; rr += 4) {
                const int rw = pan * 256 + F.wave * 32 + rr; f32x4 v[4][4];
#pragma unroll
                for (int t = 0; t < 4; ++t) { const f32x4* xr = (const f32x4*)(XR + (size_t)(rw + t) * DM) + lane;
#pragma unroll
                    for (int j = 0; j < 4; ++j) v[t][j] = xr[64 * j]; }
#pragma unroll
                for (int t = 0; t < 4; ++t) { const float rs = RSL[F.wave * 32 + rr + t]; f32x4 h[4];
#pragma unroll
                    for (int j = 0; j < 4; ++j) h[j] = v[t][j] * rs * Ar[j] + Sr[j];
                    if constexpr (MOE_FP8 != 0) { unsigned* o4 = (unsigned*)((unsigned char*)H + (size_t)(rw + t) * DM) + lane;
#pragma unroll
                        for (int j = 0; j < 4; ++j) o4[64 * j] = pk4_fp8(h[j].x * 4.f, h[j].y * 4.f, h[j].z * 4.f, h[j].w * 4.f); }
                    else store_h_row(H + (size_t)(rw + t) * DM, lane, h); }
            }
        }
        __syncthreads();
        if (F.tid < 32) { const int c = hist[F.tid]; base[F.tid] = c ? (int)__hip_atomic_fetch_add(gcnt + F.tid, (unsigned)c, __ATOMIC_RELAXED, __HIP_MEMORY_SCOPE_AGENT) : 0; }
        __syncthreads();
        for (int u = F.tid; u < 1024; u += 512) { const u32x2 sv = sel[u]; const int e = (int)(sv.x & 0xffu), pos = base[e] + (int)(sv.x >> 8), r = pan * 256 + (u >> 2);
            rowl[(size_t)e * ROWCAP + pos] = r; toki[(size_t)r * 4 + (u & 3)] = (u32x2){((unsigned)e << 20) | (unsigned)pos, sv.y}; }
        __syncthreads();
        if (F.tid < 32) hist[F.tid] = 0;
    }
    __syncthreads();
}

__device__ __forceinline__ void p_qk_prep(Frame& F) {
    bf16_t* P = (bf16_t*)(F.ws + WS_PBUF); const f32x2* tab = (const f32x2*)(F.ws + WS_TABG);
    const int lane = F.lane, sub = lane >> 4, a = lane & 15, gw = F.bid * 8 + F.wave, NGW = F.G * 8;
    const float* pq = INP(I_GQG); const float* pk = INP(I_GKG);
    float gq[8], gk[8], gqp[8], gkp[8];
#pragma unroll
    for (int j = 0; j < 8; ++j) { gq[j] = pq[8 * a + j]; gk[j] = pk[8 * a + j]; gqp[j] = pq[8 * (a ^ 4) + j]; gkp[j] = pk[8 * (a ^ 4) + j]; }
    const bool isx2 = (a & 4) != 0; const int fi = 8 * (a & 3);
    for (int rp = gw; rp < NTOK / 2; rp += NGW) {
#pragma unroll
        for (int g = 0; g < 3; ++g) {
            const int it = g * 4 + sub, hi6 = it >= 6 ? 1 : 0, r = rp * 2 + hi6, s = it - 6 * hi6;
            const int b = r / TPB, pos = r - b * TPB; const bool lat = pos >= CTXL; const int t = pos - CTXL;
            bf16_t* ptr = P + (size_t)r * 2048 + 1024 + s * 128 + 8 * a;
            const u32x4 w = *(const u32x4*)ptr; u32x4 wp;
#pragma unroll
            for (int q = 0; q < 4; ++q) wp[q] = (unsigned)__shfl_xor((int)w[q], 4);
            float x[8], xp[8];
#pragma unroll
            for (int q = 0; q < 4; ++q) { x[2 * q] = bflo(w[q]); x[2 * q + 1] = bfhi(w[q]); xp[2 * q] = bflo(wp[q]); xp[2 * q + 1] = bfhi(wp[q]); }
            float ss = 0.f;
#pragma unroll
            for (int j = 0; j < 8; ++j) ss += x[j] * x[j];
            ss += __shfl_xor(ss, 1); ss += __shfl_xor(ss, 2); ss += __shfl_xor(ss, 4); ss += __shfl_xor(ss, 8);
            const float rstd = rsqrtf(ss * (1.f / 128.f) + EPS); const bool isq = s < 4;
            float o[8];
#pragma unroll
            for (int j = 0; j < 8; ++j) { o[j] = x[j] * rstd * (isq ? gq[j] : gk[j]); xp[j] = xp[j] * rstd * (isq ? gqp[j] : gkp[j]); }
            if (lat) {
                const int pp = (a & 8) ? (t & 63) : (t >> 6); const f32x4* tp = (const f32x4*)(tab + pp * 32 + fi);
#pragma unroll
                for (int q = 0; q < 4; ++q) { const f32x4 cs = tp[q];
                    const float s0 = isx2 ? cs.y : -cs.y, s1 = isx2 ? cs.w : -cs.w;
                    o[2 * q] = o[2 * q] * cs.x + xp[2 * q] * s0; o[2 * q + 1] = o[2 * q + 1] * cs.z + xp[2 * q + 1] * s1; }
            }
            u32x4 wo; wo.x = cvtpk(o[0], o[1]); wo.y = cvtpk(o[2], o[3]); wo.z = cvtpk(o[4], o[5]); wo.w = cvtpk(o[6], o[7]);
            *(u32x4*)ptr = wo;
        }
    }
}
__device__ __forceinline__ void p_mla_prep(Frame& F) {
    bf16_t* P = (bf16_t*)(F.ws + WS_PBUF); bf16_t* KR = (bf16_t*)(F.ws + WS_KRB); const f32x2* tab = (const f32x2*)(F.ws + WS_TABM);
    const int gw = F.bid * 8 + F.wave, NGW = F.G * 8, lane = F.lane;
    const float* pqg = INP(I_MLAQG); const float* pkg = INP(I_MLAKVG);
    float qg[8], kg[4];
#pragma unroll
    for (int j = 0; j < 8; ++j) qg[j] = pqg[8 * lane + j];
#pragma unroll
    for (int j = 0; j < 4; ++j) kg[j] = pkg[4 * lane + j];
    const int krow = (lane >> 3) & 3, ka = lane & 7; const bool kx2 = (ka & 2) != 0; const int kfi = 8 * (ka & 1);
    for (int r0 = gw * 4; r0 < NTOK; r0 += NGW * 4) {
        const int b = r0 / TPB, pos0 = r0 - b * TPB; const bool lat = pos0 >= CTXL;
        u32x4 wq[4]; u32x2 wk[4];
#pragma unroll
        for (int rr = 0; rr < 4; ++rr) { const bf16_t* base = P + (size_t)(r0 + rr) * 1024; wk[rr] = *(const u32x2*)(base + 512 + 4 * lane); if (lat) wq[rr] = *(const u32x4*)(base + 8 * lane); }
        u32x4 wr = (u32x4){0u, 0u, 0u, 0u};
        if (lane < 32) wr = *(const u32x4*)(P + (size_t)(r0 + krow) * 1024 + 768 + 8 * ka);
        if (lat) {
#pragma unroll
            for (int rr = 0; rr < 4; ++rr) { float x[8];
#pragma unroll
                for (int q = 0; q < 4; ++q) { x[2 * q] = bflo(wq[rr][q]); x[2 * q + 1] = bfhi(wq[rr][q]); }
                float ss = 0.f;
#pragma unroll
                for (int j = 0; j < 8; ++j) ss += x[j] * x[j];
                const float rstd = rsqrtf(wave_sum(ss) * (1.f / 512.f) + EPS);
                u32x4 w;
#pragma unroll
                for (int q = 0; q < 4; ++q) w[q] = cvtpk(x[2 * q] * rstd * qg[2 * q], x[2 * q + 1] * rstd * qg[2 * q + 1]);
                *(u32x4*)(P + (size_t)(r0 + rr) * 1024 + 8 * lane) = w; }
        }
#pragma unroll
        for (int rr = 0; rr < 4; ++rr) { const float x0 = bflo(wk[rr].x), x1 = bfhi(wk[rr].x), x2 = bflo(wk[rr].y), x3 = bfhi(wk[rr].y);
            const float rstd = rsqrtf(wave_sum((x0 * x0 + x1 * x1) + (x2 * x2 + x3 * x3)) * (1.f / 256.f) + EPS);
            u32x2 w; w.x = cvtpk(x0 * rstd * kg[0], x1 * rstd * kg[1]); w.y = cvtpk(x2 * rstd * kg[2], x3 * rstd * kg[3]);
            *(u32x2*)(P + (size_t)(r0 + rr) * 1024 + 512 + 4 * lane) = w; }
        {
            u32x4 wp;
#pragma unroll
            for (int q = 0; q < 4; ++q) wp[q] = (unsigned)__shfl_xor((int)wr[q], 2);
            float o[8], xp[8];
#pragma unroll
            for (int q = 0; q < 4; ++q) { o[2 * q] = bflo(wr[q]); o[2 * q + 1] = bfhi(wr[q]); xp[2 * q] = bflo(wp[q]); xp[2 * q + 1] = bfhi(wp[q]); }
            if (lat) { const int t = pos0 + krow - CTXL, pp = (ka & 4) ? (t & 63) : (t >> 6); const f32x4* tp = (const f32x4*)(tab + pp * 16 + kfi);
#pragma unroll
                for (int q = 0; q < 4; ++q) { const f32x4 cs = tp[q]; const float s0 = kx2 ? cs.y : -cs.y, s1 = kx2 ? cs.w : -cs.w;
                    o[2 * q] = o[2 * q] * cs.x + xp[2 * q] * s0; o[2 * q + 1] = o[2 * q + 1] * cs.z + xp[2 * q + 1] * s1; } }
            u32x4 wo; wo.x = cvtpk(o[0], o[1]); wo.y = cvtpk(o[2], o[3]); wo.z = cvtpk(o[4], o[5]); wo.w = cvtpk(o[6], o[7]);
            if (lane < 32) *(u32x4*)(KR + (size_t)(r0 + krow) * 64 + 8 * ka) = wo;
        }
    }
}
__device__ __forceinline__ void p_sgu(Frame& F) {
    const bf16_t* P = (const bf16_t*)(F.ws + WS_PBUF); bf16_t* MIX = (bf16_t*)(F.ws + WS_MIX0); const bf16_t* SW = (const bf16_t*)(F.ws + WS_SGUW);
    const int tid = F.tid, lane = F.lane, wid = F.wave, hw = wid >> 2, w4 = wid & 3, th = tid & 255, r32 = lane & 31, hi = lane >> 5;
    LAS char* Vl = (LAS char*)F.lds + hw * 32768;
    const int sr = th >> 4, sc = (th & 15) * 8;
    const int vb0 = (int)(unsigned)(uintptr_t)Vl + att::v_rd_base(lane);
    const float* psg = INP(I_SGUNG); const float* psb = INP(I_SGUB);
    for (int U = F.bid; U < (NTOK / 128) * 2; U += F.G) {
        const int chunk = U >> 1, g = (U & 1) * 2 + hw; const size_t row0 = (size_t)chunk * 128;
        float gn[8];
#pragma unroll
        for (int j = 0; j < 8; ++j) gn[j] = psg[g * 128 + sc + j];
        __syncthreads();
#pragma unroll
        for (int i = 0; i < 8; ++i) {
            const int q = sr + 16 * i;
            u32x4 w = *(const u32x4*)(P + (row0 + q) * 2048 + 512 + g * 128 + sc); float x[8];
#pragma unroll
            for (int k = 0; k < 4; ++k) { x[2 * k] = bflo(w[k]); x[2 * k + 1] = bfhi(w[k]); }
            float ss = 0.f;
#pragma unroll
            for (int j = 0; j < 8; ++j) ss += x[j] * x[j];
            ss += __shfl_xor(ss, 1); ss += __shfl_xor(ss, 2); ss += __shfl_xor(ss, 4); ss += __shfl_xor(ss, 8);
            const float rstd = rsqrtf(ss * (1.f / 128.f) + EPS);
#pragma unroll
            for (int k = 0; k < 4; ++k) w[k] = cvtpk(x[2 * k] * rstd * gn[2 * k], x[2 * k + 1] * rstd * gn[2 * k + 1]);
            *(LAS u32x4*)(Vl + (q >> 6) * 16384 + att::v_st(q & 63, sc)) = w;
        }
        bf16x8 pa[8];
        const bf16_t* wrow = SW + ((size_t)g * 128 + 32 * w4 + r32) * 128 + 8 * hi;
#pragma unroll
        for (int k = 0; k < 8; ++k) pa[k] = *(const bf16x8*)(wrow + 16 * k);
        __syncthreads();
        f32x16 o[4] = {};
        att::pv_d0(o, vb0, pa[0], pa[1], pa[2], pa[3]);
        att::pv_d0(o, vb0 + 16384, pa[4], pa[5], pa[6], pa[7]);
#pragma unroll
        for (int r = 0; r < 16; ++r) { const int p = 32 * w4 + att::crow(r, hi); const float bs = psb[g * 128 + p];
#pragma unroll
            for (int d0 = 0; d0 < 4; ++d0) { const int c = d0 * 32 + r32; const float zu = bf2f(P[(row0 + p) * 2048 + g * 128 + c]);
                MIX[(row0 + p) * 1024 + g * 128 + c] = f2bf((o[d0][r] + bs) * zu); } }
    }
    __syncthreads();
}

using pg8::Unit; using pg8::Acc;
struct ProbIn0 {
    static constexpr bool PERM = true, GATHER = false, FP8 = false; int K, lda; const bf16_t* A; const bf16_t* Bt; bf16_t* O; pg8::StaticOrder so; int G, c;
    __device__ bool next(int i, Unit& u) const { return so.map((long)i * G + c, u.pm, u.pn); }
    __device__ const void* a_mat() const { return A; } __device__ const void* b_mat() const { return Bt; }
    __device__ unsigned a_off(const Unit& u) const { return (unsigned)u.pm * 256u * (unsigned)lda * 2u; }
    __device__ unsigned b_off(const Unit& u) const { return (unsigned)u.pn * 256u * (unsigned)K * 2u; }
    __device__ void a_voff(const Unit&, unsigned (&)[2][2]) const {}
    __device__ void epi(const Acc& acc, const Unit& u, int wr, int wc, int fr, int fq) const {
        bf16_t* dst = O + (size_t)u.pm * 256 * 2048 + u.pn * 256;
        if (u.pn < 4) pg8::epi_store_bf16<true>(acc, dst, 2048, nullptr, wr, wc, fr, fq); else pg8::epi_store_bf16<false>(acc, dst, 2048, nullptr, wr, wc, fr, fq);
    }
};
template <bool LATONLY> struct ProbPlain {
    static constexpr bool PERM = true, GATHER = false, FP8 = false; int K, lda; const bf16_t* A; const bf16_t* Bt; bf16_t* O; int ldc; pg8::StaticOrder so; int G, c;
    __device__ bool next(int i, Unit& u) const { int pm; if (!so.map((long)i * G + c, pm, u.pn)) return false; u.pm = LATONLY ? pm + pm / 8 + 1 : pm; return true; }
    __device__ const void* a_mat() const { return A; } __device__ const void* b_mat() const { return Bt; }
    __device__ unsigned a_off(const Unit& u) const { return (unsigned)u.pm * 256u * (unsigned)lda * 2u; }
    __device__ unsigned b_off(const Unit& u) const { return (unsigned)u.pn * 256u * (unsigned)K * 2u; }
    __device__ void a_voff(const Unit&, unsigned (&)[2][2]) const {}
    __device__ void epi(const Acc& acc, const Unit& u, int wr, int wc, int fr, int fq) const {
        pg8::epi_store_bf16<false>(acc, O + (size_t)u.pm * 256 * ldc + u.pn * 256, ldc, nullptr, wr, wc, fr, fq);
    }
};
struct ProbIn1 {
    static constexpr bool PERM = true, GATHER = false, FP8 = false; int K, lda; const bf16_t* A; const bf16_t* Bt; bf16_t* O; pg8::StaticOrder so; int G, c;
    __device__ bool next(int i, Unit& u) const {
        const long L = (long)i * G + c;
        if (L < 1024) { int pm; so.map(L, pm, u.pn); u.pm = pm + pm / 8 + 1; return true; }
        if (L < 1024 + 64) { const int q = (int)(L - 1024); u.pm = (q >> 1) * 9; u.pn = 2 + (q & 1); return true; }
        return false;
    }
    __device__ const void* a_mat() const { return A; } __device__ const void* b_mat() const { return Bt; }
    __device__ unsigned a_off(const Unit& u) const { return (unsigned)u.pm * 256u * (unsigned)lda * 2u; }
    __device__ unsigned b_off(const Unit& u) const { return (unsigned)u.pn * 256u * (unsigned)K * 2u; }
    __device__ void a_voff(const Unit&, unsigned (&)[2][2]) const {}
    __device__ void epi(const Acc& acc, const Unit& u, int wr, int wc, int fr, int fq) const {
        pg8::epi_store_bf16<false>(acc, O + (size_t)u.pm * 256 * 1024 + u.pn * 256, 1024, nullptr, wr, wc, fr, fq);
    }
};
template <int LAYER> struct ProbOut {
    static constexpr bool PERM = false, GATHER = false, FP8 = false; int K, lda; const bf16_t* A; const bf16_t* Bt; float* XR; const float* MOD; const float* xin; const float* cin; pg8::StaticOrder so; int G, c; float* dryout;
    __device__ bool next(int i, Unit& u) const { int pm; if (!so.map((long)i * G + c, pm, u.pn)) return false; u.pm = LAYER ? pm + pm / 8 + 1 : pm; return true; }
    __device__ const void* a_mat() const { return A; } __device__ const void* b_mat() const { return Bt; }
    __device__ unsigned a_off(const Unit& u) const { return (unsigned)u.pm * 256u * (unsigned)lda * 2u; }
    __device__ unsigned b_off(const Unit& u) const { return (unsigned)u.pn * 256u * (unsigned)K * 2u; }
    __device__ void a_voff(const Unit&, unsigned (&)[2][2]) const {}
    __device__ void epi(const Acc& acc, const Unit& u, int wr, int wc, int fr, int fq) const {
        const int b = u.pm / 9, jj = u.pm % 9, mj = jj == 0 ? 32 : b;
        const float* base = LAYER ? XR + (size_t)u.pm * 256 * DM : (jj == 0 ? cin + (size_t)b * CTXL * DM : xin + ((size_t)b * SEQ + (jj - 1) * 256) * DM);
        float* dst = (LAYER && dryout) ? dryout + ((size_t)b * SEQ + (jj - 1) * 256) * DM : XR + (size_t)u.pm * 256 * DM; const float* gate = MOD + ((size_t)(LAYER * 33 + mj) * 6 + 2) * 1024;
        const int row0 = wr * 64 + fr, col0 = u.pn * 256 + wc * 32 + 4 * fq;
        f32x4 gv[2][2];
#pragma unroll
        for (int bj = 0; bj < 2; ++bj)
#pragma unroll
            for (int n = 0; n < 2; ++n) gv[bj][n] = *(const f32x4*)(gate + col0 + bj * 128 + n * 16);
#pragma unroll
        for (int ai = 0; ai < 2; ++ai)
#pragma unroll
            for (int m = 0; m < 4; ++m) { const size_t off = (size_t)(row0 + ai * 128 + m * 16) * DM + col0;
#pragma unroll
                for (int bj = 0; bj < 2; ++bj)
#pragma unroll
                    for (int n = 0; n < 2; ++n) { const f32x4 bs = *(const f32x4*)(base + off + bj * 128 + n * 16); *(f32x4*)(dst + off + bj * 128 + n * 16) = bs + gv[bj][n] * acc[ai][bj][m][n]; } }
    }
};
struct MoeSched {
    const LAS int* pb; int NTN, G, c;
    __device__ bool map(int i, Unit& u) const {
        const int x = c & 7, q = i * (G >> 3) + (c >> 3); const int blk = (q / NTN) * 8 + x; u.pn = q % NTN;
        if (blk >= __builtin_amdgcn_readfirstlane(pb[32])) return false;
        int lo = 0;
#pragma unroll
        for (int st = 16; st >= 1; st >>= 1) { if (__builtin_amdgcn_readfirstlane(pb[lo + st]) <= blk) lo += st; }
        u.e = lo; u.rb = blk - __builtin_amdgcn_readfirstlane(pb[lo]); u.pm = blk; return true;
    }
};
struct ProbMoe1 {
    static constexpr bool PERM = true, GATHER = true, FP8 = MOE_FP8 != 0; int K, lda; const bf16_t* H; const bf16_t* W1; const float* B1; bf16_t* ACT; const int* rowl; const LAS int* cnt; MoeSched ms; int wave_s;
    __device__ bool next(int i, Unit& u) const { return ms.map(i, u); }
    __device__ const void* a_mat() const { return H; } __device__ const void* b_mat() const { return W1; }
    __device__ unsigned a_off(const Unit&) const { return 0u; }
    __device__ unsigned b_off(const Unit& u) const { return ((unsigned)u.e * 2048u + (unsigned)u.pn * 256u) * 1024u * (FP8 ? 1u : 2u); }
    __device__ void a_voff(const Unit& u, unsigned (&vo)[2][2]) const {
        const int n = cnt[u.e]; const int* rl = rowl + (size_t)u.e * ROWCAP + u.rb * 256;
        const int tidg = tid_fresh(wave_s);
#pragma unroll
        for (int i = 0; i < 2; ++i) { int R, C; pg8::stage_rc(tidg * 16 + i * 8192, R, C);
#pragma unroll
            for (int h = 0; h < 2; ++h) { const int ri = h * 128 + R; const int tok = (u.rb * 256 + ri < n) ? rl[ri] : 0; vo[h][i] = (unsigned)tok * (FP8 ? 1024u : 2048u) + (unsigned)C * 2u; } }
    }
    __device__ void epi(const Acc& acc, const Unit& u, int wr, int wc, int fr, int fq) const {
        const int row0 = wr * 64 + fr, col0 = u.pn * 128 + wc * 32 + 8 * fq;
        const float* bg = B1 + (size_t)u.e * 2048 + col0; const float* bl = bg + 1024;
        f32x4 bgv[2], blv[2];
#pragma unroll
        for (int n = 0; n < 2; ++n) { bgv[n] = *(const f32x4*)(bg + 4 * n); blv[n] = *(const f32x4*)(bl + 4 * n); }
        constexpr float SC = FP8 ? (1.f / 256.f) : 1.f;
        bf16_t* dst = ACT + (size_t)u.pm * 256 * 1024 + col0; unsigned char* dst8 = (unsigned char*)ACT + (size_t)u.pm * 256 * 1024 + col0;
#pragma unroll
        for (int ai = 0; ai < 2; ++ai)
#pragma unroll
            for (int m = 0; m < 4; ++m) { float a[8];
#pragma unroll
                for (int n = 0; n < 2; ++n) { const f32x4 g = acc[ai][0][m][n] * SC + bgv[n], l = acc[ai][1][m][n] * SC + blv[n];
#pragma unroll
                    for (int j = 0; j < 4; ++j) { const float gg = fminf(g[j], 7.f), ll = fminf(fmaxf(l[j], -7.f), 7.f);
                        a[4 * n + j] = gg * __builtin_amdgcn_rcpf(1.f + __builtin_amdgcn_exp2f(-1.702f * 1.4426950408889634f * gg)) * (ll + 1.f); } }
                if constexpr (FP8) { u32x2 w; w.x = pk4_fp8(a[0] * 8.f, a[1] * 8.f, a[2] * 8.f, a[3] * 8.f); w.y = pk4_fp8(a[4] * 8.f, a[5] * 8.f, a[6] * 8.f, a[7] * 8.f);
                    *(u32x2*)(dst8 + (size_t)(row0 + ai * 128 + m * 16) * 1024) = w; }
                else { u32x4 w; w.x = cvtpk(a[0], a[1]); w.y = cvtpk(a[2], a[3]); w.z = cvtpk(a[4], a[5]); w.w = cvtpk(a[6], a[7]);
                    *(u32x4*)(dst + (size_t)(row0 + ai * 128 + m * 16) * 1024) = w; } }
    }
};
struct ProbMoe2 {
    static constexpr bool PERM = true, GATHER = false, FP8 = MOE_FP8 != 0; int K, lda; const bf16_t* ACT; const bf16_t* W2; const float* B2; bf16_t* Y; MoeSched ms;
    __device__ bool next(int i, Unit& u) const { return ms.map(i, u); }
    __device__ const void* a_mat() const { return ACT; } __device__ const void* b_mat() const { return W2; }
    __device__ unsigned a_off(const Unit& u) const { return (unsigned)u.pm * 256u * 1024u * (FP8 ? 1u : 2u); }
    __device__ unsigned b_off(const Unit& u) const { return ((unsigned)u.e * 1024u + (unsigned)u.pn * 256u) * 1024u * (FP8 ? 1u : 2u); }
    __device__ void a_voff(const Unit&, unsigned (&)[2][2]) const {}
    __device__ void epi(const Acc& acc, const Unit& u, int wr, int wc, int fr, int fq) const {
        constexpr float SC = FP8 ? (1.f / 512.f) : 1.f;
#if Y_FP8
        const int row0 = wr * 64 + fr, col0 = wc * 32 + 8 * fq; const float* bias = B2 + (size_t)u.e * 1024 + u.pn * 256 + col0;
        f32x4 bv[2][2];
#pragma unroll
        for (int bj = 0; bj < 2; ++bj)
#pragma unroll
            for (int n = 0; n < 2; ++n) bv[bj][n] = *(const f32x4*)(bias + bj * 128 + 4 * n);
        unsigned char* dst = (unsigned char*)Y + ((size_t)u.pm * 256) * 1024 + u.pn * 256; const unsigned lane_off = (unsigned)(row0 * 1024 + col0);
#pragma unroll
        for (int ai = 0; ai < 2; ++ai)
#pragma unroll
            for (int m = 0; m < 4; ++m) { unsigned char* rowb = dst + (size_t)((ai * 128 + m * 16) * 1024);
#pragma unroll
                for (int bj = 0; bj < 2; ++bj) { const f32x4 v0 = (acc[ai][bj][m][0] * SC + bv[bj][0]) * 16.f, v1 = (acc[ai][bj][m][1] * SC + bv[bj][1]) * 16.f;
                    u32x2 w; w.x = pk4_fp8(v0[0], v0[1], v0[2], v0[3]); w.y = pk4_fp8(v1[0], v1[1], v1[2], v1[3]);
                    *(u32x2*)(rowb + lane_off + bj * 128) = w; } }
#else
        pg8::epi_store_bf16<false>(acc, Y + (size_t)u.pm * 256 * 1024 + u.pn * 256, 1024, B2 + (size_t)u.e * 1024 + u.pn * 256, wr, wc, fr, fq, SC);
#endif
    }
};

__global__ void __launch_bounds__(512, 2) fwd_kernel(Args args) {
    extern __shared__ __attribute__((aligned(16))) uchar lds_raw[];
    const int wave_s = __builtin_amdgcn_readfirstlane((int)threadIdx.x >> 6);
    Frame F; F.lds = (LAS uchar*)lds_raw; F.tid = tid_fresh(wave_s); F.lane = F.tid & 63; F.wave = wave_s; F.G = gridDim.x; F.bid = blockIdx.x;
    F.ws = args.ws; F.out = args.out;
    volatile LAS unsigned* MISC = (volatile LAS unsigned*)(F.lds + MISC_OFF);
    if (F.tid < 64) MISC[F.tid] = 0u;
    __syncthreads();
    unsigned* ctl = (unsigned*)(F.ws + WS_CTL);
    XcdBarrier bar; bar.bar = ctl + CW_BAR; bar.x = 0; bar.st = nullptr;
    const int lo = args.ph_lo, hi = args.ph_hi;
    if (hi - lo > 1) bar = xcd_barrier_post(ctl + CW_BAR, MISC + 8, F.tid == 0);
#ifndef PHMASK
#define PHMASK 0x7ffff
#endif
#define REFRAME() do { F.tid = tid_fresh(wave_s); F.lane = F.tid & 63; F.wave = wave_s; } while (0)
#define IN(k) (((PHMASK >> (k)) & 1) && lo <= (k) && (k) < hi)
#define SEAM(k) do { if (IN(k) && IN((k) + 1)) { const int t_ = tid_fresh(wave_s); xcd_barrier(bar, t_ == 0); } } while (0)
    uchar* ws = F.ws;
    bf16_t* H = (bf16_t*)(ws + WS_H); float* XR = (float*)(ws + WS_XR); const float* MOD = (const float*)(ws + WS_MOD);

    if (IN(0)) { REFRAME(); p0_prologue(F); } SEAM(0);
    if (IN(1)) { REFRAME(); p_norm0(F); } SEAM(1);
    if (IN(2)) { REFRAME(); ProbIn0 p; p.K = 1024; p.lda = 1024; p.A = H; p.Bt = (const bf16_t*)(ws + WS_WIN0); p.O = (bf16_t*)(ws + WS_PBUF); p.so.init(NPAN, 8); p.G = F.G; p.c = F.bid; pg8::gemm_phase(F.lds, p, wave_s); } SEAM(2);
    if (IN(3)) { REFRAME(); p_qk_prep(F); } SEAM(3);
    if (IN(4)) { REFRAME();
        const bf16_t* P = (const bf16_t*)(ws + WS_PBUF); bf16_t* MIX = (bf16_t*)(ws + WS_MIX0);
        for (int u = F.bid; u < 1024 + 128; u += F.G) {
            if (u < 1024) { const int qb = u & 7, g = (u >> 3) & 1, kvh = (u >> 4) & 1, b = u >> 5, h = kvh * 2 + g; const size_t kr0 = (size_t)b * TPB, qr0 = kr0 + CTXL + qb * 256;
                att::attn_unit<128, 2, false, 2048, 2048, 1024>(P + qr0 * 2048 + 1024 + h * 128, P + kr0 * 2048 + 1536 + kvh * 128, nullptr, P + kr0 * 2048 + 1792 + kvh * 128, MIX + qr0 * 1024 + 512 + h * 128, TPB, (LAS char*)F.lds, nullptr, 0, wave_s);
            } else { const int v = u - 1024, h = v & 3, b = v >> 2, kvh = h >> 1; const size_t kr0 = (size_t)b * TPB;
                att::attn_unit<128, 2, false, 2048, 2048, 1024>(P + kr0 * 2048 + 1024 + h * 128, P + kr0 * 2048 + 1536 + kvh * 128, nullptr, P + kr0 * 2048 + 1792 + kvh * 128, MIX + kr0 * 1024 + 512 + h * 128, CTXL, (LAS char*)F.lds, nullptr, 0, wave_s); }
        }
        REFRAME(); p_sgu(F);
    } SEAM(4);
    if (IN(5)) { REFRAME(); ProbOut<0> p; p.K = 1024; p.lda = 1024; p.A = (const bf16_t*)(ws + WS_MIX0); p.Bt = (const bf16_t*)(ws + WS_WOUT0); p.XR = XR; p.MOD = MOD; p.xin = INP(I_X); p.cin = INP(I_CTX); p.dryout = nullptr; p.so.init(NPAN, 4); p.G = F.G; p.c = F.bid; pg8::gemm_phase(F.lds, p, wave_s); } SEAM(5);
    if (IN(6)) { REFRAME(); p_norm_router<0>(F, args.dry); } SEAM(6);
    if (IN(7)) { REFRAME(); moe_prefix(F, 0); ProbMoe1 p; p.K = MOE_FP8 ? 512 : 1024; p.lda = p.K; p.H = H; p.W1 = (const bf16_t*)(ws + WS_W1); p.B1 = INP(I_B1); p.ACT = (bf16_t*)(ws + WS_ACT); p.rowl = (const int*)(ws + WS_ROWL);
        p.cnt = (const LAS int*)(F.lds + XTRA_OFF + X_CNT); p.wave_s = wave_s; p.ms.pb = (const LAS int*)(F.lds + XTRA_OFF + X_PB); p.ms.NTN = 8; p.ms.G = F.G; p.ms.c = F.bid; pg8::gemm_phase(F.lds, p, wave_s); } SEAM(7);
    if (IN(8)) { REFRAME(); moe_prefix(F, 0); ProbMoe2 p; p.K = MOE_FP8 ? 512 : 1024; p.lda = p.K; p.ACT = (const bf16_t*)(ws + WS_ACT); p.W2 = (const bf16_t*)(ws + WS_W2); p.B2 = INP(I_B2); p.Y = (bf16_t*)(ws + WS_Y);
        p.ms.pb = (const LAS int*)(F.lds + XTRA_OFF + X_PB); p.ms.NTN = 4; p.ms.G = F.G; p.ms.c = F.bid; pg8::gemm_phase(F.lds, p, wave_s); } SEAM(8);
    if (IN(9)) { REFRAME(); p_combine_norm(F, args.dry); } SEAM(9);
    if (IN(10)) { REFRAME(); ProbIn1 p; p.K = 1024; p.lda = 1024; p.A = H; p.Bt = (const bf16_t*)(ws + WS_WIN1); p.O = (bf16_t*)(ws + WS_PBUF); p.so.init(256, 4); p.G = F.G; p.c = F.bid; pg8::gemm_phase(F.lds, p, wave_s); } SEAM(10);
    if (IN(11)) { REFRAME(); p_mla_prep(F); } SEAM(11);
    if (IN(12)) { REFRAME();
        { ProbPlain<true> p; p.K = 512; p.lda = 1024; p.A = (const bf16_t*)(ws + WS_PBUF); p.Bt = (const bf16_t*)(ws + WS_WUQ); p.O = (bf16_t*)(ws + WS_QB); p.ldc = 1536; p.so.init(256, 6); p.G = F.G; p.c = F.bid; pg8::gemm_phase(F.lds, p, wave_s); }
        { ProbPlain<false> p; p.K = 256; p.lda = 1024; p.A = (const bf16_t*)(ws + WS_PBUF) + 512; p.Bt = (const bf16_t*)(ws + WS_WUKV); p.O = (bf16_t*)(ws + WS_KVB); p.ldc = 2048; p.so.init(NPAN, 8); p.G = F.G; p.c = F.bid; pg8::gemm_phase(F.lds, p, wave_s); }
    } SEAM(12);
    if (IN(13)) { REFRAME();
        const bf16_t* Q = (const bf16_t*)(ws + WS_QB); const bf16_t* KV = (const bf16_t*)(ws + WS_KVB); const bf16_t* KR = (const bf16_t*)(ws + WS_KRB); bf16_t* MIX = (bf16_t*)(ws + WS_MIX1);
        for (int u = F.bid; u < 2048; u += F.G) { const int qb = u & 7, h = (u >> 3) & 7, b = u >> 6; const size_t kr0 = (size_t)b * TPB, qr0 = kr0 + CTXL + qb * 256;
            att::attn_unit<192, 1, true, 1536, 2048, 1024>(Q + qr0 * 1536 + h * 192, KV + kr0 * 2048 + h * 128, KR + kr0 * 64, KV + kr0 * 2048 + 1024 + h * 128, MIX + qr0 * 1024 + h * 128, TPB, (LAS char*)F.lds, (const f32x2*)(ws + WS_TABM), qb * 256, wave_s); }
    } SEAM(13);
    if (IN(14)) { REFRAME(); ProbOut<1> p; p.K = 1024; p.lda = 1024; p.A = (const bf16_t*)(ws + WS_MIX1); p.Bt = (const bf16_t*)(ws + WS_WOUT1); p.XR = XR; p.MOD = MOD; p.xin = nullptr; p.cin = nullptr; p.dryout = args.dry ? F.out : nullptr; p.so.init(256, 4); p.G = F.G; p.c = F.bid; pg8::gemm_phase(F.lds, p, wave_s); } SEAM(14);
    if (IN(15)) { REFRAME(); p_norm_router<1>(F, args.dry); } SEAM(15);
    if (IN(16)) { REFRAME(); moe_prefix(F, 1); ProbMoe1 p; p.K = MOE_FP8 ? 512 : 1024; p.lda = p.K; p.H = H; p.W1 = (const bf16_t*)(ws + WS_W1 + (size_t)32 * 2048 * 1024 * (MOE_FP8 ? 1 : 2)); p.B1 = INP(I_B1) + 32 * 2048; p.ACT = (bf16_t*)(ws + WS_ACT); p.rowl = (const int*)(ws + WS_ROWL);
        p.cnt = (const LAS int*)(F.lds + XTRA_OFF + X_CNT); p.wave_s = wave_s; p.ms.pb = (const LAS int*)(F.lds + XTRA_OFF + X_PB); p.ms.NTN = 8; p.ms.G = F.G; p.ms.c = F.bid; pg8::gemm_phase(F.lds, p, wave_s); } SEAM(16);
    if (IN(17)) { REFRAME(); moe_prefix(F, 1); ProbMoe2 p; p.K = MOE_FP8 ? 512 : 1024; p.lda = p.K; p.ACT = (const bf16_t*)(ws + WS_ACT); p.W2 = (const bf16_t*)(ws + WS_W2 + (size_t)32 * 1024 * 1024 * (MOE_FP8 ? 1 : 2)); p.B2 = INP(I_B2) + 32 * 1024; p.Y = (bf16_t*)(ws + WS_Y);
        p.ms.pb = (const LAS int*)(F.lds + XTRA_OFF + X_PB); p.ms.NTN = 4; p.ms.G = F.G; p.ms.c = F.bid; pg8::gemm_phase(F.lds, p, wave_s); } SEAM(17);
    if (IN(18)) { REFRAME(); p_final(F); }
#undef IN
#undef SEAM
}

extern "C" void kernel_launch(void* const* d_in, const int* in_sizes, int n_in, void* d_out, int out_size, void* d_ws, size_t ws_size, hipStream_t stream) {
    static int grid = 0;
    if (grid == 0) {
        if (n_in != 28 || out_size != NBATCH * SEQ * DM || ws_size < WS_END) { fprintf(stderr, "kernel_launch: unexpected shapes (n_in %d out %d ws %zu, need ws >= %zu)\n", n_in, out_size, ws_size, (size_t)WS_END); grid = -1; return; }
        int dev = 0, cus = 0, per_cu = 0;
        if (hipGetDevice(&dev) != hipSuccess || hipDeviceGetAttribute(&cus, hipDeviceAttributeMultiprocessorCount, dev) != hipSuccess) { grid = -1; return; }
        if (hipFuncSetAttribute((const void*)fwd_kernel, hipFuncAttributeMaxDynamicSharedMemorySize, LDS_BYTES) != hipSuccess) { fprintf(stderr, "kernel_launch: hipFuncSetAttribute failed\n"); grid = -1; return; }
        if (hipOccupancyMaxActiveBlocksPerMultiprocessor(&per_cu, (const void*)fwd_kernel, 512, LDS_BYTES) != hipSuccess || per_cu < 1) { fprintf(stderr, "kernel_launch: occupancy query says %d blocks/CU\n", per_cu); }
        (void)hipGetLastError();
        grid = cus;
    }
    if (grid < 0) return;
    (void)hipMemsetAsync((char*)d_ws + WS_CTL, 0, CTL_BYTES, stream);
    Args a{};
    for (int i = 0; i < 28; ++i) a.in[i] = (const float*)d_in[i];
    a.out = (float*)d_out; a.ws = (uchar*)d_ws;
#if MK_ONE_LAUNCH
    a.ph_lo = 0; a.ph_hi = NPHASE;
    hipLaunchKernelGGL(fwd_kernel, dim3(grid), dim3(512), LDS_BYTES, stream, a);
#else
    for (int ph = 0; ph < NPHASE; ++ph) { a.ph_lo = ph; a.ph_hi = ph + 1; const int nrep = 1 + ((REPEAT_MASK >> ph) & 1); for (int rep = 0; rep < nrep; ++rep) { a.dry = (rep + 1 < nrep) ? 1 : 0; hipLaunchKernelGGL(fwd_kernel, dim3(grid), dim3(512), LDS_BYTES, stream, a); } }
#endif
}
```

```cpp
#include <hip/hip_runtime.h>
#include <cstdio>
#include <cstdint>

#ifndef MK_ONE_LAUNCH
#define MK_ONE_LAUNCH 1
#endif
#define REPEAT_MASK 0
#define USE_BUFFER_LDS 1
#define Y_FP8 1
#ifndef MOE_FP8
#define MOE_FP8 1
#endif

#define LAS __attribute__((address_space(3)))
typedef unsigned short bf16_t;
typedef unsigned char uchar;
typedef short bf16x8 __attribute__((ext_vector_type(8)));
typedef short s16x4 __attribute__((ext_vector_type(4)));
typedef float f32x2 __attribute__((ext_vector_type(2)));
typedef float f32x4 __attribute__((ext_vector_type(4)));
typedef float f32x16 __attribute__((ext_vector_type(16)));
typedef unsigned u32x2 __attribute__((ext_vector_type(2)));
typedef unsigned u32x4 __attribute__((ext_vector_type(4)));
typedef int i32x4 __attribute__((ext_vector_type(4)));
typedef int i32x8 __attribute__((ext_vector_type(8)));

constexpr int DM = 1024, NBATCH = 32, SEQ = 2048, CTXL = 256, TPB = SEQ + CTXL, NTOK = NBATCH * TPB, NPAN = NTOK / 256;
constexpr int NEXP = 32, TOPK = 4, ROWCAP = NTOK;
constexpr float EPS = 1e-6f;
constexpr int NPHASE = 19;

constexpr size_t MiB = 1u << 20;
constexpr size_t WS_CTL = 0, CTL_BYTES = 1 * MiB;
constexpr size_t WS_MOD = 1 * MiB;
constexpr size_t WS_TABG = 3 * MiB;
constexpr size_t WS_TABM = WS_TABG + 32768;
constexpr size_t WS_WRT = WS_TABG + 65536;
constexpr size_t WS_SGUW = WS_WRT + 262144;
constexpr size_t WS_WIN0 = 4 * MiB, WS_WOUT0 = 8 * MiB, WS_WIN1 = 10 * MiB, WS_WUQ = 12 * MiB, WS_WUKV = 14 * MiB, WS_WOUT1 = 15 * MiB;
constexpr size_t WS_W1 = 17 * MiB;
constexpr size_t WS_W2 = 273 * MiB;
constexpr size_t WS_ROWL = 401 * MiB;
constexpr size_t WS_TOKI = 410 * MiB;
constexpr size_t WS_XR = 413 * MiB;
constexpr size_t WS_H = 701 * MiB;
constexpr size_t WS_SCR = 845 * MiB;
constexpr size_t WS_PBUF = WS_SCR;
constexpr size_t WS_MIX0 = WS_SCR + 288 * MiB;
constexpr size_t WS_QB = WS_SCR + 144 * MiB;
constexpr size_t WS_KVB = WS_SCR + 360 * MiB;
constexpr size_t WS_KRB = WS_SCR + 648 * MiB;
constexpr size_t WS_MIX1 = WS_SCR + 660 * MiB;
constexpr size_t WS_ACT = WS_SCR;
constexpr size_t WS_Y = WS_SCR + 592 * MiB;
constexpr size_t WS_END = WS_SCR + 1184 * MiB;
constexpr int CW_BAR = 1024;
constexpr int CW_CNT = 8192;
constexpr int CW_DBG = 16384;

constexpr int RING_BYTES = 131072;
constexpr int XTRA_OFF = RING_BYTES, XTRA_BYTES = 20480;
constexpr int MISC_OFF = XTRA_OFF + XTRA_BYTES;
constexpr int LDS_BYTES = MISC_OFF + 512;
constexpr int X_PB = 0;
constexpr int X_CNT = 256;
constexpr int X_HIST = 512;
constexpr int X_BASE = 768;
constexpr int X_SEL = 1024;
constexpr int X_A2 = 9216;
constexpr int X_CB = 13312;
constexpr int X_RS = 13440;

#define LDS_WAIT() asm volatile("s_waitcnt lgkmcnt(0)" ::: "memory")
#define VM_WAIT() asm volatile("s_waitcnt vmcnt(0)" ::: "memory")
#define SBAR() __builtin_amdgcn_sched_barrier(0)
__device__ __forceinline__ unsigned cvtpk(float lo, float hi) { unsigned r; asm volatile("v_cvt_pk_bf16_f32 %0, %1, %2" : "=v"(r) : "v"(lo), "v"(hi)); return r; }
__device__ __forceinline__ float bf2f(unsigned short b) { return __uint_as_float(((unsigned)b) << 16); }
__device__ __forceinline__ float bflo(unsigned w) { return __uint_as_float(w << 16); }
__device__ __forceinline__ float bfhi(unsigned w) { return __uint_as_float(w & 0xffff0000u); }
__device__ __forceinline__ unsigned short f2bf(float f) { return (unsigned short)(cvtpk(f, 0.f) & 0xffffu); }
__device__ __forceinline__ unsigned pk4_fp8(float a, float b, float c, float d) {
    a = fminf(fmaxf(a, -448.f), 448.f); b = fminf(fmaxf(b, -448.f), 448.f); c = fminf(fmaxf(c, -448.f), 448.f); d = fminf(fmaxf(d, -448.f), 448.f);
    unsigned w = 0; w = __builtin_amdgcn_cvt_pk_fp8_f32(a, b, w, false); w = __builtin_amdgcn_cvt_pk_fp8_f32(c, d, w, true); return w;
}
__device__ __forceinline__ int tid_fresh(int wave_s) { int l; asm volatile("v_mbcnt_lo_u32_b32 %0, -1, 0\n\tv_mbcnt_hi_u32_b32 %0, -1, %0" : "=v"(l)); return wave_s * 64 + l; }
template <int CTRL, int BANK> __device__ __forceinline__ int dpp_i(int old, int x) { return __builtin_amdgcn_update_dpp(old, x, CTRL, 0xF, BANK, false); }
__device__ __forceinline__ int xs1(int x) { return dpp_i<0xB1, 0xF>(x, x); }
__device__ __forceinline__ int xs2(int x) { return dpp_i<0x4E, 0xF>(x, x); }
__device__ __forceinline__ int xs4(int x) { const int t = dpp_i<0x114, 0xA>(x, x); return dpp_i<0x104, 0x5>(t, x); }
__device__ __forceinline__ int xs8(int x) { return dpp_i<0x128, 0xF>(x, x); }
__device__ __forceinline__ float xf1(float x) { return __int_as_float(xs1(__float_as_int(x))); }
__device__ __forceinline__ float xf2(float x) { return __int_as_float(xs2(__float_as_int(x))); }
__device__ __forceinline__ float xf4(float x) { return __int_as_float(xs4(__float_as_int(x))); }
__device__ __forceinline__ float xf8(float x) { return __int_as_float(xs8(__float_as_int(x))); }
__device__ __forceinline__ float sum16(float a, float b) { auto r = __builtin_amdgcn_permlane16_swap(__float_as_uint(a), __float_as_uint(b), false, false); return __uint_as_float(r[0]) + __uint_as_float(r[1]); }
__device__ __forceinline__ float sum32(float a, float b) { auto r = __builtin_amdgcn_permlane32_swap(__float_as_uint(a), __float_as_uint(b), false, false); return __uint_as_float(r[0]) + __uint_as_float(r[1]); }
__device__ __forceinline__ unsigned xu16(unsigned x, int lane) { auto r = __builtin_amdgcn_permlane16_swap(x, x, false, false); return (lane & 16) ? r[0] : r[1]; }
__device__ __forceinline__ unsigned xu32(unsigned x, int lane) { auto r = __builtin_amdgcn_permlane32_swap(x, x, false, false); return (lane & 32) ? r[0] : r[1]; }
__device__ __forceinline__ float wave_sum(float v) {
    v += xf1(v); v += xf2(v); v += xf4(v); v += xf8(v); v = sum16(v, v); v = sum32(v, v);
    return v;
}
__device__ __forceinline__ float silu_f(float x) { return x / (1.f + __expf(-x)); }
__device__ __forceinline__ float gelu_tanh_f(float x) {
    const float u = x * (1.5957691216057308f + 0.07135481627260025f * x * x);
    const float e = __builtin_amdgcn_exp2f(-1.4426950408889634f * u);
    return x * __builtin_amdgcn_rcpf(1.f + e);
}

#define XB_TMO      128
#define XB_XCNT(j)  (256  + 64 * (j))
#define XB_XSUB(j)  (1280 + 64 * (j))
#define XB_XGEN(j)  (2304 + 64 * (j))
#define XB_TOP      3328
#define XB_TOPGEN   3392
#define XCD_BAR_WORDS 3456
#define XB_SPIN_CAP (1u << 20)
__device__ __forceinline__ unsigned xb_ld(unsigned* p)              { return __hip_atomic_load(p, __ATOMIC_RELAXED, __HIP_MEMORY_SCOPE_AGENT); }
__device__ __forceinline__ unsigned xb_add(unsigned* p, unsigned v) { return __hip_atomic_fetch_add(p, v, __ATOMIC_RELAXED, __HIP_MEMORY_SCOPE_AGENT); }
__device__ __forceinline__ unsigned xb_xcc_id() { return (unsigned)__builtin_amdgcn_s_getreg((3 << 11) | 20) & 0xFu; }
#define XB_SPIN(cond, bar) do { unsigned _sp = 0; while (cond) { __builtin_amdgcn_s_sleep(1); \
    if ((++_sp & 255u) == 0u) { if (xb_ld(&(bar)[XB_TMO])) break; if (_sp > XB_SPIN_CAP) { atomicAdd(&(bar)[XB_TMO], 1u); break; } } } } while (0)
struct XcdBarrier { unsigned* bar; unsigned x; volatile LAS unsigned* st; };
__device__ __forceinline__ XcdBarrier xcd_barrier_post(unsigned* bar, volatile LAS unsigned* st, bool t0) {
    XcdBarrier b; b.bar = bar; b.x = xb_xcc_id(); b.st = st;
    if (t0) (void)xb_add(&bar[XB_XCNT(b.x)], 1u);
    return b;
}
__device__ __forceinline__ void xcd_barrier_complete(unsigned* bar, unsigned x, unsigned& nloc, unsigned& nx) {
    const unsigned G = gridDim.x * gridDim.y * gridDim.z;
    unsigned sum, cnt, mine, sp = 0u;
    for (;;) {
        sum = 0u; cnt = 0u; mine = 0u;
#pragma unroll
        for (unsigned j = 0; j < 16; ++j) { const unsigned c = xb_ld(&bar[XB_XCNT(j)]); sum += c; cnt += (c > 0u) ? 1u : 0u; mine = (j == x) ? c : mine; }
        if (sum == G) break;
        __builtin_amdgcn_s_sleep(1);
        if ((++sp & 255u) == 0u) { if (xb_ld(&bar[XB_TMO])) break; if (sp > XB_SPIN_CAP) { atomicAdd(&bar[XB_TMO], 1u); break; } }
    }
    nloc = mine > 0u ? mine : 1u; nx = cnt > 0u ? cnt : 1u;
}
__device__ __forceinline__ void xcd_barrier(const XcdBarrier& b, bool t0) {
    asm volatile("s_waitcnt vmcnt(0)" ::: "memory");
    __syncthreads();
    if (t0) {
        unsigned* bar = b.bar;
        __builtin_amdgcn_s_waitcnt(0);
        unsigned nloc = b.st[0], nx = b.st[1];
        if (nloc == 0u) { xcd_barrier_complete(bar, b.x, nloc, nx); b.st[0] = nloc; b.st[1] = nx; }
        const unsigned old = xb_add(&bar[XB_XSUB(b.x)], 1u);
        const unsigned gen = old / nloc;
        if (old + 1u == (gen + 1u) * nloc) {
            __builtin_amdgcn_fence(__ATOMIC_RELEASE, "agent");
            asm volatile("s_waitcnt vmcnt(0)" ::: "memory");
            const unsigned og = xb_add(&bar[XB_TOP], 1u);
            const unsigned tg = og / nx;
            if (og + 1u == (tg + 1u) * nx) xb_add(&bar[XB_TOPGEN], 1u);
            else XB_SPIN(xb_ld(&bar[XB_TOPGEN]) == tg, bar);
            __builtin_amdgcn_fence(__ATOMIC_ACQUIRE, "agent");
            xb_add(&bar[XB_XGEN(b.x)], 1u);
            asm volatile("s_waitcnt vmcnt(0)" ::: "memory");
        } else {
            XB_SPIN(xb_ld(&bar[XB_XGEN(b.x)]) == gen, bar);
            __builtin_amdgcn_fence(__ATOMIC_ACQUIRE, "agent");
            asm volatile("s_waitcnt vmcnt(0)" ::: "memory");
        }
    }
    __syncthreads();
}

struct Args { const float* in[28]; float* out; uchar* ws; int ph_lo, ph_hi, dry, pad; };
enum { I_X = 0, I_C, I_CTX, I_CCTX, I_ADAW, I_ADAB, I_NMIXG, I_NFFNG, I_ABWIN, I_SGUNG, I_SGUW, I_SGUB, I_GQG, I_GKG, I_ABWOUT, I_MLAWIN, I_MLAQG, I_MLAKVG, I_MLAWUQ, I_MLAWUKV, I_MLAWOUT,
       I_RW, I_RB, I_W1, I_B1, I_W2, I_B2, I_FNG };
struct Frame {
    LAS uchar* lds; int tid, lane, wave, G, bid;
    uchar* ws; float* out;
};
__device__ __forceinline__ const float* INP(int i) {
    const __attribute__((address_space(4))) char* ka = (const __attribute__((address_space(4))) char*)__builtin_amdgcn_kernarg_segment_ptr();
    return *(const float* const volatile __attribute__((address_space(4)))*)(ka + i * 8);
}

namespace pg8 {
constexpr int BM = 256, BK = 64, HALF = 128, HTB = HALF * BK * 2, NXCD = 8, WGM = 8;
__device__ __forceinline__ int lds_byte(int r, int c) { const int st = (r >> 4) * 2 + (c >> 5), rr = r & 15, cc = c & 31, ob = rr * 64 + cc * 2; return st * 1024 + (ob ^ (((ob >> 9) & 1) << 5)); }
__device__ __forceinline__ void stage_rc(int b, int& R, int& C) { const int st = b / 1024, sb = b % 1024, swz = sb ^ (((sb >> 9) & 1) << 5); R = (st >> 1) * 16 + swz / 64; C = (st & 1) * 32 + (swz % 64) / 2; }
__device__ __forceinline__ int perm32(int rho) { const int n = rho >> 4, i = rho & 15; return 8 * (i >> 2) + 4 * n + (i & 3); }
struct Unit { int pm, pn, e, rb; };
struct StaticOrder {
    int nM, nN, nwg;
    __device__ void init(int nM_, int nN_) { nM = nM_; nN = nN_; nwg = nM * nN; }
    __device__ bool map(long L, int& pm, int& pn) const {
        if (L >= nwg) return false;
        int wgid = (int)L; { const int q = nwg / NXCD, r = nwg % NXCD, xcd = wgid % NXCD, off = wgid / NXCD; wgid = (xcd < r ? xcd * (q + 1) : r * (q + 1) + (xcd - r) * q) + off; }
        const int nig = WGM * nN, gid = wgid / nig, fm = gid * WGM, gsz = (nM - fm) < WGM ? (nM - fm) : WGM;
        pm = fm + ((wgid % nig) % gsz); pn = (wgid % nig) / gsz; return true;
    }
};
typedef f32x4 Acc[2][2][4][2];
template <class P>
__device__ __forceinline__ void gemm_phase(LAS uchar* lds, const P& p, int wave_s) {
    const int tid = tid_fresh(wave_s), wid = __builtin_amdgcn_readfirstlane(tid >> 6), lane = tid & 63, wr = wid >> 2, wc = wid & 3, fr = lane & 15, fq = lane >> 4;
    const int K = p.K, nt = K / BK;
    unsigned voffA[2][2], voffB[2];
#pragma unroll
    for (int i = 0; i < 2; ++i) { int R, C; stage_rc(tid * 16 + i * 8192, R, C); const int Rb = P::PERM ? ((R & ~31) + perm32(R & 31)) : R;
        voffA[0][i] = (unsigned)(R * p.lda + C) * 2u; voffA[1][i] = voffA[0][i]; voffB[i] = (unsigned)(Rb * K + C) * 2u; }
    const unsigned kstep = (unsigned)(BK * 2);
    const unsigned hstepB = (unsigned)HALF * K * 2;
    const unsigned hstepA = P::GATHER ? 0u : (unsigned)HALF * p.lda * 2;
#define PG8_VA1 voffA[P::GATHER ? 1 : 0]
    const __amdgpu_buffer_rsrc_t rsA = __builtin_amdgcn_make_buffer_rsrc((void*)p.a_mat(), 0, 0xffffffffu, 0x00020000);
    const __amdgpu_buffer_rsrc_t rsB = __builtin_amdgcn_make_buffer_rsrc((void*)p.b_mat(), 0, 0xffffffffu, 0x00020000);
    const char* gpA = (const char*)p.a_mat(); const char* gpB = (const char*)p.b_mat(); (void)gpA; (void)gpB; (void)rsA; (void)rsB;
    const unsigned ldsw = (unsigned)wid * 1024u;
    const int aoff = lds_byte(wr * 64 + fr, fq * 8), boff = lds_byte(wc * 32 + fr, fq * 8);
#define PG8_SA(b, h) (((b) * 2 + (h)) * HTB)
#define PG8_SB(b, h) ((4 + (b) * 2 + (h)) * HTB)
#if USE_BUFFER_LDS
#define PG8_STAGE_R(bufoff, rs, gp, soff, voff) do { _Pragma("unroll") for (int _i = 0; _i < 2; ++_i) \
        __builtin_amdgcn_raw_ptr_buffer_load_lds(rs, (LAS unsigned*)(lds + (bufoff) + ldsw + _i * 8192), 16, (int)(voff)[_i], (int)(soff), 0, 0); } while (0)
#else
#define PG8_STAGE_R(bufoff, rs, gp, soff, voff) do { _Pragma("unroll") for (int _i = 0; _i < 2; ++_i) \
        __builtin_amdgcn_global_load_lds((const unsigned*)((const char*)(gp) + (size_t)(soff) + (voff)[_i]), (LAS unsigned*)(lds + (bufoff) + ldsw + _i * 8192), 16, 0, 0); } while (0)
#endif
#define PG8_STAGE_A(bufoff, soff, voff) PG8_STAGE_R(bufoff, rsA, gpA, soff, voff)
#define PG8_STAGE_B(bufoff, soff, voff) PG8_STAGE_R(bufoff, rsB, gpB, soff, voff)
#define PG8_LDA(dst, b, h) do { _Pragma("unroll") for (int m = 0; m < 4; ++m) _Pragma("unroll") for (int k = 0; k < 2; ++k) dst[m][k] = *(const LAS i32x4*)(lds + PG8_SA(b, h) + aoff + m * 2048 + k * 1024); } while (0)
#define PG8_LDB(dst, b, h) do { _Pragma("unroll") for (int n = 0; n < 2; ++n) _Pragma("unroll") for (int k = 0; k < 2; ++k) dst[n][k] = *(const LAS i32x4*)(lds + PG8_SB(b, h) + boff + n * 2048 + k * 1024); } while (0)
#define PG8_CAT(x) __builtin_shufflevector((x)[0], (x)[1], 0, 1, 2, 3, 4, 5, 6, 7)
#define PG8_MMA(ai, bj, At, Bt) do { __builtin_amdgcn_s_setprio(1); \
        if constexpr (P::FP8) { _Pragma("unroll") for (int m = 0; m < 4; ++m) _Pragma("unroll") for (int n = 0; n < 2; ++n) \
            acc[ai][bj][m][n] = __builtin_amdgcn_mfma_scale_f32_16x16x128_f8f6f4(PG8_CAT(Bt[n]), PG8_CAT(At[m]), acc[ai][bj][m][n], 0, 0, 0, 0x7F7F7F7F, 0, 0x7F7F7F7F); } \
        else { _Pragma("unroll") for (int m = 0; m < 4; ++m) _Pragma("unroll") for (int n = 0; n < 2; ++n) _Pragma("unroll") for (int k = 0; k < 2; ++k) \
            acc[ai][bj][m][n] = __builtin_amdgcn_mfma_f32_16x16x32_bf16(__builtin_bit_cast(bf16x8, Bt[n][k]), __builtin_bit_cast(bf16x8, At[m][k]), acc[ai][bj][m][n], 0, 0, 0); } \
        __builtin_amdgcn_s_setprio(0); } while (0)
#define PG8_WAIT_V(n) asm volatile("s_waitcnt vmcnt(" #n ")" ::: "memory")
#define PG8_WAIT_L(n) asm volatile("s_waitcnt lgkmcnt(" #n ")" ::: "memory")
#define PG8_BAR __builtin_amdgcn_s_barrier()
#define PG8_SCHED __builtin_amdgcn_sched_barrier(0)
    Unit cur, nxt; int ui = 0;
    if (!p.next(0, cur)) return;
    Acc acc;
#pragma unroll
    for (int a = 0; a < 2; ++a)
#pragma unroll
        for (int b = 0; b < 2; ++b)
#pragma unroll
            for (int m = 0; m < 4; ++m)
#pragma unroll
                for (int n = 0; n < 2; ++n) acc[a][b][m][n] = (f32x4){0.f, 0.f, 0.f, 0.f};
    i32x4 At[4][2], B0[2][2], B1[2][2];
    unsigned cA = p.a_off(cur), cB = p.b_off(cur);
    if constexpr (P::GATHER) { p.a_voff(cur, voffA); }
    PG8_STAGE_B(PG8_SB(0, 0), cB, voffB); PG8_STAGE_B(PG8_SB(0, 1), cB + hstepB, voffB); PG8_STAGE_A(PG8_SA(0, 0), cA, voffA[0]); PG8_STAGE_A(PG8_SA(0, 1), cA + hstepA, PG8_VA1);
    if (wr == 1) PG8_BAR;
    PG8_WAIT_V(2); PG8_BAR;
    PG8_STAGE_B(PG8_SB(1, 0), cB + kstep, voffB); PG8_STAGE_A(PG8_SA(1, 0), cA + kstep, voffA[0]); PG8_STAGE_B(PG8_SB(1, 1), cB + hstepB + kstep, voffB);
    PG8_WAIT_V(6); PG8_BAR;
    for (;;) {
        const bool has_next = p.next(ui + 1, nxt);
        const unsigned nA = has_next ? p.a_off(nxt) : cA, nB = has_next ? p.b_off(nxt) : cB;
        for (int t = 0; t < nt; t += 2) {
            const bool last = (t == nt - 2);
            const unsigned a1 = cA + (unsigned)(t + 1) * kstep;
            const unsigned a2 = last ? nA : cA + (unsigned)(t + 2) * kstep, b2 = last ? nB : cB + (unsigned)(t + 2) * kstep;
            const unsigned a3 = a2 + kstep, b3 = b2 + kstep;
            PG8_LDB(B0, 0, 0); PG8_LDB(B1, 0, 1); PG8_SCHED; PG8_LDA(At, 0, 0); PG8_STAGE_A(PG8_SA(1, 1), a1 + hstepA, PG8_VA1);
            if constexpr (P::GATHER) { if (last && has_next) p.a_voff(nxt, voffA); }
            PG8_WAIT_V(8); PG8_WAIT_L(0); PG8_BAR; PG8_MMA(0, 0, At, B0); PG8_MMA(0, 1, At, B1); PG8_BAR; PG8_SCHED;
            PG8_LDA(At, 0, 1); PG8_STAGE_B(PG8_SB(0, 0), b2, voffB); PG8_STAGE_B(PG8_SB(0, 1), b2 + hstepB, voffB); PG8_STAGE_A(PG8_SA(0, 0), a2, voffA[0]);
            PG8_WAIT_V(8); PG8_WAIT_L(0); PG8_BAR; PG8_MMA(1, 0, At, B0); PG8_MMA(1, 1, At, B1); PG8_BAR; PG8_SCHED;
            PG8_LDB(B0, 1, 0); PG8_LDB(B1, 1, 1); PG8_SCHED; PG8_LDA(At, 1, 0); PG8_STAGE_A(PG8_SA(0, 1), a2 + hstepA, PG8_VA1);
            PG8_WAIT_V(8); PG8_WAIT_L(0); PG8_BAR; PG8_MMA(0, 0, At, B0); PG8_MMA(0, 1, At, B1); PG8_BAR; PG8_SCHED;
            PG8_LDA(At, 1, 1); PG8_STAGE_B(PG8_SB(1, 0), b3, voffB); PG8_STAGE_B(PG8_SB(1, 1), b3 + hstepB, voffB); PG8_STAGE_A(PG8_SA(1, 0), a3, voffA[0]);
            PG8_WAIT_V(8); PG8_WAIT_L(0); PG8_BAR; PG8_MMA(1, 0, At, B0); PG8_MMA(1, 1, At, B1); PG8_BAR; PG8_SCHED;
        }
        if (wr == 0) PG8_BAR;
        p.epi(acc, cur, wr, wc, fr, fq);
        if (!has_next) break;
#pragma unroll
        for (int a = 0; a < 2; ++a)
#pragma unroll
            for (int b = 0; b < 2; ++b)
#pragma unroll
                for (int m = 0; m < 4; ++m)
#pragma unroll
                    for (int n = 0; n < 2; ++n) acc[a][b][m][n] = (f32x4){0.f, 0.f, 0.f, 0.f};
        cur = nxt; cA = nA; cB = nB; ++ui;
        if (wr == 1) PG8_BAR;
    }
    PG8_WAIT_V(0);
    PG8_BAR;
#undef PG8_SA
#undef PG8_VA1
#undef PG8_SB
#undef PG8_STAGE_R
#undef PG8_STAGE_A
#undef PG8_STAGE_B
#undef PG8_LDA
#undef PG8_LDB
#undef PG8_MMA
#undef PG8_CAT
#undef PG8_WAIT_V
#undef PG8_WAIT_L
#undef PG8_BAR
#undef PG8_SCHED
}

template <bool GELU>
__device__ __forceinline__ void epi_store_bf16(const Acc& acc, bf16_t* dst  , int ldc, const float* bias  , int wr, int wc, int fr, int fq, float sc = 1.f) {
    const int row0 = wr * 64 + fr, col0 = wc * 32 + 8 * fq;
    f32x4 bv[2][2];
#pragma unroll
    for (int bj = 0; bj < 2; ++bj)
#pragma unroll
        for (int n = 0; n < 2; ++n) bv[bj][n] = bias ? *(const f32x4*)(bias + col0 + bj * HALF + 4 * n) : (f32x4){0.f, 0.f, 0.f, 0.f};
    const unsigned lane_off = (unsigned)(row0 * ldc + col0) * 2u;
#pragma unroll
    for (int ai = 0; ai < 2; ++ai)
#pragma unroll
        for (int m = 0; m < 4; ++m) { char* rowb = (char*)dst + (size_t)((ai * HALF + m * 16) * ldc) * 2;
#pragma unroll
            for (int bj = 0; bj < 2; ++bj) { f32x4 v0 = acc[ai][bj][m][0] * sc + bv[bj][0], v1 = acc[ai][bj][m][1] * sc + bv[bj][1];
                if (GELU) {
#pragma unroll
                    for (int j = 0; j < 4; ++j) { v0[j] = gelu_tanh_f(v0[j]); v1[j] = gelu_tanh_f(v1[j]); } }
                u32x4 w; w.x = cvtpk(v0[0], v0[1]); w.y = cvtpk(v0[2], v0[3]); w.z = cvtpk(v1[0], v1[1]); w.w = cvtpk(v1[2], v1[3]);
                *(u32x4*)(rowb + lane_off + bj * HALF * 2) = w; } }
}
}

namespace att {
constexpr int NW = 8, QBLK = 32, KVBLK = 64;
constexpr int SHM_V = KVBLK * 128 * 2;
constexpr float THR = 8.f;
__device__ __forceinline__ int crow(int r, int hi) { return (r & 3) + 8 * (r >> 2) + 4 * hi; }
template <int DQK> struct Cfg { static constexpr float SCALE = (DQK == 128) ? 0.088388347648318440f : 0.072168783648703220f; static constexpr int KP = DQK * 2, SHM_K = KVBLK * DQK * 2, ND = DQK / 16; };
#define KSWZ(PITCH, row, colB) ((row) * (PITCH) + ((colB) ^ (((row) & 7) << 4)))
template <int DQK> __device__ __forceinline__ void partialSM(f32x16& p0, f32x16& p1, float& m_reg, float& mn, float& alpha) {
    constexpr float SCALE = Cfg<DQK>::SCALE, C = SCALE * 1.4426950408889634f;
    float pmax = p0[0];
#pragma unroll
    for (int r = 1; r < 16; ++r) pmax = fmaxf(pmax, p0[r]);
#pragma unroll
    for (int r = 0; r < 16; ++r) pmax = fmaxf(pmax, p1[r]);
    { auto rr = __builtin_amdgcn_permlane32_swap(__float_as_uint(pmax), __float_as_uint(pmax), false, false);
      pmax = fmaxf(__uint_as_float(rr[0]), __uint_as_float(rr[1])); }
    if (__builtin_expect(__all(pmax - m_reg <= THR / SCALE), 1)) { mn = m_reg; alpha = 1.f; }
    else { mn = fmaxf(m_reg, pmax); alpha = __builtin_amdgcn_exp2f((m_reg - mn) * C); m_reg = mn; }
    const float mnC = -mn * C;
#pragma unroll
    for (int r = 0; r < 16; ++r) p0[r] = fmaf(p0[r], C, mnC);
#pragma unroll
    for (int r = 0; r < 16; ++r) p1[r] = fmaf(p1[r], C, mnC);
#pragma unroll
    for (int r = 0; r < 16; ++r) p0[r] = __builtin_amdgcn_exp2f(p0[r]);
}
__device__ __forceinline__ void finishSM(f32x16& p0, f32x16& p1, float alpha, float& l_reg, bf16x8& pa0, bf16x8& pa1, bf16x8& pa2, bf16x8& pa3) {
#pragma unroll
    for (int r = 0; r < 16; ++r) p1[r] = __builtin_amdgcn_exp2f(p1[r]);
    float ps = 0;
#pragma unroll
    for (int r = 0; r < 16; ++r) ps += p0[r];
#pragma unroll
    for (int r = 0; r < 16; ++r) ps += p1[r];
    { auto rr = __builtin_amdgcn_permlane32_swap(__float_as_uint(ps), __float_as_uint(ps), false, false);
      ps = __uint_as_float(rr[0]) + __uint_as_float(rr[1]); }
    l_reg = l_reg * alpha + ps;
#define PK4(P, BASE, OUT) do { unsigned a0 = cvtpk(P[BASE + 0], P[BASE + 1]), a1 = cvtpk(P[BASE + 2], P[BASE + 3]);   \
    unsigned b0 = cvtpk(P[BASE + 4], P[BASE + 5]), b1 = cvtpk(P[BASE + 6], P[BASE + 7]);                              \
    auto r0 = __builtin_amdgcn_permlane32_swap(a0, b0, false, false); auto r1 = __builtin_amdgcn_permlane32_swap(a1, b1, false, false); \
    u32x4 w = {r0[0], r1[0], r0[1], r1[1]}; OUT = *reinterpret_cast<bf16x8*>(&w); } while (0)
    PK4(p0, 0, pa0); PK4(p0, 8, pa1); PK4(p1, 0, pa2); PK4(p1, 8, pa3);
#undef PK4
}
template <int DQK> __device__ __forceinline__ void qkt(f32x16& p0, f32x16& p1, const LAS char* Ks, const bf16x8* qr, int r32, int hi) {
    constexpr int KP = Cfg<DQK>::KP, ND = Cfg<DQK>::ND;
    p0 = f32x16{}; p1 = f32x16{};
#pragma unroll
    for (int d0 = 0; d0 < ND; ++d0) { const int cb = (d0 * 16 + hi * 8) * 2;
        bf16x8 b0 = *reinterpret_cast<const LAS bf16x8*>(Ks + KSWZ(KP, r32, cb));
        bf16x8 b1 = *reinterpret_cast<const LAS bf16x8*>(Ks + KSWZ(KP, 32 + r32, cb));
        p0 = __builtin_amdgcn_mfma_f32_32x32x16_bf16(b0, qr[d0], p0, 0, 0, 0);
        p1 = __builtin_amdgcn_mfma_f32_32x32x16_bf16(b1, qr[d0], p1, 0, 0, 0); }
}
__device__ __forceinline__ int v_st(int k, int c) { const int kk = (k & ~0xC) | ((k & 4) << 1) | ((k & 8) >> 1); return ((kk >> 3) * 4 + (c >> 5)) * 512 + ((kk & 7) * 32 + (c & 31)) * 2; }
__device__ __forceinline__ int v_rd_base(int lane) { return ((lane & 3) << 3) | (((lane >> 2) & 3) << 6) | (((lane >> 4) & 1) << 5) | (((lane >> 5) & 1) << 8); }
constexpr int v_rd_off(int d0, int ks, int half) { return d0 * 512 + ks * 4096 + half * 2048; }
template <int OFF> __device__ __forceinline__ s16x4 tr_read(int vb) {
    s16x4 r; asm volatile("ds_read_b64_tr_b16 %0, %1 offset:%2" : "=&v"(r) : "v"(vb), "i"(OFF) : "memory"); return r;
}
template <int D0> __device__ __forceinline__ void pv_one(f32x16& od, int vb, bf16x8 pa0, bf16x8 pa1, bf16x8 pa2, bf16x8 pa3) {
    const s16x4 l0 = tr_read<v_rd_off(D0, 0, 0)>(vb), h0 = tr_read<v_rd_off(D0, 0, 1)>(vb), l1 = tr_read<v_rd_off(D0, 1, 0)>(vb), h1 = tr_read<v_rd_off(D0, 1, 1)>(vb);
    const s16x4 l2 = tr_read<v_rd_off(D0, 2, 0)>(vb), h2 = tr_read<v_rd_off(D0, 2, 1)>(vb), l3 = tr_read<v_rd_off(D0, 3, 0)>(vb), h3 = tr_read<v_rd_off(D0, 3, 1)>(vb);
    asm volatile("s_waitcnt lgkmcnt(0)" ::: "memory"); SBAR();
#define PK(L, H) (bf16x8){L[0], L[1], L[2], L[3], H[0], H[1], H[2], H[3]}
    od = __builtin_amdgcn_mfma_f32_32x32x16_bf16(pa0, PK(l0, h0), od, 0, 0, 0);
    od = __builtin_amdgcn_mfma_f32_32x32x16_bf16(pa1, PK(l1, h1), od, 0, 0, 0);
    od = __builtin_amdgcn_mfma_f32_32x32x16_bf16(pa2, PK(l2, h2), od, 0, 0, 0);
    od = __builtin_amdgcn_mfma_f32_32x32x16_bf16(pa3, PK(l3, h3), od, 0, 0, 0);
#undef PK
}
__device__ __forceinline__ void pv_d0(f32x16* o, int vb, bf16x8 pa0, bf16x8 pa1, bf16x8 pa2, bf16x8 pa3) {
    pv_one<0>(o[0], vb, pa0, pa1, pa2, pa3); pv_one<1>(o[1], vb, pa0, pa1, pa2, pa3); pv_one<2>(o[2], vb, pa0, pa1, pa2, pa3); pv_one<3>(o[3], vb, pa0, pa1, pa2, pa3);
}
__device__ __forceinline__ bf16x8 ld8(const bf16_t* p) { return *reinterpret_cast<const bf16x8*>(p); }
__device__ __forceinline__ void rope_frag(bf16x8& a, bf16x8& b, const f32x2* tab) {
    u32x4 wa = *reinterpret_cast<u32x4*>(&a), wb = *reinterpret_cast<u32x4*>(&b), oa, ob;
#pragma unroll
    for (int q = 0; q < 4; ++q) {
        const float x1l = bflo(wa[q]), x1h = bfhi(wa[q]), x2l = bflo(wb[q]), x2h = bfhi(wb[q]);
        const f32x2 t0 = tab[2 * q], t1 = tab[2 * q + 1];
        oa[q] = cvtpk(x1l * t0.x - x2l * t0.y, x1h * t1.x - x2h * t1.y);
        ob[q] = cvtpk(x2l * t0.x + x1l * t0.y, x2h * t1.x + x1h * t1.y);
    }
    a = *reinterpret_cast<bf16x8*>(&oa); b = *reinterpret_cast<bf16x8*>(&ob);
}
template <int DQK, int SDEPTH, bool MLA, int ldq, int ldkv, int ldo>
__device__ __forceinline__ void attn_unit(const bf16_t* __restrict__ Qb, const bf16_t* __restrict__ Kh, const bf16_t* __restrict__ KRh, const bf16_t* __restrict__ Vh,
                                          bf16_t* __restrict__ Ob, int seq, LAS char* lds, const f32x2* __restrict__ tabm, int qt0, int wave_s) {
    constexpr int KP = Cfg<DQK>::KP, SHM_K = Cfg<DQK>::SHM_K, ND = Cfg<DQK>::ND;
    const int tid = tid_fresh(wave_s), wid = tid >> 6, lane = tid & 63, r32 = lane & 31, hi = lane >> 5;
    LAS char* V_lds = lds; LAS char* K_lds = lds + 2 * SHM_V;
    LAS float* wsl = (LAS float*)(lds + 2 * SHM_V + 2 * SHM_K) + wid * 64; LAS float* li_l = wsl; LAS float* al_l = wsl + 32;
    float m_reg = -1e30f, l_reg = 0; f32x16 o[4] = {}; bf16x8 qr[ND];
    const bf16_t* Qw = Qb + (long)(wid * QBLK + r32) * ldq + hi * 8;
#pragma unroll
    for (int d0 = 0; d0 < ND; ++d0) qr[d0] = ld8(Qw + d0 * 16);
    if constexpr (MLA) {
        const int t = qt0 + wid * QBLK + r32, prow = t >> 6, pcol = t & 63;
        rope_frag(qr[8], qr[9], tabm + prow * 16 + hi * 8);
        rope_frag(qr[10], qr[11], tabm + pcol * 16 + hi * 8);
    }
    const int sr = tid >> 4, sc = (tid & 15) * 8, vst0 = v_st(sr, sc), vst1 = v_st(32 + sr, sc);
    const int krr = tid >> 3, krc = (tid & 7) * 8;
    const int vb0 = (int)(unsigned)(uintptr_t)V_lds + v_rd_base(lane);
    struct { bf16x8 vs0, vs1, ks0, ks1, kr; } sr_[SDEPTH];
#define SLOAD(i, k0) do { sr_[i].vs0 = ld8(&Vh[(long)((k0) + sr) * ldkv + sc]); sr_[i].vs1 = ld8(&Vh[(long)((k0) + 32 + sr) * ldkv + sc]); \
    sr_[i].ks0 = ld8(&Kh[(long)((k0) + sr) * ldkv + sc]); sr_[i].ks1 = ld8(&Kh[(long)((k0) + 32 + sr) * ldkv + sc]); \
    if constexpr (MLA) sr_[i].kr = ld8(&KRh[(long)((k0) + krr) * 64 + krc]); } while (0)
#define SWRITE(b, i) do { *(LAS bf16x8*)(V_lds + (b) * SHM_V + vst0) = sr_[i].vs0;          \
    *(LAS bf16x8*)(V_lds + (b) * SHM_V + vst1) = sr_[i].vs1; const int kc = sc * 2;               \
    *(LAS bf16x8*)(K_lds + (b) * SHM_K + KSWZ(KP, sr, kc)) = sr_[i].ks0;                       \
    *(LAS bf16x8*)(K_lds + (b) * SHM_K + KSWZ(KP, 32 + sr, kc)) = sr_[i].ks1;                  \
    if constexpr (MLA) *(LAS bf16x8*)(K_lds + (b) * SHM_K + KSWZ(KP, krr, 256 + krc * 2)) = sr_[i].kr; } while (0)
#define SWAIT() do { if constexpr (SDEPTH == 2) { if constexpr (MLA) asm volatile("s_waitcnt vmcnt(5)" ::: "memory"); else asm volatile("s_waitcnt vmcnt(4)" ::: "memory"); } else asm volatile("s_waitcnt vmcnt(0)" ::: "memory"); } while (0)
#define RESC(a) do { if (__any((a) < 1.f)) { if (hi == 0) al_l[r32] = (a); asm volatile("s_waitcnt lgkmcnt(0)" ::: "memory"); \
    _Pragma("unroll") for (int d = 0; d < 4; ++d) _Pragma("unroll") for (int r = 0; r < 16; ++r) o[d][r] *= al_l[crow(r, hi)]; } } while (0)
    bf16x8 pa0, pa1, pa2, pa3; const int NT = seq / KVBLK;
    if constexpr (MLA) {
        f32x16 p0, p1; float mn, al;
        SLOAD(0, 0); asm volatile("s_waitcnt vmcnt(0)" ::: "memory"); SWRITE(0, 0); SLOAD(0, KVBLK); __syncthreads();
        for (int j = 0; j < NT; ++j) {
            const int cb = j & 1;
            if (j + 1 < NT) { asm volatile("s_waitcnt vmcnt(0)" ::: "memory"); SWRITE(cb ^ 1, 0); if (j + 2 < NT) SLOAD(0, (j + 2) * KVBLK); }
            SBAR(); qkt<DQK>(p0, p1, K_lds + cb * SHM_K, qr, r32, hi);
            partialSM<DQK>(p0, p1, m_reg, mn, al); RESC(al);
            finishSM(p0, p1, al, l_reg, pa0, pa1, pa2, pa3); SBAR();
            pv_d0(o, vb0 + cb * SHM_V, pa0, pa1, pa2, pa3);
            __syncthreads();
        }
    } else {
    f32x16 pA0, pA1, pB0, pB1; float mnA, mnB, alA, alB;
    constexpr int SE = 0, SO = SDEPTH - 1;
    SLOAD(SE, 0); asm volatile("s_waitcnt vmcnt(0)" ::: "memory"); SWRITE(0, SE); __syncthreads();
    qkt<DQK>(pA0, pA1, K_lds, qr, r32, hi); partialSM<DQK>(pA0, pA1, m_reg, mnA, alA);
    SLOAD(SO, KVBLK); if constexpr (SDEPTH == 2) { if (2 < NT) SLOAD(SE, 2 * KVBLK); }
    SWAIT(); SWRITE(1, SO); __syncthreads();
    for (int j = 1; j + 1 < NT; j += 2) {
        SBAR(); qkt<DQK>(pB0, pB1, K_lds + SHM_K, qr, r32, hi);
        finishSM(pA0, pA1, alA, l_reg, pa0, pa1, pa2, pa3); SBAR();
        SLOAD(SO, (j + SDEPTH) * KVBLK); SBAR();
        pv_d0(o, vb0, pa0, pa1, pa2, pa3); partialSM<DQK>(pB0, pB1, m_reg, mnB, alB);
        __syncthreads(); SWAIT(); SWRITE(0, SE);
        RESC(alB); __syncthreads();
        SBAR(); qkt<DQK>(pA0, pA1, K_lds, qr, r32, hi);
        finishSM(pB0, pB1, alB, l_reg, pa0, pa1, pa2, pa3); SBAR();
        if (SDEPTH == 1 || j + 3 < NT) SLOAD(SE, (j + 1 + SDEPTH) * KVBLK); SBAR();
        pv_d0(o, vb0 + SHM_V, pa0, pa1, pa2, pa3); partialSM<DQK>(pA0, pA1, m_reg, mnA, alA);
        __syncthreads(); SWAIT(); SWRITE(1, SO);
        RESC(alA); __syncthreads();
    }
    SBAR(); qkt<DQK>(pB0, pB1, K_lds + SHM_K, qr, r32, hi);
    finishSM(pA0, pA1, alA, l_reg, pa0, pa1, pa2, pa3); SBAR();
    pv_d0(o, vb0, pa0, pa1, pa2, pa3); partialSM<DQK>(pB0, pB1, m_reg, mnB, alB);
    __syncthreads(); RESC(alB);
    finishSM(pB0, pB1, alB, l_reg, pa0, pa1, pa2, pa3); SBAR();
    pv_d0(o, vb0 + SHM_V, pa0, pa1, pa2, pa3);
    }
    if (hi == 0) li_l[r32] = l_reg; asm volatile("s_waitcnt lgkmcnt(0)" ::: "memory");
    float rli[16];
#pragma unroll
    for (int r = 0; r < 16; ++r) rli[r] = __builtin_amdgcn_rcpf(li_l[crow(r, hi)]);
    bf16_t* Ow = Ob + (long)(wid * QBLK) * ldo;
#pragma unroll
    for (int r = 0; r < 16; ++r) { const int orow = crow(r, hi);
#pragma unroll
        for (int d0 = 0; d0 < 4; ++d0) Ow[(long)orow * ldo + d0 * 32 + r32] = f2bf(o[d0][r] * rli[r]); }
    __syncthreads();
#undef SLOAD
#undef SWRITE
#undef SWAIT
#undef RESC
}
}

template <int MODE> __device__ __forceinline__ int dst_row(int n) {
    if (MODE == 1) { const int half = n >> 10, c = n & 1023; return ((c >> 7) << 8) + (half << 7) + (c & 127); }
    if (MODE == 2) { const int h = n >> 8, j = n & 255; return j < 128 ? (h << 7) + j : 1024 + (h << 7) + (j - 128); }
    return n;
}
template <int MODE> __device__ __forceinline__ void p0_transpose_item_fp8(const float* W, int K, int N, unsigned char* WT, LAS float* scr, int item, int lane) {
    const int nblk = N / 32, kb = item / nblk, nb = item % nblk, k0 = 64 * kb, n0 = 32 * nb;
#pragma unroll 8
    for (int i = 0; i < 32; ++i) { const int kk = 2 * i + (lane >> 5); scr[kk * 33 + (lane & 31)] = W[(size_t)(k0 + kk) * N + n0 + (lane & 31)]; }
    LDS_WAIT(); asm volatile("" ::: "memory");
    const int c = lane & 7;
#pragma unroll
    for (int j = 0; j < 4; ++j) { const int n = (lane >> 3) + 8 * j; const LAS float* s = scr + (8 * c) * 33 + n;
        u32x2 o; o.x = pk4_fp8(s[0 * 33] * 64.f, s[1 * 33] * 64.f, s[2 * 33] * 64.f, s[3 * 33] * 64.f); o.y = pk4_fp8(s[4 * 33] * 64.f, s[5 * 33] * 64.f, s[6 * 33] * 64.f, s[7 * 33] * 64.f);
        *(u32x2*)(WT + (size_t)dst_row<MODE>(n0 + n) * K + k0 + 8 * c) = o; }
    LDS_WAIT(); asm volatile("" ::: "memory");
}
template <int MODE> __device__ __forceinline__ void p0_transpose_item(const float* W, int K, int N, bf16_t* WT, LAS float* scr, int item, int lane) {
    const int nblk = N / 32, kb = item / nblk, nb = item % nblk, k0 = 64 * kb, n0 = 32 * nb;
#pragma unroll 8
    for (int i = 0; i < 32; ++i) { const int kk = 2 * i + (lane >> 5); scr[kk * 33 + (lane & 31)] = W[(size_t)(k0 + kk) * N + n0 + (lane & 31)]; }
    LDS_WAIT(); asm volatile("" ::: "memory");
    const int c = lane & 7;
#pragma unroll
    for (int j = 0; j < 4; ++j) { const int n = (lane >> 3) + 8 * j; const LAS float* s = scr + (8 * c) * 33 + n;
        u32x4 o; o.x = cvtpk(s[0 * 33], s[1 * 33]); o.y = cvtpk(s[2 * 33], s[3 * 33]); o.z = cvtpk(s[4 * 33], s[5 * 33]); o.w = cvtpk(s[6 * 33], s[7 * 33]);
        *(u32x4*)(WT + (size_t)dst_row<MODE>(n0 + n) * K + k0 + 8 * c) = o; }
    LDS_WAIT(); asm volatile("" ::: "memory");
}
__device__ __forceinline__ void p0_prologue(Frame& F) {
    uchar* ws = F.ws;
    {
        LAS float* S = (LAS float*)F.lds;
        const float* pC = INP(I_C); const float* pCC = INP(I_CCTX); const float* pAW = INP(I_ADAW); const float* pAB = INP(I_ADAB); const float* pNM = INP(I_NMIXG); const float* pNF = INP(I_NFFNG);
        float* MOD = (float*)(ws + WS_MOD);
        for (int item = F.bid; item < 192; item += F.G) {
            const int layer = item / 96, n0 = (item % 96) * 64;
            __syncthreads();
            for (int u = F.tid; u < 33 * 1024; u += 512) { const int j = u >> 10, k = u & 1023; const float c = j < 32 ? pC[j * 1024 + k] : pCC[k]; S[u] = silu_f(c); }
            __syncthreads();
            float acc[33];
#pragma unroll
            for (int j = 0; j < 33; ++j) acc[j] = 0.f;
            const float* wp = pAW + (size_t)layer * 1024 * 6144 + n0 + F.lane;
            const int kbeg = F.wave * 128;
            for (int k = kbeg; k < kbeg + 128; k += 4) {
                const float w0 = wp[(size_t)k * 6144], w1 = wp[(size_t)(k + 1) * 6144], w2 = wp[(size_t)(k + 2) * 6144], w3 = wp[(size_t)(k + 3) * 6144];
#pragma unroll
                for (int j = 0; j < 33; ++j) { const f32x4 s = *(const LAS f32x4*)(S + j * 1024 + k); acc[j] += s.x * w0 + s.y * w1 + s.z * w2 + s.w * w3; }
            }
            __syncthreads();
#pragma unroll
            for (int j = 0; j < 33; ++j) S[(F.wave * 33 + j) * 64 + F.lane] = acc[j];
            __syncthreads();
            for (int u = F.tid; u < 33 * 64; u += 512) { const int j = u >> 6, cl = u & 63; float s = 0.f;
#pragma unroll
                for (int w = 0; w < 8; ++w) s += S[(w * 33 + j) * 64 + cl];
                const int n = n0 + cl, part = n >> 10, col = n & 1023;
                s += pAB[layer * 6144 + n];
                if (part == 1) s = pNM[layer * 1024 + col] * (1.f + s);
                if (part == 4) s = pNF[layer * 1024 + col] * (1.f + s);
                MOD[((size_t)(layer * 33 + j) * 6 + part) * 1024 + col] = s; }
        }
        __syncthreads();
    }
    {
        const int gt = F.bid * 512 + F.tid, NT = F.G * 512;
        f32x2* tg = (f32x2*)(ws + WS_TABG); f32x2* tm = (f32x2*)(ws + WS_TABM);
        for (int u = gt; u < 64 * 32; u += NT) { const int pos = u >> 5, i = u & 31; const float inv = powf(10000.f, -(float)(2 * i) / 64.f); const float a = (float)pos * inv; tg[u] = (f32x2){cosf(a), sinf(a)}; }
        for (int u = gt; u < 64 * 16; u += NT) { const int pos = u >> 4, i = u & 15; const float inv = powf(10000.f, -(float)(2 * i) / 32.f); const float a = (float)pos * inv; tm[u] = (f32x2){cosf(a), sinf(a)}; }
        float* wrt = (float*)(ws + WS_WRT); const float* pRW = INP(I_RW); const float* pSW = INP(I_SGUW);
        for (int u = gt; u < 2 * 32 * 1024; u += NT) { const int l = u >> 15, e = (u >> 10) & 31, k = u & 1023; wrt[u] = pRW[((size_t)l * 1024 + k) * 32 + e]; }
        bf16_t* sw = (bf16_t*)(ws + WS_SGUW);
        for (int u = gt; u < 4 * 128 * 128; u += NT) sw[u] = f2bf(pSW[u]);
        u32x4* z = (u32x4*)(ws + WS_WIN1 + (size_t)832 * 1024 * 2);
        for (int u = gt; u < 192 * 1024 * 2 / 16; u += NT) z[u] = (u32x4){0u, 0u, 0u, 0u};
    }
    {
        LAS float* scr = (LAS float*)(F.lds + F.wave * 16384);
        const int gw = F.bid * 8 + F.wave, NGW = F.G * 8; const float* pW1 = INP(I_W1); const float* pW2 = INP(I_W2);
        constexpr int J0 = 16 * 64, J1 = 16 * 32, J2 = 16 * 26, J3 = 8 * 48, J4 = 4 * 64, J5 = 16 * 32, JW1 = 64 * 1024, JW2 = 64 * 512;
        constexpr int NITEMS = J0 + J1 + J2 + J3 + J4 + J5 + JW1 + JW2;
        for (int it = gw; it < NITEMS; it += NGW) {
            int r = it;
#if MOE_FP8
            if (r < JW1) { const int le = r >> 10; p0_transpose_item_fp8<1>(pW1 + (size_t)le * 1024 * 2048, 1024, 2048, (unsigned char*)(ws + WS_W1) + (size_t)le * 2048 * 1024, scr, r & 1023, F.lane); continue; } r -= JW1;
            if (r < JW2) { const int le = r >> 9; p0_transpose_item_fp8<0>(pW2 + (size_t)le * 1024 * 1024, 1024, 1024, (unsigned char*)(ws + WS_W2) + (size_t)le * 1024 * 1024, scr, r & 511, F.lane); continue; } r -= JW2;
#else
            if (r < JW1) { const int le = r >> 10; p0_transpose_item<1>(pW1 + (size_t)le * 1024 * 2048, 1024, 2048, (bf16_t*)(ws + WS_W1) + (size_t)le * 2048 * 1024, scr, r & 1023, F.lane); continue; } r -= JW1;
            if (r < JW2) { const int le = r >> 9; p0_transpose_item<0>(pW2 + (size_t)le * 1024 * 1024, 1024, 1024, (bf16_t*)(ws + WS_W2) + (size_t)le * 1024 * 1024, scr, r & 511, F.lane); continue; } r -= JW2;
#endif
            if (r < J0) { p0_transpose_item<0>(INP(I_ABWIN), 1024, 2048, (bf16_t*)(ws + WS_WIN0), scr, r, F.lane); continue; } r -= J0;
            if (r < J1) { p0_transpose_item<0>(INP(I_ABWOUT), 1024, 1024, (bf16_t*)(ws + WS_WOUT0), scr, r, F.lane); continue; } r -= J1;
            if (r < J2) { p0_transpose_item<0>(INP(I_MLAWIN), 1024, 832, (bf16_t*)(ws + WS_WIN1), scr, r, F.lane); continue; } r -= J2;
            if (r < J3) { p0_transpose_item<0>(INP(I_MLAWUQ), 512, 1536, (bf16_t*)(ws + WS_WUQ), scr, r, F.lane); continue; } r -= J3;
            if (r < J4) { p0_transpose_item<2>(INP(I_MLAWUKV), 256, 2048, (bf16_t*)(ws + WS_WUKV), scr, r, F.lane); continue; } r -= J4;
            p0_transpose_item<0>(INP(I_MLAWOUT), 1024, 1024, (bf16_t*)(ws + WS_WOUT1), scr, r, F.lane);
        }
    }
}

__device__ __forceinline__ void row_src_ptr(const float* px, const float* pctx, int r, const float*& src, int& mj) {
    const int b = r / TPB, pos = r - b * TPB;
    if (pos < CTXL) { src = pctx + ((size_t)b * CTXL + pos) * DM; mj = 32; } else { src = px + ((size_t)b * SEQ + (pos - CTXL)) * DM; mj = b; }
}
__device__ __forceinline__ f32x4 bf4(u32x2 w) { return (f32x4){bflo(w.x), bfhi(w.x), bflo(w.y), bfhi(w.y)}; }
__device__ __forceinline__ u32x2 pk4bf(f32x4 v) { return (u32x2){cvtpk(v.x, v.y), cvtpk(v.z, v.w)}; }
__device__ __forceinline__ void store_h_row(bf16_t* hrow, int lane, const f32x4 (&h)[4]) {
    unsigned long long* o8 = (unsigned long long*)hrow + lane;
#pragma unroll
    for (int j = 0; j < 4; ++j) o8[64 * j] = (unsigned long long)cvtpk(h[j].x, h[j].y) | ((unsigned long long)cvtpk(h[j].z, h[j].w) << 32);
}
__device__ __forceinline__ void p_norm0(Frame& F) {
    const float* MOD = (const float*)(F.ws + WS_MOD); bf16_t* H = (bf16_t*)(F.ws + WS_H);
    const int gw = F.bid * 8 + F.wave, NGW = F.G * 8; const float* px = INP(I_X); const float* pctx = INP(I_CTX);
    for (int r = gw; r < NTOK; r += NGW) {
        const float* src; int mj; row_src_ptr(px, pctx, r, src, mj);
        const f32x4* xr = (const f32x4*)src + F.lane; f32x4 v[4]; float ss = 0.f;
#pragma unroll
        for (int j = 0; j < 4; ++j) { v[j] = xr[64 * j]; ss += (v[j].x * v[j].x + v[j].y * v[j].y) + (v[j].z * v[j].z + v[j].w * v[j].w); }
        const float rstd = rsqrtf(wave_sum(ss) * (1.f / DM) + EPS);
        const f32x4* sh = (const f32x4*)(MOD + ((size_t)(0 * 33 + mj) * 6 + 0) * 1024) + F.lane; const f32x4* A = (const f32x4*)(MOD + ((size_t)(0 * 33 + mj) * 6 + 1) * 1024) + F.lane;
        f32x4 h[4];
#pragma unroll
        for (int j = 0; j < 4; ++j) h[j] = v[j] * rstd * A[64 * j] + sh[64 * j];
        store_h_row(H + (size_t)r * DM, F.lane, h);
    }
}
__device__ __forceinline__ void moe_prefix(Frame& F, int layer) {
    LAS int* pb = (LAS int*)(F.lds + XTRA_OFF + X_PB); LAS int* cn = (LAS int*)(F.lds + XTRA_OFF + X_CNT);
    const unsigned* gc = (const unsigned*)(F.ws + WS_CTL) + CW_CNT + layer * 64;
    __syncthreads();
    if (F.tid == 0) { int s = 0; for (int e = 0; e < 32; ++e) { const int c = (int)__hip_atomic_load(gc + e, __ATOMIC_RELAXED, __HIP_MEMORY_SCOPE_AGENT); cn[e] = c; pb[e] = s; s += (c + 255) >> 8; } pb[32] = s; }
    __syncthreads();
}
__device__ __forceinline__ void moe_gather_row(const Frame& F, int r, f32x4 (&f)[4]) {
    const LAS int* pb = (const LAS int*)(F.lds + XTRA_OFF + X_PB);
    const u32x2* ti = (const u32x2*)(F.ws + WS_TOKI) + (size_t)r * 4; const bf16_t* Y = (const bf16_t*)(F.ws + WS_Y);
#pragma unroll
    for (int j = 0; j < 4; ++j) f[j] = (f32x4){0.f, 0.f, 0.f, 0.f};
#pragma unroll
    for (int k = 0; k < 4; ++k) {
        const u32x2 t = ti[k]; const int e = (int)(t.x >> 20), pos = (int)(t.x & 0xfffffu); const float g = __uint_as_float(t.y);
        const size_t yrow = (size_t)pb[e] * 256 + pos;
#if Y_FP8
        const unsigned* yp = (const unsigned*)((const unsigned char*)Y + yrow * DM) + F.lane; const float g16 = g * (1.f / 16.f);
#pragma unroll
        for (int j = 0; j < 4; ++j) { const unsigned w = yp[64 * j]; const f32x2 lo = __builtin_amdgcn_cvt_pk_f32_fp8(w, false), hi2 = __builtin_amdgcn_cvt_pk_f32_fp8(w, true);
            f[j].x += g16 * lo.x; f[j].y += g16 * lo.y; f[j].z += g16 * hi2.x; f[j].w += g16 * hi2.y; }
#else
        const u32x2* yp = (const u32x2*)(Y + yrow * DM) + F.lane;
#pragma unroll
        for (int j = 0; j < 4; ++j) { const u32x2 w = yp[64 * j]; f[j].x += g * bflo(w.x); f[j].y += g * bfhi(w.x); f[j].z += g * bflo(w.y); f[j].w += g * bfhi(w.y); }
#endif
    }
}
__device__ __forceinline__ void p_combine_norm(Frame& F, int dry) {
    moe_prefix(F, 0);
    const float* MOD = (const float*)(F.ws + WS_MOD); bf16_t* H = (bf16_t*)(F.ws + (dry ? WS_SCR + 288 * MiB : WS_H)); bf16_t* XR = (bf16_t*)(F.ws + WS_XR); bf16_t* XW = dry ? (bf16_t*)(F.ws + WS_SCR) : XR;
    const int gw = F.bid * 8 + F.wave, NGW = F.G * 8;
    for (int r = gw; r < NTOK; r += NGW) {
        const int b = r / TPB, pos = r - b * TPB, mj = pos < CTXL ? 32 : b;
        f32x4 f[4]; moe_gather_row(F, r, f);
        const u32x2* xr = (const u32x2*)(XR + (size_t)r * DM) + F.lane; u32x2* xw = (u32x2*)(XW + (size_t)r * DM) + F.lane; const f32x4* g2 = (const f32x4*)(MOD + ((size_t)(0 * 33 + mj) * 6 + 5) * 1024) + F.lane;
        f32x4 v[4]; float ss = 0.f;
#pragma unroll
        for (int j = 0; j < 4; ++j) { v[j] = bf4(xr[64 * j]) + g2[64 * j] * f[j]; xw[64 * j] = pk4bf(v[j]); ss += (v[j].x * v[j].x + v[j].y * v[j].y) + (v[j].z * v[j].z + v[j].w * v[j].w); }
        const float rstd = rsqrtf(wave_sum(ss) * (1.f / DM) + EPS);
        const f32x4* sh = (const f32x4*)(MOD + ((size_t)(1 * 33 + mj) * 6 + 0) * 1024) + F.lane; const f32x4* A = (const f32x4*)(MOD + ((size_t)(1 * 33 + mj) * 6 + 1) * 1024) + F.lane;
        f32x4 h[4];
#pragma unroll
        for (int j = 0; j < 4; ++j) h[j] = v[j] * rstd * A[64 * j] + sh[64 * j];
        store_h_row(H + (size_t)r * DM, F.lane, h);
    }
}
__device__ __forceinline__ void p_final(Frame& F) {
    moe_prefix(F, 1);
    const float* MOD = (const float*)(F.ws + WS_MOD); const bf16_t* XR = (const bf16_t*)(F.ws + WS_XR);
    const int gw = F.bid * 8 + F.wave, NGW = F.G * 8; const float* pfg = INP(I_FNG);
    for (int q = gw; q < NBATCH * SEQ; q += NGW) {
        const int b = q >> 11, t = q & 2047, r = b * TPB + CTXL + t;
        f32x4 f[4]; moe_gather_row(F, r, f);
        const u32x2* xr = (const u32x2*)(XR + (size_t)r * DM) + F.lane; const f32x4* g2 = (const f32x4*)(MOD + ((size_t)(1 * 33 + b) * 6 + 5) * 1024) + F.lane;
        f32x4 v[4]; float ss = 0.f;
#pragma unroll
        for (int j = 0; j < 4; ++j) { v[j] = bf4(xr[64 * j]) + g2[64 * j] * f[j]; ss += (v[j].x * v[j].x + v[j].y * v[j].y) + (v[j].z * v[j].z + v[j].w * v[j].w); }
        const float rstd = rsqrtf(wave_sum(ss) * (1.f / DM) + EPS);
        const f32x4* fg = (const f32x4*)pfg + F.lane; f32x4* op = (f32x4*)(F.out + (size_t)q * DM) + F.lane;
#pragma unroll
        for (int j = 0; j < 4; ++j) op[64 * j] = v[j] * rstd * fg[64 * j];
    }
}
__device__ __forceinline__ void top4_of16(float (&v)[16], int hi, float (&tv)[4], int (&te)[4]) {
#pragma unroll
    for (int k = 0; k < 4; ++k) { float best = v[0]; int bi = 0;
#pragma unroll
        for (int r = 1; r < 16; ++r) { const bool bt = v[r] > best; best = bt ? v[r] : best; bi = bt ? r : bi; }
        tv[k] = best; te[k] = (bi & 3) + 8 * (bi >> 2) + 4 * hi;
#pragma unroll
        for (int r = 0; r < 16; ++r) v[r] = (r == bi) ? -3.0e38f : v[r]; }
}
template <int LAYER> __device__ __forceinline__ void p_norm_router(Frame& F, int dry) {
    const float* MOD = (const float*)(F.ws + WS_MOD); bf16_t* H = (bf16_t*)(F.ws + WS_H); const bf16_t* XR = (const bf16_t*)(F.ws + WS_XR);
    LAS f32x4* WL4 = (LAS f32x4*)F.lds;
    LAS int* hist = (LAS int*)(F.lds + XTRA_OFF + X_HIST); LAS int* base = (LAS int*)(F.lds + XTRA_OFF + X_BASE); LAS u32x2* sel = (LAS u32x2*)(F.lds + XTRA_OFF + X_SEL);
    LAS f32x4* A2L4 = (LAS f32x4*)(F.lds + XTRA_OFF + X_A2); LAS float* CBL = (LAS float*)(F.lds + XTRA_OFF + X_CB); LAS float* RSL = (LAS float*)(F.lds + XTRA_OFF + X_RS);
    unsigned* gcnt = (unsigned*)(F.ws + WS_CTL) + CW_CNT + LAYER * 64 + (dry ? 128 : 0);
    int* rowl = (int*)(F.ws + WS_ROWL); u32x2* toki = (u32x2*)(F.ws + WS_TOKI);
    const f32x4* wsrc = (const f32x4*)(F.ws + WS_WRT + (size_t)LAYER * 32 * 1024 * 4);
    __syncthreads();
    for (int u = F.tid; u < 8192; u += 512) { const int e = u >> 8, k4 = u & 255; WL4[e * 256 + (k4 ^ (e & 15))] = wsrc[u]; }
    if (F.tid < 32) hist[F.tid] = 0;
    const int lane = F.lane, r32 = lane & 31, hi = lane >> 5; const float* prb = INP(I_RB);
    constexpr int NP = LAYER == 0 ? NPAN : 256;
    for (int pi = F.bid; pi < NP; pi += F.G) {
        const int pan = LAYER == 0 ? pi : pi + pi / 8 + 1;
        const int b = pan / 9, mj = (pan % 9 == 0) ? 32 : b;
        const f32x4* shp = (const f32x4*)(MOD + ((size_t)(LAYER * 33 + mj) * 6 + 3) * 1024); const f32x4* Ap = (const f32x4*)(MOD + ((size_t)(LAYER * 33 + mj) * 6 + 4) * 1024);
        __syncthreads();
        if (F.tid < 256) A2L4[F.tid] = Ap[F.tid];
        {
            const int e = F.tid >> 4, part = F.tid & 15; float sum = 0.f;
#pragma unroll 4
            for (int q = 0; q < 16; ++q) { const f32x4 a = shp[part * 16 + q], w = wsrc[e * 256 + part * 16 + q]; sum += (a.x * w.x + a.y * w.y) + (a.z * w.z + a.w * w.w); }
            sum += xf1(sum); sum += xf2(sum); sum += xf4(sum); sum += xf8(sum);
            if (part == 0) CBL[e] = sum + prb[LAYER * 32 + e];
        }
        __syncthreads();
        const int row = pan * 256 + F.wave * 32 + r32;
        const u32x2* xp = (const u32x2*)(XR + (size_t)row * DM) + hi;
        const LAS f32x4* wrow = WL4 + r32 * 256; const int swz = r32 & 15;
        f32x16 acc = {}; float ssq = 0.f;
#define RT_LOAD(dst, mb) do { _Pragma("unroll") for (int u = 0; u < 8; ++u) dst[u] = xp[2 * ((mb) + u)]; } while (0)
#define RT_COMP(src, mb) do { _Pragma("unroll") for (int u = 0; u < 8; ++u) { const int k4 = 2 * ((mb) + u) + hi; const f32x4 a4 = A2L4[k4], w4 = wrow[k4 ^ swz]; const f32x4 x = bf4(src[u]); \
                ssq += (x.x * x.x + x.y * x.y) + (x.z * x.z + x.w * x.w); \
                acc = __builtin_amdgcn_mfma_f32_32x32x2f32(w4.x, x.x * a4.x, acc, 0, 0, 0); acc = __builtin_amdgcn_mfma_f32_32x32x2f32(w4.y, x.y * a4.y, acc, 0, 0, 0); \
                acc = __builtin_amdgcn_mfma_f32_32x32x2f32(w4.z, x.z * a4.z, acc, 0, 0, 0); acc = __builtin_amdgcn_mfma_f32_32x32x2f32(w4.w, x.w * a4.w, acc, 0, 0, 0); } } while (0)
        u32x2 xa[8], xb[8];
        RT_LOAD(xa, 0);
#pragma unroll 1
        for (int m0 = 0; m0 < 128; m0 += 16) {
            RT_LOAD(xb, m0 + 8); SBAR();
            RT_COMP(xa, m0); SBAR();
            if (m0 + 16 < 128) RT_LOAD(xa, m0 + 16);
            SBAR(); RT_COMP(xb, m0 + 8); SBAR();
        }
#undef RT_LOAD
#undef RT_COMP
        const float rstd = rsqrtf(sum32(ssq, ssq) * (1.f / DM) + EPS);
        float lg[16];
#pragma unroll
        for (int r = 0; r < 16; ++r) lg[r] = acc[r] * rstd + CBL[(r & 3) + 8 * (r >> 2) + 4 * hi];
        float tv[4], pv[4]; int te[4], pe[4];
        top4_of16(lg, hi, tv, te);
#pragma unroll
        for (int k = 0; k < 4; ++k) { pv[k] = __uint_as_float(xu32(__float_as_uint(tv[k]), lane)); pe[k] = (int)xu32((unsigned)te[k], lane); }
        float cv[8] = {tv[0], tv[1], tv[2], tv[3], pv[0], pv[1], pv[2], pv[3]}; int ce[8] = {te[0], te[1], te[2], te[3], pe[0], pe[1], pe[2], pe[3]};
        float gv[4]; int ge[4];
#pragma unroll
        for (int k = 0; k < 4; ++k) { float best = cv[0]; int be = ce[0];
#pragma unroll
            for (int c = 1; c < 8; ++c) { const bool bt = cv[c] > best || (cv[c] == best && ce[c] < be); best = bt ? cv[c] : best; be = bt ? ce[c] : be; }
            gv[k] = best; ge[k] = be;
#pragma unroll
            for (int c = 0; c < 8; ++c) cv[c] = (ce[c] == be) ? -3.0e38f : cv[c]; }
        const float x1 = __expf(gv[1] - gv[0]), x2 = __expf(gv[2] - gv[0]), x3 = __expf(gv[3] - gv[0]); const float inv = 1.f / (1.f + x1 + x2 + x3);
        {
            const int ea = hi ? ge[2] : ge[0], eb = hi ? ge[3] : ge[1]; const float ga = hi ? x2 * inv : inv, gb = hi ? x3 * inv : x1 * inv;
            const int ra = __hip_atomic_fetch_add(hist + ea, 1, __ATOMIC_RELAXED, __HIP_MEMORY_SCOPE_WORKGROUP), rb2 = __hip_atomic_fetch_add(hist + eb, 1, __ATOMIC_RELAXED, __HIP_MEMORY_SCOPE_WORKGROUP);
            const int rl = F.wave * 32 + r32;
            sel[rl * 4 + 2 * hi] = (u32x2){(unsigned)ea | ((unsigned)ra << 8), __float_as_uint(ga)}; sel[rl * 4 + 2 * hi + 1] = (u32x2){(unsigned)eb | ((unsigned)rb2 << 8), __float_as_uint(gb)};
            if (hi == 0) RSL[rl] = rstd;
        }
        {
            f32x4 Ar[4], Sr[4];
#pragma unroll
            for (int j = 0; j < 4; ++j) { Ar[j] = Ap[lane + 64 * j]; Sr[j] = shp[lane + 64 * j]; }
            for (int rr = 0; rr < 32; rr += 4) {
                const int rw = pan * 256 + F.wave * 32 + rr; f32x4 v[4][4];
#pragma unroll
                for (int t = 0; t < 4; ++t) { const u32x2* xr = (const u32x2*)(XR + (size_t)(rw + t) * DM) + lane;
#pragma unroll
                    for (int j = 0; j < 4; ++j) v[t][j] = bf4(xr[64 * j]); }
#pragma unroll
                for (int t = 0; t < 4; ++t) { const float rs = RSL[F.wave * 32 + rr + t]; f32x4 h[4];
#pragma unroll
                    for (int j = 0; j < 4; ++j) h[j] = v[t][j] * rs * Ar[j] + Sr[j];
                    if constexpr (MOE_FP8 != 0) { unsigned* o4 = (unsigned*)((unsigned char*)H + (size_t)(rw + t) * DM) + lane;
#pragma unroll
                        for (int j = 0; j < 4; ++j) o4[64 * j] = pk4_fp8(h[j].x * 4.f, h[j].y * 4.f, h[j].z * 4.f, h[j].w * 4.f); }
                    else store_h_row(H + (size_t)(rw + t) * DM, lane, h); }
            }
        }
        __syncthreads();
        if (F.tid < 32) { const int c = hist[F.tid]; base[F.tid] = c ? (int)__hip_atomic_fetch_add(gcnt + F.tid, (unsigned)c, __ATOMIC_RELAXED, __HIP_MEMORY_SCOPE_AGENT) : 0; }
        __syncthreads();
        for (int u = F.tid; u < 1024; u += 512) { const u32x2 sv = sel[u]; const int e = (int)(sv.x & 0xffu), pos = base[e] + (int)(sv.x >> 8), r = pan * 256 + (u >> 2);
            rowl[(size_t)e * ROWCAP + pos] = r; toki[(size_t)r * 4 + (u & 3)] = (u32x2){((unsigned)e << 20) | (unsigned)pos, sv.y}; }
        __syncthreads();
        if (F.tid < 32) hist[F.tid] = 0;
    }
    __syncthreads();
}

__device__ __forceinline__ void p_qk_prep(Frame& F) {
    bf16_t* P = (bf16_t*)(F.ws + WS_PBUF); const f32x2* tab = (const f32x2*)(F.ws + WS_TABG);
    const int lane = F.lane, sub = lane >> 4, a = lane & 15, gw = F.bid * 8 + F.wave, NGW = F.G * 8;
    const float* pq = INP(I_GQG); const float* pk = INP(I_GKG);
    float gq[8], gk[8], gqp[8], gkp[8];
#pragma unroll
    for (int j = 0; j < 8; ++j) { gq[j] = pq[8 * a + j]; gk[j] = pk[8 * a + j]; gqp[j] = pq[8 * (a ^ 4) + j]; gkp[j] = pk[8 * (a ^ 4) + j]; }
    const bool isx2 = (a & 4) != 0; const int fi = 8 * (a & 3);
    for (int rp = gw; rp < NTOK / 2; rp += NGW) {
#pragma unroll
        for (int g = 0; g < 3; ++g) {
            const int it = g * 4 + sub, hi6 = it >= 6 ? 1 : 0, r = rp * 2 + hi6, s = it - 6 * hi6;
            const int b = r / TPB, pos = r - b * TPB; const bool lat = pos >= CTXL; const int t = pos - CTXL;
            bf16_t* ptr = P + (size_t)r * 2048 + 1024 + s * 128 + 8 * a;
            const u32x4 w = *(const u32x4*)ptr; u32x4 wp;
#pragma unroll
            for (int q = 0; q < 4; ++q) wp[q] = (unsigned)__shfl_xor((int)w[q], 4);
            float x[8], xp[8];
#pragma unroll
            for (int q = 0; q < 4; ++q) { x[2 * q] = bflo(w[q]); x[2 * q + 1] = bfhi(w[q]); xp[2 * q] = bflo(wp[q]); xp[2 * q + 1] = bfhi(wp[q]); }
            float ss = 0.f;
#pragma unroll
            for (int j = 0; j < 8; ++j) ss += x[j] * x[j];
            ss += __shfl_xor(ss, 1); ss += __shfl_xor(ss, 2); ss += __shfl_xor(ss, 4); ss += __shfl_xor(ss, 8);
            const float rstd = rsqrtf(ss * (1.f / 128.f) + EPS); const bool isq = s < 4;
            float o[8];
#pragma unroll
            for (int j = 0; j < 8; ++j) { o[j] = x[j] * rstd * (isq ? gq[j] : gk[j]); xp[j] = xp[j] * rstd * (isq ? gqp[j] : gkp[j]); }
            if (lat) {
                const int pp = (a & 8) ? (t & 63) : (t >> 6); const f32x4* tp = (const f32x4*)(tab + pp * 32 + fi);
#pragma unroll
                for (int q = 0; q < 4; ++q) { const f32x4 cs = tp[q];
                    const float s0 = isx2 ? cs.y : -cs.y, s1 = isx2 ? cs.w : -cs.w;
                    o[2 * q] = o[2 * q] * cs.x + xp[2 * q] * s0; o[2 * q + 1] = o[2 * q + 1] * cs.z + xp[2 * q + 1] * s1; }
            }
            u32x4 wo; wo.x = cvtpk(o[0], o[1]); wo.y = cvtpk(o[2], o[3]); wo.z = cvtpk(o[4], o[5]); wo.w = cvtpk(o[6], o[7]);
            *(u32x4*)ptr = wo;
        }
    }
}
__device__ __forceinline__ void p_mla_prep(Frame& F) {
    bf16_t* P = (bf16_t*)(F.ws + WS_PBUF); bf16_t* KR = (bf16_t*)(F.ws + WS_KRB); const f32x2* tab = (const f32x2*)(F.ws + WS_TABM);
    const int gw = F.bid * 8 + F.wave, NGW = F.G * 8, lane = F.lane;
    const float* pqg = INP(I_MLAQG); const float* pkg = INP(I_MLAKVG);
    float qg[8], kg[4];
#pragma unroll
    for (int j = 0; j < 8; ++j) qg[j] = pqg[8 * lane + j];
#pragma unroll
    for (int j = 0; j < 4; ++j) kg[j] = pkg[4 * lane + j];
    const int krow = (lane >> 3) & 3, ka = lane & 7; const bool kx2 = (ka & 2) != 0; const int kfi = 8 * (ka & 1);
    for (int r0 = gw * 4; r0 < NTOK; r0 += NGW * 4) {
        const int b = r0 / TPB, pos0 = r0 - b * TPB; const bool lat = pos0 >= CTXL;
        u32x4 wq[4]; u32x2 wk[4];
#pragma unroll
        for (int rr = 0; rr < 4; ++rr) { const bf16_t* base = P + (size_t)(r0 + rr) * 1024; wk[rr] = *(const u32x2*)(base + 512 + 4 * lane); if (lat) wq[rr] = *(const u32x4*)(base + 8 * lane); }
        u32x4 wr = (u32x4){0u, 0u, 0u, 0u};
        if (lane < 32) wr = *(const u32x4*)(P + (size_t)(r0 + krow) * 1024 + 768 + 8 * ka);
        if (lat) {
#pragma unroll
            for (int rr = 0; rr < 4; ++rr) { float x[8];
#pragma unroll
                for (int q = 0; q < 4; ++q) { x[2 * q] = bflo(wq[rr][q]); x[2 * q + 1] = bfhi(wq[rr][q]); }
                float ss = 0.f;
#pragma unroll
                for (int j = 0; j < 8; ++j) ss += x[j] * x[j];
                const float rstd = rsqrtf(wave_sum(ss) * (1.f / 512.f) + EPS);
                u32x4 w;
#pragma unroll
                for (int q = 0; q < 4; ++q) w[q] = cvtpk(x[2 * q] * rstd * qg[2 * q], x[2 * q + 1] * rstd * qg[2 * q + 1]);
                *(u32x4*)(P + (size_t)(r0 + rr) * 1024 + 8 * lane) = w; }
        }
#pragma unroll
        for (int rr = 0; rr < 4; ++rr) { const float x0 = bflo(wk[rr].x), x1 = bfhi(wk[rr].x), x2 = bflo(wk[rr].y), x3 = bfhi(wk[rr].y);
            const float rstd = rsqrtf(wave_sum((x0 * x0 + x1 * x1) + (x2 * x2 + x3 * x3)) * (1.f / 256.f) + EPS);
            u32x2 w; w.x = cvtpk(x0 * rstd * kg[0], x1 * rstd * kg[1]); w.y = cvtpk(x2 * rstd * kg[2], x3 * rstd * kg[3]);
            *(u32x2*)(P + (size_t)(r0 + rr) * 1024 + 512 + 4 * lane) = w; }
        {
            u32x4 wp;
#pragma unroll
            for (int q = 0; q < 4; ++q) wp[q] = (unsigned)__shfl_xor((int)wr[q], 2);
            float o[8], xp[8];
#pragma unroll
            for (int q = 0; q < 4; ++q) { o[2 * q] = bflo(wr[q]); o[2 * q + 1] = bfhi(wr[q]); xp[2 * q] = bflo(wp[q]); xp[2 * q + 1] = bfhi(wp[q]); }
            if (lat) { const int t = pos0 + krow - CTXL, pp = (ka & 4) ? (t & 63) : (t >> 6); const f32x4* tp = (const f32x4*)(tab + pp * 16 + kfi);
#pragma unroll
                for (int q = 0; q < 4; ++q) { const f32x4 cs = tp[q]; const float s0 = kx2 ? cs.y : -cs.y, s1 = kx2 ? cs.w : -cs.w;
                    o[2 * q] = o[2 * q] * cs.x + xp[2 * q] * s0; o[2 * q + 1] = o[2 * q + 1] * cs.z + xp[2 * q + 1] * s1; } }
            u32x4 wo; wo.x = cvtpk(o[0], o[1]); wo.y = cvtpk(o[2], o[3]); wo.z = cvtpk(o[4], o[5]); wo.w = cvtpk(o[6], o[7]);
            if (lane < 32) *(u32x4*)(KR + (size_t)(r0 + krow) * 64 + 8 * ka) = wo;
        }
    }
}
__device__ __forceinline__ void p_sgu(Frame& F) {
    const bf16_t* P = (const bf16_t*)(F.ws + WS_PBUF); bf16_t* MIX = (bf16_t*)(F.ws + WS_MIX0); const bf16_t* SW = (const bf16_t*)(F.ws + WS_SGUW);
    const int tid = F.tid, lane = F.lane, wid = F.wave, hw = wid >> 2, w4 = wid & 3, th = tid & 255, r32 = lane & 31, hi = lane >> 5;
    LAS char* Vl = (LAS char*)F.lds + hw * 32768;
    const int sr = th >> 4, sc = (th & 15) * 8;
    const int vb0 = (int)(unsigned)(uintptr_t)Vl + att::v_rd_base(lane);
    const float* psg = INP(I_SGUNG); const float* psb = INP(I_SGUB);
    for (int U = F.bid; U < (NTOK / 128) * 2; U += F.G) {
        const int chunk = U >> 1, g = (U & 1) * 2 + hw; const size_t row0 = (size_t)chunk * 128;
        float gn[8];
#pragma unroll
        for (int j = 0; j < 8; ++j) gn[j] = psg[g * 128 + sc + j];
        __syncthreads();
#pragma unroll
        for (int i = 0; i < 8; ++i) {
            const int q = sr + 16 * i;
            u32x4 w = *(const u32x4*)(P + (row0 + q) * 2048 + 512 + g * 128 + sc); float x[8];
#pragma unroll
            for (int k = 0; k < 4; ++k) { x[2 * k] = bflo(w[k]); x[2 * k + 1] = bfhi(w[k]); }
            float ss = 0.f;
#pragma unroll
            for (int j = 0; j < 8; ++j) ss += x[j] * x[j];
            ss += __shfl_xor(ss, 1); ss += __shfl_xor(ss, 2); ss += __shfl_xor(ss, 4); ss += __shfl_xor(ss, 8);
            const float rstd = rsqrtf(ss * (1.f / 128.f) + EPS);
#pragma unroll
            for (int k = 0; k < 4; ++k) w[k] = cvtpk(x[2 * k] * rstd * gn[2 * k], x[2 * k + 1] * rstd * gn[2 * k + 1]);
            *(LAS u32x4*)(Vl + (q >> 6) * 16384 + att::v_st(q & 63, sc)) = w;
        }
        bf16x8 pa[8];
        const bf16_t* wrow = SW + ((size_t)g * 128 + 32 * w4 + r32) * 128 + 8 * hi;
#pragma unroll
        for (int k = 0; k < 8; ++k) pa[k] = *(const bf16x8*)(wrow + 16 * k);
        __syncthreads();
        f32x16 o[4] = {};
        att::pv_d0(o, vb0, pa[0], pa[1], pa[2], pa[3]);
        att::pv_d0(o, vb0 + 16384, pa[4], pa[5], pa[6], pa[7]);
#pragma unroll
        for (int r = 0; r < 16; ++r) { const int p = 32 * w4 + att::crow(r, hi); const float bs = psb[g * 128 + p];
#pragma unroll
            for (int d0 = 0; d0 < 4; ++d0) { const int c = d0 * 32 + r32; const float zu = bf2f(P[(row0 + p) * 2048 + g * 128 + c]);
                MIX[(row0 + p) * 1024 + g * 128 + c] = f2bf((o[d0][r] + bs) * zu); } }
    }
    __syncthreads();
}

using pg8::Unit; using pg8::Acc;
struct ProbIn0 {
    static constexpr bool PERM = true, GATHER = false, FP8 = false; int K, lda; const bf16_t* A; const bf16_t* Bt; bf16_t* O; pg8::StaticOrder so; int G, c;
    __device__ bool next(int i, Unit& u) const { return so.map((long)i * G + c, u.pm, u.pn); }
    __device__ const void* a_mat() const { return A; } __device__ const void* b_mat() const { return Bt; }
    __device__ unsigned a_off(const Unit& u) const { return (unsigned)u.pm * 256u * (unsigned)lda * 2u; }
    __device__ unsigned b_off(const Unit& u) const { return (unsigned)u.pn * 256u * (unsigned)K * 2u; }
    __device__ void a_voff(const Unit&, unsigned (&)[2][2]) const {}
    __device__ void epi(const Acc& acc, const Unit& u, int wr, int wc, int fr, int fq) const {
        bf16_t* dst = O + (size_t)u.pm * 256 * 2048 + u.pn * 256;
        if (u.pn < 4) pg8::epi_store_bf16<true>(acc, dst, 2048, nullptr, wr, wc, fr, fq); else pg8::epi_store_bf16<false>(acc, dst, 2048, nullptr, wr, wc, fr, fq);
    }
};
template <bool LATONLY> struct ProbPlain {
    static constexpr bool PERM = true, GATHER = false, FP8 = false; int K, lda; const bf16_t* A; const bf16_t* Bt; bf16_t* O; int ldc; pg8::StaticOrder so; int G, c;
    __device__ bool next(int i, Unit& u) const { int pm; if (!so.map((long)i * G + c, pm, u.pn)) return false; u.pm = LATONLY ? pm + pm / 8 + 1 : pm; return true; }
    __device__ const void* a_mat() const { return A; } __device__ const void* b_mat() const { return Bt; }
    __device__ unsigned a_off(const Unit& u) const { return (unsigned)u.pm * 256u * (unsigned)lda * 2u; }
    __device__ unsigned b_off(const Unit& u) const { return (unsigned)u.pn * 256u * (unsigned)K * 2u; }
    __device__ void a_voff(const Unit&, unsigned (&)[2][2]) const {}
    __device__ void epi(const Acc& acc, const Unit& u, int wr, int wc, int fr, int fq) const {
        pg8::epi_store_bf16<false>(acc, O + (size_t)u.pm * 256 * ldc + u.pn * 256, ldc, nullptr, wr, wc, fr, fq);
    }
};
struct ProbIn1 {
    static constexpr bool PERM = true, GATHER = false, FP8 = false; int K, lda; const bf16_t* A; const bf16_t* Bt; bf16_t* O; pg8::StaticOrder so; int G, c;
    __device__ bool next(int i, Unit& u) const {
        const long L = (long)i * G + c;
        if (L < 1024) { int pm; so.map(L, pm, u.pn); u.pm = pm + pm / 8 + 1; return true; }
        if (L < 1024 + 64) { const int q = (int)(L - 1024); u.pm = (q >> 1) * 9; u.pn = 2 + (q & 1); return true; }
        return false;
    }
    __device__ const void* a_mat() const { return A; } __device__ const void* b_mat() const { return Bt; }
    __device__ unsigned a_off(const Unit& u) const { return (unsigned)u.pm * 256u * (unsigned)lda * 2u; }
    __device__ unsigned b_off(const Unit& u) const { return (unsigned)u.pn * 256u * (unsigned)K * 2u; }
    __device__ void a_voff(const Unit&, unsigned (&)[2][2]) const {}
    __device__ void epi(const Acc& acc, const Unit& u, int wr, int wc, int fr, int fq) const {
        pg8::epi_store_bf16<false>(acc, O + (size_t)u.pm * 256 * 1024 + u.pn * 256, 1024, nullptr, wr, wc, fr, fq);
    }
};
template <int LAYER> struct ProbOut {
    static constexpr bool PERM = true, GATHER = false, FP8 = false; int K, lda; const bf16_t* A; const bf16_t* Bt; bf16_t* XR; const float* MOD; const float* xin; const float* cin; pg8::StaticOrder so; int G, c;
    __device__ __forceinline__ bool next(int i, Unit& u) const { int pm; if (!so.map((long)i * G + c, pm, u.pn)) return false; u.pm = LAYER ? pm + pm / 8 + 1 : pm; return true; }
    __device__ __forceinline__ const void* a_mat() const { return A; } __device__ __forceinline__ const void* b_mat() const { return Bt; }
    __device__ __forceinline__ unsigned a_off(const Unit& u) const { return (unsigned)u.pm * 256u * (unsigned)lda * 2u; }
    __device__ __forceinline__ unsigned b_off(const Unit& u) const { return (unsigned)u.pn * 256u * (unsigned)K * 2u; }
    __device__ __forceinline__ void a_voff(const Unit&, unsigned (&)[2][2]) const {}
    __device__ __forceinline__ void epi(const Acc& acc, const Unit& u, int wr, int wc, int fr, int fq) const {
        const int b = u.pm / 9, jj = u.pm % 9, mj = jj == 0 ? 32 : b;
        const float* basef = jj == 0 ? cin + (size_t)b * CTXL * DM : xin + ((size_t)b * SEQ + (jj - 1) * 256) * DM;
        bf16_t* dst = XR + (size_t)u.pm * 256 * DM; const float* gate = MOD + ((size_t)(LAYER * 33 + mj) * 6 + 2) * 1024;
        const int row0 = wr * 64 + fr, col0 = u.pn * 256 + wc * 32 + 8 * fq;
        f32x4 gv[2][2];
#pragma unroll
        for (int bj = 0; bj < 2; ++bj)
#pragma unroll
            for (int n = 0; n < 2; ++n) gv[bj][n] = *(const f32x4*)(gate + col0 + bj * 128 + 4 * n);
#pragma unroll
        for (int ai = 0; ai < 2; ++ai)
#pragma unroll
            for (int m = 0; m < 4; ++m) { const size_t off = (size_t)(row0 + ai * 128 + m * 16) * DM + col0;
#pragma unroll
                for (int bj = 0; bj < 2; ++bj) { f32x4 b0, b1;
                    if constexpr (LAYER == 0) { b0 = *(const f32x4*)(basef + off + bj * 128); b1 = *(const f32x4*)(basef + off + bj * 128 + 4); }
                    else { const u32x4 w = *(const u32x4*)(dst + off + bj * 128); b0 = (f32x4){bflo(w.x), bfhi(w.x), bflo(w.y), bfhi(w.y)}; b1 = (f32x4){bflo(w.z), bfhi(w.z), bflo(w.w), bfhi(w.w)}; }
                    const f32x4 v0 = b0 + gv[bj][0] * acc[ai][bj][m][0], v1 = b1 + gv[bj][1] * acc[ai][bj][m][1];
                    u32x4 wo; wo.x = cvtpk(v0[0], v0[1]); wo.y = cvtpk(v0[2], v0[3]); wo.z = cvtpk(v1[0], v1[1]); wo.w = cvtpk(v1[2], v1[3]);
                    *(u32x4*)(dst + off + bj * 128) = wo; } }
    }
};
struct MoeSched {
    const LAS int* pb; int NTN, G, c;
    __device__ bool map(int i, Unit& u) const {
        const int x = c & 7, q = i * (G >> 3) + (c >> 3); const int blk = (q / NTN) * 8 + x; u.pn = q % NTN;
        if (blk >= __builtin_amdgcn_readfirstlane(pb[32])) return false;
        int lo = 0;
#pragma unroll
        for (int st = 16; st >= 1; st >>= 1) { if (__builtin_amdgcn_readfirstlane(pb[lo + st]) <= blk) lo += st; }
        u.e = lo; u.rb = blk - __builtin_amdgcn_readfirstlane(pb[lo]); u.pm = blk; return true;
    }
};
struct ProbMoe1 {
    static constexpr bool PERM = true, GATHER = true, FP8 = MOE_FP8 != 0; int K, lda; const bf16_t* H; const bf16_t* W1; const float* B1; bf16_t* ACT; const int* rowl; const LAS int* cnt; MoeSched ms; int wave_s;
    __device__ bool next(int i, Unit& u) const { return ms.map(i, u); }
    __device__ const void* a_mat() const { return H; } __device__ const void* b_mat() const { return W1; }
    __device__ unsigned a_off(const Unit&) const { return 0u; }
    __device__ unsigned b_off(const Unit& u) const { return ((unsigned)u.e * 2048u + (unsigned)u.pn * 256u) * 1024u * (FP8 ? 1u : 2u); }
    __device__ void a_voff(const Unit& u, unsigned (&vo)[2][2]) const {
        const int n = cnt[u.e]; const int* rl = rowl + (size_t)u.e * ROWCAP + u.rb * 256;
        const int tidg = tid_fresh(wave_s);
#pragma unroll
        for (int i = 0; i < 2; ++i) { int R, C; pg8::stage_rc(tidg * 16 + i * 8192, R, C);
#pragma unroll
            for (int h = 0; h < 2; ++h) { const int ri = h * 128 + R; const int tok = (u.rb * 256 + ri < n) ? rl[ri] : 0; vo[h][i] = (unsigned)tok * (FP8 ? 1024u : 2048u) + (unsigned)C * 2u; } }
    }
    __device__ void epi(const Acc& acc, const Unit& u, int wr, int wc, int fr, int fq) const {
        const int row0 = wr * 64 + fr, col0 = u.pn * 128 + wc * 32 + 8 * fq;
        const float* bg = B1 + (size_t)u.e * 2048 + col0; const float* bl = bg + 1024;
        f32x4 bgv[2], blv[2];
#pragma unroll
        for (int n = 0; n < 2; ++n) { bgv[n] = *(const f32x4*)(bg + 4 * n); blv[n] = *(const f32x4*)(bl + 4 * n); }
        constexpr float SC = FP8 ? (1.f / 256.f) : 1.f;
        bf16_t* dst = ACT + (size_t)u.pm * 256 * 1024 + col0; unsigned char* dst8 = (unsigned char*)ACT + (size_t)u.pm * 256 * 1024 + col0;
#pragma unroll
        for (int ai = 0; ai < 2; ++ai)
#pragma unroll
            for (int m = 0; m < 4; ++m) { float a[8];
#pragma unroll
                for (int n = 0; n < 2; ++n) { const f32x4 g = acc[ai][0][m][n] * SC + bgv[n], l = acc[ai][1][m][n] * SC + blv[n];
#pragma unroll
                    for (int j = 0; j < 4; ++j) { const float gg = fminf(g[j], 7.f), ll = fminf(fmaxf(l[j], -7.f), 7.f);
                        a[4 * n + j] = gg * __builtin_amdgcn_rcpf(1.f + __builtin_amdgcn_exp2f(-1.702f * 1.4426950408889634f * gg)) * (ll + 1.f); } }
                if constexpr (FP8) { u32x2 w; w.x = pk4_fp8(a[0] * 8.f, a[1] * 8.f, a[2] * 8.f, a[3] * 8.f); w.y = pk4_fp8(a[4] * 8.f, a[5] * 8.f, a[6] * 8.f, a[7] * 8.f);
                    *(u32x2*)(dst8 + (size_t)(row0 + ai * 128 + m * 16) * 1024) = w; }
                else { u32x4 w; w.x = cvtpk(a[0], a[1]); w.y = cvtpk(a[2], a[3]); w.z = cvtpk(a[4], a[5]); w.w = cvtpk(a[6], a[7]);
                    *(u32x4*)(dst + (size_t)(row0 + ai * 128 + m * 16) * 1024) = w; } }
    }
};
struct ProbMoe2 {
    static constexpr bool PERM = true, GATHER = false, FP8 = MOE_FP8 != 0; int K, lda; const bf16_t* ACT; const bf16_t* W2; const float* B2; bf16_t* Y; MoeSched ms;
    __device__ bool next(int i, Unit& u) const { return ms.map(i, u); }
    __device__ const void* a_mat() const { return ACT; } __device__ const void* b_mat() const { return W2; }
    __device__ unsigned a_off(const Unit& u) const { return (unsigned)u.pm * 256u * 1024u * (FP8 ? 1u : 2u); }
    __device__ unsigned b_off(const Unit& u) const { return ((unsigned)u.e * 1024u + (unsigned)u.pn * 256u) * 1024u * (FP8 ? 1u : 2u); }
    __device__ void a_voff(const Unit&, unsigned (&)[2][2]) const {}
    __device__ void epi(const Acc& acc, const Unit& u, int wr, int wc, int fr, int fq) const {
        constexpr float SC = FP8 ? (1.f / 512.f) : 1.f;
#if Y_FP8
        const int row0 = wr * 64 + fr, col0 = wc * 32 + 8 * fq; const float* bias = B2 + (size_t)u.e * 1024 + u.pn * 256 + col0;
        f32x4 bv[2][2];
#pragma unroll
        for (int bj = 0; bj < 2; ++bj)
#pragma unroll
            for (int n = 0; n < 2; ++n) bv[bj][n] = *(const f32x4*)(bias + bj * 128 + 4 * n);
        unsigned char* dst = (unsigned char*)Y + ((size_t)u.pm * 256) * 1024 + u.pn * 256; const unsigned lane_off = (unsigned)(row0 * 1024 + col0);
#pragma unroll
        for (int ai = 0; ai < 2; ++ai)
#pragma unroll
            for (int m = 0; m < 4; ++m) { unsigned char* rowb = dst + (size_t)((ai * 128 + m * 16) * 1024);
#pragma unroll
                for (int bj = 0; bj < 2; ++bj) { const f32x4 v0 = (acc[ai][bj][m][0] * SC + bv[bj][0]) * 16.f, v1 = (acc[ai][bj][m][1] * SC + bv[bj][1]) * 16.f;
                    u32x2 w; w.x = pk4_fp8(v0[0], v0[1], v0[2], v0[3]); w.y = pk4_fp8(v1[0], v1[1], v1[2], v1[3]);
                    *(u32x2*)(rowb + lane_off + bj * 128) = w; } }
#else
        pg8::epi_store_bf16<false>(acc, Y + (size_t)u.pm * 256 * 1024 + u.pn * 256, 1024, B2 + (size_t)u.e * 1024 + u.pn * 256, wr, wc, fr, fq, SC);
#endif
    }
};

__global__ void __launch_bounds__(512, 2) fwd_kernel(Args args) {
    extern __shared__ __attribute__((aligned(16))) uchar lds_raw[];
    const int wave_s = __builtin_amdgcn_readfirstlane((int)threadIdx.x >> 6);
    Frame F; F.lds = (LAS uchar*)lds_raw; F.tid = tid_fresh(wave_s); F.lane = F.tid & 63; F.wave = wave_s; F.G = gridDim.x; F.bid = blockIdx.x;
    F.ws = args.ws; F.out = args.out;
    volatile LAS unsigned* MISC = (volatile LAS unsigned*)(F.lds + MISC_OFF);
    if (F.tid < 64) MISC[F.tid] = 0u;
    __syncthreads();
    unsigned* ctl = (unsigned*)(F.ws + WS_CTL);
    XcdBarrier bar; bar.bar = ctl + CW_BAR; bar.x = 0; bar.st = nullptr;
    const int lo = args.ph_lo, hi = args.ph_hi;
    if (hi - lo > 1) bar = xcd_barrier_post(ctl + CW_BAR, MISC + 8, F.tid == 0);
#ifndef PHMASK
#define PHMASK 0x7ffff
#endif
#define REFRAME() do { F.tid = tid_fresh(wave_s); F.lane = F.tid & 63; F.wave = wave_s; } while (0)
#define IN(k) (((PHMASK >> (k)) & 1) && lo <= (k) && (k) < hi)
#define SEAM(k) do { if (IN(k) && IN((k) + 1)) { const int t_ = tid_fresh(wave_s); xcd_barrier(bar, t_ == 0); } } while (0)
    uchar* ws = F.ws;
    bf16_t* H = (bf16_t*)(ws + WS_H); bf16_t* XR = (bf16_t*)(ws + WS_XR); const float* MOD = (const float*)(ws + WS_MOD);

    if (IN(0)) { REFRAME(); p0_prologue(F); } SEAM(0);
    if (IN(1)) { REFRAME(); p_norm0(F); } SEAM(1);
    if (IN(2)) { REFRAME(); ProbIn0 p; p.K = 1024; p.lda = 1024; p.A = H; p.Bt = (const bf16_t*)(ws + WS_WIN0); p.O = (bf16_t*)(ws + WS_PBUF); p.so.init(NPAN, 8); p.G = F.G; p.c = F.bid; pg8::gemm_phase(F.lds, p, wave_s); } SEAM(2);
    if (IN(3)) { REFRAME(); p_qk_prep(F); } SEAM(3);
    if (IN(4)) { REFRAME();
        const bf16_t* P = (const bf16_t*)(ws + WS_PBUF); bf16_t* MIX = (bf16_t*)(ws + WS_MIX0);
        for (int u = F.bid; u < 1024 + 128; u += F.G) {
            if (u < 1024) { const int qb = u & 7, g = (u >> 3) & 1, kvh = (u >> 4) & 1, b = u >> 5, h = kvh * 2 + g; const size_t kr0 = (size_t)b * TPB, qr0 = kr0 + CTXL + qb * 256;
                att::attn_unit<128, 2, false, 2048, 2048, 1024>(P + qr0 * 2048 + 1024 + h * 128, P + kr0 * 2048 + 1536 + kvh * 128, nullptr, P + kr0 * 2048 + 1792 + kvh * 128, MIX + qr0 * 1024 + 512 + h * 128, TPB, (LAS char*)F.lds, nullptr, 0, wave_s);
            } else { const int v = u - 1024, h = v & 3, b = v >> 2, kvh = h >> 1; const size_t kr0 = (size_t)b * TPB;
                att::attn_unit<128, 2, false, 2048, 2048, 1024>(P + kr0 * 2048 + 1024 + h * 128, P + kr0 * 2048 + 1536 + kvh * 128, nullptr, P + kr0 * 2048 + 1792 + kvh * 128, MIX + kr0 * 1024 + 512 + h * 128, CTXL, (LAS char*)F.lds, nullptr, 0, wave_s); }
        }
        REFRAME(); p_sgu(F);
    } SEAM(4);
    if (IN(5)) { REFRAME(); ProbOut<0> p; p.K = 1024; p.lda = 1024; p.A = (const bf16_t*)(ws + WS_MIX0); p.Bt = (const bf16_t*)(ws + WS_WOUT0); p.XR = XR; p.MOD = MOD; p.xin = INP(I_X); p.cin = INP(I_CTX); p.so.init(NPAN, 4); p.G = F.G; p.c = F.bid; pg8::gemm_phase(F.lds, p, wave_s); } SEAM(5);
    if (IN(6)) { REFRAME(); p_norm_router<0>(F, args.dry); } SEAM(6);
    if (IN(7)) { REFRAME(); moe_prefix(F, 0); ProbMoe1 p; p.K = MOE_FP8 ? 512 : 1024; p.lda = p.K; p.H = H; p.W1 = (const bf16_t*)(ws + WS_W1); p.B1 = INP(I_B1); p.ACT = (bf16_t*)(ws + WS_ACT); p.rowl = (const int*)(ws + WS_ROWL);
        p.cnt = (const LAS int*)(F.lds + XTRA_OFF + X_CNT); p.wave_s = wave_s; p.ms.pb = (const LAS int*)(F.lds + XTRA_OFF + X_PB); p.ms.NTN = 8; p.ms.G = F.G; p.ms.c = F.bid; pg8::gemm_phase(F.lds, p, wave_s); } SEAM(7);
    if (IN(8)) { REFRAME(); moe_prefix(F, 0); ProbMoe2 p; p.K = MOE_FP8 ? 512 : 1024; p.lda = p.K; p.ACT = (const bf16_t*)(ws + WS_ACT); p.W2 = (const bf16_t*)(ws + WS_W2); p.B2 = INP(I_B2); p.Y = (bf16_t*)(ws + WS_Y);
        p.ms.pb = (const LAS int*)(F.lds + XTRA_OFF + X_PB); p.ms.NTN = 4; p.ms.G = F.G; p.ms.c = F.bid; pg8::gemm_phase(F.lds, p, wave_s); } SEAM(8);
    if (IN(9)) { REFRAME(); p_combine_norm(F, args.dry); } SEAM(9);
    if (IN(10)) { REFRAME(); ProbIn1 p; p.K = 1024; p.lda = 1024; p.A = H; p.Bt = (const bf16_t*)(ws + WS_WIN1); p.O = (bf16_t*)(ws + WS_PBUF); p.so.init(256, 4); p.G = F.G; p.c = F.bid; pg8::gemm_phase(F.lds, p, wave_s); } SEAM(10);
    if (IN(11)) { REFRAME(); p_mla_prep(F); } SEAM(11);
    if (IN(12)) { REFRAME();
        { ProbPlain<true> p; p.K = 512; p.lda = 1024; p.A = (const bf16_t*)(ws + WS_PBUF); p.Bt = (const bf16_t*)(ws + WS_WUQ); p.O = (bf16_t*)(ws + WS_QB); p.ldc = 1536; p.so.init(256, 6); p.G = F.G; p.c = F.bid; pg8::gemm_phase(F.lds, p, wave_s); }
        { ProbPlain<false> p; p.K = 256; p.lda = 1024; p.A = (const bf16_t*)(ws + WS_PBUF) + 512; p.Bt = (const bf16_t*)(ws + WS_WUKV); p.O = (bf16_t*)(ws + WS_KVB); p.ldc = 2048; p.so.init(NPAN, 8); p.G = F.G; p.c = F.bid; pg8::gemm_phase(F.lds, p, wave_s); }
    } SEAM(12);
    if (IN(13)) { REFRAME();
        const bf16_t* Q = (const bf16_t*)(ws + WS_QB); const bf16_t* KV = (const bf16_t*)(ws + WS_KVB); const bf16_t* KR = (const bf16_t*)(ws + WS_KRB); bf16_t* MIX = (bf16_t*)(ws + WS_MIX1);
        for (int u = F.bid; u < 2048; u += F.G) { const int qb = u & 7, h = (u >> 3) & 7, b = u >> 6; const size_t kr0 = (size_t)b * TPB, qr0 = kr0 + CTXL + qb * 256;
            att::attn_unit<192, 1, true, 1536, 2048, 1024>(Q + qr0 * 1536 + h * 192, KV + kr0 * 2048 + h * 128, KR + kr0 * 64, KV + kr0 * 2048 + 1024 + h * 128, MIX + qr0 * 1024 + h * 128, TPB, (LAS char*)F.lds, (const f32x2*)(ws + WS_TABM), qb * 256, wave_s); }
    } SEAM(13);
    if (IN(14)) { REFRAME(); ProbOut<1> p; p.K = 1024; p.lda = 1024; p.A = (const bf16_t*)(ws + WS_MIX1); p.Bt = (const bf16_t*)(ws + WS_WOUT1); p.XR = XR; p.MOD = MOD; p.xin = nullptr; p.cin = nullptr; p.so.init(256, 4); p.G = F.G; p.c = F.bid; pg8::gemm_phase(F.lds, p, wave_s); } SEAM(14);
    if (IN(15)) { REFRAME(); p_norm_router<1>(F, args.dry); } SEAM(15);
    if (IN(16)) { REFRAME(); moe_prefix(F, 1); ProbMoe1 p; p.K = MOE_FP8 ? 512 : 1024; p.lda = p.K; p.H = H; p.W1 = (const bf16_t*)(ws + WS_W1 + (size_t)32 * 2048 * 1024 * (MOE_FP8 ? 1 : 2)); p.B1 = INP(I_B1) + 32 * 2048; p.ACT = (bf16_t*)(ws + WS_ACT); p.rowl = (const int*)(ws + WS_ROWL);
        p.cnt = (const LAS int*)(F.lds + XTRA_OFF + X_CNT); p.wave_s = wave_s; p.ms.pb = (const LAS int*)(F.lds + XTRA_OFF + X_PB); p.ms.NTN = 8; p.ms.G = F.G; p.ms.c = F.bid; pg8::gemm_phase(F.lds, p, wave_s); } SEAM(16);
    if (IN(17)) { REFRAME(); moe_prefix(F, 1); ProbMoe2 p; p.K = MOE_FP8 ? 512 : 1024; p.lda = p.K; p.ACT = (const bf16_t*)(ws + WS_ACT); p.W2 = (const bf16_t*)(ws + WS_W2 + (size_t)32 * 1024 * 1024 * (MOE_FP8 ? 1 : 2)); p.B2 = INP(I_B2) + 32 * 1024; p.Y = (bf16_t*)(ws + WS_Y);
        p.ms.pb = (const LAS int*)(F.lds + XTRA_OFF + X_PB); p.ms.NTN = 4; p.ms.G = F.G; p.ms.c = F.bid; pg8::gemm_phase(F.lds, p, wave_s); } SEAM(17);
    if (IN(18)) { REFRAME(); p_final(F); }
#undef IN
#undef SEAM
}

extern "C" void kernel_launch(void* const* d_in, const int* in_sizes, int n_in, void* d_out, int out_size, void* d_ws, size_t ws_size, hipStream_t stream) {
    static int grid = 0;
    if (grid == 0) {
        if (n_in != 28 || out_size != NBATCH * SEQ * DM || ws_size < WS_END) { fprintf(stderr, "kernel_launch: unexpected shapes (n_in %d out %d ws %zu, need ws >= %zu)\n", n_in, out_size, ws_size, (size_t)WS_END); grid = -1; return; }
        int dev = 0, cus = 0, per_cu = 0;
        if (hipGetDevice(&dev) != hipSuccess || hipDeviceGetAttribute(&cus, hipDeviceAttributeMultiprocessorCount, dev) != hipSuccess) { grid = -1; return; }
        if (hipFuncSetAttribute((const void*)fwd_kernel, hipFuncAttributeMaxDynamicSharedMemorySize, LDS_BYTES) != hipSuccess) { fprintf(stderr, "kernel_launch: hipFuncSetAttribute failed\n"); grid = -1; return; }
        if (hipOccupancyMaxActiveBlocksPerMultiprocessor(&per_cu, (const void*)fwd_kernel, 512, LDS_BYTES) != hipSuccess || per_cu < 1) { fprintf(stderr, "kernel_launch: occupancy query says %d blocks/CU\n", per_cu); }
        (void)hipGetLastError();
        grid = cus;
    }
    if (grid < 0) return;
    (void)hipMemsetAsync((char*)d_ws + WS_CTL, 0, CTL_BYTES, stream);
    Args a{};
    for (int i = 0; i < 28; ++i) a.in[i] = (const float*)d_in[i];
    a.out = (float*)d_out; a.ws = (uchar*)d_ws;
#if MK_ONE_LAUNCH
    a.ph_lo = 0; a.ph_hi = NPHASE;
    hipLaunchKernelGGL(fwd_kernel, dim3(grid), dim3(512), LDS_BYTES, stream, a);
#else
    for (int ph = 0; ph < NPHASE; ++ph) { a.ph_lo = ph; a.ph_hi = ph + 1; const int nrep = 1 + ((REPEAT_MASK >> ph) & 1); for (int rep = 0; rep < nrep; ++rep) { a.dry = (rep + 1 < nrep) ? 1 : 0; hipLaunchKernelGGL(fwd_kernel, dim3(grid), dim3(512), LDS_BYTES, stream, a); } }
#endif
}
```

```cpp
#include <hip/hip_runtime.h>
#include <cstdio>
#include <cstdint>

#ifndef MK_ONE_LAUNCH
#define MK_ONE_LAUNCH 1
#endif
#define REPEAT_MASK 0
#define USE_BUFFER_LDS 1
#define MOE_PREGATHER 0
#define PROJ0_FP8 0
#ifndef UPQ_FP8
#define UPQ_FP8 (MOE_FP8 != 0)
#endif
#ifndef UPKV_FP8
#define UPKV_FP8 0
#endif
#define UP1_FP8_UNUSED 0
#define OUT1_FP8 (MOE_FP8 != 0)
#define PROJ1_FP8 (MOE_FP8 != 0)
#define PROJ_FP8_UNUSED (MOE_FP8 != 0)
#define Y_FP8 1
#ifndef MOE_FP8
#define MOE_FP8 1
#endif

#define LAS __attribute__((address_space(3)))
typedef unsigned short bf16_t;
typedef unsigned char uchar;
typedef short bf16x8 __attribute__((ext_vector_type(8)));
typedef short s16x4 __attribute__((ext_vector_type(4)));
typedef float f32x2 __attribute__((ext_vector_type(2)));
typedef float f32x4 __attribute__((ext_vector_type(4)));
typedef float f32x16 __attribute__((ext_vector_type(16)));
typedef unsigned u32x2 __attribute__((ext_vector_type(2)));
typedef unsigned u32x4 __attribute__((ext_vector_type(4)));
typedef int i32x4 __attribute__((ext_vector_type(4)));
typedef int i32x8 __attribute__((ext_vector_type(8)));

constexpr int DM = 1024, NBATCH = 32, SEQ = 2048, CTXL = 256, TPB = SEQ + CTXL, NTOK = NBATCH * TPB, NPAN = NTOK / 256;
constexpr int NEXP = 32, TOPK = 4, ROWCAP = NTOK;
constexpr float EPS = 1e-6f;
constexpr int NPHASE = 19;

constexpr size_t MiB = 1u << 20;
constexpr size_t WS_CTL = 0, CTL_BYTES = 1 * MiB;
constexpr size_t WS_MOD = 1 * MiB;
constexpr size_t WS_TABG = 3 * MiB;
constexpr size_t WS_TABM = WS_TABG + 32768;
constexpr size_t WS_WRT = WS_TABG + 65536;
constexpr size_t WS_SGUW = WS_WRT + 262144;
constexpr size_t WS_WIN0 = 4 * MiB, WS_WOUT0 = 8 * MiB, WS_WIN1 = 10 * MiB, WS_WUQ = 12 * MiB, WS_WUKV = 14 * MiB, WS_WOUT1 = 15 * MiB;
constexpr size_t WS_W1 = 17 * MiB;
constexpr size_t WS_W2 = 273 * MiB;
constexpr size_t WS_ROWL = 401 * MiB;
constexpr size_t WS_TOKI = 410 * MiB;
constexpr size_t WS_XR = 413 * MiB;
constexpr size_t WS_H = 701 * MiB;
constexpr size_t WS_SCR = 845 * MiB;
constexpr size_t WS_PBUF = WS_SCR;
constexpr size_t WS_MIX0 = WS_SCR + 288 * MiB;
constexpr size_t WS_QB = WS_SCR + 144 * MiB;
constexpr size_t WS_KVB = WS_SCR + 360 * MiB;
constexpr size_t WS_KRB = WS_SCR + 648 * MiB;
constexpr size_t WS_MIX1 = WS_SCR + 660 * MiB;
constexpr size_t WS_CQ8 = WS_SCR + 804 * MiB;
constexpr size_t WS_CKV8 = WS_SCR + 840 * MiB;
constexpr size_t WS_ACT = WS_SCR;
constexpr size_t WS_XS = WS_SCR + 296 * MiB;
constexpr size_t WS_Y = WS_SCR + 592 * MiB;
constexpr size_t WS_END = WS_SCR + 1184 * MiB;
constexpr int CW_BAR = 1024;
constexpr int CW_CNT = 8192;
constexpr int CW_DBG = 16384;

constexpr int RING_BYTES = 131072;
constexpr int XTRA_OFF = RING_BYTES, XTRA_BYTES = 20480;
constexpr int MISC_OFF = XTRA_OFF + XTRA_BYTES;
constexpr int LDS_BYTES = MISC_OFF + 512;
constexpr int X_PB = 0;
constexpr int X_CNT = 256;
constexpr int X_HIST = 512;
constexpr int X_BASE = 768;
constexpr int X_SEL = 1024;
constexpr int X_A2 = 9216;
constexpr int X_CB = 13312;
constexpr int X_RS = 13440;

#define LDS_WAIT() asm volatile("s_waitcnt lgkmcnt(0)" ::: "memory")
#define VM_WAIT() asm volatile("s_waitcnt vmcnt(0)" ::: "memory")
#define SBAR() __builtin_amdgcn_sched_barrier(0)
__device__ __forceinline__ unsigned cvtpk(float lo, float hi) { unsigned r; asm volatile("v_cvt_pk_bf16_f32 %0, %1, %2" : "=v"(r) : "v"(lo), "v"(hi)); return r; }
__device__ __forceinline__ float bf2f(unsigned short b) { return __uint_as_float(((unsigned)b) << 16); }
__device__ __forceinline__ float bflo(unsigned w) { return __uint_as_float(w << 16); }
__device__ __forceinline__ float bfhi(unsigned w) { return __uint_as_float(w & 0xffff0000u); }
__device__ __forceinline__ unsigned short f2bf(float f) { return (unsigned short)(cvtpk(f, 0.f) & 0xffffu); }
__device__ __forceinline__ unsigned pk4_fp8(float a, float b, float c, float d) {
    a = fminf(fmaxf(a, -448.f), 448.f); b = fminf(fmaxf(b, -448.f), 448.f); c = fminf(fmaxf(c, -448.f), 448.f); d = fminf(fmaxf(d, -448.f), 448.f);
    unsigned w = 0; w = __builtin_amdgcn_cvt_pk_fp8_f32(a, b, w, false); w = __builtin_amdgcn_cvt_pk_fp8_f32(c, d, w, true); return w;
}
__device__ __forceinline__ int tid_fresh(int wave_s) { int l; asm volatile("v_mbcnt_lo_u32_b32 %0, -1, 0\n\tv_mbcnt_hi_u32_b32 %0, -1, %0" : "=v"(l)); return wave_s * 64 + l; }
template <int CTRL, int BANK> __device__ __forceinline__ int dpp_i(int old, int x) { return __builtin_amdgcn_update_dpp(old, x, CTRL, 0xF, BANK, false); }
__device__ __forceinline__ int xs1(int x) { return dpp_i<0xB1, 0xF>(x, x); }
__device__ __forceinline__ int xs2(int x) { return dpp_i<0x4E, 0xF>(x, x); }
__device__ __forceinline__ int xs4(int x) { const int t = dpp_i<0x114, 0xA>(x, x); return dpp_i<0x104, 0x5>(t, x); }
__device__ __forceinline__ int xs8(int x) { return dpp_i<0x128, 0xF>(x, x); }
__device__ __forceinline__ float xf1(float x) { return __int_as_float(xs1(__float_as_int(x))); }
__device__ __forceinline__ float xf2(float x) { return __int_as_float(xs2(__float_as_int(x))); }
__device__ __forceinline__ float xf4(float x) { return __int_as_float(xs4(__float_as_int(x))); }
__device__ __forceinline__ float xf8(float x) { return __int_as_float(xs8(__float_as_int(x))); }
__device__ __forceinline__ float sum16(float a, float b) { auto r = __builtin_amdgcn_permlane16_swap(__float_as_uint(a), __float_as_uint(b), false, false); return __uint_as_float(r[0]) + __uint_as_float(r[1]); }
__device__ __forceinline__ float sum32(float a, float b) { auto r = __builtin_amdgcn_permlane32_swap(__float_as_uint(a), __float_as_uint(b), false, false); return __uint_as_float(r[0]) + __uint_as_float(r[1]); }
__device__ __forceinline__ unsigned xu16(unsigned x, int lane) { auto r = __builtin_amdgcn_permlane16_swap(x, x, false, false); return (lane & 16) ? r[0] : r[1]; }
__device__ __forceinline__ unsigned xu32(unsigned x, int lane) { auto r = __builtin_amdgcn_permlane32_swap(x, x, false, false); return (lane & 32) ? r[0] : r[1]; }
__device__ __forceinline__ float wave_sum(float v) {
    v += xf1(v); v += xf2(v); v += xf4(v); v += xf8(v); v = sum16(v, v); v = sum32(v, v);
    return v;
}
__device__ __forceinline__ float silu_f(float x) { return x / (1.f + __expf(-x)); }
__device__ __forceinline__ float gelu_tanh_f(float x) {
    const float u = x * (1.5957691216057308f + 0.07135481627260025f * x * x);
    const float e = __builtin_amdgcn_exp2f(-1.4426950408889634f * u);
    return x * __builtin_amdgcn_rcpf(1.f + e);
}

#define XB_TMO      128
#define XB_XCNT(j)  (256  + 64 * (j))
#define XB_XSUB(j)  (1280 + 64 * (j))
#define XB_XGEN(j)  (2304 + 64 * (j))
#define XB_TOP      3328
#define XB_TOPGEN   3392
#define XCD_BAR_WORDS 3456
#define XB_SPIN_CAP (1u << 20)
__device__ __forceinline__ unsigned xb_ld(unsigned* p)              { return __hip_atomic_load(p, __ATOMIC_RELAXED, __HIP_MEMORY_SCOPE_AGENT); }
__device__ __forceinline__ unsigned xb_add(unsigned* p, unsigned v) { return __hip_atomic_fetch_add(p, v, __ATOMIC_RELAXED, __HIP_MEMORY_SCOPE_AGENT); }
__device__ __forceinline__ unsigned xb_xcc_id() { return (unsigned)__builtin_amdgcn_s_getreg((3 << 11) | 20) & 0xFu; }
#define XB_SPIN(cond, bar) do { unsigned _sp = 0; while (cond) { __builtin_amdgcn_s_sleep(1); \
    if ((++_sp & 255u) == 0u) { if (xb_ld(&(bar)[XB_TMO])) break; if (_sp > XB_SPIN_CAP) { atomicAdd(&(bar)[XB_TMO], 1u); break; } } } } while (0)
struct XcdBarrier { unsigned* bar; unsigned x; volatile LAS unsigned* st; };
__device__ __forceinline__ XcdBarrier xcd_barrier_post(unsigned* bar, volatile LAS unsigned* st, bool t0) {
    XcdBarrier b; b.bar = bar; b.x = xb_xcc_id(); b.st = st;
    if (t0) (void)xb_add(&bar[XB_XCNT(b.x)], 1u);
    return b;
}
__device__ __forceinline__ void xcd_barrier_complete(unsigned* bar, unsigned x, unsigned& nloc, unsigned& nx) {
    const unsigned G = gridDim.x * gridDim.y * gridDim.z;
    unsigned sum, cnt, mine, sp = 0u;
    for (;;) {
        sum = 0u; cnt = 0u; mine = 0u;
#pragma unroll
        for (unsigned j = 0; j < 16; ++j) { const unsigned c = xb_ld(&bar[XB_XCNT(j)]); sum += c; cnt += (c > 0u) ? 1u : 0u; mine = (j == x) ? c : mine; }
        if (sum == G) break;
        __builtin_amdgcn_s_sleep(1);
        if ((++sp & 255u) == 0u) { if (xb_ld(&bar[XB_TMO])) break; if (sp > XB_SPIN_CAP) { atomicAdd(&bar[XB_TMO], 1u); break; } }
    }
    nloc = mine > 0u ? mine : 1u; nx = cnt > 0u ? cnt : 1u;
}
__device__ __forceinline__ void xcd_barrier(const XcdBarrier& b, bool t0) {
    asm volatile("s_waitcnt vmcnt(0)" ::: "memory");
    __syncthreads();
    if (t0) {
        unsigned* bar = b.bar;
        __builtin_amdgcn_s_waitcnt(0);
        unsigned nloc = b.st[0], nx = b.st[1];
        if (nloc == 0u) { xcd_barrier_complete(bar, b.x, nloc, nx); b.st[0] = nloc; b.st[1] = nx; }
        const unsigned old = xb_add(&bar[XB_XSUB(b.x)], 1u);
        const unsigned gen = old / nloc;
        if (old + 1u == (gen + 1u) * nloc) {
            __builtin_amdgcn_fence(__ATOMIC_RELEASE, "agent");
            asm volatile("s_waitcnt vmcnt(0)" ::: "memory");
            const unsigned og = xb_add(&bar[XB_TOP], 1u);
            const unsigned tg = og / nx;
            if (og + 1u == (tg + 1u) * nx) xb_add(&bar[XB_TOPGEN], 1u);
            else XB_SPIN(xb_ld(&bar[XB_TOPGEN]) == tg, bar);
            __builtin_amdgcn_fence(__ATOMIC_ACQUIRE, "agent");
            xb_add(&bar[XB_XGEN(b.x)], 1u);
            asm volatile("s_waitcnt vmcnt(0)" ::: "memory");
        } else {
            XB_SPIN(xb_ld(&bar[XB_XGEN(b.x)]) == gen, bar);
            __builtin_amdgcn_fence(__ATOMIC_ACQUIRE, "agent");
            asm volatile("s_waitcnt vmcnt(0)" ::: "memory");
        }
    }
    __syncthreads();
}

struct Args { const float* in[28]; float* out; uchar* ws; int ph_lo, ph_hi, dry, pad; };
enum { I_X = 0, I_C, I_CTX, I_CCTX, I_ADAW, I_ADAB, I_NMIXG, I_NFFNG, I_ABWIN, I_SGUNG, I_SGUW, I_SGUB, I_GQG, I_GKG, I_ABWOUT, I_MLAWIN, I_MLAQG, I_MLAKVG, I_MLAWUQ, I_MLAWUKV, I_MLAWOUT,
       I_RW, I_RB, I_W1, I_B1, I_W2, I_B2, I_FNG };
struct Frame {
    LAS uchar* lds; int tid, lane, wave, G, bid;
    uchar* ws; float* out;
};
__device__ __forceinline__ const float* INP(int i) {
    const __attribute__((address_space(4))) char* ka = (const __attribute__((address_space(4))) char*)__builtin_amdgcn_kernarg_segment_ptr();
    return *(const float* const volatile __attribute__((address_space(4)))*)(ka + i * 8);
}

namespace pg8 {
constexpr int BM = 256, BK = 64, HALF = 128, HTB = HALF * BK * 2, NXCD = 8, WGM = 8;
__device__ __forceinline__ int lds_byte(int r, int c) { const int st = (r >> 4) * 2 + (c >> 5), rr = r & 15, cc = c & 31, ob = rr * 64 + cc * 2; return st * 1024 + (ob ^ (((ob >> 9) & 1) << 5)); }
__device__ __forceinline__ void stage_rc(int b, int& R, int& C) { const int st = b / 1024, sb = b % 1024, swz = sb ^ (((sb >> 9) & 1) << 5); R = (st >> 1) * 16 + swz / 64; C = (st & 1) * 32 + (swz % 64) / 2; }
__device__ __forceinline__ int perm32(int rho) { const int n = rho >> 4, i = rho & 15; return 8 * (i >> 2) + 4 * n + (i & 3); }
struct Unit { int pm, pn, e, rb; };
struct StaticOrder {
    int nM, nN, nwg;
    __device__ void init(int nM_, int nN_) { nM = nM_; nN = nN_; nwg = nM * nN; }
    __device__ bool map(long L, int& pm, int& pn) const {
        if (L >= nwg) return false;
        int wgid = (int)L; { const int q = nwg / NXCD, r = nwg % NXCD, xcd = wgid % NXCD, off = wgid / NXCD; wgid = (xcd < r ? xcd * (q + 1) : r * (q + 1) + (xcd - r) * q) + off; }
        const int nig = WGM * nN, gid = wgid / nig, fm = gid * WGM, gsz = (nM - fm) < WGM ? (nM - fm) : WGM;
        pm = fm + ((wgid % nig) % gsz); pn = (wgid % nig) / gsz; return true;
    }
};
typedef f32x4 Acc[2][2][4][2];
template <class P>
__device__ __forceinline__ void gemm_phase(LAS uchar* lds, const P& p, int wave_s) {
    const int tid = tid_fresh(wave_s), wid = __builtin_amdgcn_readfirstlane(tid >> 6), lane = tid & 63, wr = wid >> 2, wc = wid & 3, fr = lane & 15, fq = lane >> 4;
    const int K = p.K, nt = K / BK;
    unsigned voffA[2][2], voffB[2];
#pragma unroll
    for (int i = 0; i < 2; ++i) { int R, C; stage_rc(tid * 16 + i * 8192, R, C); const int Rb = P::PERM ? ((R & ~31) + perm32(R & 31)) : R;
        voffA[0][i] = (unsigned)(R * p.lda + C) * 2u; voffA[1][i] = voffA[0][i]; voffB[i] = (unsigned)(Rb * K + C) * 2u; }
    const unsigned kstep = (unsigned)(BK * 2);
    const unsigned hstepB = (unsigned)HALF * K * 2;
    const unsigned hstepA = P::GATHER ? 0u : (unsigned)HALF * p.lda * 2;
#define PG8_VA1 voffA[P::GATHER ? 1 : 0]
    const __amdgpu_buffer_rsrc_t rsA = __builtin_amdgcn_make_buffer_rsrc((void*)p.a_mat(), 0, 0xffffffffu, 0x00020000);
    const __amdgpu_buffer_rsrc_t rsB = __builtin_amdgcn_make_buffer_rsrc((void*)p.b_mat(), 0, 0xffffffffu, 0x00020000);
    const char* gpA = (const char*)p.a_mat(); const char* gpB = (const char*)p.b_mat(); (void)gpA; (void)gpB; (void)rsA; (void)rsB;
    const unsigned ldsw = (unsigned)wid * 1024u;
    const int aoff = lds_byte(wr * 64 + fr, fq * 8), boff = lds_byte(wc * 32 + fr, fq * 8);
#define PG8_SA(b, h) (((b) * 2 + (h)) * HTB)
#define PG8_SB(b, h) ((4 + (b) * 2 + (h)) * HTB)
#if USE_BUFFER_LDS
#define PG8_STAGE_R(bufoff, rs, gp, soff, voff) do { _Pragma("unroll") for (int _i = 0; _i < 2; ++_i) \
        __builtin_amdgcn_raw_ptr_buffer_load_lds(rs, (LAS unsigned*)(lds + (bufoff) + ldsw + _i * 8192), 16, (int)(voff)[_i], (int)(soff), 0, 0); } while (0)
#else
#define PG8_STAGE_R(bufoff, rs, gp, soff, voff) do { _Pragma("unroll") for (int _i = 0; _i < 2; ++_i) \
        __builtin_amdgcn_global_load_lds((const unsigned*)((const char*)(gp) + (size_t)(soff) + (voff)[_i]), (LAS unsigned*)(lds + (bufoff) + ldsw + _i * 8192), 16, 0, 0); } while (0)
#endif
#define PG8_STAGE_A(bufoff, soff, voff) PG8_STAGE_R(bufoff, rsA, gpA, soff, voff)
#define PG8_STAGE_B(bufoff, soff, voff) PG8_STAGE_R(bufoff, rsB, gpB, soff, voff)
#define PG8_LDA(dst, b, h) do { _Pragma("unroll") for (int m = 0; m < 4; ++m) _Pragma("unroll") for (int k = 0; k < 2; ++k) dst[m][k] = *(const LAS i32x4*)(lds + PG8_SA(b, h) + aoff + m * 2048 + k * 1024); } while (0)
#define PG8_LDB(dst, b, h) do { _Pragma("unroll") for (int n = 0; n < 2; ++n) _Pragma("unroll") for (int k = 0; k < 2; ++k) dst[n][k] = *(const LAS i32x4*)(lds + PG8_SB(b, h) + boff + n * 2048 + k * 1024); } while (0)
#define PG8_CAT(x) __builtin_shufflevector((x)[0], (x)[1], 0, 1, 2, 3, 4, 5, 6, 7)
#define PG8_MMA(ai, bj, At, Bt) do { __builtin_amdgcn_s_setprio(1); \
        if constexpr (P::FP8) { _Pragma("unroll") for (int m = 0; m < 4; ++m) _Pragma("unroll") for (int n = 0; n < 2; ++n) \
            acc[ai][bj][m][n] = __builtin_amdgcn_mfma_scale_f32_16x16x128_f8f6f4(PG8_CAT(Bt[n]), PG8_CAT(At[m]), acc[ai][bj][m][n], 0, 0, 0, 0x7F7F7F7F, 0, 0x7F7F7F7F); } \
        else { _Pragma("unroll") for (int m = 0; m < 4; ++m) _Pragma("unroll") for (int n = 0; n < 2; ++n) _Pragma("unroll") for (int k = 0; k < 2; ++k) \
            acc[ai][bj][m][n] = __builtin_amdgcn_mfma_f32_16x16x32_bf16(__builtin_bit_cast(bf16x8, Bt[n][k]), __builtin_bit_cast(bf16x8, At[m][k]), acc[ai][bj][m][n], 0, 0, 0); } \
        __builtin_amdgcn_s_setprio(0); } while (0)
#define PG8_WAIT_V(n) asm volatile("s_waitcnt vmcnt(" #n ")" ::: "memory")
#define PG8_WAIT_L(n) asm volatile("s_waitcnt lgkmcnt(" #n ")" ::: "memory")
#define PG8_BAR __builtin_amdgcn_s_barrier()
#define PG8_SCHED __builtin_amdgcn_sched_barrier(0)
    Unit cur, nxt; int ui = 0;
    if (!p.next(0, cur)) return;
    Acc acc;
#pragma unroll
    for (int a = 0; a < 2; ++a)
#pragma unroll
        for (int b = 0; b < 2; ++b)
#pragma unroll
            for (int m = 0; m < 4; ++m)
#pragma unroll
                for (int n = 0; n < 2; ++n) acc[a][b][m][n] = (f32x4){0.f, 0.f, 0.f, 0.f};
    i32x4 At[4][2], B0[2][2], B1[2][2];
    unsigned cA = p.a_off(cur), cB = p.b_off(cur);
    if constexpr (P::GATHER) { p.a_voff(cur, voffA); }
    PG8_STAGE_B(PG8_SB(0, 0), cB, voffB); PG8_STAGE_B(PG8_SB(0, 1), cB + hstepB, voffB); PG8_STAGE_A(PG8_SA(0, 0), cA, voffA[0]); PG8_STAGE_A(PG8_SA(0, 1), cA + hstepA, PG8_VA1);
    if (wr == 1) PG8_BAR;
    PG8_WAIT_V(2); PG8_BAR;
    PG8_STAGE_B(PG8_SB(1, 0), cB + kstep, voffB); PG8_STAGE_A(PG8_SA(1, 0), cA + kstep, voffA[0]); PG8_STAGE_B(PG8_SB(1, 1), cB + hstepB + kstep, voffB);
    PG8_WAIT_V(6); PG8_BAR;
    for (;;) {
        const bool has_next = p.next(ui + 1, nxt);
        const unsigned nA = has_next ? p.a_off(nxt) : cA, nB = has_next ? p.b_off(nxt) : cB;
        for (int t = 0; t < nt; t += 2) {
            const bool last = (t == nt - 2);
            const unsigned a1 = cA + (unsigned)(t + 1) * kstep;
            const unsigned a2 = last ? nA : cA + (unsigned)(t + 2) * kstep, b2 = last ? nB : cB + (unsigned)(t + 2) * kstep;
            const unsigned a3 = a2 + kstep, b3 = b2 + kstep;
            PG8_LDB(B0, 0, 0); PG8_LDB(B1, 0, 1); PG8_SCHED; PG8_LDA(At, 0, 0); PG8_STAGE_A(PG8_SA(1, 1), a1 + hstepA, PG8_VA1);
            if constexpr (P::GATHER) { if (last && has_next) p.a_voff(nxt, voffA); }
            PG8_WAIT_V(8); PG8_WAIT_L(0); PG8_BAR; PG8_MMA(0, 0, At, B0); PG8_MMA(0, 1, At, B1); PG8_BAR; PG8_SCHED;
            PG8_LDA(At, 0, 1); PG8_STAGE_B(PG8_SB(0, 0), b2, voffB); PG8_STAGE_B(PG8_SB(0, 1), b2 + hstepB, voffB); PG8_STAGE_A(PG8_SA(0, 0), a2, voffA[0]);
            PG8_WAIT_V(8); PG8_WAIT_L(0); PG8_BAR; PG8_MMA(1, 0, At, B0); PG8_MMA(1, 1, At, B1); PG8_BAR; PG8_SCHED;
            PG8_LDB(B0, 1, 0); PG8_LDB(B1, 1, 1); PG8_SCHED; PG8_LDA(At, 1, 0); PG8_STAGE_A(PG8_SA(0, 1), a2 + hstepA, PG8_VA1);
            PG8_WAIT_V(8); PG8_WAIT_L(0); PG8_BAR; PG8_MMA(0, 0, At, B0); PG8_MMA(0, 1, At, B1); PG8_BAR; PG8_SCHED;
            PG8_LDA(At, 1, 1); PG8_STAGE_B(PG8_SB(1, 0), b3, voffB); PG8_STAGE_B(PG8_SB(1, 1), b3 + hstepB, voffB); PG8_STAGE_A(PG8_SA(1, 0), a3, voffA[0]);
            PG8_WAIT_V(8); PG8_WAIT_L(0); PG8_BAR; PG8_MMA(1, 0, At, B0); PG8_MMA(1, 1, At, B1); PG8_BAR; PG8_SCHED;
        }
        if (wr == 0) PG8_BAR;
        p.epi(acc, cur, wr, wc, fr, fq);
        if (!has_next) break;
#pragma unroll
        for (int a = 0; a < 2; ++a)
#pragma unroll
            for (int b = 0; b < 2; ++b)
#pragma unroll
                for (int m = 0; m < 4; ++m)
#pragma unroll
                    for (int n = 0; n < 2; ++n) acc[a][b][m][n] = (f32x4){0.f, 0.f, 0.f, 0.f};
        cur = nxt; cA = nA; cB = nB; ++ui;
        if (wr == 1) PG8_BAR;
    }
    PG8_WAIT_V(0);
    PG8_BAR;
#undef PG8_SA
#undef PG8_VA1
#undef PG8_SB
#undef PG8_STAGE_R
#undef PG8_STAGE_A
#undef PG8_STAGE_B
#undef PG8_LDA
#undef PG8_LDB
#undef PG8_MMA
#undef PG8_CAT
#undef PG8_WAIT_V
#undef PG8_WAIT_L
#undef PG8_BAR
#undef PG8_SCHED
}

template <bool GELU>
__device__ __forceinline__ void epi_store_bf16(const Acc& acc, bf16_t* dst  , int ldc, const float* bias  , int wr, int wc, int fr, int fq, float sc = 1.f) {
    const int row0 = wr * 64 + fr, col0 = wc * 32 + 8 * fq;
    f32x4 bv[2][2];
#pragma unroll
    for (int bj = 0; bj < 2; ++bj)
#pragma unroll
        for (int n = 0; n < 2; ++n) bv[bj][n] = bias ? *(const f32x4*)(bias + col0 + bj * HALF + 4 * n) : (f32x4){0.f, 0.f, 0.f, 0.f};
    const unsigned lane_off = (unsigned)(row0 * ldc + col0) * 2u;
#pragma unroll
    for (int ai = 0; ai < 2; ++ai)
#pragma unroll
        for (int m = 0; m < 4; ++m) { char* rowb = (char*)dst + (size_t)((ai * HALF + m * 16) * ldc) * 2;
#pragma unroll
            for (int bj = 0; bj < 2; ++bj) { f32x4 v0 = acc[ai][bj][m][0] * sc + bv[bj][0], v1 = acc[ai][bj][m][1] * sc + bv[bj][1];
                if (GELU) {
#pragma unroll
                    for (int j = 0; j < 4; ++j) { v0[j] = gelu_tanh_f(v0[j]); v1[j] = gelu_tanh_f(v1[j]); } }
                u32x4 w; w.x = cvtpk(v0[0], v0[1]); w.y = cvtpk(v0[2], v0[3]); w.z = cvtpk(v1[0], v1[1]); w.w = cvtpk(v1[2], v1[3]);
                *(u32x4*)(rowb + lane_off + bj * HALF * 2) = w; } }
}
}

namespace att {
constexpr int NW = 8, QBLK = 32, KVBLK = 64;
constexpr int SHM_V = KVBLK * 128 * 2;
constexpr float THR = 8.f;
__device__ __forceinline__ int crow(int r, int hi) { return (r & 3) + 8 * (r >> 2) + 4 * hi; }
template <int DQK> struct Cfg { static constexpr float SCALE = (DQK == 128) ? 0.088388347648318440f : 0.072168783648703220f; static constexpr int KP = DQK * 2, SHM_K = KVBLK * DQK * 2, ND = DQK / 16; };
#define KSWZ(PITCH, row, colB) ((row) * (PITCH) + ((colB) ^ (((row) & 7) << 4)))
template <int DQK> __device__ __forceinline__ void partialSM(f32x16& p0, f32x16& p1, float& m_reg, float& mn, float& alpha) {
    constexpr float SCALE = Cfg<DQK>::SCALE, C = SCALE * 1.4426950408889634f;
    float pmax = p0[0];
#pragma unroll
    for (int r = 1; r < 16; ++r) pmax = fmaxf(pmax, p0[r]);
#pragma unroll
    for (int r = 0; r < 16; ++r) pmax = fmaxf(pmax, p1[r]);
    { auto rr = __builtin_amdgcn_permlane32_swap(__float_as_uint(pmax), __float_as_uint(pmax), false, false);
      pmax = fmaxf(__uint_as_float(rr[0]), __uint_as_float(rr[1])); }
    if (__builtin_expect(__all(pmax - m_reg <= THR / SCALE), 1)) { mn = m_reg; alpha = 1.f; }
    else { mn = fmaxf(m_reg, pmax); alpha = __builtin_amdgcn_exp2f((m_reg - mn) * C); m_reg = mn; }
    const float mnC = -mn * C;
#pragma unroll
    for (int r = 0; r < 16; ++r) p0[r] = fmaf(p0[r], C, mnC);
#pragma unroll
    for (int r = 0; r < 16; ++r) p1[r] = fmaf(p1[r], C, mnC);
#pragma unroll
    for (int r = 0; r < 16; ++r) p0[r] = __builtin_amdgcn_exp2f(p0[r]);
}
__device__ __forceinline__ void finishSM(f32x16& p0, f32x16& p1, float alpha, float& l_reg, bf16x8& pa0, bf16x8& pa1, bf16x8& pa2, bf16x8& pa3) {
#pragma unroll
    for (int r = 0; r < 16; ++r) p1[r] = __builtin_amdgcn_exp2f(p1[r]);
    float ps = 0;
#pragma unroll
    for (int r = 0; r < 16; ++r) ps += p0[r];
#pragma unroll
    for (int r = 0; r < 16; ++r) ps += p1[r];
    { auto rr = __builtin_amdgcn_permlane32_swap(__float_as_uint(ps), __float_as_uint(ps), false, false);
      ps = __uint_as_float(rr[0]) + __uint_as_float(rr[1]); }
    l_reg = l_reg * alpha + ps;
#define PK4(P, BASE, OUT) do { unsigned a0 = cvtpk(P[BASE + 0], P[BASE + 1]), a1 = cvtpk(P[BASE + 2], P[BASE + 3]);   \
    unsigned b0 = cvtpk(P[BASE + 4], P[BASE + 5]), b1 = cvtpk(P[BASE + 6], P[BASE + 7]);                              \
    auto r0 = __builtin_amdgcn_permlane32_swap(a0, b0, false, false); auto r1 = __builtin_amdgcn_permlane32_swap(a1, b1, false, false); \
    u32x4 w = {r0[0], r1[0], r0[1], r1[1]}; OUT = *reinterpret_cast<bf16x8*>(&w); } while (0)
    PK4(p0, 0, pa0); PK4(p0, 8, pa1); PK4(p1, 0, pa2); PK4(p1, 8, pa3);
#undef PK4
}
template <int DQK> __device__ __forceinline__ void qkt(f32x16& p0, f32x16& p1, const LAS char* Ks, const bf16x8* qr, int r32, int hi) {
    constexpr int KP = Cfg<DQK>::KP, ND = Cfg<DQK>::ND;
    p0 = f32x16{}; p1 = f32x16{};
#pragma unroll
    for (int d0 = 0; d0 < ND; ++d0) { const int cb = (d0 * 16 + hi * 8) * 2;
        bf16x8 b0 = *reinterpret_cast<const LAS bf16x8*>(Ks + KSWZ(KP, r32, cb));
        bf16x8 b1 = *reinterpret_cast<const LAS bf16x8*>(Ks + KSWZ(KP, 32 + r32, cb));
        p0 = __builtin_amdgcn_mfma_f32_32x32x16_bf16(b0, qr[d0], p0, 0, 0, 0);
        p1 = __builtin_amdgcn_mfma_f32_32x32x16_bf16(b1, qr[d0], p1, 0, 0, 0); }
}
__device__ __forceinline__ int v_st(int k, int c) { const int kk = (k & ~0xC) | ((k & 4) << 1) | ((k & 8) >> 1); return ((kk >> 3) * 4 + (c >> 5)) * 512 + ((kk & 7) * 32 + (c & 31)) * 2; }
__device__ __forceinline__ int v_rd_base(int lane) { return ((lane & 3) << 3) | (((lane >> 2) & 3) << 6) | (((lane >> 4) & 1) << 5) | (((lane >> 5) & 1) << 8); }
constexpr int v_rd_off(int d0, int ks, int half) { return d0 * 512 + ks * 4096 + half * 2048; }
template <int OFF> __device__ __forceinline__ s16x4 tr_read(int vb) {
    s16x4 r; asm volatile("ds_read_b64_tr_b16 %0, %1 offset:%2" : "=&v"(r) : "v"(vb), "i"(OFF) : "memory"); return r;
}
template <int D0> __device__ __forceinline__ void pv_one(f32x16& od, int vb, bf16x8 pa0, bf16x8 pa1, bf16x8 pa2, bf16x8 pa3) {
    const s16x4 l0 = tr_read<v_rd_off(D0, 0, 0)>(vb), h0 = tr_read<v_rd_off(D0, 0, 1)>(vb), l1 = tr_read<v_rd_off(D0, 1, 0)>(vb), h1 = tr_read<v_rd_off(D0, 1, 1)>(vb);
    const s16x4 l2 = tr_read<v_rd_off(D0, 2, 0)>(vb), h2 = tr_read<v_rd_off(D0, 2, 1)>(vb), l3 = tr_read<v_rd_off(D0, 3, 0)>(vb), h3 = tr_read<v_rd_off(D0, 3, 1)>(vb);
    asm volatile("s_waitcnt lgkmcnt(0)" ::: "memory"); SBAR();
#define PK(L, H) (bf16x8){L[0], L[1], L[2], L[3], H[0], H[1], H[2], H[3]}
    od = __builtin_amdgcn_mfma_f32_32x32x16_bf16(pa0, PK(l0, h0), od, 0, 0, 0);
    od = __builtin_amdgcn_mfma_f32_32x32x16_bf16(pa1, PK(l1, h1), od, 0, 0, 0);
    od = __builtin_amdgcn_mfma_f32_32x32x16_bf16(pa2, PK(l2, h2), od, 0, 0, 0);
    od = __builtin_amdgcn_mfma_f32_32x32x16_bf16(pa3, PK(l3, h3), od, 0, 0, 0);
#undef PK
}
__device__ __forceinline__ void pv_d0(f32x16* o, int vb, bf16x8 pa0, bf16x8 pa1, bf16x8 pa2, bf16x8 pa3) {
    pv_one<0>(o[0], vb, pa0, pa1, pa2, pa3); pv_one<1>(o[1], vb, pa0, pa1, pa2, pa3); pv_one<2>(o[2], vb, pa0, pa1, pa2, pa3); pv_one<3>(o[3], vb, pa0, pa1, pa2, pa3);
}
__device__ __forceinline__ bf16x8 ld8(const bf16_t* p) { return *reinterpret_cast<const bf16x8*>(p); }
__device__ __forceinline__ void rope_frag(bf16x8& a, bf16x8& b, const f32x2* tab) {
    u32x4 wa = *reinterpret_cast<u32x4*>(&a), wb = *reinterpret_cast<u32x4*>(&b), oa, ob;
#pragma unroll
    for (int q = 0; q < 4; ++q) {
        const float x1l = bflo(wa[q]), x1h = bfhi(wa[q]), x2l = bflo(wb[q]), x2h = bfhi(wb[q]);
        const f32x2 t0 = tab[2 * q], t1 = tab[2 * q + 1];
        oa[q] = cvtpk(x1l * t0.x - x2l * t0.y, x1h * t1.x - x2h * t1.y);
        ob[q] = cvtpk(x2l * t0.x + x1l * t0.y, x2h * t1.x + x1h * t1.y);
    }
    a = *reinterpret_cast<bf16x8*>(&oa); b = *reinterpret_cast<bf16x8*>(&ob);
}
template <int DQK, int SDEPTH, bool MLA, int ldq, int ldkv, int ldo, bool OUT8 = false>
__device__ __forceinline__ void attn_unit(const bf16_t* __restrict__ Qb, const bf16_t* __restrict__ Kh, const bf16_t* __restrict__ KRh, const bf16_t* __restrict__ Vh,
                                          bf16_t* __restrict__ Ob, int seq, LAS char* lds, const f32x2* __restrict__ tabm, int qt0, int wave_s) {
    constexpr int KP = Cfg<DQK>::KP, SHM_K = Cfg<DQK>::SHM_K, ND = Cfg<DQK>::ND;
    const int tid = tid_fresh(wave_s), wid = tid >> 6, lane = tid & 63, r32 = lane & 31, hi = lane >> 5;
    LAS char* V_lds = lds; LAS char* K_lds = lds + 2 * SHM_V;
    LAS float* wsl = (LAS float*)(lds + 2 * SHM_V + 2 * SHM_K) + wid * 64; LAS float* li_l = wsl; LAS float* al_l = wsl + 32;
    float m_reg = -1e30f, l_reg = 0; f32x16 o[4] = {}; bf16x8 qr[ND];
    const bf16_t* Qw = Qb + (long)(wid * QBLK + r32) * ldq + hi * 8;
#pragma unroll
    for (int d0 = 0; d0 < ND; ++d0) qr[d0] = ld8(Qw + d0 * 16);
    if constexpr (MLA) {
        const int t = qt0 + wid * QBLK + r32, prow = t >> 6, pcol = t & 63;
        rope_frag(qr[8], qr[9], tabm + prow * 16 + hi * 8);
        rope_frag(qr[10], qr[11], tabm + pcol * 16 + hi * 8);
    }
    const int sr = tid >> 4, sc = (tid & 15) * 8, vst0 = v_st(sr, sc), vst1 = v_st(32 + sr, sc);
    const int krr = tid >> 3, krc = (tid & 7) * 8;
    const int vb0 = (int)(unsigned)(uintptr_t)V_lds + v_rd_base(lane);
    struct { bf16x8 vs0, vs1, ks0, ks1, kr; } sr_[SDEPTH];
#define SLOAD(i, k0) do { sr_[i].vs0 = ld8(&Vh[(long)((k0) + sr) * ldkv + sc]); sr_[i].vs1 = ld8(&Vh[(long)((k0) + 32 + sr) * ldkv + sc]); \
    sr_[i].ks0 = ld8(&Kh[(long)((k0) + sr) * ldkv + sc]); sr_[i].ks1 = ld8(&Kh[(long)((k0) + 32 + sr) * ldkv + sc]); \
    if constexpr (MLA) sr_[i].kr = ld8(&KRh[(long)((k0) + krr) * 64 + krc]); } while (0)
#define SWRITE(b, i) do { *(LAS bf16x8*)(V_lds + (b) * SHM_V + vst0) = sr_[i].vs0;          \
    *(LAS bf16x8*)(V_lds + (b) * SHM_V + vst1) = sr_[i].vs1; const int kc = sc * 2;               \
    *(LAS bf16x8*)(K_lds + (b) * SHM_K + KSWZ(KP, sr, kc)) = sr_[i].ks0;                       \
    *(LAS bf16x8*)(K_lds + (b) * SHM_K + KSWZ(KP, 32 + sr, kc)) = sr_[i].ks1;                  \
    if constexpr (MLA) *(LAS bf16x8*)(K_lds + (b) * SHM_K + KSWZ(KP, krr, 256 + krc * 2)) = sr_[i].kr; } while (0)
#define SWAIT() do { if constexpr (SDEPTH == 2) { if constexpr (MLA) asm volatile("s_waitcnt vmcnt(5)" ::: "memory"); else asm volatile("s_waitcnt vmcnt(4)" ::: "memory"); } else asm volatile("s_waitcnt vmcnt(0)" ::: "memory"); } while (0)
#define RESC(a) do { if (__any((a) < 1.f)) { if (hi == 0) al_l[r32] = (a); asm volatile("s_waitcnt lgkmcnt(0)" ::: "memory"); \
    _Pragma("unroll") for (int d = 0; d < 4; ++d) _Pragma("unroll") for (int r = 0; r < 16; ++r) o[d][r] *= al_l[crow(r, hi)]; } } while (0)
    bf16x8 pa0, pa1, pa2, pa3; const int NT = seq / KVBLK;
    if constexpr (MLA) {
        f32x16 p0, p1; float mn, al;
        SLOAD(0, 0); asm volatile("s_waitcnt vmcnt(0)" ::: "memory"); SWRITE(0, 0); SLOAD(0, KVBLK); __syncthreads();
        for (int j = 0; j < NT; ++j) {
            const int cb = j & 1;
            if (j + 1 < NT) { asm volatile("s_waitcnt vmcnt(0)" ::: "memory"); SWRITE(cb ^ 1, 0); if (j + 2 < NT) SLOAD(0, (j + 2) * KVBLK); }
            SBAR(); qkt<DQK>(p0, p1, K_lds + cb * SHM_K, qr, r32, hi);
            partialSM<DQK>(p0, p1, m_reg, mn, al); RESC(al);
            finishSM(p0, p1, al, l_reg, pa0, pa1, pa2, pa3); SBAR();
            pv_d0(o, vb0 + cb * SHM_V, pa0, pa1, pa2, pa3);
            __syncthreads();
        }
    } else {
    f32x16 pA0, pA1, pB0, pB1; float mnA, mnB, alA, alB;
    constexpr int SE = 0, SO = SDEPTH - 1;
    SLOAD(SE, 0); asm volatile("s_waitcnt vmcnt(0)" ::: "memory"); SWRITE(0, SE); __syncthreads();
    qkt<DQK>(pA0, pA1, K_lds, qr, r32, hi); partialSM<DQK>(pA0, pA1, m_reg, mnA, alA);
    SLOAD(SO, KVBLK); if constexpr (SDEPTH == 2) { if (2 < NT) SLOAD(SE, 2 * KVBLK); }
    SWAIT(); SWRITE(1, SO); __syncthreads();
    for (int j = 1; j + 1 < NT; j += 2) {
        SBAR(); qkt<DQK>(pB0, pB1, K_lds + SHM_K, qr, r32, hi);
        finishSM(pA0, pA1, alA, l_reg, pa0, pa1, pa2, pa3); SBAR();
        SLOAD(SO, (j + SDEPTH) * KVBLK); SBAR();
        pv_d0(o, vb0, pa0, pa1, pa2, pa3); partialSM<DQK>(pB0, pB1, m_reg, mnB, alB);
        __syncthreads(); SWAIT(); SWRITE(0, SE);
        RESC(alB); __syncthreads();
        SBAR(); qkt<DQK>(pA0, pA1, K_lds, qr, r32, hi);
        finishSM(pB0, pB1, alB, l_reg, pa0, pa1, pa2, pa3); SBAR();
        if (SDEPTH == 1 || j + 3 < NT) SLOAD(SE, (j + 1 + SDEPTH) * KVBLK); SBAR();
        pv_d0(o, vb0 + SHM_V, pa0, pa1, pa2, pa3); partialSM<DQK>(pA0, pA1, m_reg, mnA, alA);
        __syncthreads(); SWAIT(); SWRITE(1, SO);
        RESC(alA); __syncthreads();
    }
    SBAR(); qkt<DQK>(pB0, pB1, K_lds + SHM_K, qr, r32, hi);
    finishSM(pA0, pA1, alA, l_reg, pa0, pa1, pa2, pa3); SBAR();
    pv_d0(o, vb0, pa0, pa1, pa2, pa3); partialSM<DQK>(pB0, pB1, m_reg, mnB, alB);
    __syncthreads(); RESC(alB);
    finishSM(pB0, pB1, alB, l_reg, pa0, pa1, pa2, pa3); SBAR();
    pv_d0(o, vb0 + SHM_V, pa0, pa1, pa2, pa3);
    }
    if (hi == 0) li_l[r32] = l_reg; asm volatile("s_waitcnt lgkmcnt(0)" ::: "memory");
    float rli[16];
#pragma unroll
    for (int r = 0; r < 16; ++r) rli[r] = __builtin_amdgcn_rcpf(li_l[crow(r, hi)]);
    bf16_t* Ow = OUT8 ? (bf16_t*)((unsigned char*)Ob + (long)(wid * QBLK) * ldo) : Ob + (long)(wid * QBLK) * ldo;
#pragma unroll
    for (int r = 0; r < 16; ++r) { const int orow = crow(r, hi);
#pragma unroll
        for (int d0 = 0; d0 < 4; ++d0) { if constexpr (OUT8) ((unsigned char*)Ow)[(long)orow * ldo + d0 * 32 + r32] = (unsigned char)(pk4_fp8(o[d0][r] * rli[r] * 16.f, 0.f, 0.f, 0.f) & 0xffu);
            else Ow[(long)orow * ldo + d0 * 32 + r32] = f2bf(o[d0][r] * rli[r]); } }
    __syncthreads();
#undef SLOAD
#undef SWRITE
#undef SWAIT
#undef RESC
}
}

template <int MODE> __device__ __forceinline__ int dst_row(int n) {
    if (MODE == 1) { const int half = n >> 10, c = n & 1023; return ((c >> 7) << 8) + (half << 7) + (c & 127); }
    if (MODE == 2) { const int h = n >> 8, j = n & 255; return j < 128 ? (h << 7) + j : 1024 + (h << 7) + (j - 128); }
    return n;
}
template <int MODE> __device__ __forceinline__ void p0_transpose_item_fp8(const float* W, int K, int N, unsigned char* WT, LAS float* scr, int item, int lane) {
    const int nblk = N / 32, kb = item / nblk, nb = item % nblk, k0 = 64 * kb, n0 = 32 * nb;
#pragma unroll 8
    for (int i = 0; i < 32; ++i) { const int kk = 2 * i + (lane >> 5); scr[kk * 33 + (lane & 31)] = W[(size_t)(k0 + kk) * N + n0 + (lane & 31)]; }
    LDS_WAIT(); asm volatile("" ::: "memory");
    const int c = lane & 7;
#pragma unroll
    for (int j = 0; j < 4; ++j) { const int n = (lane >> 3) + 8 * j; const LAS float* s = scr + (8 * c) * 33 + n;
        u32x2 o; o.x = pk4_fp8(s[0 * 33] * 64.f, s[1 * 33] * 64.f, s[2 * 33] * 64.f, s[3 * 33] * 64.f); o.y = pk4_fp8(s[4 * 33] * 64.f, s[5 * 33] * 64.f, s[6 * 33] * 64.f, s[7 * 33] * 64.f);
        *(u32x2*)(WT + (size_t)dst_row<MODE>(n0 + n) * K + k0 + 8 * c) = o; }
    LDS_WAIT(); asm volatile("" ::: "memory");
}
template <int MODE> __device__ __forceinline__ void p0_transpose_item(const float* W, int K, int N, bf16_t* WT, LAS float* scr, int item, int lane) {
    const int nblk = N / 32, kb = item / nblk, nb = item % nblk, k0 = 64 * kb, n0 = 32 * nb;
#pragma unroll 8
    for (int i = 0; i < 32; ++i) { const int kk = 2 * i + (lane >> 5); scr[kk * 33 + (lane & 31)] = W[(size_t)(k0 + kk) * N + n0 + (lane & 31)]; }
    LDS_WAIT(); asm volatile("" ::: "memory");
    const int c = lane & 7;
#pragma unroll
    for (int j = 0; j < 4; ++j) { const int n = (lane >> 3) + 8 * j; const LAS float* s = scr + (8 * c) * 33 + n;
        u32x4 o; o.x = cvtpk(s[0 * 33], s[1 * 33]); o.y = cvtpk(s[2 * 33], s[3 * 33]); o.z = cvtpk(s[4 * 33], s[5 * 33]); o.w = cvtpk(s[6 * 33], s[7 * 33]);
        *(u32x4*)(WT + (size_t)dst_row<MODE>(n0 + n) * K + k0 + 8 * c) = o; }
    LDS_WAIT(); asm volatile("" ::: "memory");
}
__device__ __forceinline__ void p0_prologue(Frame& F) {
    uchar* ws = F.ws;
    {
        LAS float* S = (LAS float*)F.lds;
        const float* pC = INP(I_C); const float* pCC = INP(I_CCTX); const float* pAW = INP(I_ADAW); const float* pAB = INP(I_ADAB); const float* pNM = INP(I_NMIXG); const float* pNF = INP(I_NFFNG);
        float* MOD = (float*)(ws + WS_MOD);
        for (int item = F.bid; item < 192; item += F.G) {
            const int layer = item / 96, n0 = (item % 96) * 64;
            __syncthreads();
            for (int u = F.tid; u < 33 * 1024; u += 512) { const int j = u >> 10, k = u & 1023; const float c = j < 32 ? pC[j * 1024 + k] : pCC[k]; S[u] = silu_f(c); }
            __syncthreads();
            float acc[33];
#pragma unroll
            for (int j = 0; j < 33; ++j) acc[j] = 0.f;
            const float* wp = pAW + (size_t)layer * 1024 * 6144 + n0 + F.lane;
            const int kbeg = F.wave * 128;
            for (int k = kbeg; k < kbeg + 128; k += 4) {
                const float w0 = wp[(size_t)k * 6144], w1 = wp[(size_t)(k + 1) * 6144], w2 = wp[(size_t)(k + 2) * 6144], w3 = wp[(size_t)(k + 3) * 6144];
#pragma unroll
                for (int j = 0; j < 33; ++j) { const f32x4 s = *(const LAS f32x4*)(S + j * 1024 + k); acc[j] += s.x * w0 + s.y * w1 + s.z * w2 + s.w * w3; }
            }
            __syncthreads();
#pragma unroll
            for (int j = 0; j < 33; ++j) S[(F.wave * 33 + j) * 64 + F.lane] = acc[j];
            __syncthreads();
            for (int u = F.tid; u < 33 * 64; u += 512) { const int j = u >> 6, cl = u & 63; float s = 0.f;
#pragma unroll
                for (int w = 0; w < 8; ++w) s += S[(w * 33 + j) * 64 + cl];
                const int n = n0 + cl, part = n >> 10, col = n & 1023;
                s += pAB[layer * 6144 + n];
                if (part == 1) s = pNM[layer * 1024 + col] * (1.f + s);
                if (part == 4) s = pNF[layer * 1024 + col] * (1.f + s);
                MOD[((size_t)(layer * 33 + j) * 6 + part) * 1024 + col] = s; }
        }
        __syncthreads();
    }
    {
        const int gt = F.bid * 512 + F.tid, NT = F.G * 512;
        f32x2* tg = (f32x2*)(ws + WS_TABG); f32x2* tm = (f32x2*)(ws + WS_TABM);
        for (int u = gt; u < 64 * 32; u += NT) { const int pos = u >> 5, i = u & 31; const float inv = powf(10000.f, -(float)(2 * i) / 64.f); const float a = (float)pos * inv; tg[u] = (f32x2){cosf(a), sinf(a)}; }
        for (int u = gt; u < 64 * 16; u += NT) { const int pos = u >> 4, i = u & 15; const float inv = powf(10000.f, -(float)(2 * i) / 32.f); const float a = (float)pos * inv; tm[u] = (f32x2){cosf(a), sinf(a)}; }
        float* wrt = (float*)(ws + WS_WRT); const float* pRW = INP(I_RW); const float* pSW = INP(I_SGUW);
        for (int u = gt; u < 2 * 32 * 1024; u += NT) { const int l = u >> 15, e = (u >> 10) & 31, k = u & 1023; wrt[u] = pRW[((size_t)l * 1024 + k) * 32 + e]; }
        bf16_t* sw = (bf16_t*)(ws + WS_SGUW);
        for (int u = gt; u < 4 * 128 * 128; u += NT) sw[u] = f2bf(pSW[u]);
        u32x4* z = (u32x4*)(ws + WS_WIN1 + (size_t)832 * 1024 * (PROJ1_FP8 ? 1 : 2));
        for (int u = gt; u < 192 * 1024 * (PROJ1_FP8 ? 1 : 2) / 16; u += NT) z[u] = (u32x4){0u, 0u, 0u, 0u};
    }
    {
        LAS float* scr = (LAS float*)(F.lds + F.wave * 16384);
        const int gw = F.bid * 8 + F.wave, NGW = F.G * 8; const float* pW1 = INP(I_W1); const float* pW2 = INP(I_W2);
        constexpr int J0 = 16 * 64, J1 = 16 * 32, J2 = 16 * 26, J3 = 8 * 48, J4 = 4 * 64, J5 = 16 * 32, JW1 = 64 * 1024, JW2 = 64 * 512;
        constexpr int NITEMS = J0 + J1 + J2 + J3 + J4 + J5 + JW1 + JW2;
        for (int it = gw; it < NITEMS; it += NGW) {
            int r = it;
#if MOE_FP8
            if (r < JW1) { const int le = r >> 10; p0_transpose_item_fp8<1>(pW1 + (size_t)le * 1024 * 2048, 1024, 2048, (unsigned char*)(ws + WS_W1) + (size_t)le * 2048 * 1024, scr, r & 1023, F.lane); continue; } r -= JW1;
            if (r < JW2) { const int le = r >> 9; p0_transpose_item_fp8<0>(pW2 + (size_t)le * 1024 * 1024, 1024, 1024, (unsigned char*)(ws + WS_W2) + (size_t)le * 1024 * 1024, scr, r & 511, F.lane); continue; } r -= JW2;
#else
            if (r < JW1) { const int le = r >> 10; p0_transpose_item<1>(pW1 + (size_t)le * 1024 * 2048, 1024, 2048, (bf16_t*)(ws + WS_W1) + (size_t)le * 2048 * 1024, scr, r & 1023, F.lane); continue; } r -= JW1;
            if (r < JW2) { const int le = r >> 9; p0_transpose_item<0>(pW2 + (size_t)le * 1024 * 1024, 1024, 1024, (bf16_t*)(ws + WS_W2) + (size_t)le * 1024 * 1024, scr, r & 511, F.lane); continue; } r -= JW2;
#endif
            if (r < J0) { if constexpr (PROJ0_FP8 != 0) p0_transpose_item_fp8<0>(INP(I_ABWIN), 1024, 2048, (unsigned char*)(ws + WS_WIN0), scr, r, F.lane); else p0_transpose_item<0>(INP(I_ABWIN), 1024, 2048, (bf16_t*)(ws + WS_WIN0), scr, r, F.lane); continue; } r -= J0;
            if (r < J1) { p0_transpose_item<0>(INP(I_ABWOUT), 1024, 1024, (bf16_t*)(ws + WS_WOUT0), scr, r, F.lane); continue; } r -= J1;
            if (r < J2) { if constexpr (PROJ1_FP8 != 0) p0_transpose_item_fp8<0>(INP(I_MLAWIN), 1024, 832, (unsigned char*)(ws + WS_WIN1), scr, r, F.lane); else p0_transpose_item<0>(INP(I_MLAWIN), 1024, 832, (bf16_t*)(ws + WS_WIN1), scr, r, F.lane); continue; } r -= J2;
            if (r < J3) { if constexpr (UPQ_FP8 != 0) p0_transpose_item_fp8<0>(INP(I_MLAWUQ), 512, 1536, (unsigned char*)(ws + WS_WUQ), scr, r, F.lane); else p0_transpose_item<0>(INP(I_MLAWUQ), 512, 1536, (bf16_t*)(ws + WS_WUQ), scr, r, F.lane); continue; } r -= J3;
            if (r < J4) { if constexpr (UPKV_FP8 != 0) p0_transpose_item_fp8<2>(INP(I_MLAWUKV), 256, 2048, (unsigned char*)(ws + WS_WUKV), scr, r, F.lane); else p0_transpose_item<2>(INP(I_MLAWUKV), 256, 2048, (bf16_t*)(ws + WS_WUKV), scr, r, F.lane); continue; } r -= J4;
            if constexpr (OUT1_FP8 != 0) p0_transpose_item_fp8<0>(INP(I_MLAWOUT), 1024, 1024, (unsigned char*)(ws + WS_WOUT1), scr, r, F.lane); else p0_transpose_item<0>(INP(I_MLAWOUT), 1024, 1024, (bf16_t*)(ws + WS_WOUT1), scr, r, F.lane);
        }
    }
}

__device__ __forceinline__ void row_src_ptr(const float* px, const float* pctx, int r, const float*& src, int& mj) {
    const int b = r / TPB, pos = r - b * TPB;
    if (pos < CTXL) { src = pctx + ((size_t)b * CTXL + pos) * DM; mj = 32; } else { src = px + ((size_t)b * SEQ + (pos - CTXL)) * DM; mj = b; }
}
__device__ __forceinline__ f32x4 bf4(u32x2 w) { return (f32x4){bflo(w.x), bfhi(w.x), bflo(w.y), bfhi(w.y)}; }
__device__ __forceinline__ u32x2 pk4bf(f32x4 v) { return (u32x2){cvtpk(v.x, v.y), cvtpk(v.z, v.w)}; }
__device__ __forceinline__ void store_h_row(bf16_t* hrow, int lane, const f32x4 (&h)[4]) {
    unsigned long long* o8 = (unsigned long long*)hrow + lane;
#pragma unroll
    for (int j = 0; j < 4; ++j) o8[64 * j] = (unsigned long long)cvtpk(h[j].x, h[j].y) | ((unsigned long long)cvtpk(h[j].z, h[j].w) << 32);
}
__device__ __forceinline__ void p_norm0(Frame& F) {
    const float* MOD = (const float*)(F.ws + WS_MOD); bf16_t* H = (bf16_t*)(F.ws + WS_H);
    const int gw = F.bid * 8 + F.wave, NGW = F.G * 8; const float* px = INP(I_X); const float* pctx = INP(I_CTX);
    for (int r = gw; r < NTOK; r += NGW) {
        const float* src; int mj; row_src_ptr(px, pctx, r, src, mj);
        const f32x4* xr = (const f32x4*)src + F.lane; f32x4 v[4]; float ss = 0.f;
#pragma unroll
        for (int j = 0; j < 4; ++j) { v[j] = xr[64 * j]; ss += (v[j].x * v[j].x + v[j].y * v[j].y) + (v[j].z * v[j].z + v[j].w * v[j].w); }
        const float rstd = rsqrtf(wave_sum(ss) * (1.f / DM) + EPS);
        const f32x4* sh = (const f32x4*)(MOD + ((size_t)(0 * 33 + mj) * 6 + 0) * 1024) + F.lane; const f32x4* A = (const f32x4*)(MOD + ((size_t)(0 * 33 + mj) * 6 + 1) * 1024) + F.lane;
        f32x4 h[4];
#pragma unroll
        for (int j = 0; j < 4; ++j) h[j] = v[j] * rstd * A[64 * j] + sh[64 * j];
        if constexpr (PROJ0_FP8 != 0) { unsigned* o4 = (unsigned*)((unsigned char*)H + (size_t)r * DM) + F.lane;
#pragma unroll
            for (int j = 0; j < 4; ++j) o4[64 * j] = pk4_fp8(h[j].x * 4.f, h[j].y * 4.f, h[j].z * 4.f, h[j].w * 4.f); }
        else store_h_row(H + (size_t)r * DM, F.lane, h);
    }
}
__device__ __forceinline__ void moe_prefix(Frame& F, int layer) {
    LAS int* pb = (LAS int*)(F.lds + XTRA_OFF + X_PB); LAS int* cn = (LAS int*)(F.lds + XTRA_OFF + X_CNT);
    const unsigned* gc = (const unsigned*)(F.ws + WS_CTL) + CW_CNT + layer * 64;
    __syncthreads();
    if (F.tid == 0) { int s = 0; for (int e = 0; e < 32; ++e) { const int c = (int)__hip_atomic_load(gc + e, __ATOMIC_RELAXED, __HIP_MEMORY_SCOPE_AGENT); cn[e] = c; pb[e] = s; s += (c + 255) >> 8; } pb[32] = s; }
    __syncthreads();
}
__device__ __forceinline__ void moe_gather_row(const Frame& F, int r, f32x4 (&f)[4]) {
    const LAS int* pb = (const LAS int*)(F.lds + XTRA_OFF + X_PB);
    const u32x2* ti = (const u32x2*)(F.ws + WS_TOKI) + (size_t)r * 4; const bf16_t* Y = (const bf16_t*)(F.ws + WS_Y);
#pragma unroll
    for (int j = 0; j < 4; ++j) f[j] = (f32x4){0.f, 0.f, 0.f, 0.f};
#pragma unroll
    for (int k = 0; k < 4; ++k) {
        const u32x2 t = ti[k]; const int e = (int)(t.x >> 20), pos = (int)(t.x & 0xfffffu); const float g = __uint_as_float(t.y);
        const size_t yrow = (size_t)pb[e] * 256 + pos;
#if Y_FP8
        const unsigned* yp = (const unsigned*)((const unsigned char*)Y + yrow * DM) + F.lane; const float g16 = g * (1.f / 16.f);
#pragma unroll
        for (int j = 0; j < 4; ++j) { const unsigned w = yp[64 * j]; const f32x2 lo = __builtin_amdgcn_cvt_pk_f32_fp8(w, false), hi2 = __builtin_amdgcn_cvt_pk_f32_fp8(w, true);
            f[j].x += g16 * lo.x; f[j].y += g16 * lo.y; f[j].z += g16 * hi2.x; f[j].w += g16 * hi2.y; }
#else
        const u32x2* yp = (const u32x2*)(Y + yrow * DM) + F.lane;
#pragma unroll
        for (int j = 0; j < 4; ++j) { const u32x2 w = yp[64 * j]; f[j].x += g * bflo(w.x); f[j].y += g * bfhi(w.x); f[j].z += g * bflo(w.y); f[j].w += g * bfhi(w.y); }
#endif
    }
}
__device__ __forceinline__ void p_combine_norm(Frame& F, int dry) {
    moe_prefix(F, 0);
    const float* MOD = (const float*)(F.ws + WS_MOD); bf16_t* H = (bf16_t*)(F.ws + (dry ? WS_SCR + 288 * MiB : WS_H)); bf16_t* XR = (bf16_t*)(F.ws + WS_XR); bf16_t* XW = dry ? (bf16_t*)(F.ws + WS_SCR) : XR;
    const int gw = F.bid * 8 + F.wave, NGW = F.G * 8;
    for (int r = gw; r < NTOK; r += NGW) {
        const int b = r / TPB, pos = r - b * TPB, mj = pos < CTXL ? 32 : b;
        f32x4 f[4]; moe_gather_row(F, r, f);
        const u32x2* xr = (const u32x2*)(XR + (size_t)r * DM) + F.lane; u32x2* xw = (u32x2*)(XW + (size_t)r * DM) + F.lane; const f32x4* g2 = (const f32x4*)(MOD + ((size_t)(0 * 33 + mj) * 6 + 5) * 1024) + F.lane;
        f32x4 v[4]; float ss = 0.f;
#pragma unroll
        for (int j = 0; j < 4; ++j) { v[j] = bf4(xr[64 * j]) + g2[64 * j] * f[j]; xw[64 * j] = pk4bf(v[j]); ss += (v[j].x * v[j].x + v[j].y * v[j].y) + (v[j].z * v[j].z + v[j].w * v[j].w); }
        const float rstd = rsqrtf(wave_sum(ss) * (1.f / DM) + EPS);
        const f32x4* sh = (const f32x4*)(MOD + ((size_t)(1 * 33 + mj) * 6 + 0) * 1024) + F.lane; const f32x4* A = (const f32x4*)(MOD + ((size_t)(1 * 33 + mj) * 6 + 1) * 1024) + F.lane;
        f32x4 h[4];
#pragma unroll
        for (int j = 0; j < 4; ++j) h[j] = v[j] * rstd * A[64 * j] + sh[64 * j];
        if constexpr (PROJ1_FP8 != 0) { unsigned* o4 = (unsigned*)((unsigned char*)H + (size_t)r * DM) + F.lane;
#pragma unroll
            for (int j = 0; j < 4; ++j) o4[64 * j] = pk4_fp8(h[j].x * 4.f, h[j].y * 4.f, h[j].z * 4.f, h[j].w * 4.f); }
        else store_h_row(H + (size_t)r * DM, F.lane, h);
    }
}
__device__ __forceinline__ void p_final(Frame& F) {
    moe_prefix(F, 1);
    const float* MOD = (const float*)(F.ws + WS_MOD); const bf16_t* XR = (const bf16_t*)(F.ws + WS_XR);
    const int gw = F.bid * 8 + F.wave, NGW = F.G * 8; const float* pfg = INP(I_FNG);
    for (int q = gw; q < NBATCH * SEQ; q += NGW) {
        const int b = q >> 11, t = q & 2047, r = b * TPB + CTXL + t;
        f32x4 f[4]; moe_gather_row(F, r, f);
        const u32x2* xr = (const u32x2*)(XR + (size_t)r * DM) + F.lane; const f32x4* g2 = (const f32x4*)(MOD + ((size_t)(1 * 33 + b) * 6 + 5) * 1024) + F.lane;
        f32x4 v[4]; float ss = 0.f;
#pragma unroll
        for (int j = 0; j < 4; ++j) { v[j] = bf4(xr[64 * j]) + g2[64 * j] * f[j]; ss += (v[j].x * v[j].x + v[j].y * v[j].y) + (v[j].z * v[j].z + v[j].w * v[j].w); }
        const float rstd = rsqrtf(wave_sum(ss) * (1.f / DM) + EPS);
        const f32x4* fg = (const f32x4*)pfg + F.lane; f32x4* op = (f32x4*)(F.out + (size_t)q * DM) + F.lane;
#pragma unroll
        for (int j = 0; j < 4; ++j) op[64 * j] = v[j] * rstd * fg[64 * j];
    }
}
__device__ __forceinline__ void top4_of16(float (&v)[16], int hi, float (&tv)[4], int (&te)[4]) {
#pragma unroll
    for (int k = 0; k < 4; ++k) { float best = v[0]; int bi = 0;
#pragma unroll
        for (int r = 1; r < 16; ++r) { const bool bt = v[r] > best; best = bt ? v[r] : best; bi = bt ? r : bi; }
        tv[k] = best; te[k] = (bi & 3) + 8 * (bi >> 2) + 4 * hi;
#pragma unroll
        for (int r = 0; r < 16; ++r) v[r] = (r == bi) ? -3.0e38f : v[r]; }
}
template <int LAYER> __device__ __forceinline__ void p_norm_router(Frame& F, int dry) {
    const float* MOD = (const float*)(F.ws + WS_MOD); bf16_t* H = (bf16_t*)(F.ws + WS_H); const bf16_t* XR = (const bf16_t*)(F.ws + WS_XR);
    LAS f32x4* WL4 = (LAS f32x4*)F.lds;
    LAS int* hist = (LAS int*)(F.lds + XTRA_OFF + X_HIST); LAS int* base = (LAS int*)(F.lds + XTRA_OFF + X_BASE); LAS u32x2* sel = (LAS u32x2*)(F.lds + XTRA_OFF + X_SEL);
    LAS f32x4* A2L4 = (LAS f32x4*)(F.lds + XTRA_OFF + X_A2); LAS float* CBL = (LAS float*)(F.lds + XTRA_OFF + X_CB); LAS float* RSL = (LAS float*)(F.lds + XTRA_OFF + X_RS);
    unsigned* gcnt = (unsigned*)(F.ws + WS_CTL) + CW_CNT + LAYER * 64 + (dry ? 128 : 0);
    int* rowl = (int*)(F.ws + WS_ROWL); u32x2* toki = (u32x2*)(F.ws + WS_TOKI);
    const f32x4* wsrc = (const f32x4*)(F.ws + WS_WRT + (size_t)LAYER * 32 * 1024 * 4);
    __syncthreads();
    for (int u = F.tid; u < 8192; u += 512) { const int e = u >> 8, k4 = u & 255; WL4[e * 256 + (k4 ^ (e & 15))] = wsrc[u]; }
    if (F.tid < 32) hist[F.tid] = 0;
    const int lane = F.lane, r32 = lane & 31, hi = lane >> 5; const float* prb = INP(I_RB);
    constexpr int NP = LAYER == 0 ? NPAN : 256;
    for (int pi = F.bid; pi < NP; pi += F.G) {
        const int pan = LAYER == 0 ? pi : pi + pi / 8 + 1;
        const int b = pan / 9, mj = (pan % 9 == 0) ? 32 : b;
        const f32x4* shp = (const f32x4*)(MOD + ((size_t)(LAYER * 33 + mj) * 6 + 3) * 1024); const f32x4* Ap = (const f32x4*)(MOD + ((size_t)(LAYER * 33 + mj) * 6 + 4) * 1024);
        __syncthreads();
        if (F.tid < 256) A2L4[F.tid] = Ap[F.tid];
        {
            const int e = F.tid >> 4, part = F.tid & 15; float sum = 0.f;
#pragma unroll 4
            for (int q = 0; q < 16; ++q) { const f32x4 a = shp[part * 16 + q], w = wsrc[e * 256 + part * 16 + q]; sum += (a.x * w.x + a.y * w.y) + (a.z * w.z + a.w * w.w); }
            sum += xf1(sum); sum += xf2(sum); sum += xf4(sum); sum += xf8(sum);
            if (part == 0) CBL[e] = sum + prb[LAYER * 32 + e];
        }
        __syncthreads();
        const int row = pan * 256 + F.wave * 32 + r32;
        const u32x2* xp = (const u32x2*)(XR + (size_t)row * DM) + hi;
        const LAS f32x4* wrow = WL4 + r32 * 256; const int swz = r32 & 15;
        f32x16 acc = {}; float ssq = 0.f;
#define RT_LOAD(dst, mb) do { _Pragma("unroll") for (int u = 0; u < 8; ++u) dst[u] = xp[2 * ((mb) + u)]; } while (0)
#define RT_COMP(src, mb) do { _Pragma("unroll") for (int u = 0; u < 8; ++u) { const int k4 = 2 * ((mb) + u) + hi; const f32x4 a4 = A2L4[k4], w4 = wrow[k4 ^ swz]; const f32x4 x = bf4(src[u]); \
                ssq += (x.x * x.x + x.y * x.y) + (x.z * x.z + x.w * x.w); \
                acc = __builtin_amdgcn_mfma_f32_32x32x2f32(w4.x, x.x * a4.x, acc, 0, 0, 0); acc = __builtin_amdgcn_mfma_f32_32x32x2f32(w4.y, x.y * a4.y, acc, 0, 0, 0); \
                acc = __builtin_amdgcn_mfma_f32_32x32x2f32(w4.z, x.z * a4.z, acc, 0, 0, 0); acc = __builtin_amdgcn_mfma_f32_32x32x2f32(w4.w, x.w * a4.w, acc, 0, 0, 0); } } while (0)
        u32x2 xa[8], xb[8];
        RT_LOAD(xa, 0);
#pragma unroll 1
        for (int m0 = 0; m0 < 128; m0 += 16) {
            RT_LOAD(xb, m0 + 8); SBAR();
            RT_COMP(xa, m0); SBAR();
            if (m0 + 16 < 128) RT_LOAD(xa, m0 + 16);
            SBAR(); RT_COMP(xb, m0 + 8); SBAR();
        }
#undef RT_LOAD
#undef RT_COMP
        const float rstd = rsqrtf(sum32(ssq, ssq) * (1.f / DM) + EPS);
        float lg[16];
#pragma unroll
        for (int r = 0; r < 16; ++r) lg[r] = acc[r] * rstd + CBL[(r & 3) + 8 * (r >> 2) + 4 * hi];
        float tv[4], pv[4]; int te[4], pe[4];
        top4_of16(lg, hi, tv, te);
#pragma unroll
        for (int k = 0; k < 4; ++k) { pv[k] = __uint_as_float(xu32(__float_as_uint(tv[k]), lane)); pe[k] = (int)xu32((unsigned)te[k], lane); }
        float cv[8] = {tv[0], tv[1], tv[2], tv[3], pv[0], pv[1], pv[2], pv[3]}; int ce[8] = {te[0], te[1], te[2], te[3], pe[0], pe[1], pe[2], pe[3]};
        float gv[4]; int ge[4];
#pragma unroll
        for (int k = 0; k < 4; ++k) { float best = cv[0]; int be = ce[0];
#pragma unroll
            for (int c = 1; c < 8; ++c) { const bool bt = cv[c] > best || (cv[c] == best && ce[c] < be); best = bt ? cv[c] : best; be = bt ? ce[c] : be; }
            gv[k] = best; ge[k] = be;
#pragma unroll
            for (int c = 0; c < 8; ++c) cv[c] = (ce[c] == be) ? -3.0e38f : cv[c]; }
        const float x1 = __expf(gv[1] - gv[0]), x2 = __expf(gv[2] - gv[0]), x3 = __expf(gv[3] - gv[0]); const float inv = 1.f / (1.f + x1 + x2 + x3);
        {
            const int ea = hi ? ge[2] : ge[0], eb = hi ? ge[3] : ge[1]; const float ga = hi ? x2 * inv : inv, gb = hi ? x3 * inv : x1 * inv;
            const int ra = __hip_atomic_fetch_add(hist + ea, 1, __ATOMIC_RELAXED, __HIP_MEMORY_SCOPE_WORKGROUP), rb2 = __hip_atomic_fetch_add(hist + eb, 1, __ATOMIC_RELAXED, __HIP_MEMORY_SCOPE_WORKGROUP);
            const int rl = F.wave * 32 + r32;
            sel[rl * 4 + 2 * hi] = (u32x2){(unsigned)ea | ((unsigned)ra << 8), __float_as_uint(ga)}; sel[rl * 4 + 2 * hi + 1] = (u32x2){(unsigned)eb | ((unsigned)rb2 << 8), __float_as_uint(gb)};
            if (hi == 0) RSL[rl] = rstd;
        }
        {
            f32x4 Ar[4], Sr[4];
#pragma unroll
            for (int j = 0; j < 4; ++j) { Ar[j] = Ap[lane + 64 * j]; Sr[j] = shp[lane + 64 * j]; }
            for (int rr = 0; rr < 32; rr += 4) {
                const int rw = pan * 256 + F.wave * 32 + rr; f32x4 v[4][4];
#pragma unroll
                for (int t = 0; t < 4; ++t) { const u32x2* xr = (const u32x2*)(XR + (size_t)(rw + t) * DM) + lane;
#pragma unroll
                    for (int j = 0; j < 4; ++j) v[t][j] = bf4(xr[64 * j]); }
#pragma unroll
                for (int t = 0; t < 4; ++t) { const float rs = RSL[F.wave * 32 + rr + t]; f32x4 h[4];
#pragma unroll
                    for (int j = 0; j < 4; ++j) h[j] = v[t][j] * rs * Ar[j] + Sr[j];
                    if constexpr (MOE_FP8 != 0) { unsigned* o4 = (unsigned*)((unsigned char*)H + (size_t)(rw + t) * DM) + lane;
#pragma unroll
                        for (int j = 0; j < 4; ++j) o4[64 * j] = pk4_fp8(h[j].x * 4.f, h[j].y * 4.f, h[j].z * 4.f, h[j].w * 4.f); }
                    else store_h_row(H + (size_t)(rw + t) * DM, lane, h); }
            }
        }
        __syncthreads();
        if (F.tid < 32) { const int c = hist[F.tid]; base[F.tid] = c ? (int)__hip_atomic_fetch_add(gcnt + F.tid, (unsigned)c, __ATOMIC_RELAXED, __HIP_MEMORY_SCOPE_AGENT) : 0; }
        __syncthreads();
        for (int u = F.tid; u < 1024; u += 512) { const u32x2 sv = sel[u]; const int e = (int)(sv.x & 0xffu), pos = base[e] + (int)(sv.x >> 8), r = pan * 256 + (u >> 2);
            rowl[(size_t)e * ROWCAP + pos] = r; toki[(size_t)r * 4 + (u & 3)] = (u32x2){((unsigned)e << 20) | (unsigned)pos, sv.y}; }
        __syncthreads();
        if (F.tid < 32) hist[F.tid] = 0;
    }
    __syncthreads();
}

__device__ __forceinline__ void p_moe_gather(Frame& F, int layer) {
    moe_prefix(F, layer);
    const LAS int* pb = (const LAS int*)(F.lds + XTRA_OFF + X_PB); const LAS int* cn = (const LAS int*)(F.lds + XTRA_OFF + X_CNT);
    const unsigned char* H8 = (const unsigned char*)(F.ws + WS_H); unsigned char* XS = (unsigned char*)(F.ws + WS_XS); const int* rowl = (const int*)(F.ws + WS_ROWL);
    const int nblk = pb[32];
    for (int blk = F.bid; blk < nblk; blk += F.G) {
        int e = 0;
#pragma unroll
        for (int st = 16; st >= 1; st >>= 1) { if (pb[e + st] <= blk) e += st; }
        const int rb = blk - pb[e], n = cn[e] - rb * 256;
        const int* rl = rowl + (size_t)e * ROWCAP + rb * 256 + F.wave * 32;
#pragma unroll 1
        for (int r0 = 0; r0 < 32; r0 += 8) {
            u32x4 v[8]; int tok[8];
#pragma unroll
            for (int q = 0; q < 8; ++q) { const int ri = F.wave * 32 + r0 + q; tok[q] = ri < n ? rl[r0 + q] : -1; }
#pragma unroll
            for (int q = 0; q < 8; ++q) if (tok[q] >= 0) v[q] = *(const u32x4*)(H8 + (size_t)tok[q] * 1024 + F.lane * 16);
#pragma unroll
            for (int q = 0; q < 8; ++q) if (tok[q] >= 0) *(u32x4*)(XS + ((size_t)blk * 256 + F.wave * 32 + r0 + q) * 1024 + F.lane * 16) = v[q];
        }
    }
}

__device__ __forceinline__ void p_qk_prep(Frame& F) {
    bf16_t* P = (bf16_t*)(F.ws + WS_PBUF); const f32x2* tab = (const f32x2*)(F.ws + WS_TABG);
    const int lane = F.lane, sub = lane >> 4, a = lane & 15, gw = F.bid * 8 + F.wave, NGW = F.G * 8;
    const float* pq = INP(I_GQG); const float* pk = INP(I_GKG);
    float gq[8], gk[8], gqp[8], gkp[8];
#pragma unroll
    for (int j = 0; j < 8; ++j) { gq[j] = pq[8 * a + j]; gk[j] = pk[8 * a + j]; gqp[j] = pq[8 * (a ^ 4) + j]; gkp[j] = pk[8 * (a ^ 4) + j]; }
    const bool isx2 = (a & 4) != 0; const int fi = 8 * (a & 3);
    for (int rp = gw; rp < NTOK / 2; rp += NGW) {
#pragma unroll
        for (int g = 0; g < 3; ++g) {
            const int it = g * 4 + sub, hi6 = it >= 6 ? 1 : 0, r = rp * 2 + hi6, s = it - 6 * hi6;
            const int b = r / TPB, pos = r - b * TPB; const bool lat = pos >= CTXL; const int t = pos - CTXL;
            bf16_t* ptr = P + (size_t)r * 2048 + 1024 + s * 128 + 8 * a;
            const u32x4 w = *(const u32x4*)ptr; u32x4 wp;
#pragma unroll
            for (int q = 0; q < 4; ++q) wp[q] = (unsigned)__shfl_xor((int)w[q], 4);
            float x[8], xp[8];
#pragma unroll
            for (int q = 0; q < 4; ++q) { x[2 * q] = bflo(w[q]); x[2 * q + 1] = bfhi(w[q]); xp[2 * q] = bflo(wp[q]); xp[2 * q + 1] = bfhi(wp[q]); }
            float ss = 0.f;
#pragma unroll
            for (int j = 0; j < 8; ++j) ss += x[j] * x[j];
            ss += __shfl_xor(ss, 1); ss += __shfl_xor(ss, 2); ss += __shfl_xor(ss, 4); ss += __shfl_xor(ss, 8);
            const float rstd = rsqrtf(ss * (1.f / 128.f) + EPS); const bool isq = s < 4;
            float o[8];
#pragma unroll
            for (int j = 0; j < 8; ++j) { o[j] = x[j] * rstd * (isq ? gq[j] : gk[j]); xp[j] = xp[j] * rstd * (isq ? gqp[j] : gkp[j]); }
            if (lat) {
                const int pp = (a & 8) ? (t & 63) : (t >> 6); const f32x4* tp = (const f32x4*)(tab + pp * 32 + fi);
#pragma unroll
                for (int q = 0; q < 4; ++q) { const f32x4 cs = tp[q];
                    const float s0 = isx2 ? cs.y : -cs.y, s1 = isx2 ? cs.w : -cs.w;
                    o[2 * q] = o[2 * q] * cs.x + xp[2 * q] * s0; o[2 * q + 1] = o[2 * q + 1] * cs.z + xp[2 * q + 1] * s1; }
            }
            u32x4 wo; wo.x = cvtpk(o[0], o[1]); wo.y = cvtpk(o[2], o[3]); wo.z = cvtpk(o[4], o[5]); wo.w = cvtpk(o[6], o[7]);
            *(u32x4*)ptr = wo;
        }
    }
}
__device__ __forceinline__ void p_mla_prep(Frame& F) {
    bf16_t* P = (bf16_t*)(F.ws + WS_PBUF); bf16_t* KR = (bf16_t*)(F.ws + WS_KRB); const f32x2* tab = (const f32x2*)(F.ws + WS_TABM);
    const int gw = F.bid * 8 + F.wave, NGW = F.G * 8, lane = F.lane;
    const float* pqg = INP(I_MLAQG); const float* pkg = INP(I_MLAKVG);
    float qg[8], kg[4];
#pragma unroll
    for (int j = 0; j < 8; ++j) qg[j] = pqg[8 * lane + j];
#pragma unroll
    for (int j = 0; j < 4; ++j) kg[j] = pkg[4 * lane + j];
    const int krow = (lane >> 3) & 3, ka = lane & 7; const bool kx2 = (ka & 2) != 0; const int kfi = 8 * (ka & 1);
    for (int r0 = gw * 4; r0 < NTOK; r0 += NGW * 4) {
        const int b = r0 / TPB, pos0 = r0 - b * TPB; const bool lat = pos0 >= CTXL;
        u32x4 wq[4]; u32x2 wk[4];
#pragma unroll
        for (int rr = 0; rr < 4; ++rr) { const bf16_t* base = P + (size_t)(r0 + rr) * 1024; wk[rr] = *(const u32x2*)(base + 512 + 4 * lane); if (lat) wq[rr] = *(const u32x4*)(base + 8 * lane); }
        u32x4 wr = (u32x4){0u, 0u, 0u, 0u};
        if (lane < 32) wr = *(const u32x4*)(P + (size_t)(r0 + krow) * 1024 + 768 + 8 * ka);
        if (lat) {
#pragma unroll
            for (int rr = 0; rr < 4; ++rr) { float x[8];
#pragma unroll
                for (int q = 0; q < 4; ++q) { x[2 * q] = bflo(wq[rr][q]); x[2 * q + 1] = bfhi(wq[rr][q]); }
                float ss = 0.f;
#pragma unroll
                for (int j = 0; j < 8; ++j) ss += x[j] * x[j];
                const float rstd = rsqrtf(wave_sum(ss) * (1.f / 512.f) + EPS);
                if constexpr (UPQ_FP8 != 0) { const float s4 = rstd * 4.f; u32x2 w8; w8.x = pk4_fp8(x[0] * s4 * qg[0], x[1] * s4 * qg[1], x[2] * s4 * qg[2], x[3] * s4 * qg[3]); w8.y = pk4_fp8(x[4] * s4 * qg[4], x[5] * s4 * qg[5], x[6] * s4 * qg[6], x[7] * s4 * qg[7]);
                    *(u32x2*)((unsigned char*)(F.ws + WS_CQ8) + (size_t)(r0 + rr) * 512 + 8 * lane) = w8; }
                else { u32x4 w;
#pragma unroll
                    for (int q = 0; q < 4; ++q) w[q] = cvtpk(x[2 * q] * rstd * qg[2 * q], x[2 * q + 1] * rstd * qg[2 * q + 1]);
                    *(u32x4*)(P + (size_t)(r0 + rr) * 1024 + 8 * lane) = w; } }
        }
#pragma unroll
        for (int rr = 0; rr < 4; ++rr) { const float x0 = bflo(wk[rr].x), x1 = bfhi(wk[rr].x), x2 = bflo(wk[rr].y), x3 = bfhi(wk[rr].y);
            const float rstd = rsqrtf(wave_sum((x0 * x0 + x1 * x1) + (x2 * x2 + x3 * x3)) * (1.f / 256.f) + EPS);
            if constexpr (UPKV_FP8 != 0) { const float s4 = rstd * 4.f; *(unsigned*)((unsigned char*)(F.ws + WS_CKV8) + (size_t)(r0 + rr) * 256 + 4 * lane) = pk4_fp8(x0 * s4 * kg[0], x1 * s4 * kg[1], x2 * s4 * kg[2], x3 * s4 * kg[3]); }
            else { u32x2 w; w.x = cvtpk(x0 * rstd * kg[0], x1 * rstd * kg[1]); w.y = cvtpk(x2 * rstd * kg[2], x3 * rstd * kg[3]);
                *(u32x2*)(P + (size_t)(r0 + rr) * 1024 + 512 + 4 * lane) = w; } }
        {
            u32x4 wp;
#pragma unroll
            for (int q = 0; q < 4; ++q) wp[q] = (unsigned)__shfl_xor((int)wr[q], 2);
            float o[8], xp[8];
#pragma unroll
            for (int q = 0; q < 4; ++q) { o[2 * q] = bflo(wr[q]); o[2 * q + 1] = bfhi(wr[q]); xp[2 * q] = bflo(wp[q]); xp[2 * q + 1] = bfhi(wp[q]); }
            if (lat) { const int t = pos0 + krow - CTXL, pp = (ka & 4) ? (t & 63) : (t >> 6); const f32x4* tp = (const f32x4*)(tab + pp * 16 + kfi);
#pragma unroll
                for (int q = 0; q < 4; ++q) { const f32x4 cs = tp[q]; const float s0 = kx2 ? cs.y : -cs.y, s1 = kx2 ? cs.w : -cs.w;
                    o[2 * q] = o[2 * q] * cs.x + xp[2 * q] * s0; o[2 * q + 1] = o[2 * q + 1] * cs.z + xp[2 * q + 1] * s1; } }
            u32x4 wo; wo.x = cvtpk(o[0], o[1]); wo.y = cvtpk(o[2], o[3]); wo.z = cvtpk(o[4], o[5]); wo.w = cvtpk(o[6], o[7]);
            if (lane < 32) *(u32x4*)(KR + (size_t)(r0 + krow) * 64 + 8 * ka) = wo;
        }
    }
}
__device__ __forceinline__ void p_sgu(Frame& F) {
    const bf16_t* P = (const bf16_t*)(F.ws + WS_PBUF); bf16_t* MIX = (bf16_t*)(F.ws + WS_MIX0); const bf16_t* SW = (const bf16_t*)(F.ws + WS_SGUW);
    const int tid = F.tid, lane = F.lane, wid = F.wave, hw = wid >> 2, w4 = wid & 3, th = tid & 255, r32 = lane & 31, hi = lane >> 5;
    LAS char* Vl = (LAS char*)F.lds + hw * 32768;
    const int sr = th >> 4, sc = (th & 15) * 8;
    const int vb0 = (int)(unsigned)(uintptr_t)Vl + att::v_rd_base(lane);
    const float* psg = INP(I_SGUNG); const float* psb = INP(I_SGUB);
    for (int U = F.bid; U < (NTOK / 128) * 2; U += F.G) {
        const int chunk = U >> 1, g = (U & 1) * 2 + hw; const size_t row0 = (size_t)chunk * 128;
        float gn[8];
#pragma unroll
        for (int j = 0; j < 8; ++j) gn[j] = psg[g * 128 + sc + j];
        __syncthreads();
#pragma unroll
        for (int i = 0; i < 8; ++i) {
            const int q = sr + 16 * i;
            u32x4 w = *(const u32x4*)(P + (row0 + q) * 2048 + 512 + g * 128 + sc); float x[8];
#pragma unroll
            for (int k = 0; k < 4; ++k) { x[2 * k] = bflo(w[k]); x[2 * k + 1] = bfhi(w[k]); }
            float ss = 0.f;
#pragma unroll
            for (int j = 0; j < 8; ++j) ss += x[j] * x[j];
            ss += __shfl_xor(ss, 1); ss += __shfl_xor(ss, 2); ss += __shfl_xor(ss, 4); ss += __shfl_xor(ss, 8);
            const float rstd = rsqrtf(ss * (1.f / 128.f) + EPS);
#pragma unroll
            for (int k = 0; k < 4; ++k) w[k] = cvtpk(x[2 * k] * rstd * gn[2 * k], x[2 * k + 1] * rstd * gn[2 * k + 1]);
            *(LAS u32x4*)(Vl + (q >> 6) * 16384 + att::v_st(q & 63, sc)) = w;
        }
        bf16x8 pa[8];
        const bf16_t* wrow = SW + ((size_t)g * 128 + 32 * w4 + r32) * 128 + 8 * hi;
#pragma unroll
        for (int k = 0; k < 8; ++k) pa[k] = *(const bf16x8*)(wrow + 16 * k);
        __syncthreads();
        f32x16 o[4] = {};
        att::pv_d0(o, vb0, pa[0], pa[1], pa[2], pa[3]);
        att::pv_d0(o, vb0 + 16384, pa[4], pa[5], pa[6], pa[7]);
#pragma unroll
        for (int r = 0; r < 16; ++r) { const int p = 32 * w4 + att::crow(r, hi); const float bs = psb[g * 128 + p];
#pragma unroll
            for (int d0 = 0; d0 < 4; ++d0) { const int c = d0 * 32 + r32; const float zu = bf2f(P[(row0 + p) * 2048 + g * 128 + c]);
                MIX[(row0 + p) * 1024 + g * 128 + c] = f2bf((o[d0][r] + bs) * zu); } }
    }
    __syncthreads();
}

using pg8::Unit; using pg8::Acc;
struct ProbIn0 {
    static constexpr bool PERM = true, GATHER = false, FP8 = PROJ0_FP8 != 0; int K, lda; const bf16_t* A; const bf16_t* Bt; bf16_t* O; pg8::StaticOrder so; int G, c;
    __device__ bool next(int i, Unit& u) const { return so.map((long)i * G + c, u.pm, u.pn); }
    __device__ const void* a_mat() const { return A; } __device__ const void* b_mat() const { return Bt; }
    __device__ unsigned a_off(const Unit& u) const { return (unsigned)u.pm * 256u * (unsigned)lda * 2u; }
    __device__ unsigned b_off(const Unit& u) const { return (unsigned)u.pn * 256u * (unsigned)K * 2u; }
    __device__ void a_voff(const Unit&, unsigned (&)[2][2]) const {}
    __device__ void epi(const Acc& acc, const Unit& u, int wr, int wc, int fr, int fq) const {
        bf16_t* dst = O + (size_t)u.pm * 256 * 2048 + u.pn * 256;
        if (u.pn < 4) pg8::epi_store_bf16<true>(acc, dst, 2048, nullptr, wr, wc, fr, fq, FP8 ? (1.f / 256.f) : 1.f); else pg8::epi_store_bf16<false>(acc, dst, 2048, nullptr, wr, wc, fr, fq, FP8 ? (1.f / 256.f) : 1.f);
    }
};
template <bool LATONLY, bool FP8v = false> struct ProbPlain {
    static constexpr bool PERM = true, GATHER = false, FP8 = FP8v; int K, lda; const bf16_t* A; const bf16_t* Bt; bf16_t* O; int ldc; pg8::StaticOrder so; int G, c;
    __device__ bool next(int i, Unit& u) const { int pm; if (!so.map((long)i * G + c, pm, u.pn)) return false; u.pm = LATONLY ? pm + pm / 8 + 1 : pm; return true; }
    __device__ const void* a_mat() const { return A; } __device__ const void* b_mat() const { return Bt; }
    __device__ unsigned a_off(const Unit& u) const { return (unsigned)u.pm * 256u * (unsigned)lda * 2u; }
    __device__ unsigned b_off(const Unit& u) const { return (unsigned)u.pn * 256u * (unsigned)K * 2u; }
    __device__ void a_voff(const Unit&, unsigned (&)[2][2]) const {}
    __device__ void epi(const Acc& acc, const Unit& u, int wr, int wc, int fr, int fq) const {
        pg8::epi_store_bf16<false>(acc, O + (size_t)u.pm * 256 * ldc + u.pn * 256, ldc, nullptr, wr, wc, fr, fq, FP8 ? (1.f / 256.f) : 1.f);
    }
};
struct ProbIn1 {
    static constexpr bool PERM = true, GATHER = false, FP8 = PROJ1_FP8 != 0; int K, lda; const bf16_t* A; const bf16_t* Bt; bf16_t* O; pg8::StaticOrder so; int G, c;
    __device__ bool next(int i, Unit& u) const {
        const long L = (long)i * G + c;
        if (L < 1024) { int pm; so.map(L, pm, u.pn); u.pm = pm + pm / 8 + 1; return true; }
        if (L < 1024 + 64) { const int q = (int)(L - 1024); u.pm = (q >> 1) * 9; u.pn = 2 + (q & 1); return true; }
        return false;
    }
    __device__ const void* a_mat() const { return A; } __device__ const void* b_mat() const { return Bt; }
    __device__ unsigned a_off(const Unit& u) const { return (unsigned)u.pm * 256u * (unsigned)lda * 2u; }
    __device__ unsigned b_off(const Unit& u) const { return (unsigned)u.pn * 256u * (unsigned)K * 2u; }
    __device__ void a_voff(const Unit&, unsigned (&)[2][2]) const {}
    __device__ void epi(const Acc& acc, const Unit& u, int wr, int wc, int fr, int fq) const {
        pg8::epi_store_bf16<false>(acc, O + (size_t)u.pm * 256 * 1024 + u.pn * 256, 1024, nullptr, wr, wc, fr, fq, FP8 ? (1.f / 256.f) : 1.f);
    }
};
template <int LAYER> struct ProbOut {
    static constexpr bool PERM = true, GATHER = false, FP8 = LAYER == 1 && OUT1_FP8 != 0; int K, lda; const bf16_t* A; const bf16_t* Bt; bf16_t* XR; const float* MOD; const float* xin; const float* cin; pg8::StaticOrder so; int G, c;
    __device__ __forceinline__ bool next(int i, Unit& u) const { int pm; if (!so.map((long)i * G + c, pm, u.pn)) return false; u.pm = LAYER ? pm + pm / 8 + 1 : pm; return true; }
    __device__ __forceinline__ const void* a_mat() const { return A; } __device__ __forceinline__ const void* b_mat() const { return Bt; }
    __device__ __forceinline__ unsigned a_off(const Unit& u) const { return (unsigned)u.pm * 256u * (unsigned)lda * 2u; }
    __device__ __forceinline__ unsigned b_off(const Unit& u) const { return (unsigned)u.pn * 256u * (unsigned)K * 2u; }
    __device__ __forceinline__ void a_voff(const Unit&, unsigned (&)[2][2]) const {}
    __device__ __forceinline__ void epi(const Acc& acc, const Unit& u, int wr, int wc, int fr, int fq) const {
        const int b = u.pm / 9, jj = u.pm % 9, mj = jj == 0 ? 32 : b;
        const float* basef = jj == 0 ? cin + (size_t)b * CTXL * DM : xin + ((size_t)b * SEQ + (jj - 1) * 256) * DM;
        bf16_t* dst = XR + (size_t)u.pm * 256 * DM; const float* gate = MOD + ((size_t)(LAYER * 33 + mj) * 6 + 2) * 1024;
        const int row0 = wr * 64 + fr, col0 = u.pn * 256 + wc * 32 + 8 * fq;
        f32x4 gv[2][2];
#pragma unroll
        for (int bj = 0; bj < 2; ++bj)
#pragma unroll
            for (int n = 0; n < 2; ++n) gv[bj][n] = *(const f32x4*)(gate + col0 + bj * 128 + 4 * n);
#pragma unroll
        for (int ai = 0; ai < 2; ++ai)
#pragma unroll
            for (int m = 0; m < 4; ++m) { const size_t uo = (size_t)(ai * 128 + m * 16) * DM; const unsigned lo = (unsigned)(row0 * DM + col0);
#pragma unroll
                for (int bj = 0; bj < 2; ++bj) { f32x4 b0, b1;
                    if constexpr (LAYER == 0) { const char* bp = (const char*)(basef + uo) + (size_t)(lo + bj * 128) * 4u; b0 = *(const f32x4*)bp; b1 = *(const f32x4*)(bp + 16); }
                    else { const u32x4 w = *(const u32x4*)((const char*)(dst + uo) + (lo + bj * 128) * 2u); b0 = (f32x4){bflo(w.x), bfhi(w.x), bflo(w.y), bfhi(w.y)}; b1 = (f32x4){bflo(w.z), bfhi(w.z), bflo(w.w), bfhi(w.w)}; }
                    constexpr float SC = FP8 ? (1.f / 1024.f) : 1.f;
                    const f32x4 v0 = b0 + gv[bj][0] * (acc[ai][bj][m][0] * SC), v1 = b1 + gv[bj][1] * (acc[ai][bj][m][1] * SC);
                    u32x4 wo; wo.x = cvtpk(v0[0], v0[1]); wo.y = cvtpk(v0[2], v0[3]); wo.z = cvtpk(v1[0], v1[1]); wo.w = cvtpk(v1[2], v1[3]);
                    *(u32x4*)((char*)(dst + uo) + (lo + bj * 128) * 2u) = wo; } }
    }
};
struct MoeSched {
    const LAS int* pb; int NTN, G, c;
    __device__ bool map(int i, Unit& u) const {
        const int x = c & 7, q = i * (G >> 3) + (c >> 3); const int blk = (q / NTN) * 8 + x; u.pn = q % NTN;
        if (blk >= __builtin_amdgcn_readfirstlane(pb[32])) return false;
        int lo = 0;
#pragma unroll
        for (int st = 16; st >= 1; st >>= 1) { if (__builtin_amdgcn_readfirstlane(pb[lo + st]) <= blk) lo += st; }
        u.e = lo; u.rb = blk - __builtin_amdgcn_readfirstlane(pb[lo]); u.pm = blk; return true;
    }
};
struct ProbMoe1 {
    static constexpr bool PERM = true, GATHER = !(MOE_PREGATHER && MOE_FP8), FP8 = MOE_FP8 != 0; int K, lda; const bf16_t* H; const bf16_t* W1; const float* B1; bf16_t* ACT; const int* rowl; const LAS int* cnt; MoeSched ms; int wave_s;
    __device__ bool next(int i, Unit& u) const { return ms.map(i, u); }
    __device__ const void* a_mat() const { return H; } __device__ const void* b_mat() const { return W1; }
    __device__ unsigned a_off(const Unit& u) const { return GATHER ? 0u : (unsigned)u.pm * 256u * 1024u; }
    __device__ unsigned b_off(const Unit& u) const { return ((unsigned)u.e * 2048u + (unsigned)u.pn * 256u) * 1024u * (FP8 ? 1u : 2u); }
    __device__ void a_voff(const Unit& u, unsigned (&vo)[2][2]) const {
        const int n = cnt[u.e]; const int* rl = rowl + (size_t)u.e * ROWCAP + u.rb * 256;
        const int tidg = tid_fresh(wave_s);
#pragma unroll
        for (int i = 0; i < 2; ++i) { int R, C; pg8::stage_rc(tidg * 16 + i * 8192, R, C);
#pragma unroll
            for (int h = 0; h < 2; ++h) { const int ri = h * 128 + R; const int tok = (u.rb * 256 + ri < n) ? rl[ri] : 0; vo[h][i] = (unsigned)tok * (FP8 ? 1024u : 2048u) + (unsigned)C * 2u; } }
    }
    __device__ void epi(const Acc& acc, const Unit& u, int wr, int wc, int fr, int fq) const {
        const int row0 = wr * 64 + fr, col0 = u.pn * 128 + wc * 32 + 8 * fq;
        const float* bg = B1 + (size_t)u.e * 2048 + col0; const float* bl = bg + 1024;
        f32x4 bgv[2], blv[2];
#pragma unroll
        for (int n = 0; n < 2; ++n) { bgv[n] = *(const f32x4*)(bg + 4 * n); blv[n] = *(const f32x4*)(bl + 4 * n); }
        constexpr float SC = FP8 ? (1.f / 256.f) : 1.f;
        bf16_t* dst = ACT + (size_t)u.pm * 256 * 1024; unsigned char* dst8 = (unsigned char*)ACT + (size_t)u.pm * 256 * 1024; const unsigned lane_off = (unsigned)(row0 * 1024 + col0);
#pragma unroll
        for (int ai = 0; ai < 2; ++ai)
#pragma unroll
            for (int m = 0; m < 4; ++m) { float a[8];
#pragma unroll
                for (int n = 0; n < 2; ++n) { const f32x4 g = acc[ai][0][m][n] * SC + bgv[n], l = acc[ai][1][m][n] * SC + blv[n];
#pragma unroll
                    for (int j = 0; j < 4; ++j) { const float gg = fminf(g[j], 7.f), ll = fminf(fmaxf(l[j], -7.f), 7.f);
                        a[4 * n + j] = gg * __builtin_amdgcn_rcpf(1.f + __builtin_amdgcn_exp2f(-1.702f * 1.4426950408889634f * gg)) * (ll + 1.f); } }
                if constexpr (FP8) { u32x2 w; w.x = pk4_fp8(a[0] * 8.f, a[1] * 8.f, a[2] * 8.f, a[3] * 8.f); w.y = pk4_fp8(a[4] * 8.f, a[5] * 8.f, a[6] * 8.f, a[7] * 8.f);
                    *(u32x2*)(dst8 + (size_t)((ai * 128 + m * 16) * 1024) + lane_off) = w; }
                else { u32x4 w; w.x = cvtpk(a[0], a[1]); w.y = cvtpk(a[2], a[3]); w.z = cvtpk(a[4], a[5]); w.w = cvtpk(a[6], a[7]);
                    *(u32x4*)((char*)dst + (size_t)((ai * 128 + m * 16) * 2048) + lane_off * 2u) = w; } }
    }
};
struct ProbMoe2 {
    static constexpr bool PERM = true, GATHER = false, FP8 = MOE_FP8 != 0; int K, lda; const bf16_t* ACT; const bf16_t* W2; const float* B2; bf16_t* Y; MoeSched ms;
    __device__ bool next(int i, Unit& u) const { return ms.map(i, u); }
    __device__ const void* a_mat() const { return ACT; } __device__ const void* b_mat() const { return W2; }
    __device__ unsigned a_off(const Unit& u) const { return (unsigned)u.pm * 256u * 1024u * (FP8 ? 1u : 2u); }
    __device__ unsigned b_off(const Unit& u) const { return ((unsigned)u.e * 1024u + (unsigned)u.pn * 256u) * 1024u * (FP8 ? 1u : 2u); }
    __device__ void a_voff(const Unit&, unsigned (&)[2][2]) const {}
    __device__ void epi(const Acc& acc, const Unit& u, int wr, int wc, int fr, int fq) const {
        constexpr float SC = FP8 ? (1.f / 512.f) : 1.f;
#if Y_FP8
        const int row0 = wr * 64 + fr, col0 = wc * 32 + 8 * fq; const float* bias = B2 + (size_t)u.e * 1024 + u.pn * 256 + col0;
        f32x4 bv[2][2];
#pragma unroll
        for (int bj = 0; bj < 2; ++bj)
#pragma unroll
            for (int n = 0; n < 2; ++n) bv[bj][n] = *(const f32x4*)(bias + bj * 128 + 4 * n);
        unsigned char* dst = (unsigned char*)Y + ((size_t)u.pm * 256) * 1024 + u.pn * 256; const unsigned lane_off = (unsigned)(row0 * 1024 + col0);
#pragma unroll
        for (int ai = 0; ai < 2; ++ai)
#pragma unroll
            for (int m = 0; m < 4; ++m) { unsigned char* rowb = dst + (size_t)((ai * 128 + m * 16) * 1024);
#pragma unroll
                for (int bj = 0; bj < 2; ++bj) { const f32x4 v0 = (acc[ai][bj][m][0] * SC + bv[bj][0]) * 16.f, v1 = (acc[ai][bj][m][1] * SC + bv[bj][1]) * 16.f;
                    u32x2 w; w.x = pk4_fp8(v0[0], v0[1], v0[2], v0[3]); w.y = pk4_fp8(v1[0], v1[1], v1[2], v1[3]);
                    *(u32x2*)(rowb + lane_off + bj * 128) = w; } }
#else
        pg8::epi_store_bf16<false>(acc, Y + (size_t)u.pm * 256 * 1024 + u.pn * 256, 1024, B2 + (size_t)u.e * 1024 + u.pn * 256, wr, wc, fr, fq, SC);
#endif
    }
};

__global__ void __launch_bounds__(512, 2) fwd_kernel(Args args) {
    extern __shared__ __attribute__((aligned(16))) uchar lds_raw[];
    const int wave_s = __builtin_amdgcn_readfirstlane((int)threadIdx.x >> 6);
    Frame F; F.lds = (LAS uchar*)lds_raw; F.tid = tid_fresh(wave_s); F.lane = F.tid & 63; F.wave = wave_s; F.G = gridDim.x; F.bid = blockIdx.x;
    F.ws = args.ws; F.out = args.out;
    volatile LAS unsigned* MISC = (volatile LAS unsigned*)(F.lds + MISC_OFF);
    if (F.tid < 64) MISC[F.tid] = 0u;
    __syncthreads();
    unsigned* ctl = (unsigned*)(F.ws + WS_CTL);
    XcdBarrier bar; bar.bar = ctl + CW_BAR; bar.x = 0; bar.st = nullptr;
    const int lo = args.ph_lo, hi = args.ph_hi;
    bar = xcd_barrier_post(ctl + CW_BAR + (lo & 1) * XCD_BAR_WORDS, MISC + 8, F.tid == 0);
#ifndef PHMASK
#define PHMASK 0x7ffff
#endif
#define REFRAME() do { F.tid = tid_fresh(wave_s); F.lane = F.tid & 63; F.wave = wave_s; } while (0)
#define IN(k) (((PHMASK >> (k)) & 1) && lo <= (k) && (k) < hi)
#define SEAM(k) do { if (IN(k) && IN((k) + 1)) { const int t_ = tid_fresh(wave_s); xcd_barrier(bar, t_ == 0); } } while (0)
    uchar* ws = F.ws;
    bf16_t* H = (bf16_t*)(ws + WS_H); bf16_t* XR = (bf16_t*)(ws + WS_XR); const float* MOD = (const float*)(ws + WS_MOD);

    if (IN(0)) { REFRAME(); p0_prologue(F); } SEAM(0);
    if (IN(1)) { REFRAME(); p_norm0(F); } SEAM(1);
    if (IN(2)) { REFRAME(); ProbIn0 p; p.K = PROJ0_FP8 ? 512 : 1024; p.lda = p.K; p.A = H; p.Bt = (const bf16_t*)(ws + WS_WIN0); p.O = (bf16_t*)(ws + WS_PBUF); p.so.init(NPAN, 8); p.G = F.G; p.c = F.bid; pg8::gemm_phase(F.lds, p, wave_s); } SEAM(2);
    if (IN(3)) { REFRAME(); p_qk_prep(F); } SEAM(3);
    if (IN(4)) { REFRAME();
        const bf16_t* P = (const bf16_t*)(ws + WS_PBUF); bf16_t* MIX = (bf16_t*)(ws + WS_MIX0);
        for (int u = F.bid; u < 1024 + 128; u += F.G) {
            if (u < 1024) { const int qb = u & 7, g = (u >> 3) & 1, kvh = (u >> 4) & 1, b = u >> 5, h = kvh * 2 + g; const size_t kr0 = (size_t)b * TPB, qr0 = kr0 + CTXL + qb * 256;
                att::attn_unit<128, 2, false, 2048, 2048, 1024>(P + qr0 * 2048 + 1024 + h * 128, P + kr0 * 2048 + 1536 + kvh * 128, nullptr, P + kr0 * 2048 + 1792 + kvh * 128, MIX + qr0 * 1024 + 512 + h * 128, TPB, (LAS char*)F.lds, nullptr, 0, wave_s);
            } else { const int v = u - 1024, h = v & 3, b = v >> 2, kvh = h >> 1; const size_t kr0 = (size_t)b * TPB;
                att::attn_unit<128, 2, false, 2048, 2048, 1024>(P + kr0 * 2048 + 1024 + h * 128, P + kr0 * 2048 + 1536 + kvh * 128, nullptr, P + kr0 * 2048 + 1792 + kvh * 128, MIX + kr0 * 1024 + 512 + h * 128, CTXL, (LAS char*)F.lds, nullptr, 0, wave_s); }
        }
        REFRAME(); p_sgu(F);
    } SEAM(4);
    if (IN(5)) { REFRAME(); ProbOut<0> p; p.K = 1024; p.lda = 1024; p.A = (const bf16_t*)(ws + WS_MIX0); p.Bt = (const bf16_t*)(ws + WS_WOUT0); p.XR = XR; p.MOD = MOD; p.xin = INP(I_X); p.cin = INP(I_CTX); p.so.init(NPAN, 4); p.G = F.G; p.c = F.bid; pg8::gemm_phase(F.lds, p, wave_s); } SEAM(5);
    if (IN(6)) { REFRAME(); p_norm_router<0>(F, args.dry); } SEAM(6);
    if (IN(7)) { REFRAME();
#if MOE_PREGATHER && MOE_FP8
        p_moe_gather(F, 0); { const int t_ = tid_fresh(wave_s); xcd_barrier(bar, t_ == 0); } REFRAME();
#endif
        moe_prefix(F, 0); ProbMoe1 p; p.K = MOE_FP8 ? 512 : 1024; p.lda = p.K; p.H = (MOE_PREGATHER && MOE_FP8) ? (const bf16_t*)(ws + WS_XS) : H; p.W1 = (const bf16_t*)(ws + WS_W1); p.B1 = INP(I_B1); p.ACT = (bf16_t*)(ws + WS_ACT); p.rowl = (const int*)(ws + WS_ROWL);
        p.cnt = (const LAS int*)(F.lds + XTRA_OFF + X_CNT); p.wave_s = wave_s; p.ms.pb = (const LAS int*)(F.lds + XTRA_OFF + X_PB); p.ms.NTN = 8; p.ms.G = F.G; p.ms.c = F.bid; pg8::gemm_phase(F.lds, p, wave_s); } SEAM(7);
    if (IN(8)) { REFRAME(); moe_prefix(F, 0); ProbMoe2 p; p.K = MOE_FP8 ? 512 : 1024; p.lda = p.K; p.ACT = (const bf16_t*)(ws + WS_ACT); p.W2 = (const bf16_t*)(ws + WS_W2); p.B2 = INP(I_B2); p.Y = (bf16_t*)(ws + WS_Y);
        p.ms.pb = (const LAS int*)(F.lds + XTRA_OFF + X_PB); p.ms.NTN = 4; p.ms.G = F.G; p.ms.c = F.bid; pg8::gemm_phase(F.lds, p, wave_s); } SEAM(8);
    if (IN(9)) { REFRAME(); p_combine_norm(F, args.dry); } SEAM(9);
    if (IN(10)) { REFRAME(); ProbIn1 p; p.K = PROJ1_FP8 ? 512 : 1024; p.lda = p.K; p.A = H; p.Bt = (const bf16_t*)(ws + WS_WIN1); p.O = (bf16_t*)(ws + WS_PBUF); p.so.init(256, 4); p.G = F.G; p.c = F.bid; pg8::gemm_phase(F.lds, p, wave_s); } SEAM(10);
    if (IN(11)) { REFRAME(); p_mla_prep(F); } SEAM(11);
    if (IN(12)) { REFRAME();
        { ProbPlain<true, UPQ_FP8 != 0> p; p.K = UPQ_FP8 ? 256 : 512; p.lda = UPQ_FP8 ? 256 : 1024; p.A = UPQ_FP8 ? (const bf16_t*)(ws + WS_CQ8) : (const bf16_t*)(ws + WS_PBUF); p.Bt = (const bf16_t*)(ws + WS_WUQ); p.O = (bf16_t*)(ws + WS_QB); p.ldc = 1536; p.so.init(256, 6); p.G = F.G; p.c = F.bid; pg8::gemm_phase(F.lds, p, wave_s); }
        { ProbPlain<false, UPKV_FP8 != 0> p; p.K = UPKV_FP8 ? 128 : 256; p.lda = UPKV_FP8 ? 128 : 1024; p.A = UPKV_FP8 ? (const bf16_t*)(ws + WS_CKV8) : (const bf16_t*)(ws + WS_PBUF) + 512; p.Bt = (const bf16_t*)(ws + WS_WUKV); p.O = (bf16_t*)(ws + WS_KVB); p.ldc = 2048; p.so.init(NPAN, 8); p.G = F.G; p.c = F.bid; pg8::gemm_phase(F.lds, p, wave_s); }
    } SEAM(12);
    if (IN(13)) { REFRAME();
        const bf16_t* Q = (const bf16_t*)(ws + WS_QB); const bf16_t* KV = (const bf16_t*)(ws + WS_KVB); const bf16_t* KR = (const bf16_t*)(ws + WS_KRB); bf16_t* MIX = (bf16_t*)(ws + WS_MIX1);
        for (int u = F.bid; u < 2048; u += F.G) { const int qb = u & 7, h = (u >> 3) & 7, b = u >> 6; const size_t kr0 = (size_t)b * TPB, qr0 = kr0 + CTXL + qb * 256;
            att::attn_unit<192, 1, true, 1536, 2048, 1024, OUT1_FP8 != 0>(Q + qr0 * 1536 + h * 192, KV + kr0 * 2048 + h * 128, KR + kr0 * 64, KV + kr0 * 2048 + 1024 + h * 128, OUT1_FP8 ? (bf16_t*)((unsigned char*)MIX + qr0 * 1024 + h * 128) : MIX + qr0 * 1024 + h * 128, TPB, (LAS char*)F.lds, (const f32x2*)(ws + WS_TABM), qb * 256, wave_s); }
    } SEAM(13);
    if (IN(14)) { REFRAME(); ProbOut<1> p; p.K = OUT1_FP8 ? 512 : 1024; p.lda = p.K; p.A = (const bf16_t*)(ws + WS_MIX1); p.Bt = (const bf16_t*)(ws + WS_WOUT1); p.XR = XR; p.MOD = MOD; p.xin = nullptr; p.cin = nullptr; p.so.init(256, 4); p.G = F.G; p.c = F.bid; pg8::gemm_phase(F.lds, p, wave_s); } SEAM(14);
    if (IN(15)) { REFRAME(); p_norm_router<1>(F, args.dry); } SEAM(15);
    if (IN(16)) { REFRAME();
#if MOE_PREGATHER && MOE_FP8
        p_moe_gather(F, 1); { const int t_ = tid_fresh(wave_s); xcd_barrier(bar, t_ == 0); } REFRAME();
#endif
        moe_prefix(F, 1); ProbMoe1 p; p.K = MOE_FP8 ? 512 : 1024; p.lda = p.K; p.H = (MOE_PREGATHER && MOE_FP8) ? (const bf16_t*)(ws + WS_XS) : H; p.W1 = (const bf16_t*)(ws + WS_W1 + (size_t)32 * 2048 * 1024 * (MOE_FP8 ? 1 : 2)); p.B1 = INP(I_B1) + 32 * 2048; p.ACT = (bf16_t*)(ws + WS_ACT); p.rowl = (const int*)(ws + WS_ROWL);
        p.cnt = (const LAS int*)(F.lds + XTRA_OFF + X_CNT); p.wave_s = wave_s; p.ms.pb = (const LAS int*)(F.lds + XTRA_OFF + X_PB); p.ms.NTN = 8; p.ms.G = F.G; p.ms.c = F.bid; pg8::gemm_phase(F.lds, p, wave_s); } SEAM(16);
    if (IN(17)) { REFRAME(); moe_prefix(F, 1); ProbMoe2 p; p.K = MOE_FP8 ? 512 : 1024; p.lda = p.K; p.ACT = (const bf16_t*)(ws + WS_ACT); p.W2 = (const bf16_t*)(ws + WS_W2 + (size_t)32 * 1024 * 1024 * (MOE_FP8 ? 1 : 2)); p.B2 = INP(I_B2) + 32 * 1024; p.Y = (bf16_t*)(ws + WS_Y);
        p.ms.pb = (const LAS int*)(F.lds + XTRA_OFF + X_PB); p.ms.NTN = 4; p.ms.G = F.G; p.ms.c = F.bid; pg8::gemm_phase(F.lds, p, wave_s); } SEAM(17);
    if (IN(18)) { REFRAME(); p_final(F); }
#undef IN
#undef SEAM
}

extern "C" void kernel_launch(void* const* d_in, const int* in_sizes, int n_in, void* d_out, int out_size, void* d_ws, size_t ws_size, hipStream_t stream) {
    static int grid = 0;
    if (grid == 0) {
        if (n_in != 28 || out_size != NBATCH * SEQ * DM || ws_size < WS_END) { fprintf(stderr, "kernel_launch: unexpected shapes (n_in %d out %d ws %zu, need ws >= %zu)\n", n_in, out_size, ws_size, (size_t)WS_END); grid = -1; return; }
        int dev = 0, cus = 0, per_cu = 0;
        if (hipGetDevice(&dev) != hipSuccess || hipDeviceGetAttribute(&cus, hipDeviceAttributeMultiprocessorCount, dev) != hipSuccess) { grid = -1; return; }
        if (hipFuncSetAttribute((const void*)fwd_kernel, hipFuncAttributeMaxDynamicSharedMemorySize, LDS_BYTES) != hipSuccess) { fprintf(stderr, "kernel_launch: hipFuncSetAttribute failed\n"); grid = -1; return; }
        if (hipOccupancyMaxActiveBlocksPerMultiprocessor(&per_cu, (const void*)fwd_kernel, 512, LDS_BYTES) != hipSuccess || per_cu < 1) { fprintf(stderr, "kernel_launch: occupancy query says %d blocks/CU\n", per_cu); }
        (void)hipGetLastError();
        grid = cus;
    }
    if (grid < 0) return;
    (void)hipMemsetAsync((char*)d_ws + WS_CTL, 0, CTL_BYTES, stream);
    Args a{};
    for (int i = 0; i < 28; ++i) a.in[i] = (const float*)d_in[i];
    a.out = (float*)d_out; a.ws = (uchar*)d_ws;
#if MK_ONE_LAUNCH
    a.ph_lo = 0; a.ph_hi = NPHASE;
    hipLaunchKernelGGL(fwd_kernel, dim3(grid), dim3(512), LDS_BYTES, stream, a);
#else
    for (int ph = 0; ph < NPHASE; ++ph) { a.ph_lo = ph; a.ph_hi = ph + 1; const int nrep = 1 + ((REPEAT_MASK >> ph) & 1); for (int rep = 0; rep < nrep; ++rep) { a.dry = (rep + 1 < nrep) ? 1 : 0; hipLaunchKernelGGL(fwd_kernel, dim3(grid), dim3(512), LDS_BYTES, stream, a); } }
#endif
}
```

```cpp
#include <hip/hip_runtime.h>
#include <cstdio>
#include <cstdint>

#ifndef MK_ONE_LAUNCH
#define MK_ONE_LAUNCH 1
#endif
#define REPEAT_MASK 0
#define USE_BUFFER_LDS 1
#define MOE_PREGATHER 0
#define PROJ0_FP8 0
#ifndef UPQ_FP8
#define UPQ_FP8 (MOE_FP8 != 0)
#endif
#ifndef UPKV_FP8
#define UPKV_FP8 0
#endif
#define UP1_FP8_UNUSED 0
#define MLA_QK_FP8 1
#define OUT1_FP8 (MOE_FP8 != 0)
#define PROJ1_FP8 (MOE_FP8 != 0)
#define PROJ_FP8_UNUSED (MOE_FP8 != 0)
#define Y_FP8 1
#ifndef MOE_FP8
#define MOE_FP8 1
#endif

#define LAS __attribute__((address_space(3)))
typedef unsigned short bf16_t;
typedef unsigned char uchar;
typedef short bf16x8 __attribute__((ext_vector_type(8)));
typedef short s16x4 __attribute__((ext_vector_type(4)));
typedef float f32x2 __attribute__((ext_vector_type(2)));
typedef float f32x4 __attribute__((ext_vector_type(4)));
typedef float f32x16 __attribute__((ext_vector_type(16)));
typedef unsigned u32x2 __attribute__((ext_vector_type(2)));
typedef unsigned u32x4 __attribute__((ext_vector_type(4)));
typedef int i32x4 __attribute__((ext_vector_type(4)));
typedef int i32x8 __attribute__((ext_vector_type(8)));

constexpr int DM = 1024, NBATCH = 32, SEQ = 2048, CTXL = 256, TPB = SEQ + CTXL, NTOK = NBATCH * TPB, NPAN = NTOK / 256;
constexpr int NEXP = 32, TOPK = 4, ROWCAP = NTOK;
constexpr float EPS = 1e-6f;
constexpr int NPHASE = 19;

constexpr size_t MiB = 1u << 20;
constexpr size_t WS_CTL = 0, CTL_BYTES = 1 * MiB;
constexpr size_t WS_MOD = 1 * MiB;
constexpr size_t WS_TABG = 3 * MiB;
constexpr size_t WS_TABM = WS_TABG + 32768;
constexpr size_t WS_WRT = WS_TABG + 65536;
constexpr size_t WS_SGUW = WS_WRT + 262144;
constexpr size_t WS_WIN0 = 4 * MiB, WS_WOUT0 = 8 * MiB, WS_WIN1 = 10 * MiB, WS_WUQ = 12 * MiB, WS_WUKV = 14 * MiB, WS_WOUT1 = 15 * MiB;
constexpr size_t WS_W1 = 17 * MiB;
constexpr size_t WS_W2 = 273 * MiB;
constexpr size_t WS_ROWL = 401 * MiB;
constexpr size_t WS_TOKI = 410 * MiB;
constexpr size_t WS_XR = 413 * MiB;
constexpr size_t WS_H = 701 * MiB;
constexpr size_t WS_SCR = 845 * MiB;
constexpr size_t WS_PBUF = WS_SCR;
constexpr size_t WS_MIX0 = WS_SCR + 288 * MiB;
constexpr size_t WS_QB = WS_SCR + 144 * MiB;
constexpr size_t WS_KVB = WS_SCR + 360 * MiB;
constexpr size_t WS_KRB = WS_SCR + 648 * MiB;
constexpr size_t WS_MIX1 = WS_SCR + 660 * MiB;
constexpr size_t WS_CQ8 = WS_SCR + 804 * MiB;
constexpr size_t WS_CKV8 = WS_SCR + 840 * MiB;
constexpr size_t WS_ACT = WS_SCR;
constexpr size_t WS_XS = WS_SCR + 296 * MiB;
constexpr size_t WS_Y = WS_SCR + 592 * MiB;
constexpr size_t WS_END = WS_SCR + 1184 * MiB;
constexpr int CW_BAR = 1024;
constexpr int CW_CNT = 8192;
constexpr int CW_DBG = 16384;

constexpr int RING_BYTES = 131072;
constexpr int XTRA_OFF = RING_BYTES, XTRA_BYTES = 20480;
constexpr int MISC_OFF = XTRA_OFF + XTRA_BYTES;
constexpr int LDS_BYTES = MISC_OFF + 512;
constexpr int X_PB = 0;
constexpr int X_CNT = 256;
constexpr int X_HIST = 512;
constexpr int X_BASE = 768;
constexpr int X_SEL = 1024;
constexpr int X_A2 = 9216;
constexpr int X_CB = 13312;
constexpr int X_RS = 13440;

#define LDS_WAIT() asm volatile("s_waitcnt lgkmcnt(0)" ::: "memory")
#define VM_WAIT() asm volatile("s_waitcnt vmcnt(0)" ::: "memory")
#define SBAR() __builtin_amdgcn_sched_barrier(0)
__device__ __forceinline__ unsigned cvtpk(float lo, float hi) { unsigned r; asm volatile("v_cvt_pk_bf16_f32 %0, %1, %2" : "=v"(r) : "v"(lo), "v"(hi)); return r; }
__device__ __forceinline__ float bf2f(unsigned short b) { return __uint_as_float(((unsigned)b) << 16); }
__device__ __forceinline__ float bflo(unsigned w) { return __uint_as_float(w << 16); }
__device__ __forceinline__ float bfhi(unsigned w) { return __uint_as_float(w & 0xffff0000u); }
__device__ __forceinline__ unsigned short f2bf(float f) { return (unsigned short)(cvtpk(f, 0.f) & 0xffffu); }
__device__ __forceinline__ unsigned pk4_fp8(float a, float b, float c, float d) {
    a = fminf(fmaxf(a, -448.f), 448.f); b = fminf(fmaxf(b, -448.f), 448.f); c = fminf(fmaxf(c, -448.f), 448.f); d = fminf(fmaxf(d, -448.f), 448.f);
    unsigned w = 0; w = __builtin_amdgcn_cvt_pk_fp8_f32(a, b, w, false); w = __builtin_amdgcn_cvt_pk_fp8_f32(c, d, w, true); return w;
}
__device__ __forceinline__ int tid_fresh(int wave_s) { int l; asm volatile("v_mbcnt_lo_u32_b32 %0, -1, 0\n\tv_mbcnt_hi_u32_b32 %0, -1, %0" : "=v"(l)); return wave_s * 64 + l; }
template <int CTRL, int BANK> __device__ __forceinline__ int dpp_i(int old, int x) { return __builtin_amdgcn_update_dpp(old, x, CTRL, 0xF, BANK, false); }
__device__ __forceinline__ int xs1(int x) { return dpp_i<0xB1, 0xF>(x, x); }
__device__ __forceinline__ int xs2(int x) { return dpp_i<0x4E, 0xF>(x, x); }
__device__ __forceinline__ int xs4(int x) { const int t = dpp_i<0x114, 0xA>(x, x); return dpp_i<0x104, 0x5>(t, x); }
__device__ __forceinline__ int xs8(int x) { return dpp_i<0x128, 0xF>(x, x); }
__device__ __forceinline__ float xf1(float x) { return __int_as_float(xs1(__float_as_int(x))); }
__device__ __forceinline__ float xf2(float x) { return __int_as_float(xs2(__float_as_int(x))); }
__device__ __forceinline__ float xf4(float x) { return __int_as_float(xs4(__float_as_int(x))); }
__device__ __forceinline__ float xf8(float x) { return __int_as_float(xs8(__float_as_int(x))); }
__device__ __forceinline__ float sum16(float a, float b) { auto r = __builtin_amdgcn_permlane16_swap(__float_as_uint(a), __float_as_uint(b), false, false); return __uint_as_float(r[0]) + __uint_as_float(r[1]); }
__device__ __forceinline__ float sum32(float a, float b) { auto r = __builtin_amdgcn_permlane32_swap(__float_as_uint(a), __float_as_uint(b), false, false); return __uint_as_float(r[0]) + __uint_as_float(r[1]); }
__device__ __forceinline__ unsigned xu16(unsigned x, int lane) { auto r = __builtin_amdgcn_permlane16_swap(x, x, false, false); return (lane & 16) ? r[0] : r[1]; }
__device__ __forceinline__ unsigned xu32(unsigned x, int lane) { auto r = __builtin_amdgcn_permlane32_swap(x, x, false, false); return (lane & 32) ? r[0] : r[1]; }
__device__ __forceinline__ float wave_sum(float v) {
    v += xf1(v); v += xf2(v); v += xf4(v); v += xf8(v); v = sum16(v, v); v = sum32(v, v);
    return v;
}
__device__ __forceinline__ float silu_f(float x) { return x / (1.f + __expf(-x)); }
__device__ __forceinline__ float gelu_tanh_f(float x) {
    const float u = x * (1.5957691216057308f + 0.07135481627260025f * x * x);
    const float e = __builtin_amdgcn_exp2f(-1.4426950408889634f * u);
    return x * __builtin_amdgcn_rcpf(1.f + e);
}

#define XB_TMO      128
#define XB_XCNT(j)  (256  + 64 * (j))
#define XB_XSUB(j)  (1280 + 64 * (j))
#define XB_XGEN(j)  (2304 + 64 * (j))
#define XB_TOP      3328
#define XB_TOPGEN   3392
#define XCD_BAR_WORDS 3456
#define XB_SPIN_CAP (1u << 20)
__device__ __forceinline__ unsigned xb_ld(unsigned* p)              { return __hip_atomic_load(p, __ATOMIC_RELAXED, __HIP_MEMORY_SCOPE_AGENT); }
__device__ __forceinline__ unsigned xb_add(unsigned* p, unsigned v) { return __hip_atomic_fetch_add(p, v, __ATOMIC_RELAXED, __HIP_MEMORY_SCOPE_AGENT); }
__device__ __forceinline__ unsigned xb_xcc_id() { return (unsigned)__builtin_amdgcn_s_getreg((3 << 11) | 20) & 0xFu; }
#define XB_SPIN(cond, bar) do { unsigned _sp = 0; while (cond) { __builtin_amdgcn_s_sleep(1); \
    if ((++_sp & 255u) == 0u) { if (xb_ld(&(bar)[XB_TMO])) break; if (_sp > XB_SPIN_CAP) { atomicAdd(&(bar)[XB_TMO], 1u); break; } } } } while (0)
struct XcdBarrier { unsigned* bar; unsigned x; volatile LAS unsigned* st; };
__device__ __forceinline__ XcdBarrier xcd_barrier_post(unsigned* bar, volatile LAS unsigned* st, bool t0) {
    XcdBarrier b; b.bar = bar; b.x = xb_xcc_id(); b.st = st;
    if (t0) (void)xb_add(&bar[XB_XCNT(b.x)], 1u);
    return b;
}
__device__ __forceinline__ void xcd_barrier_complete(unsigned* bar, unsigned x, unsigned& nloc, unsigned& nx) {
    const unsigned G = gridDim.x * gridDim.y * gridDim.z;
    unsigned sum, cnt, mine, sp = 0u;
    for (;;) {
        sum = 0u; cnt = 0u; mine = 0u;
#pragma unroll
        for (unsigned j = 0; j < 16; ++j) { const unsigned c = xb_ld(&bar[XB_XCNT(j)]); sum += c; cnt += (c > 0u) ? 1u : 0u; mine = (j == x) ? c : mine; }
        if (sum == G) break;
        __builtin_amdgcn_s_sleep(1);
        if ((++sp & 255u) == 0u) { if (xb_ld(&bar[XB_TMO])) break; if (sp > XB_SPIN_CAP) { atomicAdd(&bar[XB_TMO], 1u); break; } }
    }
    nloc = mine > 0u ? mine : 1u; nx = cnt > 0u ? cnt : 1u;
}
__device__ __forceinline__ void xcd_barrier(const XcdBarrier& b, bool t0) {
    asm volatile("s_waitcnt vmcnt(0)" ::: "memory");
    __syncthreads();
    if (t0) {
        unsigned* bar = b.bar;
        __builtin_amdgcn_s_waitcnt(0);
        unsigned nloc = b.st[0], nx = b.st[1];
        if (nloc == 0u) { xcd_barrier_complete(bar, b.x, nloc, nx); b.st[0] = nloc; b.st[1] = nx; }
        const unsigned old = xb_add(&bar[XB_XSUB(b.x)], 1u);
        const unsigned gen = old / nloc;
        if (old + 1u == (gen + 1u) * nloc) {
            __builtin_amdgcn_fence(__ATOMIC_RELEASE, "agent");
            asm volatile("s_waitcnt vmcnt(0)" ::: "memory");
            const unsigned og = xb_add(&bar[XB_TOP], 1u);
            const unsigned tg = og / nx;
            if (og + 1u == (tg + 1u) * nx) xb_add(&bar[XB_TOPGEN], 1u);
            else XB_SPIN(xb_ld(&bar[XB_TOPGEN]) == tg, bar);
            __builtin_amdgcn_fence(__ATOMIC_ACQUIRE, "agent");
            xb_add(&bar[XB_XGEN(b.x)], 1u);
            asm volatile("s_waitcnt vmcnt(0)" ::: "memory");
        } else {
            XB_SPIN(xb_ld(&bar[XB_XGEN(b.x)]) == gen, bar);
            __builtin_amdgcn_fence(__ATOMIC_ACQUIRE, "agent");
            asm volatile("s_waitcnt vmcnt(0)" ::: "memory");
        }
    }
    __syncthreads();
}

struct Args { const float* in[28]; float* out; uchar* ws; int ph_lo, ph_hi, dry, pad; };
enum { I_X = 0, I_C, I_CTX, I_CCTX, I_ADAW, I_ADAB, I_NMIXG, I_NFFNG, I_ABWIN, I_SGUNG, I_SGUW, I_SGUB, I_GQG, I_GKG, I_ABWOUT, I_MLAWIN, I_MLAQG, I_MLAKVG, I_MLAWUQ, I_MLAWUKV, I_MLAWOUT,
       I_RW, I_RB, I_W1, I_B1, I_W2, I_B2, I_FNG };
struct Frame {
    LAS uchar* lds; int tid, lane, wave, G, bid;
    uchar* ws; float* out;
};
__device__ __forceinline__ const float* INP(int i) {
    const __attribute__((address_space(4))) char* ka = (const __attribute__((address_space(4))) char*)__builtin_amdgcn_kernarg_segment_ptr();
    return *(const float* const volatile __attribute__((address_space(4)))*)(ka + i * 8);
}

namespace pg8 {
constexpr int BM = 256, BK = 64, HALF = 128, HTB = HALF * BK * 2, NXCD = 8, WGM = 8;
__device__ __forceinline__ int lds_byte(int r, int c) { const int st = (r >> 4) * 2 + (c >> 5), rr = r & 15, cc = c & 31, ob = rr * 64 + cc * 2; return st * 1024 + (ob ^ (((ob >> 9) & 1) << 5)); }
__device__ __forceinline__ void stage_rc(int b, int& R, int& C) { const int st = b / 1024, sb = b % 1024, swz = sb ^ (((sb >> 9) & 1) << 5); R = (st >> 1) * 16 + swz / 64; C = (st & 1) * 32 + (swz % 64) / 2; }
__device__ __forceinline__ int perm32(int rho) { const int n = rho >> 4, i = rho & 15; return 8 * (i >> 2) + 4 * n + (i & 3); }
struct Unit { int pm, pn, e, rb; };
struct StaticOrder {
    int nM, nN, nwg;
    __device__ void init(int nM_, int nN_) { nM = nM_; nN = nN_; nwg = nM * nN; }
    __device__ bool map(long L, int& pm, int& pn) const {
        if (L >= nwg) return false;
        int wgid = (int)L; { const int q = nwg / NXCD, r = nwg % NXCD, xcd = wgid % NXCD, off = wgid / NXCD; wgid = (xcd < r ? xcd * (q + 1) : r * (q + 1) + (xcd - r) * q) + off; }
        const int nig = WGM * nN, gid = wgid / nig, fm = gid * WGM, gsz = (nM - fm) < WGM ? (nM - fm) : WGM;
        pm = fm + ((wgid % nig) % gsz); pn = (wgid % nig) / gsz; return true;
    }
};
typedef f32x4 Acc[2][2][4][2];
template <class P>
__device__ __forceinline__ void gemm_phase(LAS uchar* lds, const P& p, int wave_s) {
    const int tid = tid_fresh(wave_s), wid = __builtin_amdgcn_readfirstlane(tid >> 6), lane = tid & 63, wr = wid >> 2, wc = wid & 3, fr = lane & 15, fq = lane >> 4;
    const int K = p.K, nt = K / BK;
    unsigned voffA[2][2], voffB[2];
#pragma unroll
    for (int i = 0; i < 2; ++i) { int R, C; stage_rc(tid * 16 + i * 8192, R, C); const int Rb = P::PERM ? ((R & ~31) + perm32(R & 31)) : R;
        voffA[0][i] = (unsigned)(R * p.lda + C) * 2u; voffA[1][i] = voffA[0][i]; voffB[i] = (unsigned)(Rb * K + C) * 2u; }
    const unsigned kstep = (unsigned)(BK * 2);
    const unsigned hstepB = (unsigned)HALF * K * 2;
    const unsigned hstepA = P::GATHER ? 0u : (unsigned)HALF * p.lda * 2;
#define PG8_VA1 voffA[P::GATHER ? 1 : 0]
    const __amdgpu_buffer_rsrc_t rsA = __builtin_amdgcn_make_buffer_rsrc((void*)p.a_mat(), 0, 0xffffffffu, 0x00020000);
    const __amdgpu_buffer_rsrc_t rsB = __builtin_amdgcn_make_buffer_rsrc((void*)p.b_mat(), 0, 0xffffffffu, 0x00020000);
    const char* gpA = (const char*)p.a_mat(); const char* gpB = (const char*)p.b_mat(); (void)gpA; (void)gpB; (void)rsA; (void)rsB;
    const unsigned ldsw = (unsigned)wid * 1024u;
    const int aoff = lds_byte(wr * 64 + fr, fq * 8), boff = lds_byte(wc * 32 + fr, fq * 8);
#define PG8_SA(b, h) (((b) * 2 + (h)) * HTB)
#define PG8_SB(b, h) ((4 + (b) * 2 + (h)) * HTB)
#if USE_BUFFER_LDS
#define PG8_STAGE_R(bufoff, rs, gp, soff, voff) do { _Pragma("unroll") for (int _i = 0; _i < 2; ++_i) \
        __builtin_amdgcn_raw_ptr_buffer_load_lds(rs, (LAS unsigned*)(lds + (bufoff) + ldsw + _i * 8192), 16, (int)(voff)[_i], (int)(soff), 0, 0); } while (0)
#else
#define PG8_STAGE_R(bufoff, rs, gp, soff, voff) do { _Pragma("unroll") for (int _i = 0; _i < 2; ++_i) \
        __builtin_amdgcn_global_load_lds((const unsigned*)((const char*)(gp) + (size_t)(soff) + (voff)[_i]), (LAS unsigned*)(lds + (bufoff) + ldsw + _i * 8192), 16, 0, 0); } while (0)
#endif
#define PG8_STAGE_A(bufoff, soff, voff) PG8_STAGE_R(bufoff, rsA, gpA, soff, voff)
#define PG8_STAGE_B(bufoff, soff, voff) PG8_STAGE_R(bufoff, rsB, gpB, soff, voff)
#define PG8_LDA(dst, b, h) do { _Pragma("unroll") for (int m = 0; m < 4; ++m) _Pragma("unroll") for (int k = 0; k < 2; ++k) dst[m][k] = *(const LAS i32x4*)(lds + PG8_SA(b, h) + aoff + m * 2048 + k * 1024); } while (0)
#define PG8_LDB(dst, b, h) do { _Pragma("unroll") for (int n = 0; n < 2; ++n) _Pragma("unroll") for (int k = 0; k < 2; ++k) dst[n][k] = *(const LAS i32x4*)(lds + PG8_SB(b, h) + boff + n * 2048 + k * 1024); } while (0)
#define PG8_CAT(x) __builtin_shufflevector((x)[0], (x)[1], 0, 1, 2, 3, 4, 5, 6, 7)
#define PG8_MMA(ai, bj, At, Bt) do { __builtin_amdgcn_s_setprio(1); \
        if constexpr (P::FP8) { _Pragma("unroll") for (int m = 0; m < 4; ++m) _Pragma("unroll") for (int n = 0; n < 2; ++n) \
            acc[ai][bj][m][n] = __builtin_amdgcn_mfma_scale_f32_16x16x128_f8f6f4(PG8_CAT(Bt[n]), PG8_CAT(At[m]), acc[ai][bj][m][n], 0, 0, 0, 0x7F7F7F7F, 0, 0x7F7F7F7F); } \
        else { _Pragma("unroll") for (int m = 0; m < 4; ++m) _Pragma("unroll") for (int n = 0; n < 2; ++n) _Pragma("unroll") for (int k = 0; k < 2; ++k) \
            acc[ai][bj][m][n] = __builtin_amdgcn_mfma_f32_16x16x32_bf16(__builtin_bit_cast(bf16x8, Bt[n][k]), __builtin_bit_cast(bf16x8, At[m][k]), acc[ai][bj][m][n], 0, 0, 0); } \
        __builtin_amdgcn_s_setprio(0); } while (0)
#define PG8_WAIT_V(n) asm volatile("s_waitcnt vmcnt(" #n ")" ::: "memory")
#define PG8_WAIT_L(n) asm volatile("s_waitcnt lgkmcnt(" #n ")" ::: "memory")
#define PG8_BAR __builtin_amdgcn_s_barrier()
#define PG8_SCHED __builtin_amdgcn_sched_barrier(0)
    Unit cur, nxt; int ui = 0;
    if (!p.next(0, cur)) return;
    Acc acc;
#pragma unroll
    for (int a = 0; a < 2; ++a)
#pragma unroll
        for (int b = 0; b < 2; ++b)
#pragma unroll
            for (int m = 0; m < 4; ++m)
#pragma unroll
                for (int n = 0; n < 2; ++n) acc[a][b][m][n] = (f32x4){0.f, 0.f, 0.f, 0.f};
    i32x4 At[4][2], B0[2][2], B1[2][2];
    unsigned cA = p.a_off(cur), cB = p.b_off(cur);
    if constexpr (P::GATHER) { p.a_voff(cur, voffA); }
    PG8_STAGE_B(PG8_SB(0, 0), cB, voffB); PG8_STAGE_B(PG8_SB(0, 1), cB + hstepB, voffB); PG8_STAGE_A(PG8_SA(0, 0), cA, voffA[0]); PG8_STAGE_A(PG8_SA(0, 1), cA + hstepA, PG8_VA1);
    if (wr == 1) PG8_BAR;
    PG8_WAIT_V(2); PG8_BAR;
    PG8_STAGE_B(PG8_SB(1, 0), cB + kstep, voffB); PG8_STAGE_A(PG8_SA(1, 0), cA + kstep, voffA[0]); PG8_STAGE_B(PG8_SB(1, 1), cB + hstepB + kstep, voffB);
    PG8_WAIT_V(6); PG8_BAR;
    for (;;) {
        const bool has_next = p.next(ui + 1, nxt);
        const unsigned nA = has_next ? p.a_off(nxt) : cA, nB = has_next ? p.b_off(nxt) : cB;
        for (int t = 0; t < nt; t += 2) {
            const bool last = (t == nt - 2);
            const unsigned a1 = cA + (unsigned)(t + 1) * kstep;
            const unsigned a2 = last ? nA : cA + (unsigned)(t + 2) * kstep, b2 = last ? nB : cB + (unsigned)(t + 2) * kstep;
            const unsigned a3 = a2 + kstep, b3 = b2 + kstep;
            PG8_LDB(B0, 0, 0); PG8_LDB(B1, 0, 1); PG8_SCHED; PG8_LDA(At, 0, 0); PG8_STAGE_A(PG8_SA(1, 1), a1 + hstepA, PG8_VA1);
            if constexpr (P::GATHER) { if (last && has_next) p.a_voff(nxt, voffA); }
            PG8_WAIT_V(8); PG8_WAIT_L(0); PG8_BAR; PG8_MMA(0, 0, At, B0); PG8_MMA(0, 1, At, B1); PG8_BAR; PG8_SCHED;
            PG8_LDA(At, 0, 1); PG8_STAGE_B(PG8_SB(0, 0), b2, voffB); PG8_STAGE_B(PG8_SB(0, 1), b2 + hstepB, voffB); PG8_STAGE_A(PG8_SA(0, 0), a2, voffA[0]);
            PG8_WAIT_V(8); PG8_WAIT_L(0); PG8_BAR; PG8_MMA(1, 0, At, B0); PG8_MMA(1, 1, At, B1); PG8_BAR; PG8_SCHED;
            PG8_LDB(B0, 1, 0); PG8_LDB(B1, 1, 1); PG8_SCHED; PG8_LDA(At, 1, 0); PG8_STAGE_A(PG8_SA(0, 1), a2 + hstepA, PG8_VA1);
            PG8_WAIT_V(8); PG8_WAIT_L(0); PG8_BAR; PG8_MMA(0, 0, At, B0); PG8_MMA(0, 1, At, B1); PG8_BAR; PG8_SCHED;
            PG8_LDA(At, 1, 1); PG8_STAGE_B(PG8_SB(1, 0), b3, voffB); PG8_STAGE_B(PG8_SB(1, 1), b3 + hstepB, voffB); PG8_STAGE_A(PG8_SA(1, 0), a3, voffA[0]);
            PG8_WAIT_V(8); PG8_WAIT_L(0); PG8_BAR; PG8_MMA(1, 0, At, B0); PG8_MMA(1, 1, At, B1); PG8_BAR; PG8_SCHED;
        }
        if (wr == 0) PG8_BAR;
        p.epi(acc, cur, wr, wc, fr, fq);
        if (!has_next) break;
#pragma unroll
        for (int a = 0; a < 2; ++a)
#pragma unroll
            for (int b = 0; b < 2; ++b)
#pragma unroll
                for (int m = 0; m < 4; ++m)
#pragma unroll
                    for (int n = 0; n < 2; ++n) acc[a][b][m][n] = (f32x4){0.f, 0.f, 0.f, 0.f};
        cur = nxt; cA = nA; cB = nB; ++ui;
        if (wr == 1) PG8_BAR;
    }
    PG8_WAIT_V(0);
    PG8_BAR;
#undef PG8_SA
#undef PG8_VA1
#undef PG8_SB
#undef PG8_STAGE_R
#undef PG8_STAGE_A
#undef PG8_STAGE_B
#undef PG8_LDA
#undef PG8_LDB
#undef PG8_MMA
#undef PG8_CAT
#undef PG8_WAIT_V
#undef PG8_WAIT_L
#undef PG8_BAR
#undef PG8_SCHED
}

template <bool GELU>
__device__ __forceinline__ void epi_store_bf16(const Acc& acc, bf16_t* dst  , int ldc, const float* bias  , int wr, int wc, int fr, int fq, float sc = 1.f) {
    const int row0 = wr * 64 + fr, col0 = wc * 32 + 8 * fq;
    f32x4 bv[2][2];
#pragma unroll
    for (int bj = 0; bj < 2; ++bj)
#pragma unroll
        for (int n = 0; n < 2; ++n) bv[bj][n] = bias ? *(const f32x4*)(bias + col0 + bj * HALF + 4 * n) : (f32x4){0.f, 0.f, 0.f, 0.f};
    const unsigned lane_off = (unsigned)(row0 * ldc + col0) * 2u;
#pragma unroll
    for (int ai = 0; ai < 2; ++ai)
#pragma unroll
        for (int m = 0; m < 4; ++m) { char* rowb = (char*)dst + (size_t)((ai * HALF + m * 16) * ldc) * 2;
#pragma unroll
            for (int bj = 0; bj < 2; ++bj) { f32x4 v0 = acc[ai][bj][m][0] * sc + bv[bj][0], v1 = acc[ai][bj][m][1] * sc + bv[bj][1];
                if (GELU) {
#pragma unroll
                    for (int j = 0; j < 4; ++j) { v0[j] = gelu_tanh_f(v0[j]); v1[j] = gelu_tanh_f(v1[j]); } }
                u32x4 w; w.x = cvtpk(v0[0], v0[1]); w.y = cvtpk(v0[2], v0[3]); w.z = cvtpk(v1[0], v1[1]); w.w = cvtpk(v1[2], v1[3]);
                *(u32x4*)(rowb + lane_off + bj * HALF * 2) = w; } }
}
}

namespace att {
constexpr int NW = 8, QBLK = 32, KVBLK = 64;
constexpr int SHM_V = KVBLK * 128 * 2;
constexpr float THR = 8.f;
__device__ __forceinline__ int crow(int r, int hi) { return (r & 3) + 8 * (r >> 2) + 4 * hi; }
template <int DQK> struct Cfg { static constexpr float SCALE = (DQK == 128) ? 0.088388347648318440f : 0.072168783648703220f; static constexpr int KP = DQK * 2, SHM_K = KVBLK * DQK * 2, ND = DQK / 16; };
#define KSWZ(PITCH, row, colB) ((row) * (PITCH) + ((colB) ^ (((row) & 7) << 4)))
template <int DQK, int QS = 1> __device__ __forceinline__ void partialSM(f32x16& p0, f32x16& p1, float& m_reg, float& mn, float& alpha) {
    constexpr float SCALE = Cfg<DQK>::SCALE / (float)QS, C = SCALE * 1.4426950408889634f;
    float pmax = p0[0];
#pragma unroll
    for (int r = 1; r < 16; ++r) pmax = fmaxf(pmax, p0[r]);
#pragma unroll
    for (int r = 0; r < 16; ++r) pmax = fmaxf(pmax, p1[r]);
    { auto rr = __builtin_amdgcn_permlane32_swap(__float_as_uint(pmax), __float_as_uint(pmax), false, false);
      pmax = fmaxf(__uint_as_float(rr[0]), __uint_as_float(rr[1])); }
    if (__builtin_expect(__all(pmax - m_reg <= THR / SCALE), 1)) { mn = m_reg; alpha = 1.f; }
    else { mn = fmaxf(m_reg, pmax); alpha = __builtin_amdgcn_exp2f((m_reg - mn) * C); m_reg = mn; }
    const float mnC = -mn * C;
#pragma unroll
    for (int r = 0; r < 16; ++r) p0[r] = fmaf(p0[r], C, mnC);
#pragma unroll
    for (int r = 0; r < 16; ++r) p1[r] = fmaf(p1[r], C, mnC);
#pragma unroll
    for (int r = 0; r < 16; ++r) p0[r] = __builtin_amdgcn_exp2f(p0[r]);
}
__device__ __forceinline__ void finishSM(f32x16& p0, f32x16& p1, float alpha, float& l_reg, bf16x8& pa0, bf16x8& pa1, bf16x8& pa2, bf16x8& pa3) {
#pragma unroll
    for (int r = 0; r < 16; ++r) p1[r] = __builtin_amdgcn_exp2f(p1[r]);
    float ps = 0;
#pragma unroll
    for (int r = 0; r < 16; ++r) ps += p0[r];
#pragma unroll
    for (int r = 0; r < 16; ++r) ps += p1[r];
    { auto rr = __builtin_amdgcn_permlane32_swap(__float_as_uint(ps), __float_as_uint(ps), false, false);
      ps = __uint_as_float(rr[0]) + __uint_as_float(rr[1]); }
    l_reg = l_reg * alpha + ps;
#define PK4(P, BASE, OUT) do { unsigned a0 = cvtpk(P[BASE + 0], P[BASE + 1]), a1 = cvtpk(P[BASE + 2], P[BASE + 3]);   \
    unsigned b0 = cvtpk(P[BASE + 4], P[BASE + 5]), b1 = cvtpk(P[BASE + 6], P[BASE + 7]);                              \
    auto r0 = __builtin_amdgcn_permlane32_swap(a0, b0, false, false); auto r1 = __builtin_amdgcn_permlane32_swap(a1, b1, false, false); \
    u32x4 w = {r0[0], r1[0], r0[1], r1[1]}; OUT = *reinterpret_cast<bf16x8*>(&w); } while (0)
    PK4(p0, 0, pa0); PK4(p0, 8, pa1); PK4(p1, 0, pa2); PK4(p1, 8, pa3);
#undef PK4
}
template <int DQK> __device__ __forceinline__ void qkt(f32x16& p0, f32x16& p1, const LAS char* Ks, const bf16x8* qr, int r32, int hi) {
    constexpr int KP = Cfg<DQK>::KP, ND = Cfg<DQK>::ND;
    p0 = f32x16{}; p1 = f32x16{};
#pragma unroll
    for (int d0 = 0; d0 < ND; ++d0) { const int cb = (d0 * 16 + hi * 8) * 2;
        bf16x8 b0 = *reinterpret_cast<const LAS bf16x8*>(Ks + KSWZ(KP, r32, cb));
        bf16x8 b1 = *reinterpret_cast<const LAS bf16x8*>(Ks + KSWZ(KP, 32 + r32, cb));
        p0 = __builtin_amdgcn_mfma_f32_32x32x16_bf16(b0, qr[d0], p0, 0, 0, 0);
        p1 = __builtin_amdgcn_mfma_f32_32x32x16_bf16(b1, qr[d0], p1, 0, 0, 0); }
}
__device__ __forceinline__ int v_st(int k, int c) { const int kk = (k & ~0xC) | ((k & 4) << 1) | ((k & 8) >> 1); return ((kk >> 3) * 4 + (c >> 5)) * 512 + ((kk & 7) * 32 + (c & 31)) * 2; }
__device__ __forceinline__ int v_rd_base(int lane) { return ((lane & 3) << 3) | (((lane >> 2) & 3) << 6) | (((lane >> 4) & 1) << 5) | (((lane >> 5) & 1) << 8); }
constexpr int v_rd_off(int d0, int ks, int half) { return d0 * 512 + ks * 4096 + half * 2048; }
template <int OFF> __device__ __forceinline__ s16x4 tr_read(int vb) {
    s16x4 r; asm volatile("ds_read_b64_tr_b16 %0, %1 offset:%2" : "=&v"(r) : "v"(vb), "i"(OFF) : "memory"); return r;
}
template <int D0> __device__ __forceinline__ void pv_one(f32x16& od, int vb, bf16x8 pa0, bf16x8 pa1, bf16x8 pa2, bf16x8 pa3) {
    const s16x4 l0 = tr_read<v_rd_off(D0, 0, 0)>(vb), h0 = tr_read<v_rd_off(D0, 0, 1)>(vb), l1 = tr_read<v_rd_off(D0, 1, 0)>(vb), h1 = tr_read<v_rd_off(D0, 1, 1)>(vb);
    const s16x4 l2 = tr_read<v_rd_off(D0, 2, 0)>(vb), h2 = tr_read<v_rd_off(D0, 2, 1)>(vb), l3 = tr_read<v_rd_off(D0, 3, 0)>(vb), h3 = tr_read<v_rd_off(D0, 3, 1)>(vb);
    asm volatile("s_waitcnt lgkmcnt(0)" ::: "memory"); SBAR();
#define PK(L, H) (bf16x8){L[0], L[1], L[2], L[3], H[0], H[1], H[2], H[3]}
    od = __builtin_amdgcn_mfma_f32_32x32x16_bf16(pa0, PK(l0, h0), od, 0, 0, 0);
    od = __builtin_amdgcn_mfma_f32_32x32x16_bf16(pa1, PK(l1, h1), od, 0, 0, 0);
    od = __builtin_amdgcn_mfma_f32_32x32x16_bf16(pa2, PK(l2, h2), od, 0, 0, 0);
    od = __builtin_amdgcn_mfma_f32_32x32x16_bf16(pa3, PK(l3, h3), od, 0, 0, 0);
#undef PK
}
__device__ __forceinline__ void pv_d0(f32x16* o, int vb, bf16x8 pa0, bf16x8 pa1, bf16x8 pa2, bf16x8 pa3) {
    pv_one<0>(o[0], vb, pa0, pa1, pa2, pa3); pv_one<1>(o[1], vb, pa0, pa1, pa2, pa3); pv_one<2>(o[2], vb, pa0, pa1, pa2, pa3); pv_one<3>(o[3], vb, pa0, pa1, pa2, pa3);
}
__device__ __forceinline__ bf16x8 ld8(const bf16_t* p) { return *reinterpret_cast<const bf16x8*>(p); }
__device__ __forceinline__ void rope_frag(bf16x8& a, bf16x8& b, const f32x2* tab) {
    u32x4 wa = *reinterpret_cast<u32x4*>(&a), wb = *reinterpret_cast<u32x4*>(&b), oa, ob;
#pragma unroll
    for (int q = 0; q < 4; ++q) {
        const float x1l = bflo(wa[q]), x1h = bfhi(wa[q]), x2l = bflo(wb[q]), x2h = bfhi(wb[q]);
        const f32x2 t0 = tab[2 * q], t1 = tab[2 * q + 1];
        oa[q] = cvtpk(x1l * t0.x - x2l * t0.y, x1h * t1.x - x2h * t1.y);
        ob[q] = cvtpk(x2l * t0.x + x1l * t0.y, x2h * t1.x + x1h * t1.y);
    }
    a = *reinterpret_cast<bf16x8*>(&oa); b = *reinterpret_cast<bf16x8*>(&ob);
}
template <int DQK, int SDEPTH, bool MLA, int ldq, int ldkv, int ldo, bool OUT8 = false>
__device__ __forceinline__ void attn_unit(const bf16_t* __restrict__ Qb, const bf16_t* __restrict__ Kh, const bf16_t* __restrict__ KRh, const bf16_t* __restrict__ Vh,
                                          bf16_t* __restrict__ Ob, int seq, LAS char* lds, const f32x2* __restrict__ tabm, int qt0, int wave_s) {
    constexpr int KP = Cfg<DQK>::KP, SHM_K = Cfg<DQK>::SHM_K, ND = Cfg<DQK>::ND;
    const int tid = tid_fresh(wave_s), wid = tid >> 6, lane = tid & 63, r32 = lane & 31, hi = lane >> 5;
    LAS char* V_lds = lds; LAS char* K_lds = lds + 2 * SHM_V;
    LAS float* wsl = (LAS float*)(lds + 2 * SHM_V + 2 * SHM_K) + wid * 64; LAS float* li_l = wsl; LAS float* al_l = wsl + 32;
    float m_reg = -1e30f, l_reg = 0; f32x16 o[4] = {}; bf16x8 qr[ND];
    const bf16_t* Qw = Qb + (long)(wid * QBLK + r32) * ldq + hi * 8;
#pragma unroll
    for (int d0 = 0; d0 < ND; ++d0) qr[d0] = ld8(Qw + d0 * 16);
    if constexpr (MLA) {
        const int t = qt0 + wid * QBLK + r32, prow = t >> 6, pcol = t & 63;
        rope_frag(qr[8], qr[9], tabm + prow * 16 + hi * 8);
        rope_frag(qr[10], qr[11], tabm + pcol * 16 + hi * 8);
    }
    const int sr = tid >> 4, sc = (tid & 15) * 8, vst0 = v_st(sr, sc), vst1 = v_st(32 + sr, sc);
    const int krr = tid >> 3, krc = (tid & 7) * 8;
    const int vb0 = (int)(unsigned)(uintptr_t)V_lds + v_rd_base(lane);
    struct { bf16x8 vs0, vs1, ks0, ks1, kr; } sr_[SDEPTH];
#define SLOAD(i, k0) do { sr_[i].vs0 = ld8(&Vh[(long)((k0) + sr) * ldkv + sc]); sr_[i].vs1 = ld8(&Vh[(long)((k0) + 32 + sr) * ldkv + sc]); \
    sr_[i].ks0 = ld8(&Kh[(long)((k0) + sr) * ldkv + sc]); sr_[i].ks1 = ld8(&Kh[(long)((k0) + 32 + sr) * ldkv + sc]); \
    if constexpr (MLA) sr_[i].kr = ld8(&KRh[(long)((k0) + krr) * 64 + krc]); } while (0)
#define SWRITE(b, i) do { *(LAS bf16x8*)(V_lds + (b) * SHM_V + vst0) = sr_[i].vs0;          \
    *(LAS bf16x8*)(V_lds + (b) * SHM_V + vst1) = sr_[i].vs1; const int kc = sc * 2;               \
    *(LAS bf16x8*)(K_lds + (b) * SHM_K + KSWZ(KP, sr, kc)) = sr_[i].ks0;                       \
    *(LAS bf16x8*)(K_lds + (b) * SHM_K + KSWZ(KP, 32 + sr, kc)) = sr_[i].ks1;                  \
    if constexpr (MLA) *(LAS bf16x8*)(K_lds + (b) * SHM_K + KSWZ(KP, krr, 256 + krc * 2)) = sr_[i].kr; } while (0)
#define SWAIT() do { if constexpr (SDEPTH == 2) { if constexpr (MLA) asm volatile("s_waitcnt vmcnt(5)" ::: "memory"); else asm volatile("s_waitcnt vmcnt(4)" ::: "memory"); } else asm volatile("s_waitcnt vmcnt(0)" ::: "memory"); } while (0)
#define RESC(a) do { if (__any((a) < 1.f)) { if (hi == 0) al_l[r32] = (a); asm volatile("s_waitcnt lgkmcnt(0)" ::: "memory"); \
    _Pragma("unroll") for (int d = 0; d < 4; ++d) _Pragma("unroll") for (int r = 0; r < 16; ++r) o[d][r] *= al_l[crow(r, hi)]; } } while (0)
    bf16x8 pa0, pa1, pa2, pa3; const int NT = seq / KVBLK;
    if constexpr (MLA) {
        f32x16 p0, p1; float mn, al;
        SLOAD(0, 0); asm volatile("s_waitcnt vmcnt(0)" ::: "memory"); SWRITE(0, 0); SLOAD(0, KVBLK); __syncthreads();
        for (int j = 0; j < NT; ++j) {
            const int cb = j & 1;
            if (j + 1 < NT) { asm volatile("s_waitcnt vmcnt(0)" ::: "memory"); SWRITE(cb ^ 1, 0); if (j + 2 < NT) SLOAD(0, (j + 2) * KVBLK); }
            SBAR(); qkt<DQK>(p0, p1, K_lds + cb * SHM_K, qr, r32, hi);
            partialSM<DQK>(p0, p1, m_reg, mn, al); RESC(al);
            finishSM(p0, p1, al, l_reg, pa0, pa1, pa2, pa3); SBAR();
            pv_d0(o, vb0 + cb * SHM_V, pa0, pa1, pa2, pa3);
            __syncthreads();
        }
    } else {
    f32x16 pA0, pA1, pB0, pB1; float mnA, mnB, alA, alB;
    constexpr int SE = 0, SO = SDEPTH - 1;
    SLOAD(SE, 0); asm volatile("s_waitcnt vmcnt(0)" ::: "memory"); SWRITE(0, SE); __syncthreads();
    qkt<DQK>(pA0, pA1, K_lds, qr, r32, hi); partialSM<DQK>(pA0, pA1, m_reg, mnA, alA);
    SLOAD(SO, KVBLK); if constexpr (SDEPTH == 2) { if (2 < NT) SLOAD(SE, 2 * KVBLK); }
    SWAIT(); SWRITE(1, SO); __syncthreads();
    for (int j = 1; j + 1 < NT; j += 2) {
        SBAR(); qkt<DQK>(pB0, pB1, K_lds + SHM_K, qr, r32, hi);
        finishSM(pA0, pA1, alA, l_reg, pa0, pa1, pa2, pa3); SBAR();
        SLOAD(SO, (j + SDEPTH) * KVBLK); SBAR();
        pv_d0(o, vb0, pa0, pa1, pa2, pa3); partialSM<DQK>(pB0, pB1, m_reg, mnB, alB);
        __syncthreads(); SWAIT(); SWRITE(0, SE);
        RESC(alB); __syncthreads();
        SBAR(); qkt<DQK>(pA0, pA1, K_lds, qr, r32, hi);
        finishSM(pB0, pB1, alB, l_reg, pa0, pa1, pa2, pa3); SBAR();
        if (SDEPTH == 1 || j + 3 < NT) SLOAD(SE, (j + 1 + SDEPTH) * KVBLK); SBAR();
        pv_d0(o, vb0 + SHM_V, pa0, pa1, pa2, pa3); partialSM<DQK>(pA0, pA1, m_reg, mnA, alA);
        __syncthreads(); SWAIT(); SWRITE(1, SO);
        RESC(alA); __syncthreads();
    }
    SBAR(); qkt<DQK>(pB0, pB1, K_lds + SHM_K, qr, r32, hi);
    finishSM(pA0, pA1, alA, l_reg, pa0, pa1, pa2, pa3); SBAR();
    pv_d0(o, vb0, pa0, pa1, pa2, pa3); partialSM<DQK>(pB0, pB1, m_reg, mnB, alB);
    __syncthreads(); RESC(alB);
    finishSM(pB0, pB1, alB, l_reg, pa0, pa1, pa2, pa3); SBAR();
    pv_d0(o, vb0 + SHM_V, pa0, pa1, pa2, pa3);
    }
    if (hi == 0) li_l[r32] = l_reg; asm volatile("s_waitcnt lgkmcnt(0)" ::: "memory");
    float rli[16];
#pragma unroll
    for (int r = 0; r < 16; ++r) rli[r] = __builtin_amdgcn_rcpf(li_l[crow(r, hi)]);
    bf16_t* Ow = OUT8 ? (bf16_t*)((unsigned char*)Ob + (long)(wid * QBLK) * ldo) : Ob + (long)(wid * QBLK) * ldo;
#pragma unroll
    for (int r = 0; r < 16; ++r) { const int orow = crow(r, hi);
#pragma unroll
        for (int d0 = 0; d0 < 4; ++d0) { if constexpr (OUT8) ((unsigned char*)Ow)[(long)orow * ldo + d0 * 32 + r32] = (unsigned char)(pk4_fp8(o[d0][r] * rli[r] * 16.f, 0.f, 0.f, 0.f) & 0xffu);
            else Ow[(long)orow * ldo + d0 * 32 + r32] = f2bf(o[d0][r] * rli[r]); } }
    __syncthreads();
#undef SLOAD
#undef SWRITE
#undef SWAIT
#undef RESC
}
__device__ __forceinline__ int kswz8(int row, int byte) { return row * 192 + ((((byte >> 4) ^ ((row >> 2) & 3))) << 4) + (byte & 15); }
__device__ __forceinline__ u32x2 bf8_to_fp8x4(bf16x8 v) { const u32x4 w = *reinterpret_cast<const u32x4*>(&v);
    return (u32x2){pk4_fp8(bflo(w.x) * 4.f, bfhi(w.x) * 4.f, bflo(w.y) * 4.f, bfhi(w.y) * 4.f), pk4_fp8(bflo(w.z) * 4.f, bfhi(w.z) * 4.f, bflo(w.w) * 4.f, bfhi(w.w) * 4.f)}; }
template <int ldq, int ldkv, int ldo, bool OUT8>
__device__ __forceinline__ void attn_unit_mla8(const bf16_t* __restrict__ Qb, const bf16_t* __restrict__ Kh, const bf16_t* __restrict__ KRh, const bf16_t* __restrict__ Vh,
                                               bf16_t* __restrict__ Ob, int seq, LAS char* lds, const f32x2* __restrict__ tabm, int qt0, int wave_s) {
    constexpr int SHM_K8 = KVBLK * 192;
    const int tid = tid_fresh(wave_s), wid = tid >> 6, lane = tid & 63, r32 = lane & 31, hi = lane >> 5;
    LAS char* V_lds = lds; LAS char* K_lds = lds + 2 * SHM_V;
    LAS float* wsl = (LAS float*)(lds + 2 * SHM_V + 2 * SHM_K8) + wid * 64; LAS float* li_l = wsl; LAS float* al_l = wsl + 32;
    float m_reg = -1e30f, l_reg = 0; f32x16 o[4] = {}; i32x8 q8[3];
    {
        const bf16_t* Qw = Qb + (long)(wid * QBLK + r32) * ldq + hi * 32;
        const int t = qt0 + wid * QBLK + r32; const f32x2* tb = tabm + (hi ? (t & 63) : (t >> 6)) * 16;
#pragma unroll
        for (int s3 = 0; s3 < 3; ++s3) { bf16x8 c0 = ld8(Qw + s3 * 64), c1 = ld8(Qw + s3 * 64 + 8), c2 = ld8(Qw + s3 * 64 + 16), c3 = ld8(Qw + s3 * 64 + 24);
            if (s3 == 2) { rope_frag(c0, c2, tb); rope_frag(c1, c3, tb + 8); }
            const u32x2 a = bf8_to_fp8x4(c0), b = bf8_to_fp8x4(c1), c = bf8_to_fp8x4(c2), d = bf8_to_fp8x4(c3);
            q8[s3] = (i32x8){(int)a.x, (int)a.y, (int)b.x, (int)b.y, (int)c.x, (int)c.y, (int)d.x, (int)d.y}; }
    }
    const int sr = tid >> 4, sc = (tid & 15) * 8, vst0 = v_st(sr, sc), vst1 = v_st(32 + sr, sc);
    const int krr = tid >> 3, krc = (tid & 7) * 8;
    const int kst0 = kswz8(sr, sc), kst1 = kswz8(32 + sr, sc), kstr = kswz8(krr, 128 + krc);
    const int vb0 = (int)(unsigned)(uintptr_t)V_lds + v_rd_base(lane);
    bf16x8 vs0, vs1, ks0, ks1, kr;
#define SLOAD8(k0) do { vs0 = ld8(&Vh[(long)((k0) + sr) * ldkv + sc]); vs1 = ld8(&Vh[(long)((k0) + 32 + sr) * ldkv + sc]); \
    ks0 = ld8(&Kh[(long)((k0) + sr) * ldkv + sc]); ks1 = ld8(&Kh[(long)((k0) + 32 + sr) * ldkv + sc]); kr = ld8(&KRh[(long)((k0) + krr) * 64 + krc]); } while (0)
#define SWRITE8(b) do { *(LAS bf16x8*)(V_lds + (b) * SHM_V + vst0) = vs0; *(LAS bf16x8*)(V_lds + (b) * SHM_V + vst1) = vs1; \
    *(LAS u32x2*)(K_lds + (b) * SHM_K8 + kst0) = bf8_to_fp8x4(ks0); *(LAS u32x2*)(K_lds + (b) * SHM_K8 + kst1) = bf8_to_fp8x4(ks1); *(LAS u32x2*)(K_lds + (b) * SHM_K8 + kstr) = bf8_to_fp8x4(kr); } while (0)
#define RESC8(a) do { if (__any((a) < 1.f)) { if (hi == 0) al_l[r32] = (a); asm volatile("s_waitcnt lgkmcnt(0)" ::: "memory"); \
    _Pragma("unroll") for (int d = 0; d < 4; ++d) _Pragma("unroll") for (int r = 0; r < 16; ++r) o[d][r] *= al_l[crow(r, hi)]; } } while (0)
    bf16x8 pa0, pa1, pa2, pa3; const int NT = seq / KVBLK; f32x16 p0, p1; float mn, al;
    SLOAD8(0); asm volatile("s_waitcnt vmcnt(0)" ::: "memory"); SWRITE8(0); SLOAD8(KVBLK); __syncthreads();
    for (int j = 0; j < NT; ++j) {
        const int cb = j & 1;
        if (j + 1 < NT) { asm volatile("s_waitcnt vmcnt(0)" ::: "memory"); SWRITE8(cb ^ 1); if (j + 2 < NT) SLOAD8((j + 2) * KVBLK); }
        SBAR();
        { const LAS char* Ks = K_lds + cb * SHM_K8; p0 = f32x16{}; p1 = f32x16{};
#pragma unroll
          for (int s3 = 0; s3 < 3; ++s3) { const int b0 = 64 * s3 + 32 * hi;
              const i32x4 a0 = *(const LAS i32x4*)(Ks + kswz8(r32, b0)), a1 = *(const LAS i32x4*)(Ks + kswz8(r32, b0 + 16));
              const i32x4 c0 = *(const LAS i32x4*)(Ks + kswz8(32 + r32, b0)), c1 = *(const LAS i32x4*)(Ks + kswz8(32 + r32, b0 + 16));
              p0 = __builtin_amdgcn_mfma_scale_f32_32x32x64_f8f6f4(__builtin_shufflevector(a0, a1, 0, 1, 2, 3, 4, 5, 6, 7), q8[s3], p0, 0, 0, 0, 0x7F7F7F7F, 0, 0x7F7F7F7F);
              p1 = __builtin_amdgcn_mfma_scale_f32_32x32x64_f8f6f4(__builtin_shufflevector(c0, c1, 0, 1, 2, 3, 4, 5, 6, 7), q8[s3], p1, 0, 0, 0, 0x7F7F7F7F, 0, 0x7F7F7F7F); } }
        partialSM<192, 16>(p0, p1, m_reg, mn, al); RESC8(al);
        finishSM(p0, p1, al, l_reg, pa0, pa1, pa2, pa3); SBAR();
        pv_d0(o, vb0 + cb * SHM_V, pa0, pa1, pa2, pa3);
        __syncthreads();
    }
    if (hi == 0) li_l[r32] = l_reg; asm volatile("s_waitcnt lgkmcnt(0)" ::: "memory");
    float rli[16];
#pragma unroll
    for (int r = 0; r < 16; ++r) rli[r] = __builtin_amdgcn_rcpf(li_l[crow(r, hi)]);
    bf16_t* Ow = OUT8 ? (bf16_t*)((unsigned char*)Ob + (long)(wid * QBLK) * ldo) : Ob + (long)(wid * QBLK) * ldo;
#pragma unroll
    for (int r = 0; r < 16; ++r) { const int orow = crow(r, hi);
#pragma unroll
        for (int d0 = 0; d0 < 4; ++d0) { if constexpr (OUT8) ((unsigned char*)Ow)[(long)orow * ldo + d0 * 32 + r32] = (unsigned char)(pk4_fp8(o[d0][r] * rli[r] * 16.f, 0.f, 0.f, 0.f) & 0xffu);
            else Ow[(long)orow * ldo + d0 * 32 + r32] = f2bf(o[d0][r] * rli[r]); } }
    __syncthreads();
#undef SLOAD8
#undef SWRITE8
#undef RESC8
}
}

template <int MODE> __device__ __forceinline__ int dst_row(int n) {
    if (MODE == 1) { const int half = n >> 10, c = n & 1023; return ((c >> 7) << 8) + (half << 7) + (c & 127); }
    if (MODE == 2) { const int h = n >> 8, j = n & 255; return j < 128 ? (h << 7) + j : 1024 + (h << 7) + (j - 128); }
    return n;
}
template <int MODE> __device__ __forceinline__ void p0_transpose_item_fp8(const float* W, int K, int N, unsigned char* WT, LAS float* scr, int item, int lane) {
    const int nblk = N / 32, kb = item / nblk, nb = item % nblk, k0 = 64 * kb, n0 = 32 * nb;
#pragma unroll 8
    for (int i = 0; i < 32; ++i) { const int kk = 2 * i + (lane >> 5); scr[kk * 33 + (lane & 31)] = W[(size_t)(k0 + kk) * N + n0 + (lane & 31)]; }
    LDS_WAIT(); asm volatile("" ::: "memory");
    const int c = lane & 7;
#pragma unroll
    for (int j = 0; j < 4; ++j) { const int n = (lane >> 3) + 8 * j; const LAS float* s = scr + (8 * c) * 33 + n;
        u32x2 o; o.x = pk4_fp8(s[0 * 33] * 64.f, s[1 * 33] * 64.f, s[2 * 33] * 64.f, s[3 * 33] * 64.f); o.y = pk4_fp8(s[4 * 33] * 64.f, s[5 * 33] * 64.f, s[6 * 33] * 64.f, s[7 * 33] * 64.f);
        *(u32x2*)(WT + (size_t)dst_row<MODE>(n0 + n) * K + k0 + 8 * c) = o; }
    LDS_WAIT(); asm volatile("" ::: "memory");
}
template <int MODE> __device__ __forceinline__ void p0_transpose_item(const float* W, int K, int N, bf16_t* WT, LAS float* scr, int item, int lane) {
    const int nblk = N / 32, kb = item / nblk, nb = item % nblk, k0 = 64 * kb, n0 = 32 * nb;
#pragma unroll 8
    for (int i = 0; i < 32; ++i) { const int kk = 2 * i + (lane >> 5); scr[kk * 33 + (lane & 31)] = W[(size_t)(k0 + kk) * N + n0 + (lane & 31)]; }
    LDS_WAIT(); asm volatile("" ::: "memory");
    const int c = lane & 7;
#pragma unroll
    for (int j = 0; j < 4; ++j) { const int n = (lane >> 3) + 8 * j; const LAS float* s = scr + (8 * c) * 33 + n;
        u32x4 o; o.x = cvtpk(s[0 * 33], s[1 * 33]); o.y = cvtpk(s[2 * 33], s[3 * 33]); o.z = cvtpk(s[4 * 33], s[5 * 33]); o.w = cvtpk(s[6 * 33], s[7 * 33]);
        *(u32x4*)(WT + (size_t)dst_row<MODE>(n0 + n) * K + k0 + 8 * c) = o; }
    LDS_WAIT(); asm volatile("" ::: "memory");
}
__device__ __forceinline__ void p0_prologue(Frame& F) {
    uchar* ws = F.ws;
    {
        LAS float* S = (LAS float*)F.lds;
        const float* pC = INP(I_C); const float* pCC = INP(I_CCTX); const float* pAW = INP(I_ADAW); const float* pAB = INP(I_ADAB); const float* pNM = INP(I_NMIXG); const float* pNF = INP(I_NFFNG);
        float* MOD = (float*)(ws + WS_MOD);
        for (int item = F.bid; item < 192; item += F.G) {
            const int layer = item / 96, n0 = (item % 96) * 64;
            __syncthreads();
            for (int u = F.tid; u < 33 * 1024; u += 512) { const int j = u >> 10, k = u & 1023; const float c = j < 32 ? pC[j * 1024 + k] : pCC[k]; S[u] = silu_f(c); }
            __syncthreads();
            float acc[33];
#pragma unroll
            for (int j = 0; j < 33; ++j) acc[j] = 0.f;
            const float* wp = pAW + (size_t)layer * 1024 * 6144 + n0 + F.lane;
            const int kbeg = F.wave * 128;
            for (int k = kbeg; k < kbeg + 128; k += 4) {
                const float w0 = wp[(size_t)k * 6144], w1 = wp[(size_t)(k + 1) * 6144], w2 = wp[(size_t)(k + 2) * 6144], w3 = wp[(size_t)(k + 3) * 6144];
#pragma unroll
                for (int j = 0; j < 33; ++j) { const f32x4 s = *(const LAS f32x4*)(S + j * 1024 + k); acc[j] += s.x * w0 + s.y * w1 + s.z * w2 + s.w * w3; }
            }
            __syncthreads();
#pragma unroll
            for (int j = 0; j < 33; ++j) S[(F.wave * 33 + j) * 64 + F.lane] = acc[j];
            __syncthreads();
            for (int u = F.tid; u < 33 * 64; u += 512) { const int j = u >> 6, cl = u & 63; float s = 0.f;
#pragma unroll
                for (int w = 0; w < 8; ++w) s += S[(w * 33 + j) * 64 + cl];
                const int n = n0 + cl, part = n >> 10, col = n & 1023;
                s += pAB[layer * 6144 + n];
                if (part == 1) s = pNM[layer * 1024 + col] * (1.f + s);
                if (part == 4) s = pNF[layer * 1024 + col] * (1.f + s);
                MOD[((size_t)(layer * 33 + j) * 6 + part) * 1024 + col] = s; }
        }
        __syncthreads();
    }
    {
        const int gt = F.bid * 512 + F.tid, NT = F.G * 512;
        f32x2* tg = (f32x2*)(ws + WS_TABG); f32x2* tm = (f32x2*)(ws + WS_TABM);
        for (int u = gt; u < 64 * 32; u += NT) { const int pos = u >> 5, i = u & 31; const float inv = powf(10000.f, -(float)(2 * i) / 64.f); const float a = (float)pos * inv; tg[u] = (f32x2){cosf(a), sinf(a)}; }
        for (int u = gt; u < 64 * 16; u += NT) { const int pos = u >> 4, i = u & 15; const float inv = powf(10000.f, -(float)(2 * i) / 32.f); const float a = (float)pos * inv; tm[u] = (f32x2){cosf(a), sinf(a)}; }
        float* wrt = (float*)(ws + WS_WRT); const float* pRW = INP(I_RW); const float* pSW = INP(I_SGUW);
        for (int u = gt; u < 2 * 32 * 1024; u += NT) { const int l = u >> 15, e = (u >> 10) & 31, k = u & 1023; wrt[u] = pRW[((size_t)l * 1024 + k) * 32 + e]; }
        bf16_t* sw = (bf16_t*)(ws + WS_SGUW);
        for (int u = gt; u < 4 * 128 * 128; u += NT) sw[u] = f2bf(pSW[u]);
        u32x4* z = (u32x4*)(ws + WS_WIN1 + (size_t)832 * 1024 * (PROJ1_FP8 ? 1 : 2));
        for (int u = gt; u < 192 * 1024 * (PROJ1_FP8 ? 1 : 2) / 16; u += NT) z[u] = (u32x4){0u, 0u, 0u, 0u};
    }
    {
        LAS float* scr = (LAS float*)(F.lds + F.wave * 16384);
        const int gw = F.bid * 8 + F.wave, NGW = F.G * 8; const float* pW1 = INP(I_W1); const float* pW2 = INP(I_W2);
        constexpr int J0 = 16 * 64, J1 = 16 * 32, J2 = 16 * 26, J3 = 8 * 48, J4 = 4 * 64, J5 = 16 * 32, JW1 = 64 * 1024, JW2 = 64 * 512;
        constexpr int NITEMS = J0 + J1 + J2 + J3 + J4 + J5 + JW1 + JW2;
        for (int it = gw; it < NITEMS; it += NGW) {
            int r = it;
#if MOE_FP8
            if (r < JW1) { const int le = r >> 10; p0_transpose_item_fp8<1>(pW1 + (size_t)le * 1024 * 2048, 1024, 2048, (unsigned char*)(ws + WS_W1) + (size_t)le * 2048 * 1024, scr, r & 1023, F.lane); continue; } r -= JW1;
            if (r < JW2) { const int le = r >> 9; p0_transpose_item_fp8<0>(pW2 + (size_t)le * 1024 * 1024, 1024, 1024, (unsigned char*)(ws + WS_W2) + (size_t)le * 1024 * 1024, scr, r & 511, F.lane); continue; } r -= JW2;
#else
            if (r < JW1) { const int le = r >> 10; p0_transpose_item<1>(pW1 + (size_t)le * 1024 * 2048, 1024, 2048, (bf16_t*)(ws + WS_W1) + (size_t)le * 2048 * 1024, scr, r & 1023, F.lane); continue; } r -= JW1;
            if (r < JW2) { const int le = r >> 9; p0_transpose_item<0>(pW2 + (size_t)le * 1024 * 1024, 1024, 1024, (bf16_t*)(ws + WS_W2) + (size_t)le * 1024 * 1024, scr, r & 511, F.lane); continue; } r -= JW2;
#endif
            if (r < J0) { if constexpr (PROJ0_FP8 != 0) p0_transpose_item_fp8<0>(INP(I_ABWIN), 1024, 2048, (unsigned char*)(ws + WS_WIN0), scr, r, F.lane); else p0_transpose_item<0>(INP(I_ABWIN), 1024, 2048, (bf16_t*)(ws + WS_WIN0), scr, r, F.lane); continue; } r -= J0;
            if (r < J1) { p0_transpose_item<0>(INP(I_ABWOUT), 1024, 1024, (bf16_t*)(ws + WS_WOUT0), scr, r, F.lane); continue; } r -= J1;
            if (r < J2) { if constexpr (PROJ1_FP8 != 0) p0_transpose_item_fp8<0>(INP(I_MLAWIN), 1024, 832, (unsigned char*)(ws + WS_WIN1), scr, r, F.lane); else p0_transpose_item<0>(INP(I_MLAWIN), 1024, 832, (bf16_t*)(ws + WS_WIN1), scr, r, F.lane); continue; } r -= J2;
            if (r < J3) { if constexpr (UPQ_FP8 != 0) p0_transpose_item_fp8<0>(INP(I_MLAWUQ), 512, 1536, (unsigned char*)(ws + WS_WUQ), scr, r, F.lane); else p0_transpose_item<0>(INP(I_MLAWUQ), 512, 1536, (bf16_t*)(ws + WS_WUQ), scr, r, F.lane); continue; } r -= J3;
            if (r < J4) { if constexpr (UPKV_FP8 != 0) p0_transpose_item_fp8<2>(INP(I_MLAWUKV), 256, 2048, (unsigned char*)(ws + WS_WUKV), scr, r, F.lane); else p0_transpose_item<2>(INP(I_MLAWUKV), 256, 2048, (bf16_t*)(ws + WS_WUKV), scr, r, F.lane); continue; } r -= J4;
            if constexpr (OUT1_FP8 != 0) p0_transpose_item_fp8<0>(INP(I_MLAWOUT), 1024, 1024, (unsigned char*)(ws + WS_WOUT1), scr, r, F.lane); else p0_transpose_item<0>(INP(I_MLAWOUT), 1024, 1024, (bf16_t*)(ws + WS_WOUT1), scr, r, F.lane);
        }
    }
}

__device__ __forceinline__ void row_src_ptr(const float* px, const float* pctx, int r, const float*& src, int& mj) {
    const int b = r / TPB, pos = r - b * TPB;
    if (pos < CTXL) { src = pctx + ((size_t)b * CTXL + pos) * DM; mj = 32; } else { src = px + ((size_t)b * SEQ + (pos - CTXL)) * DM; mj = b; }
}
__device__ __forceinline__ f32x4 bf4(u32x2 w) { return (f32x4){bflo(w.x), bfhi(w.x), bflo(w.y), bfhi(w.y)}; }
__device__ __forceinline__ u32x2 pk4bf(f32x4 v) { return (u32x2){cvtpk(v.x, v.y), cvtpk(v.z, v.w)}; }
__device__ __forceinline__ void store_h_row(bf16_t* hrow, int lane, const f32x4 (&h)[4]) {
    unsigned long long* o8 = (unsigned long long*)hrow + lane;
#pragma unroll
    for (int j = 0; j < 4; ++j) o8[64 * j] = (unsigned long long)cvtpk(h[j].x, h[j].y) | ((unsigned long long)cvtpk(h[j].z, h[j].w) << 32);
}
__device__ __forceinline__ void p_norm0(Frame& F) {
    const float* MOD = (const float*)(F.ws + WS_MOD); bf16_t* H = (bf16_t*)(F.ws + WS_H);
    const int gw = F.bid * 8 + F.wave, NGW = F.G * 8; const float* px = INP(I_X); const float* pctx = INP(I_CTX);
    for (int r = gw; r < NTOK; r += NGW) {
        const float* src; int mj; row_src_ptr(px, pctx, r, src, mj);
        const f32x4* xr = (const f32x4*)src + F.lane; f32x4 v[4]; float ss = 0.f;
#pragma unroll
        for (int j = 0; j < 4; ++j) { v[j] = xr[64 * j]; ss += (v[j].x * v[j].x + v[j].y * v[j].y) + (v[j].z * v[j].z + v[j].w * v[j].w); }
        const float rstd = rsqrtf(wave_sum(ss) * (1.f / DM) + EPS);
        const f32x4* sh = (const f32x4*)(MOD + ((size_t)(0 * 33 + mj) * 6 + 0) * 1024) + F.lane; const f32x4* A = (const f32x4*)(MOD + ((size_t)(0 * 33 + mj) * 6 + 1) * 1024) + F.lane;
        f32x4 h[4];
#pragma unroll
        for (int j = 0; j < 4; ++j) h[j] = v[j] * rstd * A[64 * j] + sh[64 * j];
        if constexpr (PROJ0_FP8 != 0) { unsigned* o4 = (unsigned*)((unsigned char*)H + (size_t)r * DM) + F.lane;
#pragma unroll
            for (int j = 0; j < 4; ++j) o4[64 * j] = pk4_fp8(h[j].x * 4.f, h[j].y * 4.f, h[j].z * 4.f, h[j].w * 4.f); }
        else store_h_row(H + (size_t)r * DM, F.lane, h);
    }
}
__device__ __forceinline__ void moe_prefix(Frame& F, int layer) {
    LAS int* pb = (LAS int*)(F.lds + XTRA_OFF + X_PB); LAS int* cn = (LAS int*)(F.lds + XTRA_OFF + X_CNT);
    const unsigned* gc = (const unsigned*)(F.ws + WS_CTL) + CW_CNT + layer * 64;
    __syncthreads();
    if (F.tid == 0) { int s = 0; for (int e = 0; e < 32; ++e) { const int c = (int)__hip_atomic_load(gc + e, __ATOMIC_RELAXED, __HIP_MEMORY_SCOPE_AGENT); cn[e] = c; pb[e] = s; s += (c + 255) >> 8; } pb[32] = s; }
    __syncthreads();
}
__device__ __forceinline__ void moe_gather_row(const Frame& F, int r, f32x4 (&f)[4]) {
    const LAS int* pb = (const LAS int*)(F.lds + XTRA_OFF + X_PB);
    const u32x2* ti = (const u32x2*)(F.ws + WS_TOKI) + (size_t)r * 4; const bf16_t* Y = (const bf16_t*)(F.ws + WS_Y);
#pragma unroll
    for (int j = 0; j < 4; ++j) f[j] = (f32x4){0.f, 0.f, 0.f, 0.f};
#pragma unroll
    for (int k = 0; k < 4; ++k) {
        const u32x2 t = ti[k]; const int e = (int)(t.x >> 20), pos = (int)(t.x & 0xfffffu); const float g = __uint_as_float(t.y);
        const size_t yrow = (size_t)pb[e] * 256 + pos;
#if Y_FP8
        const unsigned* yp = (const unsigned*)((const unsigned char*)Y + yrow * DM) + F.lane; const float g16 = g * (1.f / 16.f);
#pragma unroll
        for (int j = 0; j < 4; ++j) { const unsigned w = yp[64 * j]; const f32x2 lo = __builtin_amdgcn_cvt_pk_f32_fp8(w, false), hi2 = __builtin_amdgcn_cvt_pk_f32_fp8(w, true);
            f[j].x += g16 * lo.x; f[j].y += g16 * lo.y; f[j].z += g16 * hi2.x; f[j].w += g16 * hi2.y; }
#else
        const u32x2* yp = (const u32x2*)(Y + yrow * DM) + F.lane;
#pragma unroll
        for (int j = 0; j < 4; ++j) { const u32x2 w = yp[64 * j]; f[j].x += g * bflo(w.x); f[j].y += g * bfhi(w.x); f[j].z += g * bflo(w.y); f[j].w += g * bfhi(w.y); }
#endif
    }
}
__device__ __forceinline__ void p_combine_norm(Frame& F, int dry) {
    moe_prefix(F, 0);
    const float* MOD = (const float*)(F.ws + WS_MOD); bf16_t* H = (bf16_t*)(F.ws + (dry ? WS_SCR + 288 * MiB : WS_H)); bf16_t* XR = (bf16_t*)(F.ws + WS_XR); bf16_t* XW = dry ? (bf16_t*)(F.ws + WS_SCR) : XR;
    const int gw = F.bid * 8 + F.wave, NGW = F.G * 8;
    for (int r = gw; r < NTOK; r += NGW) {
        const int b = r / TPB, pos = r - b * TPB, mj = pos < CTXL ? 32 : b;
        f32x4 f[4]; moe_gather_row(F, r, f);
        const u32x2* xr = (const u32x2*)(XR + (size_t)r * DM) + F.lane; u32x2* xw = (u32x2*)(XW + (size_t)r * DM) + F.lane; const f32x4* g2 = (const f32x4*)(MOD + ((size_t)(0 * 33 + mj) * 6 + 5) * 1024) + F.lane;
        f32x4 v[4]; float ss = 0.f;
#pragma unroll
        for (int j = 0; j < 4; ++j) { v[j] = bf4(xr[64 * j]) + g2[64 * j] * f[j]; xw[64 * j] = pk4bf(v[j]); ss += (v[j].x * v[j].x + v[j].y * v[j].y) + (v[j].z * v[j].z + v[j].w * v[j].w); }
        const float rstd = rsqrtf(wave_sum(ss) * (1.f / DM) + EPS);
        const f32x4* sh = (const f32x4*)(MOD + ((size_t)(1 * 33 + mj) * 6 + 0) * 1024) + F.lane; const f32x4* A = (const f32x4*)(MOD + ((size_t)(1 * 33 + mj) * 6 + 1) * 1024) + F.lane;
        f32x4 h[4];
#pragma unroll
        for (int j = 0; j < 4; ++j) h[j] = v[j] * rstd * A[64 * j] + sh[64 * j];
        if constexpr (PROJ1_FP8 != 0) { unsigned* o4 = (unsigned*)((unsigned char*)H + (size_t)r * DM) + F.lane;
#pragma unroll
            for (int j = 0; j < 4; ++j) o4[64 * j] = pk4_fp8(h[j].x * 4.f, h[j].y * 4.f, h[j].z * 4.f, h[j].w * 4.f); }
        else store_h_row(H + (size_t)r * DM, F.lane, h);
    }
}
__device__ __forceinline__ void p_final(Frame& F) {
    moe_prefix(F, 1);
    const float* MOD = (const float*)(F.ws + WS_MOD); const bf16_t* XR = (const bf16_t*)(F.ws + WS_XR);
    const int gw = F.bid * 8 + F.wave, NGW = F.G * 8; const float* pfg = INP(I_FNG);
    for (int q = gw; q < NBATCH * SEQ; q += NGW) {
        const int b = q >> 11, t = q & 2047, r = b * TPB + CTXL + t;
        f32x4 f[4]; moe_gather_row(F, r, f);
        const u32x2* xr = (const u32x2*)(XR + (size_t)r * DM) + F.lane; const f32x4* g2 = (const f32x4*)(MOD + ((size_t)(1 * 33 + b) * 6 + 5) * 1024) + F.lane;
        f32x4 v[4]; float ss = 0.f;
#pragma unroll
        for (int j = 0; j < 4; ++j) { v[j] = bf4(xr[64 * j]) + g2[64 * j] * f[j]; ss += (v[j].x * v[j].x + v[j].y * v[j].y) + (v[j].z * v[j].z + v[j].w * v[j].w); }
        const float rstd = rsqrtf(wave_sum(ss) * (1.f / DM) + EPS);
        const f32x4* fg = (const f32x4*)pfg + F.lane; f32x4* op = (f32x4*)(F.out + (size_t)q * DM) + F.lane;
#pragma unroll
        for (int j = 0; j < 4; ++j) op[64 * j] = v[j] * rstd * fg[64 * j];
    }
}
__device__ __forceinline__ void top4_of16(float (&v)[16], int hi, float (&tv)[4], int (&te)[4]) {
#pragma unroll
    for (int k = 0; k < 4; ++k) { float best = v[0]; int bi = 0;
#pragma unroll
        for (int r = 1; r < 16; ++r) { const bool bt = v[r] > best; best = bt ? v[r] : best; bi = bt ? r : bi; }
        tv[k] = best; te[k] = (bi & 3) + 8 * (bi >> 2) + 4 * hi;
#pragma unroll
        for (int r = 0; r < 16; ++r) v[r] = (r == bi) ? -3.0e38f : v[r]; }
}
template <int LAYER> __device__ __forceinline__ void p_norm_router(Frame& F, int dry) {
    const float* MOD = (const float*)(F.ws + WS_MOD); bf16_t* H = (bf16_t*)(F.ws + WS_H); const bf16_t* XR = (const bf16_t*)(F.ws + WS_XR);
    LAS f32x4* WL4 = (LAS f32x4*)F.lds;
    LAS int* hist = (LAS int*)(F.lds + XTRA_OFF + X_HIST); LAS int* base = (LAS int*)(F.lds + XTRA_OFF + X_BASE); LAS u32x2* sel = (LAS u32x2*)(F.lds + XTRA_OFF + X_SEL);
    LAS f32x4* A2L4 = (LAS f32x4*)(F.lds + XTRA_OFF + X_A2); LAS float* CBL = (LAS float*)(F.lds + XTRA_OFF + X_CB); LAS float* RSL = (LAS float*)(F.lds + XTRA_OFF + X_RS);
    unsigned* gcnt = (unsigned*)(F.ws + WS_CTL) + CW_CNT + LAYER * 64 + (dry ? 128 : 0);
    int* rowl = (int*)(F.ws + WS_ROWL); u32x2* toki = (u32x2*)(F.ws + WS_TOKI);
    const f32x4* wsrc = (const f32x4*)(F.ws + WS_WRT + (size_t)LAYER * 32 * 1024 * 4);
    __syncthreads();
    for (int u = F.tid; u < 8192; u += 512) { const int e = u >> 8, k4 = u & 255; WL4[e * 256 + (k4 ^ (e & 15))] = wsrc[u]; }
    if (F.tid < 32) hist[F.tid] = 0;
    const int lane = F.lane, r32 = lane & 31, hi = lane >> 5; const float* prb = INP(I_RB);
    constexpr int NP = LAYER == 0 ? NPAN : 256;
    for (int pi = F.bid; pi < NP; pi += F.G) {
        const int pan = LAYER == 0 ? pi : pi + pi / 8 + 1;
        const int b = pan / 9, mj = (pan % 9 == 0) ? 32 : b;
        const f32x4* shp = (const f32x4*)(MOD + ((size_t)(LAYER * 33 + mj) * 6 + 3) * 1024); const f32x4* Ap = (const f32x4*)(MOD + ((size_t)(LAYER * 33 + mj) * 6 + 4) * 1024);
        __syncthreads();
        if (F.tid < 256) A2L4[F.tid] = Ap[F.tid];
        {
            const int e = F.tid >> 4, part = F.tid & 15; float sum = 0.f;
#pragma unroll 4
            for (int q = 0; q < 16; ++q) { const f32x4 a = shp[part * 16 + q], w = wsrc[e * 256 + part * 16 + q]; sum += (a.x * w.x + a.y * w.y) + (a.z * w.z + a.w * w.w); }
            sum += xf1(sum); sum += xf2(sum); sum += xf4(sum); sum += xf8(sum);
            if (part == 0) CBL[e] = sum + prb[LAYER * 32 + e];
        }
        __syncthreads();
        const int row = pan * 256 + F.wave * 32 + r32;
        const u32x2* xp = (const u32x2*)(XR + (size_t)row * DM) + hi;
        const LAS f32x4* wrow = WL4 + r32 * 256; const int swz = r32 & 15;
        f32x16 acc = {}; float ssq = 0.f;
#define RT_LOAD(dst, mb) do { _Pragma("unroll") for (int u = 0; u < 8; ++u) dst[u] = xp[2 * ((mb) + u)]; } while (0)
#define RT_COMP(src, mb) do { _Pragma("unroll") for (int u = 0; u < 8; ++u) { const int k4 = 2 * ((mb) + u) + hi; const f32x4 a4 = A2L4[k4], w4 = wrow[k4 ^ swz]; const f32x4 x = bf4(src[u]); \
                ssq += (x.x * x.x + x.y * x.y) + (x.z * x.z + x.w * x.w); \
                acc = __builtin_amdgcn_mfma_f32_32x32x2f32(w4.x, x.x * a4.x, acc, 0, 0, 0); acc = __builtin_amdgcn_mfma_f32_32x32x2f32(w4.y, x.y * a4.y, acc, 0, 0, 0); \
                acc = __builtin_amdgcn_mfma_f32_32x32x2f32(w4.z, x.z * a4.z, acc, 0, 0, 0); acc = __builtin_amdgcn_mfma_f32_32x32x2f32(w4.w, x.w * a4.w, acc, 0, 0, 0); } } while (0)
        u32x2 xa[8], xb[8];
        RT_LOAD(xa, 0);
#pragma unroll 1
        for (int m0 = 0; m0 < 128; m0 += 16) {
            RT_LOAD(xb, m0 + 8); SBAR();
            RT_COMP(xa, m0); SBAR();
            if (m0 + 16 < 128) RT_LOAD(xa, m0 + 16);
            SBAR(); RT_COMP(xb, m0 + 8); SBAR();
        }
#undef RT_LOAD
#undef RT_COMP
        const float rstd = rsqrtf(sum32(ssq, ssq) * (1.f / DM) + EPS);
        float lg[16];
#pragma unroll
        for (int r = 0; r < 16; ++r) lg[r] = acc[r] * rstd + CBL[(r & 3) + 8 * (r >> 2) + 4 * hi];
        float tv[4], pv[4]; int te[4], pe[4];
        top4_of16(lg, hi, tv, te);
#pragma unroll
        for (int k = 0; k < 4; ++k) { pv[k] = __uint_as_float(xu32(__float_as_uint(tv[k]), lane)); pe[k] = (int)xu32((unsigned)te[k], lane); }
        float cv[8] = {tv[0], tv[1], tv[2], tv[3], pv[0], pv[1], pv[2], pv[3]}; int ce[8] = {te[0], te[1], te[2], te[3], pe[0], pe[1], pe[2], pe[3]};
        float gv[4]; int ge[4];
#pragma unroll
        for (int k = 0; k < 4; ++k) { float best = cv[0]; int be = ce[0];
#pragma unroll
            for (int c = 1; c < 8; ++c) { const bool bt = cv[c] > best || (cv[c] == best && ce[c] < be); best = bt ? cv[c] : best; be = bt ? ce[c] : be; }
            gv[k] = best; ge[k] = be;
#pragma unroll
            for (int c = 0; c < 8; ++c) cv[c] = (ce[c] == be) ? -3.0e38f : cv[c]; }
        const float x1 = __expf(gv[1] - gv[0]), x2 = __expf(gv[2] - gv[0]), x3 = __expf(gv[3] - gv[0]); const float inv = 1.f / (1.f + x1 + x2 + x3);
        {
            const int ea = hi ? ge[2] : ge[0], eb = hi ? ge[3] : ge[1]; const float ga = hi ? x2 * inv : inv, gb = hi ? x3 * inv : x1 * inv;
            const int ra = __hip_atomic_fetch_add(hist + ea, 1, __ATOMIC_RELAXED, __HIP_MEMORY_SCOPE_WORKGROUP), rb2 = __hip_atomic_fetch_add(hist + eb, 1, __ATOMIC_RELAXED, __HIP_MEMORY_SCOPE_WORKGROUP);
            const int rl = F.wave * 32 + r32;
            sel[rl * 4 + 2 * hi] = (u32x2){(unsigned)ea | ((unsigned)ra << 8), __float_as_uint(ga)}; sel[rl * 4 + 2 * hi + 1] = (u32x2){(unsigned)eb | ((unsigned)rb2 << 8), __float_as_uint(gb)};
            if (hi == 0) RSL[rl] = rstd;
        }
        {
            f32x4 Ar[4], Sr[4];
#pragma unroll
            for (int j = 0; j < 4; ++j) { Ar[j] = Ap[lane + 64 * j]; Sr[j] = shp[lane + 64 * j]; }
            for (int rr = 0; rr < 32; rr += 4) {
                const int rw = pan * 256 + F.wave * 32 + rr; f32x4 v[4][4];
#pragma unroll
                for (int t = 0; t < 4; ++t) { const u32x2* xr = (const u32x2*)(XR + (size_t)(rw + t) * DM) + lane;
#pragma unroll
                    for (int j = 0; j < 4; ++j) v[t][j] = bf4(xr[64 * j]); }
#pragma unroll
                for (int t = 0; t < 4; ++t) { const float rs = RSL[F.wave * 32 + rr + t]; f32x4 h[4];
#pragma unroll
                    for (int j = 0; j < 4; ++j) h[j] = v[t][j] * rs * Ar[j] + Sr[j];
                    if constexpr (MOE_FP8 != 0) { unsigned* o4 = (unsigned*)((unsigned char*)H + (size_t)(rw + t) * DM) + lane;
#pragma unroll
                        for (int j = 0; j < 4; ++j) o4[64 * j] = pk4_fp8(h[j].x * 4.f, h[j].y * 4.f, h[j].z * 4.f, h[j].w * 4.f); }
                    else store_h_row(H + (size_t)(rw + t) * DM, lane, h); }
            }
        }
        __syncthreads();
        if (F.tid < 32) { const int c = hist[F.tid]; base[F.tid] = c ? (int)__hip_atomic_fetch_add(gcnt + F.tid, (unsigned)c, __ATOMIC_RELAXED, __HIP_MEMORY_SCOPE_AGENT) : 0; }
        __syncthreads();
        for (int u = F.tid; u < 1024; u += 512) { const u32x2 sv = sel[u]; const int e = (int)(sv.x & 0xffu), pos = base[e] + (int)(sv.x >> 8), r = pan * 256 + (u >> 2);
            rowl[(size_t)e * ROWCAP + pos] = r; toki[(size_t)r * 4 + (u & 3)] = (u32x2){((unsigned)e << 20) | (unsigned)pos, sv.y}; }
        __syncthreads();
        if (F.tid < 32) hist[F.tid] = 0;
    }
    __syncthreads();
}

__device__ __forceinline__ void p_moe_gather(Frame& F, int layer) {
    moe_prefix(F, layer);
    const LAS int* pb = (const LAS int*)(F.lds + XTRA_OFF + X_PB); const LAS int* cn = (const LAS int*)(F.lds + XTRA_OFF + X_CNT);
    const unsigned char* H8 = (const unsigned char*)(F.ws + WS_H); unsigned char* XS = (unsigned char*)(F.ws + WS_XS); const int* rowl = (const int*)(F.ws + WS_ROWL);
    const int nblk = pb[32];
    for (int blk = F.bid; blk < nblk; blk += F.G) {
        int e = 0;
#pragma unroll
        for (int st = 16; st >= 1; st >>= 1) { if (pb[e + st] <= blk) e += st; }
        const int rb = blk - pb[e], n = cn[e] - rb * 256;
        const int* rl = rowl + (size_t)e * ROWCAP + rb * 256 + F.wave * 32;
#pragma unroll 1
        for (int r0 = 0; r0 < 32; r0 += 8) {
            u32x4 v[8]; int tok[8];
#pragma unroll
            for (int q = 0; q < 8; ++q) { const int ri = F.wave * 32 + r0 + q; tok[q] = ri < n ? rl[r0 + q] : -1; }
#pragma unroll
            for (int q = 0; q < 8; ++q) if (tok[q] >= 0) v[q] = *(const u32x4*)(H8 + (size_t)tok[q] * 1024 + F.lane * 16);
#pragma unroll
            for (int q = 0; q < 8; ++q) if (tok[q] >= 0) *(u32x4*)(XS + ((size_t)blk * 256 + F.wave * 32 + r0 + q) * 1024 + F.lane * 16) = v[q];
        }
    }
}

__device__ __forceinline__ void p_qk_prep(Frame& F) {
    bf16_t* P = (bf16_t*)(F.ws + WS_PBUF); const f32x2* tab = (const f32x2*)(F.ws + WS_TABG);
    const int lane = F.lane, sub = lane >> 4, a = lane & 15, gw = F.bid * 8 + F.wave, NGW = F.G * 8;
    const float* pq = INP(I_GQG); const float* pk = INP(I_GKG);
    float gq[8], gk[8], gqp[8], gkp[8];
#pragma unroll
    for (int j = 0; j < 8; ++j) { gq[j] = pq[8 * a + j]; gk[j] = pk[8 * a + j]; gqp[j] = pq[8 * (a ^ 4) + j]; gkp[j] = pk[8 * (a ^ 4) + j]; }
    const bool isx2 = (a & 4) != 0; const int fi = 8 * (a & 3);
    for (int rp = gw; rp < NTOK / 2; rp += NGW) {
#pragma unroll
        for (int g = 0; g < 3; ++g) {
            const int it = g * 4 + sub, hi6 = it >= 6 ? 1 : 0, r = rp * 2 + hi6, s = it - 6 * hi6;
            const int b = r / TPB, pos = r - b * TPB; const bool lat = pos >= CTXL; const int t = pos - CTXL;
            bf16_t* ptr = P + (size_t)r * 2048 + 1024 + s * 128 + 8 * a;
            const u32x4 w = *(const u32x4*)ptr; u32x4 wp;
#pragma unroll
            for (int q = 0; q < 4; ++q) wp[q] = (unsigned)__shfl_xor((int)w[q], 4);
            float x[8], xp[8];
#pragma unroll
            for (int q = 0; q < 4; ++q) { x[2 * q] = bflo(w[q]); x[2 * q + 1] = bfhi(w[q]); xp[2 * q] = bflo(wp[q]); xp[2 * q + 1] = bfhi(wp[q]); }
            float ss = 0.f;
#pragma unroll
            for (int j = 0; j < 8; ++j) ss += x[j] * x[j];
            ss += __shfl_xor(ss, 1); ss += __shfl_xor(ss, 2); ss += __shfl_xor(ss, 4); ss += __shfl_xor(ss, 8);
            const float rstd = rsqrtf(ss * (1.f / 128.f) + EPS); const bool isq = s < 4;
            float o[8];
#pragma unroll
            for (int j = 0; j < 8; ++j) { o[j] = x[j] * rstd * (isq ? gq[j] : gk[j]); xp[j] = xp[j] * rstd * (isq ? gqp[j] : gkp[j]); }
            if (lat) {
                const int pp = (a & 8) ? (t & 63) : (t >> 6); const f32x4* tp = (const f32x4*)(tab + pp * 32 + fi);
#pragma unroll
                for (int q = 0; q < 4; ++q) { const f32x4 cs = tp[q];
                    const float s0 = isx2 ? cs.y : -cs.y, s1 = isx2 ? cs.w : -cs.w;
                    o[2 * q] = o[2 * q] * cs.x + xp[2 * q] * s0; o[2 * q + 1] = o[2 * q + 1] * cs.z + xp[2 * q + 1] * s1; }
            }
            u32x4 wo; wo.x = cvtpk(o[0], o[1]); wo.y = cvtpk(o[2], o[3]); wo.z = cvtpk(o[4], o[5]); wo.w = cvtpk(o[6], o[7]);
            *(u32x4*)ptr = wo;
        }
    }
}
__device__ __forceinline__ void p_mla_prep(Frame& F) {
    bf16_t* P = (bf16_t*)(F.ws + WS_PBUF); bf16_t* KR = (bf16_t*)(F.ws + WS_KRB); const f32x2* tab = (const f32x2*)(F.ws + WS_TABM);
    const int gw = F.bid * 8 + F.wave, NGW = F.G * 8, lane = F.lane;
    const float* pqg = INP(I_MLAQG); const float* pkg = INP(I_MLAKVG);
    float qg[8], kg[4];
#pragma unroll
    for (int j = 0; j < 8; ++j) qg[j] = pqg[8 * lane + j];
#pragma unroll
    for (int j = 0; j < 4; ++j) kg[j] = pkg[4 * lane + j];
    const int krow = (lane >> 3) & 3, ka = lane & 7; const bool kx2 = (ka & 2) != 0; const int kfi = 8 * (ka & 1);
    for (int r0 = gw * 4; r0 < NTOK; r0 += NGW * 4) {
        const int b = r0 / TPB, pos0 = r0 - b * TPB; const bool lat = pos0 >= CTXL;
        u32x4 wq[4]; u32x2 wk[4];
#pragma unroll
        for (int rr = 0; rr < 4; ++rr) { const bf16_t* base = P + (size_t)(r0 + rr) * 1024; wk[rr] = *(const u32x2*)(base + 512 + 4 * lane); if (lat) wq[rr] = *(const u32x4*)(base + 8 * lane); }
        u32x4 wr = (u32x4){0u, 0u, 0u, 0u};
        if (lane < 32) wr = *(const u32x4*)(P + (size_t)(r0 + krow) * 1024 + 768 + 8 * ka);
        if (lat) {
#pragma unroll
            for (int rr = 0; rr < 4; ++rr) { float x[8];
#pragma unroll
                for (int q = 0; q < 4; ++q) { x[2 * q] = bflo(wq[rr][q]); x[2 * q + 1] = bfhi(wq[rr][q]); }
                float ss = 0.f;
#pragma unroll
                for (int j = 0; j < 8; ++j) ss += x[j] * x[j];
                const float rstd = rsqrtf(wave_sum(ss) * (1.f / 512.f) + EPS);
                if constexpr (UPQ_FP8 != 0) { const float s4 = rstd * 4.f; u32x2 w8; w8.x = pk4_fp8(x[0] * s4 * qg[0], x[1] * s4 * qg[1], x[2] * s4 * qg[2], x[3] * s4 * qg[3]); w8.y = pk4_fp8(x[4] * s4 * qg[4], x[5] * s4 * qg[5], x[6] * s4 * qg[6], x[7] * s4 * qg[7]);
                    *(u32x2*)((unsigned char*)(F.ws + WS_CQ8) + (size_t)(r0 + rr) * 512 + 8 * lane) = w8; }
                else { u32x4 w;
#pragma unroll
                    for (int q = 0; q < 4; ++q) w[q] = cvtpk(x[2 * q] * rstd * qg[2 * q], x[2 * q + 1] * rstd * qg[2 * q + 1]);
                    *(u32x4*)(P + (size_t)(r0 + rr) * 1024 + 8 * lane) = w; } }
        }
#pragma unroll
        for (int rr = 0; rr < 4; ++rr) { const float x0 = bflo(wk[rr].x), x1 = bfhi(wk[rr].x), x2 = bflo(wk[rr].y), x3 = bfhi(wk[rr].y);
            const float rstd = rsqrtf(wave_sum((x0 * x0 + x1 * x1) + (x2 * x2 + x3 * x3)) * (1.f / 256.f) + EPS);
            if constexpr (UPKV_FP8 != 0) { const float s4 = rstd * 4.f; *(unsigned*)((unsigned char*)(F.ws + WS_CKV8) + (size_t)(r0 + rr) * 256 + 4 * lane) = pk4_fp8(x0 * s4 * kg[0], x1 * s4 * kg[1], x2 * s4 * kg[2], x3 * s4 * kg[3]); }
            else { u32x2 w; w.x = cvtpk(x0 * rstd * kg[0], x1 * rstd * kg[1]); w.y = cvtpk(x2 * rstd * kg[2], x3 * rstd * kg[3]);
                *(u32x2*)(P + (size_t)(r0 + rr) * 1024 + 512 + 4 * lane) = w; } }
        {
            u32x4 wp;
#pragma unroll
            for (int q = 0; q < 4; ++q) wp[q] = (unsigned)__shfl_xor((int)wr[q], 2);
            float o[8], xp[8];
#pragma unroll
            for (int q = 0; q < 4; ++q) { o[2 * q] = bflo(wr[q]); o[2 * q + 1] = bfhi(wr[q]); xp[2 * q] = bflo(wp[q]); xp[2 * q + 1] = bfhi(wp[q]); }
            if (lat) { const int t = pos0 + krow - CTXL, pp = (ka & 4) ? (t & 63) : (t >> 6); const f32x4* tp = (const f32x4*)(tab + pp * 16 + kfi);
#pragma unroll
                for (int q = 0; q < 4; ++q) { const f32x4 cs = tp[q]; const float s0 = kx2 ? cs.y : -cs.y, s1 = kx2 ? cs.w : -cs.w;
                    o[2 * q] = o[2 * q] * cs.x + xp[2 * q] * s0; o[2 * q + 1] = o[2 * q + 1] * cs.z + xp[2 * q + 1] * s1; } }
            u32x4 wo; wo.x = cvtpk(o[0], o[1]); wo.y = cvtpk(o[2], o[3]); wo.z = cvtpk(o[4], o[5]); wo.w = cvtpk(o[6], o[7]);
            if (lane < 32) *(u32x4*)(KR + (size_t)(r0 + krow) * 64 + 8 * ka) = wo;
        }
    }
}
__device__ __forceinline__ void p_sgu(Frame& F) {
    const bf16_t* P = (const bf16_t*)(F.ws + WS_PBUF); bf16_t* MIX = (bf16_t*)(F.ws + WS_MIX0); const bf16_t* SW = (const bf16_t*)(F.ws + WS_SGUW);
    const int tid = F.tid, lane = F.lane, wid = F.wave, hw = wid >> 2, w4 = wid & 3, th = tid & 255, r32 = lane & 31, hi = lane >> 5;
    LAS char* Vl = (LAS char*)F.lds + hw * 32768;
    const int sr = th >> 4, sc = (th & 15) * 8;
    const int vb0 = (int)(unsigned)(uintptr_t)Vl + att::v_rd_base(lane);
    const float* psg = INP(I_SGUNG); const float* psb = INP(I_SGUB);
    for (int U = F.bid; U < (NTOK / 128) * 2; U += F.G) {
        const int chunk = U >> 1, g = (U & 1) * 2 + hw; const size_t row0 = (size_t)chunk * 128;
        float gn[8];
#pragma unroll
        for (int j = 0; j < 8; ++j) gn[j] = psg[g * 128 + sc + j];
        __syncthreads();
#pragma unroll
        for (int i = 0; i < 8; ++i) {
            const int q = sr + 16 * i;
            u32x4 w = *(const u32x4*)(P + (row0 + q) * 2048 + 512 + g * 128 + sc); float x[8];
#pragma unroll
            for (int k = 0; k < 4; ++k) { x[2 * k] = bflo(w[k]); x[2 * k + 1] = bfhi(w[k]); }
            float ss = 0.f;
#pragma unroll
            for (int j = 0; j < 8; ++j) ss += x[j] * x[j];
            ss += __shfl_xor(ss, 1); ss += __shfl_xor(ss, 2); ss += __shfl_xor(ss, 4); ss += __shfl_xor(ss, 8);
            const float rstd = rsqrtf(ss * (1.f / 128.f) + EPS);
#pragma unroll
            for (int k = 0; k < 4; ++k) w[k] = cvtpk(x[2 * k] * rstd * gn[2 * k], x[2 * k + 1] * rstd * gn[2 * k + 1]);
            *(LAS u32x4*)(Vl + (q >> 6) * 16384 + att::v_st(q & 63, sc)) = w;
        }
        bf16x8 pa[8];
        const bf16_t* wrow = SW + ((size_t)g * 128 + 32 * w4 + r32) * 128 + 8 * hi;
#pragma unroll
        for (int k = 0; k < 8; ++k) pa[k] = *(const bf16x8*)(wrow + 16 * k);
        __syncthreads();
        f32x16 o[4] = {};
        att::pv_d0(o, vb0, pa[0], pa[1], pa[2], pa[3]);
        att::pv_d0(o, vb0 + 16384, pa[4], pa[5], pa[6], pa[7]);
#pragma unroll
        for (int r = 0; r < 16; ++r) { const int p = 32 * w4 + att::crow(r, hi); const float bs = psb[g * 128 + p];
#pragma unroll
            for (int d0 = 0; d0 < 4; ++d0) { const int c = d0 * 32 + r32; const float zu = bf2f(P[(row0 + p) * 2048 + g * 128 + c]);
                MIX[(row0 + p) * 1024 + g * 128 + c] = f2bf((o[d0][r] + bs) * zu); } }
    }
    __syncthreads();
}

using pg8::Unit; using pg8::Acc;
struct ProbIn0 {
    static constexpr bool PERM = true, GATHER = false, FP8 = PROJ0_FP8 != 0; int K, lda; const bf16_t* A; const bf16_t* Bt; bf16_t* O; pg8::StaticOrder so; int G, c;
    __device__ bool next(int i, Unit& u) const { return so.map((long)i * G + c, u.pm, u.pn); }
    __device__ const void* a_mat() const { return A; } __device__ const void* b_mat() const { return Bt; }
    __device__ unsigned a_off(const Unit& u) const { return (unsigned)u.pm * 256u * (unsigned)lda * 2u; }
    __device__ unsigned b_off(const Unit& u) const { return (unsigned)u.pn * 256u * (unsigned)K * 2u; }
    __device__ void a_voff(const Unit&, unsigned (&)[2][2]) const {}
    __device__ void epi(const Acc& acc, const Unit& u, int wr, int wc, int fr, int fq) const {
        bf16_t* dst = O + (size_t)u.pm * 256 * 2048 + u.pn * 256;
        if (u.pn < 4) pg8::epi_store_bf16<true>(acc, dst, 2048, nullptr, wr, wc, fr, fq, FP8 ? (1.f / 256.f) : 1.f); else pg8::epi_store_bf16<false>(acc, dst, 2048, nullptr, wr, wc, fr, fq, FP8 ? (1.f / 256.f) : 1.f);
    }
};
template <bool LATONLY, bool FP8v = false> struct ProbPlain {
    static constexpr bool PERM = true, GATHER = false, FP8 = FP8v; int K, lda; const bf16_t* A; const bf16_t* Bt; bf16_t* O; int ldc; pg8::StaticOrder so; int G, c;
    __device__ bool next(int i, Unit& u) const { int pm; if (!so.map((long)i * G + c, pm, u.pn)) return false; u.pm = LATONLY ? pm + pm / 8 + 1 : pm; return true; }
    __device__ const void* a_mat() const { return A; } __device__ const void* b_mat() const { return Bt; }
    __device__ unsigned a_off(const Unit& u) const { return (unsigned)u.pm * 256u * (unsigned)lda * 2u; }
    __device__ unsigned b_off(const Unit& u) const { return (unsigned)u.pn * 256u * (unsigned)K * 2u; }
    __device__ void a_voff(const Unit&, unsigned (&)[2][2]) const {}
    __device__ void epi(const Acc& acc, const Unit& u, int wr, int wc, int fr, int fq) const {
        pg8::epi_store_bf16<false>(acc, O + (size_t)u.pm * 256 * ldc + u.pn * 256, ldc, nullptr, wr, wc, fr, fq, FP8 ? (1.f / 256.f) : 1.f);
    }
};
struct ProbIn1 {
    static constexpr bool PERM = true, GATHER = false, FP8 = PROJ1_FP8 != 0; int K, lda; const bf16_t* A; const bf16_t* Bt; bf16_t* O; pg8::StaticOrder so; int G, c;
    __device__ bool next(int i, Unit& u) const {
        const long L = (long)i * G + c;
        if (L < 1024) { int pm; so.map(L, pm, u.pn); u.pm = pm + pm / 8 + 1; return true; }
        if (L < 1024 + 64) { const int q = (int)(L - 1024); u.pm = (q >> 1) * 9; u.pn = 2 + (q & 1); return true; }
        return false;
    }
    __device__ const void* a_mat() const { return A; } __device__ const void* b_mat() const { return Bt; }
    __device__ unsigned a_off(const Unit& u) const { return (unsigned)u.pm * 256u * (unsigned)lda * 2u; }
    __device__ unsigned b_off(const Unit& u) const { return (unsigned)u.pn * 256u * (unsigned)K * 2u; }
    __device__ void a_voff(const Unit&, unsigned (&)[2][2]) const {}
    __device__ void epi(const Acc& acc, const Unit& u, int wr, int wc, int fr, int fq) const {
        pg8::epi_store_bf16<false>(acc, O + (size_t)u.pm * 256 * 1024 + u.pn * 256, 1024, nullptr, wr, wc, fr, fq, FP8 ? (1.f / 256.f) : 1.f);
    }
};
template <int LAYER> struct ProbOut {
    static constexpr bool PERM = true, GATHER = false, FP8 = LAYER == 1 && OUT1_FP8 != 0; int K, lda; const bf16_t* A; const bf16_t* Bt; bf16_t* XR; const float* MOD; const float* xin; const float* cin; pg8::StaticOrder so; int G, c;
    __device__ __forceinline__ bool next(int i, Unit& u) const { int pm; if (!so.map((long)i * G + c, pm, u.pn)) return false; u.pm = LAYER ? pm + pm / 8 + 1 : pm; return true; }
    __device__ __forceinline__ const void* a_mat() const { return A; } __device__ __forceinline__ const void* b_mat() const { return Bt; }
    __device__ __forceinline__ unsigned a_off(const Unit& u) const { return (unsigned)u.pm * 256u * (unsigned)lda * 2u; }
    __device__ __forceinline__ unsigned b_off(const Unit& u) const { return (unsigned)u.pn * 256u * (unsigned)K * 2u; }
    __device__ __forceinline__ void a_voff(const Unit&, unsigned (&)[2][2]) const {}
    __device__ __forceinline__ void epi(const Acc& acc, const Unit& u, int wr, int wc, int fr, int fq) const {
        const int b = u.pm / 9, jj = u.pm % 9, mj = jj == 0 ? 32 : b;
        const float* basef = jj == 0 ? cin + (size_t)b * CTXL * DM : xin + ((size_t)b * SEQ + (jj - 1) * 256) * DM;
        bf16_t* dst = XR + (size_t)u.pm * 256 * DM; const float* gate = MOD + ((size_t)(LAYER * 33 + mj) * 6 + 2) * 1024;
        const int row0 = wr * 64 + fr, col0 = u.pn * 256 + wc * 32 + 8 * fq;
        f32x4 gv[2][2];
#pragma unroll
        for (int bj = 0; bj < 2; ++bj)
#pragma unroll
            for (int n = 0; n < 2; ++n) gv[bj][n] = *(const f32x4*)(gate + col0 + bj * 128 + 4 * n);
#pragma unroll
        for (int ai = 0; ai < 2; ++ai)
#pragma unroll
            for (int m = 0; m < 4; ++m) { const size_t uo = (size_t)(ai * 128 + m * 16) * DM; const unsigned lo = (unsigned)(row0 * DM + col0);
#pragma unroll
                for (int bj = 0; bj < 2; ++bj) { f32x4 b0, b1;
                    if constexpr (LAYER == 0) { const char* bp = (const char*)(basef + uo) + (size_t)(lo + bj * 128) * 4u; b0 = *(const f32x4*)bp; b1 = *(const f32x4*)(bp + 16); }
                    else { const u32x4 w = *(const u32x4*)((const char*)(dst + uo) + (lo + bj * 128) * 2u); b0 = (f32x4){bflo(w.x), bfhi(w.x), bflo(w.y), bfhi(w.y)}; b1 = (f32x4){bflo(w.z), bfhi(w.z), bflo(w.w), bfhi(w.w)}; }
                    constexpr float SC = FP8 ? (1.f / 1024.f) : 1.f;
                    const f32x4 v0 = b0 + gv[bj][0] * (acc[ai][bj][m][0] * SC), v1 = b1 + gv[bj][1] * (acc[ai][bj][m][1] * SC);
                    u32x4 wo; wo.x = cvtpk(v0[0], v0[1]); wo.y = cvtpk(v0[2], v0[3]); wo.z = cvtpk(v1[0], v1[1]); wo.w = cvtpk(v1[2], v1[3]);
                    *(u32x4*)((char*)(dst + uo) + (lo + bj * 128) * 2u) = wo; } }
    }
};
struct MoeSched {
    const LAS int* pb; int NTN, G, c;
    __device__ bool map(int i, Unit& u) const {
        const int x = c & 7, q = i * (G >> 3) + (c >> 3); const int blk = (q / NTN) * 8 + x; u.pn = q % NTN;
        if (blk >= __builtin_amdgcn_readfirstlane(pb[32])) return false;
        int lo = 0;
#pragma unroll
        for (int st = 16; st >= 1; st >>= 1) { if (__builtin_amdgcn_readfirstlane(pb[lo + st]) <= blk) lo += st; }
        u.e = lo; u.rb = blk - __builtin_amdgcn_readfirstlane(pb[lo]); u.pm = blk; return true;
    }
};
struct ProbMoe1 {
    static constexpr bool PERM = true, GATHER = !(MOE_PREGATHER && MOE_FP8), FP8 = MOE_FP8 != 0; int K, lda; const bf16_t* H; const bf16_t* W1; const float* B1; bf16_t* ACT; const int* rowl; const LAS int* cnt; MoeSched ms; int wave_s;
    __device__ bool next(int i, Unit& u) const { return ms.map(i, u); }
    __device__ const void* a_mat() const { return H; } __device__ const void* b_mat() const { return W1; }
    __device__ unsigned a_off(const Unit& u) const { return GATHER ? 0u : (unsigned)u.pm * 256u * 1024u; }
    __device__ unsigned b_off(const Unit& u) const { return ((unsigned)u.e * 2048u + (unsigned)u.pn * 256u) * 1024u * (FP8 ? 1u : 2u); }
    __device__ void a_voff(const Unit& u, unsigned (&vo)[2][2]) const {
        const int n = cnt[u.e]; const int* rl = rowl + (size_t)u.e * ROWCAP + u.rb * 256;
        const int tidg = tid_fresh(wave_s);
#pragma unroll
        for (int i = 0; i < 2; ++i) { int R, C; pg8::stage_rc(tidg * 16 + i * 8192, R, C);
#pragma unroll
            for (int h = 0; h < 2; ++h) { const int ri = h * 128 + R; const int tok = (u.rb * 256 + ri < n) ? rl[ri] : 0; vo[h][i] = (unsigned)tok * (FP8 ? 1024u : 2048u) + (unsigned)C * 2u; } }
    }
    __device__ void epi(const Acc& acc, const Unit& u, int wr, int wc, int fr, int fq) const {
        const int row0 = wr * 64 + fr, col0 = u.pn * 128 + wc * 32 + 8 * fq;
        const float* bg = B1 + (size_t)u.e * 2048 + col0; const float* bl = bg + 1024;
        f32x4 bgv[2], blv[2];
#pragma unroll
        for (int n = 0; n < 2; ++n) { bgv[n] = *(const f32x4*)(bg + 4 * n); blv[n] = *(const f32x4*)(bl + 4 * n); }
        constexpr float SC = FP8 ? (1.f / 256.f) : 1.f;
        bf16_t* dst = ACT + (size_t)u.pm * 256 * 1024; unsigned char* dst8 = (unsigned char*)ACT + (size_t)u.pm * 256 * 1024; const unsigned lane_off = (unsigned)(row0 * 1024 + col0);
#pragma unroll
        for (int ai = 0; ai < 2; ++ai)
#pragma unroll
            for (int m = 0; m < 4; ++m) { float a[8];
#pragma unroll
                for (int n = 0; n < 2; ++n) { const f32x4 g = acc[ai][0][m][n] * SC + bgv[n], l = acc[ai][1][m][n] * SC + blv[n];
#pragma unroll
                    for (int j = 0; j < 4; ++j) { const float gg = fminf(g[j], 7.f), ll = fminf(fmaxf(l[j], -7.f), 7.f);
                        a[4 * n + j] = gg * __builtin_amdgcn_rcpf(1.f + __builtin_amdgcn_exp2f(-1.702f * 1.4426950408889634f * gg)) * (ll + 1.f); } }
                if constexpr (FP8) { u32x2 w; w.x = pk4_fp8(a[0] * 8.f, a[1] * 8.f, a[2] * 8.f, a[3] * 8.f); w.y = pk4_fp8(a[4] * 8.f, a[5] * 8.f, a[6] * 8.f, a[7] * 8.f);
                    *(u32x2*)(dst8 + (size_t)((ai * 128 + m * 16) * 1024) + lane_off) = w; }
                else { u32x4 w; w.x = cvtpk(a[0], a[1]); w.y = cvtpk(a[2], a[3]); w.z = cvtpk(a[4], a[5]); w.w = cvtpk(a[6], a[7]);
                    *(u32x4*)((char*)dst + (size_t)((ai * 128 + m * 16) * 2048) + lane_off * 2u) = w; } }
    }
};
struct ProbMoe2 {
    static constexpr bool PERM = true, GATHER = false, FP8 = MOE_FP8 != 0; int K, lda; const bf16_t* ACT; const bf16_t* W2; const float* B2; bf16_t* Y; MoeSched ms;
    __device__ bool next(int i, Unit& u) const { return ms.map(i, u); }
    __device__ const void* a_mat() const { return ACT; } __device__ const void* b_mat() const { return W2; }
    __device__ unsigned a_off(const Unit& u) const { return (unsigned)u.pm * 256u * 1024u * (FP8 ? 1u : 2u); }
    __device__ unsigned b_off(const Unit& u) const { return ((unsigned)u.e * 1024u + (unsigned)u.pn * 256u) * 1024u * (FP8 ? 1u : 2u); }
    __device__ void a_voff(const Unit&, unsigned (&)[2][2]) const {}
    __device__ void epi(const Acc& acc, const Unit& u, int wr, int wc, int fr, int fq) const {
        constexpr float SC = FP8 ? (1.f / 512.f) : 1.f;
#if Y_FP8
        const int row0 = wr * 64 + fr, col0 = wc * 32 + 8 * fq; const float* bias = B2 + (size_t)u.e * 1024 + u.pn * 256 + col0;
        f32x4 bv[2][2];
#pragma unroll
        for (int bj = 0; bj < 2; ++bj)
#pragma unroll
            for (int n = 0; n < 2; ++n) bv[bj][n] = *(const f32x4*)(bias + bj * 128 + 4 * n);
        unsigned char* dst = (unsigned char*)Y + ((size_t)u.pm * 256) * 1024 + u.pn * 256; const unsigned lane_off = (unsigned)(row0 * 1024 + col0);
#pragma unroll
        for (int ai = 0; ai < 2; ++ai)
#pragma unroll
            for (int m = 0; m < 4; ++m) { unsigned char* rowb = dst + (size_t)((ai * 128 + m * 16) * 1024);
#pragma unroll
                for (int bj = 0; bj < 2; ++bj) { const f32x4 v0 = (acc[ai][bj][m][0] * SC + bv[bj][0]) * 16.f, v1 = (acc[ai][bj][m][1] * SC + bv[bj][1]) * 16.f;
                    u32x2 w; w.x = pk4_fp8(v0[0], v0[1], v0[2], v0[3]); w.y = pk4_fp8(v1[0], v1[1], v1[2], v1[3]);
                    *(u32x2*)(rowb + lane_off + bj * 128) = w; } }
#else
        pg8::epi_store_bf16<false>(acc, Y + (size_t)u.pm * 256 * 1024 + u.pn * 256, 1024, B2 + (size_t)u.e * 1024 + u.pn * 256, wr, wc, fr, fq, SC);
#endif
    }
};

__global__ void __launch_bounds__(512, 2) fwd_kernel(Args args) {
    extern __shared__ __attribute__((aligned(16))) uchar lds_raw[];
    const int wave_s = __builtin_amdgcn_readfirstlane((int)threadIdx.x >> 6);
    Frame F; F.lds = (LAS uchar*)lds_raw; F.tid = tid_fresh(wave_s); F.lane = F.tid & 63; F.wave = wave_s; F.G = gridDim.x; F.bid = blockIdx.x;
    F.ws = args.ws; F.out = args.out;
    volatile LAS unsigned* MISC = (volatile LAS unsigned*)(F.lds + MISC_OFF);
    if (F.tid < 64) MISC[F.tid] = 0u;
    __syncthreads();
    unsigned* ctl = (unsigned*)(F.ws + WS_CTL);
    XcdBarrier bar; bar.bar = ctl + CW_BAR; bar.x = 0; bar.st = nullptr;
    const int lo = args.ph_lo, hi = args.ph_hi;
    bar = xcd_barrier_post(ctl + CW_BAR + (lo & 1) * XCD_BAR_WORDS, MISC + 8, F.tid == 0);
#ifndef PHMASK
#define PHMASK 0x7ffff
#endif
#define REFRAME() do { F.tid = tid_fresh(wave_s); F.lane = F.tid & 63; F.wave = wave_s; } while (0)
#define IN(k) (((PHMASK >> (k)) & 1) && lo <= (k) && (k) < hi)
#define SEAM(k) do { if (IN(k) && IN((k) + 1)) { const int t_ = tid_fresh(wave_s); xcd_barrier(bar, t_ == 0); } } while (0)
    uchar* ws = F.ws;
    bf16_t* H = (bf16_t*)(ws + WS_H); bf16_t* XR = (bf16_t*)(ws + WS_XR); const float* MOD = (const float*)(ws + WS_MOD);

    if (IN(0)) { REFRAME(); p0_prologue(F); } SEAM(0);
    if (IN(1)) { REFRAME(); p_norm0(F); } SEAM(1);
    if (IN(2)) { REFRAME(); ProbIn0 p; p.K = PROJ0_FP8 ? 512 : 1024; p.lda = p.K; p.A = H; p.Bt = (const bf16_t*)(ws + WS_WIN0); p.O = (bf16_t*)(ws + WS_PBUF); p.so.init(NPAN, 8); p.G = F.G; p.c = F.bid; pg8::gemm_phase(F.lds, p, wave_s); } SEAM(2);
    if (IN(3)) { REFRAME(); p_qk_prep(F); } SEAM(3);
    if (IN(4)) { REFRAME();
        const bf16_t* P = (const bf16_t*)(ws + WS_PBUF); bf16_t* MIX = (bf16_t*)(ws + WS_MIX0);
        for (int u = F.bid; u < 1024 + 128; u += F.G) {
            if (u < 1024) { const int qb = u & 7, g = (u >> 3) & 1, kvh = (u >> 4) & 1, b = u >> 5, h = kvh * 2 + g; const size_t kr0 = (size_t)b * TPB, qr0 = kr0 + CTXL + qb * 256;
                att::attn_unit<128, 2, false, 2048, 2048, 1024>(P + qr0 * 2048 + 1024 + h * 128, P + kr0 * 2048 + 1536 + kvh * 128, nullptr, P + kr0 * 2048 + 1792 + kvh * 128, MIX + qr0 * 1024 + 512 + h * 128, TPB, (LAS char*)F.lds, nullptr, 0, wave_s);
            } else { const int v = u - 1024, h = v & 3, b = v >> 2, kvh = h >> 1; const size_t kr0 = (size_t)b * TPB;
                att::attn_unit<128, 2, false, 2048, 2048, 1024>(P + kr0 * 2048 + 1024 + h * 128, P + kr0 * 2048 + 1536 + kvh * 128, nullptr, P + kr0 * 2048 + 1792 + kvh * 128, MIX + kr0 * 1024 + 512 + h * 128, CTXL, (LAS char*)F.lds, nullptr, 0, wave_s); }
        }
        REFRAME(); p_sgu(F);
    } SEAM(4);
    if (IN(5)) { REFRAME(); ProbOut<0> p; p.K = 1024; p.lda = 1024; p.A = (const bf16_t*)(ws + WS_MIX0); p.Bt = (const bf16_t*)(ws + WS_WOUT0); p.XR = XR; p.MOD = MOD; p.xin = INP(I_X); p.cin = INP(I_CTX); p.so.init(NPAN, 4); p.G = F.G; p.c = F.bid; pg8::gemm_phase(F.lds, p, wave_s); } SEAM(5);
    if (IN(6)) { REFRAME(); p_norm_router<0>(F, args.dry); } SEAM(6);
    if (IN(7)) { REFRAME();
#if MOE_PREGATHER && MOE_FP8
        p_moe_gather(F, 0); { const int t_ = tid_fresh(wave_s); xcd_barrier(bar, t_ == 0); } REFRAME();
#endif
        moe_prefix(F, 0); ProbMoe1 p; p.K = MOE_FP8 ? 512 : 1024; p.lda = p.K; p.H = (MOE_PREGATHER && MOE_FP8) ? (const bf16_t*)(ws + WS_XS) : H; p.W1 = (const bf16_t*)(ws + WS_W1); p.B1 = INP(I_B1); p.ACT = (bf16_t*)(ws + WS_ACT); p.rowl = (const int*)(ws + WS_ROWL);
        p.cnt = (const LAS int*)(F.lds + XTRA_OFF + X_CNT); p.wave_s = wave_s; p.ms.pb = (const LAS int*)(F.lds + XTRA_OFF + X_PB); p.ms.NTN = 8; p.ms.G = F.G; p.ms.c = F.bid; pg8::gemm_phase(F.lds, p, wave_s); } SEAM(7);
    if (IN(8)) { REFRAME(); moe_prefix(F, 0); ProbMoe2 p; p.K = MOE_FP8 ? 512 : 1024; p.lda = p.K; p.ACT = (const bf16_t*)(ws + WS_ACT); p.W2 = (const bf16_t*)(ws + WS_W2); p.B2 = INP(I_B2); p.Y = (bf16_t*)(ws + WS_Y);
        p.ms.pb = (const LAS int*)(F.lds + XTRA_OFF + X_PB); p.ms.NTN = 4; p.ms.G = F.G; p.ms.c = F.bid; pg8::gemm_phase(F.lds, p, wave_s); } SEAM(8);
    if (IN(9)) { REFRAME(); p_combine_norm(F, args.dry); } SEAM(9);
    if (IN(10)) { REFRAME(); ProbIn1 p; p.K = PROJ1_FP8 ? 512 : 1024; p.lda = p.K; p.A = H; p.Bt = (const bf16_t*)(ws + WS_WIN1); p.O = (bf16_t*)(ws + WS_PBUF); p.so.init(256, 4); p.G = F.G; p.c = F.bid; pg8::gemm_phase(F.lds, p, wave_s); } SEAM(10);
    if (IN(11)) { REFRAME(); p_mla_prep(F); } SEAM(11);
    if (IN(12)) { REFRAME();
        { ProbPlain<true, UPQ_FP8 != 0> p; p.K = UPQ_FP8 ? 256 : 512; p.lda = UPQ_FP8 ? 256 : 1024; p.A = UPQ_FP8 ? (const bf16_t*)(ws + WS_CQ8) : (const bf16_t*)(ws + WS_PBUF); p.Bt = (const bf16_t*)(ws + WS_WUQ); p.O = (bf16_t*)(ws + WS_QB); p.ldc = 1536; p.so.init(256, 6); p.G = F.G; p.c = F.bid; pg8::gemm_phase(F.lds, p, wave_s); }
        { ProbPlain<false, UPKV_FP8 != 0> p; p.K = UPKV_FP8 ? 128 : 256; p.lda = UPKV_FP8 ? 128 : 1024; p.A = UPKV_FP8 ? (const bf16_t*)(ws + WS_CKV8) : (const bf16_t*)(ws + WS_PBUF) + 512; p.Bt = (const bf16_t*)(ws + WS_WUKV); p.O = (bf16_t*)(ws + WS_KVB); p.ldc = 2048; p.so.init(NPAN, 8); p.G = F.G; p.c = F.bid; pg8::gemm_phase(F.lds, p, wave_s); }
    } SEAM(12);
    if (IN(13)) { REFRAME();
        const bf16_t* Q = (const bf16_t*)(ws + WS_QB); const bf16_t* KV = (const bf16_t*)(ws + WS_KVB); const bf16_t* KR = (const bf16_t*)(ws + WS_KRB); bf16_t* MIX = (bf16_t*)(ws + WS_MIX1);
        for (int u = F.bid; u < 2048; u += F.G) { const int qb = u & 7, h = (u >> 3) & 7, b = u >> 6; const size_t kr0 = (size_t)b * TPB, qr0 = kr0 + CTXL + qb * 256;
            att::attn_unit_mla8<1536, 2048, 1024, OUT1_FP8 != 0>(Q + qr0 * 1536 + h * 192, KV + kr0 * 2048 + h * 128, KR + kr0 * 64, KV + kr0 * 2048 + 1024 + h * 128, OUT1_FP8 ? (bf16_t*)((unsigned char*)MIX + qr0 * 1024 + h * 128) : MIX + qr0 * 1024 + h * 128, TPB, (LAS char*)F.lds, (const f32x2*)(ws + WS_TABM), qb * 256, wave_s); }
    } SEAM(13);
    if (IN(14)) { REFRAME(); ProbOut<1> p; p.K = OUT1_FP8 ? 512 : 1024; p.lda = p.K; p.A = (const bf16_t*)(ws + WS_MIX1); p.Bt = (const bf16_t*)(ws + WS_WOUT1); p.XR = XR; p.MOD = MOD; p.xin = nullptr; p.cin = nullptr; p.so.init(256, 4); p.G = F.G; p.c = F.bid; pg8::gemm_phase(F.lds, p, wave_s); } SEAM(14);
    if (IN(15)) { REFRAME(); p_norm_router<1>(F, args.dry); } SEAM(15);
    if (IN(16)) { REFRAME();
#if MOE_PREGATHER && MOE_FP8
        p_moe_gather(F, 1); { const int t_ = tid_fresh(wave_s); xcd_barrier(bar, t_ == 0); } REFRAME();
#endif
        moe_prefix(F, 1); ProbMoe1 p; p.K = MOE_FP8 ? 512 : 1024; p.lda = p.K; p.H = (MOE_PREGATHER && MOE_FP8) ? (const bf16_t*)(ws + WS_XS) : H; p.W1 = (const bf16_t*)(ws + WS_W1 + (size_t)32 * 2048 * 1024 * (MOE_FP8 ? 1 : 2)); p.B1 = INP(I_B1) + 32 * 2048; p.ACT = (bf16_t*)(ws + WS_ACT); p.rowl = (const int*)(ws + WS_ROWL);
        p.cnt = (const LAS int*)(F.lds + XTRA_OFF + X_CNT); p.wave_s = wave_s; p.ms.pb = (const LAS int*)(F.lds + XTRA_OFF + X_PB); p.ms.NTN = 8; p.ms.G = F.G; p.ms.c = F.bid; pg8::gemm_phase(F.lds, p, wave_s); } SEAM(16);
    if (IN(17)) { REFRAME(); moe_prefix(F, 1); ProbMoe2 p; p.K = MOE_FP8 ? 512 : 1024; p.lda = p.K; p.ACT = (const bf16_t*)(ws + WS_ACT); p.W2 = (const bf16_t*)(ws + WS_W2 + (size_t)32 * 1024 * 1024 * (MOE_FP8 ? 1 : 2)); p.B2 = INP(I_B2) + 32 * 1024; p.Y = (bf16_t*)(ws + WS_Y);
        p.ms.pb = (const LAS int*)(F.lds + XTRA_OFF + X_PB); p.ms.NTN = 4; p.ms.G = F.G; p.ms.c = F.bid; pg8::gemm_phase(F.lds, p, wave_s); } SEAM(17);
    if (IN(18)) { REFRAME(); p_final(F); }
#undef IN
#undef SEAM
}

extern "C" void kernel_launch(void* const* d_in, const int* in_sizes, int n_in, void* d_out, int out_size, void* d_ws, size_t ws_size, hipStream_t stream) {
    static int grid = 0;
    if (grid == 0) {
        if (n_in != 28 || out_size != NBATCH * SEQ * DM || ws_size < WS_END) { fprintf(stderr, "kernel_launch: unexpected shapes (n_in %d out %d ws %zu, need ws >= %zu)\n", n_in, out_size, ws_size, (size_t)WS_END); grid = -1; return; }
        int dev = 0, cus = 0, per_cu = 0;
        if (hipGetDevice(&dev) != hipSuccess || hipDeviceGetAttribute(&cus, hipDeviceAttributeMultiprocessorCount, dev) != hipSuccess) { grid = -1; return; }
        if (hipFuncSetAttribute((const void*)fwd_kernel, hipFuncAttributeMaxDynamicSharedMemorySize, LDS_BYTES) != hipSuccess) { fprintf(stderr, "kernel_launch: hipFuncSetAttribute failed\n"); grid = -1; return; }
        if (hipOccupancyMaxActiveBlocksPerMultiprocessor(&per_cu, (const void*)fwd_kernel, 512, LDS_BYTES) != hipSuccess || per_cu < 1) { fprintf(stderr, "kernel_launch: occupancy query says %d blocks/CU\n", per_cu); }
        (void)hipGetLastError();
        grid = cus;
    }
    if (grid < 0) return;
    (void)hipMemsetAsync((char*)d_ws + WS_CTL, 0, CTL_BYTES, stream);
    Args a{};
    for (int i = 0; i < 28; ++i) a.in[i] = (const float*)d_in[i];
    a.out = (float*)d_out; a.ws = (uchar*)d_ws;
#if MK_ONE_LAUNCH
    a.ph_lo = 0; a.ph_hi = NPHASE;
    hipLaunchKernelGGL(fwd_kernel, dim3(grid), dim3(512), LDS_BYTES, stream, a);
#else
    for (int ph = 0; ph < NPHASE; ++ph) { a.ph_lo = ph; a.ph_hi = ph + 1; const int nrep = 1 + ((REPEAT_MASK >> ph) & 1); for (int rep = 0; rep < nrep; ++rep) { a.dry = (rep + 1 < nrep) ? 1 : 0; hipLaunchKernelGGL(fwd_kernel, dim3(grid), dim3(512), LDS_BYTES, stream, a); } }
#endif
}
```

```cpp
#include <hip/hip_runtime.h>
#include <cstdio>
#include <cstdint>

#ifndef MK_ONE_LAUNCH
#define MK_ONE_LAUNCH 1
#endif
#define REPEAT_MASK 0
#define USE_BUFFER_LDS 1
#define MOE_PREGATHER 0
#define PROJ0_FP8 0
#ifndef UPQ_FP8
#define UPQ_FP8 (MOE_FP8 != 0)
#endif
#ifndef UPKV_FP8
#define UPKV_FP8 0
#endif
#define UP1_FP8_UNUSED 0
#define GQA_QK_FP8 1
#define MLA_QK_FP8 1
#define OUT1_FP8 (MOE_FP8 != 0)
#define PROJ1_FP8 (MOE_FP8 != 0)
#define PROJ_FP8_UNUSED (MOE_FP8 != 0)
#define Y_FP8 1
#ifndef MOE_FP8
#define MOE_FP8 1
#endif

#define LAS __attribute__((address_space(3)))
typedef unsigned short bf16_t;
typedef unsigned char uchar;
typedef short bf16x8 __attribute__((ext_vector_type(8)));
typedef short s16x4 __attribute__((ext_vector_type(4)));
typedef float f32x2 __attribute__((ext_vector_type(2)));
typedef float f32x4 __attribute__((ext_vector_type(4)));
typedef float f32x16 __attribute__((ext_vector_type(16)));
typedef unsigned u32x2 __attribute__((ext_vector_type(2)));
typedef unsigned u32x4 __attribute__((ext_vector_type(4)));
typedef int i32x4 __attribute__((ext_vector_type(4)));
typedef int i32x8 __attribute__((ext_vector_type(8)));

constexpr int DM = 1024, NBATCH = 32, SEQ = 2048, CTXL = 256, TPB = SEQ + CTXL, NTOK = NBATCH * TPB, NPAN = NTOK / 256;
constexpr int NEXP = 32, TOPK = 4, ROWCAP = NTOK;
constexpr float EPS = 1e-6f;
constexpr int NPHASE = 19;

constexpr size_t MiB = 1u << 20;
constexpr size_t WS_CTL = 0, CTL_BYTES = 1 * MiB;
constexpr size_t WS_MOD = 1 * MiB;
constexpr size_t WS_TABG = 3 * MiB;
constexpr size_t WS_TABM = WS_TABG + 32768;
constexpr size_t WS_WRT = WS_TABG + 65536;
constexpr size_t WS_SGUW = WS_WRT + 262144;
constexpr size_t WS_WIN0 = 4 * MiB, WS_WOUT0 = 8 * MiB, WS_WIN1 = 10 * MiB, WS_WUQ = 12 * MiB, WS_WUKV = 14 * MiB, WS_WOUT1 = 15 * MiB;
constexpr size_t WS_W1 = 17 * MiB;
constexpr size_t WS_W2 = 273 * MiB;
constexpr size_t WS_ROWL = 401 * MiB;
constexpr size_t WS_TOKI = 410 * MiB;
constexpr size_t WS_XR = 413 * MiB;
constexpr size_t WS_H = 701 * MiB;
constexpr size_t WS_SCR = 845 * MiB;
constexpr size_t WS_PBUF = WS_SCR;
constexpr size_t WS_MIX0 = WS_SCR + 288 * MiB;
constexpr size_t WS_QB = WS_SCR + 144 * MiB;
constexpr size_t WS_KVB = WS_SCR + 360 * MiB;
constexpr size_t WS_KRB = WS_SCR + 648 * MiB;
constexpr size_t WS_MIX1 = WS_SCR + 660 * MiB;
constexpr size_t WS_CQ8 = WS_SCR + 804 * MiB;
constexpr size_t WS_CKV8 = WS_SCR + 840 * MiB;
constexpr size_t WS_ACT = WS_SCR;
constexpr size_t WS_XS = WS_SCR + 296 * MiB;
constexpr size_t WS_Y = WS_SCR + 592 * MiB;
constexpr size_t WS_END = WS_SCR + 1184 * MiB;
constexpr int CW_BAR = 1024;
constexpr int CW_CNT = 8192;
constexpr int CW_DBG = 16384;

constexpr int RING_BYTES = 131072;
constexpr int XTRA_OFF = RING_BYTES, XTRA_BYTES = 20480;
constexpr int MISC_OFF = XTRA_OFF + XTRA_BYTES;
constexpr int LDS_BYTES = MISC_OFF + 512;
constexpr int X_PB = 0;
constexpr int X_CNT = 256;
constexpr int X_HIST = 512;
constexpr int X_BASE = 768;
constexpr int X_SEL = 1024;
constexpr int X_A2 = 9216;
constexpr int X_CB = 13312;
constexpr int X_RS = 13440;

#define LDS_WAIT() asm volatile("s_waitcnt lgkmcnt(0)" ::: "memory")
#define VM_WAIT() asm volatile("s_waitcnt vmcnt(0)" ::: "memory")
#define SBAR() __builtin_amdgcn_sched_barrier(0)
__device__ __forceinline__ unsigned cvtpk(float lo, float hi) { unsigned r; asm volatile("v_cvt_pk_bf16_f32 %0, %1, %2" : "=v"(r) : "v"(lo), "v"(hi)); return r; }
__device__ __forceinline__ float bf2f(unsigned short b) { return __uint_as_float(((unsigned)b) << 16); }
__device__ __forceinline__ float bflo(unsigned w) { return __uint_as_float(w << 16); }
__device__ __forceinline__ float bfhi(unsigned w) { return __uint_as_float(w & 0xffff0000u); }
__device__ __forceinline__ unsigned short f2bf(float f) { return (unsigned short)(cvtpk(f, 0.f) & 0xffffu); }
__device__ __forceinline__ unsigned pk4_fp8(float a, float b, float c, float d) {
    a = fminf(fmaxf(a, -448.f), 448.f); b = fminf(fmaxf(b, -448.f), 448.f); c = fminf(fmaxf(c, -448.f), 448.f); d = fminf(fmaxf(d, -448.f), 448.f);
    unsigned w = 0; w = __builtin_amdgcn_cvt_pk_fp8_f32(a, b, w, false); w = __builtin_amdgcn_cvt_pk_fp8_f32(c, d, w, true); return w;
}
__device__ __forceinline__ int tid_fresh(int wave_s) { int l; asm volatile("v_mbcnt_lo_u32_b32 %0, -1, 0\n\tv_mbcnt_hi_u32_b32 %0, -1, %0" : "=v"(l)); return wave_s * 64 + l; }
template <int CTRL, int BANK> __device__ __forceinline__ int dpp_i(int old, int x) { return __builtin_amdgcn_update_dpp(old, x, CTRL, 0xF, BANK, false); }
__device__ __forceinline__ int xs1(int x) { return dpp_i<0xB1, 0xF>(x, x); }
__device__ __forceinline__ int xs2(int x) { return dpp_i<0x4E, 0xF>(x, x); }
__device__ __forceinline__ int xs4(int x) { const int t = dpp_i<0x114, 0xA>(x, x); return dpp_i<0x104, 0x5>(t, x); }
__device__ __forceinline__ int xs8(int x) { return dpp_i<0x128, 0xF>(x, x); }
__device__ __forceinline__ float xf1(float x) { return __int_as_float(xs1(__float_as_int(x))); }
__device__ __forceinline__ float xf2(float x) { return __int_as_float(xs2(__float_as_int(x))); }
__device__ __forceinline__ float xf4(float x) { return __int_as_float(xs4(__float_as_int(x))); }
__device__ __forceinline__ float xf8(float x) { return __int_as_float(xs8(__float_as_int(x))); }
__device__ __forceinline__ float sum16(float a, float b) { auto r = __builtin_amdgcn_permlane16_swap(__float_as_uint(a), __float_as_uint(b), false, false); return __uint_as_float(r[0]) + __uint_as_float(r[1]); }
__device__ __forceinline__ float sum32(float a, float b) { auto r = __builtin_amdgcn_permlane32_swap(__float_as_uint(a), __float_as_uint(b), false, false); return __uint_as_float(r[0]) + __uint_as_float(r[1]); }
__device__ __forceinline__ unsigned xu16(unsigned x, int lane) { auto r = __builtin_amdgcn_permlane16_swap(x, x, false, false); return (lane & 16) ? r[0] : r[1]; }
__device__ __forceinline__ unsigned xu32(unsigned x, int lane) { auto r = __builtin_amdgcn_permlane32_swap(x, x, false, false); return (lane & 32) ? r[0] : r[1]; }
__device__ __forceinline__ float wave_sum(float v) {
    v += xf1(v); v += xf2(v); v += xf4(v); v += xf8(v); v = sum16(v, v); v = sum32(v, v);
    return v;
}
__device__ __forceinline__ float silu_f(float x) { return x / (1.f + __expf(-x)); }
__device__ __forceinline__ float gelu_tanh_f(float x) {
    const float u = x * (1.5957691216057308f + 0.07135481627260025f * x * x);
    const float e = __builtin_amdgcn_exp2f(-1.4426950408889634f * u);
    return x * __builtin_amdgcn_rcpf(1.f + e);
}

#define XB_TMO      128
#define XB_XCNT(j)  (256  + 64 * (j))
#define XB_XSUB(j)  (1280 + 64 * (j))
#define XB_XGEN(j)  (2304 + 64 * (j))
#define XB_TOP      3328
#define XB_TOPGEN   3392
#define XCD_BAR_WORDS 3456
#define XB_SPIN_CAP (1u << 20)
__device__ __forceinline__ unsigned xb_ld(unsigned* p)              { return __hip_atomic_load(p, __ATOMIC_RELAXED, __HIP_MEMORY_SCOPE_AGENT); }
__device__ __forceinline__ unsigned xb_add(unsigned* p, unsigned v) { return __hip_atomic_fetch_add(p, v, __ATOMIC_RELAXED, __HIP_MEMORY_SCOPE_AGENT); }
__device__ __forceinline__ unsigned xb_xcc_id() { return (unsigned)__builtin_amdgcn_s_getreg((3 << 11) | 20) & 0xFu; }
#define XB_SPIN(cond, bar) do { unsigned _sp = 0; while (cond) { __builtin_amdgcn_s_sleep(1); \
    if ((++_sp & 255u) == 0u) { if (xb_ld(&(bar)[XB_TMO])) break; if (_sp > XB_SPIN_CAP) { atomicAdd(&(bar)[XB_TMO], 1u); break; } } } } while (0)
struct XcdBarrier { unsigned* bar; unsigned x; volatile LAS unsigned* st; };
__device__ __forceinline__ XcdBarrier xcd_barrier_post(unsigned* bar, volatile LAS unsigned* st, bool t0) {
    XcdBarrier b; b.bar = bar; b.x = xb_xcc_id(); b.st = st;
    if (t0) (void)xb_add(&bar[XB_XCNT(b.x)], 1u);
    return b;
}
__device__ __forceinline__ void xcd_barrier_complete(unsigned* bar, unsigned x, unsigned& nloc, unsigned& nx) {
    const unsigned G = gridDim.x * gridDim.y * gridDim.z;
    unsigned sum, cnt, mine, sp = 0u;
    for (;;) {
        sum = 0u; cnt = 0u; mine = 0u;
#pragma unroll
        for (unsigned j = 0; j < 16; ++j) { const unsigned c = xb_ld(&bar[XB_XCNT(j)]); sum += c; cnt += (c > 0u) ? 1u : 0u; mine = (j == x) ? c : mine; }
        if (sum == G) break;
        __builtin_amdgcn_s_sleep(1);
        if ((++sp & 255u) == 0u) { if (xb_ld(&bar[XB_TMO])) break; if (sp > XB_SPIN_CAP) { atomicAdd(&bar[XB_TMO], 1u); break; } }
    }
    nloc = mine > 0u ? mine : 1u; nx = cnt > 0u ? cnt : 1u;
}
__device__ __forceinline__ void xcd_barrier(const XcdBarrier& b, bool t0) {
    asm volatile("s_waitcnt vmcnt(0)" ::: "memory");
    __syncthreads();
    if (t0) {
        unsigned* bar = b.bar;
        __builtin_amdgcn_s_waitcnt(0);
        unsigned nloc = b.st[0], nx = b.st[1];
        if (nloc == 0u) { xcd_barrier_complete(bar, b.x, nloc, nx); b.st[0] = nloc; b.st[1] = nx; }
        const unsigned old = xb_add(&bar[XB_XSUB(b.x)], 1u);
        const unsigned gen = old / nloc;
        if (old + 1u == (gen + 1u) * nloc) {
            __builtin_amdgcn_fence(__ATOMIC_RELEASE, "agent");
            asm volatile("s_waitcnt vmcnt(0)" ::: "memory");
            const unsigned og = xb_add(&bar[XB_TOP], 1u);
            const unsigned tg = og / nx;
            if (og + 1u == (tg + 1u) * nx) xb_add(&bar[XB_TOPGEN], 1u);
            else XB_SPIN(xb_ld(&bar[XB_TOPGEN]) == tg, bar);
            __builtin_amdgcn_fence(__ATOMIC_ACQUIRE, "agent");
            xb_add(&bar[XB_XGEN(b.x)], 1u);
            asm volatile("s_waitcnt vmcnt(0)" ::: "memory");
        } else {
            XB_SPIN(xb_ld(&bar[XB_XGEN(b.x)]) == gen, bar);
            __builtin_amdgcn_fence(__ATOMIC_ACQUIRE, "agent");
            asm volatile("s_waitcnt vmcnt(0)" ::: "memory");
        }
    }
    __syncthreads();
}

struct Args { const float* in[28]; float* out; uchar* ws; int ph_lo, ph_hi, dry, pad; };
enum { I_X = 0, I_C, I_CTX, I_CCTX, I_ADAW, I_ADAB, I_NMIXG, I_NFFNG, I_ABWIN, I_SGUNG, I_SGUW, I_SGUB, I_GQG, I_GKG, I_ABWOUT, I_MLAWIN, I_MLAQG, I_MLAKVG, I_MLAWUQ, I_MLAWUKV, I_MLAWOUT,
       I_RW, I_RB, I_W1, I_B1, I_W2, I_B2, I_FNG };
struct Frame {
    LAS uchar* lds; int tid, lane, wave, G, bid;
    uchar* ws; float* out;
};
__device__ __forceinline__ const float* INP(int i) {
    const __attribute__((address_space(4))) char* ka = (const __attribute__((address_space(4))) char*)__builtin_amdgcn_kernarg_segment_ptr();
    return *(const float* const volatile __attribute__((address_space(4)))*)(ka + i * 8);
}

namespace pg8 {
constexpr int BM = 256, BK = 64, HALF = 128, HTB = HALF * BK * 2, NXCD = 8, WGM = 8;
__device__ __forceinline__ int lds_byte(int r, int c) { const int st = (r >> 4) * 2 + (c >> 5), rr = r & 15, cc = c & 31, ob = rr * 64 + cc * 2; return st * 1024 + (ob ^ (((ob >> 9) & 1) << 5)); }
__device__ __forceinline__ void stage_rc(int b, int& R, int& C) { const int st = b / 1024, sb = b % 1024, swz = sb ^ (((sb >> 9) & 1) << 5); R = (st >> 1) * 16 + swz / 64; C = (st & 1) * 32 + (swz % 64) / 2; }
__device__ __forceinline__ int perm32(int rho) { const int n = rho >> 4, i = rho & 15; return 8 * (i >> 2) + 4 * n + (i & 3); }
struct Unit { int pm, pn, e, rb; };
struct StaticOrder {
    int nM, nN, nwg;
    __device__ void init(int nM_, int nN_) { nM = nM_; nN = nN_; nwg = nM * nN; }
    __device__ bool map(long L, int& pm, int& pn) const {
        if (L >= nwg) return false;
        int wgid = (int)L; { const int q = nwg / NXCD, r = nwg % NXCD, xcd = wgid % NXCD, off = wgid / NXCD; wgid = (xcd < r ? xcd * (q + 1) : r * (q + 1) + (xcd - r) * q) + off; }
        const int nig = WGM * nN, gid = wgid / nig, fm = gid * WGM, gsz = (nM - fm) < WGM ? (nM - fm) : WGM;
        pm = fm + ((wgid % nig) % gsz); pn = (wgid % nig) / gsz; return true;
    }
};
typedef f32x4 Acc[2][2][4][2];
template <class P>
__device__ __forceinline__ void gemm_phase(LAS uchar* lds, const P& p, int wave_s) {
    const int tid = tid_fresh(wave_s), wid = __builtin_amdgcn_readfirstlane(tid >> 6), lane = tid & 63, wr = wid >> 2, wc = wid & 3, fr = lane & 15, fq = lane >> 4;
    const int K = p.K, nt = K / BK;
    unsigned voffA[2][2], voffB[2];
#pragma unroll
    for (int i = 0; i < 2; ++i) { int R, C; stage_rc(tid * 16 + i * 8192, R, C); const int Rb = P::PERM ? ((R & ~31) + perm32(R & 31)) : R;
        voffA[0][i] = (unsigned)(R * p.lda + C) * 2u; voffA[1][i] = voffA[0][i]; voffB[i] = (unsigned)(Rb * K + C) * 2u; }
    const unsigned kstep = (unsigned)(BK * 2);
    const unsigned hstepB = (unsigned)HALF * K * 2;
    const unsigned hstepA = P::GATHER ? 0u : (unsigned)HALF * p.lda * 2;
#define PG8_VA1 voffA[P::GATHER ? 1 : 0]
    const __amdgpu_buffer_rsrc_t rsA = __builtin_amdgcn_make_buffer_rsrc((void*)p.a_mat(), 0, 0xffffffffu, 0x00020000);
    const __amdgpu_buffer_rsrc_t rsB = __builtin_amdgcn_make_buffer_rsrc((void*)p.b_mat(), 0, 0xffffffffu, 0x00020000);
    const char* gpA = (const char*)p.a_mat(); const char* gpB = (const char*)p.b_mat(); (void)gpA; (void)gpB; (void)rsA; (void)rsB;
    const unsigned ldsw = (unsigned)wid * 1024u;
    const int aoff = lds_byte(wr * 64 + fr, fq * 8), boff = lds_byte(wc * 32 + fr, fq * 8);
#define PG8_SA(b, h) (((b) * 2 + (h)) * HTB)
#define PG8_SB(b, h) ((4 + (b) * 2 + (h)) * HTB)
#if USE_BUFFER_LDS
#define PG8_STAGE_R(bufoff, rs, gp, soff, voff) do { _Pragma("unroll") for (int _i = 0; _i < 2; ++_i) \
        __builtin_amdgcn_raw_ptr_buffer_load_lds(rs, (LAS unsigned*)(lds + (bufoff) + ldsw + _i * 8192), 16, (int)(voff)[_i], (int)(soff), 0, 0); } while (0)
#else
#define PG8_STAGE_R(bufoff, rs, gp, soff, voff) do { _Pragma("unroll") for (int _i = 0; _i < 2; ++_i) \
        __builtin_amdgcn_global_load_lds((const unsigned*)((const char*)(gp) + (size_t)(soff) + (voff)[_i]), (LAS unsigned*)(lds + (bufoff) + ldsw + _i * 8192), 16, 0, 0); } while (0)
#endif
#define PG8_STAGE_A(bufoff, soff, voff) PG8_STAGE_R(bufoff, rsA, gpA, soff, voff)
#define PG8_STAGE_B(bufoff, soff, voff) PG8_STAGE_R(bufoff, rsB, gpB, soff, voff)
#define PG8_LDA(dst, b, h) do { _Pragma("unroll") for (int m = 0; m < 4; ++m) _Pragma("unroll") for (int k = 0; k < 2; ++k) dst[m][k] = *(const LAS i32x4*)(lds + PG8_SA(b, h) + aoff + m * 2048 + k * 1024); } while (0)
#define PG8_LDB(dst, b, h) do { _Pragma("unroll") for (int n = 0; n < 2; ++n) _Pragma("unroll") for (int k = 0; k < 2; ++k) dst[n][k] = *(const LAS i32x4*)(lds + PG8_SB(b, h) + boff + n * 2048 + k * 1024); } while (0)
#define PG8_CAT(x) __builtin_shufflevector((x)[0], (x)[1], 0, 1, 2, 3, 4, 5, 6, 7)
#define PG8_MMA(ai, bj, At, Bt) do { __builtin_amdgcn_s_setprio(1); \
        if constexpr (P::FP8) { _Pragma("unroll") for (int m = 0; m < 4; ++m) _Pragma("unroll") for (int n = 0; n < 2; ++n) \
            acc[ai][bj][m][n] = __builtin_amdgcn_mfma_scale_f32_16x16x128_f8f6f4(PG8_CAT(Bt[n]), PG8_CAT(At[m]), acc[ai][bj][m][n], 0, 0, 0, 0x7F7F7F7F, 0, 0x7F7F7F7F); } \
        else { _Pragma("unroll") for (int m = 0; m < 4; ++m) _Pragma("unroll") for (int n = 0; n < 2; ++n) _Pragma("unroll") for (int k = 0; k < 2; ++k) \
            acc[ai][bj][m][n] = __builtin_amdgcn_mfma_f32_16x16x32_bf16(__builtin_bit_cast(bf16x8, Bt[n][k]), __builtin_bit_cast(bf16x8, At[m][k]), acc[ai][bj][m][n], 0, 0, 0); } \
        __builtin_amdgcn_s_setprio(0); } while (0)
#define PG8_WAIT_V(n) asm volatile("s_waitcnt vmcnt(" #n ")" ::: "memory")
#define PG8_WAIT_L(n) asm volatile("s_waitcnt lgkmcnt(" #n ")" ::: "memory")
#define PG8_BAR __builtin_amdgcn_s_barrier()
#define PG8_SCHED __builtin_amdgcn_sched_barrier(0)
    Unit cur, nxt; int ui = 0;
    if (!p.next(0, cur)) return;
    Acc acc;
#pragma unroll
    for (int a = 0; a < 2; ++a)
#pragma unroll
        for (int b = 0; b < 2; ++b)
#pragma unroll
            for (int m = 0; m < 4; ++m)
#pragma unroll
                for (int n = 0; n < 2; ++n) acc[a][b][m][n] = (f32x4){0.f, 0.f, 0.f, 0.f};
    i32x4 At[4][2], B0[2][2], B1[2][2];
    unsigned cA = p.a_off(cur), cB = p.b_off(cur);
    if constexpr (P::GATHER) { p.a_voff(cur, voffA); }
    PG8_STAGE_B(PG8_SB(0, 0), cB, voffB); PG8_STAGE_B(PG8_SB(0, 1), cB + hstepB, voffB); PG8_STAGE_A(PG8_SA(0, 0), cA, voffA[0]); PG8_STAGE_A(PG8_SA(0, 1), cA + hstepA, PG8_VA1);
    if (wr == 1) PG8_BAR;
    PG8_WAIT_V(2); PG8_BAR;
    PG8_STAGE_B(PG8_SB(1, 0), cB + kstep, voffB); PG8_STAGE_A(PG8_SA(1, 0), cA + kstep, voffA[0]); PG8_STAGE_B(PG8_SB(1, 1), cB + hstepB + kstep, voffB);
    PG8_WAIT_V(6); PG8_BAR;
    for (;;) {
        const bool has_next = p.next(ui + 1, nxt);
        const unsigned nA = has_next ? p.a_off(nxt) : cA, nB = has_next ? p.b_off(nxt) : cB;
        for (int t = 0; t < nt; t += 2) {
            const bool last = (t == nt - 2);
            const unsigned a1 = cA + (unsigned)(t + 1) * kstep;
            const unsigned a2 = last ? nA : cA + (unsigned)(t + 2) * kstep, b2 = last ? nB : cB + (unsigned)(t + 2) * kstep;
            const unsigned a3 = a2 + kstep, b3 = b2 + kstep;
            PG8_LDB(B0, 0, 0); PG8_LDB(B1, 0, 1); PG8_SCHED; PG8_LDA(At, 0, 0); PG8_STAGE_A(PG8_SA(1, 1), a1 + hstepA, PG8_VA1);
            if constexpr (P::GATHER) { if (last && has_next) p.a_voff(nxt, voffA); }
            PG8_WAIT_V(8); PG8_WAIT_L(0); PG8_BAR; PG8_MMA(0, 0, At, B0); PG8_MMA(0, 1, At, B1); PG8_BAR; PG8_SCHED;
            PG8_LDA(At, 0, 1); PG8_STAGE_B(PG8_SB(0, 0), b2, voffB); PG8_STAGE_B(PG8_SB(0, 1), b2 + hstepB, voffB); PG8_STAGE_A(PG8_SA(0, 0), a2, voffA[0]);
            PG8_WAIT_V(8); PG8_WAIT_L(0); PG8_BAR; PG8_MMA(1, 0, At, B0); PG8_MMA(1, 1, At, B1); PG8_BAR; PG8_SCHED;
            PG8_LDB(B0, 1, 0); PG8_LDB(B1, 1, 1); PG8_SCHED; PG8_LDA(At, 1, 0); PG8_STAGE_A(PG8_SA(0, 1), a2 + hstepA, PG8_VA1);
            PG8_WAIT_V(8); PG8_WAIT_L(0); PG8_BAR; PG8_MMA(0, 0, At, B0); PG8_MMA(0, 1, At, B1); PG8_BAR; PG8_SCHED;
            PG8_LDA(At, 1, 1); PG8_STAGE_B(PG8_SB(1, 0), b3, voffB); PG8_STAGE_B(PG8_SB(1, 1), b3 + hstepB, voffB); PG8_STAGE_A(PG8_SA(1, 0), a3, voffA[0]);
            PG8_WAIT_V(8); PG8_WAIT_L(0); PG8_BAR; PG8_MMA(1, 0, At, B0); PG8_MMA(1, 1, At, B1); PG8_BAR; PG8_SCHED;
        }
        if (wr == 0) PG8_BAR;
        p.epi(acc, cur, wr, wc, fr, fq);
        if (!has_next) break;
#pragma unroll
        for (int a = 0; a < 2; ++a)
#pragma unroll
            for (int b = 0; b < 2; ++b)
#pragma unroll
                for (int m = 0; m < 4; ++m)
#pragma unroll
                    for (int n = 0; n < 2; ++n) acc[a][b][m][n] = (f32x4){0.f, 0.f, 0.f, 0.f};
        cur = nxt; cA = nA; cB = nB; ++ui;
        if (wr == 1) PG8_BAR;
    }
    PG8_WAIT_V(0);
    PG8_BAR;
#undef PG8_SA
#undef PG8_VA1
#undef PG8_SB
#undef PG8_STAGE_R
#undef PG8_STAGE_A
#undef PG8_STAGE_B
#undef PG8_LDA
#undef PG8_LDB
#undef PG8_MMA
#undef PG8_CAT
#undef PG8_WAIT_V
#undef PG8_WAIT_L
#undef PG8_BAR
#undef PG8_SCHED
}

template <bool GELU>
__device__ __forceinline__ void epi_store_bf16(const Acc& acc, bf16_t* dst  , int ldc, const float* bias  , int wr, int wc, int fr, int fq, float sc = 1.f) {
    const int row0 = wr * 64 + fr, col0 = wc * 32 + 8 * fq;
    f32x4 bv[2][2];
#pragma unroll
    for (int bj = 0; bj < 2; ++bj)
#pragma unroll
        for (int n = 0; n < 2; ++n) bv[bj][n] = bias ? *(const f32x4*)(bias + col0 + bj * HALF + 4 * n) : (f32x4){0.f, 0.f, 0.f, 0.f};
    const unsigned lane_off = (unsigned)(row0 * ldc + col0) * 2u;
#pragma unroll
    for (int ai = 0; ai < 2; ++ai)
#pragma unroll
        for (int m = 0; m < 4; ++m) { char* rowb = (char*)dst + (size_t)((ai * HALF + m * 16) * ldc) * 2;
#pragma unroll
            for (int bj = 0; bj < 2; ++bj) { f32x4 v0 = acc[ai][bj][m][0] * sc + bv[bj][0], v1 = acc[ai][bj][m][1] * sc + bv[bj][1];
                if (GELU) {
#pragma unroll
                    for (int j = 0; j < 4; ++j) { v0[j] = gelu_tanh_f(v0[j]); v1[j] = gelu_tanh_f(v1[j]); } }
                u32x4 w; w.x = cvtpk(v0[0], v0[1]); w.y = cvtpk(v0[2], v0[3]); w.z = cvtpk(v1[0], v1[1]); w.w = cvtpk(v1[2], v1[3]);
                *(u32x4*)(rowb + lane_off + bj * HALF * 2) = w; } }
}
}

namespace att {
constexpr int NW = 8, QBLK = 32, KVBLK = 64;
constexpr int SHM_V = KVBLK * 128 * 2;
constexpr float THR = 8.f;
__device__ __forceinline__ int crow(int r, int hi) { return (r & 3) + 8 * (r >> 2) + 4 * hi; }
template <int DQK> struct Cfg { static constexpr float SCALE = (DQK == 128) ? 0.088388347648318440f : 0.072168783648703220f; static constexpr int KP = DQK * 2, SHM_K = KVBLK * DQK * 2, ND = DQK / 16; };
#define KSWZ(PITCH, row, colB) ((row) * (PITCH) + ((colB) ^ (((row) & 7) << 4)))
template <int DQK, int QS = 1> __device__ __forceinline__ void partialSM(f32x16& p0, f32x16& p1, float& m_reg, float& mn, float& alpha) {
    constexpr float SCALE = Cfg<DQK>::SCALE / (float)QS, C = SCALE * 1.4426950408889634f;
    float pmax = p0[0];
#pragma unroll
    for (int r = 1; r < 16; ++r) pmax = fmaxf(pmax, p0[r]);
#pragma unroll
    for (int r = 0; r < 16; ++r) pmax = fmaxf(pmax, p1[r]);
    { auto rr = __builtin_amdgcn_permlane32_swap(__float_as_uint(pmax), __float_as_uint(pmax), false, false);
      pmax = fmaxf(__uint_as_float(rr[0]), __uint_as_float(rr[1])); }
    if (__builtin_expect(__all(pmax - m_reg <= THR / SCALE), 1)) { mn = m_reg; alpha = 1.f; }
    else { mn = fmaxf(m_reg, pmax); alpha = __builtin_amdgcn_exp2f((m_reg - mn) * C); m_reg = mn; }
    const float mnC = -mn * C;
#pragma unroll
    for (int r = 0; r < 16; ++r) p0[r] = fmaf(p0[r], C, mnC);
#pragma unroll
    for (int r = 0; r < 16; ++r) p1[r] = fmaf(p1[r], C, mnC);
#pragma unroll
    for (int r = 0; r < 16; ++r) p0[r] = __builtin_amdgcn_exp2f(p0[r]);
}
__device__ __forceinline__ void finishSM(f32x16& p0, f32x16& p1, float alpha, float& l_reg, bf16x8& pa0, bf16x8& pa1, bf16x8& pa2, bf16x8& pa3) {
#pragma unroll
    for (int r = 0; r < 16; ++r) p1[r] = __builtin_amdgcn_exp2f(p1[r]);
    float ps = 0;
#pragma unroll
    for (int r = 0; r < 16; ++r) ps += p0[r];
#pragma unroll
    for (int r = 0; r < 16; ++r) ps += p1[r];
    { auto rr = __builtin_amdgcn_permlane32_swap(__float_as_uint(ps), __float_as_uint(ps), false, false);
      ps = __uint_as_float(rr[0]) + __uint_as_float(rr[1]); }
    l_reg = l_reg * alpha + ps;
#define PK4(P, BASE, OUT) do { unsigned a0 = cvtpk(P[BASE + 0], P[BASE + 1]), a1 = cvtpk(P[BASE + 2], P[BASE + 3]);   \
    unsigned b0 = cvtpk(P[BASE + 4], P[BASE + 5]), b1 = cvtpk(P[BASE + 6], P[BASE + 7]);                              \
    auto r0 = __builtin_amdgcn_permlane32_swap(a0, b0, false, false); auto r1 = __builtin_amdgcn_permlane32_swap(a1, b1, false, false); \
    u32x4 w = {r0[0], r1[0], r0[1], r1[1]}; OUT = *reinterpret_cast<bf16x8*>(&w); } while (0)
    PK4(p0, 0, pa0); PK4(p0, 8, pa1); PK4(p1, 0, pa2); PK4(p1, 8, pa3);
#undef PK4
}
template <int DQK> __device__ __forceinline__ void qkt(f32x16& p0, f32x16& p1, const LAS char* Ks, const bf16x8* qr, int r32, int hi) {
    constexpr int KP = Cfg<DQK>::KP, ND = Cfg<DQK>::ND;
    p0 = f32x16{}; p1 = f32x16{};
#pragma unroll
    for (int d0 = 0; d0 < ND; ++d0) { const int cb = (d0 * 16 + hi * 8) * 2;
        bf16x8 b0 = *reinterpret_cast<const LAS bf16x8*>(Ks + KSWZ(KP, r32, cb));
        bf16x8 b1 = *reinterpret_cast<const LAS bf16x8*>(Ks + KSWZ(KP, 32 + r32, cb));
        p0 = __builtin_amdgcn_mfma_f32_32x32x16_bf16(b0, qr[d0], p0, 0, 0, 0);
        p1 = __builtin_amdgcn_mfma_f32_32x32x16_bf16(b1, qr[d0], p1, 0, 0, 0); }
}
__device__ __forceinline__ int v_st(int k, int c) { const int kk = (k & ~0xC) | ((k & 4) << 1) | ((k & 8) >> 1); return ((kk >> 3) * 4 + (c >> 5)) * 512 + ((kk & 7) * 32 + (c & 31)) * 2; }
__device__ __forceinline__ int v_rd_base(int lane) { return ((lane & 3) << 3) | (((lane >> 2) & 3) << 6) | (((lane >> 4) & 1) << 5) | (((lane >> 5) & 1) << 8); }
constexpr int v_rd_off(int d0, int ks, int half) { return d0 * 512 + ks * 4096 + half * 2048; }
template <int OFF> __device__ __forceinline__ s16x4 tr_read(int vb) {
    s16x4 r; asm volatile("ds_read_b64_tr_b16 %0, %1 offset:%2" : "=&v"(r) : "v"(vb), "i"(OFF) : "memory"); return r;
}
template <int D0> __device__ __forceinline__ void pv_one(f32x16& od, int vb, bf16x8 pa0, bf16x8 pa1, bf16x8 pa2, bf16x8 pa3) {
    const s16x4 l0 = tr_read<v_rd_off(D0, 0, 0)>(vb), h0 = tr_read<v_rd_off(D0, 0, 1)>(vb), l1 = tr_read<v_rd_off(D0, 1, 0)>(vb), h1 = tr_read<v_rd_off(D0, 1, 1)>(vb);
    const s16x4 l2 = tr_read<v_rd_off(D0, 2, 0)>(vb), h2 = tr_read<v_rd_off(D0, 2, 1)>(vb), l3 = tr_read<v_rd_off(D0, 3, 0)>(vb), h3 = tr_read<v_rd_off(D0, 3, 1)>(vb);
    asm volatile("s_waitcnt lgkmcnt(0)" ::: "memory"); SBAR();
#define PK(L, H) (bf16x8){L[0], L[1], L[2], L[3], H[0], H[1], H[2], H[3]}
    od = __builtin_amdgcn_mfma_f32_32x32x16_bf16(pa0, PK(l0, h0), od, 0, 0, 0);
    od = __builtin_amdgcn_mfma_f32_32x32x16_bf16(pa1, PK(l1, h1), od, 0, 0, 0);
    od = __builtin_amdgcn_mfma_f32_32x32x16_bf16(pa2, PK(l2, h2), od, 0, 0, 0);
    od = __builtin_amdgcn_mfma_f32_32x32x16_bf16(pa3, PK(l3, h3), od, 0, 0, 0);
#undef PK
}
__device__ __forceinline__ void pv_d0(f32x16* o, int vb, bf16x8 pa0, bf16x8 pa1, bf16x8 pa2, bf16x8 pa3) {
    pv_one<0>(o[0], vb, pa0, pa1, pa2, pa3); pv_one<1>(o[1], vb, pa0, pa1, pa2, pa3); pv_one<2>(o[2], vb, pa0, pa1, pa2, pa3); pv_one<3>(o[3], vb, pa0, pa1, pa2, pa3);
}
__device__ __forceinline__ bf16x8 ld8(const bf16_t* p) { return *reinterpret_cast<const bf16x8*>(p); }
__device__ __forceinline__ void rope_frag(bf16x8& a, bf16x8& b, const f32x2* tab) {
    u32x4 wa = *reinterpret_cast<u32x4*>(&a), wb = *reinterpret_cast<u32x4*>(&b), oa, ob;
#pragma unroll
    for (int q = 0; q < 4; ++q) {
        const float x1l = bflo(wa[q]), x1h = bfhi(wa[q]), x2l = bflo(wb[q]), x2h = bfhi(wb[q]);
        const f32x2 t0 = tab[2 * q], t1 = tab[2 * q + 1];
        oa[q] = cvtpk(x1l * t0.x - x2l * t0.y, x1h * t1.x - x2h * t1.y);
        ob[q] = cvtpk(x2l * t0.x + x1l * t0.y, x2h * t1.x + x1h * t1.y);
    }
    a = *reinterpret_cast<bf16x8*>(&oa); b = *reinterpret_cast<bf16x8*>(&ob);
}
template <int DQK, int SDEPTH, bool MLA, int ldq, int ldkv, int ldo, bool OUT8 = false>
__device__ __forceinline__ void attn_unit(const bf16_t* __restrict__ Qb, const bf16_t* __restrict__ Kh, const bf16_t* __restrict__ KRh, const bf16_t* __restrict__ Vh,
                                          bf16_t* __restrict__ Ob, int seq, LAS char* lds, const f32x2* __restrict__ tabm, int qt0, int wave_s) {
    constexpr int KP = Cfg<DQK>::KP, SHM_K = Cfg<DQK>::SHM_K, ND = Cfg<DQK>::ND;
    const int tid = tid_fresh(wave_s), wid = tid >> 6, lane = tid & 63, r32 = lane & 31, hi = lane >> 5;
    LAS char* V_lds = lds; LAS char* K_lds = lds + 2 * SHM_V;
    LAS float* wsl = (LAS float*)(lds + 2 * SHM_V + 2 * SHM_K) + wid * 64; LAS float* li_l = wsl; LAS float* al_l = wsl + 32;
    float m_reg = -1e30f, l_reg = 0; f32x16 o[4] = {}; bf16x8 qr[ND];
    const bf16_t* Qw = Qb + (long)(wid * QBLK + r32) * ldq + hi * 8;
#pragma unroll
    for (int d0 = 0; d0 < ND; ++d0) qr[d0] = ld8(Qw + d0 * 16);
    if constexpr (MLA) {
        const int t = qt0 + wid * QBLK + r32, prow = t >> 6, pcol = t & 63;
        rope_frag(qr[8], qr[9], tabm + prow * 16 + hi * 8);
        rope_frag(qr[10], qr[11], tabm + pcol * 16 + hi * 8);
    }
    const int sr = tid >> 4, sc = (tid & 15) * 8, vst0 = v_st(sr, sc), vst1 = v_st(32 + sr, sc);
    const int krr = tid >> 3, krc = (tid & 7) * 8;
    const int vb0 = (int)(unsigned)(uintptr_t)V_lds + v_rd_base(lane);
    struct { bf16x8 vs0, vs1, ks0, ks1, kr; } sr_[SDEPTH];
#define SLOAD(i, k0) do { sr_[i].vs0 = ld8(&Vh[(long)((k0) + sr) * ldkv + sc]); sr_[i].vs1 = ld8(&Vh[(long)((k0) + 32 + sr) * ldkv + sc]); \
    sr_[i].ks0 = ld8(&Kh[(long)((k0) + sr) * ldkv + sc]); sr_[i].ks1 = ld8(&Kh[(long)((k0) + 32 + sr) * ldkv + sc]); \
    if constexpr (MLA) sr_[i].kr = ld8(&KRh[(long)((k0) + krr) * 64 + krc]); } while (0)
#define SWRITE(b, i) do { *(LAS bf16x8*)(V_lds + (b) * SHM_V + vst0) = sr_[i].vs0;          \
    *(LAS bf16x8*)(V_lds + (b) * SHM_V + vst1) = sr_[i].vs1; const int kc = sc * 2;               \
    *(LAS bf16x8*)(K_lds + (b) * SHM_K + KSWZ(KP, sr, kc)) = sr_[i].ks0;                       \
    *(LAS bf16x8*)(K_lds + (b) * SHM_K + KSWZ(KP, 32 + sr, kc)) = sr_[i].ks1;                  \
    if constexpr (MLA) *(LAS bf16x8*)(K_lds + (b) * SHM_K + KSWZ(KP, krr, 256 + krc * 2)) = sr_[i].kr; } while (0)
#define SWAIT() do { if constexpr (SDEPTH == 2) { if constexpr (MLA) asm volatile("s_waitcnt vmcnt(5)" ::: "memory"); else asm volatile("s_waitcnt vmcnt(4)" ::: "memory"); } else asm volatile("s_waitcnt vmcnt(0)" ::: "memory"); } while (0)
#define RESC(a) do { if (__any((a) < 1.f)) { if (hi == 0) al_l[r32] = (a); asm volatile("s_waitcnt lgkmcnt(0)" ::: "memory"); \
    _Pragma("unroll") for (int d = 0; d < 4; ++d) _Pragma("unroll") for (int r = 0; r < 16; ++r) o[d][r] *= al_l[crow(r, hi)]; } } while (0)
    bf16x8 pa0, pa1, pa2, pa3; const int NT = seq / KVBLK;
    if constexpr (MLA) {
        f32x16 p0, p1; float mn, al;
        SLOAD(0, 0); asm volatile("s_waitcnt vmcnt(0)" ::: "memory"); SWRITE(0, 0); SLOAD(0, KVBLK); __syncthreads();
        for (int j = 0; j < NT; ++j) {
            const int cb = j & 1;
            if (j + 1 < NT) { asm volatile("s_waitcnt vmcnt(0)" ::: "memory"); SWRITE(cb ^ 1, 0); if (j + 2 < NT) SLOAD(0, (j + 2) * KVBLK); }
            SBAR(); qkt<DQK>(p0, p1, K_lds + cb * SHM_K, qr, r32, hi);
            partialSM<DQK>(p0, p1, m_reg, mn, al); RESC(al);
            finishSM(p0, p1, al, l_reg, pa0, pa1, pa2, pa3); SBAR();
            pv_d0(o, vb0 + cb * SHM_V, pa0, pa1, pa2, pa3);
            __syncthreads();
        }
    } else {
    f32x16 pA0, pA1, pB0, pB1; float mnA, mnB, alA, alB;
    constexpr int SE = 0, SO = SDEPTH - 1;
    SLOAD(SE, 0); asm volatile("s_waitcnt vmcnt(0)" ::: "memory"); SWRITE(0, SE); __syncthreads();
    qkt<DQK>(pA0, pA1, K_lds, qr, r32, hi); partialSM<DQK>(pA0, pA1, m_reg, mnA, alA);
    SLOAD(SO, KVBLK); if constexpr (SDEPTH == 2) { if (2 < NT) SLOAD(SE, 2 * KVBLK); }
    SWAIT(); SWRITE(1, SO); __syncthreads();
    for (int j = 1; j + 1 < NT; j += 2) {
        SBAR(); qkt<DQK>(pB0, pB1, K_lds + SHM_K, qr, r32, hi);
        finishSM(pA0, pA1, alA, l_reg, pa0, pa1, pa2, pa3); SBAR();
        SLOAD(SO, (j + SDEPTH) * KVBLK); SBAR();
        pv_d0(o, vb0, pa0, pa1, pa2, pa3); partialSM<DQK>(pB0, pB1, m_reg, mnB, alB);
        __syncthreads(); SWAIT(); SWRITE(0, SE);
        RESC(alB); __syncthreads();
        SBAR(); qkt<DQK>(pA0, pA1, K_lds, qr, r32, hi);
        finishSM(pB0, pB1, alB, l_reg, pa0, pa1, pa2, pa3); SBAR();
        if (SDEPTH == 1 || j + 3 < NT) SLOAD(SE, (j + 1 + SDEPTH) * KVBLK); SBAR();
        pv_d0(o, vb0 + SHM_V, pa0, pa1, pa2, pa3); partialSM<DQK>(pA0, pA1, m_reg, mnA, alA);
        __syncthreads(); SWAIT(); SWRITE(1, SO);
        RESC(alA); __syncthreads();
    }
    SBAR(); qkt<DQK>(pB0, pB1, K_lds + SHM_K, qr, r32, hi);
    finishSM(pA0, pA1, alA, l_reg, pa0, pa1, pa2, pa3); SBAR();
    pv_d0(o, vb0, pa0, pa1, pa2, pa3); partialSM<DQK>(pB0, pB1, m_reg, mnB, alB);
    __syncthreads(); RESC(alB);
    finishSM(pB0, pB1, alB, l_reg, pa0, pa1, pa2, pa3); SBAR();
    pv_d0(o, vb0 + SHM_V, pa0, pa1, pa2, pa3);
    }
    if (hi == 0) li_l[r32] = l_reg; asm volatile("s_waitcnt lgkmcnt(0)" ::: "memory");
    float rli[16];
#pragma unroll
    for (int r = 0; r < 16; ++r) rli[r] = __builtin_amdgcn_rcpf(li_l[crow(r, hi)]);
    bf16_t* Ow = OUT8 ? (bf16_t*)((unsigned char*)Ob + (long)(wid * QBLK) * ldo) : Ob + (long)(wid * QBLK) * ldo;
#pragma unroll
    for (int r = 0; r < 16; ++r) { const int orow = crow(r, hi);
#pragma unroll
        for (int d0 = 0; d0 < 4; ++d0) { if constexpr (OUT8) ((unsigned char*)Ow)[(long)orow * ldo + d0 * 32 + r32] = (unsigned char)(pk4_fp8(o[d0][r] * rli[r] * 16.f, 0.f, 0.f, 0.f) & 0xffu);
            else Ow[(long)orow * ldo + d0 * 32 + r32] = f2bf(o[d0][r] * rli[r]); } }
    __syncthreads();
#undef SLOAD
#undef SWRITE
#undef SWAIT
#undef RESC
}
template <int KP> __device__ __forceinline__ int kswz8(int row, int byte) { return row * KP + ((((byte >> 4) ^ (KP == 192 ? ((row >> 2) & 3) : ((row >> 1) & 7)))) << 4) + (byte & 15); }
__device__ __forceinline__ u32x2 bf8_to_fp8x4(bf16x8 v) { const u32x4 w = *reinterpret_cast<const u32x4*>(&v);
    return (u32x2){pk4_fp8(bflo(w.x) * 4.f, bfhi(w.x) * 4.f, bflo(w.y) * 4.f, bfhi(w.y) * 4.f), pk4_fp8(bflo(w.z) * 4.f, bfhi(w.z) * 4.f, bflo(w.w) * 4.f, bfhi(w.w) * 4.f)}; }
template <int DQ, bool ROPEQ, int ldq, int ldkv, int ldo, bool OUT8>
__device__ __forceinline__ void attn_unit_qk8(const bf16_t* __restrict__ Qb, const bf16_t* __restrict__ Kh, const bf16_t* __restrict__ KRh, const bf16_t* __restrict__ Vh,
                                               bf16_t* __restrict__ Ob, int seq, LAS char* lds, const f32x2* __restrict__ tabm, int qt0, int wave_s) {
    constexpr int SHM_K8 = KVBLK * DQ, NS = DQ / 64;
    const int tid = tid_fresh(wave_s), wid = tid >> 6, lane = tid & 63, r32 = lane & 31, hi = lane >> 5;
    LAS char* V_lds = lds; LAS char* K_lds = lds + 2 * SHM_V;
    LAS float* wsl = (LAS float*)(lds + 2 * SHM_V + 2 * SHM_K8) + wid * 64; LAS float* li_l = wsl; LAS float* al_l = wsl + 32;
    float m_reg = -1e30f, l_reg = 0; f32x16 o[4] = {}; i32x8 q8[NS];
    {
        const bf16_t* Qw = Qb + (long)(wid * QBLK + r32) * ldq + hi * 32;
        const int t = qt0 + wid * QBLK + r32; const f32x2* tb = ROPEQ ? tabm + (hi ? (t & 63) : (t >> 6)) * 16 : nullptr;
#pragma unroll
        for (int s3 = 0; s3 < NS; ++s3) { bf16x8 c0 = ld8(Qw + s3 * 64), c1 = ld8(Qw + s3 * 64 + 8), c2 = ld8(Qw + s3 * 64 + 16), c3 = ld8(Qw + s3 * 64 + 24);
            if constexpr (ROPEQ) { if (s3 == 2) { rope_frag(c0, c2, tb); rope_frag(c1, c3, tb + 8); } }
            const u32x2 a = bf8_to_fp8x4(c0), b = bf8_to_fp8x4(c1), c = bf8_to_fp8x4(c2), d = bf8_to_fp8x4(c3);
            q8[s3] = (i32x8){(int)a.x, (int)a.y, (int)b.x, (int)b.y, (int)c.x, (int)c.y, (int)d.x, (int)d.y}; }
    }
    const int sr = tid >> 4, sc = (tid & 15) * 8, vst0 = v_st(sr, sc), vst1 = v_st(32 + sr, sc);
    const int krr = tid >> 3, krc = (tid & 7) * 8;
    const int kst0 = kswz8<DQ>(sr, sc), kst1 = kswz8<DQ>(32 + sr, sc), kstr = DQ == 192 ? kswz8<DQ>(krr, 128 + krc) : 0;
    const int vb0 = (int)(unsigned)(uintptr_t)V_lds + v_rd_base(lane);
    bf16x8 vs0, vs1, ks0, ks1, kr;
#define SLOAD8(k0) do { vs0 = ld8(&Vh[(long)((k0) + sr) * ldkv + sc]); vs1 = ld8(&Vh[(long)((k0) + 32 + sr) * ldkv + sc]); \
    ks0 = ld8(&Kh[(long)((k0) + sr) * ldkv + sc]); ks1 = ld8(&Kh[(long)((k0) + 32 + sr) * ldkv + sc]); if constexpr (DQ == 192) kr = ld8(&KRh[(long)((k0) + krr) * 64 + krc]); } while (0)
#define SWRITE8(b) do { *(LAS bf16x8*)(V_lds + (b) * SHM_V + vst0) = vs0; *(LAS bf16x8*)(V_lds + (b) * SHM_V + vst1) = vs1; \
    *(LAS u32x2*)(K_lds + (b) * SHM_K8 + kst0) = bf8_to_fp8x4(ks0); *(LAS u32x2*)(K_lds + (b) * SHM_K8 + kst1) = bf8_to_fp8x4(ks1); if constexpr (DQ == 192) *(LAS u32x2*)(K_lds + (b) * SHM_K8 + kstr) = bf8_to_fp8x4(kr); } while (0)
#define RESC8(a) do { if (__any((a) < 1.f)) { if (hi == 0) al_l[r32] = (a); asm volatile("s_waitcnt lgkmcnt(0)" ::: "memory"); \
    _Pragma("unroll") for (int d = 0; d < 4; ++d) _Pragma("unroll") for (int r = 0; r < 16; ++r) o[d][r] *= al_l[crow(r, hi)]; } } while (0)
    bf16x8 pa0, pa1, pa2, pa3; const int NT = seq / KVBLK; f32x16 p0, p1; float mn, al;
    SLOAD8(0); asm volatile("s_waitcnt vmcnt(0)" ::: "memory"); SWRITE8(0); SLOAD8(KVBLK); __syncthreads();
    for (int j = 0; j < NT; ++j) {
        const int cb = j & 1;
        if (j + 1 < NT) { asm volatile("s_waitcnt vmcnt(0)" ::: "memory"); SWRITE8(cb ^ 1); if (j + 2 < NT) SLOAD8((j + 2) * KVBLK); }
        SBAR();
        { const LAS char* Ks = K_lds + cb * SHM_K8; p0 = f32x16{}; p1 = f32x16{};
#pragma unroll
          for (int s3 = 0; s3 < NS; ++s3) { const int b0 = 64 * s3 + 32 * hi;
              const i32x4 a0 = *(const LAS i32x4*)(Ks + kswz8<DQ>(r32, b0)), a1 = *(const LAS i32x4*)(Ks + kswz8<DQ>(r32, b0 + 16));
              const i32x4 c0 = *(const LAS i32x4*)(Ks + kswz8<DQ>(32 + r32, b0)), c1 = *(const LAS i32x4*)(Ks + kswz8<DQ>(32 + r32, b0 + 16));
              p0 = __builtin_amdgcn_mfma_scale_f32_32x32x64_f8f6f4(__builtin_shufflevector(a0, a1, 0, 1, 2, 3, 4, 5, 6, 7), q8[s3], p0, 0, 0, 0, 0x7F7F7F7F, 0, 0x7F7F7F7F);
              p1 = __builtin_amdgcn_mfma_scale_f32_32x32x64_f8f6f4(__builtin_shufflevector(c0, c1, 0, 1, 2, 3, 4, 5, 6, 7), q8[s3], p1, 0, 0, 0, 0x7F7F7F7F, 0, 0x7F7F7F7F); } }
        partialSM<DQ, 16>(p0, p1, m_reg, mn, al); RESC8(al);
        finishSM(p0, p1, al, l_reg, pa0, pa1, pa2, pa3); SBAR();
        pv_d0(o, vb0 + cb * SHM_V, pa0, pa1, pa2, pa3);
        __syncthreads();
    }
    if (hi == 0) li_l[r32] = l_reg; asm volatile("s_waitcnt lgkmcnt(0)" ::: "memory");
    float rli[16];
#pragma unroll
    for (int r = 0; r < 16; ++r) rli[r] = __builtin_amdgcn_rcpf(li_l[crow(r, hi)]);
    bf16_t* Ow = OUT8 ? (bf16_t*)((unsigned char*)Ob + (long)(wid * QBLK) * ldo) : Ob + (long)(wid * QBLK) * ldo;
#pragma unroll
    for (int r = 0; r < 16; ++r) { const int orow = crow(r, hi);
#pragma unroll
        for (int d0 = 0; d0 < 4; ++d0) { if constexpr (OUT8) ((unsigned char*)Ow)[(long)orow * ldo + d0 * 32 + r32] = (unsigned char)(pk4_fp8(o[d0][r] * rli[r] * 16.f, 0.f, 0.f, 0.f) & 0xffu);
            else Ow[(long)orow * ldo + d0 * 32 + r32] = f2bf(o[d0][r] * rli[r]); } }
    __syncthreads();
#undef SLOAD8
#undef SWRITE8
#undef RESC8
}
}

template <int MODE> __device__ __forceinline__ int dst_row(int n) {
    if (MODE == 1) { const int half = n >> 10, c = n & 1023; return ((c >> 7) << 8) + (half << 7) + (c & 127); }
    if (MODE == 2) { const int h = n >> 8, j = n & 255; return j < 128 ? (h << 7) + j : 1024 + (h << 7) + (j - 128); }
    return n;
}
template <int MODE> __device__ __forceinline__ void p0_transpose_item_fp8(const float* W, int K, int N, unsigned char* WT, LAS float* scr, int item, int lane) {
    const int nblk = N / 32, kb = item / nblk, nb = item % nblk, k0 = 64 * kb, n0 = 32 * nb;
#pragma unroll 8
    for (int i = 0; i < 32; ++i) { const int kk = 2 * i + (lane >> 5); scr[kk * 33 + (lane & 31)] = W[(size_t)(k0 + kk) * N + n0 + (lane & 31)]; }
    LDS_WAIT(); asm volatile("" ::: "memory");
    const int c = lane & 7;
#pragma unroll
    for (int j = 0; j < 4; ++j) { const int n = (lane >> 3) + 8 * j; const LAS float* s = scr + (8 * c) * 33 + n;
        u32x2 o; o.x = pk4_fp8(s[0 * 33] * 64.f, s[1 * 33] * 64.f, s[2 * 33] * 64.f, s[3 * 33] * 64.f); o.y = pk4_fp8(s[4 * 33] * 64.f, s[5 * 33] * 64.f, s[6 * 33] * 64.f, s[7 * 33] * 64.f);
        *(u32x2*)(WT + (size_t)dst_row<MODE>(n0 + n) * K + k0 + 8 * c) = o; }
    LDS_WAIT(); asm volatile("" ::: "memory");
}
template <int MODE> __device__ __forceinline__ void p0_transpose_item(const float* W, int K, int N, bf16_t* WT, LAS float* scr, int item, int lane) {
    const int nblk = N / 32, kb = item / nblk, nb = item % nblk, k0 = 64 * kb, n0 = 32 * nb;
#pragma unroll 8
    for (int i = 0; i < 32; ++i) { const int kk = 2 * i + (lane >> 5); scr[kk * 33 + (lane & 31)] = W[(size_t)(k0 + kk) * N + n0 + (lane & 31)]; }
    LDS_WAIT(); asm volatile("" ::: "memory");
    const int c = lane & 7;
#pragma unroll
    for (int j = 0; j < 4; ++j) { const int n = (lane >> 3) + 8 * j; const LAS float* s = scr + (8 * c) * 33 + n;
        u32x4 o; o.x = cvtpk(s[0 * 33], s[1 * 33]); o.y = cvtpk(s[2 * 33], s[3 * 33]); o.z = cvtpk(s[4 * 33], s[5 * 33]); o.w = cvtpk(s[6 * 33], s[7 * 33]);
        *(u32x4*)(WT + (size_t)dst_row<MODE>(n0 + n) * K + k0 + 8 * c) = o; }
    LDS_WAIT(); asm volatile("" ::: "memory");
}
__device__ __forceinline__ void p0_prologue(Frame& F) {
    uchar* ws = F.ws;
    {
        LAS float* S = (LAS float*)F.lds;
        const float* pC = INP(I_C); const float* pCC = INP(I_CCTX); const float* pAW = INP(I_ADAW); const float* pAB = INP(I_ADAB); const float* pNM = INP(I_NMIXG); const float* pNF = INP(I_NFFNG);
        float* MOD = (float*)(ws + WS_MOD);
        for (int item = F.bid; item < 192; item += F.G) {
            const int layer = item / 96, n0 = (item % 96) * 64;
            __syncthreads();
            for (int u = F.tid; u < 33 * 1024; u += 512) { const int j = u >> 10, k = u & 1023; const float c = j < 32 ? pC[j * 1024 + k] : pCC[k]; S[u] = silu_f(c); }
            __syncthreads();
            float acc[33];
#pragma unroll
            for (int j = 0; j < 33; ++j) acc[j] = 0.f;
            const float* wp = pAW + (size_t)layer * 1024 * 6144 + n0 + F.lane;
            const int kbeg = F.wave * 128;
            for (int k = kbeg; k < kbeg + 128; k += 4) {
                const float w0 = wp[(size_t)k * 6144], w1 = wp[(size_t)(k + 1) * 6144], w2 = wp[(size_t)(k + 2) * 6144], w3 = wp[(size_t)(k + 3) * 6144];
#pragma unroll
                for (int j = 0; j < 33; ++j) { const f32x4 s = *(const LAS f32x4*)(S + j * 1024 + k); acc[j] += s.x * w0 + s.y * w1 + s.z * w2 + s.w * w3; }
            }
            __syncthreads();
#pragma unroll
            for (int j = 0; j < 33; ++j) S[(F.wave * 33 + j) * 64 + F.lane] = acc[j];
            __syncthreads();
            for (int u = F.tid; u < 33 * 64; u += 512) { const int j = u >> 6, cl = u & 63; float s = 0.f;
#pragma unroll
                for (int w = 0; w < 8; ++w) s += S[(w * 33 + j) * 64 + cl];
                const int n = n0 + cl, part = n >> 10, col = n & 1023;
                s += pAB[layer * 6144 + n];
                if (part == 1) s = pNM[layer * 1024 + col] * (1.f + s);
                if (part == 4) s = pNF[layer * 1024 + col] * (1.f + s);
                MOD[((size_t)(layer * 33 + j) * 6 + part) * 1024 + col] = s; }
        }
        __syncthreads();
    }
    {
        const int gt = F.bid * 512 + F.tid, NT = F.G * 512;
        f32x2* tg = (f32x2*)(ws + WS_TABG); f32x2* tm = (f32x2*)(ws + WS_TABM);
        for (int u = gt; u < 64 * 32; u += NT) { const int pos = u >> 5, i = u & 31; const float inv = powf(10000.f, -(float)(2 * i) / 64.f); const float a = (float)pos * inv; tg[u] = (f32x2){cosf(a), sinf(a)}; }
        for (int u = gt; u < 64 * 16; u += NT) { const int pos = u >> 4, i = u & 15; const float inv = powf(10000.f, -(float)(2 * i) / 32.f); const float a = (float)pos * inv; tm[u] = (f32x2){cosf(a), sinf(a)}; }
        float* wrt = (float*)(ws + WS_WRT); const float* pRW = INP(I_RW); const float* pSW = INP(I_SGUW);
        for (int u = gt; u < 2 * 32 * 1024; u += NT) { const int l = u >> 15, e = (u >> 10) & 31, k = u & 1023; wrt[u] = pRW[((size_t)l * 1024 + k) * 32 + e]; }
        bf16_t* sw = (bf16_t*)(ws + WS_SGUW);
        for (int u = gt; u < 4 * 128 * 128; u += NT) sw[u] = f2bf(pSW[u]);
        u32x4* z = (u32x4*)(ws + WS_WIN1 + (size_t)832 * 1024 * (PROJ1_FP8 ? 1 : 2));
        for (int u = gt; u < 192 * 1024 * (PROJ1_FP8 ? 1 : 2) / 16; u += NT) z[u] = (u32x4){0u, 0u, 0u, 0u};
    }
    {
        LAS float* scr = (LAS float*)(F.lds + F.wave * 16384);
        const int gw = F.bid * 8 + F.wave, NGW = F.G * 8; const float* pW1 = INP(I_W1); const float* pW2 = INP(I_W2);
        constexpr int J0 = 16 * 64, J1 = 16 * 32, J2 = 16 * 26, J3 = 8 * 48, J4 = 4 * 64, J5 = 16 * 32, JW1 = 64 * 1024, JW2 = 64 * 512;
        constexpr int NITEMS = J0 + J1 + J2 + J3 + J4 + J5 + JW1 + JW2;
        for (int it = gw; it < NITEMS; it += NGW) {
            int r = it;
#if MOE_FP8
            if (r < JW1) { const int le = r >> 10; p0_transpose_item_fp8<1>(pW1 + (size_t)le * 1024 * 2048, 1024, 2048, (unsigned char*)(ws + WS_W1) + (size_t)le * 2048 * 1024, scr, r & 1023, F.lane); continue; } r -= JW1;
            if (r < JW2) { const int le = r >> 9; p0_transpose_item_fp8<0>(pW2 + (size_t)le * 1024 * 1024, 1024, 1024, (unsigned char*)(ws + WS_W2) + (size_t)le * 1024 * 1024, scr, r & 511, F.lane); continue; } r -= JW2;
#else
            if (r < JW1) { const int le = r >> 10; p0_transpose_item<1>(pW1 + (size_t)le * 1024 * 2048, 1024, 2048, (bf16_t*)(ws + WS_W1) + (size_t)le * 2048 * 1024, scr, r & 1023, F.lane); continue; } r -= JW1;
            if (r < JW2) { const int le = r >> 9; p0_transpose_item<0>(pW2 + (size_t)le * 1024 * 1024, 1024, 1024, (bf16_t*)(ws + WS_W2) + (size_t)le * 1024 * 1024, scr, r & 511, F.lane); continue; } r -= JW2;
#endif
            if (r < J0) { if constexpr (PROJ0_FP8 != 0) p0_transpose_item_fp8<0>(INP(I_ABWIN), 1024, 2048, (unsigned char*)(ws + WS_WIN0), scr, r, F.lane); else p0_transpose_item<0>(INP(I_ABWIN), 1024, 2048, (bf16_t*)(ws + WS_WIN0), scr, r, F.lane); continue; } r -= J0;
            if (r < J1) { p0_transpose_item<0>(INP(I_ABWOUT), 1024, 1024, (bf16_t*)(ws + WS_WOUT0), scr, r, F.lane); continue; } r -= J1;
            if (r < J2) { if constexpr (PROJ1_FP8 != 0) p0_transpose_item_fp8<0>(INP(I_MLAWIN), 1024, 832, (unsigned char*)(ws + WS_WIN1), scr, r, F.lane); else p0_transpose_item<0>(INP(I_MLAWIN), 1024, 832, (bf16_t*)(ws + WS_WIN1), scr, r, F.lane); continue; } r -= J2;
            if (r < J3) { if constexpr (UPQ_FP8 != 0) p0_transpose_item_fp8<0>(INP(I_MLAWUQ), 512, 1536, (unsigned char*)(ws + WS_WUQ), scr, r, F.lane); else p0_transpose_item<0>(INP(I_MLAWUQ), 512, 1536, (bf16_t*)(ws + WS_WUQ), scr, r, F.lane); continue; } r -= J3;
            if (r < J4) { if constexpr (UPKV_FP8 != 0) p0_transpose_item_fp8<2>(INP(I_MLAWUKV), 256, 2048, (unsigned char*)(ws + WS_WUKV), scr, r, F.lane); else p0_transpose_item<2>(INP(I_MLAWUKV), 256, 2048, (bf16_t*)(ws + WS_WUKV), scr, r, F.lane); continue; } r -= J4;
            if constexpr (OUT1_FP8 != 0) p0_transpose_item_fp8<0>(INP(I_MLAWOUT), 1024, 1024, (unsigned char*)(ws + WS_WOUT1), scr, r, F.lane); else p0_transpose_item<0>(INP(I_MLAWOUT), 1024, 1024, (bf16_t*)(ws + WS_WOUT1), scr, r, F.lane);
        }
    }
}

__device__ __forceinline__ void row_src_ptr(const float* px, const float* pctx, int r, const float*& src, int& mj) {
    const int b = r / TPB, pos = r - b * TPB;
    if (pos < CTXL) { src = pctx + ((size_t)b * CTXL + pos) * DM; mj = 32; } else { src = px + ((size_t)b * SEQ + (pos - CTXL)) * DM; mj = b; }
}
__device__ __forceinline__ f32x4 bf4(u32x2 w) { return (f32x4){bflo(w.x), bfhi(w.x), bflo(w.y), bfhi(w.y)}; }
__device__ __forceinline__ u32x2 pk4bf(f32x4 v) { return (u32x2){cvtpk(v.x, v.y), cvtpk(v.z, v.w)}; }
__device__ __forceinline__ void store_h_row(bf16_t* hrow, int lane, const f32x4 (&h)[4]) {
    unsigned long long* o8 = (unsigned long long*)hrow + lane;
#pragma unroll
    for (int j = 0; j < 4; ++j) o8[64 * j] = (unsigned long long)cvtpk(h[j].x, h[j].y) | ((unsigned long long)cvtpk(h[j].z, h[j].w) << 32);
}
__device__ __forceinline__ void p_norm0(Frame& F) {
    const float* MOD = (const float*)(F.ws + WS_MOD); bf16_t* H = (bf16_t*)(F.ws + WS_H);
    const int gw = F.bid * 8 + F.wave, NGW = F.G * 8; const float* px = INP(I_X); const float* pctx = INP(I_CTX);
    for (int r = gw; r < NTOK; r += NGW) {
        const float* src; int mj; row_src_ptr(px, pctx, r, src, mj);
        const f32x4* xr = (const f32x4*)src + F.lane; f32x4 v[4]; float ss = 0.f;
#pragma unroll
        for (int j = 0; j < 4; ++j) { v[j] = xr[64 * j]; ss += (v[j].x * v[j].x + v[j].y * v[j].y) + (v[j].z * v[j].z + v[j].w * v[j].w); }
        const float rstd = rsqrtf(wave_sum(ss) * (1.f / DM) + EPS);
        const f32x4* sh = (const f32x4*)(MOD + ((size_t)(0 * 33 + mj) * 6 + 0) * 1024) + F.lane; const f32x4* A = (const f32x4*)(MOD + ((size_t)(0 * 33 + mj) * 6 + 1) * 1024) + F.lane;
        f32x4 h[4];
#pragma unroll
        for (int j = 0; j < 4; ++j) h[j] = v[j] * rstd * A[64 * j] + sh[64 * j];
        if constexpr (PROJ0_FP8 != 0) { unsigned* o4 = (unsigned*)((unsigned char*)H + (size_t)r * DM) + F.lane;
#pragma unroll
            for (int j = 0; j < 4; ++j) o4[64 * j] = pk4_fp8(h[j].x * 4.f, h[j].y * 4.f, h[j].z * 4.f, h[j].w * 4.f); }
        else store_h_row(H + (size_t)r * DM, F.lane, h);
    }
}
__device__ __forceinline__ void moe_prefix(Frame& F, int layer) {
    LAS int* pb = (LAS int*)(F.lds + XTRA_OFF + X_PB); LAS int* cn = (LAS int*)(F.lds + XTRA_OFF + X_CNT);
    const unsigned* gc = (const unsigned*)(F.ws + WS_CTL) + CW_CNT + layer * 64;
    __syncthreads();
    if (F.tid == 0) { int s = 0; for (int e = 0; e < 32; ++e) { const int c = (int)__hip_atomic_load(gc + e, __ATOMIC_RELAXED, __HIP_MEMORY_SCOPE_AGENT); cn[e] = c; pb[e] = s; s += (c + 255) >> 8; } pb[32] = s; }
    __syncthreads();
}
__device__ __forceinline__ void moe_gather_row(const Frame& F, int r, f32x4 (&f)[4]) {
    const LAS int* pb = (const LAS int*)(F.lds + XTRA_OFF + X_PB);
    const u32x2* ti = (const u32x2*)(F.ws + WS_TOKI) + (size_t)r * 4; const bf16_t* Y = (const bf16_t*)(F.ws + WS_Y);
#pragma unroll
    for (int j = 0; j < 4; ++j) f[j] = (f32x4){0.f, 0.f, 0.f, 0.f};
#pragma unroll
    for (int k = 0; k < 4; ++k) {
        const u32x2 t = ti[k]; const int e = (int)(t.x >> 20), pos = (int)(t.x & 0xfffffu); const float g = __uint_as_float(t.y);
        const size_t yrow = (size_t)pb[e] * 256 + pos;
#if Y_FP8
        const unsigned* yp = (const unsigned*)((const unsigned char*)Y + yrow * DM) + F.lane; const float g16 = g * (1.f / 16.f);
#pragma unroll
        for (int j = 0; j < 4; ++j) { const unsigned w = yp[64 * j]; const f32x2 lo = __builtin_amdgcn_cvt_pk_f32_fp8(w, false), hi2 = __builtin_amdgcn_cvt_pk_f32_fp8(w, true);
            f[j].x += g16 * lo.x; f[j].y += g16 * lo.y; f[j].z += g16 * hi2.x; f[j].w += g16 * hi2.y; }
#else
        const u32x2* yp = (const u32x2*)(Y + yrow * DM) + F.lane;
#pragma unroll
        for (int j = 0; j < 4; ++j) { const u32x2 w = yp[64 * j]; f[j].x += g * bflo(w.x); f[j].y += g * bfhi(w.x); f[j].z += g * bflo(w.y); f[j].w += g * bfhi(w.y); }
#endif
    }
}
__device__ __forceinline__ void p_combine_norm(Frame& F, int dry) {
    moe_prefix(F, 0);
    const float* MOD = (const float*)(F.ws + WS_MOD); bf16_t* H = (bf16_t*)(F.ws + (dry ? WS_SCR + 288 * MiB : WS_H)); bf16_t* XR = (bf16_t*)(F.ws + WS_XR); bf16_t* XW = dry ? (bf16_t*)(F.ws + WS_SCR) : XR;
    const int gw = F.bid * 8 + F.wave, NGW = F.G * 8;
    for (int r = gw; r < NTOK; r += NGW) {
        const int b = r / TPB, pos = r - b * TPB, mj = pos < CTXL ? 32 : b;
        f32x4 f[4]; moe_gather_row(F, r, f);
        const u32x2* xr = (const u32x2*)(XR + (size_t)r * DM) + F.lane; u32x2* xw = (u32x2*)(XW + (size_t)r * DM) + F.lane; const f32x4* g2 = (const f32x4*)(MOD + ((size_t)(0 * 33 + mj) * 6 + 5) * 1024) + F.lane;
        f32x4 v[4]; float ss = 0.f;
#pragma unroll
        for (int j = 0; j < 4; ++j) { v[j] = bf4(xr[64 * j]) + g2[64 * j] * f[j]; xw[64 * j] = pk4bf(v[j]); ss += (v[j].x * v[j].x + v[j].y * v[j].y) + (v[j].z * v[j].z + v[j].w * v[j].w); }
        const float rstd = rsqrtf(wave_sum(ss) * (1.f / DM) + EPS);
        const f32x4* sh = (const f32x4*)(MOD + ((size_t)(1 * 33 + mj) * 6 + 0) * 1024) + F.lane; const f32x4* A = (const f32x4*)(MOD + ((size_t)(1 * 33 + mj) * 6 + 1) * 1024) + F.lane;
        f32x4 h[4];
#pragma unroll
        for (int j = 0; j < 4; ++j) h[j] = v[j] * rstd * A[64 * j] + sh[64 * j];
        if constexpr (PROJ1_FP8 != 0) { unsigned* o4 = (unsigned*)((unsigned char*)H + (size_t)r * DM) + F.lane;
#pragma unroll
            for (int j = 0; j < 4; ++j) o4[64 * j] = pk4_fp8(h[j].x * 4.f, h[j].y * 4.f, h[j].z * 4.f, h[j].w * 4.f); }
        else store_h_row(H + (size_t)r * DM, F.lane, h);
    }
}
__device__ __forceinline__ void p_final(Frame& F) {
    moe_prefix(F, 1);
    const float* MOD = (const float*)(F.ws + WS_MOD); const bf16_t* XR = (const bf16_t*)(F.ws + WS_XR);
    const int gw = F.bid * 8 + F.wave, NGW = F.G * 8; const float* pfg = INP(I_FNG);
    for (int q = gw; q < NBATCH * SEQ; q += NGW) {
        const int b = q >> 11, t = q & 2047, r = b * TPB + CTXL + t;
        f32x4 f[4]; moe_gather_row(F, r, f);
        const u32x2* xr = (const u32x2*)(XR + (size_t)r * DM) + F.lane; const f32x4* g2 = (const f32x4*)(MOD + ((size_t)(1 * 33 + b) * 6 + 5) * 1024) + F.lane;
        f32x4 v[4]; float ss = 0.f;
#pragma unroll
        for (int j = 0; j < 4; ++j) { v[j] = bf4(xr[64 * j]) + g2[64 * j] * f[j]; ss += (v[j].x * v[j].x + v[j].y * v[j].y) + (v[j].z * v[j].z + v[j].w * v[j].w); }
        const float rstd = rsqrtf(wave_sum(ss) * (1.f / DM) + EPS);
        const f32x4* fg = (const f32x4*)pfg + F.lane; f32x4* op = (f32x4*)(F.out + (size_t)q * DM) + F.lane;
#pragma unroll
        for (int j = 0; j < 4; ++j) op[64 * j] = v[j] * rstd * fg[64 * j];
    }
}
__device__ __forceinline__ void top4_of16(float (&v)[16], int hi, float (&tv)[4], int (&te)[4]) {
#pragma unroll
    for (int k = 0; k < 4; ++k) { float best = v[0]; int bi = 0;
#pragma unroll
        for (int r = 1; r < 16; ++r) { const bool bt = v[r] > best; best = bt ? v[r] : best; bi = bt ? r : bi; }
        tv[k] = best; te[k] = (bi & 3) + 8 * (bi >> 2) + 4 * hi;
#pragma unroll
        for (int r = 0; r < 16; ++r) v[r] = (r == bi) ? -3.0e38f : v[r]; }
}
template <int LAYER> __device__ __forceinline__ void p_norm_router(Frame& F, int dry) {
    const float* MOD = (const float*)(F.ws + WS_MOD); bf16_t* H = (bf16_t*)(F.ws + WS_H); const bf16_t* XR = (const bf16_t*)(F.ws + WS_XR);
    LAS f32x4* WL4 = (LAS f32x4*)F.lds;
    LAS int* hist = (LAS int*)(F.lds + XTRA_OFF + X_HIST); LAS int* base = (LAS int*)(F.lds + XTRA_OFF + X_BASE); LAS u32x2* sel = (LAS u32x2*)(F.lds + XTRA_OFF + X_SEL);
    LAS f32x4* A2L4 = (LAS f32x4*)(F.lds + XTRA_OFF + X_A2); LAS float* CBL = (LAS float*)(F.lds + XTRA_OFF + X_CB); LAS float* RSL = (LAS float*)(F.lds + XTRA_OFF + X_RS);
    unsigned* gcnt = (unsigned*)(F.ws + WS_CTL) + CW_CNT + LAYER * 64 + (dry ? 128 : 0);
    int* rowl = (int*)(F.ws + WS_ROWL); u32x2* toki = (u32x2*)(F.ws + WS_TOKI);
    const f32x4* wsrc = (const f32x4*)(F.ws + WS_WRT + (size_t)LAYER * 32 * 1024 * 4);
    __syncthreads();
    for (int u = F.tid; u < 8192; u += 512) { const int e = u >> 8, k4 = u & 255; WL4[e * 256 + (k4 ^ (e & 15))] = wsrc[u]; }
    if (F.tid < 32) hist[F.tid] = 0;
    const int lane = F.lane, r32 = lane & 31, hi = lane >> 5; const float* prb = INP(I_RB);
    constexpr int NP = LAYER == 0 ? NPAN : 256;
    for (int pi = F.bid; pi < NP; pi += F.G) {
        const int pan = LAYER == 0 ? pi : pi + pi / 8 + 1;
        const int b = pan / 9, mj = (pan % 9 == 0) ? 32 : b;
        const f32x4* shp = (const f32x4*)(MOD + ((size_t)(LAYER * 33 + mj) * 6 + 3) * 1024); const f32x4* Ap = (const f32x4*)(MOD + ((size_t)(LAYER * 33 + mj) * 6 + 4) * 1024);
        __syncthreads();
        if (F.tid < 256) A2L4[F.tid] = Ap[F.tid];
        {
            const int e = F.tid >> 4, part = F.tid & 15; float sum = 0.f;
#pragma unroll 4
            for (int q = 0; q < 16; ++q) { const f32x4 a = shp[part * 16 + q], w = wsrc[e * 256 + part * 16 + q]; sum += (a.x * w.x + a.y * w.y) + (a.z * w.z + a.w * w.w); }
            sum += xf1(sum); sum += xf2(sum); sum += xf4(sum); sum += xf8(sum);
            if (part == 0) CBL[e] = sum + prb[LAYER * 32 + e];
        }
        __syncthreads();
        const int row = pan * 256 + F.wave * 32 + r32;
        const u32x2* xp = (const u32x2*)(XR + (size_t)row * DM) + hi;
        const LAS f32x4* wrow = WL4 + r32 * 256; const int swz = r32 & 15;
        f32x16 acc = {}; float ssq = 0.f;
#define RT_LOAD(dst, mb) do { _Pragma("unroll") for (int u = 0; u < 8; ++u) dst[u] = xp[2 * ((mb) + u)]; } while (0)
#define RT_COMP(src, mb) do { _Pragma("unroll") for (int u = 0; u < 8; ++u) { const int k4 = 2 * ((mb) + u) + hi; const f32x4 a4 = A2L4[k4], w4 = wrow[k4 ^ swz]; const f32x4 x = bf4(src[u]); \
                ssq += (x.x * x.x + x.y * x.y) + (x.z * x.z + x.w * x.w); \
                acc = __builtin_amdgcn_mfma_f32_32x32x2f32(w4.x, x.x * a4.x, acc, 0, 0, 0); acc = __builtin_amdgcn_mfma_f32_32x32x2f32(w4.y, x.y * a4.y, acc, 0, 0, 0); \
                acc = __builtin_amdgcn_mfma_f32_32x32x2f32(w4.z, x.z * a4.z, acc, 0, 0, 0); acc = __builtin_amdgcn_mfma_f32_32x32x2f32(w4.w, x.w * a4.w, acc, 0, 0, 0); } } while (0)
        u32x2 xa[8], xb[8];
        RT_LOAD(xa, 0);
#pragma unroll 1
        for (int m0 = 0; m0 < 128; m0 += 16) {
            RT_LOAD(xb, m0 + 8); SBAR();
            RT_COMP(xa, m0); SBAR();
            if (m0 + 16 < 128) RT_LOAD(xa, m0 + 16);
            SBAR(); RT_COMP(xb, m0 + 8); SBAR();
        }
#undef RT_LOAD
#undef RT_COMP
        const float rstd = rsqrtf(sum32(ssq, ssq) * (1.f / DM) + EPS);
        float lg[16];
#pragma unroll
        for (int r = 0; r < 16; ++r) lg[r] = acc[r] * rstd + CBL[(r & 3) + 8 * (r >> 2) + 4 * hi];
        float tv[4], pv[4]; int te[4], pe[4];
        top4_of16(lg, hi, tv, te);
#pragma unroll
        for (int k = 0; k < 4; ++k) { pv[k] = __uint_as_float(xu32(__float_as_uint(tv[k]), lane)); pe[k] = (int)xu32((unsigned)te[k], lane); }
        float cv[8] = {tv[0], tv[1], tv[2], tv[3], pv[0], pv[1], pv[2], pv[3]}; int ce[8] = {te[0], te[1], te[2], te[3], pe[0], pe[1], pe[2], pe[3]};
        float gv[4]; int ge[4];
#pragma unroll
        for (int k = 0; k < 4; ++k) { float best = cv[0]; int be = ce[0];
#pragma unroll
            for (int c = 1; c < 8; ++c) { const bool bt = cv[c] > best || (cv[c] == best && ce[c] < be); best = bt ? cv[c] : best; be = bt ? ce[c] : be; }
            gv[k] = best; ge[k] = be;
#pragma unroll
            for (int c = 0; c < 8; ++c) cv[c] = (ce[c] == be) ? -3.0e38f : cv[c]; }
        const float x1 = __expf(gv[1] - gv[0]), x2 = __expf(gv[2] - gv[0]), x3 = __expf(gv[3] - gv[0]); const float inv = 1.f / (1.f + x1 + x2 + x3);
        {
            const int ea = hi ? ge[2] : ge[0], eb = hi ? ge[3] : ge[1]; const float ga = hi ? x2 * inv : inv, gb = hi ? x3 * inv : x1 * inv;
            const int ra = __hip_atomic_fetch_add(hist + ea, 1, __ATOMIC_RELAXED, __HIP_MEMORY_SCOPE_WORKGROUP), rb2 = __hip_atomic_fetch_add(hist + eb, 1, __ATOMIC_RELAXED, __HIP_MEMORY_SCOPE_WORKGROUP);
            const int rl = F.wave * 32 + r32;
            sel[rl * 4 + 2 * hi] = (u32x2){(unsigned)ea | ((unsigned)ra << 8), __float_as_uint(ga)}; sel[rl * 4 + 2 * hi + 1] = (u32x2){(unsigned)eb | ((unsigned)rb2 << 8), __float_as_uint(gb)};
            if (hi == 0) RSL[rl] = rstd;
        }
        {
            f32x4 Ar[4], Sr[4];
#pragma unroll
            for (int j = 0; j < 4; ++j) { Ar[j] = Ap[lane + 64 * j]; Sr[j] = shp[lane + 64 * j]; }
            for (int rr = 0; rr < 32; rr += 4) {
                const int rw = pan * 256 + F.wave * 32 + rr; f32x4 v[4][4];
#pragma unroll
                for (int t = 0; t < 4; ++t) { const u32x2* xr = (const u32x2*)(XR + (size_t)(rw + t) * DM) + lane;
#pragma unroll
                    for (int j = 0; j < 4; ++j) v[t][j] = bf4(xr[64 * j]); }
#pragma unroll
                for (int t = 0; t < 4; ++t) { const float rs = RSL[F.wave * 32 + rr + t]; f32x4 h[4];
#pragma unroll
                    for (int j = 0; j < 4; ++j) h[j] = v[t][j] * rs * Ar[j] + Sr[j];
                    if constexpr (MOE_FP8 != 0) { unsigned* o4 = (unsigned*)((unsigned char*)H + (size_t)(rw + t) * DM) + lane;
#pragma unroll
                        for (int j = 0; j < 4; ++j) o4[64 * j] = pk4_fp8(h[j].x * 4.f, h[j].y * 4.f, h[j].z * 4.f, h[j].w * 4.f); }
                    else store_h_row(H + (size_t)(rw + t) * DM, lane, h); }
            }
        }
        __syncthreads();
        if (F.tid < 32) { const int c = hist[F.tid]; base[F.tid] = c ? (int)__hip_atomic_fetch_add(gcnt + F.tid, (unsigned)c, __ATOMIC_RELAXED, __HIP_MEMORY_SCOPE_AGENT) : 0; }
        __syncthreads();
        for (int u = F.tid; u < 1024; u += 512) { const u32x2 sv = sel[u]; const int e = (int)(sv.x & 0xffu), pos = base[e] + (int)(sv.x >> 8), r = pan * 256 + (u >> 2);
            rowl[(size_t)e * ROWCAP + pos] = r; toki[(size_t)r * 4 + (u & 3)] = (u32x2){((unsigned)e << 20) | (unsigned)pos, sv.y}; }
        __syncthreads();
        if (F.tid < 32) hist[F.tid] = 0;
    }
    __syncthreads();
}

__device__ __forceinline__ void p_moe_gather(Frame& F, int layer) {
    moe_prefix(F, layer);
    const LAS int* pb = (const LAS int*)(F.lds + XTRA_OFF + X_PB); const LAS int* cn = (const LAS int*)(F.lds + XTRA_OFF + X_CNT);
    const unsigned char* H8 = (const unsigned char*)(F.ws + WS_H); unsigned char* XS = (unsigned char*)(F.ws + WS_XS); const int* rowl = (const int*)(F.ws + WS_ROWL);
    const int nblk = pb[32];
    for (int blk = F.bid; blk < nblk; blk += F.G) {
        int e = 0;
#pragma unroll
        for (int st = 16; st >= 1; st >>= 1) { if (pb[e + st] <= blk) e += st; }
        const int rb = blk - pb[e], n = cn[e] - rb * 256;
        const int* rl = rowl + (size_t)e * ROWCAP + rb * 256 + F.wave * 32;
#pragma unroll 1
        for (int r0 = 0; r0 < 32; r0 += 8) {
            u32x4 v[8]; int tok[8];
#pragma unroll
            for (int q = 0; q < 8; ++q) { const int ri = F.wave * 32 + r0 + q; tok[q] = ri < n ? rl[r0 + q] : -1; }
#pragma unroll
            for (int q = 0; q < 8; ++q) if (tok[q] >= 0) v[q] = *(const u32x4*)(H8 + (size_t)tok[q] * 1024 + F.lane * 16);
#pragma unroll
            for (int q = 0; q < 8; ++q) if (tok[q] >= 0) *(u32x4*)(XS + ((size_t)blk * 256 + F.wave * 32 + r0 + q) * 1024 + F.lane * 16) = v[q];
        }
    }
}

__device__ __forceinline__ void p_qk_prep(Frame& F) {
    bf16_t* P = (bf16_t*)(F.ws + WS_PBUF); const f32x2* tab = (const f32x2*)(F.ws + WS_TABG);
    const int lane = F.lane, sub = lane >> 4, a = lane & 15, gw = F.bid * 8 + F.wave, NGW = F.G * 8;
    const float* pq = INP(I_GQG); const float* pk = INP(I_GKG);
    float gq[8], gk[8], gqp[8], gkp[8];
#pragma unroll
    for (int j = 0; j < 8; ++j) { gq[j] = pq[8 * a + j]; gk[j] = pk[8 * a + j]; gqp[j] = pq[8 * (a ^ 4) + j]; gkp[j] = pk[8 * (a ^ 4) + j]; }
    const bool isx2 = (a & 4) != 0; const int fi = 8 * (a & 3);
    for (int rp = gw; rp < NTOK / 2; rp += NGW) {
#pragma unroll
        for (int g = 0; g < 3; ++g) {
            const int it = g * 4 + sub, hi6 = it >= 6 ? 1 : 0, r = rp * 2 + hi6, s = it - 6 * hi6;
            const int b = r / TPB, pos = r - b * TPB; const bool lat = pos >= CTXL; const int t = pos - CTXL;
            bf16_t* ptr = P + (size_t)r * 2048 + 1024 + s * 128 + 8 * a;
            const u32x4 w = *(const u32x4*)ptr; u32x4 wp;
#pragma unroll
            for (int q = 0; q < 4; ++q) wp[q] = (unsigned)__shfl_xor((int)w[q], 4);
            float x[8], xp[8];
#pragma unroll
            for (int q = 0; q < 4; ++q) { x[2 * q] = bflo(w[q]); x[2 * q + 1] = bfhi(w[q]); xp[2 * q] = bflo(wp[q]); xp[2 * q + 1] = bfhi(wp[q]); }
            float ss = 0.f;
#pragma unroll
            for (int j = 0; j < 8; ++j) ss += x[j] * x[j];
            ss += __shfl_xor(ss, 1); ss += __shfl_xor(ss, 2); ss += __shfl_xor(ss, 4); ss += __shfl_xor(ss, 8);
            const float rstd = rsqrtf(ss * (1.f / 128.f) + EPS); const bool isq = s < 4;
            float o[8];
#pragma unroll
            for (int j = 0; j < 8; ++j) { o[j] = x[j] * rstd * (isq ? gq[j] : gk[j]); xp[j] = xp[j] * rstd * (isq ? gqp[j] : gkp[j]); }
            if (lat) {
                const int pp = (a & 8) ? (t & 63) : (t >> 6); const f32x4* tp = (const f32x4*)(tab + pp * 32 + fi);
#pragma unroll
                for (int q = 0; q < 4; ++q) { const f32x4 cs = tp[q];
                    const float s0 = isx2 ? cs.y : -cs.y, s1 = isx2 ? cs.w : -cs.w;
                    o[2 * q] = o[2 * q] * cs.x + xp[2 * q] * s0; o[2 * q + 1] = o[2 * q + 1] * cs.z + xp[2 * q + 1] * s1; }
            }
            u32x4 wo; wo.x = cvtpk(o[0], o[1]); wo.y = cvtpk(o[2], o[3]); wo.z = cvtpk(o[4], o[5]); wo.w = cvtpk(o[6], o[7]);
            *(u32x4*)ptr = wo;
        }
    }
}
__device__ __forceinline__ void p_mla_prep(Frame& F) {
    bf16_t* P = (bf16_t*)(F.ws + WS_PBUF); bf16_t* KR = (bf16_t*)(F.ws + WS_KRB); const f32x2* tab = (const f32x2*)(F.ws + WS_TABM);
    const int gw = F.bid * 8 + F.wave, NGW = F.G * 8, lane = F.lane;
    const float* pqg = INP(I_MLAQG); const float* pkg = INP(I_MLAKVG);
    float qg[8], kg[4];
#pragma unroll
    for (int j = 0; j < 8; ++j) qg[j] = pqg[8 * lane + j];
#pragma unroll
    for (int j = 0; j < 4; ++j) kg[j] = pkg[4 * lane + j];
    const int krow = (lane >> 3) & 3, ka = lane & 7; const bool kx2 = (ka & 2) != 0; const int kfi = 8 * (ka & 1);
    for (int r0 = gw * 4; r0 < NTOK; r0 += NGW * 4) {
        const int b = r0 / TPB, pos0 = r0 - b * TPB; const bool lat = pos0 >= CTXL;
        u32x4 wq[4]; u32x2 wk[4];
#pragma unroll
        for (int rr = 0; rr < 4; ++rr) { const bf16_t* base = P + (size_t)(r0 + rr) * 1024; wk[rr] = *(const u32x2*)(base + 512 + 4 * lane); if (lat) wq[rr] = *(const u32x4*)(base + 8 * lane); }
        u32x4 wr = (u32x4){0u, 0u, 0u, 0u};
        if (lane < 32) wr = *(const u32x4*)(P + (size_t)(r0 + krow) * 1024 + 768 + 8 * ka);
        if (lat) {
#pragma unroll
            for (int rr = 0; rr < 4; ++rr) { float x[8];
#pragma unroll
                for (int q = 0; q < 4; ++q) { x[2 * q] = bflo(wq[rr][q]); x[2 * q + 1] = bfhi(wq[rr][q]); }
                float ss = 0.f;
#pragma unroll
                for (int j = 0; j < 8; ++j) ss += x[j] * x[j];
                const float rstd = rsqrtf(wave_sum(ss) * (1.f / 512.f) + EPS);
                if constexpr (UPQ_FP8 != 0) { const float s4 = rstd * 4.f; u32x2 w8; w8.x = pk4_fp8(x[0] * s4 * qg[0], x[1] * s4 * qg[1], x[2] * s4 * qg[2], x[3] * s4 * qg[3]); w8.y = pk4_fp8(x[4] * s4 * qg[4], x[5] * s4 * qg[5], x[6] * s4 * qg[6], x[7] * s4 * qg[7]);
                    *(u32x2*)((unsigned char*)(F.ws + WS_CQ8) + (size_t)(r0 + rr) * 512 + 8 * lane) = w8; }
                else { u32x4 w;
#pragma unroll
                    for (int q = 0; q < 4; ++q) w[q] = cvtpk(x[2 * q] * rstd * qg[2 * q], x[2 * q + 1] * rstd * qg[2 * q + 1]);
                    *(u32x4*)(P + (size_t)(r0 + rr) * 1024 + 8 * lane) = w; } }
        }
#pragma unroll
        for (int rr = 0; rr < 4; ++rr) { const float x0 = bflo(wk[rr].x), x1 = bfhi(wk[rr].x), x2 = bflo(wk[rr].y), x3 = bfhi(wk[rr].y);
            const float rstd = rsqrtf(wave_sum((x0 * x0 + x1 * x1) + (x2 * x2 + x3 * x3)) * (1.f / 256.f) + EPS);
            if constexpr (UPKV_FP8 != 0) { const float s4 = rstd * 4.f; *(unsigned*)((unsigned char*)(F.ws + WS_CKV8) + (size_t)(r0 + rr) * 256 + 4 * lane) = pk4_fp8(x0 * s4 * kg[0], x1 * s4 * kg[1], x2 * s4 * kg[2], x3 * s4 * kg[3]); }
            else { u32x2 w; w.x = cvtpk(x0 * rstd * kg[0], x1 * rstd * kg[1]); w.y = cvtpk(x2 * rstd * kg[2], x3 * rstd * kg[3]);
                *(u32x2*)(P + (size_t)(r0 + rr) * 1024 + 512 + 4 * lane) = w; } }
        {
            u32x4 wp;
#pragma unroll
            for (int q = 0; q < 4; ++q) wp[q] = (unsigned)__shfl_xor((int)wr[q], 2);
            float o[8], xp[8];
#pragma unroll
            for (int q = 0; q < 4; ++q) { o[2 * q] = bflo(wr[q]); o[2 * q + 1] = bfhi(wr[q]); xp[2 * q] = bflo(wp[q]); xp[2 * q + 1] = bfhi(wp[q]); }
            if (lat) { const int t = pos0 + krow - CTXL, pp = (ka & 4) ? (t & 63) : (t >> 6); const f32x4* tp = (const f32x4*)(tab + pp * 16 + kfi);
#pragma unroll
                for (int q = 0; q < 4; ++q) { const f32x4 cs = tp[q]; const float s0 = kx2 ? cs.y : -cs.y, s1 = kx2 ? cs.w : -cs.w;
                    o[2 * q] = o[2 * q] * cs.x + xp[2 * q] * s0; o[2 * q + 1] = o[2 * q + 1] * cs.z + xp[2 * q + 1] * s1; } }
            u32x4 wo; wo.x = cvtpk(o[0], o[1]); wo.y = cvtpk(o[2], o[3]); wo.z = cvtpk(o[4], o[5]); wo.w = cvtpk(o[6], o[7]);
            if (lane < 32) *(u32x4*)(KR + (size_t)(r0 + krow) * 64 + 8 * ka) = wo;
        }
    }
}
__device__ __forceinline__ void p_sgu(Frame& F) {
    const bf16_t* P = (const bf16_t*)(F.ws + WS_PBUF); bf16_t* MIX = (bf16_t*)(F.ws + WS_MIX0); const bf16_t* SW = (const bf16_t*)(F.ws + WS_SGUW);
    const int tid = F.tid, lane = F.lane, wid = F.wave, hw = wid >> 2, w4 = wid & 3, th = tid & 255, r32 = lane & 31, hi = lane >> 5;
    LAS char* Vl = (LAS char*)F.lds + hw * 32768;
    const int sr = th >> 4, sc = (th & 15) * 8;
    const int vb0 = (int)(unsigned)(uintptr_t)Vl + att::v_rd_base(lane);
    const float* psg = INP(I_SGUNG); const float* psb = INP(I_SGUB);
    for (int U = F.bid; U < (NTOK / 128) * 2; U += F.G) {
        const int chunk = U >> 1, g = (U & 1) * 2 + hw; const size_t row0 = (size_t)chunk * 128;
        float gn[8];
#pragma unroll
        for (int j = 0; j < 8; ++j) gn[j] = psg[g * 128 + sc + j];
        __syncthreads();
#pragma unroll
        for (int i = 0; i < 8; ++i) {
            const int q = sr + 16 * i;
            u32x4 w = *(const u32x4*)(P + (row0 + q) * 2048 + 512 + g * 128 + sc); float x[8];
#pragma unroll
            for (int k = 0; k < 4; ++k) { x[2 * k] = bflo(w[k]); x[2 * k + 1] = bfhi(w[k]); }
            float ss = 0.f;
#pragma unroll
            for (int j = 0; j < 8; ++j) ss += x[j] * x[j];
            ss += __shfl_xor(ss, 1); ss += __shfl_xor(ss, 2); ss += __shfl_xor(ss, 4); ss += __shfl_xor(ss, 8);
            const float rstd = rsqrtf(ss * (1.f / 128.f) + EPS);
#pragma unroll
            for (int k = 0; k < 4; ++k) w[k] = cvtpk(x[2 * k] * rstd * gn[2 * k], x[2 * k + 1] * rstd * gn[2 * k + 1]);
            *(LAS u32x4*)(Vl + (q >> 6) * 16384 + att::v_st(q & 63, sc)) = w;
        }
        bf16x8 pa[8];
        const bf16_t* wrow = SW + ((size_t)g * 128 + 32 * w4 + r32) * 128 + 8 * hi;
#pragma unroll
        for (int k = 0; k < 8; ++k) pa[k] = *(const bf16x8*)(wrow + 16 * k);
        __syncthreads();
        f32x16 o[4] = {};
        att::pv_d0(o, vb0, pa[0], pa[1], pa[2], pa[3]);
        att::pv_d0(o, vb0 + 16384, pa[4], pa[5], pa[6], pa[7]);
#pragma unroll
        for (int r = 0; r < 16; ++r) { const int p = 32 * w4 + att::crow(r, hi); const float bs = psb[g * 128 + p];
#pragma unroll
            for (int d0 = 0; d0 < 4; ++d0) { const int c = d0 * 32 + r32; const float zu = bf2f(P[(row0 + p) * 2048 + g * 128 + c]);
                MIX[(row0 + p) * 1024 + g * 128 + c] = f2bf((o[d0][r] + bs) * zu); } }
    }
    __syncthreads();
}

using pg8::Unit; using pg8::Acc;
struct ProbIn0 {
    static constexpr bool PERM = true, GATHER = false, FP8 = PROJ0_FP8 != 0; int K, lda; const bf16_t* A; const bf16_t* Bt; bf16_t* O; pg8::StaticOrder so; int G, c;
    __device__ bool next(int i, Unit& u) const { return so.map((long)i * G + c, u.pm, u.pn); }
    __device__ const void* a_mat() const { return A; } __device__ const void* b_mat() const { return Bt; }
    __device__ unsigned a_off(const Unit& u) const { return (unsigned)u.pm * 256u * (unsigned)lda * 2u; }
    __device__ unsigned b_off(const Unit& u) const { return (unsigned)u.pn * 256u * (unsigned)K * 2u; }
    __device__ void a_voff(const Unit&, unsigned (&)[2][2]) const {}
    __device__ void epi(const Acc& acc, const Unit& u, int wr, int wc, int fr, int fq) const {
        bf16_t* dst = O + (size_t)u.pm * 256 * 2048 + u.pn * 256;
        if (u.pn < 4) pg8::epi_store_bf16<true>(acc, dst, 2048, nullptr, wr, wc, fr, fq, FP8 ? (1.f / 256.f) : 1.f); else pg8::epi_store_bf16<false>(acc, dst, 2048, nullptr, wr, wc, fr, fq, FP8 ? (1.f / 256.f) : 1.f);
    }
};
template <bool LATONLY, bool FP8v = false> struct ProbPlain {
    static constexpr bool PERM = true, GATHER = false, FP8 = FP8v; int K, lda; const bf16_t* A; const bf16_t* Bt; bf16_t* O; int ldc; pg8::StaticOrder so; int G, c;
    __device__ bool next(int i, Unit& u) const { int pm; if (!so.map((long)i * G + c, pm, u.pn)) return false; u.pm = LATONLY ? pm + pm / 8 + 1 : pm; return true; }
    __device__ const void* a_mat() const { return A; } __device__ const void* b_mat() const { return Bt; }
    __device__ unsigned a_off(const Unit& u) const { return (unsigned)u.pm * 256u * (unsigned)lda * 2u; }
    __device__ unsigned b_off(const Unit& u) const { return (unsigned)u.pn * 256u * (unsigned)K * 2u; }
    __device__ void a_voff(const Unit&, unsigned (&)[2][2]) const {}
    __device__ void epi(const Acc& acc, const Unit& u, int wr, int wc, int fr, int fq) const {
        pg8::epi_store_bf16<false>(acc, O + (size_t)u.pm * 256 * ldc + u.pn * 256, ldc, nullptr, wr, wc, fr, fq, FP8 ? (1.f / 256.f) : 1.f);
    }
};
struct ProbIn1 {
    static constexpr bool PERM = true, GATHER = false, FP8 = PROJ1_FP8 != 0; int K, lda; const bf16_t* A; const bf16_t* Bt; bf16_t* O; pg8::StaticOrder so; int G, c;
    __device__ bool next(int i, Unit& u) const {
        const long L = (long)i * G + c;
        if (L < 1024) { int pm; so.map(L, pm, u.pn); u.pm = pm + pm / 8 + 1; return true; }
        if (L < 1024 + 64) { const int q = (int)(L - 1024); u.pm = (q >> 1) * 9; u.pn = 2 + (q & 1); return true; }
        return false;
    }
    __device__ const void* a_mat() const { return A; } __device__ const void* b_mat() const { return Bt; }
    __device__ unsigned a_off(const Unit& u) const { return (unsigned)u.pm * 256u * (unsigned)lda * 2u; }
    __device__ unsigned b_off(const Unit& u) const { return (unsigned)u.pn * 256u * (unsigned)K * 2u; }
    __device__ void a_voff(const Unit&, unsigned (&)[2][2]) const {}
    __device__ void epi(const Acc& acc, const Unit& u, int wr, int wc, int fr, int fq) const {
        pg8::epi_store_bf16<false>(acc, O + (size_t)u.pm * 256 * 1024 + u.pn * 256, 1024, nullptr, wr, wc, fr, fq, FP8 ? (1.f / 256.f) : 1.f);
    }
};
template <int LAYER> struct ProbOut {
    static constexpr bool PERM = true, GATHER = false, FP8 = LAYER == 1 && OUT1_FP8 != 0; int K, lda; const bf16_t* A; const bf16_t* Bt; bf16_t* XR; const float* MOD; const float* xin; const float* cin; pg8::StaticOrder so; int G, c;
    __device__ __forceinline__ bool next(int i, Unit& u) const { int pm; if (!so.map((long)i * G + c, pm, u.pn)) return false; u.pm = LAYER ? pm + pm / 8 + 1 : pm; return true; }
    __device__ __forceinline__ const void* a_mat() const { return A; } __device__ __forceinline__ const void* b_mat() const { return Bt; }
    __device__ __forceinline__ unsigned a_off(const Unit& u) const { return (unsigned)u.pm * 256u * (unsigned)lda * 2u; }
    __device__ __forceinline__ unsigned b_off(const Unit& u) const { return (unsigned)u.pn * 256u * (unsigned)K * 2u; }
    __device__ __forceinline__ void a_voff(const Unit&, unsigned (&)[2][2]) const {}
    __device__ __forceinline__ void epi(const Acc& acc, const Unit& u, int wr, int wc, int fr, int fq) const {
        const int b = u.pm / 9, jj = u.pm % 9, mj = jj == 0 ? 32 : b;
        const float* basef = jj == 0 ? cin + (size_t)b * CTXL * DM : xin + ((size_t)b * SEQ + (jj - 1) * 256) * DM;
        bf16_t* dst = XR + (size_t)u.pm * 256 * DM; const float* gate = MOD + ((size_t)(LAYER * 33 + mj) * 6 + 2) * 1024;
        const int row0 = wr * 64 + fr, col0 = u.pn * 256 + wc * 32 + 8 * fq;
        f32x4 gv[2][2];
#pragma unroll
        for (int bj = 0; bj < 2; ++bj)
#pragma unroll
            for (int n = 0; n < 2; ++n) gv[bj][n] = *(const f32x4*)(gate + col0 + bj * 128 + 4 * n);
#pragma unroll
        for (int ai = 0; ai < 2; ++ai)
#pragma unroll
            for (int m = 0; m < 4; ++m) { const size_t uo = (size_t)(ai * 128 + m * 16) * DM; const unsigned lo = (unsigned)(row0 * DM + col0);
#pragma unroll
                for (int bj = 0; bj < 2; ++bj) { f32x4 b0, b1;
                    if constexpr (LAYER == 0) { const char* bp = (const char*)(basef + uo) + (size_t)(lo + bj * 128) * 4u; b0 = *(const f32x4*)bp; b1 = *(const f32x4*)(bp + 16); }
                    else { const u32x4 w = *(const u32x4*)((const char*)(dst + uo) + (lo + bj * 128) * 2u); b0 = (f32x4){bflo(w.x), bfhi(w.x), bflo(w.y), bfhi(w.y)}; b1 = (f32x4){bflo(w.z), bfhi(w.z), bflo(w.w), bfhi(w.w)}; }
                    constexpr float SC = FP8 ? (1.f / 1024.f) : 1.f;
                    const f32x4 v0 = b0 + gv[bj][0] * (acc[ai][bj][m][0] * SC), v1 = b1 + gv[bj][1] * (acc[ai][bj][m][1] * SC);
                    u32x4 wo; wo.x = cvtpk(v0[0], v0[1]); wo.y = cvtpk(v0[2], v0[3]); wo.z = cvtpk(v1[0], v1[1]); wo.w = cvtpk(v1[2], v1[3]);
                    *(u32x4*)((char*)(dst + uo) + (lo + bj * 128) * 2u) = wo; } }
    }
};
struct MoeSched {
    const LAS int* pb; int NTN, G, c;
    __device__ bool map(int i, Unit& u) const {
        const int x = c & 7, q = i * (G >> 3) + (c >> 3); const int blk = (q / NTN) * 8 + x; u.pn = q % NTN;
        if (blk >= __builtin_amdgcn_readfirstlane(pb[32])) return false;
        int lo = 0;
#pragma unroll
        for (int st = 16; st >= 1; st >>= 1) { if (__builtin_amdgcn_readfirstlane(pb[lo + st]) <= blk) lo += st; }
        u.e = lo; u.rb = blk - __builtin_amdgcn_readfirstlane(pb[lo]); u.pm = blk; return true;
    }
};
struct ProbMoe1 {
    static constexpr bool PERM = true, GATHER = !(MOE_PREGATHER && MOE_FP8), FP8 = MOE_FP8 != 0; int K, lda; const bf16_t* H; const bf16_t* W1; const float* B1; bf16_t* ACT; const int* rowl; const LAS int* cnt; MoeSched ms; int wave_s;
    __device__ bool next(int i, Unit& u) const { return ms.map(i, u); }
    __device__ const void* a_mat() const { return H; } __device__ const void* b_mat() const { return W1; }
    __device__ unsigned a_off(const Unit& u) const { return GATHER ? 0u : (unsigned)u.pm * 256u * 1024u; }
    __device__ unsigned b_off(const Unit& u) const { return ((unsigned)u.e * 2048u + (unsigned)u.pn * 256u) * 1024u * (FP8 ? 1u : 2u); }
    __device__ void a_voff(const Unit& u, unsigned (&vo)[2][2]) const {
        const int n = cnt[u.e]; const int* rl = rowl + (size_t)u.e * ROWCAP + u.rb * 256;
        const int tidg = tid_fresh(wave_s);
#pragma unroll
        for (int i = 0; i < 2; ++i) { int R, C; pg8::stage_rc(tidg * 16 + i * 8192, R, C);
#pragma unroll
            for (int h = 0; h < 2; ++h) { const int ri = h * 128 + R; const int tok = (u.rb * 256 + ri < n) ? rl[ri] : 0; vo[h][i] = (unsigned)tok * (FP8 ? 1024u : 2048u) + (unsigned)C * 2u; } }
    }
    __device__ void epi(const Acc& acc, const Unit& u, int wr, int wc, int fr, int fq) const {
        const int row0 = wr * 64 + fr, col0 = u.pn * 128 + wc * 32 + 8 * fq;
        const float* bg = B1 + (size_t)u.e * 2048 + col0; const float* bl = bg + 1024;
        f32x4 bgv[2], blv[2];
#pragma unroll
        for (int n = 0; n < 2; ++n) { bgv[n] = *(const f32x4*)(bg + 4 * n); blv[n] = *(const f32x4*)(bl + 4 * n); }
        constexpr float SC = FP8 ? (1.f / 256.f) : 1.f;
        bf16_t* dst = ACT + (size_t)u.pm * 256 * 1024; unsigned char* dst8 = (unsigned char*)ACT + (size_t)u.pm * 256 * 1024; const unsigned lane_off = (unsigned)(row0 * 1024 + col0);
#pragma unroll
        for (int ai = 0; ai < 2; ++ai)
#pragma unroll
            for (int m = 0; m < 4; ++m) { float a[8];
#pragma unroll
                for (int n = 0; n < 2; ++n) { const f32x4 g = acc[ai][0][m][n] * SC + bgv[n], l = acc[ai][1][m][n] * SC + blv[n];
#pragma unroll
                    for (int j = 0; j < 4; ++j) { const float gg = fminf(g[j], 7.f), ll = fminf(fmaxf(l[j], -7.f), 7.f);
                        a[4 * n + j] = gg * __builtin_amdgcn_rcpf(1.f + __builtin_amdgcn_exp2f(-1.702f * 1.4426950408889634f * gg)) * (ll + 1.f); } }
                if constexpr (FP8) { u32x2 w; w.x = pk4_fp8(a[0] * 8.f, a[1] * 8.f, a[2] * 8.f, a[3] * 8.f); w.y = pk4_fp8(a[4] * 8.f, a[5] * 8.f, a[6] * 8.f, a[7] * 8.f);
                    *(u32x2*)(dst8 + (size_t)((ai * 128 + m * 16) * 1024) + lane_off) = w; }
                else { u32x4 w; w.x = cvtpk(a[0], a[1]); w.y = cvtpk(a[2], a[3]); w.z = cvtpk(a[4], a[5]); w.w = cvtpk(a[6], a[7]);
                    *(u32x4*)((char*)dst + (size_t)((ai * 128 + m * 16) * 2048) + lane_off * 2u) = w; } }
    }
};
struct ProbMoe2 {
    static constexpr bool PERM = true, GATHER = false, FP8 = MOE_FP8 != 0; int K, lda; const bf16_t* ACT; const bf16_t* W2; const float* B2; bf16_t* Y; MoeSched ms;
    __device__ bool next(int i, Unit& u) const { return ms.map(i, u); }
    __device__ const void* a_mat() const { return ACT; } __device__ const void* b_mat() const { return W2; }
    __device__ unsigned a_off(const Unit& u) const { return (unsigned)u.pm * 256u * 1024u * (FP8 ? 1u : 2u); }
    __device__ unsigned b_off(const Unit& u) const { return ((unsigned)u.e * 1024u + (unsigned)u.pn * 256u) * 1024u * (FP8 ? 1u : 2u); }
    __device__ void a_voff(const Unit&, unsigned (&)[2][2]) const {}
    __device__ void epi(const Acc& acc, const Unit& u, int wr, int wc, int fr, int fq) const {
        constexpr float SC = FP8 ? (1.f / 512.f) : 1.f;
#if Y_FP8
        const int row0 = wr * 64 + fr, col0 = wc * 32 + 8 * fq; const float* bias = B2 + (size_t)u.e * 1024 + u.pn * 256 + col0;
        f32x4 bv[2][2];
#pragma unroll
        for (int bj = 0; bj < 2; ++bj)
#pragma unroll
            for (int n = 0; n < 2; ++n) bv[bj][n] = *(const f32x4*)(bias + bj * 128 + 4 * n);
        unsigned char* dst = (unsigned char*)Y + ((size_t)u.pm * 256) * 1024 + u.pn * 256; const unsigned lane_off = (unsigned)(row0 * 1024 + col0);
#pragma unroll
        for (int ai = 0; ai < 2; ++ai)
#pragma unroll
            for (int m = 0; m < 4; ++m) { unsigned char* rowb = dst + (size_t)((ai * 128 + m * 16) * 1024);
#pragma unroll
                for (int bj = 0; bj < 2; ++bj) { const f32x4 v0 = (acc[ai][bj][m][0] * SC + bv[bj][0]) * 16.f, v1 = (acc[ai][bj][m][1] * SC + bv[bj][1]) * 16.f;
                    u32x2 w; w.x = pk4_fp8(v0[0], v0[1], v0[2], v0[3]); w.y = pk4_fp8(v1[0], v1[1], v1[2], v1[3]);
                    *(u32x2*)(rowb + lane_off + bj * 128) = w; } }
#else
        pg8::epi_store_bf16<false>(acc, Y + (size_t)u.pm * 256 * 1024 + u.pn * 256, 1024, B2 + (size_t)u.e * 1024 + u.pn * 256, wr, wc, fr, fq, SC);
#endif
    }
};

__global__ void __launch_bounds__(512, 2) fwd_kernel(Args args) {
    extern __shared__ __attribute__((aligned(16))) uchar lds_raw[];
    const int wave_s = __builtin_amdgcn_readfirstlane((int)threadIdx.x >> 6);
    Frame F; F.lds = (LAS uchar*)lds_raw; F.tid = tid_fresh(wave_s); F.lane = F.tid & 63; F.wave = wave_s; F.G = gridDim.x; F.bid = blockIdx.x;
    F.ws = args.ws; F.out = args.out;
    volatile LAS unsigned* MISC = (volatile LAS unsigned*)(F.lds + MISC_OFF);
    if (F.tid < 64) MISC[F.tid] = 0u;
    __syncthreads();
    unsigned* ctl = (unsigned*)(F.ws + WS_CTL);
    XcdBarrier bar; bar.bar = ctl + CW_BAR; bar.x = 0; bar.st = nullptr;
    const int lo = args.ph_lo, hi = args.ph_hi;
    bar = xcd_barrier_post(ctl + CW_BAR + (lo & 1) * XCD_BAR_WORDS, MISC + 8, F.tid == 0);
#ifndef PHMASK
#define PHMASK 0x7ffff
#endif
#define REFRAME() do { F.tid = tid_fresh(wave_s); F.lane = F.tid & 63; F.wave = wave_s; } while (0)
#define IN(k) (((PHMASK >> (k)) & 1) && lo <= (k) && (k) < hi)
#define SEAM(k) do { if (IN(k) && IN((k) + 1)) { const int t_ = tid_fresh(wave_s); xcd_barrier(bar, t_ == 0); } } while (0)
    uchar* ws = F.ws;
    bf16_t* H = (bf16_t*)(ws + WS_H); bf16_t* XR = (bf16_t*)(ws + WS_XR); const float* MOD = (const float*)(ws + WS_MOD);

    if (IN(0)) { REFRAME(); p0_prologue(F); } SEAM(0);
    if (IN(1)) { REFRAME(); p_norm0(F); } SEAM(1);
    if (IN(2)) { REFRAME(); ProbIn0 p; p.K = PROJ0_FP8 ? 512 : 1024; p.lda = p.K; p.A = H; p.Bt = (const bf16_t*)(ws + WS_WIN0); p.O = (bf16_t*)(ws + WS_PBUF); p.so.init(NPAN, 8); p.G = F.G; p.c = F.bid; pg8::gemm_phase(F.lds, p, wave_s); } SEAM(2);
    if (IN(3)) { REFRAME(); p_qk_prep(F); REFRAME(); p_sgu(F); } SEAM(3);
    if (IN(4)) { REFRAME();
        const bf16_t* P = (const bf16_t*)(ws + WS_PBUF); bf16_t* MIX = (bf16_t*)(ws + WS_MIX0);
        for (int u = F.bid; u < 1024 + 128; u += F.G) {
            if (u < 1024) { const int qb = u & 7, g = (u >> 3) & 1, kvh = (u >> 4) & 1, b = u >> 5, h = kvh * 2 + g; const size_t kr0 = (size_t)b * TPB, qr0 = kr0 + CTXL + qb * 256;
                if constexpr (GQA_QK_FP8 != 0) att::attn_unit_qk8<128, false, 2048, 2048, 1024, false>(P + qr0 * 2048 + 1024 + h * 128, P + kr0 * 2048 + 1536 + kvh * 128, nullptr, P + kr0 * 2048 + 1792 + kvh * 128, MIX + qr0 * 1024 + 512 + h * 128, TPB, (LAS char*)F.lds, nullptr, 0, wave_s);
                else att::attn_unit<128, 2, false, 2048, 2048, 1024>(P + qr0 * 2048 + 1024 + h * 128, P + kr0 * 2048 + 1536 + kvh * 128, nullptr, P + kr0 * 2048 + 1792 + kvh * 128, MIX + qr0 * 1024 + 512 + h * 128, TPB, (LAS char*)F.lds, nullptr, 0, wave_s);
            } else { const int v = u - 1024, h = v & 3, b = v >> 2, kvh = h >> 1; const size_t kr0 = (size_t)b * TPB;
                if constexpr (GQA_QK_FP8 != 0) att::attn_unit_qk8<128, false, 2048, 2048, 1024, false>(P + kr0 * 2048 + 1024 + h * 128, P + kr0 * 2048 + 1536 + kvh * 128, nullptr, P + kr0 * 2048 + 1792 + kvh * 128, MIX + kr0 * 1024 + 512 + h * 128, CTXL, (LAS char*)F.lds, nullptr, 0, wave_s);
                else att::attn_unit<128, 2, false, 2048, 2048, 1024>(P + kr0 * 2048 + 1024 + h * 128, P + kr0 * 2048 + 1536 + kvh * 128, nullptr, P + kr0 * 2048 + 1792 + kvh * 128, MIX + kr0 * 1024 + 512 + h * 128, CTXL, (LAS char*)F.lds, nullptr, 0, wave_s); }
        }
    } SEAM(4);
    if (IN(5)) { REFRAME(); ProbOut<0> p; p.K = 1024; p.lda = 1024; p.A = (const bf16_t*)(ws + WS_MIX0); p.Bt = (const bf16_t*)(ws + WS_WOUT0); p.XR = XR; p.MOD = MOD; p.xin = INP(I_X); p.cin = INP(I_CTX); p.so.init(NPAN, 4); p.G = F.G; p.c = F.bid; pg8::gemm_phase(F.lds, p, wave_s); } SEAM(5);
    if (IN(6)) { REFRAME(); p_norm_router<0>(F, args.dry); } SEAM(6);
    if (IN(7)) { REFRAME();
#if MOE_PREGATHER && MOE_FP8
        p_moe_gather(F, 0); { const int t_ = tid_fresh(wave_s); xcd_barrier(bar, t_ == 0); } REFRAME();
#endif
        moe_prefix(F, 0); ProbMoe1 p; p.K = MOE_FP8 ? 512 : 1024; p.lda = p.K; p.H = (MOE_PREGATHER && MOE_FP8) ? (const bf16_t*)(ws + WS_XS) : H; p.W1 = (const bf16_t*)(ws + WS_W1); p.B1 = INP(I_B1); p.ACT = (bf16_t*)(ws + WS_ACT); p.rowl = (const int*)(ws + WS_ROWL);
        p.cnt = (const LAS int*)(F.lds + XTRA_OFF + X_CNT); p.wave_s = wave_s; p.ms.pb = (const LAS int*)(F.lds + XTRA_OFF + X_PB); p.ms.NTN = 8; p.ms.G = F.G; p.ms.c = F.bid; pg8::gemm_phase(F.lds, p, wave_s); } SEAM(7);
    if (IN(8)) { REFRAME(); moe_prefix(F, 0); ProbMoe2 p; p.K = MOE_FP8 ? 512 : 1024; p.lda = p.K; p.ACT = (const bf16_t*)(ws + WS_ACT); p.W2 = (const bf16_t*)(ws + WS_W2); p.B2 = INP(I_B2); p.Y = (bf16_t*)(ws + WS_Y);
        p.ms.pb = (const LAS int*)(F.lds + XTRA_OFF + X_PB); p.ms.NTN = 4; p.ms.G = F.G; p.ms.c = F.bid; pg8::gemm_phase(F.lds, p, wave_s); } SEAM(8);
    if (IN(9)) { REFRAME(); p_combine_norm(F, args.dry); } SEAM(9);
    if (IN(10)) { REFRAME(); ProbIn1 p; p.K = PROJ1_FP8 ? 512 : 1024; p.lda = p.K; p.A = H; p.Bt = (const bf16_t*)(ws + WS_WIN1); p.O = (bf16_t*)(ws + WS_PBUF); p.so.init(256, 4); p.G = F.G; p.c = F.bid; pg8::gemm_phase(F.lds, p, wave_s); } SEAM(10);
    if (IN(11)) { REFRAME(); p_mla_prep(F); } SEAM(11);
    if (IN(12)) { REFRAME();
        { ProbPlain<true, UPQ_FP8 != 0> p; p.K = UPQ_FP8 ? 256 : 512; p.lda = UPQ_FP8 ? 256 : 1024; p.A = UPQ_FP8 ? (const bf16_t*)(ws + WS_CQ8) : (const bf16_t*)(ws + WS_PBUF); p.Bt = (const bf16_t*)(ws + WS_WUQ); p.O = (bf16_t*)(ws + WS_QB); p.ldc = 1536; p.so.init(256, 6); p.G = F.G; p.c = F.bid; pg8::gemm_phase(F.lds, p, wave_s); }
        { ProbPlain<false, UPKV_FP8 != 0> p; p.K = UPKV_FP8 ? 128 : 256; p.lda = UPKV_FP8 ? 128 : 1024; p.A = UPKV_FP8 ? (const bf16_t*)(ws + WS_CKV8) : (const bf16_t*)(ws + WS_PBUF) + 512; p.Bt = (const bf16_t*)(ws + WS_WUKV); p.O = (bf16_t*)(ws + WS_KVB); p.ldc = 2048; p.so.init(NPAN, 8); p.G = F.G; p.c = F.bid; pg8::gemm_phase(F.lds, p, wave_s); }
    } SEAM(12);
    if (IN(13)) { REFRAME();
        const bf16_t* Q = (const bf16_t*)(ws + WS_QB); const bf16_t* KV = (const bf16_t*)(ws + WS_KVB); const bf16_t* KR = (const bf16_t*)(ws + WS_KRB); bf16_t* MIX = (bf16_t*)(ws + WS_MIX1);
        for (int u = F.bid; u < 2048; u += F.G) { const int qb = u & 7, h = (u >> 3) & 7, b = u >> 6; const size_t kr0 = (size_t)b * TPB, qr0 = kr0 + CTXL + qb * 256;
            att::attn_unit_qk8<192, true, 1536, 2048, 1024, OUT1_FP8 != 0>(Q + qr0 * 1536 + h * 192, KV + kr0 * 2048 + h * 128, KR + kr0 * 64, KV + kr0 * 2048 + 1024 + h * 128, OUT1_FP8 ? (bf16_t*)((unsigned char*)MIX + qr0 * 1024 + h * 128) : MIX + qr0 * 1024 + h * 128, TPB, (LAS char*)F.lds, (const f32x2*)(ws + WS_TABM), qb * 256, wave_s); }
    } SEAM(13);
    if (IN(14)) { REFRAME(); ProbOut<1> p; p.K = OUT1_FP8 ? 512 : 1024; p.lda = p.K; p.A = (const bf16_t*)(ws + WS_MIX1); p.Bt = (const bf16_t*)(ws + WS_WOUT1); p.XR = XR; p.MOD = MOD; p.xin = nullptr; p.cin = nullptr; p.so.init(256, 4); p.G = F.G; p.c = F.bid; pg8::gemm_phase(F.lds, p, wave_s); } SEAM(14);
    if (IN(15)) { REFRAME(); p_norm_router<1>(F, args.dry); } SEAM(15);
    if (IN(16)) { REFRAME();
#if MOE_PREGATHER && MOE_FP8
        p_moe_gather(F, 1); { const int t_ = tid_fresh(wave_s); xcd_barrier(bar, t_ == 0); } REFRAME();
#endif
        moe_prefix(F, 1); ProbMoe1 p; p.K = MOE_FP8 ? 512 : 1024; p.lda = p.K; p.H = (MOE_PREGATHER && MOE_FP8) ? (const bf16_t*)(ws + WS_XS) : H; p.W1 = (const bf16_t*)(ws + WS_W1 + (size_t)32 * 2048 * 1024 * (MOE_FP8 ? 1 : 2)); p.B1 = INP(I_B1) + 32 * 2048; p.ACT = (bf16_t*)(ws + WS_ACT); p.rowl = (const int*)(ws + WS_ROWL);
        p.cnt = (const LAS int*)(F.lds + XTRA_OFF + X_CNT); p.wave_s = wave_s; p.ms.pb = (const LAS int*)(F.lds + XTRA_OFF + X_PB); p.ms.NTN = 8; p.ms.G = F.G; p.ms.c = F.bid; pg8::gemm_phase(F.lds, p, wave_s); } SEAM(16);
    if (IN(17)) { REFRAME(); moe_prefix(F, 1); ProbMoe2 p; p.K = MOE_FP8 ? 512 : 1024; p.lda = p.K; p.ACT = (const bf16_t*)(ws + WS_ACT); p.W2 = (const bf16_t*)(ws + WS_W2 + (size_t)32 * 1024 * 1024 * (MOE_FP8 ? 1 : 2)); p.B2 = INP(I_B2) + 32 * 1024; p.Y = (bf16_t*)(ws + WS_Y);
        p.ms.pb = (const LAS int*)(F.lds + XTRA_OFF + X_PB); p.ms.NTN = 4; p.ms.G = F.G; p.ms.c = F.bid; pg8::gemm_phase(F.lds, p, wave_s); } SEAM(17);
    if (IN(18)) { REFRAME(); p_final(F); }
#undef IN
#undef SEAM
}

extern "C" void kernel_launch(void* const* d_in, const int* in_sizes, int n_in, void* d_out, int out_size, void* d_ws, size_t ws_size, hipStream_t stream) {
    static int grid = 0;
    if (grid == 0) {
        if (n_in != 28 || out_size != NBATCH * SEQ * DM || ws_size < WS_END) { fprintf(stderr, "kernel_launch: unexpected shapes (n_in %d out %d ws %zu, need ws >= %zu)\n", n_in, out_size, ws_size, (size_t)WS_END); grid = -1; return; }
        int dev = 0, cus = 0, per_cu = 0;
        if (hipGetDevice(&dev) != hipSuccess || hipDeviceGetAttribute(&cus, hipDeviceAttributeMultiprocessorCount, dev) != hipSuccess) { grid = -1; return; }
        if (hipFuncSetAttribute((const void*)fwd_kernel, hipFuncAttributeMaxDynamicSharedMemorySize, LDS_BYTES) != hipSuccess) { fprintf(stderr, "kernel_launch: hipFuncSetAttribute failed\n"); grid = -1; return; }
        if (hipOccupancyMaxActiveBlocksPerMultiprocessor(&per_cu, (const void*)fwd_kernel, 512, LDS_BYTES) != hipSuccess || per_cu < 1) { fprintf(stderr, "kernel_launch: occupancy query says %d blocks/CU\n", per_cu); }
        (void)hipGetLastError();
        grid = cus;
    }
    if (grid < 0) return;
    (void)hipMemsetAsync((char*)d_ws + WS_CTL, 0, CTL_BYTES, stream);
    Args a{};
    for (int i = 0; i < 28; ++i) a.in[i] = (const float*)d_in[i];
    a.out = (float*)d_out; a.ws = (uchar*)d_ws;
#if MK_ONE_LAUNCH
    a.ph_lo = 0; a.ph_hi = NPHASE;
    hipLaunchKernelGGL(fwd_kernel, dim3(grid), dim3(512), LDS_BYTES, stream, a);
#else
    for (int ph = 0; ph < NPHASE; ++ph) { a.ph_lo = ph; a.ph_hi = ph + 1; const int nrep = 1 + ((REPEAT_MASK >> ph) & 1); for (int rep = 0; rep < nrep; ++rep) { a.dry = (rep + 1 < nrep) ? 1 : 0; hipLaunchKernelGGL(fwd_kernel, dim3(grid), dim3(512), LDS_BYTES, stream, a); } }
#endif
}
```

```cpp
#include <hip/hip_runtime.h>
#include <cstdio>
#include <cstdint>

#ifndef MK_ONE_LAUNCH
#define MK_ONE_LAUNCH 1
#endif
#define REPEAT_MASK 0
#define USE_BUFFER_LDS 1
#define MOE_PREGATHER 0
#define PROJ0_FP8 0
#ifndef UPQ_FP8
#define UPQ_FP8 (MOE_FP8 != 0)
#endif
#ifndef UPKV_FP8
#define UPKV_FP8 1
#endif
#define UP1_FP8_UNUSED 0
#define EPI_P16 1
#define EPI_LDS1 0
#define IDX_LDS 1
#define BIAS_LDS 1
#define ATT_OT 1
#define COMBINE_V2 1
#define SGU_T 1
#define EPI1_PK 1
#define L2PF1 1
#define L2PF2 1
#define NORM0_V2 1
#define P0_ITEM128 1
#define ATT_LSUM_MFMA 1
#define ATT_FOLD 1
#define QB_FP8 1
#define PBUF1_FP8 1
#define ATT_KVDMA 1
#define QC8_FP8 1
#define L2PF 1
#define GEMM_ALIGN_EPI 1
#define ATT_KV8IN 1
#define ATT_PV_FP8 1
#define GQA_QK_FP8 1
#define MLA_QK_FP8 1
#define OUT0_FP8 0
#define OUT1_FP8 (MOE_FP8 != 0)
#define PROJ1_FP8 (MOE_FP8 != 0)
#define PROJ_FP8_UNUSED (MOE_FP8 != 0)
#define PROBE_CLK 0
#define PROBE_CLK_PH 7
#define Y_FP8 1
#ifndef MOE_FP8
#define MOE_FP8 1
#endif

#define LAS __attribute__((address_space(3)))
typedef unsigned short bf16_t;
typedef unsigned char uchar;
typedef short bf16x8 __attribute__((ext_vector_type(8)));
typedef short s16x4 __attribute__((ext_vector_type(4)));
typedef float f32x2 __attribute__((ext_vector_type(2)));
typedef float f32x4 __attribute__((ext_vector_type(4)));
typedef float f32x16 __attribute__((ext_vector_type(16)));
typedef unsigned u32x2 __attribute__((ext_vector_type(2)));
typedef unsigned u32x4 __attribute__((ext_vector_type(4)));
typedef int i32x4 __attribute__((ext_vector_type(4)));
typedef int i32x8 __attribute__((ext_vector_type(8)));

constexpr int DM = 1024, NBATCH = 32, SEQ = 2048, CTXL = 256, TPB = SEQ + CTXL, NTOK = NBATCH * TPB, NPAN = NTOK / 256;
constexpr int NEXP = 32, TOPK = 4, ROWCAP = NTOK;
constexpr float EPS = 1e-6f;
constexpr int NPHASE = 19;

constexpr size_t MiB = 1u << 20;
constexpr size_t WS_CTL = 0, CTL_BYTES = 1 * MiB;
constexpr size_t WS_MOD = 1 * MiB;
constexpr size_t WS_TABG = 3 * MiB;
constexpr size_t WS_TABM = WS_TABG + 32768;
constexpr size_t WS_WRT = WS_TABG + 65536;
constexpr size_t WS_SGUW = WS_WRT + 262144;
constexpr size_t WS_WIN0 = 4 * MiB, WS_WOUT0 = 8 * MiB, WS_WIN1 = 10 * MiB, WS_WUQ = 12 * MiB, WS_WUKV = 14 * MiB, WS_WOUT1 = 15 * MiB;
constexpr size_t WS_W1 = 17 * MiB;
constexpr size_t WS_W2 = 273 * MiB;
constexpr size_t WS_ROWL = 401 * MiB;
constexpr size_t WS_TOKI = 410 * MiB;
constexpr size_t WS_XR = 413 * MiB;
constexpr size_t WS_H = 701 * MiB;
constexpr size_t WS_SCR = 845 * MiB;
constexpr size_t WS_PBUF = WS_SCR;
constexpr size_t WS_MIX0 = WS_SCR + 288 * MiB;
constexpr size_t WS_KC8 = WS_SCR + 432 * MiB;
constexpr size_t WS_QC8 = WS_SCR + 472 * MiB;
constexpr size_t WS_VC8 = WS_SCR + 452 * MiB;
constexpr size_t WS_KR8 = WS_SCR + 880 * MiB;
constexpr size_t WS_QB = WS_SCR + 144 * MiB;
constexpr size_t WS_KVB = WS_SCR + 360 * MiB;
constexpr size_t WS_KRB = WS_SCR + 648 * MiB;
constexpr size_t WS_MIX1 = WS_SCR + 660 * MiB;
constexpr size_t WS_CQ8 = WS_SCR + 804 * MiB;
constexpr size_t WS_CKV8 = WS_SCR + 840 * MiB;
constexpr size_t WS_ACT = WS_SCR;
constexpr size_t WS_XS = WS_SCR + 296 * MiB;
constexpr size_t WS_Y = WS_SCR + 592 * MiB;
constexpr size_t WS_END = WS_SCR + 1184 * MiB;
constexpr int CW_BAR = 1024;
constexpr int CW_CNT = 8192;
constexpr int CW_DBG = 16384;

constexpr int RING_BYTES = 131072;
constexpr int XTRA_OFF = RING_BYTES, XTRA_BYTES = 20480;
constexpr int MISC_OFF = XTRA_OFF + XTRA_BYTES;
constexpr int LDS_BYTES = MISC_OFF + 512;
constexpr int X_PB = 0;
constexpr int X_CNT = 256;
constexpr int X_HIST = 512;
constexpr int X_BASE = 768;
constexpr int X_SEL = 1024;
constexpr int X_A2 = 9216;
constexpr int X_CB = 13312;
constexpr int X_BT = 12288, BT_N = 1280;
constexpr int X_RS = 13440;

#define LDS_WAIT() asm volatile("s_waitcnt lgkmcnt(0)" ::: "memory")
#define VM_WAIT() asm volatile("s_waitcnt vmcnt(0)" ::: "memory")
#define SBAR() __builtin_amdgcn_sched_barrier(0)
__device__ __forceinline__ unsigned cvtpk(float lo, float hi) { unsigned r; asm volatile("v_cvt_pk_bf16_f32 %0, %1, %2" : "=v"(r) : "v"(lo), "v"(hi)); return r; }
__device__ __forceinline__ float bf2f(unsigned short b) { return __uint_as_float(((unsigned)b) << 16); }
__device__ __forceinline__ float bflo(unsigned w) { return __uint_as_float(w << 16); }
__device__ __forceinline__ float bfhi(unsigned w) { return __uint_as_float(w & 0xffff0000u); }
__device__ __forceinline__ unsigned short f2bf(float f) { return (unsigned short)(cvtpk(f, 0.f) & 0xffffu); }
__device__ __forceinline__ unsigned pk4_fp8(float a, float b, float c, float d) {
    a = __builtin_amdgcn_fmed3f(a, -448.f, 448.f); b = __builtin_amdgcn_fmed3f(b, -448.f, 448.f); c = __builtin_amdgcn_fmed3f(c, -448.f, 448.f); d = __builtin_amdgcn_fmed3f(d, -448.f, 448.f);
    unsigned w = 0; w = __builtin_amdgcn_cvt_pk_fp8_f32(a, b, w, false); w = __builtin_amdgcn_cvt_pk_fp8_f32(c, d, w, true); return w;
}
__device__ __forceinline__ int tid_fresh(int wave_s) { int l; asm volatile("v_mbcnt_lo_u32_b32 %0, -1, 0\n\tv_mbcnt_hi_u32_b32 %0, -1, %0" : "=v"(l)); return wave_s * 64 + l; }
template <int CTRL, int BANK> __device__ __forceinline__ int dpp_i(int old, int x) { return __builtin_amdgcn_update_dpp(old, x, CTRL, 0xF, BANK, false); }
__device__ __forceinline__ int xs1(int x) { return dpp_i<0xB1, 0xF>(x, x); }
__device__ __forceinline__ int xs2(int x) { return dpp_i<0x4E, 0xF>(x, x); }
__device__ __forceinline__ int xs4(int x) { const int t = dpp_i<0x114, 0xA>(x, x); return dpp_i<0x104, 0x5>(t, x); }
__device__ __forceinline__ int xs8(int x) { return dpp_i<0x128, 0xF>(x, x); }
__device__ __forceinline__ float xf1(float x) { return __int_as_float(xs1(__float_as_int(x))); }
__device__ __forceinline__ float xf2(float x) { return __int_as_float(xs2(__float_as_int(x))); }
__device__ __forceinline__ float xf4(float x) { return __int_as_float(xs4(__float_as_int(x))); }
__device__ __forceinline__ float xf8(float x) { return __int_as_float(xs8(__float_as_int(x))); }
__device__ __forceinline__ float sum16(float a, float b) { auto r = __builtin_amdgcn_permlane16_swap(__float_as_uint(a), __float_as_uint(b), false, false); return __uint_as_float(r[0]) + __uint_as_float(r[1]); }
__device__ __forceinline__ float sum32(float a, float b) { auto r = __builtin_amdgcn_permlane32_swap(__float_as_uint(a), __float_as_uint(b), false, false); return __uint_as_float(r[0]) + __uint_as_float(r[1]); }
__device__ __forceinline__ unsigned xu16(unsigned x, int lane) { auto r = __builtin_amdgcn_permlane16_swap(x, x, false, false); return (lane & 16) ? r[0] : r[1]; }
__device__ __forceinline__ unsigned xu32(unsigned x, int lane) { auto r = __builtin_amdgcn_permlane32_swap(x, x, false, false); return (lane & 32) ? r[0] : r[1]; }
__device__ __forceinline__ unsigned pk4_fp8_nz(float a, float b, float c, float d) { unsigned w = __float_as_uint(a); w = __builtin_amdgcn_cvt_pk_fp8_f32(a, b, w, false); w = __builtin_amdgcn_cvt_pk_fp8_f32(c, d, w, true); return w; }
__device__ __forceinline__ unsigned pk4_fp8_nc(float a, float b, float c, float d) { unsigned w = 0; w = __builtin_amdgcn_cvt_pk_fp8_f32(a, b, w, false); w = __builtin_amdgcn_cvt_pk_fp8_f32(c, d, w, true); return w; }
__device__ __forceinline__ float wave_sum(float v) {
    v += xf1(v); v += xf2(v); v += xf4(v); v += xf8(v); v = sum16(v, v); v = sum32(v, v);
    return v;
}
__device__ __forceinline__ float silu_f(float x) { return x / (1.f + __expf(-x)); }
__device__ __forceinline__ float gelu_tanh_f(float x) {
    const float u = x * (1.5957691216057308f + 0.07135481627260025f * x * x);
    const float e = __builtin_amdgcn_exp2f(-1.4426950408889634f * u);
    return x * __builtin_amdgcn_rcpf(1.f + e);
}
__device__ __forceinline__ f32x4 gelu_tanh_4(f32x4 x) {
    const f32x4 x2 = x * x, u = x * (x2 * (-0.07135481627260025f * 1.4426950408889634f) + (-1.5957691216057308f * 1.4426950408889634f));
    const f32x4 d = (f32x4){__builtin_amdgcn_exp2f(u.x), __builtin_amdgcn_exp2f(u.y), __builtin_amdgcn_exp2f(u.z), __builtin_amdgcn_exp2f(u.w)} + 1.f;
    return x * (f32x4){__builtin_amdgcn_rcpf(d.x), __builtin_amdgcn_rcpf(d.y), __builtin_amdgcn_rcpf(d.z), __builtin_amdgcn_rcpf(d.w)};
}

#define XB_TMO      128
#define XB_XCNT(j)  (256  + 64 * (j))
#define XB_XSUB(j)  (1280 + 64 * (j))
#define XB_XGEN(j)  (2304 + 64 * (j))
#define XB_TOP      3328
#define XB_TOPGEN   3392
#define XCD_BAR_WORDS 3456
#define XB_SPIN_CAP (1u << 20)
__device__ __forceinline__ unsigned xb_ld(unsigned* p)              { return __hip_atomic_load(p, __ATOMIC_RELAXED, __HIP_MEMORY_SCOPE_AGENT); }
__device__ __forceinline__ unsigned xb_add(unsigned* p, unsigned v) { return __hip_atomic_fetch_add(p, v, __ATOMIC_RELAXED, __HIP_MEMORY_SCOPE_AGENT); }
__device__ __forceinline__ unsigned xb_xcc_id() { return (unsigned)__builtin_amdgcn_s_getreg((3 << 11) | 20) & 0xFu; }
#define XB_SPIN(cond, bar) do { unsigned _sp = 0; while (cond) { __builtin_amdgcn_s_sleep(1); \
    if ((++_sp & 255u) == 0u) { if (xb_ld(&(bar)[XB_TMO])) break; if (_sp > XB_SPIN_CAP) { atomicAdd(&(bar)[XB_TMO], 1u); break; } } } } while (0)
struct XcdBarrier { unsigned* bar; unsigned x; volatile LAS unsigned* st; };
__device__ __forceinline__ XcdBarrier xcd_barrier_post(unsigned* bar, volatile LAS unsigned* st, bool t0) {
    XcdBarrier b; b.bar = bar; b.x = xb_xcc_id(); b.st = st;
    if (t0) (void)xb_add(&bar[XB_XCNT(b.x)], 1u);
    return b;
}
__device__ __forceinline__ void xcd_barrier_complete(unsigned* bar, unsigned x, unsigned& nloc, unsigned& nx) {
    const unsigned G = gridDim.x * gridDim.y * gridDim.z;
    unsigned sum, cnt, mine, sp = 0u;
    for (;;) {
        sum = 0u; cnt = 0u; mine = 0u;
#pragma unroll
        for (unsigned j = 0; j < 16; ++j) { const unsigned c = xb_ld(&bar[XB_XCNT(j)]); sum += c; cnt += (c > 0u) ? 1u : 0u; mine = (j == x) ? c : mine; }
        if (sum == G) break;
        __builtin_amdgcn_s_sleep(1);
        if ((++sp & 255u) == 0u) { if (xb_ld(&bar[XB_TMO])) break; if (sp > XB_SPIN_CAP) { atomicAdd(&bar[XB_TMO], 1u); break; } }
    }
    nloc = mine > 0u ? mine : 1u; nx = cnt > 0u ? cnt : 1u;
}
__device__ __forceinline__ void xcd_barrier(const XcdBarrier& b, bool t0) {
    asm volatile("s_waitcnt vmcnt(0)" ::: "memory");
    __syncthreads();
    if (t0) {
        unsigned* bar = b.bar;
        __builtin_amdgcn_s_waitcnt(0);
        unsigned nloc = b.st[0], nx = b.st[1];
        if (nloc == 0u) { xcd_barrier_complete(bar, b.x, nloc, nx); b.st[0] = nloc; b.st[1] = nx; }
        const unsigned old = xb_add(&bar[XB_XSUB(b.x)], 1u);
        const unsigned gen = old / nloc;
        if (old + 1u == (gen + 1u) * nloc) {
            __builtin_amdgcn_fence(__ATOMIC_RELEASE, "agent");
            asm volatile("s_waitcnt vmcnt(0)" ::: "memory");
            const unsigned og = xb_add(&bar[XB_TOP], 1u);
            const unsigned tg = og / nx;
            if (og + 1u == (tg + 1u) * nx) xb_add(&bar[XB_TOPGEN], 1u);
            else XB_SPIN(xb_ld(&bar[XB_TOPGEN]) == tg, bar);
            __builtin_amdgcn_fence(__ATOMIC_ACQUIRE, "agent");
            xb_add(&bar[XB_XGEN(b.x)], 1u);
            asm volatile("s_waitcnt vmcnt(0)" ::: "memory");
        } else {
            XB_SPIN(xb_ld(&bar[XB_XGEN(b.x)]) == gen, bar);
            __builtin_amdgcn_fence(__ATOMIC_ACQUIRE, "agent");
            asm volatile("s_waitcnt vmcnt(0)" ::: "memory");
        }
    }
    __syncthreads();
}

struct Args { const float* in[28]; float* out; uchar* ws; int ph_lo, ph_hi, dry, pad; };
enum { I_X = 0, I_C, I_CTX, I_CCTX, I_ADAW, I_ADAB, I_NMIXG, I_NFFNG, I_ABWIN, I_SGUNG, I_SGUW, I_SGUB, I_GQG, I_GKG, I_ABWOUT, I_MLAWIN, I_MLAQG, I_MLAKVG, I_MLAWUQ, I_MLAWUKV, I_MLAWOUT,
       I_RW, I_RB, I_W1, I_B1, I_W2, I_B2, I_FNG };
struct Frame {
    LAS uchar* lds; int tid, lane, wave, G, bid;
    uchar* ws; float* out;
};
__device__ __forceinline__ const float* INP(int i) {
    const __attribute__((address_space(4))) char* ka = (const __attribute__((address_space(4))) char*)__builtin_amdgcn_kernarg_segment_ptr();
    return *(const float* const volatile __attribute__((address_space(4)))*)(ka + i * 8);
}

namespace pg8 {
constexpr int BM = 256, BK = 64, HALF = 128, HTB = HALF * BK * 2, NXCD = 8, WGM = 8;
__device__ __forceinline__ int lds_byte(int r, int c) { const int st = (r >> 4) * 2 + (c >> 5), rr = r & 15, cc = c & 31, ob = rr * 64 + cc * 2; return st * 1024 + (ob ^ (((ob >> 9) & 1) << 5)); }
__device__ __forceinline__ void stage_rc(int b, int& R, int& C) { const int st = b / 1024, sb = b % 1024, swz = sb ^ (((sb >> 9) & 1) << 5); R = (st >> 1) * 16 + swz / 64; C = (st & 1) * 32 + (swz % 64) / 2; }
__device__ __forceinline__ int perm32(int rho) { const int n = rho >> 4, i = rho & 15; return 8 * (i >> 2) + 4 * n + (i & 3); }
struct Unit { int pm, pn, e, rb; };
struct StaticOrder {
    int nM, nN, nwg;
    __device__ void init(int nM_, int nN_) { nM = nM_; nN = nN_; nwg = nM * nN; }
    __device__ bool map(long L, int& pm, int& pn) const {
        if (L >= nwg) return false;
        int wgid = (int)L; { const int q = nwg / NXCD, r = nwg % NXCD, xcd = wgid % NXCD, off = wgid / NXCD; wgid = (xcd < r ? xcd * (q + 1) : r * (q + 1) + (xcd - r) * q) + off; }
        const int nig = WGM * nN, gid = wgid / nig, fm = gid * WGM, gsz = (nM - fm) < WGM ? (nM - fm) : WGM;
        pm = fm + ((wgid % nig) % gsz); pn = (wgid % nig) / gsz; return true;
    }
};
typedef f32x4 Acc[2][2][4][2];
template <class P>
__device__ __forceinline__ void gemm_phase(LAS uchar* lds, const P& p, int wave_s) {
    const int tid = tid_fresh(wave_s), wid = __builtin_amdgcn_readfirstlane(tid >> 6), lane = tid & 63, wr = wid >> 2, wc = wid & 3, fr = lane & 15, fq = lane >> 4;
    const int K = P::KCONST ? P::KCONST : p.K, nt = K / BK;
    unsigned voffA[2][2], voffB[2];
#pragma unroll
    for (int i = 0; i < 2; ++i) { int R, C; stage_rc(tid * 16 + i * 8192, R, C); const int Rb = P::P16 ? (64 * (R >> 5) + 16 * ((R & 15) >> 2) + 4 * ((R >> 4) & 1) + (R & 3)) : P::PERM ? ((R & ~31) + perm32(R & 31)) : R;
        voffA[0][i] = (unsigned)(R * p.lda + C) * 2u; voffA[1][i] = voffA[0][i]; voffB[i] = (unsigned)(Rb * K + C) * 2u; }
    const unsigned kstep = (unsigned)(BK * 2);
    const unsigned hstepB = (unsigned)(P::P16 ? 8 : HALF) * K * 2;
    const unsigned hstepA = P::GATHER ? 0u : (unsigned)HALF * p.lda * 2;
#define PG8_VA1 voffA[P::GATHER ? 1 : 0]
    const __amdgpu_buffer_rsrc_t rsA = __builtin_amdgcn_make_buffer_rsrc((void*)p.a_mat(), 0, 0xffffffffu, 0x00020000);
    const __amdgpu_buffer_rsrc_t rsB = __builtin_amdgcn_make_buffer_rsrc((void*)p.b_mat(), 0, 0xffffffffu, 0x00020000);
    const char* gpA = (const char*)p.a_mat(); const char* gpB = (const char*)p.b_mat(); (void)gpA; (void)gpB; (void)rsA; (void)rsB;
    unsigned ldsw = (unsigned)wid * 1024u;
    const int aoff = lds_byte(wr * 64 + fr, fq * 8), boff = lds_byte(wc * 32 + fr, fq * 8);
#define PG8_SA(b, h) (((b) * 2 + (h)) * HTB)
#define PG8_SB(b, h) ((4 + (b) * 2 + (h)) * HTB)
#if USE_BUFFER_LDS
#define PG8_STAGE_R(bufoff, rs, gp, soff, voff) do { _Pragma("unroll") for (int _i = 0; _i < 2; ++_i) \
        __builtin_amdgcn_raw_ptr_buffer_load_lds(rs, (LAS unsigned*)(lds + (bufoff) + ldsw + _i * 8192), 16, (int)(voff)[_i], (int)(soff), 0, 0); } while (0)
#else
#define PG8_STAGE_R(bufoff, rs, gp, soff, voff) do { _Pragma("unroll") for (int _i = 0; _i < 2; ++_i) \
        __builtin_amdgcn_global_load_lds((const unsigned*)((const char*)(gp) + (size_t)(soff) + (voff)[_i]), (LAS unsigned*)(lds + (bufoff) + ldsw + _i * 8192), 16, 0, 0); } while (0)
#endif
#define PG8_STAGE_A(bufoff, soff, voff) PG8_STAGE_R(bufoff, rsA, gpA, soff, voff)
#define PG8_STAGE_B(bufoff, soff, voff) PG8_STAGE_R(bufoff, rsB, gpB, soff, voff)
#define PG8_LDA(dst, b, h) do { _Pragma("unroll") for (int m = 0; m < 4; ++m) _Pragma("unroll") for (int k = 0; k < 2; ++k) dst[m][k] = *(const LAS i32x4*)(lds + PG8_SA(b, h) + aoff + m * 2048 + k * 1024); } while (0)
#define PG8_LDB(dst, b, h) do { _Pragma("unroll") for (int n = 0; n < 2; ++n) _Pragma("unroll") for (int k = 0; k < 2; ++k) dst[n][k] = *(const LAS i32x4*)(lds + PG8_SB(b, h) + boff + n * 2048 + k * 1024); } while (0)
#define PG8_CAT(x) __builtin_shufflevector((x)[0], (x)[1], 0, 1, 2, 3, 4, 5, 6, 7)
#define PG8_MMA(ai, bj, At, Bt) do { __builtin_amdgcn_s_setprio(1); \
        if constexpr (P::FP8) { _Pragma("unroll") for (int m = 0; m < 4; ++m) _Pragma("unroll") for (int n = 0; n < 2; ++n) \
            acc[ai][bj][m][n] = __builtin_amdgcn_mfma_scale_f32_16x16x128_f8f6f4(PG8_CAT(Bt[n]), PG8_CAT(At[m]), acc[ai][bj][m][n], 0, 0, 0, 0x7F7F7F7F, 0, 0x7F7F7F7F); } \
        else { _Pragma("unroll") for (int m = 0; m < 4; ++m) _Pragma("unroll") for (int n = 0; n < 2; ++n) _Pragma("unroll") for (int k = 0; k < 2; ++k) \
            acc[ai][bj][m][n] = __builtin_amdgcn_mfma_f32_16x16x32_bf16(__builtin_bit_cast(bf16x8, Bt[n][k]), __builtin_bit_cast(bf16x8, At[m][k]), acc[ai][bj][m][n], 0, 0, 0); } \
        __builtin_amdgcn_s_setprio(0); } while (0)
#define PG8_WAIT_V(n) asm volatile("s_waitcnt vmcnt(" #n ")" ::: "memory")
#define PG8_WAIT_L(n) asm volatile("s_waitcnt lgkmcnt(" #n ")" ::: "memory")
#define PG8_BAR __builtin_amdgcn_s_barrier()
#define PG8_SCHED __builtin_amdgcn_sched_barrier(0)
    Unit cur, nxt; int ui = 0;
    if (!p.next(0, cur)) return;
    Acc acc;
#pragma unroll
    for (int a = 0; a < 2; ++a)
#pragma unroll
        for (int b = 0; b < 2; ++b)
#pragma unroll
            for (int m = 0; m < 4; ++m)
#pragma unroll
                for (int n = 0; n < 2; ++n) acc[a][b][m][n] = (f32x4){0.f, 0.f, 0.f, 0.f};
    i32x4 At[4][2], B0[2][2], B1[2][2];
    unsigned cA = p.a_off(cur), cB = p.b_off(cur);
    if constexpr (P::GATHER) { p.a_voff(cur, voffA); }
    PG8_STAGE_B(PG8_SB(0, 0), cB, voffB); PG8_STAGE_B(PG8_SB(0, 1), cB + hstepB, voffB); PG8_STAGE_A(PG8_SA(0, 0), cA, voffA[0]); PG8_STAGE_A(PG8_SA(0, 1), cA + hstepA, PG8_VA1);
    if (wr == 1) PG8_BAR;
    PG8_WAIT_V(2); PG8_BAR;
    PG8_STAGE_B(PG8_SB(1, 0), cB + kstep, voffB); PG8_STAGE_A(PG8_SA(1, 0), cA + kstep, voffA[0]); PG8_STAGE_B(PG8_SB(1, 1), cB + hstepB + kstep, voffB);
    PG8_WAIT_V(6); PG8_BAR;
    for (;;) {
        const bool has_next = p.next(ui + 1, nxt);
        if constexpr (P::MOE) p.unit_top(cur, nxt, has_next, wid, ui);
        const unsigned nA = has_next ? p.a_off(nxt) : cA, nB = has_next ? p.b_off(nxt) : cB;
#pragma unroll 1
        for (int t = 0; t < nt; t += 2) {
            const bool last = (t == nt - 2);
            asm volatile("" : "+s"(ldsw));
            const unsigned a1 = cA + (unsigned)(t + 1) * kstep;
            const unsigned a2 = last ? nA : cA + (unsigned)(t + 2) * kstep, b2 = last ? nB : cB + (unsigned)(t + 2) * kstep;
            const unsigned a3 = a2 + kstep, b3 = b2 + kstep;
            PG8_LDB(B0, 0, 0); PG8_LDB(B1, 0, 1); PG8_SCHED; PG8_LDA(At, 0, 0); PG8_STAGE_A(PG8_SA(1, 1), a1 + hstepA, PG8_VA1);
            if constexpr (P::GATHER) { if (last && has_next) p.a_voff_next(nxt, voffA); }
            PG8_WAIT_V(8); PG8_WAIT_L(0); PG8_BAR; PG8_MMA(0, 0, At, B0); PG8_MMA(0, 1, At, B1); PG8_BAR; PG8_SCHED;
            PG8_LDA(At, 0, 1); PG8_STAGE_B(PG8_SB(0, 0), b2, voffB); PG8_STAGE_B(PG8_SB(0, 1), b2 + hstepB, voffB); PG8_STAGE_A(PG8_SA(0, 0), a2, voffA[0]);
            PG8_WAIT_V(8); PG8_WAIT_L(0); PG8_BAR; PG8_MMA(1, 0, At, B0); PG8_MMA(1, 1, At, B1); PG8_BAR; PG8_SCHED;
            PG8_LDB(B0, 1, 0); PG8_LDB(B1, 1, 1); PG8_SCHED; PG8_LDA(At, 1, 0); PG8_STAGE_A(PG8_SA(0, 1), a2 + hstepA, PG8_VA1);
            PG8_WAIT_V(8); PG8_WAIT_L(0); PG8_BAR; PG8_MMA(0, 0, At, B0); PG8_MMA(0, 1, At, B1); PG8_BAR; PG8_SCHED;
            PG8_LDA(At, 1, 1); PG8_STAGE_B(PG8_SB(1, 0), b3, voffB); PG8_STAGE_B(PG8_SB(1, 1), b3 + hstepB, voffB); PG8_STAGE_A(PG8_SA(1, 0), a3, voffA[0]);
            PG8_WAIT_V(8); PG8_WAIT_L(0); PG8_BAR; PG8_MMA(1, 0, At, B0); PG8_MMA(1, 1, At, B1); PG8_BAR; PG8_SCHED;
        }
        if (GEMM_ALIGN_EPI && wr == 0) PG8_BAR;
        if constexpr (P::MOE) {
            if constexpr (P::GATHER) {
                if (L2PF != 0 && L2PF1 != 0 && IDX_LDS != 0 && has_next) { const int ln = tid_fresh(p.wave_s) & 63; const int n = p.cnt[nxt.e]; const volatile LAS int* il = (const volatile LAS int*)p.stage;
#pragma unroll
                    for (int r = 0; r < 4; ++r) { const int ri = nxt.pn * 32 + wid * 4 + r; const int tk = il[ri]; const unsigned tok = (nxt.rb * 256 + ri < n) ? (unsigned)tk : 0u;
                        __builtin_amdgcn_raw_ptr_buffer_load_lds(rsA, (LAS unsigned*)(p.stage + 3072 + wid * 1024), 16, (int)(tok * 1024u + (unsigned)ln * 16u), 0, 0, 0); } }
            } else p.epi_prefetch(nxt, has_next, wid);
            p.epi(acc, cur, wr, wc, fr, fq, ui); } else p.epi(acc, cur, wr, wc, fr, fq);
        if (!has_next) break;
#pragma unroll
        for (int a = 0; a < 2; ++a)
#pragma unroll
            for (int b = 0; b < 2; ++b)
#pragma unroll
                for (int m = 0; m < 4; ++m)
#pragma unroll
                    for (int n = 0; n < 2; ++n) acc[a][b][m][n] = (f32x4){0.f, 0.f, 0.f, 0.f};
        cur = nxt; cA = nA; cB = nB; ++ui;
        if (GEMM_ALIGN_EPI && wr == 1) PG8_BAR;
    }
    PG8_WAIT_V(0);
    if (!GEMM_ALIGN_EPI && wr == 0) PG8_BAR;
    PG8_BAR;
#undef PG8_SA
#undef PG8_VA1
#undef PG8_SB
#undef PG8_STAGE_R
#undef PG8_STAGE_A
#undef PG8_STAGE_B
#undef PG8_LDA
#undef PG8_LDB
#undef PG8_MMA
#undef PG8_CAT
#undef PG8_WAIT_V
#undef PG8_WAIT_L
#undef PG8_BAR
#undef PG8_SCHED
}

template <bool GELU>
__device__ __forceinline__ void epi_store_bf16(const Acc& acc, bf16_t* dst  , int ldc, const float* bias  , int wr, int wc, int fr, int fq, float sc = 1.f) {
    const int row0 = wr * 64 + fr, col0 = wc * 32 + 8 * fq;
    f32x4 bv[2][2];
#pragma unroll
    for (int bj = 0; bj < 2; ++bj)
#pragma unroll
        for (int n = 0; n < 2; ++n) bv[bj][n] = bias ? *(const f32x4*)(bias + col0 + bj * HALF + 4 * n) : (f32x4){0.f, 0.f, 0.f, 0.f};
    const unsigned lane_off = (unsigned)(row0 * ldc + col0) * 2u;
#pragma unroll
    for (int ai = 0; ai < 2; ++ai)
#pragma unroll
        for (int m = 0; m < 4; ++m) { char* rowb = (char*)dst + (size_t)((ai * HALF + m * 16) * ldc) * 2;
#pragma unroll
            for (int bj = 0; bj < 2; ++bj) { f32x4 v0 = acc[ai][bj][m][0] * sc + bv[bj][0], v1 = acc[ai][bj][m][1] * sc + bv[bj][1];
                if (GELU) { v0 = gelu_tanh_4(v0); v1 = gelu_tanh_4(v1); }
                u32x4 w; w.x = cvtpk(v0[0], v0[1]); w.y = cvtpk(v0[2], v0[3]); w.z = cvtpk(v1[0], v1[1]); w.w = cvtpk(v1[2], v1[3]);
                *(u32x4*)(rowb + lane_off + bj * HALF * 2) = w; } }
}
template <bool P16v = false>
__device__ __forceinline__ void epi_store_fp8(const Acc& acc, unsigned char* dst  , int ldc, int wr, int wc, int fr, int fq, float sc) {
    const int row0 = wr * 64 + fr, col0 = P16v ? wc * 64 + 16 * fq : wc * 32 + 8 * fq; const unsigned lane_off = (unsigned)(row0 * ldc + col0);
#pragma unroll
    for (int ai = 0; ai < 2; ++ai)
#pragma unroll
        for (int m = 0; m < 4; ++m) { unsigned char* rowb = dst + (size_t)((ai * HALF + m * 16) * ldc);
            if constexpr (P16v) { u32x4 w;
#pragma unroll
                for (int bj = 0; bj < 2; ++bj) { const f32x4 v0 = acc[ai][bj][m][0] * sc, v1 = acc[ai][bj][m][1] * sc;
                    w[2 * bj] = pk4_fp8(v0[0], v0[1], v0[2], v0[3]); w[2 * bj + 1] = pk4_fp8(v1[0], v1[1], v1[2], v1[3]); }
                *(u32x4*)(rowb + lane_off) = w; }
            else {
#pragma unroll
            for (int bj = 0; bj < 2; ++bj) { const f32x4 v0 = acc[ai][bj][m][0] * sc, v1 = acc[ai][bj][m][1] * sc;
                u32x2 w; w.x = pk4_fp8(v0[0], v0[1], v0[2], v0[3]); w.y = pk4_fp8(v1[0], v1[1], v1[2], v1[3]);
                *(u32x2*)(rowb + lane_off + bj * HALF) = w; } } }
}
}

namespace att {
constexpr int NW = 8, QBLK = 32, KVBLK = 64;
constexpr int SHM_V = KVBLK * 128 * 2;
constexpr float THR = 8.f;
__device__ __forceinline__ int crow(int r, int hi) { return (r & 3) + 8 * (r >> 2) + 4 * hi; }
template <int DQK> struct Cfg { static constexpr float SCALE = (DQK == 128) ? 0.088388347648318440f : 0.072168783648703220f; static constexpr int KP = DQK * 2, SHM_K = KVBLK * DQK * 2, ND = DQK / 16; };
#define KSWZ(PITCH, row, colB) ((row) * (PITCH) + ((colB) ^ (((row) & 7) << 4)))
template <int DQK, int QS = 1, int THRI = 8> __device__ __forceinline__ void partialSM(f32x16& p0, f32x16& p1, float& m_reg, float& mn, float& alpha) {
    constexpr float SCALE = Cfg<DQK>::SCALE / (float)QS, C = SCALE * 1.4426950408889634f;
    float pmax = p0[0];
#pragma unroll
    for (int r = 1; r < 16; ++r) pmax = fmaxf(pmax, p0[r]);
#pragma unroll
    for (int r = 0; r < 16; ++r) pmax = fmaxf(pmax, p1[r]);
    { auto rr = __builtin_amdgcn_permlane32_swap(__float_as_uint(pmax), __float_as_uint(pmax), false, false);
      pmax = fmaxf(__uint_as_float(rr[0]), __uint_as_float(rr[1])); }
    if (__builtin_expect(__all(pmax - m_reg <= (float)THRI / SCALE), 1)) { mn = m_reg; alpha = 1.f; }
    else { mn = fmaxf(m_reg, pmax); alpha = __builtin_amdgcn_exp2f((m_reg - mn) * C); m_reg = mn; }
    const float mnC = -mn * C;
#pragma unroll
    for (int r = 0; r < 16; ++r) p0[r] = fmaf(p0[r], C, mnC);
#pragma unroll
    for (int r = 0; r < 16; ++r) p1[r] = fmaf(p1[r], C, mnC);
#pragma unroll
    for (int r = 0; r < 16; ++r) p0[r] = __builtin_amdgcn_exp2f(p0[r]);
}
__device__ __forceinline__ void finishSM(f32x16& p0, f32x16& p1, float alpha, float& l_reg, bf16x8& pa0, bf16x8& pa1, bf16x8& pa2, bf16x8& pa3) {
#pragma unroll
    for (int r = 0; r < 16; ++r) p1[r] = __builtin_amdgcn_exp2f(p1[r]);
    float ps = 0;
#pragma unroll
    for (int r = 0; r < 16; ++r) ps += p0[r];
#pragma unroll
    for (int r = 0; r < 16; ++r) ps += p1[r];
    { auto rr = __builtin_amdgcn_permlane32_swap(__float_as_uint(ps), __float_as_uint(ps), false, false);
      ps = __uint_as_float(rr[0]) + __uint_as_float(rr[1]); }
    l_reg = l_reg * alpha + ps;
#define PK4(P, BASE, OUT) do { unsigned a0 = cvtpk(P[BASE + 0], P[BASE + 1]), a1 = cvtpk(P[BASE + 2], P[BASE + 3]);   \
    unsigned b0 = cvtpk(P[BASE + 4], P[BASE + 5]), b1 = cvtpk(P[BASE + 6], P[BASE + 7]);                              \
    auto r0 = __builtin_amdgcn_permlane32_swap(a0, b0, false, false); auto r1 = __builtin_amdgcn_permlane32_swap(a1, b1, false, false); \
    u32x4 w = {r0[0], r1[0], r0[1], r1[1]}; OUT = *reinterpret_cast<bf16x8*>(&w); } while (0)
    PK4(p0, 0, pa0); PK4(p0, 8, pa1); PK4(p1, 0, pa2); PK4(p1, 8, pa3);
#undef PK4
}
template <int DQK> __device__ __forceinline__ void qkt(f32x16& p0, f32x16& p1, const LAS char* Ks, const bf16x8* qr, int r32, int hi) {
    constexpr int KP = Cfg<DQK>::KP, ND = Cfg<DQK>::ND;
    p0 = f32x16{}; p1 = f32x16{};
#pragma unroll
    for (int d0 = 0; d0 < ND; ++d0) { const int cb = (d0 * 16 + hi * 8) * 2;
        bf16x8 b0 = *reinterpret_cast<const LAS bf16x8*>(Ks + KSWZ(KP, r32, cb));
        bf16x8 b1 = *reinterpret_cast<const LAS bf16x8*>(Ks + KSWZ(KP, 32 + r32, cb));
        p0 = __builtin_amdgcn_mfma_f32_32x32x16_bf16(b0, qr[d0], p0, 0, 0, 0);
        p1 = __builtin_amdgcn_mfma_f32_32x32x16_bf16(b1, qr[d0], p1, 0, 0, 0); }
}
__device__ __forceinline__ int v_st(int k, int c) { const int kk = (k & ~0xC) | ((k & 4) << 1) | ((k & 8) >> 1); return ((kk >> 3) * 4 + (c >> 5)) * 512 + ((kk & 7) * 32 + (c & 31)) * 2; }
__device__ __forceinline__ int v_rd_base(int lane) { return ((lane & 3) << 3) | (((lane >> 2) & 3) << 6) | (((lane >> 4) & 1) << 5) | (((lane >> 5) & 1) << 8); }
constexpr int v_rd_off(int d0, int ks, int half) { return d0 * 512 + ks * 4096 + half * 2048; }
template <int OFF> __device__ __forceinline__ s16x4 tr_read(int vb) {
    s16x4 r; asm volatile("ds_read_b64_tr_b16 %0, %1 offset:%2" : "=&v"(r) : "v"(vb), "i"(OFF) : "memory"); return r;
}
template <int D0, bool TR = false> __device__ __forceinline__ void pv_one(f32x16& od, int vb, bf16x8 pa0, bf16x8 pa1, bf16x8 pa2, bf16x8 pa3) {
    const s16x4 l0 = tr_read<v_rd_off(D0, 0, 0)>(vb), h0 = tr_read<v_rd_off(D0, 0, 1)>(vb), l1 = tr_read<v_rd_off(D0, 1, 0)>(vb), h1 = tr_read<v_rd_off(D0, 1, 1)>(vb);
    const s16x4 l2 = tr_read<v_rd_off(D0, 2, 0)>(vb), h2 = tr_read<v_rd_off(D0, 2, 1)>(vb), l3 = tr_read<v_rd_off(D0, 3, 0)>(vb), h3 = tr_read<v_rd_off(D0, 3, 1)>(vb);
    asm volatile("s_waitcnt lgkmcnt(0)" ::: "memory"); SBAR();
#define PK(L, H) (bf16x8){L[0], L[1], L[2], L[3], H[0], H[1], H[2], H[3]}
    if constexpr (TR) {
    od = __builtin_amdgcn_mfma_f32_32x32x16_bf16(PK(l0, h0), pa0, od, 0, 0, 0);
    od = __builtin_amdgcn_mfma_f32_32x32x16_bf16(PK(l1, h1), pa1, od, 0, 0, 0);
    od = __builtin_amdgcn_mfma_f32_32x32x16_bf16(PK(l2, h2), pa2, od, 0, 0, 0);
    od = __builtin_amdgcn_mfma_f32_32x32x16_bf16(PK(l3, h3), pa3, od, 0, 0, 0);
    } else {
    od = __builtin_amdgcn_mfma_f32_32x32x16_bf16(pa0, PK(l0, h0), od, 0, 0, 0);
    od = __builtin_amdgcn_mfma_f32_32x32x16_bf16(pa1, PK(l1, h1), od, 0, 0, 0);
    od = __builtin_amdgcn_mfma_f32_32x32x16_bf16(pa2, PK(l2, h2), od, 0, 0, 0);
    od = __builtin_amdgcn_mfma_f32_32x32x16_bf16(pa3, PK(l3, h3), od, 0, 0, 0);
    }
#undef PK
}
template <bool TR = false> __device__ __forceinline__ void pv_d0(f32x16* o, int vb, bf16x8 pa0, bf16x8 pa1, bf16x8 pa2, bf16x8 pa3) {
    pv_one<0, TR>(o[0], vb, pa0, pa1, pa2, pa3); pv_one<1, TR>(o[1], vb, pa0, pa1, pa2, pa3); pv_one<2, TR>(o[2], vb, pa0, pa1, pa2, pa3); pv_one<3, TR>(o[3], vb, pa0, pa1, pa2, pa3);
}
__device__ __forceinline__ bf16x8 ld8(const bf16_t* p) { return *reinterpret_cast<const bf16x8*>(p); }
__device__ __forceinline__ void rope_frag(bf16x8& a, bf16x8& b, const f32x2* tab) {
    u32x4 wa = *reinterpret_cast<u32x4*>(&a), wb = *reinterpret_cast<u32x4*>(&b), oa, ob;
#pragma unroll
    for (int q = 0; q < 4; ++q) {
        const float x1l = bflo(wa[q]), x1h = bfhi(wa[q]), x2l = bflo(wb[q]), x2h = bfhi(wb[q]);
        const f32x2 t0 = tab[2 * q], t1 = tab[2 * q + 1];
        oa[q] = cvtpk(x1l * t0.x - x2l * t0.y, x1h * t1.x - x2h * t1.y);
        ob[q] = cvtpk(x2l * t0.x + x1l * t0.y, x2h * t1.x + x1h * t1.y);
    }
    a = *reinterpret_cast<bf16x8*>(&oa); b = *reinterpret_cast<bf16x8*>(&ob);
}
template <int DQK, int SDEPTH, bool MLA, int ldq, int ldkv, int ldo, bool OUT8 = false>
__device__ __forceinline__ void attn_unit(const bf16_t* __restrict__ Qb, const bf16_t* __restrict__ Kh, const bf16_t* __restrict__ KRh, const bf16_t* __restrict__ Vh,
                                          bf16_t* __restrict__ Ob, int seq, LAS char* lds, const f32x2* __restrict__ tabm, int qt0, int wave_s) {
    constexpr int KP = Cfg<DQK>::KP, SHM_K = Cfg<DQK>::SHM_K, ND = Cfg<DQK>::ND;
    const int tid = tid_fresh(wave_s), wid = tid >> 6, lane = tid & 63, r32 = lane & 31, hi = lane >> 5;
    LAS char* V_lds = lds; LAS char* K_lds = lds + 2 * SHM_V;
    LAS float* wsl = (LAS float*)(lds + 2 * SHM_V + 2 * SHM_K) + wid * 64; LAS float* li_l = wsl; LAS float* al_l = wsl + 32;
    float m_reg = -1e30f, l_reg = 0; f32x16 o[4] = {}; bf16x8 qr[ND];
    const bf16_t* Qw = Qb + (long)(wid * QBLK + r32) * ldq + hi * 8;
#pragma unroll
    for (int d0 = 0; d0 < ND; ++d0) qr[d0] = ld8(Qw + d0 * 16);
    if constexpr (MLA) {
        const int t = qt0 + wid * QBLK + r32, prow = t >> 6, pcol = t & 63;
        rope_frag(qr[8], qr[9], tabm + prow * 16 + hi * 8);
        rope_frag(qr[10], qr[11], tabm + pcol * 16 + hi * 8);
    }
    const int sr = tid >> 4, sc = (tid & 15) * 8, vst0 = v_st(sr, sc), vst1 = v_st(32 + sr, sc);
    const int krr = tid >> 3, krc = (tid & 7) * 8;
    const int vb0 = (int)(unsigned)(uintptr_t)V_lds + v_rd_base(lane);
    struct { bf16x8 vs0, vs1, ks0, ks1, kr; } sr_[SDEPTH];
#define SLOAD(i, k0) do { sr_[i].vs0 = ld8(&Vh[(long)((k0) + sr) * ldkv + sc]); sr_[i].vs1 = ld8(&Vh[(long)((k0) + 32 + sr) * ldkv + sc]); \
    sr_[i].ks0 = ld8(&Kh[(long)((k0) + sr) * ldkv + sc]); sr_[i].ks1 = ld8(&Kh[(long)((k0) + 32 + sr) * ldkv + sc]); \
    if constexpr (MLA) sr_[i].kr = ld8(&KRh[(long)((k0) + krr) * 64 + krc]); } while (0)
#define SWRITE(b, i) do { *(LAS bf16x8*)(V_lds + (b) * SHM_V + vst0) = sr_[i].vs0;          \
    *(LAS bf16x8*)(V_lds + (b) * SHM_V + vst1) = sr_[i].vs1; const int kc = sc * 2;               \
    *(LAS bf16x8*)(K_lds + (b) * SHM_K + KSWZ(KP, sr, kc)) = sr_[i].ks0;                       \
    *(LAS bf16x8*)(K_lds + (b) * SHM_K + KSWZ(KP, 32 + sr, kc)) = sr_[i].ks1;                  \
    if constexpr (MLA) *(LAS bf16x8*)(K_lds + (b) * SHM_K + KSWZ(KP, krr, 256 + krc * 2)) = sr_[i].kr; } while (0)
#define SWAIT() do { if constexpr (SDEPTH == 2) { if constexpr (MLA) asm volatile("s_waitcnt vmcnt(5)" ::: "memory"); else asm volatile("s_waitcnt vmcnt(4)" ::: "memory"); } else asm volatile("s_waitcnt vmcnt(0)" ::: "memory"); } while (0)
#define RESC(a) do { if (__any((a) < 1.f)) { if (hi == 0) al_l[r32] = (a); asm volatile("s_waitcnt lgkmcnt(0)" ::: "memory"); \
    _Pragma("unroll") for (int d = 0; d < 4; ++d) _Pragma("unroll") for (int r = 0; r < 16; ++r) o[d][r] *= al_l[crow(r, hi)]; } } while (0)
    bf16x8 pa0, pa1, pa2, pa3; const int NT = seq / KVBLK;
    if constexpr (MLA) {
        f32x16 p0, p1; float mn, al;
        SLOAD(0, 0); asm volatile("s_waitcnt vmcnt(0)" ::: "memory"); SWRITE(0, 0); SLOAD(0, KVBLK); __syncthreads();
        for (int j = 0; j < NT; ++j) {
            const int cb = j & 1;
            if (j + 1 < NT) { asm volatile("s_waitcnt vmcnt(0)" ::: "memory"); SWRITE(cb ^ 1, 0); if (j + 2 < NT) SLOAD(0, (j + 2) * KVBLK); }
            SBAR(); qkt<DQK>(p0, p1, K_lds + cb * SHM_K, qr, r32, hi);
            partialSM<DQK>(p0, p1, m_reg, mn, al); RESC(al);
            finishSM(p0, p1, al, l_reg, pa0, pa1, pa2, pa3); SBAR();
            pv_d0(o, vb0 + cb * SHM_V, pa0, pa1, pa2, pa3);
            __syncthreads();
        }
    } else {
    f32x16 pA0, pA1, pB0, pB1; float mnA, mnB, alA, alB;
    constexpr int SE = 0, SO = SDEPTH - 1;
    SLOAD(SE, 0); asm volatile("s_waitcnt vmcnt(0)" ::: "memory"); SWRITE(0, SE); __syncthreads();
    qkt<DQK>(pA0, pA1, K_lds, qr, r32, hi); partialSM<DQK>(pA0, pA1, m_reg, mnA, alA);
    SLOAD(SO, KVBLK); if constexpr (SDEPTH == 2) { if (2 < NT) SLOAD(SE, 2 * KVBLK); }
    SWAIT(); SWRITE(1, SO); __syncthreads();
    for (int j = 1; j + 1 < NT; j += 2) {
        SBAR(); qkt<DQK>(pB0, pB1, K_lds + SHM_K, qr, r32, hi);
        finishSM(pA0, pA1, alA, l_reg, pa0, pa1, pa2, pa3); SBAR();
        SLOAD(SO, (j + SDEPTH) * KVBLK); SBAR();
        pv_d0(o, vb0, pa0, pa1, pa2, pa3); partialSM<DQK>(pB0, pB1, m_reg, mnB, alB);
        __syncthreads(); SWAIT(); SWRITE(0, SE);
        RESC(alB); __syncthreads();
        SBAR(); qkt<DQK>(pA0, pA1, K_lds, qr, r32, hi);
        finishSM(pB0, pB1, alB, l_reg, pa0, pa1, pa2, pa3); SBAR();
        if (SDEPTH == 1 || j + 3 < NT) SLOAD(SE, (j + 1 + SDEPTH) * KVBLK); SBAR();
        pv_d0(o, vb0 + SHM_V, pa0, pa1, pa2, pa3); partialSM<DQK>(pA0, pA1, m_reg, mnA, alA);
        __syncthreads(); SWAIT(); SWRITE(1, SO);
        RESC(alA); __syncthreads();
    }
    SBAR(); qkt<DQK>(pB0, pB1, K_lds + SHM_K, qr, r32, hi);
    finishSM(pA0, pA1, alA, l_reg, pa0, pa1, pa2, pa3); SBAR();
    pv_d0(o, vb0, pa0, pa1, pa2, pa3); partialSM<DQK>(pB0, pB1, m_reg, mnB, alB);
    __syncthreads(); RESC(alB);
    finishSM(pB0, pB1, alB, l_reg, pa0, pa1, pa2, pa3); SBAR();
    pv_d0(o, vb0 + SHM_V, pa0, pa1, pa2, pa3);
    }
    if (hi == 0) li_l[r32] = l_reg; asm volatile("s_waitcnt lgkmcnt(0)" ::: "memory");
    float rli[16];
#pragma unroll
    for (int r = 0; r < 16; ++r) rli[r] = __builtin_amdgcn_rcpf(li_l[crow(r, hi)]);
    bf16_t* Ow = OUT8 ? (bf16_t*)((unsigned char*)Ob + (long)(wid * QBLK) * ldo) : Ob + (long)(wid * QBLK) * ldo;
#pragma unroll
    for (int r = 0; r < 16; ++r) { const int orow = crow(r, hi);
#pragma unroll
        for (int d0 = 0; d0 < 4; ++d0) { if constexpr (OUT8) ((unsigned char*)Ow)[(long)orow * ldo + d0 * 32 + r32] = (unsigned char)(pk4_fp8(o[d0][r] * rli[r] * 16.f, 0.f, 0.f, 0.f) & 0xffu);
            else Ow[(long)orow * ldo + d0 * 32 + r32] = f2bf(o[d0][r] * rli[r]); } }
    __syncthreads();
#undef SLOAD
#undef SWRITE
#undef SWAIT
#undef RESC
}
template <int KP> __device__ __forceinline__ int kswz8(int row, int byte) { return row * KP + ((((byte >> 4) ^ (KP == 192 ? ((row >> 2) & 3) : ((row >> 1) & 7)))) << 4) + (byte & 15); }
__device__ __forceinline__ u32x2 bf8_to_fp8x4(bf16x8 v) { const u32x4 w = *reinterpret_cast<const u32x4*>(&v);
    return (u32x2){pk4_fp8_nc(bflo(w.x) * 4.f, bfhi(w.x) * 4.f, bflo(w.y) * 4.f, bfhi(w.y) * 4.f), pk4_fp8_nc(bflo(w.z) * 4.f, bfhi(w.z) * 4.f, bflo(w.w) * 4.f, bfhi(w.w) * 4.f)}; }
__device__ __forceinline__ u32x2 bf8_to_fp8x4s(bf16x8 v, float sc) { const u32x4 w = *reinterpret_cast<const u32x4*>(&v);
    return (u32x2){pk4_fp8_nc(bflo(w.x) * sc, bfhi(w.x) * sc, bflo(w.y) * sc, bfhi(w.y) * sc), pk4_fp8_nc(bflo(w.z) * sc, bfhi(w.z) * sc, bflo(w.w) * sc, bfhi(w.w) * sc)}; }
template <int DQ, bool ROPEQ, int ldq, int ldkv, int ldo, bool OUT8, bool PV8 = (ATT_PV_FP8 != 0), bool Q8IN = false>
__device__ __forceinline__ void attn_unit_qk8(const bf16_t* __restrict__ Qb, const bf16_t* __restrict__ Kh, const bf16_t* __restrict__ KRh, const bf16_t* __restrict__ Vh,
                                               bf16_t* __restrict__ Ob, int seq, LAS char* lds, const f32x2* __restrict__ tabm, int qt0, int wave_s) {
    constexpr int SHM_K8 = KVBLK * DQ, NS = DQ / 64, SHM_VV = PV8 ? KVBLK * 128 : SHM_V;
    const int tid = tid_fresh(wave_s), wid = tid >> 6, lane = tid & 63, r32 = lane & 31, hi = lane >> 5;
    LAS char* V_lds = lds; LAS char* K_lds = lds + 2 * SHM_VV;
    LAS float* wsl = (LAS float*)(lds + 2 * SHM_VV + 2 * SHM_K8) + wid * 64; LAS float* li_l = wsl; LAS float* al_l = wsl + 32;
    float m_reg = -1e30f, l_reg = 0; f32x16 o[4] = {}; i32x8 q8[NS];
    constexpr bool LSM = PV8 && (ATT_OT != 0) && (ATT_LSUM_MFMA != 0); f32x16 osum = {}; (void)osum;
    constexpr bool FOLD = LSM && (ATT_FOLD != 0);
    constexpr float QMUL = FOLD ? Cfg<DQ>::SCALE * 1.4426950408889634f * 32.f : 4.f;
    f32x16 negM = {}; (void)negM;
    {
        const bf16_t* Qw = Qb + (long)(wid * QBLK + r32) * ldq + hi * 32;
        const int t = qt0 + wid * QBLK + r32; const f32x2* tb = ROPEQ ? tabm + (hi ? (t & 63) : (t >> 6)) * 16 : nullptr;
        if constexpr (Q8IN) {
            const unsigned char* Q8w = (const unsigned char*)Qb + (long)(wid * QBLK + r32) * ldq + hi * 32;
#pragma unroll
            for (int s3 = 0; s3 < NS; ++s3) { u32x4 lo4 = *(const u32x4*)(Q8w + s3 * 64), hi4 = *(const u32x4*)(Q8w + s3 * 64 + 16);
                if constexpr (ROPEQ) { if (s3 == 2) {
#pragma unroll
                    for (int w = 0; w < 4; ++w) { const f32x2 x1a = __builtin_amdgcn_cvt_pk_f32_fp8(lo4[w], false), x1b = __builtin_amdgcn_cvt_pk_f32_fp8(lo4[w], true), x2a = __builtin_amdgcn_cvt_pk_f32_fp8(hi4[w], false), x2b = __builtin_amdgcn_cvt_pk_f32_fp8(hi4[w], true);
                        const f32x2 t0 = tb[4 * w], t1 = tb[4 * w + 1], t2 = tb[4 * w + 2], t3 = tb[4 * w + 3];
                        lo4[w] = pk4_fp8(x1a.x * t0.x - x2a.x * t0.y, x1a.y * t1.x - x2a.y * t1.y, x1b.x * t2.x - x2b.x * t2.y, x1b.y * t3.x - x2b.y * t3.y);
                        hi4[w] = pk4_fp8(x2a.x * t0.x + x1a.x * t0.y, x2a.y * t1.x + x1a.y * t1.y, x2b.x * t2.x + x1b.x * t2.y, x2b.y * t3.x + x1b.y * t3.y); } } }
                q8[s3] = (i32x8){(int)lo4.x, (int)lo4.y, (int)lo4.z, (int)lo4.w, (int)hi4.x, (int)hi4.y, (int)hi4.z, (int)hi4.w}; }
        } else {
#pragma unroll
        for (int s3 = 0; s3 < NS; ++s3) { bf16x8 c0 = ld8(Qw + s3 * 64), c1 = ld8(Qw + s3 * 64 + 8), c2 = ld8(Qw + s3 * 64 + 16), c3 = ld8(Qw + s3 * 64 + 24);
            if constexpr (ROPEQ) { if (s3 == 2) { rope_frag(c0, c2, tb); rope_frag(c1, c3, tb + 8); } }
            const u32x2 a = bf8_to_fp8x4s(c0, QMUL), b = bf8_to_fp8x4s(c1, QMUL), c = bf8_to_fp8x4s(c2, QMUL), d = bf8_to_fp8x4s(c3, QMUL);
            q8[s3] = (i32x8){(int)a.x, (int)a.y, (int)b.x, (int)b.y, (int)c.x, (int)c.y, (int)d.x, (int)d.y}; }
        }
    }
    const int sr = tid >> 4, sc = (tid & 15) * 8;
    const int vslot = (sr & 3) | ((sr >> 3) << 2) | (((sr >> 2) & 1) << 4);
    const int vst0 = PV8 ? vslot * 128 + (sc ^ (((vslot >> 1) & 3) << 5)) : v_st(sr, sc), vst1 = PV8 ? (32 + vslot) * 128 + (sc ^ (((vslot >> 1) & 3) << 5)) : v_st(32 + sr, sc);
    const int krr = tid >> 3, krc = (tid & 7) * 8;
    const int kst0 = kswz8<DQ>(sr, sc), kst1 = kswz8<DQ>(32 + sr, sc), kstr = DQ == 192 ? kswz8<DQ>(krr, 128 + krc) : 0;
    const int vb0 = (int)(unsigned)(uintptr_t)V_lds + (PV8 ? ((hi * 32 + ((lane & 15) >> 1)) * 128 + ((lane >> 4) & 1) * 16 + (lane & 1) * 8) : v_rd_base(lane));
    bf16x8 vs0, vs1, ks0, ks1, kr;
    constexpr bool KV8 = PV8 && (ATT_KV8IN != 0);
    constexpr bool OT = PV8 && (ATT_OT != 0);
    const int ckey = tid >> 3, cch = (tid & 7) * 16, rkey = (tid >> 2) & 63, rch = (tid & 3) * 16;
    const int cslot = (ckey & 32) | (ckey & 3) | (((ckey & 31) >> 3) << 2) | (((ckey >> 2) & 1) << 4);
    u32x4 k8, v8, r8;
    constexpr bool KVDMA = KV8 && (ATT_KVDMA != 0); constexpr int NCH = DQ / 16, NKJ = DQ / 16, NJ = NKJ + 8;
    const int widu = __builtin_amdgcn_readfirstlane(wid); (void)widu;
    const unsigned char* jp0 = nullptr; const unsigned char* jp1 = nullptr; const unsigned char* jp2 = nullptr; unsigned js0 = 0, js1 = 0, js2 = 0; (void)jp0; (void)jp1; (void)jp2; (void)js0; (void)js1; (void)js2;
    if constexpr (KVDMA) {
#define KVD_SETUP(JP, JS, Q) do { const int job = widu + 8 * (Q); const bool isK = job < NKJ; \
            const int c = job * 64 + lane, row = (c / NCH) & 63, pos = c - (c / NCH) * NCH, chk = pos ^ (DQ == 192 ? ((row >> 2) & 3) : ((row >> 1) & 7)); \
            const int slot = ((job - NKJ) * 8 + (lane >> 3)) & 63, key = (slot & 32) | (slot & 3) | (((slot >> 2) & 3) << 3) | (((slot >> 4) & 1) << 2), chv = (lane & 7) ^ (((slot >> 1) & 3) << 1); \
            const bool rope = isK && (DQ == 192) && (chk >= 8); \
            const unsigned long long bK = (unsigned long long)(uintptr_t)Kh, bR = (unsigned long long)(uintptr_t)KRh, bV = (unsigned long long)(uintptr_t)Vh; \
            const unsigned long long base_ = isK ? (rope ? bR : bK) : bV; \
            const long off_ = isK ? (rope ? (long)row * 64 + (chk - 8) * 16 : (long)row * ldkv + chk * 16) : (long)key * ldkv + chv * 16; \
            JP = (const unsigned char*)(uintptr_t)(base_ + (unsigned long long)off_); JS = rope ? (unsigned)(KVBLK * 64) : (unsigned)(KVBLK * ldkv); } while (0)
        KVD_SETUP(jp0, js0, 0); KVD_SETUP(jp1, js1, 1); KVD_SETUP(jp2, js2, 2);
#undef KVD_SETUP
    }
#define KVD_ONE(JP, JS, Q, b) do { const int job = widu + 8 * (Q); \
        if (job < NKJ) { __builtin_amdgcn_global_load_lds((const unsigned*)(JP), (LAS unsigned*)(K_lds + (b) * SHM_K8 + job * 1024), 16, 0, 0); JP += JS; } \
        if (job >= NKJ && job < NJ) { __builtin_amdgcn_global_load_lds((const unsigned*)(JP), (LAS unsigned*)(V_lds + (b) * SHM_VV + (job - NKJ) * 1024), 16, 0, 0); JP += JS; } } while (0)
#define KVD_ISSUE(b) do { KVD_ONE(jp0, js0, 0, b); KVD_ONE(jp1, js1, 1, b); if constexpr (NJ > 16) KVD_ONE(jp2, js2, 2, b); } while (0)
#define SLOAD8(k0) do { if constexpr (KV8) { k8 = *(const u32x4*)((const unsigned char*)Kh + (long)((k0) + ckey) * ldkv + cch); v8 = *(const u32x4*)((const unsigned char*)Vh + (long)((k0) + ckey) * ldkv + cch); \
    if constexpr (DQ == 192) { if (tid < 256) r8 = *(const u32x4*)((const unsigned char*)KRh + (long)((k0) + rkey) * 64 + rch); } } else { vs0 = ld8(&Vh[(long)((k0) + sr) * ldkv + sc]); vs1 = ld8(&Vh[(long)((k0) + 32 + sr) * ldkv + sc]); \
    ks0 = ld8(&Kh[(long)((k0) + sr) * ldkv + sc]); ks1 = ld8(&Kh[(long)((k0) + 32 + sr) * ldkv + sc]); if constexpr (DQ == 192) kr = ld8(&KRh[(long)((k0) + krr) * 64 + krc]); } } while (0)
#define SWRITE8(b) do { if constexpr (KV8) { *(LAS u32x4*)(K_lds + (b) * SHM_K8 + kswz8<DQ>(ckey, cch)) = k8; *(LAS u32x4*)(V_lds + (b) * SHM_VV + cslot * 128 + (cch ^ (((cslot >> 1) & 3) << 5))) = v8; \
    if constexpr (DQ == 192) { if (tid < 256) *(LAS u32x4*)(K_lds + (b) * SHM_K8 + kswz8<DQ>(rkey, 128 + rch)) = r8; } } else { if constexpr (PV8) { *(LAS u32x2*)(V_lds + (b) * SHM_VV + vst0) = bf8_to_fp8x4(vs0); *(LAS u32x2*)(V_lds + (b) * SHM_VV + vst1) = bf8_to_fp8x4(vs1); } \
    else { *(LAS bf16x8*)(V_lds + (b) * SHM_VV + vst0) = vs0; *(LAS bf16x8*)(V_lds + (b) * SHM_VV + vst1) = vs1; } \
    *(LAS u32x2*)(K_lds + (b) * SHM_K8 + kst0) = bf8_to_fp8x4(ks0); *(LAS u32x2*)(K_lds + (b) * SHM_K8 + kst1) = bf8_to_fp8x4(ks1); if constexpr (DQ == 192) *(LAS u32x2*)(K_lds + (b) * SHM_K8 + kstr) = bf8_to_fp8x4(kr); } } while (0)
#define RESC8(a) do { if (__any((a) < 1.f)) { if constexpr (OT) { _Pragma("unroll") for (int d = 0; d < 4; ++d) _Pragma("unroll") for (int r = 0; r < 16; ++r) o[d][r] *= (a); if constexpr (LSM) { _Pragma("unroll") for (int r = 0; r < 16; ++r) osum[r] *= (a); } } \
    else { if (hi == 0) al_l[r32] = (a); asm volatile("s_waitcnt lgkmcnt(0)" ::: "memory"); \
    _Pragma("unroll") for (int d = 0; d < 4; ++d) _Pragma("unroll") for (int r = 0; r < 16; ++r) o[d][r] *= al_l[crow(r, hi)]; } } } while (0)
    bf16x8 pa0, pa1, pa2, pa3; const int NT = seq / KVBLK; f32x16 p0, p1; float mn, al;
    i32x8 ones8 = (i32x8){0x38383838, 0x38383838, 0x38383838, 0x38383838, 0x38383838, 0x38383838, 0x38383838, 0x38383838}; asm volatile("" : "+v"(ones8));
    if constexpr (KVDMA) { KVD_ISSUE(0); __syncthreads(); }
    else { SLOAD8(0); asm volatile("s_waitcnt vmcnt(0)" ::: "memory"); SWRITE8(0); SLOAD8(KVBLK); __syncthreads(); }
#pragma unroll 2
    for (int j = 0; j < NT; ++j) {
        const int cb = j & 1;
        if constexpr (KVDMA) { if (j + 1 < NT) KVD_ISSUE(cb ^ 1); }
        else if (j + 1 < NT) { asm volatile("s_waitcnt vmcnt(0)" ::: "memory"); SWRITE8(cb ^ 1); if (j + 2 < NT) SLOAD8((j + 2) * KVBLK); }
        SBAR();
        { const LAS char* Ks = K_lds + cb * SHM_K8; if constexpr (FOLD) { p0 = negM; p1 = negM; } else { p0 = f32x16{}; p1 = f32x16{}; }
#pragma unroll
          for (int s3 = 0; s3 < NS; ++s3) { const int b0 = 64 * s3 + 32 * hi;
              const i32x4 a0 = *(const LAS i32x4*)(Ks + kswz8<DQ>(r32, b0)), a1 = *(const LAS i32x4*)(Ks + kswz8<DQ>(r32, b0 + 16));
              const i32x4 c0 = *(const LAS i32x4*)(Ks + kswz8<DQ>(32 + r32, b0)), c1 = *(const LAS i32x4*)(Ks + kswz8<DQ>(32 + r32, b0 + 16));
              p0 = __builtin_amdgcn_mfma_scale_f32_32x32x64_f8f6f4(__builtin_shufflevector(a0, a1, 0, 1, 2, 3, 4, 5, 6, 7), q8[s3], p0, 0, 0, 0, 0x7F7F7F7F, 0, FOLD ? 0x78787878 : 0x7F7F7F7F);
              p1 = __builtin_amdgcn_mfma_scale_f32_32x32x64_f8f6f4(__builtin_shufflevector(c0, c1, 0, 1, 2, 3, 4, 5, 6, 7), q8[s3], p1, 0, 0, 0, 0x7F7F7F7F, 0, FOLD ? 0x78787878 : 0x7F7F7F7F); } }
        if constexpr (FOLD) {
            float pmax = p0[0];
#pragma unroll
            for (int r = 1; r < 16; ++r) pmax = fmaxf(pmax, p0[r]);
#pragma unroll
            for (int r = 0; r < 16; ++r) pmax = fmaxf(pmax, p1[r]);
            { auto rr = __builtin_amdgcn_permlane32_swap(__float_as_uint(pmax), __float_as_uint(pmax), false, false); pmax = fmaxf(__uint_as_float(rr[0]), __uint_as_float(rr[1])); }
            constexpr float T2 = 5.f * 1.4426950408889634f;
            al = 1.f;
            if (j == 0 || !__all(pmax <= T2)) {
                const float d = (j == 0) ? pmax : fmaxf(pmax, 0.f);
                al = (j == 0) ? 1.f : __builtin_amdgcn_exp2f(-d);
#pragma unroll
                for (int r = 0; r < 16; ++r) { p0[r] -= d; p1[r] -= d; negM[r] -= d; }
            }
#pragma unroll
            for (int r = 0; r < 16; ++r) p0[r] = __builtin_amdgcn_exp2f(p0[r]);
            RESC8(al);
        } else { partialSM<DQ, 16, PV8 ? 5 : 8>(p0, p1, m_reg, mn, al); RESC8(al); }
        if constexpr (PV8) {
            SBAR();
            const int vb = vb0 + cb * SHM_VV;
            u32x2 tv[4][4];
            const int vsx = ((lane & 15) >> 2) & 3; const int vbd[4] = {vb + ((0 ^ vsx) << 5), vb + ((1 ^ vsx) << 5), vb + ((2 ^ vsx) << 5), vb + ((3 ^ vsx) << 5)};
#define PV8_RD(D0, T) asm volatile("ds_read_b64_tr_b8 %0, %1 offset:%2" : "=&v"(tv[D0][T]) : "v"(vbd[D0]), "i"((T) * 1024) : "memory")
            PV8_RD(0, 0); PV8_RD(0, 1); PV8_RD(0, 2); PV8_RD(0, 3); PV8_RD(1, 0); PV8_RD(1, 1); PV8_RD(1, 2); PV8_RD(1, 3);
            PV8_RD(2, 0); PV8_RD(2, 1); PV8_RD(2, 2); PV8_RD(2, 3); PV8_RD(3, 0); PV8_RD(3, 1); PV8_RD(3, 2); PV8_RD(3, 3);
#undef PV8_RD
            SBAR();
#pragma unroll
            for (int r = 0; r < 16; ++r) p1[r] = __builtin_amdgcn_exp2f(p1[r]);
            if constexpr (!LSM) { float ps = 0;
#pragma unroll
                for (int r = 0; r < 16; ++r) ps += p0[r] + p1[r];
                l_reg = l_reg * al + sum32(ps, ps); }
            unsigned a0[4], a1[4];
#pragma unroll
            for (int q = 0; q < 4; ++q) { a0[q] = pk4_fp8_nz(p0[4 * q], p0[4 * q + 1], p0[4 * q + 2], p0[4 * q + 3]); a1[q] = pk4_fp8_nz(p1[4 * q], p1[4 * q + 1], p1[4 * q + 2], p1[4 * q + 3]); }
            i32x8 pf;
#pragma unroll
            for (int q = 0; q < 4; ++q) { auto rr = __builtin_amdgcn_permlane32_swap(a0[q], a1[q], false, false); pf[q] = (int)rr[0]; pf[4 + q] = (int)rr[1]; }
            asm volatile("s_waitcnt lgkmcnt(0)" ::: "memory"); SBAR();
#pragma unroll
            for (int d0 = 0; d0 < 4; ++d0) { const i32x8 vf = (i32x8){(int)tv[d0][0].x, (int)tv[d0][0].y, (int)tv[d0][1].x, (int)tv[d0][1].y, (int)tv[d0][2].x, (int)tv[d0][2].y, (int)tv[d0][3].x, (int)tv[d0][3].y};
                if constexpr (LSM) { if (d0 == 0) {
                    osum = __builtin_amdgcn_mfma_scale_f32_32x32x64_f8f6f4(ones8, pf, osum, 0, 0, 0, 0x7F7F7F7F, 0, 0x7F7F7F7F); } }
                if constexpr (OT) o[d0] = __builtin_amdgcn_mfma_scale_f32_32x32x64_f8f6f4(vf, pf, o[d0], 0, 0, 0, 0x7F7F7F7F, 0, 0x7F7F7F7F);
                else o[d0] = __builtin_amdgcn_mfma_scale_f32_32x32x64_f8f6f4(pf, vf, o[d0], 0, 0, 0, 0x7F7F7F7F, 0, 0x7F7F7F7F); }
        } else {
        finishSM(p0, p1, al, l_reg, pa0, pa1, pa2, pa3); SBAR();
        pv_d0(o, vb0 + cb * SHM_VV, pa0, pa1, pa2, pa3);
        }
        __syncthreads();
    }
    bf16_t* Ow = OUT8 ? (bf16_t*)((unsigned char*)Ob + (long)(wid * QBLK) * ldo) : Ob + (long)(wid * QBLK) * ldo;
    if constexpr (OT) {
        const float rl = __builtin_amdgcn_rcpf(LSM ? osum[0] : l_reg) * (OUT8 ? 4.f : 0.25f);
        LAS char* T = lds + wid * (OUT8 ? 4096 : 8192);
        if constexpr (OUT8) {
#pragma unroll
            for (int d0 = 0; d0 < 4; ++d0)
#pragma unroll
                for (int g = 0; g < 4; ++g) { const unsigned w = pk4_fp8(o[d0][4 * g] * rl, o[d0][4 * g + 1] * rl, o[d0][4 * g + 2] * rl, o[d0][4 * g + 3] * rl);
                    *(LAS unsigned*)(T + r32 * 128 + (((d0 * 2 + (g >> 1)) ^ (r32 & 7)) << 4) + (g & 1) * 8 + 4 * hi) = w; }
            asm volatile("s_waitcnt lgkmcnt(0)" ::: "memory");
#pragma unroll
            for (int i = 0; i < 4; ++i) { const int R = (lane >> 3) + 8 * i, j = lane & 7; const u32x4 v = *(const LAS u32x4*)(T + R * 128 + ((j ^ (R & 7)) << 4));
                *(u32x4*)((unsigned char*)Ow + (long)R * ldo + j * 16) = v; }
        } else {
#pragma unroll
            for (int d0 = 0; d0 < 4; ++d0)
#pragma unroll
                for (int g = 0; g < 4; ++g) { u32x2 w; w.x = cvtpk(o[d0][4 * g] * rl, o[d0][4 * g + 1] * rl); w.y = cvtpk(o[d0][4 * g + 2] * rl, o[d0][4 * g + 3] * rl);
                    *(LAS u32x2*)(T + r32 * 256 + (((d0 * 4 + g) ^ (r32 & 15)) << 4) + 8 * hi) = w; }
            asm volatile("s_waitcnt lgkmcnt(0)" ::: "memory");
#pragma unroll
            for (int i = 0; i < 8; ++i) { const int R = (lane >> 4) + 4 * i, j = lane & 15; const u32x4 v = *(const LAS u32x4*)(T + R * 256 + ((j ^ (R & 15)) << 4));
                *(u32x4*)((char*)Ow + ((long)R * ldo) * 2 + j * 16) = v; }
        }
    } else {
    if (hi == 0) li_l[r32] = l_reg; asm volatile("s_waitcnt lgkmcnt(0)" ::: "memory");
    float rli[16];
#pragma unroll
    for (int r = 0; r < 16; ++r) rli[r] = __builtin_amdgcn_rcpf(li_l[crow(r, hi)]) * (PV8 ? 0.25f : 1.f);
#pragma unroll
    for (int r = 0; r < 16; ++r) { const int orow = crow(r, hi);
#pragma unroll
        for (int d0 = 0; d0 < 4; ++d0) { if constexpr (OUT8) ((unsigned char*)Ow)[(long)orow * ldo + d0 * 32 + r32] = (unsigned char)(pk4_fp8(o[d0][r] * rli[r] * 16.f, 0.f, 0.f, 0.f) & 0xffu);
            else Ow[(long)orow * ldo + d0 * 32 + r32] = f2bf(o[d0][r] * rli[r]); } }
    }
    __syncthreads();
#undef SLOAD8
#undef KVD_ONE
#undef KVD_ISSUE
#undef SWRITE8
#undef RESC8
}
}

template <int MODE> __device__ __forceinline__ int dst_row(int n) {
    if (MODE == 1) { const int half = n >> 10, c = n & 1023; return ((c >> 7) << 8) + (half << 7) + (c & 127); }
    if (MODE == 2) { const int h = n >> 8, j = n & 255; return j < 128 ? (h << 7) + j : 1024 + (h << 7) + (j - 128); }
    return n;
}
template <int MODE> __device__ __forceinline__ void p0_transpose_item_fp8(const float* W, int K, int N, unsigned char* WT, LAS float* scr, int item, int lane) {
    const int nblk = N / 32, kb = item / nblk, nb = item % nblk, k0 = 64 * kb, n0 = 32 * nb;
#pragma unroll 8
    for (int i = 0; i < 32; ++i) { const int kk = 2 * i + (lane >> 5); scr[kk * 33 + (lane & 31)] = W[(size_t)(k0 + kk) * N + n0 + (lane & 31)]; }
    LDS_WAIT(); asm volatile("" ::: "memory");
    const int c = lane & 7;
#pragma unroll
    for (int j = 0; j < 4; ++j) { const int n = (lane >> 3) + 8 * j; const LAS float* s = scr + (8 * c) * 33 + n;
        u32x2 o; o.x = pk4_fp8(s[0 * 33] * 64.f, s[1 * 33] * 64.f, s[2 * 33] * 64.f, s[3 * 33] * 64.f); o.y = pk4_fp8(s[4 * 33] * 64.f, s[5 * 33] * 64.f, s[6 * 33] * 64.f, s[7 * 33] * 64.f);
        *(u32x2*)(WT + (size_t)dst_row<MODE>(n0 + n) * K + k0 + 8 * c) = o; }
    LDS_WAIT(); asm volatile("" ::: "memory");
}
template <int MODE> __device__ __forceinline__ void p0_transpose_item64_fp8(const float* W, int K, int N, unsigned char* WT, LAS float* scr, int item, int lane) {
    const int nblk = N / 64, kb = item / nblk, nb = item % nblk, k0 = 64 * kb, n0 = 64 * nb;
#pragma unroll 4
    for (int i = 0; i < 16; ++i) { const int kk = 4 * i + (lane >> 4), nc = (lane & 15) * 4; const f32x4 v = *(const f32x4*)(W + (size_t)(k0 + kk) * N + n0 + nc);
        LAS float* d = scr + kk * 65 + nc; d[0] = v.x; d[1] = v.y; d[2] = v.z; d[3] = v.w; }
    LDS_WAIT(); asm volatile("" ::: "memory");
    const int c = lane & 7;
#pragma unroll
    for (int j = 0; j < 8; ++j) { const int n = (lane >> 3) + 8 * j; const LAS float* s = scr + (8 * c) * 65 + n;
        u32x2 o; o.x = pk4_fp8(s[0 * 65] * 64.f, s[1 * 65] * 64.f, s[2 * 65] * 64.f, s[3 * 65] * 64.f); o.y = pk4_fp8(s[4 * 65] * 64.f, s[5 * 65] * 64.f, s[6 * 65] * 64.f, s[7 * 65] * 64.f);
        *(u32x2*)(WT + (size_t)dst_row<MODE>(n0 + n) * K + k0 + 8 * c) = o; }
    LDS_WAIT(); asm volatile("" ::: "memory");
}
template <int MODE> __device__ __forceinline__ void p0_transpose_item128_fp8(const float* W, int K, int N, unsigned char* WT, LAS unsigned char* scr, int item, int lane) {
    const int nblk = N / 64, kb = item / nblk, nb = item % nblk, k0 = 128 * kb, n0 = 64 * nb, kq = lane >> 4, nq = lane & 15;
#pragma unroll 4
    for (int i = 0; i < 8; ++i) { const float* src = W + (size_t)(k0 + 4 * (4 * i + kq)) * N + n0 + 4 * nq;
        const f32x4 v0 = *(const f32x4*)src, v1 = *(const f32x4*)(src + N), v2 = *(const f32x4*)(src + 2 * (size_t)N), v3 = *(const f32x4*)(src + 3 * (size_t)N);
        LAS unsigned char* d = scr + (4 * nq) * 128 + ((i ^ (nq & 7)) << 4) + kq * 4;
        *(LAS unsigned*)(d) = pk4_fp8(v0.x * 64.f, v1.x * 64.f, v2.x * 64.f, v3.x * 64.f); *(LAS unsigned*)(d + 128) = pk4_fp8(v0.y * 64.f, v1.y * 64.f, v2.y * 64.f, v3.y * 64.f);
        *(LAS unsigned*)(d + 256) = pk4_fp8(v0.z * 64.f, v1.z * 64.f, v2.z * 64.f, v3.z * 64.f); *(LAS unsigned*)(d + 384) = pk4_fp8(v0.w * 64.f, v1.w * 64.f, v2.w * 64.f, v3.w * 64.f); }
    LDS_WAIT(); asm volatile("" ::: "memory");
#pragma unroll
    for (int j = 0; j < 8; ++j) { const int n = (lane >> 3) + 8 * j, pc = lane & 7; const u32x4 o = *(const LAS u32x4*)(scr + n * 128 + ((pc ^ ((n >> 2) & 7)) << 4));
        *(u32x4*)(WT + (size_t)dst_row<MODE>(n0 + n) * K + k0 + 16 * pc) = o; }
    LDS_WAIT(); asm volatile("" ::: "memory");
}
template <int MODE> __device__ __forceinline__ void p0_transpose_item(const float* W, int K, int N, bf16_t* WT, LAS float* scr, int item, int lane) {
    const int nblk = N / 32, kb = item / nblk, nb = item % nblk, k0 = 64 * kb, n0 = 32 * nb;
#pragma unroll 8
    for (int i = 0; i < 32; ++i) { const int kk = 2 * i + (lane >> 5); scr[kk * 33 + (lane & 31)] = W[(size_t)(k0 + kk) * N + n0 + (lane & 31)]; }
    LDS_WAIT(); asm volatile("" ::: "memory");
    const int c = lane & 7;
#pragma unroll
    for (int j = 0; j < 4; ++j) { const int n = (lane >> 3) + 8 * j; const LAS float* s = scr + (8 * c) * 33 + n;
        u32x4 o; o.x = cvtpk(s[0 * 33], s[1 * 33]); o.y = cvtpk(s[2 * 33], s[3 * 33]); o.z = cvtpk(s[4 * 33], s[5 * 33]); o.w = cvtpk(s[6 * 33], s[7 * 33]);
        *(u32x4*)(WT + (size_t)dst_row<MODE>(n0 + n) * K + k0 + 8 * c) = o; }
    LDS_WAIT(); asm volatile("" ::: "memory");
}
__device__ __forceinline__ void p0_prologue(Frame& F) {
    uchar* ws = F.ws;
    {
        LAS float* S = (LAS float*)F.lds;
        const float* pC = INP(I_C); const float* pCC = INP(I_CCTX); const float* pAW = INP(I_ADAW); const float* pAB = INP(I_ADAB); const float* pNM = INP(I_NMIXG); const float* pNF = INP(I_NFFNG);
        float* MOD = (float*)(ws + WS_MOD);
        for (int item = F.bid; item < 192; item += F.G) {
            const int layer = item / 96, n0 = (item % 96) * 64;
            __syncthreads();
            for (int u = F.tid; u < 33 * 1024; u += 512) { const int j = u >> 10, k = u & 1023; const float c = j < 32 ? pC[j * 1024 + k] : pCC[k]; S[u] = silu_f(c); }
            __syncthreads();
            float acc[33];
#pragma unroll
            for (int j = 0; j < 33; ++j) acc[j] = 0.f;
            const float* wp = pAW + (size_t)layer * 1024 * 6144 + n0 + F.lane;
            const int kbeg = F.wave * 128;
            for (int k = kbeg; k < kbeg + 128; k += 4) {
                const float w0 = wp[(size_t)k * 6144], w1 = wp[(size_t)(k + 1) * 6144], w2 = wp[(size_t)(k + 2) * 6144], w3 = wp[(size_t)(k + 3) * 6144];
#pragma unroll
                for (int j = 0; j < 33; ++j) { const f32x4 s = *(const LAS f32x4*)(S + j * 1024 + k); acc[j] += s.x * w0 + s.y * w1 + s.z * w2 + s.w * w3; }
            }
            __syncthreads();
#pragma unroll
            for (int j = 0; j < 33; ++j) S[(F.wave * 33 + j) * 64 + F.lane] = acc[j];
            __syncthreads();
            for (int u = F.tid; u < 33 * 64; u += 512) { const int j = u >> 6, cl = u & 63; float s = 0.f;
#pragma unroll
                for (int w = 0; w < 8; ++w) s += S[(w * 33 + j) * 64 + cl];
                const int n = n0 + cl, part = n >> 10, col = n & 1023;
                s += pAB[layer * 6144 + n];
                if (part == 1) s = pNM[layer * 1024 + col] * (1.f + s);
                if (part == 4) s = pNF[layer * 1024 + col] * (1.f + s);
                MOD[((size_t)(layer * 33 + j) * 6 + part) * 1024 + col] = s; }
        }
        __syncthreads();
    }
    {
        const int gt = F.bid * 512 + F.tid, NT = F.G * 512;
        f32x2* tg = (f32x2*)(ws + WS_TABG); f32x2* tm = (f32x2*)(ws + WS_TABM);
        for (int u = gt; u < 64 * 32; u += NT) { const int pos = u >> 5, i = u & 31; const float inv = powf(10000.f, -(float)(2 * i) / 64.f); const float a = (float)pos * inv; tg[u] = (f32x2){cosf(a), sinf(a)}; }
        for (int u = gt; u < 64 * 16; u += NT) { const int pos = u >> 4, i = u & 15; const float inv = powf(10000.f, -(float)(2 * i) / 32.f); const float a = (float)pos * inv; tm[u] = (f32x2){cosf(a), sinf(a)}; }
        float* wrt = (float*)(ws + WS_WRT); const float* pRW = INP(I_RW); const float* pSW = INP(I_SGUW);
        for (int u = gt; u < 2 * 32 * 1024; u += NT) { const int l = u >> 15, e = (u >> 10) & 31, k = u & 1023; wrt[u] = pRW[((size_t)l * 1024 + k) * 32 + e]; }
        bf16_t* sw = (bf16_t*)(ws + WS_SGUW);
        for (int u = gt; u < 4 * 128 * 128; u += NT) sw[u] = f2bf(pSW[u]);
        u32x4* z = (u32x4*)(ws + WS_WIN1 + (size_t)832 * 1024 * (PROJ1_FP8 ? 1 : 2));
        for (int u = gt; u < 192 * 1024 * (PROJ1_FP8 ? 1 : 2) / 16; u += NT) z[u] = (u32x4){0u, 0u, 0u, 0u};
    }
    {
        LAS float* scr = (LAS float*)(F.lds + F.wave * 16640);
        const int gw = F.bid * 8 + F.wave, NGW = F.G * 8; const float* pW1 = INP(I_W1); const float* pW2 = INP(I_W2);
        constexpr int J0 = 16 * 64, J1 = 16 * 32, J2 = 16 * 26, J3 = 8 * 48, J4 = 4 * 64, J5 = 16 * 32, JW1 = MOE_FP8 ? (P0_ITEM128 ? 64 * 256 : 64 * 512) : 64 * 1024, JW2 = MOE_FP8 ? (P0_ITEM128 ? 64 * 128 : 64 * 256) : 64 * 512;
        constexpr int NITEMS = J0 + J1 + J2 + J3 + J4 + J5 + JW1 + JW2;
        for (int it = gw; it < NITEMS; it += NGW) {
            int r = it;
#if MOE_FP8
#if P0_ITEM128
            if (r < JW1) { const int le = r >> 8; p0_transpose_item128_fp8<1>(pW1 + (size_t)le * 1024 * 2048, 1024, 2048, (unsigned char*)(ws + WS_W1) + (size_t)le * 2048 * 1024, (LAS unsigned char*)scr, r & 255, F.lane); continue; } r -= JW1;
            if (r < JW2) { const int le = r >> 7; p0_transpose_item128_fp8<0>(pW2 + (size_t)le * 1024 * 1024, 1024, 1024, (unsigned char*)(ws + WS_W2) + (size_t)le * 1024 * 1024, (LAS unsigned char*)scr, r & 127, F.lane); continue; } r -= JW2;
#else
            if (r < JW1) { const int le = r >> 9; p0_transpose_item64_fp8<1>(pW1 + (size_t)le * 1024 * 2048, 1024, 2048, (unsigned char*)(ws + WS_W1) + (size_t)le * 2048 * 1024, scr, r & 511, F.lane); continue; } r -= JW1;
            if (r < JW2) { const int le = r >> 8; p0_transpose_item64_fp8<0>(pW2 + (size_t)le * 1024 * 1024, 1024, 1024, (unsigned char*)(ws + WS_W2) + (size_t)le * 1024 * 1024, scr, r & 255, F.lane); continue; } r -= JW2;
#endif
#else
            if (r < JW1) { const int le = r >> 10; p0_transpose_item<1>(pW1 + (size_t)le * 1024 * 2048, 1024, 2048, (bf16_t*)(ws + WS_W1) + (size_t)le * 2048 * 1024, scr, r & 1023, F.lane); continue; } r -= JW1;
            if (r < JW2) { const int le = r >> 9; p0_transpose_item<0>(pW2 + (size_t)le * 1024 * 1024, 1024, 1024, (bf16_t*)(ws + WS_W2) + (size_t)le * 1024 * 1024, scr, r & 511, F.lane); continue; } r -= JW2;
#endif
            if (r < J0) { if constexpr (PROJ0_FP8 != 0) p0_transpose_item_fp8<0>(INP(I_ABWIN), 1024, 2048, (unsigned char*)(ws + WS_WIN0), scr, r, F.lane); else p0_transpose_item<0>(INP(I_ABWIN), 1024, 2048, (bf16_t*)(ws + WS_WIN0), scr, r, F.lane); continue; } r -= J0;
            if (r < J1) { if constexpr (OUT0_FP8 != 0) p0_transpose_item_fp8<0>(INP(I_ABWOUT), 1024, 1024, (unsigned char*)(ws + WS_WOUT0), scr, r, F.lane); else p0_transpose_item<0>(INP(I_ABWOUT), 1024, 1024, (bf16_t*)(ws + WS_WOUT0), scr, r, F.lane); continue; } r -= J1;
            if (r < J2) { if constexpr (PROJ1_FP8 != 0) p0_transpose_item_fp8<0>(INP(I_MLAWIN), 1024, 832, (unsigned char*)(ws + WS_WIN1), scr, r, F.lane); else p0_transpose_item<0>(INP(I_MLAWIN), 1024, 832, (bf16_t*)(ws + WS_WIN1), scr, r, F.lane); continue; } r -= J2;
            if (r < J3) { if constexpr (UPQ_FP8 != 0) p0_transpose_item_fp8<0>(INP(I_MLAWUQ), 512, 1536, (unsigned char*)(ws + WS_WUQ), scr, r, F.lane); else p0_transpose_item<0>(INP(I_MLAWUQ), 512, 1536, (bf16_t*)(ws + WS_WUQ), scr, r, F.lane); continue; } r -= J3;
            if (r < J4) { if constexpr (UPKV_FP8 != 0) p0_transpose_item_fp8<2>(INP(I_MLAWUKV), 256, 2048, (unsigned char*)(ws + WS_WUKV), scr, r, F.lane); else p0_transpose_item<2>(INP(I_MLAWUKV), 256, 2048, (bf16_t*)(ws + WS_WUKV), scr, r, F.lane); continue; } r -= J4;
            if constexpr (OUT1_FP8 != 0) p0_transpose_item_fp8<0>(INP(I_MLAWOUT), 1024, 1024, (unsigned char*)(ws + WS_WOUT1), scr, r, F.lane); else p0_transpose_item<0>(INP(I_MLAWOUT), 1024, 1024, (bf16_t*)(ws + WS_WOUT1), scr, r, F.lane);
        }
    }
}

__device__ __forceinline__ void row_src_ptr(const float* px, const float* pctx, int r, const float*& src, int& mj) {
    const int b = r / TPB, pos = r - b * TPB;
    if (pos < CTXL) { src = pctx + ((size_t)b * CTXL + pos) * DM; mj = 32; } else { src = px + ((size_t)b * SEQ + (pos - CTXL)) * DM; mj = b; }
}
__device__ __forceinline__ f32x4 bf4(u32x2 w) { return (f32x4){bflo(w.x), bfhi(w.x), bflo(w.y), bfhi(w.y)}; }
__device__ __forceinline__ u32x2 pk4bf(f32x4 v) { return (u32x2){cvtpk(v.x, v.y), cvtpk(v.z, v.w)}; }
__device__ __forceinline__ void store_h_row(bf16_t* hrow, int lane, const f32x4 (&h)[4]) {
    unsigned long long* o8 = (unsigned long long*)hrow + lane;
#pragma unroll
    for (int j = 0; j < 4; ++j) o8[64 * j] = (unsigned long long)cvtpk(h[j].x, h[j].y) | ((unsigned long long)cvtpk(h[j].z, h[j].w) << 32);
}
__device__ __forceinline__ void p_norm0(Frame& F) {
    const float* MOD = (const float*)(F.ws + WS_MOD); bf16_t* H = (bf16_t*)(F.ws + WS_H);
    const int gw = F.bid * 8 + F.wave, NGW = F.G * 8; const float* px = INP(I_X); const float* pctx = INP(I_CTX);
    for (int r = gw; r < NTOK; r += NGW) {
        const float* src; int mj; row_src_ptr(px, pctx, r, src, mj);
        const f32x4* xr = (const f32x4*)src + F.lane; f32x4 v[4]; float ss = 0.f;
#pragma unroll
        for (int j = 0; j < 4; ++j) { v[j] = xr[64 * j]; ss += (v[j].x * v[j].x + v[j].y * v[j].y) + (v[j].z * v[j].z + v[j].w * v[j].w); }
        const float rstd = rsqrtf(wave_sum(ss) * (1.f / DM) + EPS);
        const f32x4* sh = (const f32x4*)(MOD + ((size_t)(0 * 33 + mj) * 6 + 0) * 1024) + F.lane; const f32x4* A = (const f32x4*)(MOD + ((size_t)(0 * 33 + mj) * 6 + 1) * 1024) + F.lane;
        f32x4 h[4];
#pragma unroll
        for (int j = 0; j < 4; ++j) h[j] = v[j] * rstd * A[64 * j] + sh[64 * j];
        if constexpr (PROJ0_FP8 != 0) { unsigned* o4 = (unsigned*)((unsigned char*)H + (size_t)r * DM) + F.lane;
#pragma unroll
            for (int j = 0; j < 4; ++j) o4[64 * j] = pk4_fp8(h[j].x * 4.f, h[j].y * 4.f, h[j].z * 4.f, h[j].w * 4.f); }
        else store_h_row(H + (size_t)r * DM, F.lane, h);
    }
}
__device__ __forceinline__ void p_norm0_v2(Frame& F) {
    const float* MOD = (const float*)(F.ws + WS_MOD); bf16_t* H = (bf16_t*)(F.ws + WS_H); const float* px = INP(I_X); const float* pctx = INP(I_CTX);
    const int RPW = (NTOK + F.G - 1) / F.G, r_first = F.bid * RPW, r_last = (r_first + RPW < NTOK) ? r_first + RPW : NTOK;
    int ra = r_first;
    while (ra < r_last) {
        const int b = ra / TPB, pos = ra - b * TPB; const bool cx = pos < CTXL; const int mj = cx ? 32 : b; int rb = cx ? b * TPB + CTXL : (b + 1) * TPB; rb = rb < r_last ? rb : r_last;
        f32x4 Av[4], Sv[4];
        { const f32x4* sh = (const f32x4*)(MOD + ((size_t)(0 * 33 + mj) * 6 + 0) * 1024) + F.lane; const f32x4* A = (const f32x4*)(MOD + ((size_t)(0 * 33 + mj) * 6 + 1) * 1024) + F.lane;
#pragma unroll
          for (int j = 0; j < 4; ++j) { Av[j] = A[64 * j]; Sv[j] = sh[64 * j]; } }
        const int r0 = ra + F.wave, n = (rb - r0 + 7) >> 3;
        if (n > 0) {
            const float* sbase = cx ? pctx + ((size_t)b * CTXL + (r0 - b * TPB)) * DM : px + ((size_t)b * SEQ + (r0 - b * TPB - CTXL)) * DM;
            f32x4 RA[4], RB[4], RC[4]; int i = 0;
#define N0_ISSUE(T_, idx) do { const int i_ = (idx) < n ? (idx) : n - 1; const f32x4* xr_ = (const f32x4*)(sbase + (size_t)i_ * 8 * DM) + F.lane; \
            _Pragma("unroll") for (int j = 0; j < 4; ++j) T_[j] = xr_[64 * j]; __builtin_amdgcn_sched_barrier(0); } while (0)
#define N0_COMP(T_, idx) do { float ss_ = 0.f; _Pragma("unroll") for (int j = 0; j < 4; ++j) ss_ += (T_[j].x * T_[j].x + T_[j].y * T_[j].y) + (T_[j].z * T_[j].z + T_[j].w * T_[j].w); \
            const float rstd_ = rsqrtf(wave_sum(ss_) * (1.f / DM) + EPS); f32x4 h_[4]; _Pragma("unroll") for (int j = 0; j < 4; ++j) h_[j] = T_[j] * rstd_ * Av[j] + Sv[j]; \
            store_h_row(H + (size_t)(r0 + 8 * (idx)) * DM, F.lane, h_); __builtin_amdgcn_sched_barrier(0); } while (0)
            N0_ISSUE(RA, 0); N0_ISSUE(RB, 1);
            for (; i + 3 <= n; i += 3) {
                N0_ISSUE(RC, i + 2); N0_COMP(RA, i);
                N0_ISSUE(RA, i + 3); N0_COMP(RB, i + 1);
                N0_ISSUE(RB, i + 4); N0_COMP(RC, i + 2);
            }
            if (i < n) N0_COMP(RA, i);
            if (i + 1 < n) N0_COMP(RB, i + 1);
#undef N0_ISSUE
#undef N0_COMP
        }
        ra = rb;
    }
}
__device__ __forceinline__ void moe_prefix(Frame& F, int layer) {
    LAS int* pb = (LAS int*)(F.lds + XTRA_OFF + X_PB); LAS int* cn = (LAS int*)(F.lds + XTRA_OFF + X_CNT);
    const unsigned* gc = (const unsigned*)(F.ws + WS_CTL) + CW_CNT + layer * 64;
    __syncthreads();
    if (F.tid == 0) { int s = 0; for (int e = 0; e < 32; ++e) { const int c = (int)__hip_atomic_load(gc + e, __ATOMIC_RELAXED, __HIP_MEMORY_SCOPE_AGENT); cn[e] = c; pb[e] = s; s += (c + 255) >> 8; } pb[32] = s; }
    __syncthreads();
    {
        LAS unsigned* bt = (LAS unsigned*)(F.lds + XTRA_OFF + X_BT); const int tot = pb[32];
        for (int blk = F.tid; blk < BT_N; blk += 512) { int lo = 0;
#pragma unroll
            for (int st = 16; st >= 1; st >>= 1) { if (pb[lo + st] <= blk) lo += st; }
            bt[blk] = blk < tot ? ((unsigned)lo << 16) | (unsigned)(blk - pb[lo]) : 0xffffffffu; }
    }
    __syncthreads();
}
__device__ __forceinline__ void moe_gather_row(const Frame& F, int r, f32x4 (&f)[4]) {
    const LAS int* pb = (const LAS int*)(F.lds + XTRA_OFF + X_PB);
    const u32x2* ti = (const u32x2*)(F.ws + WS_TOKI) + (size_t)r * 4; const bf16_t* Y = (const bf16_t*)(F.ws + WS_Y);
#pragma unroll
    for (int j = 0; j < 4; ++j) f[j] = (f32x4){0.f, 0.f, 0.f, 0.f};
#pragma unroll
    for (int k = 0; k < 4; ++k) {
        const u32x2 t = ti[k]; const int e = (int)(t.x >> 20), pos = (int)(t.x & 0xfffffu); const float g = __uint_as_float(t.y);
        const size_t yrow = (size_t)pb[e] * 256 + pos;
#if Y_FP8
        const unsigned* yp = (const unsigned*)((const unsigned char*)Y + yrow * DM) + F.lane; const float g16 = g * (1.f / 16.f);
#pragma unroll
        for (int j = 0; j < 4; ++j) { const unsigned w = yp[64 * j]; const f32x2 lo = __builtin_amdgcn_cvt_pk_f32_fp8(w, false), hi2 = __builtin_amdgcn_cvt_pk_f32_fp8(w, true);
            f[j].x += g16 * lo.x; f[j].y += g16 * lo.y; f[j].z += g16 * hi2.x; f[j].w += g16 * hi2.y; }
#else
        const u32x2* yp = (const u32x2*)(Y + yrow * DM) + F.lane;
#pragma unroll
        for (int j = 0; j < 4; ++j) { const u32x2 w = yp[64 * j]; f[j].x += g * bflo(w.x); f[j].y += g * bfhi(w.x); f[j].z += g * bflo(w.y); f[j].w += g * bfhi(w.y); }
#endif
    }
}
__device__ __forceinline__ void p_combine_norm(Frame& F, int dry) {
    moe_prefix(F, 0);
    const float* MOD = (const float*)(F.ws + WS_MOD); bf16_t* H = (bf16_t*)(F.ws + (dry ? WS_SCR + 288 * MiB : WS_H)); bf16_t* XR = (bf16_t*)(F.ws + WS_XR); bf16_t* XW = dry ? (bf16_t*)(F.ws + WS_SCR) : XR;
    const int gw = F.bid * 8 + F.wave, NGW = F.G * 8;
    for (int r = gw; r < NTOK; r += NGW) {
        const int b = r / TPB, pos = r - b * TPB, mj = pos < CTXL ? 32 : b;
        f32x4 f[4]; moe_gather_row(F, r, f);
        const u32x2* xr = (const u32x2*)(XR + (size_t)r * DM) + F.lane; u32x2* xw = (u32x2*)(XW + (size_t)r * DM) + F.lane; const f32x4* g2 = (const f32x4*)(MOD + ((size_t)(0 * 33 + mj) * 6 + 5) * 1024) + F.lane;
        f32x4 v[4]; float ss = 0.f;
#pragma unroll
        for (int j = 0; j < 4; ++j) { v[j] = bf4(xr[64 * j]) + g2[64 * j] * f[j]; xw[64 * j] = pk4bf(v[j]); ss += (v[j].x * v[j].x + v[j].y * v[j].y) + (v[j].z * v[j].z + v[j].w * v[j].w); }
        const float rstd = rsqrtf(wave_sum(ss) * (1.f / DM) + EPS);
        const f32x4* sh = (const f32x4*)(MOD + ((size_t)(1 * 33 + mj) * 6 + 0) * 1024) + F.lane; const f32x4* A = (const f32x4*)(MOD + ((size_t)(1 * 33 + mj) * 6 + 1) * 1024) + F.lane;
        f32x4 h[4];
#pragma unroll
        for (int j = 0; j < 4; ++j) h[j] = v[j] * rstd * A[64 * j] + sh[64 * j];
        if constexpr (PROJ1_FP8 != 0) { unsigned* o4 = (unsigned*)((unsigned char*)H + (size_t)r * DM) + F.lane;
#pragma unroll
            for (int j = 0; j < 4; ++j) o4[64 * j] = pk4_fp8(h[j].x * 4.f, h[j].y * 4.f, h[j].z * 4.f, h[j].w * 4.f); }
        else store_h_row(H + (size_t)r * DM, F.lane, h);
    }
}
__device__ __forceinline__ void p_final(Frame& F) {
    moe_prefix(F, 1);
    const float* MOD = (const float*)(F.ws + WS_MOD); const bf16_t* XR = (const bf16_t*)(F.ws + WS_XR);
    const int gw = F.bid * 8 + F.wave, NGW = F.G * 8; const float* pfg = INP(I_FNG);
    for (int q = gw; q < NBATCH * SEQ; q += NGW) {
        const int b = q >> 11, t = q & 2047, r = b * TPB + CTXL + t;
        f32x4 f[4]; moe_gather_row(F, r, f);
        const u32x2* xr = (const u32x2*)(XR + (size_t)r * DM) + F.lane; const f32x4* g2 = (const f32x4*)(MOD + ((size_t)(1 * 33 + b) * 6 + 5) * 1024) + F.lane;
        f32x4 v[4]; float ss = 0.f;
#pragma unroll
        for (int j = 0; j < 4; ++j) { v[j] = bf4(xr[64 * j]) + g2[64 * j] * f[j]; ss += (v[j].x * v[j].x + v[j].y * v[j].y) + (v[j].z * v[j].z + v[j].w * v[j].w); }
        const float rstd = rsqrtf(wave_sum(ss) * (1.f / DM) + EPS);
        const f32x4* fg = (const f32x4*)pfg + F.lane; f32x4* op = (f32x4*)(F.out + (size_t)q * DM) + F.lane;
#pragma unroll
        for (int j = 0; j < 4; ++j) op[64 * j] = v[j] * rstd * fg[64 * j];
    }
}
struct TokIn { u32x4 y[4]; float g[4]; u32x4 x0, x1; };
__device__ __forceinline__ void tok_issue(const Frame& F, const LAS u32x2* tl  , int r, TokIn& t) {
    const LAS int* pb = (const LAS int*)(F.lds + XTRA_OFF + X_PB); const unsigned char* Y = (const unsigned char*)(F.ws + WS_Y);
#pragma unroll
    for (int k = 0; k < 4; ++k) { const u32x2 tt = tl[k]; const int e = (int)(tt.x >> 20), pos = (int)(tt.x & 0xfffffu); t.g[k] = __uint_as_float(tt.y) * (1.f / 16.f);
        t.y[k] = *(const u32x4*)(Y + ((size_t)pb[e] * 256 + pos) * DM + F.lane * 16); }
    const unsigned char* xp = (const unsigned char*)(F.ws + WS_XR) + (size_t)r * (DM * 2) + F.lane * 32; t.x0 = *(const u32x4*)xp; t.x1 = *(const u32x4*)(xp + 16);
}
__device__ __forceinline__ float tok_mix(const TokIn& t, const f32x4 (&g2)[4], float (&v)[16]) {
    float f[16];
#pragma unroll
    for (int i = 0; i < 16; ++i) f[i] = 0.f;
#pragma unroll
    for (int k = 0; k < 4; ++k)
#pragma unroll
        for (int q = 0; q < 4; ++q) { const unsigned w = t.y[k][q]; const f32x2 lo = __builtin_amdgcn_cvt_pk_f32_fp8(w, false), hi2 = __builtin_amdgcn_cvt_pk_f32_fp8(w, true);
            f[4 * q] += t.g[k] * lo.x; f[4 * q + 1] += t.g[k] * lo.y; f[4 * q + 2] += t.g[k] * hi2.x; f[4 * q + 3] += t.g[k] * hi2.y; }
    float ss = 0.f;
#pragma unroll
    for (int i = 0; i < 8; ++i) { const unsigned w = i < 4 ? t.x0[i & 3] : t.x1[i & 3]; v[2 * i] = bflo(w) + g2[(2 * i) >> 2][(2 * i) & 3] * f[2 * i]; v[2 * i + 1] = bfhi(w) + g2[(2 * i + 1) >> 2][(2 * i + 1) & 3] * f[2 * i + 1];
        ss += v[2 * i] * v[2 * i] + v[2 * i + 1] * v[2 * i + 1]; }
    return ss;
}
template <bool FINAL> __device__ __forceinline__ int cmb_row(int q) { return FINAL ? (q >> 11) * TPB + CTXL + (q & 2047) : q; }
template <bool FINAL> __device__ __forceinline__ void tok_compute(const Frame& F, const TokIn& t, int q, const f32x4 (&g2)[4], const f32x4 (&Av)[4], const f32x4 (&shv)[4], unsigned char* XW, unsigned char* H8) {
    float v[16]; const float ss = tok_mix(t, g2, v); LAS char* T = (LAS char*)F.lds + F.wave * 4096;
    if constexpr (!FINAL) { const int r = q;
        u32x4 w0, w1;
#pragma unroll
        for (int i = 0; i < 4; ++i) { w0[i] = cvtpk(v[2 * i], v[2 * i + 1]); w1[i] = cvtpk(v[8 + 2 * i], v[8 + 2 * i + 1]); }
        *(LAS u32x4*)(T + F.lane * 32) = w0; *(LAS u32x4*)(T + F.lane * 32 + 16) = w1;
        const u32x4 a0 = *(const LAS u32x4*)(T + F.lane * 16), a1 = *(const LAS u32x4*)(T + 1024 + F.lane * 16);
        unsigned char* xo = XW + (size_t)r * (DM * 2) + F.lane * 16; *(u32x4*)xo = a0; *(u32x4*)(xo + 1024) = a1;
        const float rstd = rsqrtf(wave_sum(ss) * (1.f / DM) + EPS);
        u32x4 hw;
#pragma unroll
        for (int i = 0; i < 4; ++i) hw[i] = pk4_fp8((v[4 * i] * rstd * Av[i].x + shv[i].x) * 4.f, (v[4 * i + 1] * rstd * Av[i].y + shv[i].y) * 4.f, (v[4 * i + 2] * rstd * Av[i].z + shv[i].z) * 4.f, (v[4 * i + 3] * rstd * Av[i].w + shv[i].w) * 4.f);
        *(u32x4*)(H8 + (size_t)r * DM + F.lane * 16) = hw;
    } else {
        const float rstd = rsqrtf(wave_sum(ss) * (1.f / DM) + EPS);
#pragma unroll
        for (int i = 0; i < 4; ++i) *(LAS f32x4*)(T + F.lane * 64 + i * 16) = (f32x4){v[4 * i] * rstd * Av[i].x, v[4 * i + 1] * rstd * Av[i].y, v[4 * i + 2] * rstd * Av[i].z, v[4 * i + 3] * rstd * Av[i].w};
        float* op = F.out + (size_t)q * DM + F.lane * 4;
#pragma unroll
        for (int j = 0; j < 4; ++j) { const f32x4 a = *(const LAS f32x4*)(T + j * 1024 + F.lane * 16); *(f32x4*)(op + j * 256) = a; }
    }
}
template <bool FINAL> __device__ __forceinline__ void p_combine_v2(Frame& F, int dry) {
    moe_prefix(F, FINAL ? 1 : 0);
    const float* MOD = (const float*)(F.ws + WS_MOD);
    unsigned char* H8 = (unsigned char*)(F.ws + (dry ? WS_SCR + 288 * MiB : WS_H)); unsigned char* XW = (unsigned char*)(F.ws + (dry ? WS_SCR : WS_XR));
    const int NQ = FINAL ? NBATCH * SEQ : NTOK, RPW = (NQ + F.G - 1) / F.G, q_first = F.bid * RPW, q_last = (q_first + RPW < NQ) ? q_first + RPW : NQ;
    LAS u32x4* tl4 = (LAS u32x4*)(F.lds + XTRA_OFF + 1024); const u32x4* tg = (const u32x4*)(F.ws + WS_TOKI);
    for (int i = F.tid; i < (q_last - q_first) * 2; i += 512) tl4[i] = tg[(size_t)cmb_row<FINAL>(q_first + (i >> 1)) * 2 + (i & 1)];
    __syncthreads();
    const LAS u32x2* tl = (const LAS u32x2*)tl4;
    int qa = q_first;
    while (qa < q_last) {
        int mj, qb;
        if constexpr (FINAL) { const int b = qa >> 11; mj = b; qb = (b + 1) << 11; }
        else { const int b = qa / TPB, pos = qa - b * TPB; const bool cx = pos < CTXL; mj = cx ? 32 : b; qb = cx ? b * TPB + CTXL : (b + 1) * TPB; }
        qb = qb < q_last ? qb : q_last;
        f32x4 g2[4], Av[4], shv[4];
        { const f32x4* pg = (const f32x4*)(MOD + ((size_t)((FINAL ? 1 : 0) * 33 + mj) * 6 + 5) * 1024) + F.lane * 4;
          const f32x4* pa = FINAL ? (const f32x4*)INP(I_FNG) + F.lane * 4 : (const f32x4*)(MOD + ((size_t)(1 * 33 + mj) * 6 + 1) * 1024) + F.lane * 4;
          const f32x4* ps = (const f32x4*)(MOD + ((size_t)(1 * 33 + mj) * 6 + 0) * 1024) + F.lane * 4;
#pragma unroll
          for (int i = 0; i < 4; ++i) { g2[i] = pg[i]; Av[i] = pa[i]; shv[i] = FINAL ? (f32x4){0.f, 0.f, 0.f, 0.f} : ps[i]; } }
        const int q0 = qa + F.wave, n = (qb - q0 + 7) >> 3;
        if (n > 0) {
            TokIn A, B, C; int i = 0;
#define CMB_ISSUE(T_, idx) do { const int i_ = (idx) < n ? (idx) : n - 1, q_ = q0 + 8 * i_; tok_issue(F, tl + (q_ - q_first) * 4, cmb_row<FINAL>(q_), T_); __builtin_amdgcn_sched_barrier(0); } while (0)
#define CMB_COMP(T_, idx) do { tok_compute<FINAL>(F, T_, q0 + 8 * (idx), g2, Av, shv, XW, H8); __builtin_amdgcn_sched_barrier(0); } while (0)
            CMB_ISSUE(A, 0); CMB_ISSUE(B, 1);
            for (; i + 3 <= n; i += 3) {
                CMB_ISSUE(C, i + 2); CMB_COMP(A, i);
                CMB_ISSUE(A, i + 3); CMB_COMP(B, i + 1);
                CMB_ISSUE(B, i + 4); CMB_COMP(C, i + 2);
            }
            if (i < n) CMB_COMP(A, i);
            if (i + 1 < n) CMB_COMP(B, i + 1);
#undef CMB_ISSUE
#undef CMB_COMP
        }
        qa = qb;
    }
}
__device__ __forceinline__ void top4_of16(float (&v)[16], int hi, float (&tv)[4], int (&te)[4]) {
#pragma unroll
    for (int k = 0; k < 4; ++k) { float best = v[0]; int bi = 0;
#pragma unroll
        for (int r = 1; r < 16; ++r) { const bool bt = v[r] > best; best = bt ? v[r] : best; bi = bt ? r : bi; }
        tv[k] = best; te[k] = (bi & 3) + 8 * (bi >> 2) + 4 * hi;
#pragma unroll
        for (int r = 0; r < 16; ++r) v[r] = (r == bi) ? -3.0e38f : v[r]; }
}
template <int LAYER> __device__ __forceinline__ void p_norm_router(Frame& F, int dry) {
    const float* MOD = (const float*)(F.ws + WS_MOD); bf16_t* H = (bf16_t*)(F.ws + WS_H); const bf16_t* XR = (const bf16_t*)(F.ws + WS_XR);
    LAS f32x4* WL4 = (LAS f32x4*)F.lds;
    LAS int* hist = (LAS int*)(F.lds + XTRA_OFF + X_HIST); LAS int* base = (LAS int*)(F.lds + XTRA_OFF + X_BASE); LAS u32x2* sel = (LAS u32x2*)(F.lds + XTRA_OFF + X_SEL);
    LAS f32x4* A2L4 = (LAS f32x4*)(F.lds + XTRA_OFF + X_A2); LAS float* CBL = (LAS float*)(F.lds + XTRA_OFF + X_CB); LAS float* RSL = (LAS float*)(F.lds + XTRA_OFF + X_RS);
    unsigned* gcnt = (unsigned*)(F.ws + WS_CTL) + CW_CNT + LAYER * 64 + (dry ? 128 : 0);
    int* rowl = (int*)(F.ws + WS_ROWL); u32x2* toki = (u32x2*)(F.ws + WS_TOKI);
    const f32x4* wsrc = (const f32x4*)(F.ws + WS_WRT + (size_t)LAYER * 32 * 1024 * 4);
    __syncthreads();
    for (int u = F.tid; u < 8192; u += 512) { const int e = u >> 8, k4 = u & 255; WL4[e * 256 + (k4 ^ (e & 15))] = wsrc[u]; }
    if (F.tid < 32) hist[F.tid] = 0;
    const int lane = F.lane, r32 = lane & 31, hi = lane >> 5; const float* prb = INP(I_RB);
    constexpr int NP = LAYER == 0 ? NPAN : 256;
    for (int pi = F.bid; pi < NP; pi += F.G) {
        const int pan = LAYER == 0 ? pi : pi + pi / 8 + 1;
        const int b = pan / 9, mj = (pan % 9 == 0) ? 32 : b;
        const f32x4* shp = (const f32x4*)(MOD + ((size_t)(LAYER * 33 + mj) * 6 + 3) * 1024); const f32x4* Ap = (const f32x4*)(MOD + ((size_t)(LAYER * 33 + mj) * 6 + 4) * 1024);
        __syncthreads();
        if (F.tid < 256) A2L4[F.tid] = Ap[F.tid];
        {
            const int e = F.tid >> 4, part = F.tid & 15; float sum = 0.f;
#pragma unroll 4
            for (int q = 0; q < 16; ++q) { const f32x4 a = shp[part * 16 + q], w = wsrc[e * 256 + part * 16 + q]; sum += (a.x * w.x + a.y * w.y) + (a.z * w.z + a.w * w.w); }
            sum += xf1(sum); sum += xf2(sum); sum += xf4(sum); sum += xf8(sum);
            if (part == 0) CBL[e] = sum + prb[LAYER * 32 + e];
        }
        __syncthreads();
        const int row = pan * 256 + F.wave * 32 + r32;
        const u32x2* xp = (const u32x2*)(XR + (size_t)row * DM) + hi;
        const LAS f32x4* wrow = WL4 + r32 * 256; const int swz = r32 & 15;
        f32x16 acc = {}; float ssq = 0.f;
#define RT_LOAD(dst, mb) do { _Pragma("unroll") for (int u = 0; u < 8; ++u) dst[u] = xp[2 * ((mb) + u)]; } while (0)
#define RT_COMP(src, mb) do { _Pragma("unroll") for (int u = 0; u < 8; ++u) { const int k4 = 2 * ((mb) + u) + hi; const f32x4 a4 = A2L4[k4], w4 = wrow[k4 ^ swz]; const f32x4 x = bf4(src[u]); \
                ssq += (x.x * x.x + x.y * x.y) + (x.z * x.z + x.w * x.w); \
                acc = __builtin_amdgcn_mfma_f32_32x32x2f32(w4.x, x.x * a4.x, acc, 0, 0, 0); acc = __builtin_amdgcn_mfma_f32_32x32x2f32(w4.y, x.y * a4.y, acc, 0, 0, 0); \
                acc = __builtin_amdgcn_mfma_f32_32x32x2f32(w4.z, x.z * a4.z, acc, 0, 0, 0); acc = __builtin_amdgcn_mfma_f32_32x32x2f32(w4.w, x.w * a4.w, acc, 0, 0, 0); } } while (0)
        u32x2 xa[8], xb[8];
        RT_LOAD(xa, 0);
#pragma unroll 1
        for (int m0 = 0; m0 < 128; m0 += 16) {
            RT_LOAD(xb, m0 + 8); SBAR();
            RT_COMP(xa, m0); SBAR();
            if (m0 + 16 < 128) RT_LOAD(xa, m0 + 16);
            SBAR(); RT_COMP(xb, m0 + 8); SBAR();
        }
#undef RT_LOAD
#undef RT_COMP
        const float rstd = rsqrtf(sum32(ssq, ssq) * (1.f / DM) + EPS);
        float lg[16];
#pragma unroll
        for (int r = 0; r < 16; ++r) lg[r] = acc[r] * rstd + CBL[(r & 3) + 8 * (r >> 2) + 4 * hi];
        float tv[4], pv[4]; int te[4], pe[4];
        top4_of16(lg, hi, tv, te);
#pragma unroll
        for (int k = 0; k < 4; ++k) { pv[k] = __uint_as_float(xu32(__float_as_uint(tv[k]), lane)); pe[k] = (int)xu32((unsigned)te[k], lane); }
        float cv[8] = {tv[0], tv[1], tv[2], tv[3], pv[0], pv[1], pv[2], pv[3]}; int ce[8] = {te[0], te[1], te[2], te[3], pe[0], pe[1], pe[2], pe[3]};
        float gv[4]; int ge[4];
#pragma unroll
        for (int k = 0; k < 4; ++k) { float best = cv[0]; int be = ce[0];
#pragma unroll
            for (int c = 1; c < 8; ++c) { const bool bt = cv[c] > best || (cv[c] == best && ce[c] < be); best = bt ? cv[c] : best; be = bt ? ce[c] : be; }
            gv[k] = best; ge[k] = be;
#pragma unroll
            for (int c = 0; c < 8; ++c) cv[c] = (ce[c] == be) ? -3.0e38f : cv[c]; }
        const float x1 = __expf(gv[1] - gv[0]), x2 = __expf(gv[2] - gv[0]), x3 = __expf(gv[3] - gv[0]); const float inv = 1.f / (1.f + x1 + x2 + x3);
        {
            const int ea = hi ? ge[2] : ge[0], eb = hi ? ge[3] : ge[1]; const float ga = hi ? x2 * inv : inv, gb = hi ? x3 * inv : x1 * inv;
            const int ra = __hip_atomic_fetch_add(hist + ea, 1, __ATOMIC_RELAXED, __HIP_MEMORY_SCOPE_WORKGROUP), rb2 = __hip_atomic_fetch_add(hist + eb, 1, __ATOMIC_RELAXED, __HIP_MEMORY_SCOPE_WORKGROUP);
            const int rl = F.wave * 32 + r32;
            sel[rl * 4 + 2 * hi] = (u32x2){(unsigned)ea | ((unsigned)ra << 8), __float_as_uint(ga)}; sel[rl * 4 + 2 * hi + 1] = (u32x2){(unsigned)eb | ((unsigned)rb2 << 8), __float_as_uint(gb)};
            if (hi == 0) RSL[rl] = rstd;
        }
        {
            f32x4 Ar[4], Sr[4];
#pragma unroll
            for (int j = 0; j < 4; ++j) { Ar[j] = Ap[lane + 64 * j]; Sr[j] = shp[lane + 64 * j]; }
            for (int rr = 0; rr < 32; rr += 4) {
                const int rw = pan * 256 + F.wave * 32 + rr; f32x4 v[4][4];
#pragma unroll
                for (int t = 0; t < 4; ++t) { const u32x2* xr = (const u32x2*)(XR + (size_t)(rw + t) * DM) + lane;
#pragma unroll
                    for (int j = 0; j < 4; ++j) v[t][j] = bf4(xr[64 * j]); }
#pragma unroll
                for (int t = 0; t < 4; ++t) { const float rs = RSL[F.wave * 32 + rr + t]; f32x4 h[4];
#pragma unroll
                    for (int j = 0; j < 4; ++j) h[j] = v[t][j] * rs * Ar[j] + Sr[j];
                    if constexpr (MOE_FP8 != 0) { unsigned* o4 = (unsigned*)((unsigned char*)H + (size_t)(rw + t) * DM) + lane;
#pragma unroll
                        for (int j = 0; j < 4; ++j) o4[64 * j] = pk4_fp8(h[j].x * 4.f, h[j].y * 4.f, h[j].z * 4.f, h[j].w * 4.f); }
                    else store_h_row(H + (size_t)(rw + t) * DM, lane, h); }
            }
        }
        __syncthreads();
        if (F.tid < 32) { const int c = hist[F.tid]; base[F.tid] = c ? (int)__hip_atomic_fetch_add(gcnt + F.tid, (unsigned)c, __ATOMIC_RELAXED, __HIP_MEMORY_SCOPE_AGENT) : 0; }
        __syncthreads();
        for (int u = F.tid; u < 1024; u += 512) { const u32x2 sv = sel[u]; const int e = (int)(sv.x & 0xffu), pos = base[e] + (int)(sv.x >> 8), r = pan * 256 + (u >> 2);
            rowl[(size_t)e * ROWCAP + pos] = r; toki[(size_t)r * 4 + (u & 3)] = (u32x2){((unsigned)e << 20) | (unsigned)pos, sv.y}; }
        __syncthreads();
        if (F.tid < 32) hist[F.tid] = 0;
    }
    __syncthreads();
}

__device__ __forceinline__ void p_moe_gather(Frame& F, int layer) {
    moe_prefix(F, layer);
    const LAS int* pb = (const LAS int*)(F.lds + XTRA_OFF + X_PB); const LAS int* cn = (const LAS int*)(F.lds + XTRA_OFF + X_CNT);
    const unsigned char* H8 = (const unsigned char*)(F.ws + WS_H); unsigned char* XS = (unsigned char*)(F.ws + WS_XS); const int* rowl = (const int*)(F.ws + WS_ROWL);
    const int nblk = pb[32];
    for (int blk = F.bid; blk < nblk; blk += F.G) {
        int e = 0;
#pragma unroll
        for (int st = 16; st >= 1; st >>= 1) { if (pb[e + st] <= blk) e += st; }
        const int rb = blk - pb[e], n = cn[e] - rb * 256;
        const int* rl = rowl + (size_t)e * ROWCAP + rb * 256 + F.wave * 32;
#pragma unroll 1
        for (int r0 = 0; r0 < 32; r0 += 8) {
            u32x4 v[8]; int tok[8];
#pragma unroll
            for (int q = 0; q < 8; ++q) { const int ri = F.wave * 32 + r0 + q; tok[q] = ri < n ? rl[r0 + q] : -1; }
#pragma unroll
            for (int q = 0; q < 8; ++q) if (tok[q] >= 0) v[q] = *(const u32x4*)(H8 + (size_t)tok[q] * 1024 + F.lane * 16);
#pragma unroll
            for (int q = 0; q < 8; ++q) if (tok[q] >= 0) *(u32x4*)(XS + ((size_t)blk * 256 + F.wave * 32 + r0 + q) * 1024 + F.lane * 16) = v[q];
        }
    }
}

__device__ __forceinline__ void p_qk_prep(Frame& F) {
    bf16_t* P = (bf16_t*)(F.ws + WS_PBUF); const f32x2* tab = (const f32x2*)(F.ws + WS_TABG); unsigned char* KC8 = (unsigned char*)(F.ws + WS_KC8); unsigned char* VC8 = (unsigned char*)(F.ws + WS_VC8); (void)KC8; (void)VC8;
    const int lane = F.lane, sub = lane >> 4, a = lane & 15, gw = F.bid * 8 + F.wave, NGW = F.G * 8;
    const float* pq = INP(I_GQG); const float* pk = INP(I_GKG);
    float gq[8], gk[8], gqp[8], gkp[8];
#pragma unroll
    for (int j = 0; j < 8; ++j) { gq[j] = pq[8 * a + j]; gk[j] = pk[8 * a + j]; gqp[j] = pq[8 * (a ^ 4) + j]; gkp[j] = pk[8 * (a ^ 4) + j]; }
    const bool isx2 = (a & 4) != 0; const int fi = 8 * (a & 3);
    LAS f32x4* ltab = (LAS f32x4*)F.lds; { const f32x4* gt = (const f32x4*)tab; for (int u = F.tid; u < 64 * 32 / 2; u += 512) ltab[u] = gt[u]; } __syncthreads();
    for (int rp0 = gw; rp0 < NTOK / 2; rp0 += 2 * NGW) {
        u32x4 wl[2][4];
#pragma unroll
        for (int h = 0; h < 2; ++h) { const int rp = rp0 + h * NGW; if (rp < NTOK / 2) {
#pragma unroll
            for (int g = 0; g < ((ATT_KV8IN && ATT_PV_FP8 && GQA_QK_FP8) ? 4 : 3); ++g) { int it = g * 4 + sub, hi6, s;
                if constexpr (ATT_KV8IN && ATT_PV_FP8 && GQA_QK_FP8) { hi6 = it >> 3; s = it & 7; } else { hi6 = it >= 6 ? 1 : 0; s = it - 6 * hi6; }
                wl[h][g] = *(const u32x4*)(P + (size_t)(rp * 2 + hi6) * 2048 + 1024 + s * 128 + 8 * a); } } }
        __builtin_amdgcn_sched_barrier(0);
#pragma unroll
        for (int h = 0; h < 2; ++h) { const int rp = rp0 + h * NGW; if (rp < NTOK / 2) {
#pragma unroll
        for (int g = 0; g < ((ATT_KV8IN && ATT_PV_FP8 && GQA_QK_FP8) ? 4 : 3); ++g) {
            int it = g * 4 + sub, hi6, s;
            if constexpr (ATT_KV8IN && ATT_PV_FP8 && GQA_QK_FP8) { hi6 = it >> 3; s = it & 7; } else { hi6 = it >= 6 ? 1 : 0; s = it - 6 * hi6; }
            const int r = rp * 2 + hi6;
            const int b = r / TPB, pos = r - b * TPB; const bool lat = pos >= CTXL; const int t = pos - CTXL;
            bf16_t* ptr = P + (size_t)r * 2048 + 1024 + s * 128 + 8 * a;
            const u32x4 w = wl[h][g]; u32x4 wp;
#pragma unroll
            for (int q = 0; q < 4; ++q) wp[q] = (unsigned)__shfl_xor((int)w[q], 4);
            float x[8], xp[8];
#pragma unroll
            for (int q = 0; q < 4; ++q) { x[2 * q] = bflo(w[q]); x[2 * q + 1] = bfhi(w[q]); xp[2 * q] = bflo(wp[q]); xp[2 * q + 1] = bfhi(wp[q]); }
            float ss = 0.f;
#pragma unroll
            for (int j = 0; j < 8; ++j) ss += x[j] * x[j];
            ss += __shfl_xor(ss, 1); ss += __shfl_xor(ss, 2); ss += __shfl_xor(ss, 4); ss += __shfl_xor(ss, 8);
            const float rstd = rsqrtf(ss * (1.f / 128.f) + EPS); const bool isq = s < 4;
            float o[8];
#pragma unroll
            for (int j = 0; j < 8; ++j) { o[j] = x[j] * rstd * (isq ? gq[j] : gk[j]); xp[j] = xp[j] * rstd * (isq ? gqp[j] : gkp[j]); }
            if (lat) {
                const int pp = (a & 8) ? (t & 63) : (t >> 6); const LAS f32x4* tp = ltab + ((pp * 32 + fi) >> 1);
#pragma unroll
                for (int q = 0; q < 4; ++q) { const f32x4 cs = tp[q];
                    const float s0 = isx2 ? cs.y : -cs.y, s1 = isx2 ? cs.w : -cs.w;
                    o[2 * q] = o[2 * q] * cs.x + xp[2 * q] * s0; o[2 * q + 1] = o[2 * q + 1] * cs.z + xp[2 * q + 1] * s1; }
            }
            if constexpr (ATT_KV8IN && ATT_PV_FP8 && GQA_QK_FP8) {
                if (s < 4) {
                    if constexpr (QC8_FP8 != 0 && ATT_FOLD != 0) { constexpr float QM = att::Cfg<128>::SCALE * 1.4426950408889634f * 32.f; u32x2 w8; w8.x = pk4_fp8(o[0] * QM, o[1] * QM, o[2] * QM, o[3] * QM); w8.y = pk4_fp8(o[4] * QM, o[5] * QM, o[6] * QM, o[7] * QM);
                        *(u32x2*)((unsigned char*)(F.ws + WS_QC8) + (size_t)r * 512 + s * 128 + 8 * a) = w8; }
                    else { u32x4 wo; wo.x = cvtpk(o[0], o[1]); wo.y = cvtpk(o[2], o[3]); wo.z = cvtpk(o[4], o[5]); wo.w = cvtpk(o[6], o[7]); *(u32x4*)ptr = wo; } }
                else if (s < 6) { u32x2 w8; w8.x = pk4_fp8(o[0] * 4.f, o[1] * 4.f, o[2] * 4.f, o[3] * 4.f); w8.y = pk4_fp8(o[4] * 4.f, o[5] * 4.f, o[6] * 4.f, o[7] * 4.f); *(u32x2*)(KC8 + (size_t)r * 256 + (s - 4) * 128 + 8 * a) = w8; }
                else { u32x2 w8; w8.x = pk4_fp8(x[0] * 4.f, x[1] * 4.f, x[2] * 4.f, x[3] * 4.f); w8.y = pk4_fp8(x[4] * 4.f, x[5] * 4.f, x[6] * 4.f, x[7] * 4.f); *(u32x2*)(VC8 + (size_t)r * 256 + (s - 6) * 128 + 8 * a) = w8; }
            } else {
            u32x4 wo; wo.x = cvtpk(o[0], o[1]); wo.y = cvtpk(o[2], o[3]); wo.z = cvtpk(o[4], o[5]); wo.w = cvtpk(o[6], o[7]);
            *(u32x4*)ptr = wo; }
        } } }
    }
}
__device__ __forceinline__ u32x2 fp8x4_to_bf16(unsigned w) { const f32x2 a = __builtin_amdgcn_cvt_pk_f32_fp8(w, false), b = __builtin_amdgcn_cvt_pk_f32_fp8(w, true); return (u32x2){cvtpk(a.x * 0.125f, a.y * 0.125f), cvtpk(b.x * 0.125f, b.y * 0.125f)}; }
__device__ __forceinline__ u32x4 fp8x8_to_bf16(u32x2 w) { const u32x2 l = fp8x4_to_bf16(w.x), h = fp8x4_to_bf16(w.y); return (u32x4){l.x, l.y, h.x, h.y}; }
__device__ __forceinline__ void p_mla_prep(Frame& F) {
    bf16_t* P = (bf16_t*)(F.ws + WS_PBUF); bf16_t* KR = (bf16_t*)(F.ws + WS_KRB); const f32x2* tab = (const f32x2*)(F.ws + WS_TABM);
    const int gw = F.bid * 8 + F.wave, NGW = F.G * 8, lane = F.lane;
    const float* pqg = INP(I_MLAQG); const float* pkg = INP(I_MLAKVG);
    float qg[8], kg[4];
#pragma unroll
    for (int j = 0; j < 8; ++j) qg[j] = pqg[8 * lane + j];
#pragma unroll
    for (int j = 0; j < 4; ++j) kg[j] = pkg[4 * lane + j];
    const int krow = (lane >> 3) & 3, ka = lane & 7; const bool kx2 = (ka & 2) != 0; const int kfi = 8 * (ka & 1);
    LAS f32x4* ltab = (LAS f32x4*)F.lds; { const f32x4* gt = (const f32x4*)tab; for (int u = F.tid; u < 64 * 16 / 2; u += 512) ltab[u] = gt[u]; } __syncthreads();
    for (int r0 = gw * 4; r0 < NTOK; r0 += NGW * 4) {
        const int b = r0 / TPB, pos0 = r0 - b * TPB; const bool lat = pos0 >= CTXL;
        u32x4 wq[4]; u32x2 wk[4];
#pragma unroll
        for (int rr = 0; rr < 4; ++rr) {
            if constexpr (PBUF1_FP8 != 0) { const unsigned char* b8 = (const unsigned char*)P + (size_t)(r0 + rr) * 1024; wk[rr] = fp8x4_to_bf16(*(const unsigned*)(b8 + 512 + 4 * lane)); if (lat) wq[rr] = fp8x8_to_bf16(*(const u32x2*)(b8 + 8 * lane)); }
            else { const bf16_t* base = P + (size_t)(r0 + rr) * 1024; wk[rr] = *(const u32x2*)(base + 512 + 4 * lane); if (lat) wq[rr] = *(const u32x4*)(base + 8 * lane); } }
        u32x4 wr = (u32x4){0u, 0u, 0u, 0u};
        if (lane < 32) { if constexpr (PBUF1_FP8 != 0) wr = fp8x8_to_bf16(*(const u32x2*)((const unsigned char*)P + (size_t)(r0 + krow) * 1024 + 768 + 8 * ka)); else wr = *(const u32x4*)(P + (size_t)(r0 + krow) * 1024 + 768 + 8 * ka); }
        if (lat) {
#pragma unroll
            for (int rr = 0; rr < 4; ++rr) { float x[8];
#pragma unroll
                for (int q = 0; q < 4; ++q) { x[2 * q] = bflo(wq[rr][q]); x[2 * q + 1] = bfhi(wq[rr][q]); }
                float ss = 0.f;
#pragma unroll
                for (int j = 0; j < 8; ++j) ss += x[j] * x[j];
                const float rstd = rsqrtf(wave_sum(ss) * (1.f / 512.f) + EPS);
                if constexpr (UPQ_FP8 != 0) { const float s4 = rstd * 4.f; u32x2 w8; w8.x = pk4_fp8(x[0] * s4 * qg[0], x[1] * s4 * qg[1], x[2] * s4 * qg[2], x[3] * s4 * qg[3]); w8.y = pk4_fp8(x[4] * s4 * qg[4], x[5] * s4 * qg[5], x[6] * s4 * qg[6], x[7] * s4 * qg[7]);
                    *(u32x2*)((unsigned char*)(F.ws + WS_CQ8) + (size_t)(r0 + rr) * 512 + 8 * lane) = w8; }
                else { u32x4 w;
#pragma unroll
                    for (int q = 0; q < 4; ++q) w[q] = cvtpk(x[2 * q] * rstd * qg[2 * q], x[2 * q + 1] * rstd * qg[2 * q + 1]);
                    *(u32x4*)(P + (size_t)(r0 + rr) * 1024 + 8 * lane) = w; } }
        }
#pragma unroll
        for (int rr = 0; rr < 4; ++rr) { const float x0 = bflo(wk[rr].x), x1 = bfhi(wk[rr].x), x2 = bflo(wk[rr].y), x3 = bfhi(wk[rr].y);
            const float rstd = rsqrtf(wave_sum((x0 * x0 + x1 * x1) + (x2 * x2 + x3 * x3)) * (1.f / 256.f) + EPS);
            if constexpr (UPKV_FP8 != 0) { const float s4 = rstd * 4.f; *(unsigned*)((unsigned char*)(F.ws + WS_CKV8) + (size_t)(r0 + rr) * 256 + 4 * lane) = pk4_fp8(x0 * s4 * kg[0], x1 * s4 * kg[1], x2 * s4 * kg[2], x3 * s4 * kg[3]); }
            else { u32x2 w; w.x = cvtpk(x0 * rstd * kg[0], x1 * rstd * kg[1]); w.y = cvtpk(x2 * rstd * kg[2], x3 * rstd * kg[3]);
                *(u32x2*)(P + (size_t)(r0 + rr) * 1024 + 512 + 4 * lane) = w; } }
        {
            u32x4 wp;
#pragma unroll
            for (int q = 0; q < 4; ++q) wp[q] = (unsigned)__shfl_xor((int)wr[q], 2);
            float o[8], xp[8];
#pragma unroll
            for (int q = 0; q < 4; ++q) { o[2 * q] = bflo(wr[q]); o[2 * q + 1] = bfhi(wr[q]); xp[2 * q] = bflo(wp[q]); xp[2 * q + 1] = bfhi(wp[q]); }
            if (lat) { const int t = pos0 + krow - CTXL, pp = (ka & 4) ? (t & 63) : (t >> 6); const LAS f32x4* tp = ltab + ((pp * 16 + kfi) >> 1);
#pragma unroll
                for (int q = 0; q < 4; ++q) { const f32x4 cs = tp[q]; const float s0 = kx2 ? cs.y : -cs.y, s1 = kx2 ? cs.w : -cs.w;
                    o[2 * q] = o[2 * q] * cs.x + xp[2 * q] * s0; o[2 * q + 1] = o[2 * q + 1] * cs.z + xp[2 * q + 1] * s1; } }
            u32x4 wo; wo.x = cvtpk(o[0], o[1]); wo.y = cvtpk(o[2], o[3]); wo.z = cvtpk(o[4], o[5]); wo.w = cvtpk(o[6], o[7]);
            if (lane < 32) { if constexpr (ATT_KV8IN && ATT_PV_FP8 && MLA_QK_FP8) { u32x2 w8; w8.x = pk4_fp8(o[0] * 4.f, o[1] * 4.f, o[2] * 4.f, o[3] * 4.f); w8.y = pk4_fp8(o[4] * 4.f, o[5] * 4.f, o[6] * 4.f, o[7] * 4.f); *(u32x2*)((unsigned char*)(F.ws + WS_KR8) + (size_t)(r0 + krow) * 64 + 8 * ka) = w8; }
                else *(u32x4*)(KR + (size_t)(r0 + krow) * 64 + 8 * ka) = wo; }
        }
    }
}
__device__ __forceinline__ void p_sgu(Frame& F) {
    const bf16_t* P = (const bf16_t*)(F.ws + WS_PBUF); bf16_t* MIX = (bf16_t*)(F.ws + WS_MIX0); const bf16_t* SW = (const bf16_t*)(F.ws + WS_SGUW);
    const int tid = F.tid, lane = F.lane, wid = F.wave, hw = wid >> 2, w4 = wid & 3, th = tid & 255, r32 = lane & 31, hi = lane >> 5;
    LAS char* Vl = (LAS char*)F.lds + hw * 32768;
    const int sr = th >> 4, sc = (th & 15) * 8;
    const int vb0 = (int)(unsigned)(uintptr_t)Vl + att::v_rd_base(lane);
    const float* psg = INP(I_SGUNG); const float* psb = INP(I_SGUB);
    for (int U = F.bid; U < (NTOK / 128) * 2; U += F.G) {
        const int chunk = U >> 1, g = (U & 1) * 2 + hw; const size_t row0 = (size_t)chunk * 128;
        float gn[8];
#pragma unroll
        for (int j = 0; j < 8; ++j) gn[j] = psg[g * 128 + sc + j];
        bf16x8 pa[8];
        const bf16_t* wrow = SW + ((size_t)g * 128 + 32 * w4 + r32) * 128 + 8 * hi;
#pragma unroll
        for (int k = 0; k < 8; ++k) pa[k] = *(const bf16x8*)(wrow + 16 * k);
        const float bs_row = psb[g * 128 + 32 * w4 + r32]; (void)bs_row;
        u32x4 zr[8]; LAS char* T = (LAS char*)F.lds + 65536 + wid * 8192;
        if constexpr (SGU_T != 0) {
#pragma unroll
            for (int i = 0; i < 8; ++i) zr[i] = *(const u32x4*)(P + (row0 + 32 * w4 + 4 * i + (lane >> 4)) * 2048 + g * 128 + (lane & 15) * 8);
        }
        __syncthreads();
#pragma unroll
        for (int i = 0; i < 8; ++i) {
            const int q = sr + 16 * i;
            u32x4 w = *(const u32x4*)(P + (row0 + q) * 2048 + 512 + g * 128 + sc); float x[8];
#pragma unroll
            for (int k = 0; k < 4; ++k) { x[2 * k] = bflo(w[k]); x[2 * k + 1] = bfhi(w[k]); }
            float ss = 0.f;
#pragma unroll
            for (int j = 0; j < 8; ++j) ss += x[j] * x[j];
            ss += __shfl_xor(ss, 1); ss += __shfl_xor(ss, 2); ss += __shfl_xor(ss, 4); ss += __shfl_xor(ss, 8);
            const float rstd = rsqrtf(ss * (1.f / 128.f) + EPS);
#pragma unroll
            for (int k = 0; k < 4; ++k) w[k] = cvtpk(x[2 * k] * rstd * gn[2 * k], x[2 * k + 1] * rstd * gn[2 * k + 1]);
            *(LAS u32x4*)(Vl + (q >> 6) * 16384 + att::v_st(q & 63, sc)) = w;
        }
        __syncthreads();
        f32x16 o[4] = {};
        if constexpr (SGU_T != 0) {
#pragma unroll
            for (int i = 0; i < 8; ++i) { const int R = 4 * i + (lane >> 4); *(LAS u32x4*)(T + R * 256 + (((lane & 15) ^ (R & 15)) << 4)) = zr[i]; }
            att::pv_d0<true>(o, vb0, pa[0], pa[1], pa[2], pa[3]);
            att::pv_d0<true>(o, vb0 + 16384, pa[4], pa[5], pa[6], pa[7]);
            const float bs = bs_row;
            if constexpr (OUT0_FP8 != 0) {
                unsigned ow[4][4];
#pragma unroll
                for (int d0 = 0; d0 < 4; ++d0)
#pragma unroll
                    for (int gq = 0; gq < 4; ++gq) { const u32x2 zz = *(const LAS u32x2*)(T + r32 * 256 + (((d0 * 4 + gq) ^ (r32 & 15)) << 4) + 8 * hi);
                        ow[d0][gq] = pk4_fp8((o[d0][4 * gq] + bs) * bflo(zz.x) * 16.f, (o[d0][4 * gq + 1] + bs) * bfhi(zz.x) * 16.f, (o[d0][4 * gq + 2] + bs) * bflo(zz.y) * 16.f, (o[d0][4 * gq + 3] + bs) * bfhi(zz.y) * 16.f); }
                asm volatile("s_waitcnt lgkmcnt(0)" ::: "memory");
#pragma unroll
                for (int d0 = 0; d0 < 4; ++d0)
#pragma unroll
                    for (int gq = 0; gq < 4; ++gq) *(LAS unsigned*)(T + r32 * 128 + (((d0 * 2 + (gq >> 1)) ^ (r32 & 7)) << 4) + (gq & 1) * 8 + 4 * hi) = ow[d0][gq];
                asm volatile("s_waitcnt lgkmcnt(0)" ::: "memory");
#pragma unroll
                for (int i = 0; i < 4; ++i) { const int R = (lane >> 3) + 8 * i, j = lane & 7; const u32x4 v = *(const LAS u32x4*)(T + R * 128 + ((j ^ (R & 7)) << 4));
                    *(u32x4*)((unsigned char*)MIX + (row0 + 32 * w4 + R) * 1024 + g * 128 + j * 16) = v; }
            } else {
#pragma unroll
            for (int d0 = 0; d0 < 4; ++d0)
#pragma unroll
                for (int gq = 0; gq < 4; ++gq) { LAS u32x2* tp = (LAS u32x2*)(T + r32 * 256 + (((d0 * 4 + gq) ^ (r32 & 15)) << 4) + 8 * hi); const u32x2 zz = *tp;
                    u32x2 wo; wo.x = cvtpk((o[d0][4 * gq] + bs) * bflo(zz.x), (o[d0][4 * gq + 1] + bs) * bfhi(zz.x)); wo.y = cvtpk((o[d0][4 * gq + 2] + bs) * bflo(zz.y), (o[d0][4 * gq + 3] + bs) * bfhi(zz.y)); *tp = wo; }
#pragma unroll
            for (int i = 0; i < 8; ++i) { const int R = 4 * i + (lane >> 4); const u32x4 v = *(const LAS u32x4*)(T + R * 256 + (((lane & 15) ^ (R & 15)) << 4));
                *(u32x4*)(MIX + (row0 + 32 * w4 + R) * 1024 + g * 128 + (lane & 15) * 8) = v; }
            }
        } else {
        att::pv_d0(o, vb0, pa[0], pa[1], pa[2], pa[3]);
        att::pv_d0(o, vb0 + 16384, pa[4], pa[5], pa[6], pa[7]);
#pragma unroll
        for (int r = 0; r < 16; ++r) { const int p = 32 * w4 + att::crow(r, hi); const float bs = psb[g * 128 + p];
#pragma unroll
            for (int d0 = 0; d0 < 4; ++d0) { const int c = d0 * 32 + r32; const float zu = bf2f(P[(row0 + p) * 2048 + g * 128 + c]);
                MIX[(row0 + p) * 1024 + g * 128 + c] = f2bf((o[d0][r] + bs) * zu); } }
        }
    }
    __syncthreads();
}

using pg8::Unit; using pg8::Acc;
struct ProbIn0 {
    static constexpr bool PERM = true, GATHER = false, FP8 = PROJ0_FP8 != 0, P16 = false, MOE = false; static constexpr int KCONST = 0; int K, lda; const bf16_t* A; const bf16_t* Bt; bf16_t* O; pg8::StaticOrder so; int G, c;
    __device__ bool next(int i, Unit& u) const { return so.map((long)i * G + c, u.pm, u.pn); }
    __device__ const void* a_mat() const { return A; } __device__ const void* b_mat() const { return Bt; }
    __device__ unsigned a_off(const Unit& u) const { return (unsigned)u.pm * 256u * (unsigned)lda * 2u; }
    __device__ unsigned b_off(const Unit& u) const { return (unsigned)u.pn * 256u * (unsigned)K * 2u; }
    __device__ void a_voff(const Unit&, unsigned (&)[2][2]) const {}
    __device__ void epi(const Acc& acc, const Unit& u, int wr, int wc, int fr, int fq) const {
        bf16_t* dst = O + (size_t)u.pm * 256 * 2048 + u.pn * 256;
        if (u.pn < 4) pg8::epi_store_bf16<true>(acc, dst, 2048, nullptr, wr, wc, fr, fq, FP8 ? (1.f / 256.f) : 1.f); else pg8::epi_store_bf16<false>(acc, dst, 2048, nullptr, wr, wc, fr, fq, FP8 ? (1.f / 256.f) : 1.f);
    }
};
template <bool LATONLY, bool FP8v = false, int KC = 0, bool O8 = false> struct ProbPlain {
    static constexpr bool PERM = true, GATHER = false, FP8 = FP8v, P16 = O8 && (EPI_P16 != 0), MOE = false; static constexpr int KCONST = KC; int K, lda; const bf16_t* A; const bf16_t* Bt; bf16_t* O; int ldc; pg8::StaticOrder so; int G, c; float osc8 = 4.f;
    __device__ bool next(int i, Unit& u) const { int pm; if (!so.map((long)i * G + c, pm, u.pn)) return false; u.pm = LATONLY ? pm + pm / 8 + 1 : pm; return true; }
    __device__ const void* a_mat() const { return A; } __device__ const void* b_mat() const { return Bt; }
    __device__ unsigned a_off(const Unit& u) const { return (unsigned)u.pm * 256u * (unsigned)lda * 2u; }
    __device__ unsigned b_off(const Unit& u) const { return (unsigned)u.pn * 256u * (unsigned)K * 2u; }
    __device__ void a_voff(const Unit&, unsigned (&)[2][2]) const {}
    __device__ void epi(const Acc& acc, const Unit& u, int wr, int wc, int fr, int fq) const {
        if constexpr (O8) pg8::epi_store_fp8<P16>(acc, (unsigned char*)O + (size_t)u.pm * 256 * ldc + u.pn * 256, ldc, wr, wc, fr, fq, (FP8 ? (1.f / 256.f) : 1.f) * osc8);
        else pg8::epi_store_bf16<false>(acc, O + (size_t)u.pm * 256 * ldc + u.pn * 256, ldc, nullptr, wr, wc, fr, fq, FP8 ? (1.f / 256.f) : 1.f);
    }
};
struct ProbIn1 {
    static constexpr bool PERM = true, GATHER = false, FP8 = PROJ1_FP8 != 0, P16 = (PBUF1_FP8 != 0) && (EPI_P16 != 0), MOE = false; static constexpr int KCONST = 0; int K, lda; const bf16_t* A; const bf16_t* Bt; bf16_t* O; pg8::StaticOrder so; int G, c;
    __device__ bool next(int i, Unit& u) const {
        const long L = (long)i * G + c;
        if (L < 1024) { int pm; so.map(L, pm, u.pn); u.pm = pm + pm / 8 + 1; return true; }
        if (L < 1024 + 64) { const int q = (int)(L - 1024); u.pm = (q >> 1) * 9; u.pn = 2 + (q & 1); return true; }
        return false;
    }
    __device__ const void* a_mat() const { return A; } __device__ const void* b_mat() const { return Bt; }
    __device__ unsigned a_off(const Unit& u) const { return (unsigned)u.pm * 256u * (unsigned)lda * 2u; }
    __device__ unsigned b_off(const Unit& u) const { return (unsigned)u.pn * 256u * (unsigned)K * 2u; }
    __device__ void a_voff(const Unit&, unsigned (&)[2][2]) const {}
    __device__ void epi(const Acc& acc, const Unit& u, int wr, int wc, int fr, int fq) const {
        if constexpr (PBUF1_FP8 != 0) pg8::epi_store_fp8<P16>(acc, (unsigned char*)O + (size_t)u.pm * 256 * 1024 + u.pn * 256, 1024, wr, wc, fr, fq, (FP8 ? (1.f / 256.f) : 1.f) * 8.f);
        else pg8::epi_store_bf16<false>(acc, O + (size_t)u.pm * 256 * 1024 + u.pn * 256, 1024, nullptr, wr, wc, fr, fq, FP8 ? (1.f / 256.f) : 1.f);
    }
};
template <int LAYER> struct ProbOut {
    static constexpr bool PERM = true, GATHER = false, FP8 = (LAYER == 1 ? (OUT1_FP8 != 0) : (OUT0_FP8 != 0)), P16 = false, MOE = false; static constexpr int KCONST = 0; int K, lda; const bf16_t* A; const bf16_t* Bt; bf16_t* XR; const float* MOD; const float* xin; const float* cin; pg8::StaticOrder so; int G, c;
    __device__ __forceinline__ bool next(int i, Unit& u) const { int pm; if (!so.map((long)i * G + c, pm, u.pn)) return false; u.pm = LAYER ? pm + pm / 8 + 1 : pm; return true; }
    __device__ __forceinline__ const void* a_mat() const { return A; } __device__ __forceinline__ const void* b_mat() const { return Bt; }
    __device__ __forceinline__ unsigned a_off(const Unit& u) const { return (unsigned)u.pm * 256u * (unsigned)lda * 2u; }
    __device__ __forceinline__ unsigned b_off(const Unit& u) const { return (unsigned)u.pn * 256u * (unsigned)K * 2u; }
    __device__ __forceinline__ void a_voff(const Unit&, unsigned (&)[2][2]) const {}
    __device__ __forceinline__ void epi(const Acc& acc, const Unit& u, int wr, int wc, int fr, int fq) const {
        const int b = u.pm / 9, jj = u.pm % 9, mj = jj == 0 ? 32 : b;
        const float* basef = jj == 0 ? cin + (size_t)b * CTXL * DM : xin + ((size_t)b * SEQ + (jj - 1) * 256) * DM;
        bf16_t* dst = XR + (size_t)u.pm * 256 * DM; const float* gate = MOD + ((size_t)(LAYER * 33 + mj) * 6 + 2) * 1024;
        const int row0 = wr * 64 + fr, col0 = u.pn * 256 + wc * 32 + 8 * fq;
        f32x4 gv[2][2];
#pragma unroll
        for (int bj = 0; bj < 2; ++bj)
#pragma unroll
            for (int n = 0; n < 2; ++n) gv[bj][n] = *(const f32x4*)(gate + col0 + bj * 128 + 4 * n);
        const unsigned lo = (unsigned)(row0 * DM + col0); constexpr int GD = 4; constexpr float SC = FP8 ? (1.f / 1024.f) : 1.f;
        f32x4 pb0[GD], pb1[GD]; u32x4 pw[GD]; (void)pb0; (void)pb1; (void)pw;
#define PO_LD(slot, g) do { const int ai_ = (g) >> 3, m_ = ((g) >> 1) & 3, bj_ = (g) & 1; const size_t uo_ = (size_t)(ai_ * 128 + m_ * 16) * DM; \
            if constexpr (LAYER == 0) { const char* bp = (const char*)(basef + uo_) + (size_t)(lo + bj_ * 128) * 4u; pb0[slot] = *(const f32x4*)bp; pb1[slot] = *(const f32x4*)(bp + 16); } \
            else pw[slot] = *(const u32x4*)((const char*)(dst + uo_) + (lo + bj_ * 128) * 2u); } while (0)
#pragma unroll
        for (int g = 0; g < GD; ++g) PO_LD(g, g);
#pragma unroll
        for (int g = 0; g < 16; ++g) { const int sl = g % GD, ai = g >> 3, m = (g >> 1) & 3, bj = g & 1; const size_t uo = (size_t)(ai * 128 + m * 16) * DM; f32x4 b0, b1;
            if constexpr (LAYER == 0) { b0 = pb0[sl]; b1 = pb1[sl]; }
            else { const u32x4 w = pw[sl]; b0 = (f32x4){bflo(w.x), bfhi(w.x), bflo(w.y), bfhi(w.y)}; b1 = (f32x4){bflo(w.z), bfhi(w.z), bflo(w.w), bfhi(w.w)}; }
            const f32x4 v0 = b0 + gv[bj][0] * (acc[ai][bj][m][0] * SC), v1 = b1 + gv[bj][1] * (acc[ai][bj][m][1] * SC);
            u32x4 wo; wo.x = cvtpk(v0[0], v0[1]); wo.y = cvtpk(v0[2], v0[3]); wo.z = cvtpk(v1[0], v1[1]); wo.w = cvtpk(v1[2], v1[3]);
            *(u32x4*)((char*)(dst + uo) + (lo + bj * 128) * 2u) = wo;
            if (g + GD < 16) PO_LD(sl, g + GD);
            __builtin_amdgcn_sched_barrier(0); }
#undef PO_LD
    }
};
struct MoeSched {
    const LAS int* pb; const LAS unsigned* bt; int NTN, G, c;
    __device__ bool map(int i, Unit& u) const {
        const int x = c & 7, q = i * (G >> 3) + (c >> 3); const int blk = (q / NTN) * 8 + x; u.pn = q % NTN;
        const unsigned ent = (unsigned)__builtin_amdgcn_readfirstlane((int)bt[blk < BT_N ? blk : BT_N - 1]);
        if (ent == 0xffffffffu) return false;
        u.e = (int)(ent >> 16); u.rb = (int)(ent & 0xffffu); u.pm = blk; return true;
    }
};
struct ProbMoe1 {
    static constexpr bool PERM = true, GATHER = !(MOE_PREGATHER && MOE_FP8), FP8 = MOE_FP8 != 0, P16 = false, MOE = true; static constexpr int KCONST = 0; int K, lda; const bf16_t* H; const bf16_t* W1; const float* B1; bf16_t* ACT; const int* rowl; const LAS int* cnt; MoeSched ms; int wave_s; LAS uchar* stage;
    __device__ bool next(int i, Unit& u) const { return ms.map(i, u); }
    __device__ const void* a_mat() const { return H; } __device__ const void* b_mat() const { return W1; }
    __device__ unsigned a_off(const Unit& u) const { return GATHER ? 0u : (unsigned)u.pm * 256u * 1024u; }
    __device__ unsigned b_off(const Unit& u) const { return ((unsigned)u.e * 2048u + (unsigned)u.pn * 256u) * 1024u * (FP8 ? 1u : 2u); }
    __device__ void a_voff(const Unit& u, unsigned (&vo)[2][2]) const {
        const int n = cnt[u.e]; const int* rl = rowl + (size_t)u.e * ROWCAP + u.rb * 256;
        const int tidg = tid_fresh(wave_s);
#pragma unroll
        for (int i = 0; i < 2; ++i) { int R, C; pg8::stage_rc(tidg * 16 + i * 8192, R, C);
#pragma unroll
            for (int h = 0; h < 2; ++h) { const int ri = h * 128 + R; const int tk = rl[ri]; const int tok = (u.rb * 256 + ri < n) ? tk : 0; vo[h][i] = (unsigned)tok * (FP8 ? 1024u : 2048u) + (unsigned)C * 2u; } }
    }
    __device__ void unit_top(const Unit& cur, const Unit& nx, bool has_next, int wid, int ui) const {
        if (IDX_LDS != 0 && wid == 0 && has_next) { const int ln = tid_fresh(wave_s) & 63;
            __builtin_amdgcn_global_load_lds((const unsigned*)(rowl + (size_t)nx.e * ROWCAP + nx.rb * 256 + ln * 4), (LAS unsigned*)(stage), 16, 0, 0); }
        if (BIAS_LDS != 0 && wid == 1) { const int ln = tid_fresh(wave_s) & 63;
            __builtin_amdgcn_global_load_lds((const unsigned*)(B1 + (size_t)cur.e * 2048 + (ln >> 5) * 1024 + cur.pn * 128 + (ln & 31) * 4), (LAS unsigned*)(stage + 1024 + (ui & 1) * 1024), 16, 0, 0); }
    }
    __device__ void a_voff_next(const Unit& u, unsigned (&vo)[2][2]) const {
        if constexpr (IDX_LDS == 0) { a_voff(u, vo); return; }
        const int n = cnt[u.e]; const volatile LAS int* il = (const volatile LAS int*)stage;
        const int tidg = tid_fresh(wave_s);
#pragma unroll
        for (int i = 0; i < 2; ++i) { int R, C; pg8::stage_rc(tidg * 16 + i * 8192, R, C);
#pragma unroll
            for (int h = 0; h < 2; ++h) { const int ri = h * 128 + R; const int tk = il[ri]; const int tok = (u.rb * 256 + ri < n) ? tk : 0; vo[h][i] = (unsigned)tok * (FP8 ? 1024u : 2048u) + (unsigned)C * 2u; } }
    }
    __device__ void epi(const Acc& acc, const Unit& u, int wr, int wc, int fr, int fq, int ui) const {
        const int row0 = wr * 64 + fr, col0 = u.pn * 128 + wc * 32 + 8 * fq;
        f32x4 bgv[2], blv[2];
        if constexpr (BIAS_LDS != 0) { const LAS float* bb = (const LAS float*)(stage + 1024 + (ui & 1) * 1024) + wc * 32 + 8 * fq;
#pragma unroll
            for (int n = 0; n < 2; ++n) { bgv[n] = *(const LAS f32x4*)(bb + 4 * n); blv[n] = *(const LAS f32x4*)(bb + 128 + 4 * n); } }
        else { const float* bg = B1 + (size_t)u.e * 2048 + col0; const float* bl = bg + 1024;
#pragma unroll
            for (int n = 0; n < 2; ++n) { bgv[n] = *(const f32x4*)(bg + 4 * n); blv[n] = *(const f32x4*)(bl + 4 * n); } }
        constexpr float SC = FP8 ? (1.f / 256.f) : 1.f;
        if constexpr (FP8 && EPI1_PK != 0) { bgv[0] *= 1.702f * 1.4426950408889634f; bgv[1] *= 1.702f * 1.4426950408889634f; }
        bf16_t* dst = ACT + (size_t)u.pm * 256 * 1024; unsigned char* dst8 = (unsigned char*)ACT + (size_t)u.pm * 256 * 1024; const unsigned lane_off = (unsigned)(row0 * 1024 + col0);
        const int tl = tid_fresh(wave_s); const int pc = wc * 4 + fq;
        const unsigned woff = (unsigned)((wr * 64 + fr) * 128 + ((((pc >> 1) ^ (fr & 7)) << 4) | ((pc & 1) << 3)));
        const unsigned roff = (unsigned)((tl >> 3) * 128 + (((tl & 7) ^ ((tl >> 3) & 7)) << 4));
        const unsigned goff = (unsigned)((tl >> 3) * 1024 + (tl & 7) * 16) + (unsigned)(u.pn * 128);
#pragma unroll
        for (int ai = 0; ai < 2; ++ai) {
            if (EPI_LDS1 != 0 && FP8 && ai == 1) { asm volatile("s_waitcnt lgkmcnt(0)" ::: "memory"); __builtin_amdgcn_s_barrier(); }
#pragma unroll
            for (int m = 0; m < 4; ++m) { float a[8];
                if constexpr (FP8 && EPI1_PK != 0) {
                    constexpr float C2 = 1.702f * 1.4426950408889634f, K8 = 8.f / C2;
#pragma unroll
                    for (int n = 0; n < 2; ++n)
#pragma unroll
                        for (int h = 0; h < 2; ++h) { const f32x4 ag = acc[ai][0][m][n], al = acc[ai][1][m][n];
                            f32x2 wv = (f32x2){ag[2 * h], ag[2 * h + 1]} * (SC * C2) + (f32x2){bgv[n][2 * h], bgv[n][2 * h + 1]};
                            wv.x = fminf(wv.x, 7.f * C2); wv.y = fminf(wv.y, 7.f * C2);
                            const f32x2 d = (f32x2){__builtin_amdgcn_exp2f(-wv.x), __builtin_amdgcn_exp2f(-wv.y)} + 1.f;
                            const f32x2 t = wv * (f32x2){__builtin_amdgcn_rcpf(d.x), __builtin_amdgcn_rcpf(d.y)};
                            f32x2 lv = (f32x2){al[2 * h], al[2 * h + 1]} * SC + (f32x2){blv[n][2 * h], blv[n][2 * h + 1]};
                            lv.x = __builtin_amdgcn_fmed3f(lv.x, -7.f, 7.f); lv.y = __builtin_amdgcn_fmed3f(lv.y, -7.f, 7.f);
                            const f32x2 a8 = t * (lv * K8 + K8);
                            a[4 * n + 2 * h] = a8.x; a[4 * n + 2 * h + 1] = a8.y; }
                } else {
#pragma unroll
                for (int n = 0; n < 2; ++n) { const f32x4 g = acc[ai][0][m][n] * SC + bgv[n], l = acc[ai][1][m][n] * SC + blv[n];
#pragma unroll
                    for (int j = 0; j < 4; ++j) { const float gg = fminf(g[j], 7.f), ll = fminf(fmaxf(l[j], -7.f), 7.f);
                        a[4 * n + j] = gg * __builtin_amdgcn_rcpf(1.f + __builtin_amdgcn_exp2f(-1.702f * 1.4426950408889634f * gg)) * (ll + 1.f) * (FP8 ? 8.f : 1.f); } }
                }
                if constexpr (FP8) { u32x2 w; w.x = pk4_fp8_nc(a[0], a[1], a[2], a[3]); w.y = pk4_fp8_nc(a[4], a[5], a[6], a[7]);
                    if constexpr (EPI_LDS1 != 0) *(LAS u32x2*)(stage + woff + m * 2048) = w;
                    else *(u32x2*)(dst8 + (size_t)((ai * 128 + m * 16) * 1024) + lane_off) = w; }
                else { u32x4 w; w.x = cvtpk(a[0], a[1]); w.y = cvtpk(a[2], a[3]); w.z = cvtpk(a[4], a[5]); w.w = cvtpk(a[6], a[7]);
                    *(u32x4*)((char*)dst + (size_t)((ai * 128 + m * 16) * 2048) + lane_off * 2u) = w; } }
            if constexpr (EPI_LDS1 != 0 && FP8) {
                asm volatile("s_waitcnt lgkmcnt(0)" ::: "memory"); __builtin_amdgcn_s_barrier();
                const u32x4 r0 = *(const LAS u32x4*)(stage + roff), r1 = *(const LAS u32x4*)(stage + roff + 64 * 128);
                unsigned char* rowb = (unsigned char*)ACT + (size_t)u.pm * 256 * 1024 + (size_t)(ai * 128) * 1024;
                *(u32x4*)(rowb + goff) = r0; *(u32x4*)(rowb + goff + 64 * 1024) = r1; } }
    }
};
struct ProbMoe2 {
    static constexpr bool PERM = true, GATHER = false, FP8 = MOE_FP8 != 0, P16 = (Y_FP8 != 0) && (EPI_P16 != 0), MOE = true; static constexpr int KCONST = 0; int K, lda; const bf16_t* ACT; const bf16_t* W2; const float* B2; bf16_t* Y; MoeSched ms; int wave_s; LAS uchar* stage;
    __device__ bool next(int i, Unit& u) const { return ms.map(i, u); }
    __device__ const void* a_mat() const { return ACT; } __device__ const void* b_mat() const { return W2; }
    __device__ unsigned a_off(const Unit& u) const { return (unsigned)u.pm * 256u * 1024u * (FP8 ? 1u : 2u); }
    __device__ unsigned b_off(const Unit& u) const { return ((unsigned)u.e * 1024u + (unsigned)u.pn * 256u) * 1024u * (FP8 ? 1u : 2u); }
    __device__ void a_voff(const Unit&, unsigned (&)[2][2]) const {}
    __device__ void unit_top(const Unit& cur, const Unit&, bool, int wid, int ui) const {
        if (BIAS_LDS != 0 && Y_FP8 != 0 && wid == 1) { const int ln = tid_fresh(wave_s) & 63;
            __builtin_amdgcn_global_load_lds((const unsigned*)(B2 + (size_t)cur.e * 1024 + cur.pn * 256 + ln * 4), (LAS unsigned*)(stage + 1024 + (ui & 1) * 1024), 16, 0, 0); }
    }
    __device__ void epi_prefetch(const Unit& nx, bool has_next, int wid) const {
        if (L2PF != 0 && L2PF2 != 0 && FP8 && has_next) { const int ln = tid_fresh(wave_s) & 63;
#pragma unroll
            for (int r = 0; r < 8; ++r)
                __builtin_amdgcn_global_load_lds((const unsigned*)((const unsigned char*)ACT + ((size_t)nx.pm * 256 + nx.pn * 64 + wid * 8 + r) * 1024 + ln * 16), (LAS unsigned*)(stage + 3072 + wid * 1024), 16, 0, 0); }
    }
    __device__ void epi(const Acc& acc, const Unit& u, int wr, int wc, int fr, int fq, int ui) const {
        constexpr float SC = FP8 ? (1.f / 512.f) : 1.f;
#if Y_FP8
        const int row0 = wr * 64 + fr, col0 = P16 ? wc * 64 + 16 * fq : wc * 32 + 8 * fq; const float* bias = B2 + (size_t)u.e * 1024 + u.pn * 256 + col0;
        f32x4 bv[2][2];
#pragma unroll
        for (int bj = 0; bj < 2; ++bj)
#pragma unroll
            for (int n = 0; n < 2; ++n) { if constexpr (BIAS_LDS != 0) bv[bj][n] = *(const LAS f32x4*)((const LAS float*)(stage + 1024 + (ui & 1) * 1024) + col0 + bj * (P16 ? 8 : 128) + 4 * n);
                else bv[bj][n] = *(const f32x4*)(bias + bj * (P16 ? 8 : 128) + 4 * n);
                bv[bj][n] *= 16.f; }
        unsigned char* dst = (unsigned char*)Y + ((size_t)u.pm * 256) * 1024 + u.pn * 256; const unsigned lane_off = (unsigned)(row0 * 1024 + col0);
#pragma unroll
        for (int ai = 0; ai < 2; ++ai)
#pragma unroll
            for (int m = 0; m < 4; ++m) { unsigned char* rowb = dst + (size_t)((ai * 128 + m * 16) * 1024);
                if constexpr (P16) { u32x4 w;
#pragma unroll
                    for (int bj = 0; bj < 2; ++bj) { const f32x4 v0 = acc[ai][bj][m][0] * (SC * 16.f) + bv[bj][0], v1 = acc[ai][bj][m][1] * (SC * 16.f) + bv[bj][1];
                        w[2 * bj] = pk4_fp8(v0[0], v0[1], v0[2], v0[3]); w[2 * bj + 1] = pk4_fp8(v1[0], v1[1], v1[2], v1[3]); }
                    *(u32x4*)(rowb + lane_off) = w; }
                else {
#pragma unroll
                for (int bj = 0; bj < 2; ++bj) { const f32x4 v0 = acc[ai][bj][m][0] * (SC * 16.f) + bv[bj][0], v1 = acc[ai][bj][m][1] * (SC * 16.f) + bv[bj][1];
                    u32x2 w; w.x = pk4_fp8(v0[0], v0[1], v0[2], v0[3]); w.y = pk4_fp8(v1[0], v1[1], v1[2], v1[3]);
                    *(u32x2*)(rowb + lane_off + bj * 128) = w; } } }
#else
        pg8::epi_store_bf16<false>(acc, Y + (size_t)u.pm * 256 * 1024 + u.pn * 256, 1024, B2 + (size_t)u.e * 1024 + u.pn * 256, wr, wc, fr, fq, SC);
#endif
    }
};

__global__ void __launch_bounds__(512, 2) fwd_kernel(Args args) {
    extern __shared__ __attribute__((aligned(16))) uchar lds_raw[];
    const int wave_s = __builtin_amdgcn_readfirstlane((int)threadIdx.x >> 6);
    Frame F; F.lds = (LAS uchar*)lds_raw; F.tid = tid_fresh(wave_s); F.lane = F.tid & 63; F.wave = wave_s; F.G = gridDim.x; F.bid = blockIdx.x;
    F.ws = args.ws; F.out = args.out;
    volatile LAS unsigned* MISC = (volatile LAS unsigned*)(F.lds + MISC_OFF);
    if (F.tid < 64) MISC[F.tid] = 0u;
    __syncthreads();
    unsigned* ctl = (unsigned*)(F.ws + WS_CTL);
    XcdBarrier bar; bar.bar = ctl + CW_BAR; bar.x = 0; bar.st = nullptr;
    const int lo = args.ph_lo, hi = args.ph_hi;
    bar = xcd_barrier_post(ctl + CW_BAR + (lo & 1) * XCD_BAR_WORDS, MISC + 8, F.tid == 0);
#ifndef PHMASK
#define PHMASK 0x7ffff
#endif
#define REFRAME() do { F.tid = tid_fresh(wave_s); F.lane = F.tid & 63; F.wave = wave_s; } while (0)
#define IN(k) (((PHMASK >> (k)) & 1) && lo <= (k) && (k) < hi)
#define SEAM(k) do { if (IN(k) && IN((k) + 1)) { const int t_ = tid_fresh(wave_s); xcd_barrier(bar, t_ == 0); } } while (0)
    uchar* ws = F.ws;
    bf16_t* H = (bf16_t*)(ws + WS_H); bf16_t* XR = (bf16_t*)(ws + WS_XR); const float* MOD = (const float*)(ws + WS_MOD);

#if PROBE_CLK
#define CLK_A(k) do { if ((k) == PROBE_CLK_PH && F.bid == 0 && tid_fresh(wave_s) == 0) { unsigned long long* st_ = (unsigned long long*)(ws + WS_CTL) + (CW_DBG / 2); st_[0] = __builtin_amdgcn_s_memrealtime(); st_[1] = __builtin_amdgcn_s_memtime(); } } while (0)
#define CLK_B(k) do { if ((k) == PROBE_CLK_PH && F.bid == 0 && tid_fresh(wave_s) == 0) { unsigned long long* st_ = (unsigned long long*)(ws + WS_CTL) + (CW_DBG / 2); st_[2] = __builtin_amdgcn_s_memrealtime(); st_[3] = __builtin_amdgcn_s_memtime(); } } while (0)
#else
#define CLK_A(k) do { } while (0)
#define CLK_B(k) do { } while (0)
#endif
    if (IN(0)) { REFRAME(); p0_prologue(F); } SEAM(0);
    if (IN(1)) { REFRAME(); if constexpr (NORM0_V2 != 0 && PROJ0_FP8 == 0) p_norm0_v2(F); else p_norm0(F); } SEAM(1);
    if (IN(2)) { REFRAME(); ProbIn0 p; p.K = PROJ0_FP8 ? 512 : 1024; p.lda = p.K; p.A = H; p.Bt = (const bf16_t*)(ws + WS_WIN0); p.O = (bf16_t*)(ws + WS_PBUF); p.so.init(NPAN, 8); p.G = F.G; p.c = F.bid; pg8::gemm_phase(F.lds, p, wave_s); } SEAM(2);
    if (IN(3)) { REFRAME(); p_qk_prep(F); REFRAME(); p_sgu(F); } SEAM(3);
    if (IN(4)) { REFRAME();
        const bf16_t* P = (const bf16_t*)(ws + WS_PBUF); bf16_t* MIX = (bf16_t*)(ws + WS_MIX0); const unsigned char* KC8 = (const unsigned char*)(ws + WS_KC8); const unsigned char* VC8 = (const unsigned char*)(ws + WS_VC8); (void)KC8; (void)VC8;
        for (int u = F.bid; u < 1024 + 128; u += F.G) {
            if (u < 1024) { const int qb = u & 7, g = (u >> 3) & 1, kvh = (u >> 4) & 1, b = u >> 5, h = kvh * 2 + g; const size_t kr0 = (size_t)b * TPB, qr0 = kr0 + CTXL + qb * 256;
                if constexpr (GQA_QK_FP8 != 0 && ATT_KV8IN && ATT_PV_FP8) att::attn_unit_qk8<128, false, (QC8_FP8 != 0 && ATT_FOLD != 0) ? 512 : 2048, 256, 1024, OUT0_FP8 != 0, (ATT_PV_FP8 != 0), (QC8_FP8 != 0 && ATT_FOLD != 0)>((QC8_FP8 != 0 && ATT_FOLD != 0) ? (const bf16_t*)((const unsigned char*)(ws + WS_QC8) + qr0 * 512 + h * 128) : P + qr0 * 2048 + 1024 + h * 128, (const bf16_t*)(KC8 + kr0 * 256 + kvh * 128), nullptr, (const bf16_t*)(VC8 + kr0 * 256 + kvh * 128), OUT0_FP8 ? (bf16_t*)((unsigned char*)MIX + qr0 * 1024 + 512 + h * 128) : MIX + qr0 * 1024 + 512 + h * 128, TPB, (LAS char*)F.lds, nullptr, 0, wave_s);
                else if constexpr (GQA_QK_FP8 != 0) att::attn_unit_qk8<128, false, 2048, 2048, 1024, false>(P + qr0 * 2048 + 1024 + h * 128, P + kr0 * 2048 + 1536 + kvh * 128, nullptr, P + kr0 * 2048 + 1792 + kvh * 128, MIX + qr0 * 1024 + 512 + h * 128, TPB, (LAS char*)F.lds, nullptr, 0, wave_s);
                else att::attn_unit<128, 2, false, 2048, 2048, 1024>(P + qr0 * 2048 + 1024 + h * 128, P + kr0 * 2048 + 1536 + kvh * 128, nullptr, P + kr0 * 2048 + 1792 + kvh * 128, MIX + qr0 * 1024 + 512 + h * 128, TPB, (LAS char*)F.lds, nullptr, 0, wave_s);
            } else { const int v = u - 1024, h = v & 3, b = v >> 2, kvh = h >> 1; const size_t kr0 = (size_t)b * TPB;
                if constexpr (GQA_QK_FP8 != 0 && ATT_KV8IN && ATT_PV_FP8) att::attn_unit_qk8<128, false, (QC8_FP8 != 0 && ATT_FOLD != 0) ? 512 : 2048, 256, 1024, OUT0_FP8 != 0, (ATT_PV_FP8 != 0), (QC8_FP8 != 0 && ATT_FOLD != 0)>((QC8_FP8 != 0 && ATT_FOLD != 0) ? (const bf16_t*)((const unsigned char*)(ws + WS_QC8) + kr0 * 512 + h * 128) : P + kr0 * 2048 + 1024 + h * 128, (const bf16_t*)(KC8 + kr0 * 256 + kvh * 128), nullptr, (const bf16_t*)(VC8 + kr0 * 256 + kvh * 128), OUT0_FP8 ? (bf16_t*)((unsigned char*)MIX + kr0 * 1024 + 512 + h * 128) : MIX + kr0 * 1024 + 512 + h * 128, CTXL, (LAS char*)F.lds, nullptr, 0, wave_s);
                else if constexpr (GQA_QK_FP8 != 0) att::attn_unit_qk8<128, false, 2048, 2048, 1024, false>(P + kr0 * 2048 + 1024 + h * 128, P + kr0 * 2048 + 1536 + kvh * 128, nullptr, P + kr0 * 2048 + 1792 + kvh * 128, MIX + kr0 * 1024 + 512 + h * 128, CTXL, (LAS char*)F.lds, nullptr, 0, wave_s);
                else att::attn_unit<128, 2, false, 2048, 2048, 1024>(P + kr0 * 2048 + 1024 + h * 128, P + kr0 * 2048 + 1536 + kvh * 128, nullptr, P + kr0 * 2048 + 1792 + kvh * 128, MIX + kr0 * 1024 + 512 + h * 128, CTXL, (LAS char*)F.lds, nullptr, 0, wave_s); }
        }
    } SEAM(4);
    if (IN(5)) { REFRAME(); ProbOut<0> p; p.K = OUT0_FP8 ? 512 : 1024; p.lda = p.K; p.A = (const bf16_t*)(ws + WS_MIX0); p.Bt = (const bf16_t*)(ws + WS_WOUT0); p.XR = XR; p.MOD = MOD; p.xin = INP(I_X); p.cin = INP(I_CTX); p.so.init(NPAN, 4); p.G = F.G; p.c = F.bid; pg8::gemm_phase(F.lds, p, wave_s); } SEAM(5);
    if (IN(6)) { REFRAME(); p_norm_router<0>(F, args.dry); } SEAM(6);
    if (IN(7)) { REFRAME(); CLK_A(7);
#if MOE_PREGATHER && MOE_FP8
        p_moe_gather(F, 0); { const int t_ = tid_fresh(wave_s); xcd_barrier(bar, t_ == 0); } REFRAME();
#endif
        moe_prefix(F, 0); ProbMoe1 p; p.K = MOE_FP8 ? 512 : 1024; p.lda = p.K; p.H = (MOE_PREGATHER && MOE_FP8) ? (const bf16_t*)(ws + WS_XS) : H; p.W1 = (const bf16_t*)(ws + WS_W1); p.B1 = INP(I_B1); p.ACT = (bf16_t*)(ws + WS_ACT); p.rowl = (const int*)(ws + WS_ROWL);
        p.cnt = (const LAS int*)(F.lds + XTRA_OFF + X_CNT); p.stage = F.lds + XTRA_OFF + 1024; p.wave_s = wave_s; p.ms.pb = (const LAS int*)(F.lds + XTRA_OFF + X_PB); p.ms.bt = (const LAS unsigned*)(F.lds + XTRA_OFF + X_BT); p.ms.NTN = 8; p.ms.G = F.G; p.ms.c = F.bid; pg8::gemm_phase(F.lds, p, wave_s); CLK_B(7); } SEAM(7);
    if (IN(8)) { REFRAME(); moe_prefix(F, 0); ProbMoe2 p; p.K = MOE_FP8 ? 512 : 1024; p.lda = p.K; p.ACT = (const bf16_t*)(ws + WS_ACT); p.W2 = (const bf16_t*)(ws + WS_W2); p.B2 = INP(I_B2); p.Y = (bf16_t*)(ws + WS_Y);
        p.wave_s = wave_s; p.stage = F.lds + XTRA_OFF + 1024; p.ms.pb = (const LAS int*)(F.lds + XTRA_OFF + X_PB); p.ms.bt = (const LAS unsigned*)(F.lds + XTRA_OFF + X_BT); p.ms.NTN = 4; p.ms.G = F.G; p.ms.c = F.bid; pg8::gemm_phase(F.lds, p, wave_s); } SEAM(8);
    if (IN(9)) { REFRAME(); if constexpr (COMBINE_V2 != 0 && PROJ1_FP8 != 0 && Y_FP8 != 0) p_combine_v2<false>(F, args.dry); else p_combine_norm(F, args.dry); } SEAM(9);
    if (IN(10)) { REFRAME(); ProbIn1 p; p.K = PROJ1_FP8 ? 512 : 1024; p.lda = p.K; p.A = H; p.Bt = (const bf16_t*)(ws + WS_WIN1); p.O = (bf16_t*)(ws + WS_PBUF); p.so.init(256, 4); p.G = F.G; p.c = F.bid; pg8::gemm_phase(F.lds, p, wave_s); } SEAM(10);
    if (IN(11)) { REFRAME(); p_mla_prep(F); } SEAM(11);
    if (IN(12)) { REFRAME();
        { ProbPlain<true, UPQ_FP8 != 0, 0, (QB_FP8 != 0 && ATT_FOLD != 0 && UPQ_FP8 != 0)> p; p.osc8 = att::Cfg<192>::SCALE * 1.4426950408889634f * 32.f; p.K = UPQ_FP8 ? 256 : 512; p.lda = UPQ_FP8 ? 256 : 1024; p.A = UPQ_FP8 ? (const bf16_t*)(ws + WS_CQ8) : (const bf16_t*)(ws + WS_PBUF); p.Bt = (const bf16_t*)(ws + WS_WUQ); p.O = (bf16_t*)(ws + WS_QB); p.ldc = 1536; p.so.init(256, 6); p.G = F.G; p.c = F.bid; pg8::gemm_phase(F.lds, p, wave_s); }
        { ProbPlain<false, UPKV_FP8 != 0, (UPKV_FP8 ? 128 : 256), (ATT_KV8IN && ATT_PV_FP8 && MLA_QK_FP8)> p; p.K = UPKV_FP8 ? 128 : 256; p.lda = UPKV_FP8 ? 128 : 1024; p.A = UPKV_FP8 ? (const bf16_t*)(ws + WS_CKV8) : (const bf16_t*)(ws + WS_PBUF) + 512; p.Bt = (const bf16_t*)(ws + WS_WUKV); p.O = (bf16_t*)(ws + WS_KVB); p.ldc = 2048; p.so.init(NPAN, 8); p.G = F.G; p.c = F.bid; pg8::gemm_phase(F.lds, p, wave_s); }
    } SEAM(12);
    if (IN(13)) { REFRAME(); CLK_A(13);
        const bf16_t* Q = (const bf16_t*)(ws + WS_QB); const bf16_t* KV = (const bf16_t*)(ws + WS_KVB); const bf16_t* KR = (const bf16_t*)(ws + WS_KRB); bf16_t* MIX = (bf16_t*)(ws + WS_MIX1);
        for (int u = F.bid; u < 2048; u += F.G) { const int qb = u & 7, h = (u >> 3) & 7, b = u >> 6; const size_t kr0 = (size_t)b * TPB, qr0 = kr0 + CTXL + qb * 256;
            att::attn_unit_qk8<192, true, 1536, 2048, 1024, OUT1_FP8 != 0, (ATT_PV_FP8 != 0), (QB_FP8 != 0 && ATT_FOLD != 0 && UPQ_FP8 != 0)>((QB_FP8 != 0 && ATT_FOLD != 0 && UPQ_FP8 != 0) ? (const bf16_t*)((const unsigned char*)Q + qr0 * 1536 + h * 192) : Q + qr0 * 1536 + h * 192, (ATT_KV8IN && ATT_PV_FP8) ? (const bf16_t*)((const unsigned char*)KV + kr0 * 2048 + h * 128) : KV + kr0 * 2048 + h * 128, (ATT_KV8IN && ATT_PV_FP8) ? (const bf16_t*)((const unsigned char*)(ws + WS_KR8) + kr0 * 64) : KR + kr0 * 64, (ATT_KV8IN && ATT_PV_FP8) ? (const bf16_t*)((const unsigned char*)KV + kr0 * 2048 + 1024 + h * 128) : KV + kr0 * 2048 + 1024 + h * 128, OUT1_FP8 ? (bf16_t*)((unsigned char*)MIX + qr0 * 1024 + h * 128) : MIX + qr0 * 1024 + h * 128, TPB, (LAS char*)F.lds, (const f32x2*)(ws + WS_TABM), qb * 256, wave_s); }
    CLK_B(13); } SEAM(13);
    if (IN(14)) { REFRAME(); ProbOut<1> p; p.K = OUT1_FP8 ? 512 : 1024; p.lda = p.K; p.A = (const bf16_t*)(ws + WS_MIX1); p.Bt = (const bf16_t*)(ws + WS_WOUT1); p.XR = XR; p.MOD = MOD; p.xin = nullptr; p.cin = nullptr; p.so.init(256, 4); p.G = F.G; p.c = F.bid; pg8::gemm_phase(F.lds, p, wave_s); } SEAM(14);
    if (IN(15)) { REFRAME(); p_norm_router<1>(F, args.dry); } SEAM(15);
    if (IN(16)) { REFRAME();
#if MOE_PREGATHER && MOE_FP8
        p_moe_gather(F, 1); { const int t_ = tid_fresh(wave_s); xcd_barrier(bar, t_ == 0); } REFRAME();
#endif
        moe_prefix(F, 1); ProbMoe1 p; p.K = MOE_FP8 ? 512 : 1024; p.lda = p.K; p.H = (MOE_PREGATHER && MOE_FP8) ? (const bf16_t*)(ws + WS_XS) : H; p.W1 = (const bf16_t*)(ws + WS_W1 + (size_t)32 * 2048 * 1024 * (MOE_FP8 ? 1 : 2)); p.B1 = INP(I_B1) + 32 * 2048; p.ACT = (bf16_t*)(ws + WS_ACT); p.rowl = (const int*)(ws + WS_ROWL);
        p.cnt = (const LAS int*)(F.lds + XTRA_OFF + X_CNT); p.stage = F.lds + XTRA_OFF + 1024; p.wave_s = wave_s; p.ms.pb = (const LAS int*)(F.lds + XTRA_OFF + X_PB); p.ms.bt = (const LAS unsigned*)(F.lds + XTRA_OFF + X_BT); p.ms.NTN = 8; p.ms.G = F.G; p.ms.c = F.bid; pg8::gemm_phase(F.lds, p, wave_s); } SEAM(16);
    if (IN(17)) { REFRAME(); moe_prefix(F, 1); ProbMoe2 p; p.K = MOE_FP8 ? 512 : 1024; p.lda = p.K; p.ACT = (const bf16_t*)(ws + WS_ACT); p.W2 = (const bf16_t*)(ws + WS_W2 + (size_t)32 * 1024 * 1024 * (MOE_FP8 ? 1 : 2)); p.B2 = INP(I_B2) + 32 * 1024; p.Y = (bf16_t*)(ws + WS_Y);
        p.wave_s = wave_s; p.stage = F.lds + XTRA_OFF + 1024; p.ms.pb = (const LAS int*)(F.lds + XTRA_OFF + X_PB); p.ms.bt = (const LAS unsigned*)(F.lds + XTRA_OFF + X_BT); p.ms.NTN = 4; p.ms.G = F.G; p.ms.c = F.bid; pg8::gemm_phase(F.lds, p, wave_s); } SEAM(17);
    if (IN(18)) { REFRAME(); if constexpr (COMBINE_V2 != 0 && PROJ1_FP8 != 0 && Y_FP8 != 0) p_combine_v2<true>(F, 0); else p_final(F); }
#if PROBE_CLK
    if (F.bid == 0 && hi == NPHASE) { __syncthreads(); const unsigned long long* st_ = (const unsigned long long*)(ws + WS_CTL) + (CW_DBG / 2);
        unsigned long long d = 0;
        if (PROBE_CLK == 1) d = (st_[3] - st_[1]) * 1000ull / (st_[2] - st_[0]);
        if (PROBE_CLK == 2) d = (st_[2] - st_[0]);
        const unsigned long long t0 = __builtin_amdgcn_s_memrealtime(); while (__builtin_amdgcn_s_memrealtime() - t0 < d) __builtin_amdgcn_s_sleep(8); }
#endif
#undef IN
#undef SEAM
}

extern "C" void kernel_launch(void* const* d_in, const int* in_sizes, int n_in, void* d_out, int out_size, void* d_ws, size_t ws_size, hipStream_t stream) {
    static int grid = 0;
    if (grid == 0) {
        if (n_in != 28 || out_size != NBATCH * SEQ * DM || ws_size < WS_END) { fprintf(stderr, "kernel_launch: unexpected shapes (n_in %d out %d ws %zu, need ws >= %zu)\n", n_in, out_size, ws_size, (size_t)WS_END); grid = -1; return; }
        int dev = 0, cus = 0, per_cu = 0;
        if (hipGetDevice(&dev) != hipSuccess || hipDeviceGetAttribute(&cus, hipDeviceAttributeMultiprocessorCount, dev) != hipSuccess) { grid = -1; return; }
        if (hipFuncSetAttribute((const void*)fwd_kernel, hipFuncAttributeMaxDynamicSharedMemorySize, LDS_BYTES) != hipSuccess) { fprintf(stderr, "kernel_launch: hipFuncSetAttribute failed\n"); grid = -1; return; }
        if (hipOccupancyMaxActiveBlocksPerMultiprocessor(&per_cu, (const void*)fwd_kernel, 512, LDS_BYTES) != hipSuccess || per_cu < 1) { fprintf(stderr, "kernel_launch: occupancy query says %d blocks/CU\n", per_cu); }
        (void)hipGetLastError();
        grid = cus;
    }
    if (grid < 0) return;
    (void)hipMemsetAsync((char*)d_ws + WS_CTL, 0, CTL_BYTES, stream);
    Args a{};
    for (int i = 0; i < 28; ++i) a.in[i] = (const float*)d_in[i];
    a.out = (float*)d_out; a.ws = (uchar*)d_ws;
#if MK_ONE_LAUNCH
    a.ph_lo = 0; a.ph_hi = NPHASE;
    hipLaunchKernelGGL(fwd_kernel, dim3(grid), dim3(512), LDS_BYTES, stream, a);
#else
    for (int ph = 0; ph < NPHASE; ++ph) { a.ph_lo = ph; a.ph_hi = ph + 1; const int nrep = 1 + ((REPEAT_MASK >> ph) & 1); for (int rep = 0; rep < nrep; ++rep) { a.dry = (rep + 1 < nrep) ? 1 : 0; hipLaunchKernelGGL(fwd_kernel, dim3(grid), dim3(512), LDS_BYTES, stream, a); } }
#endif
}
```

```cpp
#include <hip/hip_runtime.h>
#include <cstdio>
#include <cstdint>

#ifndef MK_ONE_LAUNCH
#define MK_ONE_LAUNCH 1
#endif
#define REPEAT_MASK 0
#define USE_BUFFER_LDS 1
#define MOE_PREGATHER 0
#define PROJ0_FP8 0
#ifndef UPQ_FP8
#define UPQ_FP8 (MOE_FP8 != 0)
#endif
#ifndef UPKV_FP8
#define UPKV_FP8 1
#endif
#define UP1_FP8_UNUSED 0
#define EPI_P16 1
#define EPI_LDS1 0
#define IDX_LDS 1
#define BIAS_LDS 1
#define ATT_OT 1
#define COMBINE_V2 1
#define SGU_T 1
#define EPI1_PK 1
#define L2PF1 1
#define L2PF2 1
#define NORM0_V2 1
#define P0_ITEM128 1
#define ATT_LSUM_MFMA 1
#define ATT_FOLD 1
#define QB_FP8 1
#define PBUF1_FP8 1
#define ATT_KVDMA 1
#define QC8_FP8 1
#define L2PF 1
#define GEMM_ALIGN_EPI 1
#define ATT_KV8IN 1
#define ATT_PV_FP8 1
#define GQA_QK_FP8 1
#define MLA_QK_FP8 1
#define OUT0_FP8 0
#define OUT1_FP8 (MOE_FP8 != 0)
#define PROJ1_FP8 (MOE_FP8 != 0)
#define PROJ_FP8_UNUSED (MOE_FP8 != 0)
#define PROBE_CLK 0
#define PROBE_CLK_PH 7
#define Y_FP8 1
#ifndef MOE_FP8
#define MOE_FP8 1
#endif

#define LAS __attribute__((address_space(3)))
typedef unsigned short bf16_t;
typedef unsigned char uchar;
typedef short bf16x8 __attribute__((ext_vector_type(8)));
typedef short s16x4 __attribute__((ext_vector_type(4)));
typedef float f32x2 __attribute__((ext_vector_type(2)));
typedef float f32x4 __attribute__((ext_vector_type(4)));
typedef float f32x16 __attribute__((ext_vector_type(16)));
typedef unsigned u32x2 __attribute__((ext_vector_type(2)));
typedef unsigned u32x4 __attribute__((ext_vector_type(4)));
typedef int i32x4 __attribute__((ext_vector_type(4)));
typedef int i32x8 __attribute__((ext_vector_type(8)));

constexpr int DM = 1024, NBATCH = 32, SEQ = 2048, CTXL = 256, TPB = SEQ + CTXL, NTOK = NBATCH * TPB, NPAN = NTOK / 256;
constexpr int NEXP = 32, TOPK = 4, ROWCAP = NTOK;
constexpr float EPS = 1e-6f;
constexpr int NPHASE = 19;

constexpr size_t MiB = 1u << 20;
constexpr size_t WS_CTL = 0, CTL_BYTES = 1 * MiB;
constexpr size_t WS_MOD = 1 * MiB;
constexpr size_t WS_TABG = 3 * MiB;
constexpr size_t WS_TABM = WS_TABG + 32768;
constexpr size_t WS_WRT = WS_TABG + 65536;
constexpr size_t WS_SGUW = WS_WRT + 262144;
constexpr size_t WS_WIN0 = 4 * MiB, WS_WOUT0 = 8 * MiB, WS_WIN1 = 10 * MiB, WS_WUQ = 12 * MiB, WS_WUKV = 14 * MiB, WS_WOUT1 = 15 * MiB;
constexpr size_t WS_W1 = 17 * MiB;
constexpr size_t WS_W2 = 273 * MiB;
constexpr size_t WS_ROWL = 401 * MiB;
constexpr size_t WS_TOKI = 410 * MiB;
constexpr size_t WS_XR = 413 * MiB;
constexpr size_t WS_H = 701 * MiB;
constexpr size_t WS_SCR = 845 * MiB;
constexpr size_t WS_PBUF = WS_SCR;
constexpr size_t WS_MIX0 = WS_SCR + 288 * MiB;
constexpr size_t WS_KC8 = WS_SCR + 432 * MiB;
constexpr size_t WS_QC8 = WS_SCR + 472 * MiB;
constexpr size_t WS_VC8 = WS_SCR + 452 * MiB;
constexpr size_t WS_KR8 = WS_SCR + 880 * MiB;
constexpr size_t WS_QB = WS_SCR + 144 * MiB;
constexpr size_t WS_KVB = WS_SCR + 360 * MiB;
constexpr size_t WS_KRB = WS_SCR + 648 * MiB;
constexpr size_t WS_MIX1 = WS_SCR + 660 * MiB;
constexpr size_t WS_CQ8 = WS_SCR + 804 * MiB;
constexpr size_t WS_CKV8 = WS_SCR + 840 * MiB;
constexpr size_t WS_ACT = WS_SCR;
constexpr size_t WS_XS = WS_SCR + 296 * MiB;
constexpr size_t WS_Y = WS_SCR + 592 * MiB;
constexpr size_t WS_END = WS_SCR + 1184 * MiB;
constexpr int CW_BAR = 1024;
constexpr int CW_CNT = 8192;
constexpr int CW_DBG = 16384;

constexpr int RING_BYTES = 131072;
constexpr int XTRA_OFF = RING_BYTES, XTRA_BYTES = 20480;
constexpr int MISC_OFF = XTRA_OFF + XTRA_BYTES;
constexpr int LDS_BYTES = MISC_OFF + 512;
constexpr int X_PB = 0;
constexpr int X_CNT = 256;
constexpr int X_HIST = 512;
constexpr int X_BASE = 768;
constexpr int X_SEL = 1024;
constexpr int X_A2 = 9216;
constexpr int X_CB = 13312;
constexpr int X_BT = 12288, BT_N = 1280;
constexpr int X_RS = 13440;

#define LDS_WAIT() asm volatile("s_waitcnt lgkmcnt(0)" ::: "memory")
#define VM_WAIT() asm volatile("s_waitcnt vmcnt(0)" ::: "memory")
#define SBAR() __builtin_amdgcn_sched_barrier(0)
__device__ __forceinline__ unsigned cvtpk(float lo, float hi) { unsigned r; asm volatile("v_cvt_pk_bf16_f32 %0, %1, %2" : "=v"(r) : "v"(lo), "v"(hi)); return r; }
__device__ __forceinline__ float bf2f(unsigned short b) { return __uint_as_float(((unsigned)b) << 16); }
__device__ __forceinline__ float bflo(unsigned w) { return __uint_as_float(w << 16); }
__device__ __forceinline__ float bfhi(unsigned w) { return __uint_as_float(w & 0xffff0000u); }
__device__ __forceinline__ unsigned short f2bf(float f) { return (unsigned short)(cvtpk(f, 0.f) & 0xffffu); }
__device__ __forceinline__ unsigned pk4_fp8(float a, float b, float c, float d) {
    a = __builtin_amdgcn_fmed3f(a, -448.f, 448.f); b = __builtin_amdgcn_fmed3f(b, -448.f, 448.f); c = __builtin_amdgcn_fmed3f(c, -448.f, 448.f); d = __builtin_amdgcn_fmed3f(d, -448.f, 448.f);
    unsigned w = 0; w = __builtin_amdgcn_cvt_pk_fp8_f32(a, b, w, false); w = __builtin_amdgcn_cvt_pk_fp8_f32(c, d, w, true); return w;
}
__device__ __forceinline__ int tid_fresh(int wave_s) { int l; asm volatile("v_mbcnt_lo_u32_b32 %0, -1, 0\n\tv_mbcnt_hi_u32_b32 %0, -1, %0" : "=v"(l)); return wave_s * 64 + l; }
template <int CTRL, int BANK> __device__ __forceinline__ int dpp_i(int old, int x) { return __builtin_amdgcn_update_dpp(old, x, CTRL, 0xF, BANK, false); }
__device__ __forceinline__ int xs1(int x) { return dpp_i<0xB1, 0xF>(x, x); }
__device__ __forceinline__ int xs2(int x) { return dpp_i<0x4E, 0xF>(x, x); }
__device__ __forceinline__ int xs4(int x) { const int t = dpp_i<0x114, 0xA>(x, x); return dpp_i<0x104, 0x5>(t, x); }
__device__ __forceinline__ int xs8(int x) { return dpp_i<0x128, 0xF>(x, x); }
__device__ __forceinline__ float xf1(float x) { return __int_as_float(xs1(__float_as_int(x))); }
__device__ __forceinline__ float xf2(float x) { return __int_as_float(xs2(__float_as_int(x))); }
__device__ __forceinline__ float xf4(float x) { return __int_as_float(xs4(__float_as_int(x))); }
__device__ __forceinline__ float xf8(float x) { return __int_as_float(xs8(__float_as_int(x))); }
__device__ __forceinline__ float sum16(float a, float b) { auto r = __builtin_amdgcn_permlane16_swap(__float_as_uint(a), __float_as_uint(b), false, false); return __uint_as_float(r[0]) + __uint_as_float(r[1]); }
__device__ __forceinline__ float sum32(float a, float b) { auto r = __builtin_amdgcn_permlane32_swap(__float_as_uint(a), __float_as_uint(b), false, false); return __uint_as_float(r[0]) + __uint_as_float(r[1]); }
__device__ __forceinline__ unsigned xu16(unsigned x, int lane) { auto r = __builtin_amdgcn_permlane16_swap(x, x, false, false); return (lane & 16) ? r[0] : r[1]; }
__device__ __forceinline__ unsigned xu32(unsigned x, int lane) { auto r = __builtin_amdgcn_permlane32_swap(x, x, false, false); return (lane & 32) ? r[0] : r[1]; }
__device__ __forceinline__ unsigned pk4_fp8_nz(float a, float b, float c, float d) { unsigned w = __float_as_uint(a); w = __builtin_amdgcn_cvt_pk_fp8_f32(a, b, w, false); w = __builtin_amdgcn_cvt_pk_fp8_f32(c, d, w, true); return w; }
__device__ __forceinline__ unsigned pk4_fp8_nc(float a, float b, float c, float d) { unsigned w = 0; w = __builtin_amdgcn_cvt_pk_fp8_f32(a, b, w, false); w = __builtin_amdgcn_cvt_pk_fp8_f32(c, d, w, true); return w; }
__device__ __forceinline__ float wave_sum(float v) {
    v += xf1(v); v += xf2(v); v += xf4(v); v += xf8(v); v = sum16(v, v); v = sum32(v, v);
    return v;
}
__device__ __forceinline__ float silu_f(float x) { return x / (1.f + __expf(-x)); }
__device__ __forceinline__ float gelu_tanh_f(float x) {
    const float u = x * (1.5957691216057308f + 0.07135481627260025f * x * x);
    const float e = __builtin_amdgcn_exp2f(-1.4426950408889634f * u);
    return x * __builtin_amdgcn_rcpf(1.f + e);
}
__device__ __forceinline__ f32x4 gelu_tanh_4(f32x4 x) {
    const f32x4 x2 = x * x, u = x * (x2 * (-0.07135481627260025f * 1.4426950408889634f) + (-1.5957691216057308f * 1.4426950408889634f));
    const f32x4 d = (f32x4){__builtin_amdgcn_exp2f(u.x), __builtin_amdgcn_exp2f(u.y), __builtin_amdgcn_exp2f(u.z), __builtin_amdgcn_exp2f(u.w)} + 1.f;
    return x * (f32x4){__builtin_amdgcn_rcpf(d.x), __builtin_amdgcn_rcpf(d.y), __builtin_amdgcn_rcpf(d.z), __builtin_amdgcn_rcpf(d.w)};
}

#define XB_TMO      128
#define XB_XCNT(j)  (256  + 64 * (j))
#define XB_XSUB(j)  (1280 + 64 * (j))
#define XB_XGEN(j)  (2304 + 64 * (j))
#define XB_TOP      3328
#define XB_TOPGEN   3392
#define XCD_BAR_WORDS 3456
#define XB_SPIN_CAP (1u << 20)
__device__ __forceinline__ unsigned xb_ld(unsigned* p)              { return __hip_atomic_load(p, __ATOMIC_RELAXED, __HIP_MEMORY_SCOPE_AGENT); }
__device__ __forceinline__ unsigned xb_add(unsigned* p, unsigned v) { return __hip_atomic_fetch_add(p, v, __ATOMIC_RELAXED, __HIP_MEMORY_SCOPE_AGENT); }
__device__ __forceinline__ unsigned xb_xcc_id() { return (unsigned)__builtin_amdgcn_s_getreg((3 << 11) | 20) & 0xFu; }
#define XB_SPIN(cond, bar) do { unsigned _sp = 0; while (cond) { __builtin_amdgcn_s_sleep(1); \
    if ((++_sp & 255u) == 0u) { if (xb_ld(&(bar)[XB_TMO])) break; if (_sp > XB_SPIN_CAP) { atomicAdd(&(bar)[XB_TMO], 1u); break; } } } } while (0)
struct XcdBarrier { unsigned* bar; unsigned x; volatile LAS unsigned* st; };
__device__ __forceinline__ XcdBarrier xcd_barrier_post(unsigned* bar, volatile LAS unsigned* st, bool t0) {
    XcdBarrier b; b.bar = bar; b.x = xb_xcc_id(); b.st = st;
    if (t0) (void)xb_add(&bar[XB_XCNT(b.x)], 1u);
    return b;
}
__device__ __forceinline__ void xcd_barrier_complete(unsigned* bar, unsigned x, unsigned& nloc, unsigned& nx) {
    const unsigned G = gridDim.x * gridDim.y * gridDim.z;
    unsigned sum, cnt, mine, sp = 0u;
    for (;;) {
        sum = 0u; cnt = 0u; mine = 0u;
#pragma unroll
        for (unsigned j = 0; j < 16; ++j) { const unsigned c = xb_ld(&bar[XB_XCNT(j)]); sum += c; cnt += (c > 0u) ? 1u : 0u; mine = (j == x) ? c : mine; }
        if (sum == G) break;
        __builtin_amdgcn_s_sleep(1);
        if ((++sp & 255u) == 0u) { if (xb_ld(&bar[XB_TMO])) break; if (sp > XB_SPIN_CAP) { atomicAdd(&bar[XB_TMO], 1u); break; } }
    }
    nloc = mine > 0u ? mine : 1u; nx = cnt > 0u ? cnt : 1u;
}
__device__ __forceinline__ void xcd_barrier(const XcdBarrier& b, bool t0) {
    asm volatile("s_waitcnt vmcnt(0)" ::: "memory");
    __syncthreads();
    if (t0) {
        unsigned* bar = b.bar;
        __builtin_amdgcn_s_waitcnt(0);
        unsigned nloc = b.st[0], nx = b.st[1];
        if (nloc == 0u) { xcd_barrier_complete(bar, b.x, nloc, nx); b.st[0] = nloc; b.st[1] = nx; }
        const unsigned old = xb_add(&bar[XB_XSUB(b.x)], 1u);
        const unsigned gen = old / nloc;
        if (old + 1u == (gen + 1u) * nloc) {
            __builtin_amdgcn_fence(__ATOMIC_RELEASE, "agent");
            asm volatile("s_waitcnt vmcnt(0)" ::: "memory");
            const unsigned og = xb_add(&bar[XB_TOP], 1u);
            const unsigned tg = og / nx;
            if (og + 1u == (tg + 1u) * nx) xb_add(&bar[XB_TOPGEN], 1u);
            else XB_SPIN(xb_ld(&bar[XB_TOPGEN]) == tg, bar);
            __builtin_amdgcn_fence(__ATOMIC_ACQUIRE, "agent");
            xb_add(&bar[XB_XGEN(b.x)], 1u);
            asm volatile("s_waitcnt vmcnt(0)" ::: "memory");
        } else {
            XB_SPIN(xb_ld(&bar[XB_XGEN(b.x)]) == gen, bar);
            __builtin_amdgcn_fence(__ATOMIC_ACQUIRE, "agent");
            asm volatile("s_waitcnt vmcnt(0)" ::: "memory");
        }
    }
    __syncthreads();
}

struct Args { const float* in[28]; float* out; uchar* ws; int ph_lo, ph_hi, dry, pad; };
enum { I_X = 0, I_C, I_CTX, I_CCTX, I_ADAW, I_ADAB, I_NMIXG, I_NFFNG, I_ABWIN, I_SGUNG, I_SGUW, I_SGUB, I_GQG, I_GKG, I_ABWOUT, I_MLAWIN, I_MLAQG, I_MLAKVG, I_MLAWUQ, I_MLAWUKV, I_MLAWOUT,
       I_RW, I_RB, I_W1, I_B1, I_W2, I_B2, I_FNG };
struct Frame {
    LAS uchar* lds; int tid, lane, wave, G, bid;
    uchar* ws; float* out;
};
__device__ __forceinline__ const float* INP(int i) {
    const __attribute__((address_space(4))) char* ka = (const __attribute__((address_space(4))) char*)__builtin_amdgcn_kernarg_segment_ptr();
    return *(const float* const volatile __attribute__((address_space(4)))*)(ka + i * 8);
}

namespace pg8 {
constexpr int BM = 256, BK = 64, HALF = 128, HTB = HALF * BK * 2, NXCD = 8, WGM = 8;
__device__ __forceinline__ int lds_byte(int r, int c) { const int st = (r >> 4) * 2 + (c >> 5), rr = r & 15, cc = c & 31, ob = rr * 64 + cc * 2; return st * 1024 + (ob ^ (((ob >> 9) & 1) << 5)); }
__device__ __forceinline__ void stage_rc(int b, int& R, int& C) { const int st = b / 1024, sb = b % 1024, swz = sb ^ (((sb >> 9) & 1) << 5); R = (st >> 1) * 16 + swz / 64; C = (st & 1) * 32 + (swz % 64) / 2; }
__device__ __forceinline__ int perm32(int rho) { const int n = rho >> 4, i = rho & 15; return 8 * (i >> 2) + 4 * n + (i & 3); }
struct Unit { int pm, pn, e, rb; };
struct StaticOrder {
    int nM, nN, nwg;
    __device__ void init(int nM_, int nN_) { nM = nM_; nN = nN_; nwg = nM * nN; }
    __device__ bool map(long L, int& pm, int& pn) const {
        if (L >= nwg) return false;
        int wgid = (int)L; { const int q = nwg / NXCD, r = nwg % NXCD, xcd = wgid % NXCD, off = wgid / NXCD; wgid = (xcd < r ? xcd * (q + 1) : r * (q + 1) + (xcd - r) * q) + off; }
        const int nig = WGM * nN, gid = wgid / nig, fm = gid * WGM, gsz = (nM - fm) < WGM ? (nM - fm) : WGM;
        pm = fm + ((wgid % nig) % gsz); pn = (wgid % nig) / gsz; return true;
    }
};
typedef f32x4 Acc[2][2][4][2];
template <class P>
__device__ __forceinline__ void gemm_phase(LAS uchar* lds, const P& p, int wave_s) {
    const int tid = tid_fresh(wave_s), wid = __builtin_amdgcn_readfirstlane(tid >> 6), lane = tid & 63, wr = wid >> 2, wc = wid & 3, fr = lane & 15, fq = lane >> 4;
    const int K = P::KCONST ? P::KCONST : p.K, nt = K / BK;
    unsigned voffA[2][2], voffB[2];
#pragma unroll
    for (int i = 0; i < 2; ++i) { int R, C; stage_rc(tid * 16 + i * 8192, R, C); const int Rb = P::P16 ? (64 * (R >> 5) + 16 * ((R & 15) >> 2) + 4 * ((R >> 4) & 1) + (R & 3)) : P::PERM ? ((R & ~31) + perm32(R & 31)) : R;
        voffA[0][i] = (unsigned)(R * p.lda + C) * 2u; voffA[1][i] = voffA[0][i]; voffB[i] = (unsigned)(Rb * K + C) * 2u; }
    const unsigned kstep = (unsigned)(BK * 2);
    const unsigned hstepB = (unsigned)(P::P16 ? 8 : HALF) * K * 2;
    const unsigned hstepA = P::GATHER ? 0u : (unsigned)HALF * p.lda * 2;
#define PG8_VA1 voffA[P::GATHER ? 1 : 0]
    const __amdgpu_buffer_rsrc_t rsA = __builtin_amdgcn_make_buffer_rsrc((void*)p.a_mat(), 0, 0xffffffffu, 0x00020000);
    const __amdgpu_buffer_rsrc_t rsB = __builtin_amdgcn_make_buffer_rsrc((void*)p.b_mat(), 0, 0xffffffffu, 0x00020000);
    const char* gpA = (const char*)p.a_mat(); const char* gpB = (const char*)p.b_mat(); (void)gpA; (void)gpB; (void)rsA; (void)rsB;
    unsigned ldsw = (unsigned)wid * 1024u;
    const int aoff = lds_byte(wr * 64 + fr, fq * 8), boff = lds_byte(wc * 32 + fr, fq * 8);
#define PG8_SA(b, h) (((b) * 2 + (h)) * HTB)
#define PG8_SB(b, h) ((4 + (b) * 2 + (h)) * HTB)
#if USE_BUFFER_LDS
#define PG8_STAGE_R(bufoff, rs, gp, soff, voff) do { _Pragma("unroll") for (int _i = 0; _i < 2; ++_i) \
        __builtin_amdgcn_raw_ptr_buffer_load_lds(rs, (LAS unsigned*)(lds + (bufoff) + ldsw + _i * 8192), 16, (int)(voff)[_i], (int)(soff), 0, 0); } while (0)
#else
#define PG8_STAGE_R(bufoff, rs, gp, soff, voff) do { _Pragma("unroll") for (int _i = 0; _i < 2; ++_i) \
        __builtin_amdgcn_global_load_lds((const unsigned*)((const char*)(gp) + (size_t)(soff) + (voff)[_i]), (LAS unsigned*)(lds + (bufoff) + ldsw + _i * 8192), 16, 0, 0); } while (0)
#endif
#define PG8_STAGE_A(bufoff, soff, voff) PG8_STAGE_R(bufoff, rsA, gpA, soff, voff)
#define PG8_STAGE_B(bufoff, soff, voff) PG8_STAGE_R(bufoff, rsB, gpB, soff, voff)
#define PG8_LDA(dst, b, h) do { _Pragma("unroll") for (int m = 0; m < 4; ++m) _Pragma("unroll") for (int k = 0; k < 2; ++k) dst[m][k] = *(const LAS i32x4*)(lds + PG8_SA(b, h) + aoff + m * 2048 + k * 1024); } while (0)
#define PG8_LDB(dst, b, h) do { _Pragma("unroll") for (int n = 0; n < 2; ++n) _Pragma("unroll") for (int k = 0; k < 2; ++k) dst[n][k] = *(const LAS i32x4*)(lds + PG8_SB(b, h) + boff + n * 2048 + k * 1024); } while (0)
#define PG8_CAT(x) __builtin_shufflevector((x)[0], (x)[1], 0, 1, 2, 3, 4, 5, 6, 7)
#define PG8_MMA(ai, bj, At, Bt) do { __builtin_amdgcn_s_setprio(1); \
        if constexpr (P::FP8) { _Pragma("unroll") for (int m = 0; m < 4; ++m) _Pragma("unroll") for (int n = 0; n < 2; ++n) \
            acc[ai][bj][m][n] = __builtin_amdgcn_mfma_scale_f32_16x16x128_f8f6f4(PG8_CAT(Bt[n]), PG8_CAT(At[m]), acc[ai][bj][m][n], 0, 0, 0, 0x7F7F7F7F, 0, 0x7F7F7F7F); } \
        else { _Pragma("unroll") for (int m = 0; m < 4; ++m) _Pragma("unroll") for (int n = 0; n < 2; ++n) _Pragma("unroll") for (int k = 0; k < 2; ++k) \
            acc[ai][bj][m][n] = __builtin_amdgcn_mfma_f32_16x16x32_bf16(__builtin_bit_cast(bf16x8, Bt[n][k]), __builtin_bit_cast(bf16x8, At[m][k]), acc[ai][bj][m][n], 0, 0, 0); } \
        __builtin_amdgcn_s_setprio(0); } while (0)
#define PG8_WAIT_V(n) asm volatile("s_waitcnt vmcnt(" #n ")" ::: "memory")
#define PG8_WAIT_L(n) asm volatile("s_waitcnt lgkmcnt(" #n ")" ::: "memory")
#define PG8_BAR __builtin_amdgcn_s_barrier()
#define PG8_SCHED __builtin_amdgcn_sched_barrier(0)
    Unit cur, nxt; int ui = 0;
    if (!p.next(0, cur)) return;
    Acc acc;
#pragma unroll
    for (int a = 0; a < 2; ++a)
#pragma unroll
        for (int b = 0; b < 2; ++b)
#pragma unroll
            for (int m = 0; m < 4; ++m)
#pragma unroll
                for (int n = 0; n < 2; ++n) acc[a][b][m][n] = (f32x4){0.f, 0.f, 0.f, 0.f};
    i32x4 At[4][2], B0[2][2], B1[2][2];
    unsigned cA = p.a_off(cur), cB = p.b_off(cur);
    if constexpr (P::GATHER) { p.a_voff(cur, voffA); }
    PG8_STAGE_B(PG8_SB(0, 0), cB, voffB); PG8_STAGE_B(PG8_SB(0, 1), cB + hstepB, voffB); PG8_STAGE_A(PG8_SA(0, 0), cA, voffA[0]); PG8_STAGE_A(PG8_SA(0, 1), cA + hstepA, PG8_VA1);
    if (wr == 1) PG8_BAR;
    PG8_WAIT_V(2); PG8_BAR;
    PG8_STAGE_B(PG8_SB(1, 0), cB + kstep, voffB); PG8_STAGE_A(PG8_SA(1, 0), cA + kstep, voffA[0]); PG8_STAGE_B(PG8_SB(1, 1), cB + hstepB + kstep, voffB);
    PG8_WAIT_V(6); PG8_BAR;
    for (;;) {
        const bool has_next = p.next(ui + 1, nxt);
        if constexpr (P::MOE) p.unit_top(cur, nxt, has_next, wid, ui);
        const unsigned nA = has_next ? p.a_off(nxt) : cA, nB = has_next ? p.b_off(nxt) : cB;
#pragma unroll 1
        for (int t = 0; t < nt; t += 2) {
            const bool last = (t == nt - 2);
            asm volatile("" : "+s"(ldsw));
            const unsigned a1 = cA + (unsigned)(t + 1) * kstep;
            const unsigned a2 = last ? nA : cA + (unsigned)(t + 2) * kstep, b2 = last ? nB : cB + (unsigned)(t + 2) * kstep;
            const unsigned a3 = a2 + kstep, b3 = b2 + kstep;
            PG8_LDB(B0, 0, 0); PG8_LDB(B1, 0, 1); PG8_SCHED; PG8_LDA(At, 0, 0); PG8_STAGE_A(PG8_SA(1, 1), a1 + hstepA, PG8_VA1);
            if constexpr (P::GATHER) { if (last && has_next) p.a_voff_next(nxt, voffA); }
            PG8_WAIT_V(8); PG8_WAIT_L(0); PG8_BAR; PG8_MMA(0, 0, At, B0); PG8_MMA(0, 1, At, B1); PG8_BAR; PG8_SCHED;
            PG8_LDA(At, 0, 1); PG8_STAGE_B(PG8_SB(0, 0), b2, voffB); PG8_STAGE_B(PG8_SB(0, 1), b2 + hstepB, voffB); PG8_STAGE_A(PG8_SA(0, 0), a2, voffA[0]);
            PG8_WAIT_V(8); PG8_WAIT_L(0); PG8_BAR; PG8_MMA(1, 0, At, B0); PG8_MMA(1, 1, At, B1); PG8_BAR; PG8_SCHED;
            PG8_LDB(B0, 1, 0); PG8_LDB(B1, 1, 1); PG8_SCHED; PG8_LDA(At, 1, 0); PG8_STAGE_A(PG8_SA(0, 1), a2 + hstepA, PG8_VA1);
            PG8_WAIT_V(8); PG8_WAIT_L(0); PG8_BAR; PG8_MMA(0, 0, At, B0); PG8_MMA(0, 1, At, B1); PG8_BAR; PG8_SCHED;
            PG8_LDA(At, 1, 1); PG8_STAGE_B(PG8_SB(1, 0), b3, voffB); PG8_STAGE_B(PG8_SB(1, 1), b3 + hstepB, voffB); PG8_STAGE_A(PG8_SA(1, 0), a3, voffA[0]);
            PG8_WAIT_V(8); PG8_WAIT_L(0); PG8_BAR; PG8_MMA(1, 0, At, B0); PG8_MMA(1, 1, At, B1); PG8_BAR; PG8_SCHED;
        }
        if (GEMM_ALIGN_EPI && wr == 0) PG8_BAR;
        if constexpr (P::MOE) {
            if constexpr (P::GATHER) {
                if (L2PF != 0 && L2PF1 != 0 && IDX_LDS != 0 && has_next) { const int ln = tid_fresh(p.wave_s) & 63; const int n = p.cnt[nxt.e]; const volatile LAS int* il = (const volatile LAS int*)p.stage;
#pragma unroll
                    for (int r = 0; r < 4; ++r) { const int ri = nxt.pn * 32 + wid * 4 + r; const int tk = il[ri]; const unsigned tok = (nxt.rb * 256 + ri < n) ? (unsigned)tk : 0u;
                        __builtin_amdgcn_raw_ptr_buffer_load_lds(rsA, (LAS unsigned*)(p.stage + 3072 + wid * 1024), 16, (int)(tok * 1024u + (unsigned)ln * 16u), 0, 0, 0); } }
            } else p.epi_prefetch(nxt, has_next, wid);
            p.epi(acc, cur, wr, wc, fr, fq, ui); } else p.epi(acc, cur, wr, wc, fr, fq);
        if (!has_next) break;
#pragma unroll
        for (int a = 0; a < 2; ++a)
#pragma unroll
            for (int b = 0; b < 2; ++b)
#pragma unroll
                for (int m = 0; m < 4; ++m)
#pragma unroll
                    for (int n = 0; n < 2; ++n) acc[a][b][m][n] = (f32x4){0.f, 0.f, 0.f, 0.f};
        cur = nxt; cA = nA; cB = nB; ++ui;
        if (GEMM_ALIGN_EPI && wr == 1) PG8_BAR;
    }
    PG8_WAIT_V(0);
    if (!GEMM_ALIGN_EPI && wr == 0) PG8_BAR;
    PG8_BAR;
#undef PG8_SA
#undef PG8_VA1
#undef PG8_SB
#undef PG8_STAGE_R
#undef PG8_STAGE_A
#undef PG8_STAGE_B
#undef PG8_LDA
#undef PG8_LDB
#undef PG8_MMA
#undef PG8_CAT
#undef PG8_WAIT_V
#undef PG8_WAIT_L
#undef PG8_BAR
#undef PG8_SCHED
}

template <bool GELU>
__device__ __forceinline__ void epi_store_bf16(const Acc& acc, bf16_t* dst  , int ldc, const float* bias  , int wr, int wc, int fr, int fq, float sc = 1.f) {
    const int row0 = wr * 64 + fr, col0 = wc * 32 + 8 * fq;
    f32x4 bv[2][2];
#pragma unroll
    for (int bj = 0; bj < 2; ++bj)
#pragma unroll
        for (int n = 0; n < 2; ++n) bv[bj][n] = bias ? *(const f32x4*)(bias + col0 + bj * HALF + 4 * n) : (f32x4){0.f, 0.f, 0.f, 0.f};
    const unsigned lane_off = (unsigned)(row0 * ldc + col0) * 2u;
#pragma unroll
    for (int ai = 0; ai < 2; ++ai)
#pragma unroll
        for (int m = 0; m < 4; ++m) { char* rowb = (char*)dst + (size_t)((ai * HALF + m * 16) * ldc) * 2;
#pragma unroll
            for (int bj = 0; bj < 2; ++bj) { f32x4 v0 = acc[ai][bj][m][0] * sc + bv[bj][0], v1 = acc[ai][bj][m][1] * sc + bv[bj][1];
                if (GELU) { v0 = gelu_tanh_4(v0); v1 = gelu_tanh_4(v1); }
                u32x4 w; w.x = cvtpk(v0[0], v0[1]); w.y = cvtpk(v0[2], v0[3]); w.z = cvtpk(v1[0], v1[1]); w.w = cvtpk(v1[2], v1[3]);
                *(u32x4*)(rowb + lane_off + bj * HALF * 2) = w; } }
}
template <bool P16v = false>
__device__ __forceinline__ void epi_store_fp8(const Acc& acc, unsigned char* dst  , int ldc, int wr, int wc, int fr, int fq, float sc) {
    const int row0 = wr * 64 + fr, col0 = P16v ? wc * 64 + 16 * fq : wc * 32 + 8 * fq; const unsigned lane_off = (unsigned)(row0 * ldc + col0);
#pragma unroll
    for (int ai = 0; ai < 2; ++ai)
#pragma unroll
        for (int m = 0; m < 4; ++m) { unsigned char* rowb = dst + (size_t)((ai * HALF + m * 16) * ldc);
            if constexpr (P16v) { u32x4 w;
#pragma unroll
                for (int bj = 0; bj < 2; ++bj) { const f32x4 v0 = acc[ai][bj][m][0] * sc, v1 = acc[ai][bj][m][1] * sc;
                    w[2 * bj] = pk4_fp8(v0[0], v0[1], v0[2], v0[3]); w[2 * bj + 1] = pk4_fp8(v1[0], v1[1], v1[2], v1[3]); }
                *(u32x4*)(rowb + lane_off) = w; }
            else {
#pragma unroll
            for (int bj = 0; bj < 2; ++bj) { const f32x4 v0 = acc[ai][bj][m][0] * sc, v1 = acc[ai][bj][m][1] * sc;
                u32x2 w; w.x = pk4_fp8(v0[0], v0[1], v0[2], v0[3]); w.y = pk4_fp8(v1[0], v1[1], v1[2], v1[3]);
                *(u32x2*)(rowb + lane_off + bj * HALF) = w; } } }
}
}

namespace att {
constexpr int NW = 8, QBLK = 32, KVBLK = 64;
constexpr int SHM_V = KVBLK * 128 * 2;
constexpr float THR = 8.f;
__device__ __forceinline__ int crow(int r, int hi) { return (r & 3) + 8 * (r >> 2) + 4 * hi; }
template <int DQK> struct Cfg { static constexpr float SCALE = (DQK == 128) ? 0.088388347648318440f : 0.072168783648703220f; static constexpr int KP = DQK * 2, SHM_K = KVBLK * DQK * 2, ND = DQK / 16; };
#define KSWZ(PITCH, row, colB) ((row) * (PITCH) + ((colB) ^ (((row) & 7) << 4)))
template <int DQK, int QS = 1, int THRI = 8> __device__ __forceinline__ void partialSM(f32x16& p0, f32x16& p1, float& m_reg, float& mn, float& alpha) {
    constexpr float SCALE = Cfg<DQK>::SCALE / (float)QS, C = SCALE * 1.4426950408889634f;
    float pmax = p0[0];
#pragma unroll
    for (int r = 1; r < 16; ++r) pmax = fmaxf(pmax, p0[r]);
#pragma unroll
    for (int r = 0; r < 16; ++r) pmax = fmaxf(pmax, p1[r]);
    { auto rr = __builtin_amdgcn_permlane32_swap(__float_as_uint(pmax), __float_as_uint(pmax), false, false);
      pmax = fmaxf(__uint_as_float(rr[0]), __uint_as_float(rr[1])); }
    if (__builtin_expect(__all(pmax - m_reg <= (float)THRI / SCALE), 1)) { mn = m_reg; alpha = 1.f; }
    else { mn = fmaxf(m_reg, pmax); alpha = __builtin_amdgcn_exp2f((m_reg - mn) * C); m_reg = mn; }
    const float mnC = -mn * C;
#pragma unroll
    for (int r = 0; r < 16; ++r) p0[r] = fmaf(p0[r], C, mnC);
#pragma unroll
    for (int r = 0; r < 16; ++r) p1[r] = fmaf(p1[r], C, mnC);
#pragma unroll
    for (int r = 0; r < 16; ++r) p0[r] = __builtin_amdgcn_exp2f(p0[r]);
}
__device__ __forceinline__ void finishSM(f32x16& p0, f32x16& p1, float alpha, float& l_reg, bf16x8& pa0, bf16x8& pa1, bf16x8& pa2, bf16x8& pa3) {
#pragma unroll
    for (int r = 0; r < 16; ++r) p1[r] = __builtin_amdgcn_exp2f(p1[r]);
    float ps = 0;
#pragma unroll
    for (int r = 0; r < 16; ++r) ps += p0[r];
#pragma unroll
    for (int r = 0; r < 16; ++r) ps += p1[r];
    { auto rr = __builtin_amdgcn_permlane32_swap(__float_as_uint(ps), __float_as_uint(ps), false, false);
      ps = __uint_as_float(rr[0]) + __uint_as_float(rr[1]); }
    l_reg = l_reg * alpha + ps;
#define PK4(P, BASE, OUT) do { unsigned a0 = cvtpk(P[BASE + 0], P[BASE + 1]), a1 = cvtpk(P[BASE + 2], P[BASE + 3]);   \
    unsigned b0 = cvtpk(P[BASE + 4], P[BASE + 5]), b1 = cvtpk(P[BASE + 6], P[BASE + 7]);                              \
    auto r0 = __builtin_amdgcn_permlane32_swap(a0, b0, false, false); auto r1 = __builtin_amdgcn_permlane32_swap(a1, b1, false, false); \
    u32x4 w = {r0[0], r1[0], r0[1], r1[1]}; OUT = *reinterpret_cast<bf16x8*>(&w); } while (0)
    PK4(p0, 0, pa0); PK4(p0, 8, pa1); PK4(p1, 0, pa2); PK4(p1, 8, pa3);
#undef PK4
}
template <int DQK> __device__ __forceinline__ void qkt(f32x16& p0, f32x16& p1, const LAS char* Ks, const bf16x8* qr, int r32, int hi) {
    constexpr int KP = Cfg<DQK>::KP, ND = Cfg<DQK>::ND;
    p0 = f32x16{}; p1 = f32x16{};
#pragma unroll
    for (int d0 = 0; d0 < ND; ++d0) { const int cb = (d0 * 16 + hi * 8) * 2;
        bf16x8 b0 = *reinterpret_cast<const LAS bf16x8*>(Ks + KSWZ(KP, r32, cb));
        bf16x8 b1 = *reinterpret_cast<const LAS bf16x8*>(Ks + KSWZ(KP, 32 + r32, cb));
        p0 = __builtin_amdgcn_mfma_f32_32x32x16_bf16(b0, qr[d0], p0, 0, 0, 0);
        p1 = __builtin_amdgcn_mfma_f32_32x32x16_bf16(b1, qr[d0], p1, 0, 0, 0); }
}
__device__ __forceinline__ int v_st(int k, int c) { const int kk = (k & ~0xC) | ((k & 4) << 1) | ((k & 8) >> 1); return ((kk >> 3) * 4 + (c >> 5)) * 512 + ((kk & 7) * 32 + (c & 31)) * 2; }
__device__ __forceinline__ int v_rd_base(int lane) { return ((lane & 3) << 3) | (((lane >> 2) & 3) << 6) | (((lane >> 4) & 1) << 5) | (((lane >> 5) & 1) << 8); }
constexpr int v_rd_off(int d0, int ks, int half) { return d0 * 512 + ks * 4096 + half * 2048; }
template <int OFF> __device__ __forceinline__ s16x4 tr_read(int vb) {
    s16x4 r; asm volatile("ds_read_b64_tr_b16 %0, %1 offset:%2" : "=&v"(r) : "v"(vb), "i"(OFF) : "memory"); return r;
}
template <int D0, bool TR = false> __device__ __forceinline__ void pv_one(f32x16& od, int vb, bf16x8 pa0, bf16x8 pa1, bf16x8 pa2, bf16x8 pa3) {
    const s16x4 l0 = tr_read<v_rd_off(D0, 0, 0)>(vb), h0 = tr_read<v_rd_off(D0, 0, 1)>(vb), l1 = tr_read<v_rd_off(D0, 1, 0)>(vb), h1 = tr_read<v_rd_off(D0, 1, 1)>(vb);
    const s16x4 l2 = tr_read<v_rd_off(D0, 2, 0)>(vb), h2 = tr_read<v_rd_off(D0, 2, 1)>(vb), l3 = tr_read<v_rd_off(D0, 3, 0)>(vb), h3 = tr_read<v_rd_off(D0, 3, 1)>(vb);
    asm volatile("s_waitcnt lgkmcnt(0)" ::: "memory"); SBAR();
#define PK(L, H) (bf16x8){L[0], L[1], L[2], L[3], H[0], H[1], H[2], H[3]}
    if constexpr (TR) {
    od = __builtin_amdgcn_mfma_f32_32x32x16_bf16(PK(l0, h0), pa0, od, 0, 0, 0);
    od = __builtin_amdgcn_mfma_f32_32x32x16_bf16(PK(l1, h1), pa1, od, 0, 0, 0);
    od = __builtin_amdgcn_mfma_f32_32x32x16_bf16(PK(l2, h2), pa2, od, 0, 0, 0);
    od = __builtin_amdgcn_mfma_f32_32x32x16_bf16(PK(l3, h3), pa3, od, 0, 0, 0);
    } else {
    od = __builtin_amdgcn_mfma_f32_32x32x16_bf16(pa0, PK(l0, h0), od, 0, 0, 0);
    od = __builtin_amdgcn_mfma_f32_32x32x16_bf16(pa1, PK(l1, h1), od, 0, 0, 0);
    od = __builtin_amdgcn_mfma_f32_32x32x16_bf16(pa2, PK(l2, h2), od, 0, 0, 0);
    od = __builtin_amdgcn_mfma_f32_32x32x16_bf16(pa3, PK(l3, h3), od, 0, 0, 0);
    }
#undef PK
}
template <bool TR = false> __device__ __forceinline__ void pv_d0(f32x16* o, int vb, bf16x8 pa0, bf16x8 pa1, bf16x8 pa2, bf16x8 pa3) {
    pv_one<0, TR>(o[0], vb, pa0, pa1, pa2, pa3); pv_one<1, TR>(o[1], vb, pa0, pa1, pa2, pa3); pv_one<2, TR>(o[2], vb, pa0, pa1, pa2, pa3); pv_one<3, TR>(o[3], vb, pa0, pa1, pa2, pa3);
}
__device__ __forceinline__ bf16x8 ld8(const bf16_t* p) { return *reinterpret_cast<const bf16x8*>(p); }
__device__ __forceinline__ void rope_frag(bf16x8& a, bf16x8& b, const f32x2* tab) {
    u32x4 wa = *reinterpret_cast<u32x4*>(&a), wb = *reinterpret_cast<u32x4*>(&b), oa, ob;
#pragma unroll
    for (int q = 0; q < 4; ++q) {
        const float x1l = bflo(wa[q]), x1h = bfhi(wa[q]), x2l = bflo(wb[q]), x2h = bfhi(wb[q]);
        const f32x2 t0 = tab[2 * q], t1 = tab[2 * q + 1];
        oa[q] = cvtpk(x1l * t0.x - x2l * t0.y, x1h * t1.x - x2h * t1.y);
        ob[q] = cvtpk(x2l * t0.x + x1l * t0.y, x2h * t1.x + x1h * t1.y);
    }
    a = *reinterpret_cast<bf16x8*>(&oa); b = *reinterpret_cast<bf16x8*>(&ob);
}
template <int DQK, int SDEPTH, bool MLA, int ldq, int ldkv, int ldo, bool OUT8 = false>
__device__ __forceinline__ void attn_unit(const bf16_t* __restrict__ Qb, const bf16_t* __restrict__ Kh, const bf16_t* __restrict__ KRh, const bf16_t* __restrict__ Vh,
                                          bf16_t* __restrict__ Ob, int seq, LAS char* lds, const f32x2* __restrict__ tabm, int qt0, int wave_s) {
    constexpr int KP = Cfg<DQK>::KP, SHM_K = Cfg<DQK>::SHM_K, ND = Cfg<DQK>::ND;
    const int tid = tid_fresh(wave_s), wid = tid >> 6, lane = tid & 63, r32 = lane & 31, hi = lane >> 5;
    LAS char* V_lds = lds; LAS char* K_lds = lds + 2 * SHM_V;
    LAS float* wsl = (LAS float*)(lds + 2 * SHM_V + 2 * SHM_K) + wid * 64; LAS float* li_l = wsl; LAS float* al_l = wsl + 32;
    float m_reg = -1e30f, l_reg = 0; f32x16 o[4] = {}; bf16x8 qr[ND];
    const bf16_t* Qw = Qb + (long)(wid * QBLK + r32) * ldq + hi * 8;
#pragma unroll
    for (int d0 = 0; d0 < ND; ++d0) qr[d0] = ld8(Qw + d0 * 16);
    if constexpr (MLA) {
        const int t = qt0 + wid * QBLK + r32, prow = t >> 6, pcol = t & 63;
        rope_frag(qr[8], qr[9], tabm + prow * 16 + hi * 8);
        rope_frag(qr[10], qr[11], tabm + pcol * 16 + hi * 8);
    }
    const int sr = tid >> 4, sc = (tid & 15) * 8, vst0 = v_st(sr, sc), vst1 = v_st(32 + sr, sc);
    const int krr = tid >> 3, krc = (tid & 7) * 8;
    const int vb0 = (int)(unsigned)(uintptr_t)V_lds + v_rd_base(lane);
    struct { bf16x8 vs0, vs1, ks0, ks1, kr; } sr_[SDEPTH];
#define SLOAD(i, k0) do { sr_[i].vs0 = ld8(&Vh[(long)((k0) + sr) * ldkv + sc]); sr_[i].vs1 = ld8(&Vh[(long)((k0) + 32 + sr) * ldkv + sc]); \
    sr_[i].ks0 = ld8(&Kh[(long)((k0) + sr) * ldkv + sc]); sr_[i].ks1 = ld8(&Kh[(long)((k0) + 32 + sr) * ldkv + sc]); \
    if constexpr (MLA) sr_[i].kr = ld8(&KRh[(long)((k0) + krr) * 64 + krc]); } while (0)
#define SWRITE(b, i) do { *(LAS bf16x8*)(V_lds + (b) * SHM_V + vst0) = sr_[i].vs0;          \
    *(LAS bf16x8*)(V_lds + (b) * SHM_V + vst1) = sr_[i].vs1; const int kc = sc * 2;               \
    *(LAS bf16x8*)(K_lds + (b) * SHM_K + KSWZ(KP, sr, kc)) = sr_[i].ks0;                       \
    *(LAS bf16x8*)(K_lds + (b) * SHM_K + KSWZ(KP, 32 + sr, kc)) = sr_[i].ks1;                  \
    if constexpr (MLA) *(LAS bf16x8*)(K_lds + (b) * SHM_K + KSWZ(KP, krr, 256 + krc * 2)) = sr_[i].kr; } while (0)
#define SWAIT() do { if constexpr (SDEPTH == 2) { if constexpr (MLA) asm volatile("s_waitcnt vmcnt(5)" ::: "memory"); else asm volatile("s_waitcnt vmcnt(4)" ::: "memory"); } else asm volatile("s_waitcnt vmcnt(0)" ::: "memory"); } while (0)
#define RESC(a) do { if (__any((a) < 1.f)) { if (hi == 0) al_l[r32] = (a); asm volatile("s_waitcnt lgkmcnt(0)" ::: "memory"); \
    _Pragma("unroll") for (int d = 0; d < 4; ++d) _Pragma("unroll") for (int r = 0; r < 16; ++r) o[d][r] *= al_l[crow(r, hi)]; } } while (0)
    bf16x8 pa0, pa1, pa2, pa3; const int NT = seq / KVBLK;
    if constexpr (MLA) {
        f32x16 p0, p1; float mn, al;
        SLOAD(0, 0); asm volatile("s_waitcnt vmcnt(0)" ::: "memory"); SWRITE(0, 0); SLOAD(0, KVBLK); __syncthreads();
        for (int j = 0; j < NT; ++j) {
            const int cb = j & 1;
            if (j + 1 < NT) { asm volatile("s_waitcnt vmcnt(0)" ::: "memory"); SWRITE(cb ^ 1, 0); if (j + 2 < NT) SLOAD(0, (j + 2) * KVBLK); }
            SBAR(); qkt<DQK>(p0, p1, K_lds + cb * SHM_K, qr, r32, hi);
            partialSM<DQK>(p0, p1, m_reg, mn, al); RESC(al);
            finishSM(p0, p1, al, l_reg, pa0, pa1, pa2, pa3); SBAR();
            pv_d0(o, vb0 + cb * SHM_V, pa0, pa1, pa2, pa3);
            __syncthreads();
        }
    } else {
    f32x16 pA0, pA1, pB0, pB1; float mnA, mnB, alA, alB;
    constexpr int SE = 0, SO = SDEPTH - 1;
    SLOAD(SE, 0); asm volatile("s_waitcnt vmcnt(0)" ::: "memory"); SWRITE(0, SE); __syncthreads();
    qkt<DQK>(pA0, pA1, K_lds, qr, r32, hi); partialSM<DQK>(pA0, pA1, m_reg, mnA, alA);
    SLOAD(SO, KVBLK); if constexpr (SDEPTH == 2) { if (2 < NT) SLOAD(SE, 2 * KVBLK); }
    SWAIT(); SWRITE(1, SO); __syncthreads();
    for (int j = 1; j + 1 < NT; j += 2) {
        SBAR(); qkt<DQK>(pB0, pB1, K_lds + SHM_K, qr, r32, hi);
        finishSM(pA0, pA1, alA, l_reg, pa0, pa1, pa2, pa3); SBAR();
        SLOAD(SO, (j + SDEPTH) * KVBLK); SBAR();
        pv_d0(o, vb0, pa0, pa1, pa2, pa3); partialSM<DQK>(pB0, pB1, m_reg, mnB, alB);
        __syncthreads(); SWAIT(); SWRITE(0, SE);
        RESC(alB); __syncthreads();
        SBAR(); qkt<DQK>(pA0, pA1, K_lds, qr, r32, hi);
        finishSM(pB0, pB1, alB, l_reg, pa0, pa1, pa2, pa3); SBAR();
        if (SDEPTH == 1 || j + 3 < NT) SLOAD(SE, (j + 1 + SDEPTH) * KVBLK); SBAR();
        pv_d0(o, vb0 + SHM_V, pa0, pa1, pa2, pa3); partialSM<DQK>(pA0, pA1, m_reg, mnA, alA);
        __syncthreads(); SWAIT(); SWRITE(1, SO);
        RESC(alA); __syncthreads();
    }
    SBAR(); qkt<DQK>(pB0, pB1, K_lds + SHM_K, qr, r32, hi);
    finishSM(pA0, pA1, alA, l_reg, pa0, pa1, pa2, pa3); SBAR();
    pv_d0(o, vb0, pa0, pa1, pa2, pa3); partialSM<DQK>(pB0, pB1, m_reg, mnB, alB);
    __syncthreads(); RESC(alB);
    finishSM(pB0, pB1, alB, l_reg, pa0, pa1, pa2, pa3); SBAR();
    pv_d0(o, vb0 + SHM_V, pa0, pa1, pa2, pa3);
    }
    if (hi == 0) li_l[r32] = l_reg; asm volatile("s_waitcnt lgkmcnt(0)" ::: "memory");
    float rli[16];
#pragma unroll
    for (int r = 0; r < 16; ++r) rli[r] = __builtin_amdgcn_rcpf(li_l[crow(r, hi)]);
    bf16_t* Ow = OUT8 ? (bf16_t*)((unsigned char*)Ob + (long)(wid * QBLK) * ldo) : Ob + (long)(wid * QBLK) * ldo;
#pragma unroll
    for (int r = 0; r < 16; ++r) { const int orow = crow(r, hi);
#pragma unroll
        for (int d0 = 0; d0 < 4; ++d0) { if constexpr (OUT8) ((unsigned char*)Ow)[(long)orow * ldo + d0 * 32 + r32] = (unsigned char)(pk4_fp8(o[d0][r] * rli[r] * 16.f, 0.f, 0.f, 0.f) & 0xffu);
            else Ow[(long)orow * ldo + d0 * 32 + r32] = f2bf(o[d0][r] * rli[r]); } }
    __syncthreads();
#undef SLOAD
#undef SWRITE
#undef SWAIT
#undef RESC
}
template <int KP> __device__ __forceinline__ int kswz8(int row, int byte) { return row * KP + ((((byte >> 4) ^ (KP == 192 ? ((row >> 2) & 3) : ((row >> 1) & 7)))) << 4) + (byte & 15); }
__device__ __forceinline__ u32x2 bf8_to_fp8x4(bf16x8 v) { const u32x4 w = *reinterpret_cast<const u32x4*>(&v);
    return (u32x2){pk4_fp8_nc(bflo(w.x) * 4.f, bfhi(w.x) * 4.f, bflo(w.y) * 4.f, bfhi(w.y) * 4.f), pk4_fp8_nc(bflo(w.z) * 4.f, bfhi(w.z) * 4.f, bflo(w.w) * 4.f, bfhi(w.w) * 4.f)}; }
__device__ __forceinline__ u32x2 bf8_to_fp8x4s(bf16x8 v, float sc) { const u32x4 w = *reinterpret_cast<const u32x4*>(&v);
    return (u32x2){pk4_fp8_nc(bflo(w.x) * sc, bfhi(w.x) * sc, bflo(w.y) * sc, bfhi(w.y) * sc), pk4_fp8_nc(bflo(w.z) * sc, bfhi(w.z) * sc, bflo(w.w) * sc, bfhi(w.w) * sc)}; }
template <int DQ, bool ROPEQ, int ldq, int ldkv, int ldo, bool OUT8, bool PV8 = (ATT_PV_FP8 != 0), bool Q8IN = false>
__device__ __forceinline__ void attn_unit_qk8(const bf16_t* __restrict__ Qb, const bf16_t* __restrict__ Kh, const bf16_t* __restrict__ KRh, const bf16_t* __restrict__ Vh,
                                               bf16_t* __restrict__ Ob, int seq, LAS char* lds, const f32x2* __restrict__ tabm, int qt0, int wave_s) {
    constexpr int SHM_K8 = KVBLK * DQ, NS = DQ / 64, SHM_VV = PV8 ? KVBLK * 128 : SHM_V;
    const int tid = tid_fresh(wave_s), wid = tid >> 6, lane = tid & 63, r32 = lane & 31, hi = lane >> 5;
    LAS char* V_lds = lds; LAS char* K_lds = lds + 2 * SHM_VV;
    LAS float* wsl = (LAS float*)(lds + 2 * SHM_VV + 2 * SHM_K8) + wid * 64; LAS float* li_l = wsl; LAS float* al_l = wsl + 32;
    float m_reg = -1e30f, l_reg = 0; f32x16 o[4] = {}; i32x8 q8[NS];
    constexpr bool LSM = PV8 && (ATT_OT != 0) && (ATT_LSUM_MFMA != 0); f32x16 osum = {}; (void)osum;
    constexpr bool FOLD = LSM && (ATT_FOLD != 0);
    constexpr float QMUL = FOLD ? Cfg<DQ>::SCALE * 1.4426950408889634f * 32.f : 4.f;
    f32x16 negM = {}; (void)negM;
    {
        const bf16_t* Qw = Qb + (long)(wid * QBLK + r32) * ldq + hi * 32;
        const int t = qt0 + wid * QBLK + r32; const f32x2* tb = ROPEQ ? tabm + (hi ? (t & 63) : (t >> 6)) * 16 : nullptr;
        if constexpr (Q8IN) {
            const unsigned char* Q8w = (const unsigned char*)Qb + (long)(wid * QBLK + r32) * ldq + hi * 32;
#pragma unroll
            for (int s3 = 0; s3 < NS; ++s3) { u32x4 lo4 = *(const u32x4*)(Q8w + s3 * 64), hi4 = *(const u32x4*)(Q8w + s3 * 64 + 16);
                if constexpr (ROPEQ) { if (s3 == 2) {
#pragma unroll
                    for (int w = 0; w < 4; ++w) { const f32x2 x1a = __builtin_amdgcn_cvt_pk_f32_fp8(lo4[w], false), x1b = __builtin_amdgcn_cvt_pk_f32_fp8(lo4[w], true), x2a = __builtin_amdgcn_cvt_pk_f32_fp8(hi4[w], false), x2b = __builtin_amdgcn_cvt_pk_f32_fp8(hi4[w], true);
                        const f32x2 t0 = tb[4 * w], t1 = tb[4 * w + 1], t2 = tb[4 * w + 2], t3 = tb[4 * w + 3];
                        lo4[w] = pk4_fp8(x1a.x * t0.x - x2a.x * t0.y, x1a.y * t1.x - x2a.y * t1.y, x1b.x * t2.x - x2b.x * t2.y, x1b.y * t3.x - x2b.y * t3.y);
                        hi4[w] = pk4_fp8(x2a.x * t0.x + x1a.x * t0.y, x2a.y * t1.x + x1a.y * t1.y, x2b.x * t2.x + x1b.x * t2.y, x2b.y * t3.x + x1b.y * t3.y); } } }
                q8[s3] = (i32x8){(int)lo4.x, (int)lo4.y, (int)lo4.z, (int)lo4.w, (int)hi4.x, (int)hi4.y, (int)hi4.z, (int)hi4.w}; }
        } else {
#pragma unroll
        for (int s3 = 0; s3 < NS; ++s3) { bf16x8 c0 = ld8(Qw + s3 * 64), c1 = ld8(Qw + s3 * 64 + 8), c2 = ld8(Qw + s3 * 64 + 16), c3 = ld8(Qw + s3 * 64 + 24);
            if constexpr (ROPEQ) { if (s3 == 2) { rope_frag(c0, c2, tb); rope_frag(c1, c3, tb + 8); } }
            const u32x2 a = bf8_to_fp8x4s(c0, QMUL), b = bf8_to_fp8x4s(c1, QMUL), c = bf8_to_fp8x4s(c2, QMUL), d = bf8_to_fp8x4s(c3, QMUL);
            q8[s3] = (i32x8){(int)a.x, (int)a.y, (int)b.x, (int)b.y, (int)c.x, (int)c.y, (int)d.x, (int)d.y}; }
        }
    }
    const int sr = tid >> 4, sc = (tid & 15) * 8;
    const int vslot = (sr & 3) | ((sr >> 3) << 2) | (((sr >> 2) & 1) << 4);
    const int vst0 = PV8 ? vslot * 128 + (sc ^ (((vslot >> 1) & 3) << 5)) : v_st(sr, sc), vst1 = PV8 ? (32 + vslot) * 128 + (sc ^ (((vslot >> 1) & 3) << 5)) : v_st(32 + sr, sc);
    const int krr = tid >> 3, krc = (tid & 7) * 8;
    const int kst0 = kswz8<DQ>(sr, sc), kst1 = kswz8<DQ>(32 + sr, sc), kstr = DQ == 192 ? kswz8<DQ>(krr, 128 + krc) : 0;
    const int vb0 = (int)(unsigned)(uintptr_t)V_lds + (PV8 ? ((hi * 32 + ((lane & 15) >> 1)) * 128 + ((lane >> 4) & 1) * 16 + (lane & 1) * 8) : v_rd_base(lane));
    bf16x8 vs0, vs1, ks0, ks1, kr;
    constexpr bool KV8 = PV8 && (ATT_KV8IN != 0);
    constexpr bool OT = PV8 && (ATT_OT != 0);
    const int ckey = tid >> 3, cch = (tid & 7) * 16, rkey = (tid >> 2) & 63, rch = (tid & 3) * 16;
    const int cslot = (ckey & 32) | (ckey & 3) | (((ckey & 31) >> 3) << 2) | (((ckey >> 2) & 1) << 4);
    u32x4 k8, v8, r8;
    constexpr bool KVDMA = KV8 && (ATT_KVDMA != 0); constexpr int NCH = DQ / 16, NKJ = DQ / 16, NJ = NKJ + 8;
    const int widu = __builtin_amdgcn_readfirstlane(wid); (void)widu;
    const unsigned char* jp0 = nullptr; const unsigned char* jp1 = nullptr; const unsigned char* jp2 = nullptr; unsigned js0 = 0, js1 = 0, js2 = 0; (void)jp0; (void)jp1; (void)jp2; (void)js0; (void)js1; (void)js2;
    if constexpr (KVDMA) {
#define KVD_SETUP(JP, JS, Q) do { const int job = widu + 8 * (Q); const bool isK = job < NKJ; \
            const int c = job * 64 + lane, row = (c / NCH) & 63, pos = c - (c / NCH) * NCH, chk = pos ^ (DQ == 192 ? ((row >> 2) & 3) : ((row >> 1) & 7)); \
            const int slot = ((job - NKJ) * 8 + (lane >> 3)) & 63, key = (slot & 32) | (slot & 3) | (((slot >> 2) & 3) << 3) | (((slot >> 4) & 1) << 2), chv = (lane & 7) ^ (((slot >> 1) & 3) << 1); \
            const bool rope = isK && (DQ == 192) && (chk >= 8); \
            const unsigned long long bK = (unsigned long long)(uintptr_t)Kh, bR = (unsigned long long)(uintptr_t)KRh, bV = (unsigned long long)(uintptr_t)Vh; \
            const unsigned long long base_ = isK ? (rope ? bR : bK) : bV; \
            const long off_ = isK ? (rope ? (long)row * 64 + (chk - 8) * 16 : (long)row * ldkv + chk * 16) : (long)key * ldkv + chv * 16; \
            JP = (const unsigned char*)(uintptr_t)(base_ + (unsigned long long)off_); JS = rope ? (unsigned)(KVBLK * 64) : (unsigned)(KVBLK * ldkv); } while (0)
        KVD_SETUP(jp0, js0, 0); KVD_SETUP(jp1, js1, 1); KVD_SETUP(jp2, js2, 2);
#undef KVD_SETUP
    }
#define KVD_ONE(JP, JS, Q, b) do { const int job = widu + 8 * (Q); \
        if (job < NKJ) { __builtin_amdgcn_global_load_lds((const unsigned*)(JP), (LAS unsigned*)(K_lds + (b) * SHM_K8 + job * 1024), 16, 0, 0); JP += JS; } \
        if (job >= NKJ && job < NJ) { __builtin_amdgcn_global_load_lds((const unsigned*)(JP), (LAS unsigned*)(V_lds + (b) * SHM_VV + (job - NKJ) * 1024), 16, 0, 0); JP += JS; } } while (0)
#define KVD_ISSUE(b) do { KVD_ONE(jp0, js0, 0, b); KVD_ONE(jp1, js1, 1, b); if constexpr (NJ > 16) KVD_ONE(jp2, js2, 2, b); } while (0)
#define SLOAD8(k0) do { if constexpr (KV8) { k8 = *(const u32x4*)((const unsigned char*)Kh + (long)((k0) + ckey) * ldkv + cch); v8 = *(const u32x4*)((const unsigned char*)Vh + (long)((k0) + ckey) * ldkv + cch); \
    if constexpr (DQ == 192) { if (tid < 256) r8 = *(const u32x4*)((const unsigned char*)KRh + (long)((k0) + rkey) * 64 + rch); } } else { vs0 = ld8(&Vh[(long)((k0) + sr) * ldkv + sc]); vs1 = ld8(&Vh[(long)((k0) + 32 + sr) * ldkv + sc]); \
    ks0 = ld8(&Kh[(long)((k0) + sr) * ldkv + sc]); ks1 = ld8(&Kh[(long)((k0) + 32 + sr) * ldkv + sc]); if constexpr (DQ == 192) kr = ld8(&KRh[(long)((k0) + krr) * 64 + krc]); } } while (0)
#define SWRITE8(b) do { if constexpr (KV8) { *(LAS u32x4*)(K_lds + (b) * SHM_K8 + kswz8<DQ>(ckey, cch)) = k8; *(LAS u32x4*)(V_lds + (b) * SHM_VV + cslot * 128 + (cch ^ (((cslot >> 1) & 3) << 5))) = v8; \
    if constexpr (DQ == 192) { if (tid < 256) *(LAS u32x4*)(K_lds + (b) * SHM_K8 + kswz8<DQ>(rkey, 128 + rch)) = r8; } } else { if constexpr (PV8) { *(LAS u32x2*)(V_lds + (b) * SHM_VV + vst0) = bf8_to_fp8x4(vs0); *(LAS u32x2*)(V_lds + (b) * SHM_VV + vst1) = bf8_to_fp8x4(vs1); } \
    else { *(LAS bf16x8*)(V_lds + (b) * SHM_VV + vst0) = vs0; *(LAS bf16x8*)(V_lds + (b) * SHM_VV + vst1) = vs1; } \
    *(LAS u32x2*)(K_lds + (b) * SHM_K8 + kst0) = bf8_to_fp8x4(ks0); *(LAS u32x2*)(K_lds + (b) * SHM_K8 + kst1) = bf8_to_fp8x4(ks1); if constexpr (DQ == 192) *(LAS u32x2*)(K_lds + (b) * SHM_K8 + kstr) = bf8_to_fp8x4(kr); } } while (0)
#define RESC8(a) do { if (__any((a) < 1.f)) { if constexpr (OT) { _Pragma("unroll") for (int d = 0; d < 4; ++d) _Pragma("unroll") for (int r = 0; r < 16; ++r) o[d][r] *= (a); if constexpr (LSM) { _Pragma("unroll") for (int r = 0; r < 16; ++r) osum[r] *= (a); } } \
    else { if (hi == 0) al_l[r32] = (a); asm volatile("s_waitcnt lgkmcnt(0)" ::: "memory"); \
    _Pragma("unroll") for (int d = 0; d < 4; ++d) _Pragma("unroll") for (int r = 0; r < 16; ++r) o[d][r] *= al_l[crow(r, hi)]; } } } while (0)
    bf16x8 pa0, pa1, pa2, pa3; const int NT = seq / KVBLK; f32x16 p0, p1; float mn, al;
    i32x8 ones8 = (i32x8){0x38383838, 0x38383838, 0x38383838, 0x38383838, 0x38383838, 0x38383838, 0x38383838, 0x38383838}; asm volatile("" : "+v"(ones8));
    if constexpr (KVDMA) { KVD_ISSUE(0); __syncthreads(); }
    else { SLOAD8(0); asm volatile("s_waitcnt vmcnt(0)" ::: "memory"); SWRITE8(0); SLOAD8(KVBLK); __syncthreads(); }
#pragma unroll 2
    for (int j = 0; j < NT; ++j) {
        const int cb = j & 1;
        if constexpr (KVDMA) { if (j + 1 < NT) KVD_ISSUE(cb ^ 1); }
        else if (j + 1 < NT) { asm volatile("s_waitcnt vmcnt(0)" ::: "memory"); SWRITE8(cb ^ 1); if (j + 2 < NT) SLOAD8((j + 2) * KVBLK); }
        SBAR();
        { const LAS char* Ks = K_lds + cb * SHM_K8; if constexpr (FOLD) { p0 = negM; p1 = negM; } else { p0 = f32x16{}; p1 = f32x16{}; }
#pragma unroll
          for (int s3 = 0; s3 < NS; ++s3) { const int b0 = 64 * s3 + 32 * hi;
              const i32x4 a0 = *(const LAS i32x4*)(Ks + kswz8<DQ>(r32, b0)), a1 = *(const LAS i32x4*)(Ks + kswz8<DQ>(r32, b0 + 16));
              const i32x4 c0 = *(const LAS i32x4*)(Ks + kswz8<DQ>(32 + r32, b0)), c1 = *(const LAS i32x4*)(Ks + kswz8<DQ>(32 + r32, b0 + 16));
              p0 = __builtin_amdgcn_mfma_scale_f32_32x32x64_f8f6f4(__builtin_shufflevector(a0, a1, 0, 1, 2, 3, 4, 5, 6, 7), q8[s3], p0, 0, 0, 0, 0x7F7F7F7F, 0, FOLD ? 0x78787878 : 0x7F7F7F7F);
              p1 = __builtin_amdgcn_mfma_scale_f32_32x32x64_f8f6f4(__builtin_shufflevector(c0, c1, 0, 1, 2, 3, 4, 5, 6, 7), q8[s3], p1, 0, 0, 0, 0x7F7F7F7F, 0, FOLD ? 0x78787878 : 0x7F7F7F7F); } }
        if constexpr (FOLD) {
            float pmax = p0[0];
#pragma unroll
            for (int r = 1; r < 16; ++r) pmax = fmaxf(pmax, p0[r]);
#pragma unroll
            for (int r = 0; r < 16; ++r) pmax = fmaxf(pmax, p1[r]);
            { auto rr = __builtin_amdgcn_permlane32_swap(__float_as_uint(pmax), __float_as_uint(pmax), false, false); pmax = fmaxf(__uint_as_float(rr[0]), __uint_as_float(rr[1])); }
            constexpr float T2 = 5.f * 1.4426950408889634f;
            al = 1.f;
            if (j == 0 || !__all(pmax <= T2)) {
                const float d = (j == 0) ? pmax : fmaxf(pmax, 0.f);
                al = (j == 0) ? 1.f : __builtin_amdgcn_exp2f(-d);
#pragma unroll
                for (int r = 0; r < 16; ++r) { p0[r] -= d; p1[r] -= d; negM[r] -= d; }
            }
#pragma unroll
            for (int r = 0; r < 16; ++r) p0[r] = __builtin_amdgcn_exp2f(p0[r]);
            RESC8(al);
        } else { partialSM<DQ, 16, PV8 ? 5 : 8>(p0, p1, m_reg, mn, al); RESC8(al); }
        if constexpr (PV8) {
            SBAR();
            const int vb = vb0 + cb * SHM_VV;
            u32x2 tv[4][4];
            const int vsx = ((lane & 15) >> 2) & 3; const int vbd[4] = {vb + ((0 ^ vsx) << 5), vb + ((1 ^ vsx) << 5), vb + ((2 ^ vsx) << 5), vb + ((3 ^ vsx) << 5)};
#define PV8_RD(D0, T) asm volatile("ds_read_b64_tr_b8 %0, %1 offset:%2" : "=&v"(tv[D0][T]) : "v"(vbd[D0]), "i"((T) * 1024) : "memory")
            PV8_RD(0, 0); PV8_RD(0, 1); PV8_RD(0, 2); PV8_RD(0, 3); PV8_RD(1, 0); PV8_RD(1, 1); PV8_RD(1, 2); PV8_RD(1, 3);
            PV8_RD(2, 0); PV8_RD(2, 1); PV8_RD(2, 2); PV8_RD(2, 3); PV8_RD(3, 0); PV8_RD(3, 1); PV8_RD(3, 2); PV8_RD(3, 3);
#undef PV8_RD
            SBAR();
#pragma unroll
            for (int r = 0; r < 16; ++r) p1[r] = __builtin_amdgcn_exp2f(p1[r]);
            if constexpr (!LSM) { float ps = 0;
#pragma unroll
                for (int r = 0; r < 16; ++r) ps += p0[r] + p1[r];
                l_reg = l_reg * al + sum32(ps, ps); }
            unsigned a0[4], a1[4];
#pragma unroll
            for (int q = 0; q < 4; ++q) { a0[q] = pk4_fp8_nz(p0[4 * q], p0[4 * q + 1], p0[4 * q + 2], p0[4 * q + 3]); a1[q] = pk4_fp8_nz(p1[4 * q], p1[4 * q + 1], p1[4 * q + 2], p1[4 * q + 3]); }
            i32x8 pf;
#pragma unroll
            for (int q = 0; q < 4; ++q) { auto rr = __builtin_amdgcn_permlane32_swap(a0[q], a1[q], false, false); pf[q] = (int)rr[0]; pf[4 + q] = (int)rr[1]; }
            asm volatile("s_waitcnt lgkmcnt(0)" ::: "memory"); SBAR();
#pragma unroll
            for (int d0 = 0; d0 < 4; ++d0) { const i32x8 vf = (i32x8){(int)tv[d0][0].x, (int)tv[d0][0].y, (int)tv[d0][1].x, (int)tv[d0][1].y, (int)tv[d0][2].x, (int)tv[d0][2].y, (int)tv[d0][3].x, (int)tv[d0][3].y};
                if constexpr (LSM) { if (d0 == 0) {
                    osum = __builtin_amdgcn_mfma_scale_f32_32x32x64_f8f6f4(ones8, pf, osum, 0, 0, 0, 0x7F7F7F7F, 0, 0x7F7F7F7F); } }
                if constexpr (OT) o[d0] = __builtin_amdgcn_mfma_scale_f32_32x32x64_f8f6f4(vf, pf, o[d0], 0, 0, 0, 0x7F7F7F7F, 0, 0x7F7F7F7F);
                else o[d0] = __builtin_amdgcn_mfma_scale_f32_32x32x64_f8f6f4(pf, vf, o[d0], 0, 0, 0, 0x7F7F7F7F, 0, 0x7F7F7F7F); }
        } else {
        finishSM(p0, p1, al, l_reg, pa0, pa1, pa2, pa3); SBAR();
        pv_d0(o, vb0 + cb * SHM_VV, pa0, pa1, pa2, pa3);
        }
        __syncthreads();
    }
    bf16_t* Ow = OUT8 ? (bf16_t*)((unsigned char*)Ob + (long)(wid * QBLK) * ldo) : Ob + (long)(wid * QBLK) * ldo;
    if constexpr (OT) {
        const float rl = __builtin_amdgcn_rcpf(LSM ? osum[0] : l_reg) * (OUT8 ? 4.f : 0.25f);
        LAS char* T = lds + wid * (OUT8 ? 4096 : 8192);
        if constexpr (OUT8) {
#pragma unroll
            for (int d0 = 0; d0 < 4; ++d0)
#pragma unroll
                for (int g = 0; g < 4; ++g) { const unsigned w = pk4_fp8(o[d0][4 * g] * rl, o[d0][4 * g + 1] * rl, o[d0][4 * g + 2] * rl, o[d0][4 * g + 3] * rl);
                    *(LAS unsigned*)(T + r32 * 128 + (((d0 * 2 + (g >> 1)) ^ (r32 & 7)) << 4) + (g & 1) * 8 + 4 * hi) = w; }
            asm volatile("s_waitcnt lgkmcnt(0)" ::: "memory");
#pragma unroll
            for (int i = 0; i < 4; ++i) { const int R = (lane >> 3) + 8 * i, j = lane & 7; const u32x4 v = *(const LAS u32x4*)(T + R * 128 + ((j ^ (R & 7)) << 4));
                *(u32x4*)((unsigned char*)Ow + (long)R * ldo + j * 16) = v; }
        } else {
#pragma unroll
            for (int d0 = 0; d0 < 4; ++d0)
#pragma unroll
                for (int g = 0; g < 4; ++g) { u32x2 w; w.x = cvtpk(o[d0][4 * g] * rl, o[d0][4 * g + 1] * rl); w.y = cvtpk(o[d0][4 * g + 2] * rl, o[d0][4 * g + 3] * rl);
                    *(LAS u32x2*)(T + r32 * 256 + (((d0 * 4 + g) ^ (r32 & 15)) << 4) + 8 * hi) = w; }
            asm volatile("s_waitcnt lgkmcnt(0)" ::: "memory");
#pragma unroll
            for (int i = 0; i < 8; ++i) { const int R = (lane >> 4) + 4 * i, j = lane & 15; const u32x4 v = *(const LAS u32x4*)(T + R * 256 + ((j ^ (R & 15)) << 4));
                *(u32x4*)((char*)Ow + ((long)R * ldo) * 2 + j * 16) = v; }
        }
    } else {
    if (hi == 0) li_l[r32] = l_reg; asm volatile("s_waitcnt lgkmcnt(0)" ::: "memory");
    float rli[16];
#pragma unroll
    for (int r = 0; r < 16; ++r) rli[r] = __builtin_amdgcn_rcpf(li_l[crow(r, hi)]) * (PV8 ? 0.25f : 1.f);
#pragma unroll
    for (int r = 0; r < 16; ++r) { const int orow = crow(r, hi);
#pragma unroll
        for (int d0 = 0; d0 < 4; ++d0) { if constexpr (OUT8) ((unsigned char*)Ow)[(long)orow * ldo + d0 * 32 + r32] = (unsigned char)(pk4_fp8(o[d0][r] * rli[r] * 16.f, 0.f, 0.f, 0.f) & 0xffu);
            else Ow[(long)orow * ldo + d0 * 32 + r32] = f2bf(o[d0][r] * rli[r]); } }
    }
    __syncthreads();
#undef SLOAD8
#undef KVD_ONE
#undef KVD_ISSUE
#undef SWRITE8
#undef RESC8
}
}

template <int MODE> __device__ __forceinline__ int dst_row(int n) {
    if (MODE == 1) { const int half = n >> 10, c = n & 1023; return ((c >> 7) << 8) + (half << 7) + (c & 127); }
    if (MODE == 2) { const int h = n >> 8, j = n & 255; return j < 128 ? (h << 7) + j : 1024 + (h << 7) + (j - 128); }
    return n;
}
template <int MODE> __device__ __forceinline__ void p0_transpose_item_fp8(const float* W, int K, int N, unsigned char* WT, LAS float* scr, int item, int lane) {
    const int nblk = N / 32, kb = item / nblk, nb = item % nblk, k0 = 64 * kb, n0 = 32 * nb;
#pragma unroll 8
    for (int i = 0; i < 32; ++i) { const int kk = 2 * i + (lane >> 5); scr[kk * 33 + (lane & 31)] = W[(size_t)(k0 + kk) * N + n0 + (lane & 31)]; }
    LDS_WAIT(); asm volatile("" ::: "memory");
    const int c = lane & 7;
#pragma unroll
    for (int j = 0; j < 4; ++j) { const int n = (lane >> 3) + 8 * j; const LAS float* s = scr + (8 * c) * 33 + n;
        u32x2 o; o.x = pk4_fp8(s[0 * 33] * 64.f, s[1 * 33] * 64.f, s[2 * 33] * 64.f, s[3 * 33] * 64.f); o.y = pk4_fp8(s[4 * 33] * 64.f, s[5 * 33] * 64.f, s[6 * 33] * 64.f, s[7 * 33] * 64.f);
        *(u32x2*)(WT + (size_t)dst_row<MODE>(n0 + n) * K + k0 + 8 * c) = o; }
    LDS_WAIT(); asm volatile("" ::: "memory");
}
template <int MODE> __device__ __forceinline__ void p0_transpose_item64_fp8(const float* W, int K, int N, unsigned char* WT, LAS float* scr, int item, int lane) {
    const int nblk = N / 64, kb = item / nblk, nb = item % nblk, k0 = 64 * kb, n0 = 64 * nb;
#pragma unroll 4
    for (int i = 0; i < 16; ++i) { const int kk = 4 * i + (lane >> 4), nc = (lane & 15) * 4; const f32x4 v = *(const f32x4*)(W + (size_t)(k0 + kk) * N + n0 + nc);
        LAS float* d = scr + kk * 65 + nc; d[0] = v.x; d[1] = v.y; d[2] = v.z; d[3] = v.w; }
    LDS_WAIT(); asm volatile("" ::: "memory");
    const int c = lane & 7;
#pragma unroll
    for (int j = 0; j < 8; ++j) { const int n = (lane >> 3) + 8 * j; const LAS float* s = scr + (8 * c) * 65 + n;
        u32x2 o; o.x = pk4_fp8(s[0 * 65] * 64.f, s[1 * 65] * 64.f, s[2 * 65] * 64.f, s[3 * 65] * 64.f); o.y = pk4_fp8(s[4 * 65] * 64.f, s[5 * 65] * 64.f, s[6 * 65] * 64.f, s[7 * 65] * 64.f);
        *(u32x2*)(WT + (size_t)dst_row<MODE>(n0 + n) * K + k0 + 8 * c) = o; }
    LDS_WAIT(); asm volatile("" ::: "memory");
}
template <int MODE> __device__ __forceinline__ void p0_transpose_item128_fp8(const float* W, int K, int N, unsigned char* WT, LAS unsigned char* scr, int item, int lane) {
    const int nblk = N / 64, kb = item / nblk, nb = item % nblk, k0 = 128 * kb, n0 = 64 * nb, kq = lane >> 4, nq = lane & 15;
#pragma unroll 4
    for (int i = 0; i < 8; ++i) { const float* src = W + (size_t)(k0 + 4 * (4 * i + kq)) * N + n0 + 4 * nq;
        const f32x4 v0 = *(const f32x4*)src, v1 = *(const f32x4*)(src + N), v2 = *(const f32x4*)(src + 2 * (size_t)N), v3 = *(const f32x4*)(src + 3 * (size_t)N);
        LAS unsigned char* d = scr + (4 * nq) * 128 + ((i ^ (nq & 7)) << 4) + kq * 4;
        *(LAS unsigned*)(d) = pk4_fp8(v0.x * 64.f, v1.x * 64.f, v2.x * 64.f, v3.x * 64.f); *(LAS unsigned*)(d + 128) = pk4_fp8(v0.y * 64.f, v1.y * 64.f, v2.y * 64.f, v3.y * 64.f);
        *(LAS unsigned*)(d + 256) = pk4_fp8(v0.z * 64.f, v1.z * 64.f, v2.z * 64.f, v3.z * 64.f); *(LAS unsigned*)(d + 384) = pk4_fp8(v0.w * 64.f, v1.w * 64.f, v2.w * 64.f, v3.w * 64.f); }
    LDS_WAIT(); asm volatile("" ::: "memory");
#pragma unroll
    for (int j = 0; j < 8; ++j) { const int n = (lane >> 3) + 8 * j, pc = lane & 7; const u32x4 o = *(const LAS u32x4*)(scr + n * 128 + ((pc ^ ((n >> 2) & 7)) << 4));
        *(u32x4*)(WT + (size_t)dst_row<MODE>(n0 + n) * K + k0 + 16 * pc) = o; }
    LDS_WAIT(); asm volatile("" ::: "memory");
}
template <int MODE> __device__ __forceinline__ void p0_transpose_item(const float* W, int K, int N, bf16_t* WT, LAS float* scr, int item, int lane) {
    const int nblk = N / 32, kb = item / nblk, nb = item % nblk, k0 = 64 * kb, n0 = 32 * nb;
#pragma unroll 8
    for (int i = 0; i < 32; ++i) { const int kk = 2 * i + (lane >> 5); scr[kk * 33 + (lane & 31)] = W[(size_t)(k0 + kk) * N + n0 + (lane & 31)]; }
    LDS_WAIT(); asm volatile("" ::: "memory");
    const int c = lane & 7;
#pragma unroll
    for (int j = 0; j < 4; ++j) { const int n = (lane >> 3) + 8 * j; const LAS float* s = scr + (8 * c) * 33 + n;
        u32x4 o; o.x = cvtpk(s[0 * 33], s[1 * 33]); o.y = cvtpk(s[2 * 33], s[3 * 33]); o.z = cvtpk(s[4 * 33], s[5 * 33]); o.w = cvtpk(s[6 * 33], s[7 * 33]);
        *(u32x4*)(WT + (size_t)dst_row<MODE>(n0 + n) * K + k0 + 8 * c) = o; }
    LDS_WAIT(); asm volatile("" ::: "memory");
}
__device__ __forceinline__ void p0_prologue(Frame& F) {
    uchar* ws = F.ws;
    {
        LAS float* S = (LAS float*)F.lds;
        const float* pC = INP(I_C); const float* pCC = INP(I_CCTX); const float* pAW = INP(I_ADAW); const float* pAB = INP(I_ADAB); const float* pNM = INP(I_NMIXG); const float* pNF = INP(I_NFFNG);
        float* MOD = (float*)(ws + WS_MOD);
        for (int item = F.bid; item < 192; item += F.G) {
            const int layer = item / 96, n0 = (item % 96) * 64;
            __syncthreads();
            for (int u = F.tid; u < 33 * 1024; u += 512) { const int j = u >> 10, k = u & 1023; const float c = j < 32 ? pC[j * 1024 + k] : pCC[k]; S[u] = silu_f(c); }
            __syncthreads();
            float acc[33];
#pragma unroll
            for (int j = 0; j < 33; ++j) acc[j] = 0.f;
            const float* wp = pAW + (size_t)layer * 1024 * 6144 + n0 + F.lane;
            const int kbeg = F.wave * 128;
            for (int k = kbeg; k < kbeg + 128; k += 4) {
                const float w0 = wp[(size_t)k * 6144], w1 = wp[(size_t)(k + 1) * 6144], w2 = wp[(size_t)(k + 2) * 6144], w3 = wp[(size_t)(k + 3) * 6144];
#pragma unroll
                for (int j = 0; j < 33; ++j) { const f32x4 s = *(const LAS f32x4*)(S + j * 1024 + k); acc[j] += s.x * w0 + s.y * w1 + s.z * w2 + s.w * w3; }
            }
            __syncthreads();
#pragma unroll
            for (int j = 0; j < 33; ++j) S[(F.wave * 33 + j) * 64 + F.lane] = acc[j];
            __syncthreads();
            for (int u = F.tid; u < 33 * 64; u += 512) { const int j = u >> 6, cl = u & 63; float s = 0.f;
#pragma unroll
                for (int w = 0; w < 8; ++w) s += S[(w * 33 + j) * 64 + cl];
                const int n = n0 + cl, part = n >> 10, col = n & 1023;
                s += pAB[layer * 6144 + n];
                if (part == 1) s = pNM[layer * 1024 + col] * (1.f + s);
                if (part == 4) s = pNF[layer * 1024 + col] * (1.f + s);
                MOD[((size_t)(layer * 33 + j) * 6 + part) * 1024 + col] = s; }
        }
        __syncthreads();
    }
    {
        const int gt = F.bid * 512 + F.tid, NT = F.G * 512;
        f32x2* tg = (f32x2*)(ws + WS_TABG); f32x2* tm = (f32x2*)(ws + WS_TABM);
        for (int u = gt; u < 64 * 32; u += NT) { const int pos = u >> 5, i = u & 31; const float inv = powf(10000.f, -(float)(2 * i) / 64.f); const float a = (float)pos * inv; tg[u] = (f32x2){cosf(a), sinf(a)}; }
        for (int u = gt; u < 64 * 16; u += NT) { const int pos = u >> 4, i = u & 15; const float inv = powf(10000.f, -(float)(2 * i) / 32.f); const float a = (float)pos * inv; tm[u] = (f32x2){cosf(a), sinf(a)}; }
        float* wrt = (float*)(ws + WS_WRT); const float* pRW = INP(I_RW); const float* pSW = INP(I_SGUW);
        for (int u = gt; u < 2 * 32 * 1024; u += NT) { const int l = u >> 15, e = (u >> 10) & 31, k = u & 1023; wrt[u] = pRW[((size_t)l * 1024 + k) * 32 + e]; }
        bf16_t* sw = (bf16_t*)(ws + WS_SGUW);
        for (int u = gt; u < 4 * 128 * 128; u += NT) sw[u] = f2bf(pSW[u]);
        u32x4* z = (u32x4*)(ws + WS_WIN1 + (size_t)832 * 1024 * (PROJ1_FP8 ? 1 : 2));
        for (int u = gt; u < 192 * 1024 * (PROJ1_FP8 ? 1 : 2) / 16; u += NT) z[u] = (u32x4){0u, 0u, 0u, 0u};
    }
    {
        LAS float* scr = (LAS float*)(F.lds + F.wave * 16640);
        const int gw = F.bid * 8 + F.wave, NGW = F.G * 8; const float* pW1 = INP(I_W1); const float* pW2 = INP(I_W2);
        constexpr int J0 = 16 * 64, J1 = 16 * 32, J2 = 16 * 26, J3 = 8 * 48, J4 = 4 * 64, J5 = 16 * 32, JW1 = MOE_FP8 ? (P0_ITEM128 ? 64 * 256 : 64 * 512) : 64 * 1024, JW2 = MOE_FP8 ? (P0_ITEM128 ? 64 * 128 : 64 * 256) : 64 * 512;
        constexpr int NITEMS = J0 + J1 + J2 + J3 + J4 + J5 + JW1 + JW2;
        for (int it = gw; it < NITEMS; it += NGW) {
            int r = it;
#if MOE_FP8
#if P0_ITEM128
            if (r < JW1) { const int le = r >> 8; p0_transpose_item128_fp8<1>(pW1 + (size_t)le * 1024 * 2048, 1024, 2048, (unsigned char*)(ws + WS_W1) + (size_t)le * 2048 * 1024, (LAS unsigned char*)scr, r & 255, F.lane); continue; } r -= JW1;
            if (r < JW2) { const int le = r >> 7; p0_transpose_item128_fp8<0>(pW2 + (size_t)le * 1024 * 1024, 1024, 1024, (unsigned char*)(ws + WS_W2) + (size_t)le * 1024 * 1024, (LAS unsigned char*)scr, r & 127, F.lane); continue; } r -= JW2;
#else
            if (r < JW1) { const int le = r >> 9; p0_transpose_item64_fp8<1>(pW1 + (size_t)le * 1024 * 2048, 1024, 2048, (unsigned char*)(ws + WS_W1) + (size_t)le * 2048 * 1024, scr, r & 511, F.lane); continue; } r -= JW1;
            if (r < JW2) { const int le = r >> 8; p0_transpose_item64_fp8<0>(pW2 + (size_t)le * 1024 * 1024, 1024, 1024, (unsigned char*)(ws + WS_W2) + (size_t)le * 1024 * 1024, scr, r & 255, F.lane); continue; } r -= JW2;
#endif
#else
            if (r < JW1) { const int le = r >> 10; p0_transpose_item<1>(pW1 + (size_t)le * 1024 * 2048, 1024, 2048, (bf16_t*)(ws + WS_W1) + (size_t)le * 2048 * 1024, scr, r & 1023, F.lane); continue; } r -= JW1;
            if (r < JW2) { const int le = r >> 9; p0_transpose_item<0>(pW2 + (size_t)le * 1024 * 1024, 1024, 1024, (bf16_t*)(ws + WS_W2) + (size_t)le * 1024 * 1024, scr, r & 511, F.lane); continue; } r -= JW2;
#endif
            if (r < J0) { if constexpr (PROJ0_FP8 != 0) p0_transpose_item_fp8<0>(INP(I_ABWIN), 1024, 2048, (unsigned char*)(ws + WS_WIN0), scr, r, F.lane); else p0_transpose_item<0>(INP(I_ABWIN), 1024, 2048, (bf16_t*)(ws + WS_WIN0), scr, r, F.lane); continue; } r -= J0;
            if (r < J1) { if constexpr (OUT0_FP8 != 0) p0_transpose_item_fp8<0>(INP(I_ABWOUT), 1024, 1024, (unsigned char*)(ws + WS_WOUT0), scr, r, F.lane); else p0_transpose_item<0>(INP(I_ABWOUT), 1024, 1024, (bf16_t*)(ws + WS_WOUT0), scr, r, F.lane); continue; } r -= J1;
            if (r < J2) { if constexpr (PROJ1_FP8 != 0) p0_transpose_item_fp8<0>(INP(I_MLAWIN), 1024, 832, (unsigned char*)(ws + WS_WIN1), scr, r, F.lane); else p0_transpose_item<0>(INP(I_MLAWIN), 1024, 832, (bf16_t*)(ws + WS_WIN1), scr, r, F.lane); continue; } r -= J2;
            if (r < J3) { if constexpr (UPQ_FP8 != 0) p0_transpose_item_fp8<0>(INP(I_MLAWUQ), 512, 1536, (unsigned char*)(ws + WS_WUQ), scr, r, F.lane); else p0_transpose_item<0>(INP(I_MLAWUQ), 512, 1536, (bf16_t*)(ws + WS_WUQ), scr, r, F.lane); continue; } r -= J3;
            if (r < J4) { if constexpr (UPKV_FP8 != 0) p0_transpose_item_fp8<2>(INP(I_MLAWUKV), 256, 2048, (unsigned char*)(ws + WS_WUKV), scr, r, F.lane); else p0_transpose_item<2>(INP(I_MLAWUKV), 256, 2048, (bf16_t*)(ws + WS_WUKV), scr, r, F.lane); continue; } r -= J4;
            if constexpr (OUT1_FP8 != 0) p0_transpose_item_fp8<0>(INP(I_MLAWOUT), 1024, 1024, (unsigned char*)(ws + WS_WOUT1), scr, r, F.lane); else p0_transpose_item<0>(INP(I_MLAWOUT), 1024, 1024, (bf16_t*)(ws + WS_WOUT1), scr, r, F.lane);
        }
    }
}

__device__ __forceinline__ void row_src_ptr(const float* px, const float* pctx, int r, const float*& src, int& mj) {
    const int b = r / TPB, pos = r - b * TPB;
    if (pos < CTXL) { src = pctx + ((size_t)b * CTXL + pos) * DM; mj = 32; } else { src = px + ((size_t)b * SEQ + (pos - CTXL)) * DM; mj = b; }
}
__device__ __forceinline__ f32x4 bf4(u32x2 w) { return (f32x4){bflo(w.x), bfhi(w.x), bflo(w.y), bfhi(w.y)}; }
__device__ __forceinline__ u32x2 pk4bf(f32x4 v) { return (u32x2){cvtpk(v.x, v.y), cvtpk(v.z, v.w)}; }
__device__ __forceinline__ void store_h_row(bf16_t* hrow, int lane, const f32x4 (&h)[4]) {
    unsigned long long* o8 = (unsigned long long*)hrow + lane;
#pragma unroll
    for (int j = 0; j < 4; ++j) o8[64 * j] = (unsigned long long)cvtpk(h[j].x, h[j].y) | ((unsigned long long)cvtpk(h[j].z, h[j].w) << 32);
}
__device__ __forceinline__ void p_norm0(Frame& F) {
    const float* MOD = (const float*)(F.ws + WS_MOD); bf16_t* H = (bf16_t*)(F.ws + WS_H);
    const int gw = F.bid * 8 + F.wave, NGW = F.G * 8; const float* px = INP(I_X); const float* pctx = INP(I_CTX);
    for (int r = gw; r < NTOK; r += NGW) {
        const float* src; int mj; row_src_ptr(px, pctx, r, src, mj);
        const f32x4* xr = (const f32x4*)src + F.lane; f32x4 v[4]; float ss = 0.f;
#pragma unroll
        for (int j = 0; j < 4; ++j) { v[j] = xr[64 * j]; ss += (v[j].x * v[j].x + v[j].y * v[j].y) + (v[j].z * v[j].z + v[j].w * v[j].w); }
        const float rstd = rsqrtf(wave_sum(ss) * (1.f / DM) + EPS);
        const f32x4* sh = (const f32x4*)(MOD + ((size_t)(0 * 33 + mj) * 6 + 0) * 1024) + F.lane; const f32x4* A = (const f32x4*)(MOD + ((size_t)(0 * 33 + mj) * 6 + 1) * 1024) + F.lane;
        f32x4 h[4];
#pragma unroll
        for (int j = 0; j < 4; ++j) h[j] = v[j] * rstd * A[64 * j] + sh[64 * j];
        if constexpr (PROJ0_FP8 != 0) { unsigned* o4 = (unsigned*)((unsigned char*)H + (size_t)r * DM) + F.lane;
#pragma unroll
            for (int j = 0; j < 4; ++j) o4[64 * j] = pk4_fp8(h[j].x * 4.f, h[j].y * 4.f, h[j].z * 4.f, h[j].w * 4.f); }
        else store_h_row(H + (size_t)r * DM, F.lane, h);
    }
}
__device__ __forceinline__ void p_norm0_v2(Frame& F) {
    const float* MOD = (const float*)(F.ws + WS_MOD); bf16_t* H = (bf16_t*)(F.ws + WS_H); const float* px = INP(I_X); const float* pctx = INP(I_CTX);
    const int RPW = (NTOK + F.G - 1) / F.G, r_first = F.bid * RPW, r_last = (r_first + RPW < NTOK) ? r_first + RPW : NTOK;
    int ra = r_first;
    while (ra < r_last) {
        const int b = ra / TPB, pos = ra - b * TPB; const bool cx = pos < CTXL; const int mj = cx ? 32 : b; int rb = cx ? b * TPB + CTXL : (b + 1) * TPB; rb = rb < r_last ? rb : r_last;
        f32x4 Av[4], Sv[4];
        { const f32x4* sh = (const f32x4*)(MOD + ((size_t)(0 * 33 + mj) * 6 + 0) * 1024) + F.lane; const f32x4* A = (const f32x4*)(MOD + ((size_t)(0 * 33 + mj) * 6 + 1) * 1024) + F.lane;
#pragma unroll
          for (int j = 0; j < 4; ++j) { Av[j] = A[64 * j]; Sv[j] = sh[64 * j]; } }
        const int r0 = ra + F.wave, n = (rb - r0 + 7) >> 3;
        if (n > 0) {
            const float* sbase = cx ? pctx + ((size_t)b * CTXL + (r0 - b * TPB)) * DM : px + ((size_t)b * SEQ + (r0 - b * TPB - CTXL)) * DM;
            f32x4 RA[4], RB[4], RC[4]; int i = 0;
#define N0_ISSUE(T_, idx) do { const int i_ = (idx) < n ? (idx) : n - 1; const f32x4* xr_ = (const f32x4*)(sbase + (size_t)i_ * 8 * DM) + F.lane; \
            _Pragma("unroll") for (int j = 0; j < 4; ++j) T_[j] = xr_[64 * j]; __builtin_amdgcn_sched_barrier(0); } while (0)
#define N0_COMP(T_, idx) do { float ss_ = 0.f; _Pragma("unroll") for (int j = 0; j < 4; ++j) ss_ += (T_[j].x * T_[j].x + T_[j].y * T_[j].y) + (T_[j].z * T_[j].z + T_[j].w * T_[j].w); \
            const float rstd_ = rsqrtf(wave_sum(ss_) * (1.f / DM) + EPS); f32x4 h_[4]; _Pragma("unroll") for (int j = 0; j < 4; ++j) h_[j] = T_[j] * rstd_ * Av[j] + Sv[j]; \
            store_h_row(H + (size_t)(r0 + 8 * (idx)) * DM, F.lane, h_); __builtin_amdgcn_sched_barrier(0); } while (0)
            N0_ISSUE(RA, 0); N0_ISSUE(RB, 1);
            for (; i + 3 <= n; i += 3) {
                N0_ISSUE(RC, i + 2); N0_COMP(RA, i);
                N0_ISSUE(RA, i + 3); N0_COMP(RB, i + 1);
                N0_ISSUE(RB, i + 4); N0_COMP(RC, i + 2);
            }
            if (i < n) N0_COMP(RA, i);
            if (i + 1 < n) N0_COMP(RB, i + 1);
#undef N0_ISSUE
#undef N0_COMP
        }
        ra = rb;
    }
}
__device__ __forceinline__ void moe_prefix(Frame& F, int layer) {
    LAS int* pb = (LAS int*)(F.lds + XTRA_OFF + X_PB); LAS int* cn = (LAS int*)(F.lds + XTRA_OFF + X_CNT);
    const unsigned* gc = (const unsigned*)(F.ws + WS_CTL) + CW_CNT + layer * 64;
    __syncthreads();
    if (F.tid == 0) { int s = 0; for (int e = 0; e < 32; ++e) { const int c = (int)__hip_atomic_load(gc + e, __ATOMIC_RELAXED, __HIP_MEMORY_SCOPE_AGENT); cn[e] = c; pb[e] = s; s += (c + 255) >> 8; } pb[32] = s; }
    __syncthreads();
    {
        LAS unsigned* bt = (LAS unsigned*)(F.lds + XTRA_OFF + X_BT); const int tot = pb[32];
        for (int blk = F.tid; blk < BT_N; blk += 512) { int lo = 0;
#pragma unroll
            for (int st = 16; st >= 1; st >>= 1) { if (pb[lo + st] <= blk) lo += st; }
            bt[blk] = blk < tot ? ((unsigned)lo << 16) | (unsigned)(blk - pb[lo]) : 0xffffffffu; }
    }
    __syncthreads();
}
__device__ __forceinline__ void moe_gather_row(const Frame& F, int r, f32x4 (&f)[4]) {
    const LAS int* pb = (const LAS int*)(F.lds + XTRA_OFF + X_PB);
    const u32x2* ti = (const u32x2*)(F.ws + WS_TOKI) + (size_t)r * 4; const bf16_t* Y = (const bf16_t*)(F.ws + WS_Y);
#pragma unroll
    for (int j = 0; j < 4; ++j) f[j] = (f32x4){0.f, 0.f, 0.f, 0.f};
#pragma unroll
    for (int k = 0; k < 4; ++k) {
        const u32x2 t = ti[k]; const int e = (int)(t.x >> 20), pos = (int)(t.x & 0xfffffu); const float g = __uint_as_float(t.y);
        const size_t yrow = (size_t)pb[e] * 256 + pos;
#if Y_FP8
        const unsigned* yp = (const unsigned*)((const unsigned char*)Y + yrow * DM) + F.lane; const float g16 = g * (1.f / 16.f);
#pragma unroll
        for (int j = 0; j < 4; ++j) { const unsigned w = yp[64 * j]; const f32x2 lo = __builtin_amdgcn_cvt_pk_f32_fp8(w, false), hi2 = __builtin_amdgcn_cvt_pk_f32_fp8(w, true);
            f[j].x += g16 * lo.x; f[j].y += g16 * lo.y; f[j].z += g16 * hi2.x; f[j].w += g16 * hi2.y; }
#else
        const u32x2* yp = (const u32x2*)(Y + yrow * DM) + F.lane;
#pragma unroll
        for (int j = 0; j < 4; ++j) { const u32x2 w = yp[64 * j]; f[j].x += g * bflo(w.x); f[j].y += g * bfhi(w.x); f[j].z += g * bflo(w.y); f[j].w += g * bfhi(w.y); }
#endif
    }
}
__device__ __forceinline__ void p_combine_norm(Frame& F, int dry) {
    moe_prefix(F, 0);
    const float* MOD = (const float*)(F.ws + WS_MOD); bf16_t* H = (bf16_t*)(F.ws + (dry ? WS_SCR + 288 * MiB : WS_H)); bf16_t* XR = (bf16_t*)(F.ws + WS_XR); bf16_t* XW = dry ? (bf16_t*)(F.ws + WS_SCR) : XR;
    const int gw = F.bid * 8 + F.wave, NGW = F.G * 8;
    for (int r = gw; r < NTOK; r += NGW) {
        const int b = r / TPB, pos = r - b * TPB, mj = pos < CTXL ? 32 : b;
        f32x4 f[4]; moe_gather_row(F, r, f);
        const u32x2* xr = (const u32x2*)(XR + (size_t)r * DM) + F.lane; u32x2* xw = (u32x2*)(XW + (size_t)r * DM) + F.lane; const f32x4* g2 = (const f32x4*)(MOD + ((size_t)(0 * 33 + mj) * 6 + 5) * 1024) + F.lane;
        f32x4 v[4]; float ss = 0.f;
#pragma unroll
        for (int j = 0; j < 4; ++j) { v[j] = bf4(xr[64 * j]) + g2[64 * j] * f[j]; xw[64 * j] = pk4bf(v[j]); ss += (v[j].x * v[j].x + v[j].y * v[j].y) + (v[j].z * v[j].z + v[j].w * v[j].w); }
        const float rstd = rsqrtf(wave_sum(ss) * (1.f / DM) + EPS);
        const f32x4* sh = (const f32x4*)(MOD + ((size_t)(1 * 33 + mj) * 6 + 0) * 1024) + F.lane; const f32x4* A = (const f32x4*)(MOD + ((size_t)(1 * 33 + mj) * 6 + 1) * 1024) + F.lane;
        f32x4 h[4];
#pragma unroll
        for (int j = 0; j < 4; ++j) h[j] = v[j] * rstd * A[64 * j] + sh[64 * j];
        if constexpr (PROJ1_FP8 != 0) { unsigned* o4 = (unsigned*)((unsigned char*)H + (size_t)r * DM) + F.lane;
#pragma unroll
            for (int j = 0; j < 4; ++j) o4[64 * j] = pk4_fp8(h[j].x * 4.f, h[j].y * 4.f, h[j].z * 4.f, h[j].w * 4.f); }
        else store_h_row(H + (size_t)r * DM, F.lane, h);
    }
}
__device__ __forceinline__ void p_final(Frame& F) {
    moe_prefix(F, 1);
    const float* MOD = (const float*)(F.ws + WS_MOD); const bf16_t* XR = (const bf16_t*)(F.ws + WS_XR);
    const int gw = F.bid * 8 + F.wave, NGW = F.G * 8; const float* pfg = INP(I_FNG);
    for (int q = gw; q < NBATCH * SEQ; q += NGW) {
        const int b = q >> 11, t = q & 2047, r = b * TPB + CTXL + t;
        f32x4 f[4]; moe_gather_row(F, r, f);
        const u32x2* xr = (const u32x2*)(XR + (size_t)r * DM) + F.lane; const f32x4* g2 = (const f32x4*)(MOD + ((size_t)(1 * 33 + b) * 6 + 5) * 1024) + F.lane;
        f32x4 v[4]; float ss = 0.f;
#pragma unroll
        for (int j = 0; j < 4; ++j) { v[j] = bf4(xr[64 * j]) + g2[64 * j] * f[j]; ss += (v[j].x * v[j].x + v[j].y * v[j].y) + (v[j].z * v[j].z + v[j].w * v[j].w); }
        const float rstd = rsqrtf(wave_sum(ss) * (1.f / DM) + EPS);
        const f32x4* fg = (const f32x4*)pfg + F.lane; f32x4* op = (f32x4*)(F.out + (size_t)q * DM) + F.lane;
#pragma unroll
        for (int j = 0; j < 4; ++j) op[64 * j] = v[j] * rstd * fg[64 * j];
    }
}
struct TokIn { u32x4 y[4]; float g[4]; u32x4 x0, x1; };
__device__ __forceinline__ void tok_issue(const Frame& F, const LAS u32x2* tl  , int r, TokIn& t) {
    const LAS int* pb = (const LAS int*)(F.lds + XTRA_OFF + X_PB); const unsigned char* Y = (const unsigned char*)(F.ws + WS_Y);
#pragma unroll
    for (int k = 0; k < 4; ++k) { const u32x2 tt = tl[k]; const int e = (int)(tt.x >> 20), pos = (int)(tt.x & 0xfffffu); t.g[k] = __uint_as_float(tt.y) * (1.f / 16.f);
        t.y[k] = *(const u32x4*)(Y + ((size_t)pb[e] * 256 + pos) * DM + F.lane * 16); }
    const unsigned char* xp = (const unsigned char*)(F.ws + WS_XR) + (size_t)r * (DM * 2) + F.lane * 32; t.x0 = *(const u32x4*)xp; t.x1 = *(const u32x4*)(xp + 16);
}
__device__ __forceinline__ float tok_mix(const TokIn& t, const f32x4 (&g2)[4], float (&v)[16]) {
    float f[16];
#pragma unroll
    for (int i = 0; i < 16; ++i) f[i] = 0.f;
#pragma unroll
    for (int k = 0; k < 4; ++k)
#pragma unroll
        for (int q = 0; q < 4; ++q) { const unsigned w = t.y[k][q]; const f32x2 lo = __builtin_amdgcn_cvt_pk_f32_fp8(w, false), hi2 = __builtin_amdgcn_cvt_pk_f32_fp8(w, true);
            f[4 * q] += t.g[k] * lo.x; f[4 * q + 1] += t.g[k] * lo.y; f[4 * q + 2] += t.g[k] * hi2.x; f[4 * q + 3] += t.g[k] * hi2.y; }
    float ss = 0.f;
#pragma unroll
    for (int i = 0; i < 8; ++i) { const unsigned w = i < 4 ? t.x0[i & 3] : t.x1[i & 3]; v[2 * i] = bflo(w) + g2[(2 * i) >> 2][(2 * i) & 3] * f[2 * i]; v[2 * i + 1] = bfhi(w) + g2[(2 * i + 1) >> 2][(2 * i + 1) & 3] * f[2 * i + 1];
        ss += v[2 * i] * v[2 * i] + v[2 * i + 1] * v[2 * i + 1]; }
    return ss;
}
template <bool FINAL> __device__ __forceinline__ int cmb_row(int q) { return FINAL ? (q >> 11) * TPB + CTXL + (q & 2047) : q; }
template <bool FINAL> __device__ __forceinline__ void tok_compute(const Frame& F, const TokIn& t, int q, const f32x4 (&g2)[4], const f32x4 (&Av)[4], const f32x4 (&shv)[4], unsigned char* XW, unsigned char* H8) {
    float v[16]; const float ss = tok_mix(t, g2, v); LAS char* T = (LAS char*)F.lds + F.wave * 4096;
    if constexpr (!FINAL) { const int r = q;
        u32x4 w0, w1;
#pragma unroll
        for (int i = 0; i < 4; ++i) { w0[i] = cvtpk(v[2 * i], v[2 * i + 1]); w1[i] = cvtpk(v[8 + 2 * i], v[8 + 2 * i + 1]); }
        *(LAS u32x4*)(T + F.lane * 32) = w0; *(LAS u32x4*)(T + F.lane * 32 + 16) = w1;
        const u32x4 a0 = *(const LAS u32x4*)(T + F.lane * 16), a1 = *(const LAS u32x4*)(T + 1024 + F.lane * 16);
        unsigned char* xo = XW + (size_t)r * (DM * 2) + F.lane * 16; *(u32x4*)xo = a0; *(u32x4*)(xo + 1024) = a1;
        const float rstd = rsqrtf(wave_sum(ss) * (1.f / DM) + EPS);
        u32x4 hw;
#pragma unroll
        for (int i = 0; i < 4; ++i) hw[i] = pk4_fp8((v[4 * i] * rstd * Av[i].x + shv[i].x) * 4.f, (v[4 * i + 1] * rstd * Av[i].y + shv[i].y) * 4.f, (v[4 * i + 2] * rstd * Av[i].z + shv[i].z) * 4.f, (v[4 * i + 3] * rstd * Av[i].w + shv[i].w) * 4.f);
        *(u32x4*)(H8 + (size_t)r * DM + F.lane * 16) = hw;
    } else {
        const float rstd = rsqrtf(wave_sum(ss) * (1.f / DM) + EPS);
#pragma unroll
        for (int i = 0; i < 4; ++i) *(LAS f32x4*)(T + F.lane * 64 + i * 16) = (f32x4){v[4 * i] * rstd * Av[i].x, v[4 * i + 1] * rstd * Av[i].y, v[4 * i + 2] * rstd * Av[i].z, v[4 * i + 3] * rstd * Av[i].w};
        float* op = F.out + (size_t)q * DM + F.lane * 4;
#pragma unroll
        for (int j = 0; j < 4; ++j) { const f32x4 a = *(const LAS f32x4*)(T + j * 1024 + F.lane * 16); *(f32x4*)(op + j * 256) = a; }
    }
}
template <bool FINAL> __device__ __forceinline__ void p_combine_v2(Frame& F, int dry) {
    moe_prefix(F, FINAL ? 1 : 0);
    const float* MOD = (const float*)(F.ws + WS_MOD);
    unsigned char* H8 = (unsigned char*)(F.ws + (dry ? WS_SCR + 288 * MiB : WS_H)); unsigned char* XW = (unsigned char*)(F.ws + (dry ? WS_SCR : WS_XR));
    const int NQ = FINAL ? NBATCH * SEQ : NTOK, RPW = (NQ + F.G - 1) / F.G, q_first = F.bid * RPW, q_last = (q_first + RPW < NQ) ? q_first + RPW : NQ;
    LAS u32x4* tl4 = (LAS u32x4*)(F.lds + XTRA_OFF + 1024); const u32x4* tg = (const u32x4*)(F.ws + WS_TOKI);
    for (int i = F.tid; i < (q_last - q_first) * 2; i += 512) tl4[i] = tg[(size_t)cmb_row<FINAL>(q_first + (i >> 1)) * 2 + (i & 1)];
    __syncthreads();
    const LAS u32x2* tl = (const LAS u32x2*)tl4;
    int qa = q_first;
    while (qa < q_last) {
        int mj, qb;
        if constexpr (FINAL) { const int b = qa >> 11; mj = b; qb = (b + 1) << 11; }
        else { const int b = qa / TPB, pos = qa - b * TPB; const bool cx = pos < CTXL; mj = cx ? 32 : b; qb = cx ? b * TPB + CTXL : (b + 1) * TPB; }
        qb = qb < q_last ? qb : q_last;
        f32x4 g2[4], Av[4], shv[4];
        { const f32x4* pg = (const f32x4*)(MOD + ((size_t)((FINAL ? 1 : 0) * 33 + mj) * 6 + 5) * 1024) + F.lane * 4;
          const f32x4* pa = FINAL ? (const f32x4*)INP(I_FNG) + F.lane * 4 : (const f32x4*)(MOD + ((size_t)(1 * 33 + mj) * 6 + 1) * 1024) + F.lane * 4;
          const f32x4* ps = (const f32x4*)(MOD + ((size_t)(1 * 33 + mj) * 6 + 0) * 1024) + F.lane * 4;
#pragma unroll
          for (int i = 0; i < 4; ++i) { g2[i] = pg[i]; Av[i] = pa[i]; shv[i] = FINAL ? (f32x4){0.f, 0.f, 0.f, 0.f} : ps[i]; } }
        const int q0 = qa + F.wave, n = (qb - q0 + 7) >> 3;
        if (n > 0) {
            TokIn A, B, C; int i = 0;
#define CMB_ISSUE(T_, idx) do { const int i_ = (idx) < n ? (idx) : n - 1, q_ = q0 + 8 * i_; tok_issue(F, tl + (q_ - q_first) * 4, cmb_row<FINAL>(q_), T_); __builtin_amdgcn_sched_barrier(0); } while (0)
#define CMB_COMP(T_, idx) do { tok_compute<FINAL>(F, T_, q0 + 8 * (idx), g2, Av, shv, XW, H8); __builtin_amdgcn_sched_barrier(0); } while (0)
            CMB_ISSUE(A, 0); CMB_ISSUE(B, 1);
            for (; i + 3 <= n; i += 3) {
                CMB_ISSUE(C, i + 2); CMB_COMP(A, i);
                CMB_ISSUE(A, i + 3); CMB_COMP(B, i + 1);
                CMB_ISSUE(B, i + 4); CMB_COMP(C, i + 2);
            }
            if (i < n) CMB_COMP(A, i);
            if (i + 1 < n) CMB_COMP(B, i + 1);
#undef CMB_ISSUE
#undef CMB_COMP
        }
        qa = qb;
    }
}
__device__ __forceinline__ void top4_of16(float (&v)[16], int hi, float (&tv)[4], int (&te)[4]) {
#pragma unroll
    for (int k = 0; k < 4; ++k) { float best = v[0]; int bi = 0;
#pragma unroll
        for (int r = 1; r < 16; ++r) { const bool bt = v[r] > best; best = bt ? v[r] : best; bi = bt ? r : bi; }
        tv[k] = best; te[k] = (bi & 3) + 8 * (bi >> 2) + 4 * hi;
#pragma unroll
        for (int r = 0; r < 16; ++r) v[r] = (r == bi) ? -3.0e38f : v[r]; }
}
template <int LAYER> __device__ __forceinline__ void p_norm_router(Frame& F, int dry) {
    const float* MOD = (const float*)(F.ws + WS_MOD); bf16_t* H = (bf16_t*)(F.ws + WS_H); const bf16_t* XR = (const bf16_t*)(F.ws + WS_XR);
    LAS f32x4* WL4 = (LAS f32x4*)F.lds;
    LAS int* hist = (LAS int*)(F.lds + XTRA_OFF + X_HIST); LAS int* base = (LAS int*)(F.lds + XTRA_OFF + X_BASE); LAS u32x2* sel = (LAS u32x2*)(F.lds + XTRA_OFF + X_SEL);
    LAS f32x4* A2L4 = (LAS f32x4*)(F.lds + XTRA_OFF + X_A2); LAS float* CBL = (LAS float*)(F.lds + XTRA_OFF + X_CB); LAS float* RSL = (LAS float*)(F.lds + XTRA_OFF + X_RS);
    unsigned* gcnt = (unsigned*)(F.ws + WS_CTL) + CW_CNT + LAYER * 64 + (dry ? 128 : 0);
    int* rowl = (int*)(F.ws + WS_ROWL); u32x2* toki = (u32x2*)(F.ws + WS_TOKI);
    const f32x4* wsrc = (const f32x4*)(F.ws + WS_WRT + (size_t)LAYER * 32 * 1024 * 4);
    __syncthreads();
    for (int u = F.tid; u < 8192; u += 512) { const int e = u >> 8, k4 = u & 255; WL4[e * 256 + (k4 ^ (e & 15))] = wsrc[u]; }
    if (F.tid < 32) hist[F.tid] = 0;
    const int lane = F.lane, r32 = lane & 31, hi = lane >> 5; const float* prb = INP(I_RB);
    constexpr int NP = LAYER == 0 ? NPAN : 256;
    for (int pi = F.bid; pi < NP; pi += F.G) {
        const int pan = LAYER == 0 ? pi : pi + pi / 8 + 1;
        const int b = pan / 9, mj = (pan % 9 == 0) ? 32 : b;
        const f32x4* shp = (const f32x4*)(MOD + ((size_t)(LAYER * 33 + mj) * 6 + 3) * 1024); const f32x4* Ap = (const f32x4*)(MOD + ((size_t)(LAYER * 33 + mj) * 6 + 4) * 1024);
        __syncthreads();
        if (F.tid < 256) A2L4[F.tid] = Ap[F.tid];
        {
            const int e = F.tid >> 4, part = F.tid & 15; float sum = 0.f;
#pragma unroll 4
            for (int q = 0; q < 16; ++q) { const f32x4 a = shp[part * 16 + q], w = wsrc[e * 256 + part * 16 + q]; sum += (a.x * w.x + a.y * w.y) + (a.z * w.z + a.w * w.w); }
            sum += xf1(sum); sum += xf2(sum); sum += xf4(sum); sum += xf8(sum);
            if (part == 0) CBL[e] = sum + prb[LAYER * 32 + e];
        }
        __syncthreads();
        const int row = pan * 256 + F.wave * 32 + r32;
        const u32x2* xp = (const u32x2*)(XR + (size_t)row * DM) + hi;
        const LAS f32x4* wrow = WL4 + r32 * 256; const int swz = r32 & 15;
        f32x16 acc = {}; float ssq = 0.f;
#define RT_LOAD(dst, mb) do { _Pragma("unroll") for (int u = 0; u < 8; ++u) dst[u] = xp[2 * ((mb) + u)]; } while (0)
#define RT_COMP(src, mb) do { _Pragma("unroll") for (int u = 0; u < 8; ++u) { const int k4 = 2 * ((mb) + u) + hi; const f32x4 a4 = A2L4[k4], w4 = wrow[k4 ^ swz]; const f32x4 x = bf4(src[u]); \
                ssq += (x.x * x.x + x.y * x.y) + (x.z * x.z + x.w * x.w); \
                acc = __builtin_amdgcn_mfma_f32_32x32x2f32(w4.x, x.x * a4.x, acc, 0, 0, 0); acc = __builtin_amdgcn_mfma_f32_32x32x2f32(w4.y, x.y * a4.y, acc, 0, 0, 0); \
                acc = __builtin_amdgcn_mfma_f32_32x32x2f32(w4.z, x.z * a4.z, acc, 0, 0, 0); acc = __builtin_amdgcn_mfma_f32_32x32x2f32(w4.w, x.w * a4.w, acc, 0, 0, 0); } } while (0)
        u32x2 xa[8], xb[8];
        RT_LOAD(xa, 0);
#pragma unroll 1
        for (int m0 = 0; m0 < 128; m0 += 16) {
            RT_LOAD(xb, m0 + 8); SBAR();
            RT_COMP(xa, m0); SBAR();
            if (m0 + 16 < 128) RT_LOAD(xa, m0 + 16);
            SBAR(); RT_COMP(xb, m0 + 8); SBAR();
        }
#undef RT_LOAD
#undef RT_COMP
        const float rstd = rsqrtf(sum32(ssq, ssq) * (1.f / DM) + EPS);
        float lg[16];
#pragma unroll
        for (int r = 0; r < 16; ++r) lg[r] = acc[r] * rstd + CBL[(r & 3) + 8 * (r >> 2) + 4 * hi];
        float tv[4], pv[4]; int te[4], pe[4];
        top4_of16(lg, hi, tv, te);
#pragma unroll
        for (int k = 0; k < 4; ++k) { pv[k] = __uint_as_float(xu32(__float_as_uint(tv[k]), lane)); pe[k] = (int)xu32((unsigned)te[k], lane); }
        float cv[8] = {tv[0], tv[1], tv[2], tv[3], pv[0], pv[1], pv[2], pv[3]}; int ce[8] = {te[0], te[1], te[2], te[3], pe[0], pe[1], pe[2], pe[3]};
        float gv[4]; int ge[4];
#pragma unroll
        for (int k = 0; k < 4; ++k) { float best = cv[0]; int be = ce[0];
#pragma unroll
            for (int c = 1; c < 8; ++c) { const bool bt = cv[c] > best || (cv[c] == best && ce[c] < be); best = bt ? cv[c] : best; be = bt ? ce[c] : be; }
            gv[k] = best; ge[k] = be;
#pragma unroll
            for (int c = 0; c < 8; ++c) cv[c] = (ce[c] == be) ? -3.0e38f : cv[c]; }
        const float x1 = __expf(gv[1] - gv[0]), x2 = __expf(gv[2] - gv[0]), x3 = __expf(gv[3] - gv[0]); const float inv = 1.f / (1.f + x1 + x2 + x3);
        {
            const int ea = hi ? ge[2] : ge[0], eb = hi ? ge[3] : ge[1]; const float ga = hi ? x2 * inv : inv, gb = hi ? x3 * inv : x1 * inv;
            const int ra = __hip_atomic_fetch_add(hist + ea, 1, __ATOMIC_RELAXED, __HIP_MEMORY_SCOPE_WORKGROUP), rb2 = __hip_atomic_fetch_add(hist + eb, 1, __ATOMIC_RELAXED, __HIP_MEMORY_SCOPE_WORKGROUP);
            const int rl = F.wave * 32 + r32;
            sel[rl * 4 + 2 * hi] = (u32x2){(unsigned)ea | ((unsigned)ra << 8), __float_as_uint(ga)}; sel[rl * 4 + 2 * hi + 1] = (u32x2){(unsigned)eb | ((unsigned)rb2 << 8), __float_as_uint(gb)};
            if (hi == 0) RSL[rl] = rstd;
        }
        {
            f32x4 Ar[4], Sr[4];
#pragma unroll
            for (int j = 0; j < 4; ++j) { Ar[j] = Ap[lane + 64 * j]; Sr[j] = shp[lane + 64 * j]; }
            for (int rr = 0; rr < 32; rr += 4) {
                const int rw = pan * 256 + F.wave * 32 + rr; f32x4 v[4][4];
#pragma unroll
                for (int t = 0; t < 4; ++t) { const u32x2* xr = (const u32x2*)(XR + (size_t)(rw + t) * DM) + lane;
#pragma unroll
                    for (int j = 0; j < 4; ++j) v[t][j] = bf4(xr[64 * j]); }
#pragma unroll
                for (int t = 0; t < 4; ++t) { const float rs = RSL[F.wave * 32 + rr + t]; f32x4 h[4];
#pragma unroll
                    for (int j = 0; j < 4; ++j) h[j] = v[t][j] * rs * Ar[j] + Sr[j];
                    if constexpr (MOE_FP8 != 0) { unsigned* o4 = (unsigned*)((unsigned char*)H + (size_t)(rw + t) * DM) + lane;
#pragma unroll
                        for (int j = 0; j < 4; ++j) o4[64 * j] = pk4_fp8(h[j].x * 4.f, h[j].y * 4.f, h[j].z * 4.f, h[j].w * 4.f); }
                    else store_h_row(H + (size_t)(rw + t) * DM, lane, h); }
            }
        }
        __syncthreads();
        if (F.tid < 32) { const int c = hist[F.tid]; base[F.tid] = c ? (int)__hip_atomic_fetch_add(gcnt + F.tid, (unsigned)c, __ATOMIC_RELAXED, __HIP_MEMORY_SCOPE_AGENT) : 0; }
        __syncthreads();
        for (int u = F.tid; u < 1024; u += 512) { const u32x2 sv = sel[u]; const int e = (int)(sv.x & 0xffu), pos = base[e] + (int)(sv.x >> 8), r = pan * 256 + (u >> 2);
            rowl[(size_t)e * ROWCAP + pos] = r; toki[(size_t)r * 4 + (u & 3)] = (u32x2){((unsigned)e << 20) | (unsigned)pos, sv.y}; }
        __syncthreads();
        if (F.tid < 32) hist[F.tid] = 0;
    }
    __syncthreads();
}

__device__ __forceinline__ void p_moe_gather(Frame& F, int layer) {
    moe_prefix(F, layer);
    const LAS int* pb = (const LAS int*)(F.lds + XTRA_OFF + X_PB); const LAS int* cn = (const LAS int*)(F.lds + XTRA_OFF + X_CNT);
    const unsigned char* H8 = (const unsigned char*)(F.ws + WS_H); unsigned char* XS = (unsigned char*)(F.ws + WS_XS); const int* rowl = (const int*)(F.ws + WS_ROWL);
    const int nblk = pb[32];
    for (int blk = F.bid; blk < nblk; blk += F.G) {
        int e = 0;
#pragma unroll
        for (int st = 16; st >= 1; st >>= 1) { if (pb[e + st] <= blk) e += st; }
        const int rb = blk - pb[e], n = cn[e] - rb * 256;
        const int* rl = rowl + (size_t)e * ROWCAP + rb * 256 + F.wave * 32;
#pragma unroll 1
        for (int r0 = 0; r0 < 32; r0 += 8) {
            u32x4 v[8]; int tok[8];
#pragma unroll
            for (int q = 0; q < 8; ++q) { const int ri = F.wave * 32 + r0 + q; tok[q] = ri < n ? rl[r0 + q] : -1; }
#pragma unroll
            for (int q = 0; q < 8; ++q) if (tok[q] >= 0) v[q] = *(const u32x4*)(H8 + (size_t)tok[q] * 1024 + F.lane * 16);
#pragma unroll
            for (int q = 0; q < 8; ++q) if (tok[q] >= 0) *(u32x4*)(XS + ((size_t)blk * 256 + F.wave * 32 + r0 + q) * 1024 + F.lane * 16) = v[q];
        }
    }
}

__device__ __forceinline__ void p_qk_prep(Frame& F) {
    bf16_t* P = (bf16_t*)(F.ws + WS_PBUF); const f32x2* tab = (const f32x2*)(F.ws + WS_TABG); unsigned char* KC8 = (unsigned char*)(F.ws + WS_KC8); unsigned char* VC8 = (unsigned char*)(F.ws + WS_VC8); (void)KC8; (void)VC8;
    const int lane = F.lane, sub = lane >> 4, a = lane & 15, gw = F.bid * 8 + F.wave, NGW = F.G * 8;
    const float* pq = INP(I_GQG); const float* pk = INP(I_GKG);
    float gq[8], gk[8], gqp[8], gkp[8];
#pragma unroll
    for (int j = 0; j < 8; ++j) { gq[j] = pq[8 * a + j]; gk[j] = pk[8 * a + j]; gqp[j] = pq[8 * (a ^ 4) + j]; gkp[j] = pk[8 * (a ^ 4) + j]; }
    const bool isx2 = (a & 4) != 0; const int fi = 8 * (a & 3);
    LAS f32x4* ltab = (LAS f32x4*)F.lds; { const f32x4* gt = (const f32x4*)tab; for (int u = F.tid; u < 64 * 32 / 2; u += 512) ltab[u] = gt[u]; } __syncthreads();
    for (int rp0 = gw; rp0 < NTOK / 2; rp0 += 3 * NGW) {
        u32x4 wl[3][4];
#pragma unroll
        for (int h = 0; h < 3; ++h) { const int rp = rp0 + h * NGW; if (rp < NTOK / 2) {
#pragma unroll
            for (int g = 0; g < ((ATT_KV8IN && ATT_PV_FP8 && GQA_QK_FP8) ? 4 : 3); ++g) { int it = g * 4 + sub, hi6, s;
                if constexpr (ATT_KV8IN && ATT_PV_FP8 && GQA_QK_FP8) { hi6 = it >> 3; s = it & 7; } else { hi6 = it >= 6 ? 1 : 0; s = it - 6 * hi6; }
                wl[h][g] = *(const u32x4*)(P + (size_t)(rp * 2 + hi6) * 2048 + 1024 + s * 128 + 8 * a); } } }
        __builtin_amdgcn_sched_barrier(0);
#pragma unroll
        for (int h = 0; h < 3; ++h) { const int rp = rp0 + h * NGW; if (rp < NTOK / 2) {
#pragma unroll
        for (int g = 0; g < ((ATT_KV8IN && ATT_PV_FP8 && GQA_QK_FP8) ? 4 : 3); ++g) {
            int it = g * 4 + sub, hi6, s;
            if constexpr (ATT_KV8IN && ATT_PV_FP8 && GQA_QK_FP8) { hi6 = it >> 3; s = it & 7; } else { hi6 = it >= 6 ? 1 : 0; s = it - 6 * hi6; }
            const int r = rp * 2 + hi6;
            const int b = r / TPB, pos = r - b * TPB; const bool lat = pos >= CTXL; const int t = pos - CTXL;
            bf16_t* ptr = P + (size_t)r * 2048 + 1024 + s * 128 + 8 * a;
            const u32x4 w = wl[h][g]; u32x4 wp;
#pragma unroll
            for (int q = 0; q < 4; ++q) wp[q] = (unsigned)__shfl_xor((int)w[q], 4);
            float x[8], xp[8];
#pragma unroll
            for (int q = 0; q < 4; ++q) { x[2 * q] = bflo(w[q]); x[2 * q + 1] = bfhi(w[q]); xp[2 * q] = bflo(wp[q]); xp[2 * q + 1] = bfhi(wp[q]); }
            float ss = 0.f;
#pragma unroll
            for (int j = 0; j < 8; ++j) ss += x[j] * x[j];
            ss += __shfl_xor(ss, 1); ss += __shfl_xor(ss, 2); ss += __shfl_xor(ss, 4); ss += __shfl_xor(ss, 8);
            const float rstd = rsqrtf(ss * (1.f / 128.f) + EPS); const bool isq = s < 4;
            float o[8];
#pragma unroll
            for (int j = 0; j < 8; ++j) { o[j] = x[j] * rstd * (isq ? gq[j] : gk[j]); xp[j] = xp[j] * rstd * (isq ? gqp[j] : gkp[j]); }
            if (lat) {
                const int pp = (a & 8) ? (t & 63) : (t >> 6); const LAS f32x4* tp = ltab + ((pp * 32 + fi) >> 1);
#pragma unroll
                for (int q = 0; q < 4; ++q) { const f32x4 cs = tp[q];
                    const float s0 = isx2 ? cs.y : -cs.y, s1 = isx2 ? cs.w : -cs.w;
                    o[2 * q] = o[2 * q] * cs.x + xp[2 * q] * s0; o[2 * q + 1] = o[2 * q + 1] * cs.z + xp[2 * q + 1] * s1; }
            }
            if constexpr (ATT_KV8IN && ATT_PV_FP8 && GQA_QK_FP8) {
                if (s < 4) {
                    if constexpr (QC8_FP8 != 0 && ATT_FOLD != 0) { constexpr float QM = att::Cfg<128>::SCALE * 1.4426950408889634f * 32.f; u32x2 w8; w8.x = pk4_fp8(o[0] * QM, o[1] * QM, o[2] * QM, o[3] * QM); w8.y = pk4_fp8(o[4] * QM, o[5] * QM, o[6] * QM, o[7] * QM);
                        *(u32x2*)((unsigned char*)(F.ws + WS_QC8) + (size_t)r * 512 + s * 128 + 8 * a) = w8; }
                    else { u32x4 wo; wo.x = cvtpk(o[0], o[1]); wo.y = cvtpk(o[2], o[3]); wo.z = cvtpk(o[4], o[5]); wo.w = cvtpk(o[6], o[7]); *(u32x4*)ptr = wo; } }
                else if (s < 6) { u32x2 w8; w8.x = pk4_fp8(o[0] * 4.f, o[1] * 4.f, o[2] * 4.f, o[3] * 4.f); w8.y = pk4_fp8(o[4] * 4.f, o[5] * 4.f, o[6] * 4.f, o[7] * 4.f); *(u32x2*)(KC8 + (size_t)r * 256 + (s - 4) * 128 + 8 * a) = w8; }
                else { u32x2 w8; w8.x = pk4_fp8(x[0] * 4.f, x[1] * 4.f, x[2] * 4.f, x[3] * 4.f); w8.y = pk4_fp8(x[4] * 4.f, x[5] * 4.f, x[6] * 4.f, x[7] * 4.f); *(u32x2*)(VC8 + (size_t)r * 256 + (s - 6) * 128 + 8 * a) = w8; }
            } else {
            u32x4 wo; wo.x = cvtpk(o[0], o[1]); wo.y = cvtpk(o[2], o[3]); wo.z = cvtpk(o[4], o[5]); wo.w = cvtpk(o[6], o[7]);
            *(u32x4*)ptr = wo; }
        } } }
    }
}
__device__ __forceinline__ u32x2 fp8x4_to_bf16(unsigned w) { const f32x2 a = __builtin_amdgcn_cvt_pk_f32_fp8(w, false), b = __builtin_amdgcn_cvt_pk_f32_fp8(w, true); return (u32x2){cvtpk(a.x * 0.125f, a.y * 0.125f), cvtpk(b.x * 0.125f, b.y * 0.125f)}; }
__device__ __forceinline__ u32x4 fp8x8_to_bf16(u32x2 w) { const u32x2 l = fp8x4_to_bf16(w.x), h = fp8x4_to_bf16(w.y); return (u32x4){l.x, l.y, h.x, h.y}; }
__device__ __forceinline__ void p_mla_prep(Frame& F) {
    bf16_t* P = (bf16_t*)(F.ws + WS_PBUF); bf16_t* KR = (bf16_t*)(F.ws + WS_KRB); const f32x2* tab = (const f32x2*)(F.ws + WS_TABM);
    const int gw = F.bid * 8 + F.wave, NGW = F.G * 8, lane = F.lane;
    const float* pqg = INP(I_MLAQG); const float* pkg = INP(I_MLAKVG);
    float qg[8], kg[4];
#pragma unroll
    for (int j = 0; j < 8; ++j) qg[j] = pqg[8 * lane + j];
#pragma unroll
    for (int j = 0; j < 4; ++j) kg[j] = pkg[4 * lane + j];
    const int krow = (lane >> 3) & 3, ka = lane & 7; const bool kx2 = (ka & 2) != 0; const int kfi = 8 * (ka & 1);
    LAS f32x4* ltab = (LAS f32x4*)F.lds; { const f32x4* gt = (const f32x4*)tab; for (int u = F.tid; u < 64 * 16 / 2; u += 512) ltab[u] = gt[u]; } __syncthreads();
    for (int r0 = gw * 4; r0 < NTOK; r0 += NGW * 4) {
        const int b = r0 / TPB, pos0 = r0 - b * TPB; const bool lat = pos0 >= CTXL;
        u32x4 wq[4]; u32x2 wk[4];
#pragma unroll
        for (int rr = 0; rr < 4; ++rr) {
            if constexpr (PBUF1_FP8 != 0) { const unsigned char* b8 = (const unsigned char*)P + (size_t)(r0 + rr) * 1024; wk[rr] = fp8x4_to_bf16(*(const unsigned*)(b8 + 512 + 4 * lane)); if (lat) wq[rr] = fp8x8_to_bf16(*(const u32x2*)(b8 + 8 * lane)); }
            else { const bf16_t* base = P + (size_t)(r0 + rr) * 1024; wk[rr] = *(const u32x2*)(base + 512 + 4 * lane); if (lat) wq[rr] = *(const u32x4*)(base + 8 * lane); } }
        u32x4 wr = (u32x4){0u, 0u, 0u, 0u};
        if (lane < 32) { if constexpr (PBUF1_FP8 != 0) wr = fp8x8_to_bf16(*(const u32x2*)((const unsigned char*)P + (size_t)(r0 + krow) * 1024 + 768 + 8 * ka)); else wr = *(const u32x4*)(P + (size_t)(r0 + krow) * 1024 + 768 + 8 * ka); }
        if (lat) {
#pragma unroll
            for (int rr = 0; rr < 4; ++rr) { float x[8];
#pragma unroll
                for (int q = 0; q < 4; ++q) { x[2 * q] = bflo(wq[rr][q]); x[2 * q + 1] = bfhi(wq[rr][q]); }
                float ss = 0.f;
#pragma unroll
                for (int j = 0; j < 8; ++j) ss += x[j] * x[j];
                const float rstd = rsqrtf(wave_sum(ss) * (1.f / 512.f) + EPS);
                if constexpr (UPQ_FP8 != 0) { const float s4 = rstd * 4.f; u32x2 w8; w8.x = pk4_fp8(x[0] * s4 * qg[0], x[1] * s4 * qg[1], x[2] * s4 * qg[2], x[3] * s4 * qg[3]); w8.y = pk4_fp8(x[4] * s4 * qg[4], x[5] * s4 * qg[5], x[6] * s4 * qg[6], x[7] * s4 * qg[7]);
                    *(u32x2*)((unsigned char*)(F.ws + WS_CQ8) + (size_t)(r0 + rr) * 512 + 8 * lane) = w8; }
                else { u32x4 w;
#pragma unroll
                    for (int q = 0; q < 4; ++q) w[q] = cvtpk(x[2 * q] * rstd * qg[2 * q], x[2 * q + 1] * rstd * qg[2 * q + 1]);
                    *(u32x4*)(P + (size_t)(r0 + rr) * 1024 + 8 * lane) = w; } }
        }
#pragma unroll
        for (int rr = 0; rr < 4; ++rr) { const float x0 = bflo(wk[rr].x), x1 = bfhi(wk[rr].x), x2 = bflo(wk[rr].y), x3 = bfhi(wk[rr].y);
            const float rstd = rsqrtf(wave_sum((x0 * x0 + x1 * x1) + (x2 * x2 + x3 * x3)) * (1.f / 256.f) + EPS);
            if constexpr (UPKV_FP8 != 0) { const float s4 = rstd * 4.f; *(unsigned*)((unsigned char*)(F.ws + WS_CKV8) + (size_t)(r0 + rr) * 256 + 4 * lane) = pk4_fp8(x0 * s4 * kg[0], x1 * s4 * kg[1], x2 * s4 * kg[2], x3 * s4 * kg[3]); }
            else { u32x2 w; w.x = cvtpk(x0 * rstd * kg[0], x1 * rstd * kg[1]); w.y = cvtpk(x2 * rstd * kg[2], x3 * rstd * kg[3]);
                *(u32x2*)(P + (size_t)(r0 + rr) * 1024 + 512 + 4 * lane) = w; } }
        {
            u32x4 wp;
#pragma unroll
            for (int q = 0; q < 4; ++q) wp[q] = (unsigned)__shfl_xor((int)wr[q], 2);
            float o[8], xp[8];
#pragma unroll
            for (int q = 0; q < 4; ++q) { o[2 * q] = bflo(wr[q]); o[2 * q + 1] = bfhi(wr[q]); xp[2 * q] = bflo(wp[q]); xp[2 * q + 1] = bfhi(wp[q]); }
            if (lat) { const int t = pos0 + krow - CTXL, pp = (ka & 4) ? (t & 63) : (t >> 6); const LAS f32x4* tp = ltab + ((pp * 16 + kfi) >> 1);
#pragma unroll
                for (int q = 0; q < 4; ++q) { const f32x4 cs = tp[q]; const float s0 = kx2 ? cs.y : -cs.y, s1 = kx2 ? cs.w : -cs.w;
                    o[2 * q] = o[2 * q] * cs.x + xp[2 * q] * s0; o[2 * q + 1] = o[2 * q + 1] * cs.z + xp[2 * q + 1] * s1; } }
            u32x4 wo; wo.x = cvtpk(o[0], o[1]); wo.y = cvtpk(o[2], o[3]); wo.z = cvtpk(o[4], o[5]); wo.w = cvtpk(o[6], o[7]);
            if (lane < 32) { if constexpr (ATT_KV8IN && ATT_PV_FP8 && MLA_QK_FP8) { u32x2 w8; w8.x = pk4_fp8(o[0] * 4.f, o[1] * 4.f, o[2] * 4.f, o[3] * 4.f); w8.y = pk4_fp8(o[4] * 4.f, o[5] * 4.f, o[6] * 4.f, o[7] * 4.f); *(u32x2*)((unsigned char*)(F.ws + WS_KR8) + (size_t)(r0 + krow) * 64 + 8 * ka) = w8; }
                else *(u32x4*)(KR + (size_t)(r0 + krow) * 64 + 8 * ka) = wo; }
        }
    }
}
__device__ __forceinline__ void p_sgu(Frame& F) {
    const bf16_t* P = (const bf16_t*)(F.ws + WS_PBUF); bf16_t* MIX = (bf16_t*)(F.ws + WS_MIX0); const bf16_t* SW = (const bf16_t*)(F.ws + WS_SGUW);
    const int tid = F.tid, lane = F.lane, wid = F.wave, hw = wid >> 2, w4 = wid & 3, th = tid & 255, r32 = lane & 31, hi = lane >> 5;
    LAS char* Vl = (LAS char*)F.lds + hw * 32768;
    const int sr = th >> 4, sc = (th & 15) * 8;
    const int vb0 = (int)(unsigned)(uintptr_t)Vl + att::v_rd_base(lane);
    const float* psg = INP(I_SGUNG); const float* psb = INP(I_SGUB);
    for (int U = F.bid; U < (NTOK / 128) * 2; U += F.G) {
        const int chunk = U >> 1, g = (U & 1) * 2 + hw; const size_t row0 = (size_t)chunk * 128;
        float gn[8];
#pragma unroll
        for (int j = 0; j < 8; ++j) gn[j] = psg[g * 128 + sc + j];
        u32x4 zr[8]; LAS char* T = (LAS char*)F.lds + 65536 + wid * 8192;
        if constexpr (SGU_T != 0) {
#pragma unroll
            for (int i = 0; i < 8; ++i) zr[i] = *(const u32x4*)(P + (row0 + 32 * w4 + 4 * i + (lane >> 4)) * 2048 + g * 128 + (lane & 15) * 8);
        }
        __syncthreads();
#pragma unroll
        for (int i = 0; i < 8; ++i) {
            const int q = sr + 16 * i;
            u32x4 w = *(const u32x4*)(P + (row0 + q) * 2048 + 512 + g * 128 + sc); float x[8];
#pragma unroll
            for (int k = 0; k < 4; ++k) { x[2 * k] = bflo(w[k]); x[2 * k + 1] = bfhi(w[k]); }
            float ss = 0.f;
#pragma unroll
            for (int j = 0; j < 8; ++j) ss += x[j] * x[j];
            ss += __shfl_xor(ss, 1); ss += __shfl_xor(ss, 2); ss += __shfl_xor(ss, 4); ss += __shfl_xor(ss, 8);
            const float rstd = rsqrtf(ss * (1.f / 128.f) + EPS);
#pragma unroll
            for (int k = 0; k < 4; ++k) w[k] = cvtpk(x[2 * k] * rstd * gn[2 * k], x[2 * k + 1] * rstd * gn[2 * k + 1]);
            *(LAS u32x4*)(Vl + (q >> 6) * 16384 + att::v_st(q & 63, sc)) = w;
        }
        bf16x8 pa[8];
        const bf16_t* wrow = SW + ((size_t)g * 128 + 32 * w4 + r32) * 128 + 8 * hi;
#pragma unroll
        for (int k = 0; k < 8; ++k) pa[k] = *(const bf16x8*)(wrow + 16 * k);
        __syncthreads();
        f32x16 o[4] = {};
        if constexpr (SGU_T != 0) {
#pragma unroll
            for (int i = 0; i < 8; ++i) { const int R = 4 * i + (lane >> 4); *(LAS u32x4*)(T + R * 256 + (((lane & 15) ^ (R & 15)) << 4)) = zr[i]; }
            att::pv_d0<true>(o, vb0, pa[0], pa[1], pa[2], pa[3]);
            att::pv_d0<true>(o, vb0 + 16384, pa[4], pa[5], pa[6], pa[7]);
            const float bs = psb[g * 128 + 32 * w4 + r32];
            if constexpr (OUT0_FP8 != 0) {
                unsigned ow[4][4];
#pragma unroll
                for (int d0 = 0; d0 < 4; ++d0)
#pragma unroll
                    for (int gq = 0; gq < 4; ++gq) { const u32x2 zz = *(const LAS u32x2*)(T + r32 * 256 + (((d0 * 4 + gq) ^ (r32 & 15)) << 4) + 8 * hi);
                        ow[d0][gq] = pk4_fp8((o[d0][4 * gq] + bs) * bflo(zz.x) * 16.f, (o[d0][4 * gq + 1] + bs) * bfhi(zz.x) * 16.f, (o[d0][4 * gq + 2] + bs) * bflo(zz.y) * 16.f, (o[d0][4 * gq + 3] + bs) * bfhi(zz.y) * 16.f); }
                asm volatile("s_waitcnt lgkmcnt(0)" ::: "memory");
#pragma unroll
                for (int d0 = 0; d0 < 4; ++d0)
#pragma unroll
                    for (int gq = 0; gq < 4; ++gq) *(LAS unsigned*)(T + r32 * 128 + (((d0 * 2 + (gq >> 1)) ^ (r32 & 7)) << 4) + (gq & 1) * 8 + 4 * hi) = ow[d0][gq];
                asm volatile("s_waitcnt lgkmcnt(0)" ::: "memory");
#pragma unroll
                for (int i = 0; i < 4; ++i) { const int R = (lane >> 3) + 8 * i, j = lane & 7; const u32x4 v = *(const LAS u32x4*)(T + R * 128 + ((j ^ (R & 7)) << 4));
                    *(u32x4*)((unsigned char*)MIX + (row0 + 32 * w4 + R) * 1024 + g * 128 + j * 16) = v; }
            } else {
#pragma unroll
            for (int d0 = 0; d0 < 4; ++d0)
#pragma unroll
                for (int gq = 0; gq < 4; ++gq) { LAS u32x2* tp = (LAS u32x2*)(T + r32 * 256 + (((d0 * 4 + gq) ^ (r32 & 15)) << 4) + 8 * hi); const u32x2 zz = *tp;
                    u32x2 wo; wo.x = cvtpk((o[d0][4 * gq] + bs) * bflo(zz.x), (o[d0][4 * gq + 1] + bs) * bfhi(zz.x)); wo.y = cvtpk((o[d0][4 * gq + 2] + bs) * bflo(zz.y), (o[d0][4 * gq + 3] + bs) * bfhi(zz.y)); *tp = wo; }
#pragma unroll
            for (int i = 0; i < 8; ++i) { const int R = 4 * i + (lane >> 4); const u32x4 v = *(const LAS u32x4*)(T + R * 256 + (((lane & 15) ^ (R & 15)) << 4));
                *(u32x4*)(MIX + (row0 + 32 * w4 + R) * 1024 + g * 128 + (lane & 15) * 8) = v; }
            }
        } else {
        att::pv_d0(o, vb0, pa[0], pa[1], pa[2], pa[3]);
        att::pv_d0(o, vb0 + 16384, pa[4], pa[5], pa[6], pa[7]);
#pragma unroll
        for (int r = 0; r < 16; ++r) { const int p = 32 * w4 + att::crow(r, hi); const float bs = psb[g * 128 + p];
#pragma unroll
            for (int d0 = 0; d0 < 4; ++d0) { const int c = d0 * 32 + r32; const float zu = bf2f(P[(row0 + p) * 2048 + g * 128 + c]);
                MIX[(row0 + p) * 1024 + g * 128 + c] = f2bf((o[d0][r] + bs) * zu); } }
        }
    }
    __syncthreads();
}

using pg8::Unit; using pg8::Acc;
struct ProbIn0 {
    static constexpr bool PERM = true, GATHER = false, FP8 = PROJ0_FP8 != 0, P16 = false, MOE = false; static constexpr int KCONST = 0; int K, lda; const bf16_t* A; const bf16_t* Bt; bf16_t* O; pg8::StaticOrder so; int G, c;
    __device__ bool next(int i, Unit& u) const { return so.map((long)i * G + c, u.pm, u.pn); }
    __device__ const void* a_mat() const { return A; } __device__ const void* b_mat() const { return Bt; }
    __device__ unsigned a_off(const Unit& u) const { return (unsigned)u.pm * 256u * (unsigned)lda * 2u; }
    __device__ unsigned b_off(const Unit& u) const { return (unsigned)u.pn * 256u * (unsigned)K * 2u; }
    __device__ void a_voff(const Unit&, unsigned (&)[2][2]) const {}
    __device__ void epi(const Acc& acc, const Unit& u, int wr, int wc, int fr, int fq) const {
        bf16_t* dst = O + (size_t)u.pm * 256 * 2048 + u.pn * 256;
        if (u.pn < 4) pg8::epi_store_bf16<true>(acc, dst, 2048, nullptr, wr, wc, fr, fq, FP8 ? (1.f / 256.f) : 1.f); else pg8::epi_store_bf16<false>(acc, dst, 2048, nullptr, wr, wc, fr, fq, FP8 ? (1.f / 256.f) : 1.f);
    }
};
template <bool LATONLY, bool FP8v = false, int KC = 0, bool O8 = false> struct ProbPlain {
    static constexpr bool PERM = true, GATHER = false, FP8 = FP8v, P16 = O8 && (EPI_P16 != 0), MOE = false; static constexpr int KCONST = KC; int K, lda; const bf16_t* A; const bf16_t* Bt; bf16_t* O; int ldc; pg8::StaticOrder so; int G, c; float osc8 = 4.f;
    __device__ bool next(int i, Unit& u) const { int pm; if (!so.map((long)i * G + c, pm, u.pn)) return false; u.pm = LATONLY ? pm + pm / 8 + 1 : pm; return true; }
    __device__ const void* a_mat() const { return A; } __device__ const void* b_mat() const { return Bt; }
    __device__ unsigned a_off(const Unit& u) const { return (unsigned)u.pm * 256u * (unsigned)lda * 2u; }
    __device__ unsigned b_off(const Unit& u) const { return (unsigned)u.pn * 256u * (unsigned)K * 2u; }
    __device__ void a_voff(const Unit&, unsigned (&)[2][2]) const {}
    __device__ void epi(const Acc& acc, const Unit& u, int wr, int wc, int fr, int fq) const {
        if constexpr (O8) pg8::epi_store_fp8<P16>(acc, (unsigned char*)O + (size_t)u.pm * 256 * ldc + u.pn * 256, ldc, wr, wc, fr, fq, (FP8 ? (1.f / 256.f) : 1.f) * osc8);
        else pg8::epi_store_bf16<false>(acc, O + (size_t)u.pm * 256 * ldc + u.pn * 256, ldc, nullptr, wr, wc, fr, fq, FP8 ? (1.f / 256.f) : 1.f);
    }
};
struct ProbIn1 {
    static constexpr bool PERM = true, GATHER = false, FP8 = PROJ1_FP8 != 0, P16 = (PBUF1_FP8 != 0) && (EPI_P16 != 0), MOE = false; static constexpr int KCONST = 0; int K, lda; const bf16_t* A; const bf16_t* Bt; bf16_t* O; pg8::StaticOrder so; int G, c;
    __device__ bool next(int i, Unit& u) const {
        const long L = (long)i * G + c;
        if (L < 1024) { int pm; so.map(L, pm, u.pn); u.pm = pm + pm / 8 + 1; return true; }
        if (L < 1024 + 64) { const int q = (int)(L - 1024); u.pm = (q >> 1) * 9; u.pn = 2 + (q & 1); return true; }
        return false;
    }
    __device__ const void* a_mat() const { return A; } __device__ const void* b_mat() const { return Bt; }
    __device__ unsigned a_off(const Unit& u) const { return (unsigned)u.pm * 256u * (unsigned)lda * 2u; }
    __device__ unsigned b_off(const Unit& u) const { return (unsigned)u.pn * 256u * (unsigned)K * 2u; }
    __device__ void a_voff(const Unit&, unsigned (&)[2][2]) const {}
    __device__ void epi(const Acc& acc, const Unit& u, int wr, int wc, int fr, int fq) const {
        if constexpr (PBUF1_FP8 != 0) pg8::epi_store_fp8<P16>(acc, (unsigned char*)O + (size_t)u.pm * 256 * 1024 + u.pn * 256, 1024, wr, wc, fr, fq, (FP8 ? (1.f / 256.f) : 1.f) * 8.f);
        else pg8::epi_store_bf16<false>(acc, O + (size_t)u.pm * 256 * 1024 + u.pn * 256, 1024, nullptr, wr, wc, fr, fq, FP8 ? (1.f / 256.f) : 1.f);
    }
};
template <int LAYER> struct ProbOut {
    static constexpr bool PERM = true, GATHER = false, FP8 = (LAYER == 1 ? (OUT1_FP8 != 0) : (OUT0_FP8 != 0)), P16 = false, MOE = false; static constexpr int KCONST = 0; int K, lda; const bf16_t* A; const bf16_t* Bt; bf16_t* XR; const float* MOD; const float* xin; const float* cin; pg8::StaticOrder so; int G, c;
    __device__ __forceinline__ bool next(int i, Unit& u) const { int pm; if (!so.map((long)i * G + c, pm, u.pn)) return false; u.pm = LAYER ? pm + pm / 8 + 1 : pm; return true; }
    __device__ __forceinline__ const void* a_mat() const { return A; } __device__ __forceinline__ const void* b_mat() const { return Bt; }
    __device__ __forceinline__ unsigned a_off(const Unit& u) const { return (unsigned)u.pm * 256u * (unsigned)lda * 2u; }
    __device__ __forceinline__ unsigned b_off(const Unit& u) const { return (unsigned)u.pn * 256u * (unsigned)K * 2u; }
    __device__ __forceinline__ void a_voff(const Unit&, unsigned (&)[2][2]) const {}
    __device__ __forceinline__ void epi(const Acc& acc, const Unit& u, int wr, int wc, int fr, int fq) const {
        const int b = u.pm / 9, jj = u.pm % 9, mj = jj == 0 ? 32 : b;
        const float* basef = jj == 0 ? cin + (size_t)b * CTXL * DM : xin + ((size_t)b * SEQ + (jj - 1) * 256) * DM;
        bf16_t* dst = XR + (size_t)u.pm * 256 * DM; const float* gate = MOD + ((size_t)(LAYER * 33 + mj) * 6 + 2) * 1024;
        const int row0 = wr * 64 + fr, col0 = u.pn * 256 + wc * 32 + 8 * fq;
        f32x4 gv[2][2];
#pragma unroll
        for (int bj = 0; bj < 2; ++bj)
#pragma unroll
            for (int n = 0; n < 2; ++n) gv[bj][n] = *(const f32x4*)(gate + col0 + bj * 128 + 4 * n);
        const unsigned lo = (unsigned)(row0 * DM + col0); constexpr int GD = 4; constexpr float SC = FP8 ? (1.f / 1024.f) : 1.f;
        f32x4 pb0[GD], pb1[GD]; u32x4 pw[GD]; (void)pb0; (void)pb1; (void)pw;
#define PO_LD(slot, g) do { const int ai_ = (g) >> 3, m_ = ((g) >> 1) & 3, bj_ = (g) & 1; const size_t uo_ = (size_t)(ai_ * 128 + m_ * 16) * DM; \
            if constexpr (LAYER == 0) { const char* bp = (const char*)(basef + uo_) + (size_t)(lo + bj_ * 128) * 4u; pb0[slot] = *(const f32x4*)bp; pb1[slot] = *(const f32x4*)(bp + 16); } \
            else pw[slot] = *(const u32x4*)((const char*)(dst + uo_) + (lo + bj_ * 128) * 2u); } while (0)
#pragma unroll
        for (int g = 0; g < GD; ++g) PO_LD(g, g);
#pragma unroll
        for (int g = 0; g < 16; ++g) { const int sl = g % GD, ai = g >> 3, m = (g >> 1) & 3, bj = g & 1; const size_t uo = (size_t)(ai * 128 + m * 16) * DM; f32x4 b0, b1;
            if constexpr (LAYER == 0) { b0 = pb0[sl]; b1 = pb1[sl]; }
            else { const u32x4 w = pw[sl]; b0 = (f32x4){bflo(w.x), bfhi(w.x), bflo(w.y), bfhi(w.y)}; b1 = (f32x4){bflo(w.z), bfhi(w.z), bflo(w.w), bfhi(w.w)}; }
            const f32x4 v0 = b0 + gv[bj][0] * (acc[ai][bj][m][0] * SC), v1 = b1 + gv[bj][1] * (acc[ai][bj][m][1] * SC);
            u32x4 wo; wo.x = cvtpk(v0[0], v0[1]); wo.y = cvtpk(v0[2], v0[3]); wo.z = cvtpk(v1[0], v1[1]); wo.w = cvtpk(v1[2], v1[3]);
            *(u32x4*)((char*)(dst + uo) + (lo + bj * 128) * 2u) = wo;
            if (g + GD < 16) PO_LD(sl, g + GD);
            __builtin_amdgcn_sched_barrier(0); }
#undef PO_LD
    }
};
struct MoeSched {
    const LAS int* pb; const LAS unsigned* bt; int NTN, G, c;
    __device__ bool map(int i, Unit& u) const {
        const int x = c & 7, q = i * (G >> 3) + (c >> 3); const int blk = (q / NTN) * 8 + x; u.pn = q % NTN;
        const unsigned ent = (unsigned)__builtin_amdgcn_readfirstlane((int)bt[blk < BT_N ? blk : BT_N - 1]);
        if (ent == 0xffffffffu) return false;
        u.e = (int)(ent >> 16); u.rb = (int)(ent & 0xffffu); u.pm = blk; return true;
    }
};
struct ProbMoe1 {
    static constexpr bool PERM = true, GATHER = !(MOE_PREGATHER && MOE_FP8), FP8 = MOE_FP8 != 0, P16 = false, MOE = true; static constexpr int KCONST = 0; int K, lda; const bf16_t* H; const bf16_t* W1; const float* B1; bf16_t* ACT; const int* rowl; const LAS int* cnt; MoeSched ms; int wave_s; LAS uchar* stage;
    __device__ bool next(int i, Unit& u) const { return ms.map(i, u); }
    __device__ const void* a_mat() const { return H; } __device__ const void* b_mat() const { return W1; }
    __device__ unsigned a_off(const Unit& u) const { return GATHER ? 0u : (unsigned)u.pm * 256u * 1024u; }
    __device__ unsigned b_off(const Unit& u) const { return ((unsigned)u.e * 2048u + (unsigned)u.pn * 256u) * 1024u * (FP8 ? 1u : 2u); }
    __device__ void a_voff(const Unit& u, unsigned (&vo)[2][2]) const {
        const int n = cnt[u.e]; const int* rl = rowl + (size_t)u.e * ROWCAP + u.rb * 256;
        const int tidg = tid_fresh(wave_s);
#pragma unroll
        for (int i = 0; i < 2; ++i) { int R, C; pg8::stage_rc(tidg * 16 + i * 8192, R, C);
#pragma unroll
            for (int h = 0; h < 2; ++h) { const int ri = h * 128 + R; const int tk = rl[ri]; const int tok = (u.rb * 256 + ri < n) ? tk : 0; vo[h][i] = (unsigned)tok * (FP8 ? 1024u : 2048u) + (unsigned)C * 2u; } }
    }
    __device__ void unit_top(const Unit& cur, const Unit& nx, bool has_next, int wid, int ui) const {
        if (IDX_LDS != 0 && wid == 0 && has_next) { const int ln = tid_fresh(wave_s) & 63;
            __builtin_amdgcn_global_load_lds((const unsigned*)(rowl + (size_t)nx.e * ROWCAP + nx.rb * 256 + ln * 4), (LAS unsigned*)(stage), 16, 0, 0); }
        if (BIAS_LDS != 0 && wid == 1) { const int ln = tid_fresh(wave_s) & 63;
            __builtin_amdgcn_global_load_lds((const unsigned*)(B1 + (size_t)cur.e * 2048 + (ln >> 5) * 1024 + cur.pn * 128 + (ln & 31) * 4), (LAS unsigned*)(stage + 1024 + (ui & 1) * 1024), 16, 0, 0); }
    }
    __device__ void a_voff_next(const Unit& u, unsigned (&vo)[2][2]) const {
        if constexpr (IDX_LDS == 0) { a_voff(u, vo); return; }
        const int n = cnt[u.e]; const volatile LAS int* il = (const volatile LAS int*)stage;
        const int tidg = tid_fresh(wave_s);
#pragma unroll
        for (int i = 0; i < 2; ++i) { int R, C; pg8::stage_rc(tidg * 16 + i * 8192, R, C);
#pragma unroll
            for (int h = 0; h < 2; ++h) { const int ri = h * 128 + R; const int tk = il[ri]; const int tok = (u.rb * 256 + ri < n) ? tk : 0; vo[h][i] = (unsigned)tok * (FP8 ? 1024u : 2048u) + (unsigned)C * 2u; } }
    }
    __device__ void epi(const Acc& acc, const Unit& u, int wr, int wc, int fr, int fq, int ui) const {
        const int row0 = wr * 64 + fr, col0 = u.pn * 128 + wc * 32 + 8 * fq;
        f32x4 bgv[2], blv[2];
        if constexpr (BIAS_LDS != 0) { const LAS float* bb = (const LAS float*)(stage + 1024 + (ui & 1) * 1024) + wc * 32 + 8 * fq;
#pragma unroll
            for (int n = 0; n < 2; ++n) { bgv[n] = *(const LAS f32x4*)(bb + 4 * n); blv[n] = *(const LAS f32x4*)(bb + 128 + 4 * n); } }
        else { const float* bg = B1 + (size_t)u.e * 2048 + col0; const float* bl = bg + 1024;
#pragma unroll
            for (int n = 0; n < 2; ++n) { bgv[n] = *(const f32x4*)(bg + 4 * n); blv[n] = *(const f32x4*)(bl + 4 * n); } }
        constexpr float SC = FP8 ? (1.f / 256.f) : 1.f;
        if constexpr (FP8 && EPI1_PK != 0) { bgv[0] *= 1.702f * 1.4426950408889634f; bgv[1] *= 1.702f * 1.4426950408889634f; }
        bf16_t* dst = ACT + (size_t)u.pm * 256 * 1024; unsigned char* dst8 = (unsigned char*)ACT + (size_t)u.pm * 256 * 1024; const unsigned lane_off = (unsigned)(row0 * 1024 + col0);
        const int tl = tid_fresh(wave_s); const int pc = wc * 4 + fq;
        const unsigned woff = (unsigned)((wr * 64 + fr) * 128 + ((((pc >> 1) ^ (fr & 7)) << 4) | ((pc & 1) << 3)));
        const unsigned roff = (unsigned)((tl >> 3) * 128 + (((tl & 7) ^ ((tl >> 3) & 7)) << 4));
        const unsigned goff = (unsigned)((tl >> 3) * 1024 + (tl & 7) * 16) + (unsigned)(u.pn * 128);
#pragma unroll
        for (int ai = 0; ai < 2; ++ai) {
            if (EPI_LDS1 != 0 && FP8 && ai == 1) { asm volatile("s_waitcnt lgkmcnt(0)" ::: "memory"); __builtin_amdgcn_s_barrier(); }
#pragma unroll
            for (int m = 0; m < 4; ++m) { float a[8];
                if constexpr (FP8 && EPI1_PK != 0) {
                    constexpr float C2 = 1.702f * 1.4426950408889634f, K8 = 8.f / C2;
#pragma unroll
                    for (int n = 0; n < 2; ++n)
#pragma unroll
                        for (int h = 0; h < 2; ++h) { const f32x4 ag = acc[ai][0][m][n], al = acc[ai][1][m][n];
                            f32x2 wv = (f32x2){ag[2 * h], ag[2 * h + 1]} * (SC * C2) + (f32x2){bgv[n][2 * h], bgv[n][2 * h + 1]};
                            wv.x = fminf(wv.x, 7.f * C2); wv.y = fminf(wv.y, 7.f * C2);
                            const f32x2 d = (f32x2){__builtin_amdgcn_exp2f(-wv.x), __builtin_amdgcn_exp2f(-wv.y)} + 1.f;
                            const f32x2 t = wv * (f32x2){__builtin_amdgcn_rcpf(d.x), __builtin_amdgcn_rcpf(d.y)};
                            f32x2 lv = (f32x2){al[2 * h], al[2 * h + 1]} * SC + (f32x2){blv[n][2 * h], blv[n][2 * h + 1]};
                            lv.x = __builtin_amdgcn_fmed3f(lv.x, -7.f, 7.f); lv.y = __builtin_amdgcn_fmed3f(lv.y, -7.f, 7.f);
                            const f32x2 a8 = t * (lv * K8 + K8);
                            a[4 * n + 2 * h] = a8.x; a[4 * n + 2 * h + 1] = a8.y; }
                } else {
#pragma unroll
                for (int n = 0; n < 2; ++n) { const f32x4 g = acc[ai][0][m][n] * SC + bgv[n], l = acc[ai][1][m][n] * SC + blv[n];
#pragma unroll
                    for (int j = 0; j < 4; ++j) { const float gg = fminf(g[j], 7.f), ll = fminf(fmaxf(l[j], -7.f), 7.f);
                        a[4 * n + j] = gg * __builtin_amdgcn_rcpf(1.f + __builtin_amdgcn_exp2f(-1.702f * 1.4426950408889634f * gg)) * (ll + 1.f) * (FP8 ? 8.f : 1.f); } }
                }
                if constexpr (FP8) { u32x2 w; w.x = pk4_fp8_nc(a[0], a[1], a[2], a[3]); w.y = pk4_fp8_nc(a[4], a[5], a[6], a[7]);
                    if constexpr (EPI_LDS1 != 0) *(LAS u32x2*)(stage + woff + m * 2048) = w;
                    else *(u32x2*)(dst8 + (size_t)((ai * 128 + m * 16) * 1024) + lane_off) = w; }
                else { u32x4 w; w.x = cvtpk(a[0], a[1]); w.y = cvtpk(a[2], a[3]); w.z = cvtpk(a[4], a[5]); w.w = cvtpk(a[6], a[7]);
                    *(u32x4*)((char*)dst + (size_t)((ai * 128 + m * 16) * 2048) + lane_off * 2u) = w; } }
            if constexpr (EPI_LDS1 != 0 && FP8) {
                asm volatile("s_waitcnt lgkmcnt(0)" ::: "memory"); __builtin_amdgcn_s_barrier();
                const u32x4 r0 = *(const LAS u32x4*)(stage + roff), r1 = *(const LAS u32x4*)(stage + roff + 64 * 128);
                unsigned char* rowb = (unsigned char*)ACT + (size_t)u.pm * 256 * 1024 + (size_t)(ai * 128) * 1024;
                *(u32x4*)(rowb + goff) = r0; *(u32x4*)(rowb + goff + 64 * 1024) = r1; } }
    }
};
struct ProbMoe2 {
    static constexpr bool PERM = true, GATHER = false, FP8 = MOE_FP8 != 0, P16 = (Y_FP8 != 0) && (EPI_P16 != 0), MOE = true; static constexpr int KCONST = 0; int K, lda; const bf16_t* ACT; const bf16_t* W2; const float* B2; bf16_t* Y; MoeSched ms; int wave_s; LAS uchar* stage;
    __device__ bool next(int i, Unit& u) const { return ms.map(i, u); }
    __device__ const void* a_mat() const { return ACT; } __device__ const void* b_mat() const { return W2; }
    __device__ unsigned a_off(const Unit& u) const { return (unsigned)u.pm * 256u * 1024u * (FP8 ? 1u : 2u); }
    __device__ unsigned b_off(const Unit& u) const { return ((unsigned)u.e * 1024u + (unsigned)u.pn * 256u) * 1024u * (FP8 ? 1u : 2u); }
    __device__ void a_voff(const Unit&, unsigned (&)[2][2]) const {}
    __device__ void unit_top(const Unit& cur, const Unit&, bool, int wid, int ui) const {
        if (BIAS_LDS != 0 && Y_FP8 != 0 && wid == 1) { const int ln = tid_fresh(wave_s) & 63;
            __builtin_amdgcn_global_load_lds((const unsigned*)(B2 + (size_t)cur.e * 1024 + cur.pn * 256 + ln * 4), (LAS unsigned*)(stage + 1024 + (ui & 1) * 1024), 16, 0, 0); }
    }
    __device__ void epi_prefetch(const Unit& nx, bool has_next, int wid) const {
        if (L2PF != 0 && L2PF2 != 0 && FP8 && has_next) { const int ln = tid_fresh(wave_s) & 63;
#pragma unroll
            for (int r = 0; r < 8; ++r)
                __builtin_amdgcn_global_load_lds((const unsigned*)((const unsigned char*)ACT + ((size_t)nx.pm * 256 + nx.pn * 64 + wid * 8 + r) * 1024 + ln * 16), (LAS unsigned*)(stage + 3072 + wid * 1024), 16, 0, 0); }
    }
    __device__ void epi(const Acc& acc, const Unit& u, int wr, int wc, int fr, int fq, int ui) const {
        constexpr float SC = FP8 ? (1.f / 512.f) : 1.f;
#if Y_FP8
        const int row0 = wr * 64 + fr, col0 = P16 ? wc * 64 + 16 * fq : wc * 32 + 8 * fq; const float* bias = B2 + (size_t)u.e * 1024 + u.pn * 256 + col0;
        f32x4 bv[2][2];
#pragma unroll
        for (int bj = 0; bj < 2; ++bj)
#pragma unroll
            for (int n = 0; n < 2; ++n) { if constexpr (BIAS_LDS != 0) bv[bj][n] = *(const LAS f32x4*)((const LAS float*)(stage + 1024 + (ui & 1) * 1024) + col0 + bj * (P16 ? 8 : 128) + 4 * n);
                else bv[bj][n] = *(const f32x4*)(bias + bj * (P16 ? 8 : 128) + 4 * n);
                bv[bj][n] *= 16.f; }
        unsigned char* dst = (unsigned char*)Y + ((size_t)u.pm * 256) * 1024 + u.pn * 256; const unsigned lane_off = (unsigned)(row0 * 1024 + col0);
#pragma unroll
        for (int ai = 0; ai < 2; ++ai)
#pragma unroll
            for (int m = 0; m < 4; ++m) { unsigned char* rowb = dst + (size_t)((ai * 128 + m * 16) * 1024);
                if constexpr (P16) { u32x4 w;
#pragma unroll
                    for (int bj = 0; bj < 2; ++bj) { const f32x4 v0 = acc[ai][bj][m][0] * (SC * 16.f) + bv[bj][0], v1 = acc[ai][bj][m][1] * (SC * 16.f) + bv[bj][1];
                        w[2 * bj] = pk4_fp8(v0[0], v0[1], v0[2], v0[3]); w[2 * bj + 1] = pk4_fp8(v1[0], v1[1], v1[2], v1[3]); }
                    *(u32x4*)(rowb + lane_off) = w; }
                else {
#pragma unroll
                for (int bj = 0; bj < 2; ++bj) { const f32x4 v0 = acc[ai][bj][m][0] * (SC * 16.f) + bv[bj][0], v1 = acc[ai][bj][m][1] * (SC * 16.f) + bv[bj][1];
                    u32x2 w; w.x = pk4_fp8(v0[0], v0[1], v0[2], v0[3]); w.y = pk4_fp8(v1[0], v1[1], v1[2], v1[3]);
                    *(u32x2*)(rowb + lane_off + bj * 128) = w; } } }
#else
        pg8::epi_store_bf16<false>(acc, Y + (size_t)u.pm * 256 * 1024 + u.pn * 256, 1024, B2 + (size_t)u.e * 1024 + u.pn * 256, wr, wc, fr, fq, SC);
#endif
    }
};

__global__ void __launch_bounds__(512, 2) fwd_kernel(Args args) {
    extern __shared__ __attribute__((aligned(16))) uchar lds_raw[];
    const int wave_s = __builtin_amdgcn_readfirstlane((int)threadIdx.x >> 6);
    Frame F; F.lds = (LAS uchar*)lds_raw; F.tid = tid_fresh(wave_s); F.lane = F.tid & 63; F.wave = wave_s; F.G = gridDim.x; F.bid = blockIdx.x;
    F.ws = args.ws; F.out = args.out;
    volatile LAS unsigned* MISC = (volatile LAS unsigned*)(F.lds + MISC_OFF);
    if (F.tid < 64) MISC[F.tid] = 0u;
    __syncthreads();
    unsigned* ctl = (unsigned*)(F.ws + WS_CTL);
    XcdBarrier bar; bar.bar = ctl + CW_BAR; bar.x = 0; bar.st = nullptr;
    const int lo = args.ph_lo, hi = args.ph_hi;
    bar = xcd_barrier_post(ctl + CW_BAR + (lo & 1) * XCD_BAR_WORDS, MISC + 8, F.tid == 0);
#ifndef PHMASK
#define PHMASK 0x7ffff
#endif
#define REFRAME() do { F.tid = tid_fresh(wave_s); F.lane = F.tid & 63; F.wave = wave_s; } while (0)
#define IN(k) (((PHMASK >> (k)) & 1) && lo <= (k) && (k) < hi)
#define SEAM(k) do { if (IN(k) && IN((k) + 1)) { const int t_ = tid_fresh(wave_s); xcd_barrier(bar, t_ == 0); } } while (0)
    uchar* ws = F.ws;
    bf16_t* H = (bf16_t*)(ws + WS_H); bf16_t* XR = (bf16_t*)(ws + WS_XR); const float* MOD = (const float*)(ws + WS_MOD);

#if PROBE_CLK
#define CLK_A(k) do { if ((k) == PROBE_CLK_PH && F.bid == 0 && tid_fresh(wave_s) == 0) { unsigned long long* st_ = (unsigned long long*)(ws + WS_CTL) + (CW_DBG / 2); st_[0] = __builtin_amdgcn_s_memrealtime(); st_[1] = __builtin_amdgcn_s_memtime(); } } while (0)
#define CLK_B(k) do { if ((k) == PROBE_CLK_PH && F.bid == 0 && tid_fresh(wave_s) == 0) { unsigned long long* st_ = (unsigned long long*)(ws + WS_CTL) + (CW_DBG / 2); st_[2] = __builtin_amdgcn_s_memrealtime(); st_[3] = __builtin_amdgcn_s_memtime(); } } while (0)
#else
#define CLK_A(k) do { } while (0)
#define CLK_B(k) do { } while (0)
#endif
    if (IN(0)) { REFRAME(); p0_prologue(F); } SEAM(0);
    if (IN(1)) { REFRAME(); if constexpr (NORM0_V2 != 0 && PROJ0_FP8 == 0) p_norm0_v2(F); else p_norm0(F); } SEAM(1);
    if (IN(2)) { REFRAME(); ProbIn0 p; p.K = PROJ0_FP8 ? 512 : 1024; p.lda = p.K; p.A = H; p.Bt = (const bf16_t*)(ws + WS_WIN0); p.O = (bf16_t*)(ws + WS_PBUF); p.so.init(NPAN, 8); p.G = F.G; p.c = F.bid; pg8::gemm_phase(F.lds, p, wave_s); } SEAM(2);
    if (IN(3)) { REFRAME(); p_qk_prep(F); REFRAME(); p_sgu(F); } SEAM(3);
    if (IN(4)) { REFRAME();
        const bf16_t* P = (const bf16_t*)(ws + WS_PBUF); bf16_t* MIX = (bf16_t*)(ws + WS_MIX0); const unsigned char* KC8 = (const unsigned char*)(ws + WS_KC8); const unsigned char* VC8 = (const unsigned char*)(ws + WS_VC8); (void)KC8; (void)VC8;
        for (int u = F.bid; u < 1024 + 128; u += F.G) {
            if (u < 1024) { const int qb = u & 7, g = (u >> 3) & 1, kvh = (u >> 4) & 1, b = u >> 5, h = kvh * 2 + g; const size_t kr0 = (size_t)b * TPB, qr0 = kr0 + CTXL + qb * 256;
                if constexpr (GQA_QK_FP8 != 0 && ATT_KV8IN && ATT_PV_FP8) att::attn_unit_qk8<128, false, (QC8_FP8 != 0 && ATT_FOLD != 0) ? 512 : 2048, 256, 1024, OUT0_FP8 != 0, (ATT_PV_FP8 != 0), (QC8_FP8 != 0 && ATT_FOLD != 0)>((QC8_FP8 != 0 && ATT_FOLD != 0) ? (const bf16_t*)((const unsigned char*)(ws + WS_QC8) + qr0 * 512 + h * 128) : P + qr0 * 2048 + 1024 + h * 128, (const bf16_t*)(KC8 + kr0 * 256 + kvh * 128), nullptr, (const bf16_t*)(VC8 + kr0 * 256 + kvh * 128), OUT0_FP8 ? (bf16_t*)((unsigned char*)MIX + qr0 * 1024 + 512 + h * 128) : MIX + qr0 * 1024 + 512 + h * 128, TPB, (LAS char*)F.lds, nullptr, 0, wave_s);
                else if constexpr (GQA_QK_FP8 != 0) att::attn_unit_qk8<128, false, 2048, 2048, 1024, false>(P + qr0 * 2048 + 1024 + h * 128, P + kr0 * 2048 + 1536 + kvh * 128, nullptr, P + kr0 * 2048 + 1792 + kvh * 128, MIX + qr0 * 1024 + 512 + h * 128, TPB, (LAS char*)F.lds, nullptr, 0, wave_s);
                else att::attn_unit<128, 2, false, 2048, 2048, 1024>(P + qr0 * 2048 + 1024 + h * 128, P + kr0 * 2048 + 1536 + kvh * 128, nullptr, P + kr0 * 2048 + 1792 + kvh * 128, MIX + qr0 * 1024 + 512 + h * 128, TPB, (LAS char*)F.lds, nullptr, 0, wave_s);
            } else { const int v = u - 1024, h = v & 3, b = v >> 2, kvh = h >> 1; const size_t kr0 = (size_t)b * TPB;
                if constexpr (GQA_QK_FP8 != 0 && ATT_KV8IN && ATT_PV_FP8) att::attn_unit_qk8<128, false, (QC8_FP8 != 0 && ATT_FOLD != 0) ? 512 : 2048, 256, 1024, OUT0_FP8 != 0, (ATT_PV_FP8 != 0), (QC8_FP8 != 0 && ATT_FOLD != 0)>((QC8_FP8 != 0 && ATT_FOLD != 0) ? (const bf16_t*)((const unsigned char*)(ws + WS_QC8) + kr0 * 512 + h * 128) : P + kr0 * 2048 + 1024 + h * 128, (const bf16_t*)(KC8 + kr0 * 256 + kvh * 128), nullptr, (const bf16_t*)(VC8 + kr0 * 256 + kvh * 128), OUT0_FP8 ? (bf16_t*)((unsigned char*)MIX + kr0 * 1024 + 512 + h * 128) : MIX + kr0 * 1024 + 512 + h * 128, CTXL, (LAS char*)F.lds, nullptr, 0, wave_s);
                else if constexpr (GQA_QK_FP8 != 0) att::attn_unit_qk8<128, false, 2048, 2048, 1024, false>(P + kr0 * 2048 + 1024 + h * 128, P + kr0 * 2048 + 1536 + kvh * 128, nullptr, P + kr0 * 2048 + 1792 + kvh * 128, MIX + kr0 * 1024 + 512 + h * 128, CTXL, (LAS char*)F.lds, nullptr, 0, wave_s);
                else att::attn_unit<128, 2, false, 2048, 2048, 1024>(P + kr0 * 2048 + 1024 + h * 128, P + kr0 * 2048 + 1536 + kvh * 128, nullptr, P + kr0 * 2048 + 1792 + kvh * 128, MIX + kr0 * 1024 + 512 + h * 128, CTXL, (LAS char*)F.lds, nullptr, 0, wave_s); }
        }
    } SEAM(4);
    if (IN(5)) { REFRAME(); ProbOut<0> p; p.K = OUT0_FP8 ? 512 : 1024; p.lda = p.K; p.A = (const bf16_t*)(ws + WS_MIX0); p.Bt = (const bf16_t*)(ws + WS_WOUT0); p.XR = XR; p.MOD = MOD; p.xin = INP(I_X); p.cin = INP(I_CTX); p.so.init(NPAN, 4); p.G = F.G; p.c = F.bid; pg8::gemm_phase(F.lds, p, wave_s); } SEAM(5);
    if (IN(6)) { REFRAME(); p_norm_router<0>(F, args.dry); } SEAM(6);
    if (IN(7)) { REFRAME(); CLK_A(7);
#if MOE_PREGATHER && MOE_FP8
        p_moe_gather(F, 0); { const int t_ = tid_fresh(wave_s); xcd_barrier(bar, t_ == 0); } REFRAME();
#endif
        moe_prefix(F, 0); ProbMoe1 p; p.K = MOE_FP8 ? 512 : 1024; p.lda = p.K; p.H = (MOE_PREGATHER && MOE_FP8) ? (const bf16_t*)(ws + WS_XS) : H; p.W1 = (const bf16_t*)(ws + WS_W1); p.B1 = INP(I_B1); p.ACT = (bf16_t*)(ws + WS_ACT); p.rowl = (const int*)(ws + WS_ROWL);
        p.cnt = (const LAS int*)(F.lds + XTRA_OFF + X_CNT); p.stage = F.lds + XTRA_OFF + 1024; p.wave_s = wave_s; p.ms.pb = (const LAS int*)(F.lds + XTRA_OFF + X_PB); p.ms.bt = (const LAS unsigned*)(F.lds + XTRA_OFF + X_BT); p.ms.NTN = 8; p.ms.G = F.G; p.ms.c = F.bid; pg8::gemm_phase(F.lds, p, wave_s); CLK_B(7); } SEAM(7);
    if (IN(8)) { REFRAME(); moe_prefix(F, 0); ProbMoe2 p; p.K = MOE_FP8 ? 512 : 1024; p.lda = p.K; p.ACT = (const bf16_t*)(ws + WS_ACT); p.W2 = (const bf16_t*)(ws + WS_W2); p.B2 = INP(I_B2); p.Y = (bf16_t*)(ws + WS_Y);
        p.wave_s = wave_s; p.stage = F.lds + XTRA_OFF + 1024; p.ms.pb = (const LAS int*)(F.lds + XTRA_OFF + X_PB); p.ms.bt = (const LAS unsigned*)(F.lds + XTRA_OFF + X_BT); p.ms.NTN = 4; p.ms.G = F.G; p.ms.c = F.bid; pg8::gemm_phase(F.lds, p, wave_s); } SEAM(8);
    if (IN(9)) { REFRAME(); if constexpr (COMBINE_V2 != 0 && PROJ1_FP8 != 0 && Y_FP8 != 0) p_combine_v2<false>(F, args.dry); else p_combine_norm(F, args.dry); } SEAM(9);
    if (IN(10)) { REFRAME(); ProbIn1 p; p.K = PROJ1_FP8 ? 512 : 1024; p.lda = p.K; p.A = H; p.Bt = (const bf16_t*)(ws + WS_WIN1); p.O = (bf16_t*)(ws + WS_PBUF); p.so.init(256, 4); p.G = F.G; p.c = F.bid; pg8::gemm_phase(F.lds, p, wave_s); } SEAM(10);
    if (IN(11)) { REFRAME(); p_mla_prep(F); } SEAM(11);
    if (IN(12)) { REFRAME();
        { ProbPlain<true, UPQ_FP8 != 0, 0, (QB_FP8 != 0 && ATT_FOLD != 0 && UPQ_FP8 != 0)> p; p.osc8 = att::Cfg<192>::SCALE * 1.4426950408889634f * 32.f; p.K = UPQ_FP8 ? 256 : 512; p.lda = UPQ_FP8 ? 256 : 1024; p.A = UPQ_FP8 ? (const bf16_t*)(ws + WS_CQ8) : (const bf16_t*)(ws + WS_PBUF); p.Bt = (const bf16_t*)(ws + WS_WUQ); p.O = (bf16_t*)(ws + WS_QB); p.ldc = 1536; p.so.init(256, 6); p.G = F.G; p.c = F.bid; pg8::gemm_phase(F.lds, p, wave_s); }
        { ProbPlain<false, UPKV_FP8 != 0, (UPKV_FP8 ? 128 : 256), (ATT_KV8IN && ATT_PV_FP8 && MLA_QK_FP8)> p; p.K = UPKV_FP8 ? 128 : 256; p.lda = UPKV_FP8 ? 128 : 1024; p.A = UPKV_FP8 ? (const bf16_t*)(ws + WS_CKV8) : (const bf16_t*)(ws + WS_PBUF) + 512; p.Bt = (const bf16_t*)(ws + WS_WUKV); p.O = (bf16_t*)(ws + WS_KVB); p.ldc = 2048; p.so.init(NPAN, 8); p.G = F.G; p.c = F.bid; pg8::gemm_phase(F.lds, p, wave_s); }
    } SEAM(12);
    if (IN(13)) { REFRAME(); CLK_A(13);
        const bf16_t* Q = (const bf16_t*)(ws + WS_QB); const bf16_t* KV = (const bf16_t*)(ws + WS_KVB); const bf16_t* KR = (const bf16_t*)(ws + WS_KRB); bf16_t* MIX = (bf16_t*)(ws + WS_MIX1);
        for (int u = F.bid; u < 2048; u += F.G) { const int qb = u & 7, h = (u >> 3) & 7, b = u >> 6; const size_t kr0 = (size_t)b * TPB, qr0 = kr0 + CTXL + qb * 256;
            att::attn_unit_qk8<192, true, 1536, 2048, 1024, OUT1_FP8 != 0, (ATT_PV_FP8 != 0), (QB_FP8 != 0 && ATT_FOLD != 0 && UPQ_FP8 != 0)>((QB_FP8 != 0 && ATT_FOLD != 0 && UPQ_FP8 != 0) ? (const bf16_t*)((const unsigned char*)Q + qr0 * 1536 + h * 192) : Q + qr0 * 1536 + h * 192, (ATT_KV8IN && ATT_PV_FP8) ? (const bf16_t*)((const unsigned char*)KV + kr0 * 2048 + h * 128) : KV + kr0 * 2048 + h * 128, (ATT_KV8IN && ATT_PV_FP8) ? (const bf16_t*)((const unsigned char*)(ws + WS_KR8) + kr0 * 64) : KR + kr0 * 64, (ATT_KV8IN && ATT_PV_FP8) ? (const bf16_t*)((const unsigned char*)KV + kr0 * 2048 + 1024 + h * 128) : KV + kr0 * 2048 + 1024 + h * 128, OUT1_FP8 ? (bf16_t*)((unsigned char*)MIX + qr0 * 1024 + h * 128) : MIX + qr0 * 1024 + h * 128, TPB, (LAS char*)F.lds, (const f32x2*)(ws + WS_TABM), qb * 256, wave_s); }
    CLK_B(13); } SEAM(13);
    if (IN(14)) { REFRAME(); ProbOut<1> p; p.K = OUT1_FP8 ? 512 : 1024; p.lda = p.K; p.A = (const bf16_t*)(ws + WS_MIX1); p.Bt = (const bf16_t*)(ws + WS_WOUT1); p.XR = XR; p.MOD = MOD; p.xin = nullptr; p.cin = nullptr; p.so.init(256, 4); p.G = F.G; p.c = F.bid; pg8::gemm_phase(F.lds, p, wave_s); } SEAM(14);
    if (IN(15)) { REFRAME(); p_norm_router<1>(F, args.dry); } SEAM(15);
    if (IN(16)) { REFRAME();
#if MOE_PREGATHER && MOE_FP8
        p_moe_gather(F, 1); { const int t_ = tid_fresh(wave_s); xcd_barrier(bar, t_ == 0); } REFRAME();
#endif
        moe_prefix(F, 1); ProbMoe1 p; p.K = MOE_FP8 ? 512 : 1024; p.lda = p.K; p.H = (MOE_PREGATHER && MOE_FP8) ? (const bf16_t*)(ws + WS_XS) : H; p.W1 = (const bf16_t*)(ws + WS_W1 + (size_t)32 * 2048 * 1024 * (MOE_FP8 ? 1 : 2)); p.B1 = INP(I_B1) + 32 * 2048; p.ACT = (bf16_t*)(ws + WS_ACT); p.rowl = (const int*)(ws + WS_ROWL);
        p.cnt = (const LAS int*)(F.lds + XTRA_OFF + X_CNT); p.stage = F.lds + XTRA_OFF + 1024; p.wave_s = wave_s; p.ms.pb = (const LAS int*)(F.lds + XTRA_OFF + X_PB); p.ms.bt = (const LAS unsigned*)(F.lds + XTRA_OFF + X_BT); p.ms.NTN = 8; p.ms.G = F.G; p.ms.c = F.bid; pg8::gemm_phase(F.lds, p, wave_s); } SEAM(16);
    if (IN(17)) { REFRAME(); moe_prefix(F, 1); ProbMoe2 p; p.K = MOE_FP8 ? 512 : 1024; p.lda = p.K; p.ACT = (const bf16_t*)(ws + WS_ACT); p.W2 = (const bf16_t*)(ws + WS_W2 + (size_t)32 * 1024 * 1024 * (MOE_FP8 ? 1 : 2)); p.B2 = INP(I_B2) + 32 * 1024; p.Y = (bf16_t*)(ws + WS_Y);
        p.wave_s = wave_s; p.stage = F.lds + XTRA_OFF + 1024; p.ms.pb = (const LAS int*)(F.lds + XTRA_OFF + X_PB); p.ms.bt = (const LAS unsigned*)(F.lds + XTRA_OFF + X_BT); p.ms.NTN = 4; p.ms.G = F.G; p.ms.c = F.bid; pg8::gemm_phase(F.lds, p, wave_s); } SEAM(17);
    if (IN(18)) { REFRAME(); if constexpr (COMBINE_V2 != 0 && PROJ1_FP8 != 0 && Y_FP8 != 0) p_combine_v2<true>(F, 0); else p_final(F); }
#if PROBE_CLK
    if (F.bid == 0 && hi == NPHASE) { __syncthreads(); const unsigned long long* st_ = (const unsigned long long*)(ws + WS_CTL) + (CW_DBG / 2);
        unsigned long long d = 0;
        if (PROBE_CLK == 1) d = (st_[3] - st_[1]) * 1000ull / (st_[2] - st_[0]);
        if (PROBE_CLK == 2) d = (st_[2] - st_[0]);
        const unsigned long long t0 = __builtin_amdgcn_s_memrealtime(); while (__builtin_amdgcn_s_memrealtime() - t0 < d) __builtin_amdgcn_s_sleep(8); }
#endif
#undef IN
#undef SEAM
}

extern "C" void kernel_launch(void* const* d_in, const int* in_sizes, int n_in, void* d_out, int out_size, void* d_ws, size_t ws_size, hipStream_t stream) {
    static int grid = 0;
    if (grid == 0) {
        if (n_in != 28 || out_size != NBATCH * SEQ * DM || ws_size < WS_END) { fprintf(stderr, "kernel_launch: unexpected shapes (n_in %d out %d ws %zu, need ws >= %zu)\n", n_in, out_size, ws_size, (size_t)WS_END); grid = -1; return; }
        int dev = 0, cus = 0, per_cu = 0;
        if (hipGetDevice(&dev) != hipSuccess || hipDeviceGetAttribute(&cus, hipDeviceAttributeMultiprocessorCount, dev) != hipSuccess) { grid = -1; return; }
        if (hipFuncSetAttribute((const void*)fwd_kernel, hipFuncAttributeMaxDynamicSharedMemorySize, LDS_BYTES) != hipSuccess) { fprintf(stderr, "kernel_launch: hipFuncSetAttribute failed\n"); grid = -1; return; }
        if (hipOccupancyMaxActiveBlocksPerMultiprocessor(&per_cu, (const void*)fwd_kernel, 512, LDS_BYTES) != hipSuccess || per_cu < 1) { fprintf(stderr, "kernel_launch: occupancy query says %d blocks/CU\n", per_cu); }
        (void)hipGetLastError();
        grid = cus;
    }
    if (grid < 0) return;
    (void)hipMemsetAsync((char*)d_ws + WS_CTL, 0, CTL_BYTES, stream);
    Args a{};
    for (int i = 0; i < 28; ++i) a.in[i] = (const float*)d_in[i];
    a.out = (float*)d_out; a.ws = (uchar*)d_ws;
#if MK_ONE_LAUNCH
    a.ph_lo = 0; a.ph_hi = NPHASE;
    hipLaunchKernelGGL(fwd_kernel, dim3(grid), dim3(512), LDS_BYTES, stream, a);
#else
    for (int ph = 0; ph < NPHASE; ++ph) { a.ph_lo = ph; a.ph_hi = ph + 1; const int nrep = 1 + ((REPEAT_MASK >> ph) & 1); for (int rep = 0; rep < nrep; ++rep) { a.dry = (rep + 1 < nrep) ? 1 : 0; hipLaunchKernelGGL(fwd_kernel, dim3(grid), dim3(512), LDS_BYTES, stream, a); } }
#endif
}
```

```cpp
#include <hip/hip_runtime.h>
#include <cstdio>
#include <cstdint>

#ifndef MK_ONE_LAUNCH
#define MK_ONE_LAUNCH 1
#endif
#define REPEAT_MASK 0
#define USE_BUFFER_LDS 1
#define MOE_PREGATHER 0
#define PROJ0_FP8 1
#ifndef UPQ_FP8
#define UPQ_FP8 (MOE_FP8 != 0)
#endif
#ifndef UPKV_FP8
#define UPKV_FP8 1
#endif
#define UP1_FP8_UNUSED 0
#define EPI_P16 1
#define EPI_LDS1 0
#define IDX_LDS 1
#define BIAS_LDS 1
#define ATT_OT 1
#define COMBINE_V2 1
#define SGU_T 1
#define EPI1_PK 1
#define L2PF1 1
#define L2PF2 1
#define NORM0_V2 1
#define P0_ITEM128 1
#define ATT_LSUM_MFMA 1
#define ATT_FOLD 1
#define QB_FP8 1
#define PBUF1_FP8 1
#define ATT_KVDMA 1
#define QC8_FP8 1
#define NT_HINTS 1
#define P0_REBAL 1
#define L2PF 1
#define GEMM_ALIGN_EPI 1
#define ATT_KV8IN 1
#define ATT_PV_FP8 1
#define GQA_QK_FP8 1
#define MLA_QK_FP8 1
#define OUT0_FP8 0
#define OUT1_FP8 (MOE_FP8 != 0)
#define PROJ1_FP8 (MOE_FP8 != 0)
#define PROJ_FP8_UNUSED (MOE_FP8 != 0)
#define PROBE_CLK 0
#define PROBE_CLK_PH 7
#define Y_FP8 1
#ifndef MOE_FP8
#define MOE_FP8 1
#endif

#define LAS __attribute__((address_space(3)))
typedef unsigned short bf16_t;
typedef unsigned char uchar;
typedef short bf16x8 __attribute__((ext_vector_type(8)));
typedef short s16x4 __attribute__((ext_vector_type(4)));
typedef float f32x2 __attribute__((ext_vector_type(2)));
typedef float f32x4 __attribute__((ext_vector_type(4)));
typedef float f32x16 __attribute__((ext_vector_type(16)));
typedef unsigned u32x2 __attribute__((ext_vector_type(2)));
typedef unsigned u32x4 __attribute__((ext_vector_type(4)));
typedef int i32x4 __attribute__((ext_vector_type(4)));
typedef int i32x8 __attribute__((ext_vector_type(8)));

constexpr int DM = 1024, NBATCH = 32, SEQ = 2048, CTXL = 256, TPB = SEQ + CTXL, NTOK = NBATCH * TPB, NPAN = NTOK / 256;
constexpr int NEXP = 32, TOPK = 4, ROWCAP = NTOK;
constexpr float EPS = 1e-6f;
constexpr int NPHASE = 19;

constexpr size_t MiB = 1u << 20;
constexpr size_t WS_CTL = 0, CTL_BYTES = 1 * MiB;
constexpr size_t WS_MOD = 1 * MiB;
constexpr size_t WS_TABG = 3 * MiB;
constexpr size_t WS_TABM = WS_TABG + 32768;
constexpr size_t WS_WRT = WS_TABG + 65536;
constexpr size_t WS_SGUW = WS_WRT + 262144;
constexpr size_t WS_WIN0 = 4 * MiB, WS_WOUT0 = 8 * MiB, WS_WIN1 = 10 * MiB, WS_WUQ = 12 * MiB, WS_WUKV = 14 * MiB, WS_WOUT1 = 15 * MiB;
constexpr size_t WS_W1 = 17 * MiB;
constexpr size_t WS_W2 = 273 * MiB;
constexpr size_t WS_ROWL = 401 * MiB;
constexpr size_t WS_TOKI = 410 * MiB;
constexpr size_t WS_XR = 413 * MiB;
constexpr size_t WS_H = 701 * MiB;
constexpr size_t WS_SCR = 845 * MiB;
constexpr size_t WS_PBUF = WS_SCR;
constexpr size_t WS_MIX0 = WS_SCR + 288 * MiB;
constexpr size_t WS_KC8 = WS_SCR + 432 * MiB;
constexpr size_t WS_QC8 = WS_SCR + 472 * MiB;
constexpr size_t WS_VC8 = WS_SCR + 452 * MiB;
constexpr size_t WS_KR8 = WS_SCR + 880 * MiB;
constexpr size_t WS_QB = WS_SCR + 144 * MiB;
constexpr size_t WS_KVB = WS_SCR + 360 * MiB;
constexpr size_t WS_KRB = WS_SCR + 648 * MiB;
constexpr size_t WS_MIX1 = WS_SCR + 660 * MiB;
constexpr size_t WS_CQ8 = WS_SCR + 804 * MiB;
constexpr size_t WS_CKV8 = WS_SCR + 840 * MiB;
constexpr size_t WS_ACT = WS_SCR;
constexpr size_t WS_XS = WS_SCR + 296 * MiB;
constexpr size_t WS_Y = WS_SCR + 592 * MiB;
constexpr size_t WS_END = WS_SCR + 1184 * MiB;
constexpr int CW_BAR = 1024;
constexpr int CW_CNT = 8192;
constexpr int CW_DBG = 16384;

constexpr int RING_BYTES = 131072;
constexpr int XTRA_OFF = RING_BYTES, XTRA_BYTES = 20480;
constexpr int MISC_OFF = XTRA_OFF + XTRA_BYTES;
constexpr int LDS_BYTES = MISC_OFF + 512;
constexpr int X_PB = 0;
constexpr int X_CNT = 256;
constexpr int X_HIST = 512;
constexpr int X_BASE = 768;
constexpr int X_SEL = 1024;
constexpr int X_A2 = 9216;
constexpr int X_CB = 13312;
constexpr int X_BT = 12288, BT_N = 1280;
constexpr int X_RS = 13440;

#define LDS_WAIT() asm volatile("s_waitcnt lgkmcnt(0)" ::: "memory")
#define VM_WAIT() asm volatile("s_waitcnt vmcnt(0)" ::: "memory")
#define SBAR() __builtin_amdgcn_sched_barrier(0)
#if NT_HINTS
#define NT_LD(p) __builtin_nontemporal_load(p)
#define NT_ST(v, p) __builtin_nontemporal_store(v, p)
#else
#define NT_LD(p) (*(p))
#define NT_ST(v, p) (*(p) = (v))
#endif
__device__ __forceinline__ unsigned cvtpk(float lo, float hi) { unsigned r; asm volatile("v_cvt_pk_bf16_f32 %0, %1, %2" : "=v"(r) : "v"(lo), "v"(hi)); return r; }
__device__ __forceinline__ float bf2f(unsigned short b) { return __uint_as_float(((unsigned)b) << 16); }
__device__ __forceinline__ float bflo(unsigned w) { return __uint_as_float(w << 16); }
__device__ __forceinline__ float bfhi(unsigned w) { return __uint_as_float(w & 0xffff0000u); }
__device__ __forceinline__ unsigned short f2bf(float f) { return (unsigned short)(cvtpk(f, 0.f) & 0xffffu); }
__device__ __forceinline__ unsigned pk4_fp8(float a, float b, float c, float d) {
    a = __builtin_amdgcn_fmed3f(a, -448.f, 448.f); b = __builtin_amdgcn_fmed3f(b, -448.f, 448.f); c = __builtin_amdgcn_fmed3f(c, -448.f, 448.f); d = __builtin_amdgcn_fmed3f(d, -448.f, 448.f);
    unsigned w = 0; w = __builtin_amdgcn_cvt_pk_fp8_f32(a, b, w, false); w = __builtin_amdgcn_cvt_pk_fp8_f32(c, d, w, true); return w;
}
__device__ __forceinline__ int tid_fresh(int wave_s) { int l; asm volatile("v_mbcnt_lo_u32_b32 %0, -1, 0\n\tv_mbcnt_hi_u32_b32 %0, -1, %0" : "=v"(l)); return wave_s * 64 + l; }
template <int CTRL, int BANK> __device__ __forceinline__ int dpp_i(int old, int x) { return __builtin_amdgcn_update_dpp(old, x, CTRL, 0xF, BANK, false); }
__device__ __forceinline__ int xs1(int x) { return dpp_i<0xB1, 0xF>(x, x); }
__device__ __forceinline__ int xs2(int x) { return dpp_i<0x4E, 0xF>(x, x); }
__device__ __forceinline__ int xs4(int x) { const int t = dpp_i<0x114, 0xA>(x, x); return dpp_i<0x104, 0x5>(t, x); }
__device__ __forceinline__ int xs8(int x) { return dpp_i<0x128, 0xF>(x, x); }
__device__ __forceinline__ float xf1(float x) { return __int_as_float(xs1(__float_as_int(x))); }
__device__ __forceinline__ float xf2(float x) { return __int_as_float(xs2(__float_as_int(x))); }
__device__ __forceinline__ float xf4(float x) { return __int_as_float(xs4(__float_as_int(x))); }
__device__ __forceinline__ float xf8(float x) { return __int_as_float(xs8(__float_as_int(x))); }
__device__ __forceinline__ float sum16(float a, float b) { auto r = __builtin_amdgcn_permlane16_swap(__float_as_uint(a), __float_as_uint(b), false, false); return __uint_as_float(r[0]) + __uint_as_float(r[1]); }
__device__ __forceinline__ float sum32(float a, float b) { auto r = __builtin_amdgcn_permlane32_swap(__float_as_uint(a), __float_as_uint(b), false, false); return __uint_as_float(r[0]) + __uint_as_float(r[1]); }
__device__ __forceinline__ unsigned xu16(unsigned x, int lane) { auto r = __builtin_amdgcn_permlane16_swap(x, x, false, false); return (lane & 16) ? r[0] : r[1]; }
__device__ __forceinline__ unsigned xu32(unsigned x, int lane) { auto r = __builtin_amdgcn_permlane32_swap(x, x, false, false); return (lane & 32) ? r[0] : r[1]; }
__device__ __forceinline__ unsigned pk4_fp8_nz(float a, float b, float c, float d) { unsigned w = __float_as_uint(a); w = __builtin_amdgcn_cvt_pk_fp8_f32(a, b, w, false); w = __builtin_amdgcn_cvt_pk_fp8_f32(c, d, w, true); return w; }
__device__ __forceinline__ unsigned pk4_fp8_nc(float a, float b, float c, float d) { unsigned w = 0; w = __builtin_amdgcn_cvt_pk_fp8_f32(a, b, w, false); w = __builtin_amdgcn_cvt_pk_fp8_f32(c, d, w, true); return w; }
__device__ __forceinline__ float wave_sum(float v) {
    v += xf1(v); v += xf2(v); v += xf4(v); v += xf8(v); v = sum16(v, v); v = sum32(v, v);
    return v;
}
__device__ __forceinline__ float silu_f(float x) { return x / (1.f + __expf(-x)); }
__device__ __forceinline__ float gelu_tanh_f(float x) {
    const float u = x * (1.5957691216057308f + 0.07135481627260025f * x * x);
    const float e = __builtin_amdgcn_exp2f(-1.4426950408889634f * u);
    return x * __builtin_amdgcn_rcpf(1.f + e);
}
__device__ __forceinline__ f32x4 gelu_tanh_4(f32x4 x) {
    const f32x4 x2 = x * x, u = x * (x2 * (-0.07135481627260025f * 1.4426950408889634f) + (-1.5957691216057308f * 1.4426950408889634f));
    const f32x4 d = (f32x4){__builtin_amdgcn_exp2f(u.x), __builtin_amdgcn_exp2f(u.y), __builtin_amdgcn_exp2f(u.z), __builtin_amdgcn_exp2f(u.w)} + 1.f;
    return x * (f32x4){__builtin_amdgcn_rcpf(d.x), __builtin_amdgcn_rcpf(d.y), __builtin_amdgcn_rcpf(d.z), __builtin_amdgcn_rcpf(d.w)};
}

#define XB_TMO      128
#define XB_XCNT(j)  (256  + 64 * (j))
#define XB_XSUB(j)  (1280 + 64 * (j))
#define XB_XGEN(j)  (2304 + 64 * (j))
#define XB_TOP      3328
#define XB_TOPGEN   3392
#define XCD_BAR_WORDS 3456
#define XB_SPIN_CAP (1u << 20)
__device__ __forceinline__ unsigned xb_ld(unsigned* p)              { return __hip_atomic_load(p, __ATOMIC_RELAXED, __HIP_MEMORY_SCOPE_AGENT); }
__device__ __forceinline__ unsigned xb_add(unsigned* p, unsigned v) { return __hip_atomic_fetch_add(p, v, __ATOMIC_RELAXED, __HIP_MEMORY_SCOPE_AGENT); }
__device__ __forceinline__ unsigned xb_xcc_id() { return (unsigned)__builtin_amdgcn_s_getreg((3 << 11) | 20) & 0xFu; }
#define XB_SPIN(cond, bar) do { unsigned _sp = 0; while (cond) { __builtin_amdgcn_s_sleep(1); \
    if ((++_sp & 255u) == 0u) { if (xb_ld(&(bar)[XB_TMO])) break; if (_sp > XB_SPIN_CAP) { atomicAdd(&(bar)[XB_TMO], 1u); break; } } } } while (0)
struct XcdBarrier { unsigned* bar; unsigned x; volatile LAS unsigned* st; };
__device__ __forceinline__ XcdBarrier xcd_barrier_post(unsigned* bar, volatile LAS unsigned* st, bool t0) {
    XcdBarrier b; b.bar = bar; b.x = xb_xcc_id(); b.st = st;
    if (t0) (void)xb_add(&bar[XB_XCNT(b.x)], 1u);
    return b;
}
__device__ __forceinline__ void xcd_barrier_complete(unsigned* bar, unsigned x, unsigned& nloc, unsigned& nx) {
    const unsigned G = gridDim.x * gridDim.y * gridDim.z;
    unsigned sum, cnt, mine, sp = 0u;
    for (;;) {
        sum = 0u; cnt = 0u; mine = 0u;
#pragma unroll
        for (unsigned j = 0; j < 16; ++j) { const unsigned c = xb_ld(&bar[XB_XCNT(j)]); sum += c; cnt += (c > 0u) ? 1u : 0u; mine = (j == x) ? c : mine; }
        if (sum == G) break;
        __builtin_amdgcn_s_sleep(1);
        if ((++sp & 255u) == 0u) { if (xb_ld(&bar[XB_TMO])) break; if (sp > XB_SPIN_CAP) { atomicAdd(&bar[XB_TMO], 1u); break; } }
    }
    nloc = mine > 0u ? mine : 1u; nx = cnt > 0u ? cnt : 1u;
}
__device__ __forceinline__ void xcd_barrier(const XcdBarrier& b, bool t0) {
    asm volatile("s_waitcnt vmcnt(0)" ::: "memory");
    __syncthreads();
    if (t0) {
        unsigned* bar = b.bar;
        __builtin_amdgcn_s_waitcnt(0);
        unsigned nloc = b.st[0], nx = b.st[1];
        if (nloc == 0u) { xcd_barrier_complete(bar, b.x, nloc, nx); b.st[0] = nloc; b.st[1] = nx; }
        const unsigned old = xb_add(&bar[XB_XSUB(b.x)], 1u);
        const unsigned gen = old / nloc;
        if (old + 1u == (gen + 1u) * nloc) {
            __builtin_amdgcn_fence(__ATOMIC_RELEASE, "agent");
            asm volatile("s_waitcnt vmcnt(0)" ::: "memory");
            const unsigned og = xb_add(&bar[XB_TOP], 1u);
            const unsigned tg = og / nx;
            if (og + 1u == (tg + 1u) * nx) xb_add(&bar[XB_TOPGEN], 1u);
            else XB_SPIN(xb_ld(&bar[XB_TOPGEN]) == tg, bar);
            __builtin_amdgcn_fence(__ATOMIC_ACQUIRE, "agent");
            xb_add(&bar[XB_XGEN(b.x)], 1u);
            asm volatile("s_waitcnt vmcnt(0)" ::: "memory");
        } else {
            XB_SPIN(xb_ld(&bar[XB_XGEN(b.x)]) == gen, bar);
            __builtin_amdgcn_fence(__ATOMIC_ACQUIRE, "agent");
            asm volatile("s_waitcnt vmcnt(0)" ::: "memory");
        }
    }
    __syncthreads();
}

struct Args { const float* in[28]; float* out; uchar* ws; int ph_lo, ph_hi, dry, pad; };
enum { I_X = 0, I_C, I_CTX, I_CCTX, I_ADAW, I_ADAB, I_NMIXG, I_NFFNG, I_ABWIN, I_SGUNG, I_SGUW, I_SGUB, I_GQG, I_GKG, I_ABWOUT, I_MLAWIN, I_MLAQG, I_MLAKVG, I_MLAWUQ, I_MLAWUKV, I_MLAWOUT,
       I_RW, I_RB, I_W1, I_B1, I_W2, I_B2, I_FNG };
struct Frame {
    LAS uchar* lds; int tid, lane, wave, G, bid;
    uchar* ws; float* out;
};
__device__ __forceinline__ const float* INP(int i) {
    const __attribute__((address_space(4))) char* ka = (const __attribute__((address_space(4))) char*)__builtin_amdgcn_kernarg_segment_ptr();
    return *(const float* const volatile __attribute__((address_space(4)))*)(ka + i * 8);
}

namespace pg8 {
constexpr int BM = 256, BK = 64, HALF = 128, HTB = HALF * BK * 2, NXCD = 8, WGM = 8;
__device__ __forceinline__ int lds_byte(int r, int c) { const int st = (r >> 4) * 2 + (c >> 5), rr = r & 15, cc = c & 31, ob = rr * 64 + cc * 2; return st * 1024 + (ob ^ (((ob >> 9) & 1) << 5)); }
__device__ __forceinline__ void stage_rc(int b, int& R, int& C) { const int st = b / 1024, sb = b % 1024, swz = sb ^ (((sb >> 9) & 1) << 5); R = (st >> 1) * 16 + swz / 64; C = (st & 1) * 32 + (swz % 64) / 2; }
__device__ __forceinline__ int perm32(int rho) { const int n = rho >> 4, i = rho & 15; return 8 * (i >> 2) + 4 * n + (i & 3); }
struct Unit { int pm, pn, e, rb; };
struct StaticOrder {
    int nM, nN, nwg;
    __device__ void init(int nM_, int nN_) { nM = nM_; nN = nN_; nwg = nM * nN; }
    __device__ bool map(long L, int& pm, int& pn) const {
        if (L >= nwg) return false;
        int wgid = (int)L; { const int q = nwg / NXCD, r = nwg % NXCD, xcd = wgid % NXCD, off = wgid / NXCD; wgid = (xcd < r ? xcd * (q + 1) : r * (q + 1) + (xcd - r) * q) + off; }
        const int nig = WGM * nN, gid = wgid / nig, fm = gid * WGM, gsz = (nM - fm) < WGM ? (nM - fm) : WGM;
        pm = fm + ((wgid % nig) % gsz); pn = (wgid % nig) / gsz; return true;
    }
};
typedef f32x4 Acc[2][2][4][2];
template <class P>
__device__ __forceinline__ void gemm_phase(LAS uchar* lds, const P& p, int wave_s) {
    const int tid = tid_fresh(wave_s), wid = __builtin_amdgcn_readfirstlane(tid >> 6), lane = tid & 63, wr = wid >> 2, wc = wid & 3, fr = lane & 15, fq = lane >> 4;
    const int K = P::KCONST ? P::KCONST : p.K, nt = K / BK;
    unsigned voffA[2][2], voffB[2];
#pragma unroll
    for (int i = 0; i < 2; ++i) { int R, C; stage_rc(tid * 16 + i * 8192, R, C); const int Rb = P::P16 ? (64 * (R >> 5) + 16 * ((R & 15) >> 2) + 4 * ((R >> 4) & 1) + (R & 3)) : P::PERM ? ((R & ~31) + perm32(R & 31)) : R;
        voffA[0][i] = (unsigned)(R * p.lda + C) * 2u; voffA[1][i] = voffA[0][i]; voffB[i] = (unsigned)(Rb * K + C) * 2u; }
    const unsigned kstep = (unsigned)(BK * 2);
    const unsigned hstepB = (unsigned)(P::P16 ? 8 : HALF) * K * 2;
    const unsigned hstepA = P::GATHER ? 0u : (unsigned)HALF * p.lda * 2;
#define PG8_VA1 voffA[P::GATHER ? 1 : 0]
    const __amdgpu_buffer_rsrc_t rsA = __builtin_amdgcn_make_buffer_rsrc((void*)p.a_mat(), 0, 0xffffffffu, 0x00020000);
    const __amdgpu_buffer_rsrc_t rsB = __builtin_amdgcn_make_buffer_rsrc((void*)p.b_mat(), 0, 0xffffffffu, 0x00020000);
    const char* gpA = (const char*)p.a_mat(); const char* gpB = (const char*)p.b_mat(); (void)gpA; (void)gpB; (void)rsA; (void)rsB;
    unsigned ldsw = (unsigned)wid * 1024u;
    const int aoff = lds_byte(wr * 64 + fr, fq * 8), boff = lds_byte(wc * 32 + fr, fq * 8);
#define PG8_SA(b, h) (((b) * 2 + (h)) * HTB)
#define PG8_SB(b, h) ((4 + (b) * 2 + (h)) * HTB)
#if USE_BUFFER_LDS
#define PG8_STAGE_R(bufoff, rs, gp, soff, voff) do { _Pragma("unroll") for (int _i = 0; _i < 2; ++_i) \
        __builtin_amdgcn_raw_ptr_buffer_load_lds(rs, (LAS unsigned*)(lds + (bufoff) + ldsw + _i * 8192), 16, (int)(voff)[_i], (int)(soff), 0, 0); } while (0)
#else
#define PG8_STAGE_R(bufoff, rs, gp, soff, voff) do { _Pragma("unroll") for (int _i = 0; _i < 2; ++_i) \
        __builtin_amdgcn_global_load_lds((const unsigned*)((const char*)(gp) + (size_t)(soff) + (voff)[_i]), (LAS unsigned*)(lds + (bufoff) + ldsw + _i * 8192), 16, 0, 0); } while (0)
#endif
#define PG8_STAGE_A(bufoff, soff, voff) PG8_STAGE_R(bufoff, rsA, gpA, soff, voff)
#define PG8_STAGE_B(bufoff, soff, voff) PG8_STAGE_R(bufoff, rsB, gpB, soff, voff)
#define PG8_LDA(dst, b, h) do { _Pragma("unroll") for (int m = 0; m < 4; ++m) _Pragma("unroll") for (int k = 0; k < 2; ++k) dst[m][k] = *(const LAS i32x4*)(lds + PG8_SA(b, h) + aoff + m * 2048 + k * 1024); } while (0)
#define PG8_LDB(dst, b, h) do { _Pragma("unroll") for (int n = 0; n < 2; ++n) _Pragma("unroll") for (int k = 0; k < 2; ++k) dst[n][k] = *(const LAS i32x4*)(lds + PG8_SB(b, h) + boff + n * 2048 + k * 1024); } while (0)
#define PG8_CAT(x) __builtin_shufflevector((x)[0], (x)[1], 0, 1, 2, 3, 4, 5, 6, 7)
#define PG8_MMA(ai, bj, At, Bt) do { __builtin_amdgcn_s_setprio(1); \
        if constexpr (P::FP8) { _Pragma("unroll") for (int m = 0; m < 4; ++m) _Pragma("unroll") for (int n = 0; n < 2; ++n) \
            acc[ai][bj][m][n] = __builtin_amdgcn_mfma_scale_f32_16x16x128_f8f6f4(PG8_CAT(Bt[n]), PG8_CAT(At[m]), acc[ai][bj][m][n], 0, 0, 0, 0x7F7F7F7F, 0, 0x7F7F7F7F); } \
        else { _Pragma("unroll") for (int m = 0; m < 4; ++m) _Pragma("unroll") for (int n = 0; n < 2; ++n) _Pragma("unroll") for (int k = 0; k < 2; ++k) \
            acc[ai][bj][m][n] = __builtin_amdgcn_mfma_f32_16x16x32_bf16(__builtin_bit_cast(bf16x8, Bt[n][k]), __builtin_bit_cast(bf16x8, At[m][k]), acc[ai][bj][m][n], 0, 0, 0); } \
        __builtin_amdgcn_s_setprio(0); } while (0)
#define PG8_WAIT_V(n) asm volatile("s_waitcnt vmcnt(" #n ")" ::: "memory")
#define PG8_WAIT_L(n) asm volatile("s_waitcnt lgkmcnt(" #n ")" ::: "memory")
#define PG8_BAR __builtin_amdgcn_s_barrier()
#define PG8_SCHED __builtin_amdgcn_sched_barrier(0)
    Unit cur, nxt; int ui = 0;
    if (!p.next(0, cur)) return;
    Acc acc;
#pragma unroll
    for (int a = 0; a < 2; ++a)
#pragma unroll
        for (int b = 0; b < 2; ++b)
#pragma unroll
            for (int m = 0; m < 4; ++m)
#pragma unroll
                for (int n = 0; n < 2; ++n) acc[a][b][m][n] = (f32x4){0.f, 0.f, 0.f, 0.f};
    i32x4 At[4][2], B0[2][2], B1[2][2];
    unsigned cA = p.a_off(cur), cB = p.b_off(cur);
    if constexpr (P::GATHER) { p.a_voff(cur, voffA); }
    PG8_STAGE_B(PG8_SB(0, 0), cB, voffB); PG8_STAGE_B(PG8_SB(0, 1), cB + hstepB, voffB); PG8_STAGE_A(PG8_SA(0, 0), cA, voffA[0]); PG8_STAGE_A(PG8_SA(0, 1), cA + hstepA, PG8_VA1);
    if (wr == 1) PG8_BAR;
    PG8_WAIT_V(2); PG8_BAR;
    PG8_STAGE_B(PG8_SB(1, 0), cB + kstep, voffB); PG8_STAGE_A(PG8_SA(1, 0), cA + kstep, voffA[0]); PG8_STAGE_B(PG8_SB(1, 1), cB + hstepB + kstep, voffB);
    PG8_WAIT_V(6); PG8_BAR;
    for (;;) {
        const bool has_next = p.next(ui + 1, nxt);
        if constexpr (P::MOE) p.unit_top(cur, nxt, has_next, wid, ui);
        const unsigned nA = has_next ? p.a_off(nxt) : cA, nB = has_next ? p.b_off(nxt) : cB;
#pragma unroll 1
        for (int t = 0; t < nt; t += 2) {
            const bool last = (t == nt - 2);
            asm volatile("" : "+s"(ldsw));
            const unsigned a1 = cA + (unsigned)(t + 1) * kstep;
            const unsigned a2 = last ? nA : cA + (unsigned)(t + 2) * kstep, b2 = last ? nB : cB + (unsigned)(t + 2) * kstep;
            const unsigned a3 = a2 + kstep, b3 = b2 + kstep;
            PG8_LDB(B0, 0, 0); PG8_LDB(B1, 0, 1); PG8_SCHED; PG8_LDA(At, 0, 0); PG8_STAGE_A(PG8_SA(1, 1), a1 + hstepA, PG8_VA1);
            if constexpr (P::GATHER) { if (last && has_next) p.a_voff_next(nxt, voffA); }
            PG8_WAIT_V(8); PG8_WAIT_L(0); PG8_BAR; PG8_MMA(0, 0, At, B0); PG8_MMA(0, 1, At, B1); PG8_BAR; PG8_SCHED;
            PG8_LDA(At, 0, 1); PG8_STAGE_B(PG8_SB(0, 0), b2, voffB); PG8_STAGE_B(PG8_SB(0, 1), b2 + hstepB, voffB); PG8_STAGE_A(PG8_SA(0, 0), a2, voffA[0]);
            PG8_WAIT_V(8); PG8_WAIT_L(0); PG8_BAR; PG8_MMA(1, 0, At, B0); PG8_MMA(1, 1, At, B1); PG8_BAR; PG8_SCHED;
            PG8_LDB(B0, 1, 0); PG8_LDB(B1, 1, 1); PG8_SCHED; PG8_LDA(At, 1, 0); PG8_STAGE_A(PG8_SA(0, 1), a2 + hstepA, PG8_VA1);
            PG8_WAIT_V(8); PG8_WAIT_L(0); PG8_BAR; PG8_MMA(0, 0, At, B0); PG8_MMA(0, 1, At, B1); PG8_BAR; PG8_SCHED;
            PG8_LDA(At, 1, 1); PG8_STAGE_B(PG8_SB(1, 0), b3, voffB); PG8_STAGE_B(PG8_SB(1, 1), b3 + hstepB, voffB); PG8_STAGE_A(PG8_SA(1, 0), a3, voffA[0]);
            PG8_WAIT_V(8); PG8_WAIT_L(0); PG8_BAR; PG8_MMA(1, 0, At, B0); PG8_MMA(1, 1, At, B1); PG8_BAR; PG8_SCHED;
        }
        if (GEMM_ALIGN_EPI && wr == 0) PG8_BAR;
        if constexpr (P::MOE) {
            if constexpr (P::GATHER) {
                if (L2PF != 0 && L2PF1 != 0 && IDX_LDS != 0 && has_next) { const int ln = tid_fresh(p.wave_s) & 63; const int n = p.cnt[nxt.e]; const volatile LAS int* il = (const volatile LAS int*)p.stage;
#pragma unroll
                    for (int r = 0; r < 4; ++r) { const int ri = nxt.pn * 32 + wid * 4 + r; const int tk = il[ri]; const unsigned tok = (nxt.rb * 256 + ri < n) ? (unsigned)tk : 0u;
                        __builtin_amdgcn_raw_ptr_buffer_load_lds(rsA, (LAS unsigned*)(p.stage + 3072 + wid * 1024), 16, (int)(tok * 1024u + (unsigned)ln * 16u), 0, 0, 0); } }
            } else p.epi_prefetch(nxt, has_next, wid);
            p.epi(acc, cur, wr, wc, fr, fq, ui); } else p.epi(acc, cur, wr, wc, fr, fq);
        if (!has_next) break;
#pragma unroll
        for (int a = 0; a < 2; ++a)
#pragma unroll
            for (int b = 0; b < 2; ++b)
#pragma unroll
                for (int m = 0; m < 4; ++m)
#pragma unroll
                    for (int n = 0; n < 2; ++n) acc[a][b][m][n] = (f32x4){0.f, 0.f, 0.f, 0.f};
        cur = nxt; cA = nA; cB = nB; ++ui;
        if (GEMM_ALIGN_EPI && wr == 1) PG8_BAR;
    }
    PG8_WAIT_V(0);
    if (!GEMM_ALIGN_EPI && wr == 0) PG8_BAR;
    PG8_BAR;
#undef PG8_SA
#undef PG8_VA1
#undef PG8_SB
#undef PG8_STAGE_R
#undef PG8_STAGE_A
#undef PG8_STAGE_B
#undef PG8_LDA
#undef PG8_LDB
#undef PG8_MMA
#undef PG8_CAT
#undef PG8_WAIT_V
#undef PG8_WAIT_L
#undef PG8_BAR
#undef PG8_SCHED
}

template <bool GELU>
__device__ __forceinline__ void epi_store_bf16(const Acc& acc, bf16_t* dst  , int ldc, const float* bias  , int wr, int wc, int fr, int fq, float sc = 1.f) {
    const int row0 = wr * 64 + fr, col0 = wc * 32 + 8 * fq;
    f32x4 bv[2][2];
#pragma unroll
    for (int bj = 0; bj < 2; ++bj)
#pragma unroll
        for (int n = 0; n < 2; ++n) bv[bj][n] = bias ? *(const f32x4*)(bias + col0 + bj * HALF + 4 * n) : (f32x4){0.f, 0.f, 0.f, 0.f};
    const unsigned lane_off = (unsigned)(row0 * ldc + col0) * 2u;
#pragma unroll
    for (int ai = 0; ai < 2; ++ai)
#pragma unroll
        for (int m = 0; m < 4; ++m) { char* rowb = (char*)dst + (size_t)((ai * HALF + m * 16) * ldc) * 2;
#pragma unroll
            for (int bj = 0; bj < 2; ++bj) { f32x4 v0 = acc[ai][bj][m][0] * sc + bv[bj][0], v1 = acc[ai][bj][m][1] * sc + bv[bj][1];
                if (GELU) { v0 = gelu_tanh_4(v0); v1 = gelu_tanh_4(v1); }
                u32x4 w; w.x = cvtpk(v0[0], v0[1]); w.y = cvtpk(v0[2], v0[3]); w.z = cvtpk(v1[0], v1[1]); w.w = cvtpk(v1[2], v1[3]);
                *(u32x4*)(rowb + lane_off + bj * HALF * 2) = w; } }
}
template <bool P16v = false>
__device__ __forceinline__ void epi_store_fp8(const Acc& acc, unsigned char* dst  , int ldc, int wr, int wc, int fr, int fq, float sc) {
    const int row0 = wr * 64 + fr, col0 = P16v ? wc * 64 + 16 * fq : wc * 32 + 8 * fq; const unsigned lane_off = (unsigned)(row0 * ldc + col0);
#pragma unroll
    for (int ai = 0; ai < 2; ++ai)
#pragma unroll
        for (int m = 0; m < 4; ++m) { unsigned char* rowb = dst + (size_t)((ai * HALF + m * 16) * ldc);
            if constexpr (P16v) { u32x4 w;
#pragma unroll
                for (int bj = 0; bj < 2; ++bj) { const f32x4 v0 = acc[ai][bj][m][0] * sc, v1 = acc[ai][bj][m][1] * sc;
                    w[2 * bj] = pk4_fp8(v0[0], v0[1], v0[2], v0[3]); w[2 * bj + 1] = pk4_fp8(v1[0], v1[1], v1[2], v1[3]); }
                *(u32x4*)(rowb + lane_off) = w; }
            else {
#pragma unroll
            for (int bj = 0; bj < 2; ++bj) { const f32x4 v0 = acc[ai][bj][m][0] * sc, v1 = acc[ai][bj][m][1] * sc;
                u32x2 w; w.x = pk4_fp8(v0[0], v0[1], v0[2], v0[3]); w.y = pk4_fp8(v1[0], v1[1], v1[2], v1[3]);
                *(u32x2*)(rowb + lane_off + bj * HALF) = w; } } }
}
}

namespace att {
constexpr int NW = 8, QBLK = 32, KVBLK = 64;
constexpr int SHM_V = KVBLK * 128 * 2;
constexpr float THR = 8.f;
__device__ __forceinline__ int crow(int r, int hi) { return (r & 3) + 8 * (r >> 2) + 4 * hi; }
template <int DQK> struct Cfg { static constexpr float SCALE = (DQK == 128) ? 0.088388347648318440f : 0.072168783648703220f; static constexpr int KP = DQK * 2, SHM_K = KVBLK * DQK * 2, ND = DQK / 16; };
#define KSWZ(PITCH, row, colB) ((row) * (PITCH) + ((colB) ^ (((row) & 7) << 4)))
template <int DQK, int QS = 1, int THRI = 8> __device__ __forceinline__ void partialSM(f32x16& p0, f32x16& p1, float& m_reg, float& mn, float& alpha) {
    constexpr float SCALE = Cfg<DQK>::SCALE / (float)QS, C = SCALE * 1.4426950408889634f;
    float pmax = p0[0];
#pragma unroll
    for (int r = 1; r < 16; ++r) pmax = fmaxf(pmax, p0[r]);
#pragma unroll
    for (int r = 0; r < 16; ++r) pmax = fmaxf(pmax, p1[r]);
    { auto rr = __builtin_amdgcn_permlane32_swap(__float_as_uint(pmax), __float_as_uint(pmax), false, false);
      pmax = fmaxf(__uint_as_float(rr[0]), __uint_as_float(rr[1])); }
    if (__builtin_expect(__all(pmax - m_reg <= (float)THRI / SCALE), 1)) { mn = m_reg; alpha = 1.f; }
    else { mn = fmaxf(m_reg, pmax); alpha = __builtin_amdgcn_exp2f((m_reg - mn) * C); m_reg = mn; }
    const float mnC = -mn * C;
#pragma unroll
    for (int r = 0; r < 16; ++r) p0[r] = fmaf(p0[r], C, mnC);
#pragma unroll
    for (int r = 0; r < 16; ++r) p1[r] = fmaf(p1[r], C, mnC);
#pragma unroll
    for (int r = 0; r < 16; ++r) p0[r] = __builtin_amdgcn_exp2f(p0[r]);
}
__device__ __forceinline__ void finishSM(f32x16& p0, f32x16& p1, float alpha, float& l_reg, bf16x8& pa0, bf16x8& pa1, bf16x8& pa2, bf16x8& pa3) {
#pragma unroll
    for (int r = 0; r < 16; ++r) p1[r] = __builtin_amdgcn_exp2f(p1[r]);
    float ps = 0;
#pragma unroll
    for (int r = 0; r < 16; ++r) ps += p0[r];
#pragma unroll
    for (int r = 0; r < 16; ++r) ps += p1[r];
    { auto rr = __builtin_amdgcn_permlane32_swap(__float_as_uint(ps), __float_as_uint(ps), false, false);
      ps = __uint_as_float(rr[0]) + __uint_as_float(rr[1]); }
    l_reg = l_reg * alpha + ps;
#define PK4(P, BASE, OUT) do { unsigned a0 = cvtpk(P[BASE + 0], P[BASE + 1]), a1 = cvtpk(P[BASE + 2], P[BASE + 3]);   \
    unsigned b0 = cvtpk(P[BASE + 4], P[BASE + 5]), b1 = cvtpk(P[BASE + 6], P[BASE + 7]);                              \
    auto r0 = __builtin_amdgcn_permlane32_swap(a0, b0, false, false); auto r1 = __builtin_amdgcn_permlane32_swap(a1, b1, false, false); \
    u32x4 w = {r0[0], r1[0], r0[1], r1[1]}; OUT = *reinterpret_cast<bf16x8*>(&w); } while (0)
    PK4(p0, 0, pa0); PK4(p0, 8, pa1); PK4(p1, 0, pa2); PK4(p1, 8, pa3);
#undef PK4
}
template <int DQK> __device__ __forceinline__ void qkt(f32x16& p0, f32x16& p1, const LAS char* Ks, const bf16x8* qr, int r32, int hi) {
    constexpr int KP = Cfg<DQK>::KP, ND = Cfg<DQK>::ND;
    p0 = f32x16{}; p1 = f32x16{};
#pragma unroll
    for (int d0 = 0; d0 < ND; ++d0) { const int cb = (d0 * 16 + hi * 8) * 2;
        bf16x8 b0 = *reinterpret_cast<const LAS bf16x8*>(Ks + KSWZ(KP, r32, cb));
        bf16x8 b1 = *reinterpret_cast<const LAS bf16x8*>(Ks + KSWZ(KP, 32 + r32, cb));
        p0 = __builtin_amdgcn_mfma_f32_32x32x16_bf16(b0, qr[d0], p0, 0, 0, 0);
        p1 = __builtin_amdgcn_mfma_f32_32x32x16_bf16(b1, qr[d0], p1, 0, 0, 0); }
}
__device__ __forceinline__ int v_st(int k, int c) { const int kk = (k & ~0xC) | ((k & 4) << 1) | ((k & 8) >> 1); return ((kk >> 3) * 4 + (c >> 5)) * 512 + ((kk & 7) * 32 + (c & 31)) * 2; }
__device__ __forceinline__ int v_rd_base(int lane) { return ((lane & 3) << 3) | (((lane >> 2) & 3) << 6) | (((lane >> 4) & 1) << 5) | (((lane >> 5) & 1) << 8); }
constexpr int v_rd_off(int d0, int ks, int half) { return d0 * 512 + ks * 4096 + half * 2048; }
template <int OFF> __device__ __forceinline__ s16x4 tr_read(int vb) {
    s16x4 r; asm volatile("ds_read_b64_tr_b16 %0, %1 offset:%2" : "=&v"(r) : "v"(vb), "i"(OFF) : "memory"); return r;
}
template <int D0, bool TR = false> __device__ __forceinline__ void pv_one(f32x16& od, int vb, bf16x8 pa0, bf16x8 pa1, bf16x8 pa2, bf16x8 pa3) {
    const s16x4 l0 = tr_read<v_rd_off(D0, 0, 0)>(vb), h0 = tr_read<v_rd_off(D0, 0, 1)>(vb), l1 = tr_read<v_rd_off(D0, 1, 0)>(vb), h1 = tr_read<v_rd_off(D0, 1, 1)>(vb);
    const s16x4 l2 = tr_read<v_rd_off(D0, 2, 0)>(vb), h2 = tr_read<v_rd_off(D0, 2, 1)>(vb), l3 = tr_read<v_rd_off(D0, 3, 0)>(vb), h3 = tr_read<v_rd_off(D0, 3, 1)>(vb);
    asm volatile("s_waitcnt lgkmcnt(0)" ::: "memory"); SBAR();
#define PK(L, H) (bf16x8){L[0], L[1], L[2], L[3], H[0], H[1], H[2], H[3]}
    if constexpr (TR) {
    od = __builtin_amdgcn_mfma_f32_32x32x16_bf16(PK(l0, h0), pa0, od, 0, 0, 0);
    od = __builtin_amdgcn_mfma_f32_32x32x16_bf16(PK(l1, h1), pa1, od, 0, 0, 0);
    od = __builtin_amdgcn_mfma_f32_32x32x16_bf16(PK(l2, h2), pa2, od, 0, 0, 0);
    od = __builtin_amdgcn_mfma_f32_32x32x16_bf16(PK(l3, h3), pa3, od, 0, 0, 0);
    } else {
    od = __builtin_amdgcn_mfma_f32_32x32x16_bf16(pa0, PK(l0, h0), od, 0, 0, 0);
    od = __builtin_amdgcn_mfma_f32_32x32x16_bf16(pa1, PK(l1, h1), od, 0, 0, 0);
    od = __builtin_amdgcn_mfma_f32_32x32x16_bf16(pa2, PK(l2, h2), od, 0, 0, 0);
    od = __builtin_amdgcn_mfma_f32_32x32x16_bf16(pa3, PK(l3, h3), od, 0, 0, 0);
    }
#undef PK
}
template <bool TR = false> __device__ __forceinline__ void pv_d0(f32x16* o, int vb, bf16x8 pa0, bf16x8 pa1, bf16x8 pa2, bf16x8 pa3) {
    pv_one<0, TR>(o[0], vb, pa0, pa1, pa2, pa3); pv_one<1, TR>(o[1], vb, pa0, pa1, pa2, pa3); pv_one<2, TR>(o[2], vb, pa0, pa1, pa2, pa3); pv_one<3, TR>(o[3], vb, pa0, pa1, pa2, pa3);
}
__device__ __forceinline__ bf16x8 ld8(const bf16_t* p) { return *reinterpret_cast<const bf16x8*>(p); }
__device__ __forceinline__ void rope_frag(bf16x8& a, bf16x8& b, const f32x2* tab) {
    u32x4 wa = *reinterpret_cast<u32x4*>(&a), wb = *reinterpret_cast<u32x4*>(&b), oa, ob;
#pragma unroll
    for (int q = 0; q < 4; ++q) {
        const float x1l = bflo(wa[q]), x1h = bfhi(wa[q]), x2l = bflo(wb[q]), x2h = bfhi(wb[q]);
        const f32x2 t0 = tab[2 * q], t1 = tab[2 * q + 1];
        oa[q] = cvtpk(x1l * t0.x - x2l * t0.y, x1h * t1.x - x2h * t1.y);
        ob[q] = cvtpk(x2l * t0.x + x1l * t0.y, x2h * t1.x + x1h * t1.y);
    }
    a = *reinterpret_cast<bf16x8*>(&oa); b = *reinterpret_cast<bf16x8*>(&ob);
}
template <int DQK, int SDEPTH, bool MLA, int ldq, int ldkv, int ldo, bool OUT8 = false>
__device__ __forceinline__ void attn_unit(const bf16_t* __restrict__ Qb, const bf16_t* __restrict__ Kh, const bf16_t* __restrict__ KRh, const bf16_t* __restrict__ Vh,
                                          bf16_t* __restrict__ Ob, int seq, LAS char* lds, const f32x2* __restrict__ tabm, int qt0, int wave_s) {
    constexpr int KP = Cfg<DQK>::KP, SHM_K = Cfg<DQK>::SHM_K, ND = Cfg<DQK>::ND;
    const int tid = tid_fresh(wave_s), wid = tid >> 6, lane = tid & 63, r32 = lane & 31, hi = lane >> 5;
    LAS char* V_lds = lds; LAS char* K_lds = lds + 2 * SHM_V;
    LAS float* wsl = (LAS float*)(lds + 2 * SHM_V + 2 * SHM_K) + wid * 64; LAS float* li_l = wsl; LAS float* al_l = wsl + 32;
    float m_reg = -1e30f, l_reg = 0; f32x16 o[4] = {}; bf16x8 qr[ND];
    const bf16_t* Qw = Qb + (long)(wid * QBLK + r32) * ldq + hi * 8;
#pragma unroll
    for (int d0 = 0; d0 < ND; ++d0) qr[d0] = ld8(Qw + d0 * 16);
    if constexpr (MLA) {
        const int t = qt0 + wid * QBLK + r32, prow = t >> 6, pcol = t & 63;
        rope_frag(qr[8], qr[9], tabm + prow * 16 + hi * 8);
        rope_frag(qr[10], qr[11], tabm + pcol * 16 + hi * 8);
    }
    const int sr = tid >> 4, sc = (tid & 15) * 8, vst0 = v_st(sr, sc), vst1 = v_st(32 + sr, sc);
    const int krr = tid >> 3, krc = (tid & 7) * 8;
    const int vb0 = (int)(unsigned)(uintptr_t)V_lds + v_rd_base(lane);
    struct { bf16x8 vs0, vs1, ks0, ks1, kr; } sr_[SDEPTH];
#define SLOAD(i, k0) do { sr_[i].vs0 = ld8(&Vh[(long)((k0) + sr) * ldkv + sc]); sr_[i].vs1 = ld8(&Vh[(long)((k0) + 32 + sr) * ldkv + sc]); \
    sr_[i].ks0 = ld8(&Kh[(long)((k0) + sr) * ldkv + sc]); sr_[i].ks1 = ld8(&Kh[(long)((k0) + 32 + sr) * ldkv + sc]); \
    if constexpr (MLA) sr_[i].kr = ld8(&KRh[(long)((k0) + krr) * 64 + krc]); } while (0)
#define SWRITE(b, i) do { *(LAS bf16x8*)(V_lds + (b) * SHM_V + vst0) = sr_[i].vs0;          \
    *(LAS bf16x8*)(V_lds + (b) * SHM_V + vst1) = sr_[i].vs1; const int kc = sc * 2;               \
    *(LAS bf16x8*)(K_lds + (b) * SHM_K + KSWZ(KP, sr, kc)) = sr_[i].ks0;                       \
    *(LAS bf16x8*)(K_lds + (b) * SHM_K + KSWZ(KP, 32 + sr, kc)) = sr_[i].ks1;                  \
    if constexpr (MLA) *(LAS bf16x8*)(K_lds + (b) * SHM_K + KSWZ(KP, krr, 256 + krc * 2)) = sr_[i].kr; } while (0)
#define SWAIT() do { if constexpr (SDEPTH == 2) { if constexpr (MLA) asm volatile("s_waitcnt vmcnt(5)" ::: "memory"); else asm volatile("s_waitcnt vmcnt(4)" ::: "memory"); } else asm volatile("s_waitcnt vmcnt(0)" ::: "memory"); } while (0)
#define RESC(a) do { if (__any((a) < 1.f)) { if (hi == 0) al_l[r32] = (a); asm volatile("s_waitcnt lgkmcnt(0)" ::: "memory"); \
    _Pragma("unroll") for (int d = 0; d < 4; ++d) _Pragma("unroll") for (int r = 0; r < 16; ++r) o[d][r] *= al_l[crow(r, hi)]; } } while (0)
    bf16x8 pa0, pa1, pa2, pa3; const int NT = seq / KVBLK;
    if constexpr (MLA) {
        f32x16 p0, p1; float mn, al;
        SLOAD(0, 0); asm volatile("s_waitcnt vmcnt(0)" ::: "memory"); SWRITE(0, 0); SLOAD(0, KVBLK); __syncthreads();
        for (int j = 0; j < NT; ++j) {
            const int cb = j & 1;
            if (j + 1 < NT) { asm volatile("s_waitcnt vmcnt(0)" ::: "memory"); SWRITE(cb ^ 1, 0); if (j + 2 < NT) SLOAD(0, (j + 2) * KVBLK); }
            SBAR(); qkt<DQK>(p0, p1, K_lds + cb * SHM_K, qr, r32, hi);
            partialSM<DQK>(p0, p1, m_reg, mn, al); RESC(al);
            finishSM(p0, p1, al, l_reg, pa0, pa1, pa2, pa3); SBAR();
            pv_d0(o, vb0 + cb * SHM_V, pa0, pa1, pa2, pa3);
            __syncthreads();
        }
    } else {
    f32x16 pA0, pA1, pB0, pB1; float mnA, mnB, alA, alB;
    constexpr int SE = 0, SO = SDEPTH - 1;
    SLOAD(SE, 0); asm volatile("s_waitcnt vmcnt(0)" ::: "memory"); SWRITE(0, SE); __syncthreads();
    qkt<DQK>(pA0, pA1, K_lds, qr, r32, hi); partialSM<DQK>(pA0, pA1, m_reg, mnA, alA);
    SLOAD(SO, KVBLK); if constexpr (SDEPTH == 2) { if (2 < NT) SLOAD(SE, 2 * KVBLK); }
    SWAIT(); SWRITE(1, SO); __syncthreads();
    for (int j = 1; j + 1 < NT; j += 2) {
        SBAR(); qkt<DQK>(pB0, pB1, K_lds + SHM_K, qr, r32, hi);
        finishSM(pA0, pA1, alA, l_reg, pa0, pa1, pa2, pa3); SBAR();
        SLOAD(SO, (j + SDEPTH) * KVBLK); SBAR();
        pv_d0(o, vb0, pa0, pa1, pa2, pa3); partialSM<DQK>(pB0, pB1, m_reg, mnB, alB);
        __syncthreads(); SWAIT(); SWRITE(0, SE);
        RESC(alB); __syncthreads();
        SBAR(); qkt<DQK>(pA0, pA1, K_lds, qr, r32, hi);
        finishSM(pB0, pB1, alB, l_reg, pa0, pa1, pa2, pa3); SBAR();
        if (SDEPTH == 1 || j + 3 < NT) SLOAD(SE, (j + 1 + SDEPTH) * KVBLK); SBAR();
        pv_d0(o, vb0 + SHM_V, pa0, pa1, pa2, pa3); partialSM<DQK>(pA0, pA1, m_reg, mnA, alA);
        __syncthreads(); SWAIT(); SWRITE(1, SO);
        RESC(alA); __syncthreads();
    }
    SBAR(); qkt<DQK>(pB0, pB1, K_lds + SHM_K, qr, r32, hi);
    finishSM(pA0, pA1, alA, l_reg, pa0, pa1, pa2, pa3); SBAR();
    pv_d0(o, vb0, pa0, pa1, pa2, pa3); partialSM<DQK>(pB0, pB1, m_reg, mnB, alB);
    __syncthreads(); RESC(alB);
    finishSM(pB0, pB1, alB, l_reg, pa0, pa1, pa2, pa3); SBAR();
    pv_d0(o, vb0 + SHM_V, pa0, pa1, pa2, pa3);
    }
    if (hi == 0) li_l[r32] = l_reg; asm volatile("s_waitcnt lgkmcnt(0)" ::: "memory");
    float rli[16];
#pragma unroll
    for (int r = 0; r < 16; ++r) rli[r] = __builtin_amdgcn_rcpf(li_l[crow(r, hi)]);
    bf16_t* Ow = OUT8 ? (bf16_t*)((unsigned char*)Ob + (long)(wid * QBLK) * ldo) : Ob + (long)(wid * QBLK) * ldo;
#pragma unroll
    for (int r = 0; r < 16; ++r) { const int orow = crow(r, hi);
#pragma unroll
        for (int d0 = 0; d0 < 4; ++d0) { if constexpr (OUT8) ((unsigned char*)Ow)[(long)orow * ldo + d0 * 32 + r32] = (unsigned char)(pk4_fp8(o[d0][r] * rli[r] * 16.f, 0.f, 0.f, 0.f) & 0xffu);
            else Ow[(long)orow * ldo + d0 * 32 + r32] = f2bf(o[d0][r] * rli[r]); } }
    __syncthreads();
#undef SLOAD
#undef SWRITE
#undef SWAIT
#undef RESC
}
template <int KP> __device__ __forceinline__ int kswz8(int row, int byte) { return row * KP + ((((byte >> 4) ^ (KP == 192 ? ((row >> 2) & 3) : ((row >> 1) & 7)))) << 4) + (byte & 15); }
__device__ __forceinline__ u32x2 bf8_to_fp8x4(bf16x8 v) { const u32x4 w = *reinterpret_cast<const u32x4*>(&v);
    return (u32x2){pk4_fp8_nc(bflo(w.x) * 4.f, bfhi(w.x) * 4.f, bflo(w.y) * 4.f, bfhi(w.y) * 4.f), pk4_fp8_nc(bflo(w.z) * 4.f, bfhi(w.z) * 4.f, bflo(w.w) * 4.f, bfhi(w.w) * 4.f)}; }
__device__ __forceinline__ u32x2 bf8_to_fp8x4s(bf16x8 v, float sc) { const u32x4 w = *reinterpret_cast<const u32x4*>(&v);
    return (u32x2){pk4_fp8_nc(bflo(w.x) * sc, bfhi(w.x) * sc, bflo(w.y) * sc, bfhi(w.y) * sc), pk4_fp8_nc(bflo(w.z) * sc, bfhi(w.z) * sc, bflo(w.w) * sc, bfhi(w.w) * sc)}; }
template <int DQ, bool ROPEQ, int ldq, int ldkv, int ldo, bool OUT8, bool PV8 = (ATT_PV_FP8 != 0), bool Q8IN = false>
__device__ __forceinline__ void attn_unit_qk8(const bf16_t* __restrict__ Qb, const bf16_t* __restrict__ Kh, const bf16_t* __restrict__ KRh, const bf16_t* __restrict__ Vh,
                                               bf16_t* __restrict__ Ob, int seq, LAS char* lds, const f32x2* __restrict__ tabm, int qt0, int wave_s) {
    constexpr int SHM_K8 = KVBLK * DQ, NS = DQ / 64, SHM_VV = PV8 ? KVBLK * 128 : SHM_V;
    const int tid = tid_fresh(wave_s), wid = tid >> 6, lane = tid & 63, r32 = lane & 31, hi = lane >> 5;
    LAS char* V_lds = lds; LAS char* K_lds = lds + 2 * SHM_VV;
    LAS float* wsl = (LAS float*)(lds + 2 * SHM_VV + 2 * SHM_K8) + wid * 64; LAS float* li_l = wsl; LAS float* al_l = wsl + 32;
    float m_reg = -1e30f, l_reg = 0; f32x16 o[4] = {}; i32x8 q8[NS];
    constexpr bool LSM = PV8 && (ATT_OT != 0) && (ATT_LSUM_MFMA != 0); f32x16 osum = {}; (void)osum;
    constexpr bool FOLD = LSM && (ATT_FOLD != 0);
    constexpr float QMUL = FOLD ? Cfg<DQ>::SCALE * 1.4426950408889634f * 32.f : 4.f;
    f32x16 negM = {}; (void)negM;
    {
        const bf16_t* Qw = Qb + (long)(wid * QBLK + r32) * ldq + hi * 32;
        const int t = qt0 + wid * QBLK + r32; const f32x2* tb = ROPEQ ? tabm + (hi ? (t & 63) : (t >> 6)) * 16 : nullptr;
        if constexpr (Q8IN) {
            const unsigned char* Q8w = (const unsigned char*)Qb + (long)(wid * QBLK + r32) * ldq + hi * 32;
#pragma unroll
            for (int s3 = 0; s3 < NS; ++s3) { u32x4 lo4 = *(const u32x4*)(Q8w + s3 * 64), hi4 = *(const u32x4*)(Q8w + s3 * 64 + 16);
                if constexpr (ROPEQ) { if (s3 == 2) {
#pragma unroll
                    for (int w = 0; w < 4; ++w) { const f32x2 x1a = __builtin_amdgcn_cvt_pk_f32_fp8(lo4[w], false), x1b = __builtin_amdgcn_cvt_pk_f32_fp8(lo4[w], true), x2a = __builtin_amdgcn_cvt_pk_f32_fp8(hi4[w], false), x2b = __builtin_amdgcn_cvt_pk_f32_fp8(hi4[w], true);
                        const f32x2 t0 = tb[4 * w], t1 = tb[4 * w + 1], t2 = tb[4 * w + 2], t3 = tb[4 * w + 3];
                        lo4[w] = pk4_fp8(x1a.x * t0.x - x2a.x * t0.y, x1a.y * t1.x - x2a.y * t1.y, x1b.x * t2.x - x2b.x * t2.y, x1b.y * t3.x - x2b.y * t3.y);
                        hi4[w] = pk4_fp8(x2a.x * t0.x + x1a.x * t0.y, x2a.y * t1.x + x1a.y * t1.y, x2b.x * t2.x + x1b.x * t2.y, x2b.y * t3.x + x1b.y * t3.y); } } }
                q8[s3] = (i32x8){(int)lo4.x, (int)lo4.y, (int)lo4.z, (int)lo4.w, (int)hi4.x, (int)hi4.y, (int)hi4.z, (int)hi4.w}; }
        } else {
#pragma unroll
        for (int s3 = 0; s3 < NS; ++s3) { bf16x8 c0 = ld8(Qw + s3 * 64), c1 = ld8(Qw + s3 * 64 + 8), c2 = ld8(Qw + s3 * 64 + 16), c3 = ld8(Qw + s3 * 64 + 24);
            if constexpr (ROPEQ) { if (s3 == 2) { rope_frag(c0, c2, tb); rope_frag(c1, c3, tb + 8); } }
            const u32x2 a = bf8_to_fp8x4s(c0, QMUL), b = bf8_to_fp8x4s(c1, QMUL), c = bf8_to_fp8x4s(c2, QMUL), d = bf8_to_fp8x4s(c3, QMUL);
            q8[s3] = (i32x8){(int)a.x, (int)a.y, (int)b.x, (int)b.y, (int)c.x, (int)c.y, (int)d.x, (int)d.y}; }
        }
    }
    const int sr = tid >> 4, sc = (tid & 15) * 8;
    const int vslot = (sr & 3) | ((sr >> 3) << 2) | (((sr >> 2) & 1) << 4);
    const int vst0 = PV8 ? vslot * 128 + (sc ^ (((vslot >> 1) & 3) << 5)) : v_st(sr, sc), vst1 = PV8 ? (32 + vslot) * 128 + (sc ^ (((vslot >> 1) & 3) << 5)) : v_st(32 + sr, sc);
    const int krr = tid >> 3, krc = (tid & 7) * 8;
    const int kst0 = kswz8<DQ>(sr, sc), kst1 = kswz8<DQ>(32 + sr, sc), kstr = DQ == 192 ? kswz8<DQ>(krr, 128 + krc) : 0;
    const int vb0 = (int)(unsigned)(uintptr_t)V_lds + (PV8 ? ((hi * 32 + ((lane & 15) >> 1)) * 128 + ((lane >> 4) & 1) * 16 + (lane & 1) * 8) : v_rd_base(lane));
    bf16x8 vs0, vs1, ks0, ks1, kr;
    constexpr bool KV8 = PV8 && (ATT_KV8IN != 0);
    constexpr bool OT = PV8 && (ATT_OT != 0);
    const int ckey = tid >> 3, cch = (tid & 7) * 16, rkey = (tid >> 2) & 63, rch = (tid & 3) * 16;
    const int cslot = (ckey & 32) | (ckey & 3) | (((ckey & 31) >> 3) << 2) | (((ckey >> 2) & 1) << 4);
    u32x4 k8, v8, r8;
    constexpr bool KVDMA = KV8 && (ATT_KVDMA != 0); constexpr int NCH = DQ / 16, NKJ = DQ / 16, NJ = NKJ + 8;
    const int widu = __builtin_amdgcn_readfirstlane(wid); (void)widu;
    const unsigned char* jp0 = nullptr; const unsigned char* jp1 = nullptr; const unsigned char* jp2 = nullptr; unsigned js0 = 0, js1 = 0, js2 = 0; (void)jp0; (void)jp1; (void)jp2; (void)js0; (void)js1; (void)js2;
    if constexpr (KVDMA) {
#define KVD_SETUP(JP, JS, Q) do { const int job = widu + 8 * (Q); const bool isK = job < NKJ; \
            const int c = job * 64 + lane, row = (c / NCH) & 63, pos = c - (c / NCH) * NCH, chk = pos ^ (DQ == 192 ? ((row >> 2) & 3) : ((row >> 1) & 7)); \
            const int slot = ((job - NKJ) * 8 + (lane >> 3)) & 63, key = (slot & 32) | (slot & 3) | (((slot >> 2) & 3) << 3) | (((slot >> 4) & 1) << 2), chv = (lane & 7) ^ (((slot >> 1) & 3) << 1); \
            const bool rope = isK && (DQ == 192) && (chk >= 8); \
            const unsigned long long bK = (unsigned long long)(uintptr_t)Kh, bR = (unsigned long long)(uintptr_t)KRh, bV = (unsigned long long)(uintptr_t)Vh; \
            const unsigned long long base_ = isK ? (rope ? bR : bK) : bV; \
            const long off_ = isK ? (rope ? (long)row * 64 + (chk - 8) * 16 : (long)row * ldkv + chk * 16) : (long)key * ldkv + chv * 16; \
            JP = (const unsigned char*)(uintptr_t)(base_ + (unsigned long long)off_); JS = rope ? (unsigned)(KVBLK * 64) : (unsigned)(KVBLK * ldkv); } while (0)
        KVD_SETUP(jp0, js0, 0); KVD_SETUP(jp1, js1, 1); KVD_SETUP(jp2, js2, 2);
#undef KVD_SETUP
    }
#define KVD_ONE(JP, JS, Q, b) do { const int job = widu + 8 * (Q); \
        if (job < NKJ) { __builtin_amdgcn_global_load_lds((const unsigned*)(JP), (LAS unsigned*)(K_lds + (b) * SHM_K8 + job * 1024), 16, 0, 0); JP += JS; } \
        if (job >= NKJ && job < NJ) { __builtin_amdgcn_global_load_lds((const unsigned*)(JP), (LAS unsigned*)(V_lds + (b) * SHM_VV + (job - NKJ) * 1024), 16, 0, 0); JP += JS; } } while (0)
#define KVD_ISSUE(b) do { KVD_ONE(jp0, js0, 0, b); KVD_ONE(jp1, js1, 1, b); if constexpr (NJ > 16) KVD_ONE(jp2, js2, 2, b); } while (0)
#define SLOAD8(k0) do { if constexpr (KV8) { k8 = *(const u32x4*)((const unsigned char*)Kh + (long)((k0) + ckey) * ldkv + cch); v8 = *(const u32x4*)((const unsigned char*)Vh + (long)((k0) + ckey) * ldkv + cch); \
    if constexpr (DQ == 192) { if (tid < 256) r8 = *(const u32x4*)((const unsigned char*)KRh + (long)((k0) + rkey) * 64 + rch); } } else { vs0 = ld8(&Vh[(long)((k0) + sr) * ldkv + sc]); vs1 = ld8(&Vh[(long)((k0) + 32 + sr) * ldkv + sc]); \
    ks0 = ld8(&Kh[(long)((k0) + sr) * ldkv + sc]); ks1 = ld8(&Kh[(long)((k0) + 32 + sr) * ldkv + sc]); if constexpr (DQ == 192) kr = ld8(&KRh[(long)((k0) + krr) * 64 + krc]); } } while (0)
#define SWRITE8(b) do { if constexpr (KV8) { *(LAS u32x4*)(K_lds + (b) * SHM_K8 + kswz8<DQ>(ckey, cch)) = k8; *(LAS u32x4*)(V_lds + (b) * SHM_VV + cslot * 128 + (cch ^ (((cslot >> 1) & 3) << 5))) = v8; \
    if constexpr (DQ == 192) { if (tid < 256) *(LAS u32x4*)(K_lds + (b) * SHM_K8 + kswz8<DQ>(rkey, 128 + rch)) = r8; } } else { if constexpr (PV8) { *(LAS u32x2*)(V_lds + (b) * SHM_VV + vst0) = bf8_to_fp8x4(vs0); *(LAS u32x2*)(V_lds + (b) * SHM_VV + vst1) = bf8_to_fp8x4(vs1); } \
    else { *(LAS bf16x8*)(V_lds + (b) * SHM_VV + vst0) = vs0; *(LAS bf16x8*)(V_lds + (b) * SHM_VV + vst1) = vs1; } \
    *(LAS u32x2*)(K_lds + (b) * SHM_K8 + kst0) = bf8_to_fp8x4(ks0); *(LAS u32x2*)(K_lds + (b) * SHM_K8 + kst1) = bf8_to_fp8x4(ks1); if constexpr (DQ == 192) *(LAS u32x2*)(K_lds + (b) * SHM_K8 + kstr) = bf8_to_fp8x4(kr); } } while (0)
#define RESC8(a) do { if (__any((a) < 1.f)) { if constexpr (OT) { _Pragma("unroll") for (int d = 0; d < 4; ++d) _Pragma("unroll") for (int r = 0; r < 16; ++r) o[d][r] *= (a); if constexpr (LSM) { _Pragma("unroll") for (int r = 0; r < 16; ++r) osum[r] *= (a); } } \
    else { if (hi == 0) al_l[r32] = (a); asm volatile("s_waitcnt lgkmcnt(0)" ::: "memory"); \
    _Pragma("unroll") for (int d = 0; d < 4; ++d) _Pragma("unroll") for (int r = 0; r < 16; ++r) o[d][r] *= al_l[crow(r, hi)]; } } } while (0)
    bf16x8 pa0, pa1, pa2, pa3; const int NT = seq / KVBLK; f32x16 p0, p1; float mn, al;
    i32x8 ones8 = (i32x8){0x38383838, 0x38383838, 0x38383838, 0x38383838, 0x38383838, 0x38383838, 0x38383838, 0x38383838}; asm volatile("" : "+v"(ones8));
    if constexpr (KVDMA) { KVD_ISSUE(0); __syncthreads(); }
    else { SLOAD8(0); asm volatile("s_waitcnt vmcnt(0)" ::: "memory"); SWRITE8(0); SLOAD8(KVBLK); __syncthreads(); }
#pragma unroll 2
    for (int j = 0; j < NT; ++j) {
        const int cb = j & 1;
        if constexpr (KVDMA) { if (j + 1 < NT) KVD_ISSUE(cb ^ 1); }
        else if (j + 1 < NT) { asm volatile("s_waitcnt vmcnt(0)" ::: "memory"); SWRITE8(cb ^ 1); if (j + 2 < NT) SLOAD8((j + 2) * KVBLK); }
        SBAR();
        { const LAS char* Ks = K_lds + cb * SHM_K8; if constexpr (FOLD) { p0 = negM; p1 = negM; } else { p0 = f32x16{}; p1 = f32x16{}; }
#pragma unroll
          for (int s3 = 0; s3 < NS; ++s3) { const int b0 = 64 * s3 + 32 * hi;
              const i32x4 a0 = *(const LAS i32x4*)(Ks + kswz8<DQ>(r32, b0)), a1 = *(const LAS i32x4*)(Ks + kswz8<DQ>(r32, b0 + 16));
              const i32x4 c0 = *(const LAS i32x4*)(Ks + kswz8<DQ>(32 + r32, b0)), c1 = *(const LAS i32x4*)(Ks + kswz8<DQ>(32 + r32, b0 + 16));
              p0 = __builtin_amdgcn_mfma_scale_f32_32x32x64_f8f6f4(__builtin_shufflevector(a0, a1, 0, 1, 2, 3, 4, 5, 6, 7), q8[s3], p0, 0, 0, 0, 0x7F7F7F7F, 0, FOLD ? 0x78787878 : 0x7F7F7F7F);
              p1 = __builtin_amdgcn_mfma_scale_f32_32x32x64_f8f6f4(__builtin_shufflevector(c0, c1, 0, 1, 2, 3, 4, 5, 6, 7), q8[s3], p1, 0, 0, 0, 0x7F7F7F7F, 0, FOLD ? 0x78787878 : 0x7F7F7F7F); } }
        if constexpr (FOLD) {
            float pmax = p0[0];
#pragma unroll
            for (int r = 1; r < 16; ++r) pmax = fmaxf(pmax, p0[r]);
#pragma unroll
            for (int r = 0; r < 16; ++r) pmax = fmaxf(pmax, p1[r]);
            { auto rr = __builtin_amdgcn_permlane32_swap(__float_as_uint(pmax), __float_as_uint(pmax), false, false); pmax = fmaxf(__uint_as_float(rr[0]), __uint_as_float(rr[1])); }
            constexpr float T2 = 5.f * 1.4426950408889634f;
            al = 1.f;
            if (j == 0 || !__all(pmax <= T2)) {
                const float d = (j == 0) ? pmax : fmaxf(pmax, 0.f);
                al = (j == 0) ? 1.f : __builtin_amdgcn_exp2f(-d);
#pragma unroll
                for (int r = 0; r < 16; ++r) { p0[r] -= d; p1[r] -= d; negM[r] -= d; }
            }
#pragma unroll
            for (int r = 0; r < 16; ++r) p0[r] = __builtin_amdgcn_exp2f(p0[r]);
            RESC8(al);
        } else { partialSM<DQ, 16, PV8 ? 5 : 8>(p0, p1, m_reg, mn, al); RESC8(al); }
        if constexpr (PV8) {
            SBAR();
            const int vb = vb0 + cb * SHM_VV;
            u32x2 tv[4][4];
            const int vsx = ((lane & 15) >> 2) & 3; const int vbd[4] = {vb + ((0 ^ vsx) << 5), vb + ((1 ^ vsx) << 5), vb + ((2 ^ vsx) << 5), vb + ((3 ^ vsx) << 5)};
#define PV8_RD(D0, T) asm volatile("ds_read_b64_tr_b8 %0, %1 offset:%2" : "=&v"(tv[D0][T]) : "v"(vbd[D0]), "i"((T) * 1024) : "memory")
            PV8_RD(0, 0); PV8_RD(0, 1); PV8_RD(0, 2); PV8_RD(0, 3); PV8_RD(1, 0); PV8_RD(1, 1); PV8_RD(1, 2); PV8_RD(1, 3);
            PV8_RD(2, 0); PV8_RD(2, 1); PV8_RD(2, 2); PV8_RD(2, 3); PV8_RD(3, 0); PV8_RD(3, 1); PV8_RD(3, 2); PV8_RD(3, 3);
#undef PV8_RD
            SBAR();
#pragma unroll
            for (int r = 0; r < 16; ++r) p1[r] = __builtin_amdgcn_exp2f(p1[r]);
            if constexpr (!LSM) { float ps = 0;
#pragma unroll
                for (int r = 0; r < 16; ++r) ps += p0[r] + p1[r];
                l_reg = l_reg * al + sum32(ps, ps); }
            unsigned a0[4], a1[4];
#pragma unroll
            for (int q = 0; q < 4; ++q) { a0[q] = pk4_fp8_nz(p0[4 * q], p0[4 * q + 1], p0[4 * q + 2], p0[4 * q + 3]); a1[q] = pk4_fp8_nz(p1[4 * q], p1[4 * q + 1], p1[4 * q + 2], p1[4 * q + 3]); }
            i32x8 pf;
#pragma unroll
            for (int q = 0; q < 4; ++q) { auto rr = __builtin_amdgcn_permlane32_swap(a0[q], a1[q], false, false); pf[q] = (int)rr[0]; pf[4 + q] = (int)rr[1]; }
            asm volatile("s_waitcnt lgkmcnt(0)" ::: "memory"); SBAR();
#pragma unroll
            for (int d0 = 0; d0 < 4; ++d0) { const i32x8 vf = (i32x8){(int)tv[d0][0].x, (int)tv[d0][0].y, (int)tv[d0][1].x, (int)tv[d0][1].y, (int)tv[d0][2].x, (int)tv[d0][2].y, (int)tv[d0][3].x, (int)tv[d0][3].y};
                if constexpr (LSM) { if (d0 == 0) {
                    osum = __builtin_amdgcn_mfma_scale_f32_32x32x64_f8f6f4(ones8, pf, osum, 0, 0, 0, 0x7F7F7F7F, 0, 0x7F7F7F7F); } }
                if constexpr (OT) o[d0] = __builtin_amdgcn_mfma_scale_f32_32x32x64_f8f6f4(vf, pf, o[d0], 0, 0, 0, 0x7F7F7F7F, 0, 0x7F7F7F7F);
                else o[d0] = __builtin_amdgcn_mfma_scale_f32_32x32x64_f8f6f4(pf, vf, o[d0], 0, 0, 0, 0x7F7F7F7F, 0, 0x7F7F7F7F); }
        } else {
        finishSM(p0, p1, al, l_reg, pa0, pa1, pa2, pa3); SBAR();
        pv_d0(o, vb0 + cb * SHM_VV, pa0, pa1, pa2, pa3);
        }
        __syncthreads();
    }
    bf16_t* Ow = OUT8 ? (bf16_t*)((unsigned char*)Ob + (long)(wid * QBLK) * ldo) : Ob + (long)(wid * QBLK) * ldo;
    if constexpr (OT) {
        const float rl = __builtin_amdgcn_rcpf(LSM ? osum[0] : l_reg) * (OUT8 ? 4.f : 0.25f);
        LAS char* T = lds + wid * (OUT8 ? 4096 : 8192);
        if constexpr (OUT8) {
#pragma unroll
            for (int d0 = 0; d0 < 4; ++d0)
#pragma unroll
                for (int g = 0; g < 4; ++g) { const unsigned w = pk4_fp8(o[d0][4 * g] * rl, o[d0][4 * g + 1] * rl, o[d0][4 * g + 2] * rl, o[d0][4 * g + 3] * rl);
                    *(LAS unsigned*)(T + r32 * 128 + (((d0 * 2 + (g >> 1)) ^ (r32 & 7)) << 4) + (g & 1) * 8 + 4 * hi) = w; }
            asm volatile("s_waitcnt lgkmcnt(0)" ::: "memory");
#pragma unroll
            for (int i = 0; i < 4; ++i) { const int R = (lane >> 3) + 8 * i, j = lane & 7; const u32x4 v = *(const LAS u32x4*)(T + R * 128 + ((j ^ (R & 7)) << 4));
                *(u32x4*)((unsigned char*)Ow + (long)R * ldo + j * 16) = v; }
        } else {
#pragma unroll
            for (int d0 = 0; d0 < 4; ++d0)
#pragma unroll
                for (int g = 0; g < 4; ++g) { u32x2 w; w.x = cvtpk(o[d0][4 * g] * rl, o[d0][4 * g + 1] * rl); w.y = cvtpk(o[d0][4 * g + 2] * rl, o[d0][4 * g + 3] * rl);
                    *(LAS u32x2*)(T + r32 * 256 + (((d0 * 4 + g) ^ (r32 & 15)) << 4) + 8 * hi) = w; }
            asm volatile("s_waitcnt lgkmcnt(0)" ::: "memory");
#pragma unroll
            for (int i = 0; i < 8; ++i) { const int R = (lane >> 4) + 4 * i, j = lane & 15; const u32x4 v = *(const LAS u32x4*)(T + R * 256 + ((j ^ (R & 15)) << 4));
                *(u32x4*)((char*)Ow + ((long)R * ldo) * 2 + j * 16) = v; }
        }
    } else {
    if (hi == 0) li_l[r32] = l_reg; asm volatile("s_waitcnt lgkmcnt(0)" ::: "memory");
    float rli[16];
#pragma unroll
    for (int r = 0; r < 16; ++r) rli[r] = __builtin_amdgcn_rcpf(li_l[crow(r, hi)]) * (PV8 ? 0.25f : 1.f);
#pragma unroll
    for (int r = 0; r < 16; ++r) { const int orow = crow(r, hi);
#pragma unroll
        for (int d0 = 0; d0 < 4; ++d0) { if constexpr (OUT8) ((unsigned char*)Ow)[(long)orow * ldo + d0 * 32 + r32] = (unsigned char)(pk4_fp8(o[d0][r] * rli[r] * 16.f, 0.f, 0.f, 0.f) & 0xffu);
            else Ow[(long)orow * ldo + d0 * 32 + r32] = f2bf(o[d0][r] * rli[r]); } }
    }
    __syncthreads();
#undef SLOAD8
#undef KVD_ONE
#undef KVD_ISSUE
#undef SWRITE8
#undef RESC8
}
}

template <int MODE> __device__ __forceinline__ int dst_row(int n) {
    if (MODE == 1) { const int half = n >> 10, c = n & 1023; return ((c >> 7) << 8) + (half << 7) + (c & 127); }
    if (MODE == 2) { const int h = n >> 8, j = n & 255; return j < 128 ? (h << 7) + j : 1024 + (h << 7) + (j - 128); }
    return n;
}
template <int MODE> __device__ __forceinline__ void p0_transpose_item_fp8(const float* W, int K, int N, unsigned char* WT, LAS float* scr, int item, int lane) {
    const int nblk = N / 32, kb = item / nblk, nb = item % nblk, k0 = 64 * kb, n0 = 32 * nb;
#pragma unroll 8
    for (int i = 0; i < 32; ++i) { const int kk = 2 * i + (lane >> 5); scr[kk * 33 + (lane & 31)] = W[(size_t)(k0 + kk) * N + n0 + (lane & 31)]; }
    LDS_WAIT(); asm volatile("" ::: "memory");
    const int c = lane & 7;
#pragma unroll
    for (int j = 0; j < 4; ++j) { const int n = (lane >> 3) + 8 * j; const LAS float* s = scr + (8 * c) * 33 + n;
        u32x2 o; o.x = pk4_fp8(s[0 * 33] * 64.f, s[1 * 33] * 64.f, s[2 * 33] * 64.f, s[3 * 33] * 64.f); o.y = pk4_fp8(s[4 * 33] * 64.f, s[5 * 33] * 64.f, s[6 * 33] * 64.f, s[7 * 33] * 64.f);
        *(u32x2*)(WT + (size_t)dst_row<MODE>(n0 + n) * K + k0 + 8 * c) = o; }
    LDS_WAIT(); asm volatile("" ::: "memory");
}
template <int MODE> __device__ __forceinline__ void p0_transpose_item64_fp8(const float* W, int K, int N, unsigned char* WT, LAS float* scr, int item, int lane) {
    const int nblk = N / 64, kb = item / nblk, nb = item % nblk, k0 = 64 * kb, n0 = 64 * nb;
#pragma unroll 4
    for (int i = 0; i < 16; ++i) { const int kk = 4 * i + (lane >> 4), nc = (lane & 15) * 4; const f32x4 v = *(const f32x4*)(W + (size_t)(k0 + kk) * N + n0 + nc);
        LAS float* d = scr + kk * 65 + nc; d[0] = v.x; d[1] = v.y; d[2] = v.z; d[3] = v.w; }
    LDS_WAIT(); asm volatile("" ::: "memory");
    const int c = lane & 7;
#pragma unroll
    for (int j = 0; j < 8; ++j) { const int n = (lane >> 3) + 8 * j; const LAS float* s = scr + (8 * c) * 65 + n;
        u32x2 o; o.x = pk4_fp8(s[0 * 65] * 64.f, s[1 * 65] * 64.f, s[2 * 65] * 64.f, s[3 * 65] * 64.f); o.y = pk4_fp8(s[4 * 65] * 64.f, s[5 * 65] * 64.f, s[6 * 65] * 64.f, s[7 * 65] * 64.f);
        *(u32x2*)(WT + (size_t)dst_row<MODE>(n0 + n) * K + k0 + 8 * c) = o; }
    LDS_WAIT(); asm volatile("" ::: "memory");
}
template <int MODE> __device__ __forceinline__ void p0_transpose_item128_fp8(const float* W, int K, int N, unsigned char* WT, LAS unsigned char* scr, int item, int lane) {
    const int nblk = N / 64, kb = item / nblk, nb = item % nblk, k0 = 128 * kb, n0 = 64 * nb, kq = lane >> 4, nq = lane & 15;
#pragma unroll 4
    for (int i = 0; i < 8; ++i) { const float* src = W + (size_t)(k0 + 4 * (4 * i + kq)) * N + n0 + 4 * nq;
        const f32x4 v0 = NT_LD((const f32x4*)src), v1 = NT_LD((const f32x4*)(src + N)), v2 = NT_LD((const f32x4*)(src + 2 * (size_t)N)), v3 = NT_LD((const f32x4*)(src + 3 * (size_t)N));
        LAS unsigned char* d = scr + (4 * nq) * 128 + ((i ^ (nq & 7)) << 4) + kq * 4;
        *(LAS unsigned*)(d) = pk4_fp8(v0.x * 64.f, v1.x * 64.f, v2.x * 64.f, v3.x * 64.f); *(LAS unsigned*)(d + 128) = pk4_fp8(v0.y * 64.f, v1.y * 64.f, v2.y * 64.f, v3.y * 64.f);
        *(LAS unsigned*)(d + 256) = pk4_fp8(v0.z * 64.f, v1.z * 64.f, v2.z * 64.f, v3.z * 64.f); *(LAS unsigned*)(d + 384) = pk4_fp8(v0.w * 64.f, v1.w * 64.f, v2.w * 64.f, v3.w * 64.f); }
    LDS_WAIT(); asm volatile("" ::: "memory");
#pragma unroll
    for (int j = 0; j < 8; ++j) { const int n = (lane >> 3) + 8 * j, pc = lane & 7; const u32x4 o = *(const LAS u32x4*)(scr + n * 128 + ((pc ^ ((n >> 2) & 7)) << 4));
        *(u32x4*)(WT + (size_t)dst_row<MODE>(n0 + n) * K + k0 + 16 * pc) = o; }
    LDS_WAIT(); asm volatile("" ::: "memory");
}
template <int MODE> __device__ __forceinline__ void p0_transpose_item(const float* W, int K, int N, bf16_t* WT, LAS float* scr, int item, int lane) {
    const int nblk = N / 32, kb = item / nblk, nb = item % nblk, k0 = 64 * kb, n0 = 32 * nb;
#pragma unroll 8
    for (int i = 0; i < 32; ++i) { const int kk = 2 * i + (lane >> 5); scr[kk * 33 + (lane & 31)] = W[(size_t)(k0 + kk) * N + n0 + (lane & 31)]; }
    LDS_WAIT(); asm volatile("" ::: "memory");
    const int c = lane & 7;
#pragma unroll
    for (int j = 0; j < 4; ++j) { const int n = (lane >> 3) + 8 * j; const LAS float* s = scr + (8 * c) * 33 + n;
        u32x4 o; o.x = cvtpk(s[0 * 33], s[1 * 33]); o.y = cvtpk(s[2 * 33], s[3 * 33]); o.z = cvtpk(s[4 * 33], s[5 * 33]); o.w = cvtpk(s[6 * 33], s[7 * 33]);
        *(u32x4*)(WT + (size_t)dst_row<MODE>(n0 + n) * K + k0 + 8 * c) = o; }
    LDS_WAIT(); asm volatile("" ::: "memory");
}
__device__ __forceinline__ void p0_prologue(Frame& F) {
    uchar* ws = F.ws;
    {
        LAS float* S = (LAS float*)F.lds;
        const float* pC = INP(I_C); const float* pCC = INP(I_CCTX); const float* pAW = INP(I_ADAW); const float* pAB = INP(I_ADAB); const float* pNM = INP(I_NMIXG); const float* pNF = INP(I_NFFNG);
        float* MOD = (float*)(ws + WS_MOD);
        for (int item = F.bid; item < 192; item += F.G) {
            const int layer = item / 96, n0 = (item % 96) * 64;
            __syncthreads();
            for (int u = F.tid; u < 33 * 1024; u += 512) { const int j = u >> 10, k = u & 1023; const float c = j < 32 ? pC[j * 1024 + k] : pCC[k]; S[u] = silu_f(c); }
            __syncthreads();
            float acc[33];
#pragma unroll
            for (int j = 0; j < 33; ++j) acc[j] = 0.f;
            const float* wp = pAW + (size_t)layer * 1024 * 6144 + n0 + F.lane;
            const int kbeg = F.wave * 128;
            for (int k = kbeg; k < kbeg + 128; k += 4) {
                const float w0 = wp[(size_t)k * 6144], w1 = wp[(size_t)(k + 1) * 6144], w2 = wp[(size_t)(k + 2) * 6144], w3 = wp[(size_t)(k + 3) * 6144];
#pragma unroll
                for (int j = 0; j < 33; ++j) { const f32x4 s = *(const LAS f32x4*)(S + j * 1024 + k); acc[j] += s.x * w0 + s.y * w1 + s.z * w2 + s.w * w3; }
            }
            __syncthreads();
#pragma unroll
            for (int j = 0; j < 33; ++j) S[(F.wave * 33 + j) * 64 + F.lane] = acc[j];
            __syncthreads();
            for (int u = F.tid; u < 33 * 64; u += 512) { const int j = u >> 6, cl = u & 63; float s = 0.f;
#pragma unroll
                for (int w = 0; w < 8; ++w) s += S[(w * 33 + j) * 64 + cl];
                const int n = n0 + cl, part = n >> 10, col = n & 1023;
                s += pAB[layer * 6144 + n];
                if (part == 1) s = pNM[layer * 1024 + col] * (1.f + s);
                if (part == 4) s = pNF[layer * 1024 + col] * (1.f + s);
                MOD[((size_t)(layer * 33 + j) * 6 + part) * 1024 + col] = s; }
        }
        __syncthreads();
    }
    {
        const int gt = F.bid * 512 + F.tid, NT = F.G * 512;
        f32x2* tg = (f32x2*)(ws + WS_TABG); f32x2* tm = (f32x2*)(ws + WS_TABM);
        for (int u = gt; u < 64 * 32; u += NT) { const int pos = u >> 5, i = u & 31; const float inv = powf(10000.f, -(float)(2 * i) / 64.f); const float a = (float)pos * inv; tg[u] = (f32x2){cosf(a), sinf(a)}; }
        for (int u = gt; u < 64 * 16; u += NT) { const int pos = u >> 4, i = u & 15; const float inv = powf(10000.f, -(float)(2 * i) / 32.f); const float a = (float)pos * inv; tm[u] = (f32x2){cosf(a), sinf(a)}; }
        float* wrt = (float*)(ws + WS_WRT); const float* pRW = INP(I_RW); const float* pSW = INP(I_SGUW);
        for (int u = gt; u < 2 * 32 * 1024; u += NT) { const int l = u >> 15, e = (u >> 10) & 31, k = u & 1023; wrt[u] = pRW[((size_t)l * 1024 + k) * 32 + e]; }
        bf16_t* sw = (bf16_t*)(ws + WS_SGUW);
        for (int u = gt; u < 4 * 128 * 128; u += NT) sw[u] = f2bf(pSW[u]);
        u32x4* z = (u32x4*)(ws + WS_WIN1 + (size_t)832 * 1024 * (PROJ1_FP8 ? 1 : 2));
        for (int u = gt; u < 192 * 1024 * (PROJ1_FP8 ? 1 : 2) / 16; u += NT) z[u] = (u32x4){0u, 0u, 0u, 0u};
    }
    {
        LAS float* scr = (LAS float*)(F.lds + F.wave * 16640);
        const int gw = F.bid * 8 + F.wave, NGW = F.G * 8; const float* pW1 = INP(I_W1); const float* pW2 = INP(I_W2);
        constexpr int J0 = 16 * 64, J1 = 16 * 32, J2 = 16 * 26, J3 = 8 * 48, J4 = 4 * 64, J5 = 16 * 32, JW1 = MOE_FP8 ? (P0_ITEM128 ? 64 * 256 : 64 * 512) : 64 * 1024, JW2 = MOE_FP8 ? (P0_ITEM128 ? 64 * 128 : 64 * 256) : 64 * 512;
        constexpr int NITEMS = J0 + J1 + J2 + J3 + J4 + J5 + JW1 + JW2;
        const int NX = (P0_REBAL != 0 && F.G == 256) ? 64 * 8 * 3 : 0, gx = gw - 192 * 8;
        for (int k_ = 0; ; ++k_) {
            int it;
            if (NX != 0 && gx >= 0 && k_ < 3) it = gx + k_ * 512;
            else { const int kk = k_ - ((NX != 0 && gx >= 0) ? 3 : 0); it = NX + gw + kk * NGW; if (it >= NITEMS) break; }
            int r = it;
#if MOE_FP8
#if P0_ITEM128
            if (r < JW1) { const int le = r >> 8; p0_transpose_item128_fp8<1>(pW1 + (size_t)le * 1024 * 2048, 1024, 2048, (unsigned char*)(ws + WS_W1) + (size_t)le * 2048 * 1024, (LAS unsigned char*)scr, r & 255, F.lane); continue; } r -= JW1;
            if (r < JW2) { const int le = r >> 7; p0_transpose_item128_fp8<0>(pW2 + (size_t)le * 1024 * 1024, 1024, 1024, (unsigned char*)(ws + WS_W2) + (size_t)le * 1024 * 1024, (LAS unsigned char*)scr, r & 127, F.lane); continue; } r -= JW2;
#else
            if (r < JW1) { const int le = r >> 9; p0_transpose_item64_fp8<1>(pW1 + (size_t)le * 1024 * 2048, 1024, 2048, (unsigned char*)(ws + WS_W1) + (size_t)le * 2048 * 1024, scr, r & 511, F.lane); continue; } r -= JW1;
            if (r < JW2) { const int le = r >> 8; p0_transpose_item64_fp8<0>(pW2 + (size_t)le * 1024 * 1024, 1024, 1024, (unsigned char*)(ws + WS_W2) + (size_t)le * 1024 * 1024, scr, r & 255, F.lane); continue; } r -= JW2;
#endif
#else
            if (r < JW1) { const int le = r >> 10; p0_transpose_item<1>(pW1 + (size_t)le * 1024 * 2048, 1024, 2048, (bf16_t*)(ws + WS_W1) + (size_t)le * 2048 * 1024, scr, r & 1023, F.lane); continue; } r -= JW1;
            if (r < JW2) { const int le = r >> 9; p0_transpose_item<0>(pW2 + (size_t)le * 1024 * 1024, 1024, 1024, (bf16_t*)(ws + WS_W2) + (size_t)le * 1024 * 1024, scr, r & 511, F.lane); continue; } r -= JW2;
#endif
            if (r < J0) { if constexpr (PROJ0_FP8 != 0) p0_transpose_item_fp8<0>(INP(I_ABWIN), 1024, 2048, (unsigned char*)(ws + WS_WIN0), scr, r, F.lane); else p0_transpose_item<0>(INP(I_ABWIN), 1024, 2048, (bf16_t*)(ws + WS_WIN0), scr, r, F.lane); continue; } r -= J0;
            if (r < J1) { if constexpr (OUT0_FP8 != 0) p0_transpose_item_fp8<0>(INP(I_ABWOUT), 1024, 1024, (unsigned char*)(ws + WS_WOUT0), scr, r, F.lane); else p0_transpose_item<0>(INP(I_ABWOUT), 1024, 1024, (bf16_t*)(ws + WS_WOUT0), scr, r, F.lane); continue; } r -= J1;
            if (r < J2) { if constexpr (PROJ1_FP8 != 0) p0_transpose_item_fp8<0>(INP(I_MLAWIN), 1024, 832, (unsigned char*)(ws + WS_WIN1), scr, r, F.lane); else p0_transpose_item<0>(INP(I_MLAWIN), 1024, 832, (bf16_t*)(ws + WS_WIN1), scr, r, F.lane); continue; } r -= J2;
            if (r < J3) { if constexpr (UPQ_FP8 != 0) p0_transpose_item_fp8<0>(INP(I_MLAWUQ), 512, 1536, (unsigned char*)(ws + WS_WUQ), scr, r, F.lane); else p0_transpose_item<0>(INP(I_MLAWUQ), 512, 1536, (bf16_t*)(ws + WS_WUQ), scr, r, F.lane); continue; } r -= J3;
            if (r < J4) { if constexpr (UPKV_FP8 != 0) p0_transpose_item_fp8<2>(INP(I_MLAWUKV), 256, 2048, (unsigned char*)(ws + WS_WUKV), scr, r, F.lane); else p0_transpose_item<2>(INP(I_MLAWUKV), 256, 2048, (bf16_t*)(ws + WS_WUKV), scr, r, F.lane); continue; } r -= J4;
            if constexpr (OUT1_FP8 != 0) p0_transpose_item_fp8<0>(INP(I_MLAWOUT), 1024, 1024, (unsigned char*)(ws + WS_WOUT1), scr, r, F.lane); else p0_transpose_item<0>(INP(I_MLAWOUT), 1024, 1024, (bf16_t*)(ws + WS_WOUT1), scr, r, F.lane);
        }
    }
}

__device__ __forceinline__ void row_src_ptr(const float* px, const float* pctx, int r, const float*& src, int& mj) {
    const int b = r / TPB, pos = r - b * TPB;
    if (pos < CTXL) { src = pctx + ((size_t)b * CTXL + pos) * DM; mj = 32; } else { src = px + ((size_t)b * SEQ + (pos - CTXL)) * DM; mj = b; }
}
__device__ __forceinline__ f32x4 bf4(u32x2 w) { return (f32x4){bflo(w.x), bfhi(w.x), bflo(w.y), bfhi(w.y)}; }
__device__ __forceinline__ u32x2 pk4bf(f32x4 v) { return (u32x2){cvtpk(v.x, v.y), cvtpk(v.z, v.w)}; }
__device__ __forceinline__ void store_h_row(bf16_t* hrow, int lane, const f32x4 (&h)[4]) {
    unsigned long long* o8 = (unsigned long long*)hrow + lane;
#pragma unroll
    for (int j = 0; j < 4; ++j) o8[64 * j] = (unsigned long long)cvtpk(h[j].x, h[j].y) | ((unsigned long long)cvtpk(h[j].z, h[j].w) << 32);
}
__device__ __forceinline__ void p_norm0(Frame& F) {
    const float* MOD = (const float*)(F.ws + WS_MOD); bf16_t* H = (bf16_t*)(F.ws + WS_H);
    const int gw = F.bid * 8 + F.wave, NGW = F.G * 8; const float* px = INP(I_X); const float* pctx = INP(I_CTX);
    for (int r = gw; r < NTOK; r += NGW) {
        const float* src; int mj; row_src_ptr(px, pctx, r, src, mj);
        const f32x4* xr = (const f32x4*)src + F.lane; f32x4 v[4]; float ss = 0.f;
#pragma unroll
        for (int j = 0; j < 4; ++j) { v[j] = xr[64 * j]; ss += (v[j].x * v[j].x + v[j].y * v[j].y) + (v[j].z * v[j].z + v[j].w * v[j].w); }
        const float rstd = rsqrtf(wave_sum(ss) * (1.f / DM) + EPS);
        const f32x4* sh = (const f32x4*)(MOD + ((size_t)(0 * 33 + mj) * 6 + 0) * 1024) + F.lane; const f32x4* A = (const f32x4*)(MOD + ((size_t)(0 * 33 + mj) * 6 + 1) * 1024) + F.lane;
        f32x4 h[4];
#pragma unroll
        for (int j = 0; j < 4; ++j) h[j] = v[j] * rstd * A[64 * j] + sh[64 * j];
        if constexpr (PROJ0_FP8 != 0) { unsigned* o4 = (unsigned*)((unsigned char*)H + (size_t)r * DM) + F.lane;
#pragma unroll
            for (int j = 0; j < 4; ++j) o4[64 * j] = pk4_fp8(h[j].x * 4.f, h[j].y * 4.f, h[j].z * 4.f, h[j].w * 4.f); }
        else store_h_row(H + (size_t)r * DM, F.lane, h);
    }
}
__device__ __forceinline__ void p_norm0_v2(Frame& F) {
    const float* MOD = (const float*)(F.ws + WS_MOD); bf16_t* H = (bf16_t*)(F.ws + WS_H); const float* px = INP(I_X); const float* pctx = INP(I_CTX);
    const int RPW = (NTOK + F.G - 1) / F.G, r_first = F.bid * RPW, r_last = (r_first + RPW < NTOK) ? r_first + RPW : NTOK;
    int ra = r_first;
    while (ra < r_last) {
        const int b = ra / TPB, pos = ra - b * TPB; const bool cx = pos < CTXL; const int mj = cx ? 32 : b; int rb = cx ? b * TPB + CTXL : (b + 1) * TPB; rb = rb < r_last ? rb : r_last;
        f32x4 Av[4], Sv[4];
        { const f32x4* sh = (const f32x4*)(MOD + ((size_t)(0 * 33 + mj) * 6 + 0) * 1024) + F.lane; const f32x4* A = (const f32x4*)(MOD + ((size_t)(0 * 33 + mj) * 6 + 1) * 1024) + F.lane;
#pragma unroll
          for (int j = 0; j < 4; ++j) { Av[j] = A[64 * j]; Sv[j] = sh[64 * j]; } }
        const int r0 = ra + F.wave, n = (rb - r0 + 7) >> 3;
        if (n > 0) {
            const float* sbase = cx ? pctx + ((size_t)b * CTXL + (r0 - b * TPB)) * DM : px + ((size_t)b * SEQ + (r0 - b * TPB - CTXL)) * DM;
            f32x4 RA[4], RB[4], RC[4]; int i = 0;
#define N0_ISSUE(T_, idx) do { const int i_ = (idx) < n ? (idx) : n - 1; const f32x4* xr_ = (const f32x4*)(sbase + (size_t)i_ * 8 * DM) + F.lane; \
            _Pragma("unroll") for (int j = 0; j < 4; ++j) T_[j] = NT_LD(xr_ + 64 * j); __builtin_amdgcn_sched_barrier(0); } while (0)
#define N0_COMP(T_, idx) do { float ss_ = 0.f; _Pragma("unroll") for (int j = 0; j < 4; ++j) ss_ += (T_[j].x * T_[j].x + T_[j].y * T_[j].y) + (T_[j].z * T_[j].z + T_[j].w * T_[j].w); \
            const float rstd_ = rsqrtf(wave_sum(ss_) * (1.f / DM) + EPS); f32x4 h_[4]; _Pragma("unroll") for (int j = 0; j < 4; ++j) h_[j] = T_[j] * rstd_ * Av[j] + Sv[j]; \
            if constexpr (PROJ0_FP8 != 0) { unsigned* o4_ = (unsigned*)((unsigned char*)H + (size_t)(r0 + 8 * (idx)) * DM) + F.lane; \
                _Pragma("unroll") for (int j = 0; j < 4; ++j) o4_[64 * j] = pk4_fp8(h_[j].x * 4.f, h_[j].y * 4.f, h_[j].z * 4.f, h_[j].w * 4.f); } \
            else store_h_row(H + (size_t)(r0 + 8 * (idx)) * DM, F.lane, h_); __builtin_amdgcn_sched_barrier(0); } while (0)
            N0_ISSUE(RA, 0); N0_ISSUE(RB, 1);
            for (; i + 3 <= n; i += 3) {
                N0_ISSUE(RC, i + 2); N0_COMP(RA, i);
                N0_ISSUE(RA, i + 3); N0_COMP(RB, i + 1);
                N0_ISSUE(RB, i + 4); N0_COMP(RC, i + 2);
            }
            if (i < n) N0_COMP(RA, i);
            if (i + 1 < n) N0_COMP(RB, i + 1);
#undef N0_ISSUE
#undef N0_COMP
        }
        ra = rb;
    }
}
__device__ __forceinline__ void moe_prefix(Frame& F, int layer) {
    LAS int* pb = (LAS int*)(F.lds + XTRA_OFF + X_PB); LAS int* cn = (LAS int*)(F.lds + XTRA_OFF + X_CNT);
    const unsigned* gc = (const unsigned*)(F.ws + WS_CTL) + CW_CNT + layer * 64;
    __syncthreads();
    if (F.tid == 0) { int s = 0; for (int e = 0; e < 32; ++e) { const int c = (int)__hip_atomic_load(gc + e, __ATOMIC_RELAXED, __HIP_MEMORY_SCOPE_AGENT); cn[e] = c; pb[e] = s; s += (c + 255) >> 8; } pb[32] = s; }
    __syncthreads();
    {
        LAS unsigned* bt = (LAS unsigned*)(F.lds + XTRA_OFF + X_BT); const int tot = pb[32];
        for (int blk = F.tid; blk < BT_N; blk += 512) { int lo = 0;
#pragma unroll
            for (int st = 16; st >= 1; st >>= 1) { if (pb[lo + st] <= blk) lo += st; }
            bt[blk] = blk < tot ? ((unsigned)lo << 16) | (unsigned)(blk - pb[lo]) : 0xffffffffu; }
    }
    __syncthreads();
}
__device__ __forceinline__ void moe_gather_row(const Frame& F, int r, f32x4 (&f)[4]) {
    const LAS int* pb = (const LAS int*)(F.lds + XTRA_OFF + X_PB);
    const u32x2* ti = (const u32x2*)(F.ws + WS_TOKI) + (size_t)r * 4; const bf16_t* Y = (const bf16_t*)(F.ws + WS_Y);
#pragma unroll
    for (int j = 0; j < 4; ++j) f[j] = (f32x4){0.f, 0.f, 0.f, 0.f};
#pragma unroll
    for (int k = 0; k < 4; ++k) {
        const u32x2 t = ti[k]; const int e = (int)(t.x >> 20), pos = (int)(t.x & 0xfffffu); const float g = __uint_as_float(t.y);
        const size_t yrow = (size_t)pb[e] * 256 + pos;
#if Y_FP8
        const unsigned* yp = (const unsigned*)((const unsigned char*)Y + yrow * DM) + F.lane; const float g16 = g * (1.f / 16.f);
#pragma unroll
        for (int j = 0; j < 4; ++j) { const unsigned w = yp[64 * j]; const f32x2 lo = __builtin_amdgcn_cvt_pk_f32_fp8(w, false), hi2 = __builtin_amdgcn_cvt_pk_f32_fp8(w, true);
            f[j].x += g16 * lo.x; f[j].y += g16 * lo.y; f[j].z += g16 * hi2.x; f[j].w += g16 * hi2.y; }
#else
        const u32x2* yp = (const u32x2*)(Y + yrow * DM) + F.lane;
#pragma unroll
        for (int j = 0; j < 4; ++j) { const u32x2 w = yp[64 * j]; f[j].x += g * bflo(w.x); f[j].y += g * bfhi(w.x); f[j].z += g * bflo(w.y); f[j].w += g * bfhi(w.y); }
#endif
    }
}
__device__ __forceinline__ void p_combine_norm(Frame& F, int dry) {
    moe_prefix(F, 0);
    const float* MOD = (const float*)(F.ws + WS_MOD); bf16_t* H = (bf16_t*)(F.ws + (dry ? WS_SCR + 288 * MiB : WS_H)); bf16_t* XR = (bf16_t*)(F.ws + WS_XR); bf16_t* XW = dry ? (bf16_t*)(F.ws + WS_SCR) : XR;
    const int gw = F.bid * 8 + F.wave, NGW = F.G * 8;
    for (int r = gw; r < NTOK; r += NGW) {
        const int b = r / TPB, pos = r - b * TPB, mj = pos < CTXL ? 32 : b;
        f32x4 f[4]; moe_gather_row(F, r, f);
        const u32x2* xr = (const u32x2*)(XR + (size_t)r * DM) + F.lane; u32x2* xw = (u32x2*)(XW + (size_t)r * DM) + F.lane; const f32x4* g2 = (const f32x4*)(MOD + ((size_t)(0 * 33 + mj) * 6 + 5) * 1024) + F.lane;
        f32x4 v[4]; float ss = 0.f;
#pragma unroll
        for (int j = 0; j < 4; ++j) { v[j] = bf4(xr[64 * j]) + g2[64 * j] * f[j]; xw[64 * j] = pk4bf(v[j]); ss += (v[j].x * v[j].x + v[j].y * v[j].y) + (v[j].z * v[j].z + v[j].w * v[j].w); }
        const float rstd = rsqrtf(wave_sum(ss) * (1.f / DM) + EPS);
        const f32x4* sh = (const f32x4*)(MOD + ((size_t)(1 * 33 + mj) * 6 + 0) * 1024) + F.lane; const f32x4* A = (const f32x4*)(MOD + ((size_t)(1 * 33 + mj) * 6 + 1) * 1024) + F.lane;
        f32x4 h[4];
#pragma unroll
        for (int j = 0; j < 4; ++j) h[j] = v[j] * rstd * A[64 * j] + sh[64 * j];
        if constexpr (PROJ1_FP8 != 0) { unsigned* o4 = (unsigned*)((unsigned char*)H + (size_t)r * DM) + F.lane;
#pragma unroll
            for (int j = 0; j < 4; ++j) o4[64 * j] = pk4_fp8(h[j].x * 4.f, h[j].y * 4.f, h[j].z * 4.f, h[j].w * 4.f); }
        else store_h_row(H + (size_t)r * DM, F.lane, h);
    }
}
__device__ __forceinline__ void p_final(Frame& F) {
    moe_prefix(F, 1);
    const float* MOD = (const float*)(F.ws + WS_MOD); const bf16_t* XR = (const bf16_t*)(F.ws + WS_XR);
    const int gw = F.bid * 8 + F.wave, NGW = F.G * 8; const float* pfg = INP(I_FNG);
    for (int q = gw; q < NBATCH * SEQ; q += NGW) {
        const int b = q >> 11, t = q & 2047, r = b * TPB + CTXL + t;
        f32x4 f[4]; moe_gather_row(F, r, f);
        const u32x2* xr = (const u32x2*)(XR + (size_t)r * DM) + F.lane; const f32x4* g2 = (const f32x4*)(MOD + ((size_t)(1 * 33 + b) * 6 + 5) * 1024) + F.lane;
        f32x4 v[4]; float ss = 0.f;
#pragma unroll
        for (int j = 0; j < 4; ++j) { v[j] = bf4(xr[64 * j]) + g2[64 * j] * f[j]; ss += (v[j].x * v[j].x + v[j].y * v[j].y) + (v[j].z * v[j].z + v[j].w * v[j].w); }
        const float rstd = rsqrtf(wave_sum(ss) * (1.f / DM) + EPS);
        const f32x4* fg = (const f32x4*)pfg + F.lane; f32x4* op = (f32x4*)(F.out + (size_t)q * DM) + F.lane;
#pragma unroll
        for (int j = 0; j < 4; ++j) op[64 * j] = v[j] * rstd * fg[64 * j];
    }
}
struct TokIn { u32x4 y[4]; float g[4]; u32x4 x0, x1; };
__device__ __forceinline__ void tok_issue(const Frame& F, const LAS u32x2* tl  , int r, TokIn& t) {
    const LAS int* pb = (const LAS int*)(F.lds + XTRA_OFF + X_PB); const unsigned char* Y = (const unsigned char*)(F.ws + WS_Y);
#pragma unroll
    for (int k = 0; k < 4; ++k) { const u32x2 tt = tl[k]; const int e = (int)(tt.x >> 20), pos = (int)(tt.x & 0xfffffu); t.g[k] = __uint_as_float(tt.y) * (1.f / 16.f);
        t.y[k] = NT_LD((const u32x4*)(Y + ((size_t)pb[e] * 256 + pos) * DM + F.lane * 16)); }
    const unsigned char* xp = (const unsigned char*)(F.ws + WS_XR) + (size_t)r * (DM * 2) + F.lane * 32; t.x0 = NT_LD((const u32x4*)xp); t.x1 = NT_LD((const u32x4*)(xp + 16));
}
__device__ __forceinline__ float tok_mix(const TokIn& t, const f32x4 (&g2)[4], float (&v)[16]) {
    float f[16];
#pragma unroll
    for (int i = 0; i < 16; ++i) f[i] = 0.f;
#pragma unroll
    for (int k = 0; k < 4; ++k)
#pragma unroll
        for (int q = 0; q < 4; ++q) { const unsigned w = t.y[k][q]; const f32x2 lo = __builtin_amdgcn_cvt_pk_f32_fp8(w, false), hi2 = __builtin_amdgcn_cvt_pk_f32_fp8(w, true);
            f[4 * q] += t.g[k] * lo.x; f[4 * q + 1] += t.g[k] * lo.y; f[4 * q + 2] += t.g[k] * hi2.x; f[4 * q + 3] += t.g[k] * hi2.y; }
    float ss = 0.f;
#pragma unroll
    for (int i = 0; i < 8; ++i) { const unsigned w = i < 4 ? t.x0[i & 3] : t.x1[i & 3]; v[2 * i] = bflo(w) + g2[(2 * i) >> 2][(2 * i) & 3] * f[2 * i]; v[2 * i + 1] = bfhi(w) + g2[(2 * i + 1) >> 2][(2 * i + 1) & 3] * f[2 * i + 1];
        ss += v[2 * i] * v[2 * i] + v[2 * i + 1] * v[2 * i + 1]; }
    return ss;
}
template <bool FINAL> __device__ __forceinline__ int cmb_row(int q) { return FINAL ? (q >> 11) * TPB + CTXL + (q & 2047) : q; }
template <bool FINAL> __device__ __forceinline__ void tok_compute(const Frame& F, const TokIn& t, int q, const f32x4 (&g2)[4], const f32x4 (&Av)[4], const f32x4 (&shv)[4], unsigned char* XW, unsigned char* H8) {
    float v[16]; const float ss = tok_mix(t, g2, v); LAS char* T = (LAS char*)F.lds + F.wave * 4096;
    if constexpr (!FINAL) { const int r = q;
        u32x4 w0, w1;
#pragma unroll
        for (int i = 0; i < 4; ++i) { w0[i] = cvtpk(v[2 * i], v[2 * i + 1]); w1[i] = cvtpk(v[8 + 2 * i], v[8 + 2 * i + 1]); }
        *(LAS u32x4*)(T + F.lane * 32) = w0; *(LAS u32x4*)(T + F.lane * 32 + 16) = w1;
        const u32x4 a0 = *(const LAS u32x4*)(T + F.lane * 16), a1 = *(const LAS u32x4*)(T + 1024 + F.lane * 16);
        unsigned char* xo = XW + (size_t)r * (DM * 2) + F.lane * 16; *(u32x4*)xo = a0; *(u32x4*)(xo + 1024) = a1;
        const float rstd = rsqrtf(wave_sum(ss) * (1.f / DM) + EPS);
        u32x4 hw;
#pragma unroll
        for (int i = 0; i < 4; ++i) hw[i] = pk4_fp8((v[4 * i] * rstd * Av[i].x + shv[i].x) * 4.f, (v[4 * i + 1] * rstd * Av[i].y + shv[i].y) * 4.f, (v[4 * i + 2] * rstd * Av[i].z + shv[i].z) * 4.f, (v[4 * i + 3] * rstd * Av[i].w + shv[i].w) * 4.f);
        *(u32x4*)(H8 + (size_t)r * DM + F.lane * 16) = hw;
    } else {
        const float rstd = rsqrtf(wave_sum(ss) * (1.f / DM) + EPS);
#pragma unroll
        for (int i = 0; i < 4; ++i) *(LAS f32x4*)(T + F.lane * 64 + i * 16) = (f32x4){v[4 * i] * rstd * Av[i].x, v[4 * i + 1] * rstd * Av[i].y, v[4 * i + 2] * rstd * Av[i].z, v[4 * i + 3] * rstd * Av[i].w};
        float* op = F.out + (size_t)q * DM + F.lane * 4;
#pragma unroll
        for (int j = 0; j < 4; ++j) { const f32x4 a = *(const LAS f32x4*)(T + j * 1024 + F.lane * 16); NT_ST(a, (f32x4*)(op + j * 256)); }
    }
}
template <bool FINAL> __device__ __forceinline__ void p_combine_v2(Frame& F, int dry) {
    moe_prefix(F, FINAL ? 1 : 0);
    const float* MOD = (const float*)(F.ws + WS_MOD);
    unsigned char* H8 = (unsigned char*)(F.ws + (dry ? WS_SCR + 288 * MiB : WS_H)); unsigned char* XW = (unsigned char*)(F.ws + (dry ? WS_SCR : WS_XR));
    const int NQ = FINAL ? NBATCH * SEQ : NTOK, RPW = (NQ + F.G - 1) / F.G, q_first = F.bid * RPW, q_last = (q_first + RPW < NQ) ? q_first + RPW : NQ;
    LAS u32x4* tl4 = (LAS u32x4*)(F.lds + XTRA_OFF + 1024); const u32x4* tg = (const u32x4*)(F.ws + WS_TOKI);
    for (int i = F.tid; i < (q_last - q_first) * 2; i += 512) tl4[i] = tg[(size_t)cmb_row<FINAL>(q_first + (i >> 1)) * 2 + (i & 1)];
    __syncthreads();
    const LAS u32x2* tl = (const LAS u32x2*)tl4;
    int qa = q_first;
    while (qa < q_last) {
        int mj, qb;
        if constexpr (FINAL) { const int b = qa >> 11; mj = b; qb = (b + 1) << 11; }
        else { const int b = qa / TPB, pos = qa - b * TPB; const bool cx = pos < CTXL; mj = cx ? 32 : b; qb = cx ? b * TPB + CTXL : (b + 1) * TPB; }
        qb = qb < q_last ? qb : q_last;
        f32x4 g2[4], Av[4], shv[4];
        { const f32x4* pg = (const f32x4*)(MOD + ((size_t)((FINAL ? 1 : 0) * 33 + mj) * 6 + 5) * 1024) + F.lane * 4;
          const f32x4* pa = FINAL ? (const f32x4*)INP(I_FNG) + F.lane * 4 : (const f32x4*)(MOD + ((size_t)(1 * 33 + mj) * 6 + 1) * 1024) + F.lane * 4;
          const f32x4* ps = (const f32x4*)(MOD + ((size_t)(1 * 33 + mj) * 6 + 0) * 1024) + F.lane * 4;
#pragma unroll
          for (int i = 0; i < 4; ++i) { g2[i] = pg[i]; Av[i] = pa[i]; shv[i] = FINAL ? (f32x4){0.f, 0.f, 0.f, 0.f} : ps[i]; } }
        const int q0 = qa + F.wave, n = (qb - q0 + 7) >> 3;
        if (n > 0) {
            TokIn A, B, C; int i = 0;
#define CMB_ISSUE(T_, idx) do { const int i_ = (idx) < n ? (idx) : n - 1, q_ = q0 + 8 * i_; tok_issue(F, tl + (q_ - q_first) * 4, cmb_row<FINAL>(q_), T_); __builtin_amdgcn_sched_barrier(0); } while (0)
#define CMB_COMP(T_, idx) do { tok_compute<FINAL>(F, T_, q0 + 8 * (idx), g2, Av, shv, XW, H8); __builtin_amdgcn_sched_barrier(0); } while (0)
            CMB_ISSUE(A, 0); CMB_ISSUE(B, 1);
            for (; i + 3 <= n; i += 3) {
                CMB_ISSUE(C, i + 2); CMB_COMP(A, i);
                CMB_ISSUE(A, i + 3); CMB_COMP(B, i + 1);
                CMB_ISSUE(B, i + 4); CMB_COMP(C, i + 2);
            }
            if (i < n) CMB_COMP(A, i);
            if (i + 1 < n) CMB_COMP(B, i + 1);
#undef CMB_ISSUE
#undef CMB_COMP
        }
        qa = qb;
    }
}
__device__ __forceinline__ void top4_of16(float (&v)[16], int hi, float (&tv)[4], int (&te)[4]) {
#pragma unroll
    for (int k = 0; k < 4; ++k) { float best = v[0]; int bi = 0;
#pragma unroll
        for (int r = 1; r < 16; ++r) { const bool bt = v[r] > best; best = bt ? v[r] : best; bi = bt ? r : bi; }
        tv[k] = best; te[k] = (bi & 3) + 8 * (bi >> 2) + 4 * hi;
#pragma unroll
        for (int r = 0; r < 16; ++r) v[r] = (r == bi) ? -3.0e38f : v[r]; }
}
template <int LAYER> __device__ __forceinline__ void p_norm_router(Frame& F, int dry) {
    const float* MOD = (const float*)(F.ws + WS_MOD); bf16_t* H = (bf16_t*)(F.ws + WS_H); const bf16_t* XR = (const bf16_t*)(F.ws + WS_XR);
    LAS f32x4* WL4 = (LAS f32x4*)F.lds;
    LAS int* hist = (LAS int*)(F.lds + XTRA_OFF + X_HIST); LAS int* base = (LAS int*)(F.lds + XTRA_OFF + X_BASE); LAS u32x2* sel = (LAS u32x2*)(F.lds + XTRA_OFF + X_SEL);
    LAS f32x4* A2L4 = (LAS f32x4*)(F.lds + XTRA_OFF + X_A2); LAS float* CBL = (LAS float*)(F.lds + XTRA_OFF + X_CB); LAS float* RSL = (LAS float*)(F.lds + XTRA_OFF + X_RS);
    unsigned* gcnt = (unsigned*)(F.ws + WS_CTL) + CW_CNT + LAYER * 64 + (dry ? 128 : 0);
    int* rowl = (int*)(F.ws + WS_ROWL); u32x2* toki = (u32x2*)(F.ws + WS_TOKI);
    const f32x4* wsrc = (const f32x4*)(F.ws + WS_WRT + (size_t)LAYER * 32 * 1024 * 4);
    __syncthreads();
    for (int u = F.tid; u < 8192; u += 512) { const int e = u >> 8, k4 = u & 255; WL4[e * 256 + (k4 ^ (e & 15))] = wsrc[u]; }
    if (F.tid < 32) hist[F.tid] = 0;
    const int lane = F.lane, r32 = lane & 31, hi = lane >> 5; const float* prb = INP(I_RB);
    constexpr int NP = LAYER == 0 ? NPAN : 256;
    for (int pi = F.bid; pi < NP; pi += F.G) {
        const int pan = LAYER == 0 ? pi : pi + pi / 8 + 1;
        const int b = pan / 9, mj = (pan % 9 == 0) ? 32 : b;
        const f32x4* shp = (const f32x4*)(MOD + ((size_t)(LAYER * 33 + mj) * 6 + 3) * 1024); const f32x4* Ap = (const f32x4*)(MOD + ((size_t)(LAYER * 33 + mj) * 6 + 4) * 1024);
        __syncthreads();
        if (F.tid < 256) A2L4[F.tid] = Ap[F.tid];
        {
            const int e = F.tid >> 4, part = F.tid & 15; float sum = 0.f;
#pragma unroll 4
            for (int q = 0; q < 16; ++q) { const f32x4 a = shp[part * 16 + q], w = wsrc[e * 256 + part * 16 + q]; sum += (a.x * w.x + a.y * w.y) + (a.z * w.z + a.w * w.w); }
            sum += xf1(sum); sum += xf2(sum); sum += xf4(sum); sum += xf8(sum);
            if (part == 0) CBL[e] = sum + prb[LAYER * 32 + e];
        }
        __syncthreads();
        const int row = pan * 256 + F.wave * 32 + r32;
        const u32x2* xp = (const u32x2*)(XR + (size_t)row * DM) + hi;
        const LAS f32x4* wrow = WL4 + r32 * 256; const int swz = r32 & 15;
        f32x16 acc = {}; float ssq = 0.f;
#define RT_LOAD(dst, mb) do { _Pragma("unroll") for (int u = 0; u < 8; ++u) dst[u] = xp[2 * ((mb) + u)]; } while (0)
#define RT_COMP(src, mb) do { _Pragma("unroll") for (int u = 0; u < 8; ++u) { const int k4 = 2 * ((mb) + u) + hi; const f32x4 a4 = A2L4[k4], w4 = wrow[k4 ^ swz]; const f32x4 x = bf4(src[u]); \
                ssq += (x.x * x.x + x.y * x.y) + (x.z * x.z + x.w * x.w); \
                acc = __builtin_amdgcn_mfma_f32_32x32x2f32(w4.x, x.x * a4.x, acc, 0, 0, 0); acc = __builtin_amdgcn_mfma_f32_32x32x2f32(w4.y, x.y * a4.y, acc, 0, 0, 0); \
                acc = __builtin_amdgcn_mfma_f32_32x32x2f32(w4.z, x.z * a4.z, acc, 0, 0, 0); acc = __builtin_amdgcn_mfma_f32_32x32x2f32(w4.w, x.w * a4.w, acc, 0, 0, 0); } } while (0)
        u32x2 xa[8], xb[8];
        RT_LOAD(xa, 0);
#pragma unroll 1
        for (int m0 = 0; m0 < 128; m0 += 16) {
            RT_LOAD(xb, m0 + 8); SBAR();
            RT_COMP(xa, m0); SBAR();
            if (m0 + 16 < 128) RT_LOAD(xa, m0 + 16);
            SBAR(); RT_COMP(xb, m0 + 8); SBAR();
        }
#undef RT_LOAD
#undef RT_COMP
        const float rstd = rsqrtf(sum32(ssq, ssq) * (1.f / DM) + EPS);
        float lg[16];
#pragma unroll
        for (int r = 0; r < 16; ++r) lg[r] = acc[r] * rstd + CBL[(r & 3) + 8 * (r >> 2) + 4 * hi];
        float tv[4], pv[4]; int te[4], pe[4];
        top4_of16(lg, hi, tv, te);
#pragma unroll
        for (int k = 0; k < 4; ++k) { pv[k] = __uint_as_float(xu32(__float_as_uint(tv[k]), lane)); pe[k] = (int)xu32((unsigned)te[k], lane); }
        float cv[8] = {tv[0], tv[1], tv[2], tv[3], pv[0], pv[1], pv[2], pv[3]}; int ce[8] = {te[0], te[1], te[2], te[3], pe[0], pe[1], pe[2], pe[3]};
        float gv[4]; int ge[4];
#pragma unroll
        for (int k = 0; k < 4; ++k) { float best = cv[0]; int be = ce[0];
#pragma unroll
            for (int c = 1; c < 8; ++c) { const bool bt = cv[c] > best || (cv[c] == best && ce[c] < be); best = bt ? cv[c] : best; be = bt ? ce[c] : be; }
            gv[k] = best; ge[k] = be;
#pragma unroll
            for (int c = 0; c < 8; ++c) cv[c] = (ce[c] == be) ? -3.0e38f : cv[c]; }
        const float x1 = __expf(gv[1] - gv[0]), x2 = __expf(gv[2] - gv[0]), x3 = __expf(gv[3] - gv[0]); const float inv = 1.f / (1.f + x1 + x2 + x3);
        {
            const int ea = hi ? ge[2] : ge[0], eb = hi ? ge[3] : ge[1]; const float ga = hi ? x2 * inv : inv, gb = hi ? x3 * inv : x1 * inv;
            const int ra = __hip_atomic_fetch_add(hist + ea, 1, __ATOMIC_RELAXED, __HIP_MEMORY_SCOPE_WORKGROUP), rb2 = __hip_atomic_fetch_add(hist + eb, 1, __ATOMIC_RELAXED, __HIP_MEMORY_SCOPE_WORKGROUP);
            const int rl = F.wave * 32 + r32;
            sel[rl * 4 + 2 * hi] = (u32x2){(unsigned)ea | ((unsigned)ra << 8), __float_as_uint(ga)}; sel[rl * 4 + 2 * hi + 1] = (u32x2){(unsigned)eb | ((unsigned)rb2 << 8), __float_as_uint(gb)};
            if (hi == 0) RSL[rl] = rstd;
        }
        {
            f32x4 Ar[4], Sr[4];
#pragma unroll
            for (int j = 0; j < 4; ++j) { Ar[j] = Ap[lane + 64 * j]; Sr[j] = shp[lane + 64 * j]; }
            for (int rr = 0; rr < 32; rr += 4) {
                const int rw = pan * 256 + F.wave * 32 + rr; f32x4 v[4][4];
#pragma unroll
                for (int t = 0; t < 4; ++t) { const u32x2* xr = (const u32x2*)(XR + (size_t)(rw + t) * DM) + lane;
#pragma unroll
                    for (int j = 0; j < 4; ++j) v[t][j] = bf4(xr[64 * j]); }
#pragma unroll
                for (int t = 0; t < 4; ++t) { const float rs = RSL[F.wave * 32 + rr + t]; f32x4 h[4];
#pragma unroll
                    for (int j = 0; j < 4; ++j) h[j] = v[t][j] * rs * Ar[j] + Sr[j];
                    if constexpr (MOE_FP8 != 0) { unsigned* o4 = (unsigned*)((unsigned char*)H + (size_t)(rw + t) * DM) + lane;
#pragma unroll
                        for (int j = 0; j < 4; ++j) o4[64 * j] = pk4_fp8(h[j].x * 4.f, h[j].y * 4.f, h[j].z * 4.f, h[j].w * 4.f); }
                    else store_h_row(H + (size_t)(rw + t) * DM, lane, h); }
            }
        }
        __syncthreads();
        if (F.tid < 32) { const int c = hist[F.tid]; base[F.tid] = c ? (int)__hip_atomic_fetch_add(gcnt + F.tid, (unsigned)c, __ATOMIC_RELAXED, __HIP_MEMORY_SCOPE_AGENT) : 0; }
        __syncthreads();
        for (int u = F.tid; u < 1024; u += 512) { const u32x2 sv = sel[u]; const int e = (int)(sv.x & 0xffu), pos = base[e] + (int)(sv.x >> 8), r = pan * 256 + (u >> 2);
            rowl[(size_t)e * ROWCAP + pos] = r; toki[(size_t)r * 4 + (u & 3)] = (u32x2){((unsigned)e << 20) | (unsigned)pos, sv.y}; }
        __syncthreads();
        if (F.tid < 32) hist[F.tid] = 0;
    }
    __syncthreads();
}

__device__ __forceinline__ void p_moe_gather(Frame& F, int layer) {
    moe_prefix(F, layer);
    const LAS int* pb = (const LAS int*)(F.lds + XTRA_OFF + X_PB); const LAS int* cn = (const LAS int*)(F.lds + XTRA_OFF + X_CNT);
    const unsigned char* H8 = (const unsigned char*)(F.ws + WS_H); unsigned char* XS = (unsigned char*)(F.ws + WS_XS); const int* rowl = (const int*)(F.ws + WS_ROWL);
    const int nblk = pb[32];
    for (int blk = F.bid; blk < nblk; blk += F.G) {
        int e = 0;
#pragma unroll
        for (int st = 16; st >= 1; st >>= 1) { if (pb[e + st] <= blk) e += st; }
        const int rb = blk - pb[e], n = cn[e] - rb * 256;
        const int* rl = rowl + (size_t)e * ROWCAP + rb * 256 + F.wave * 32;
#pragma unroll 1
        for (int r0 = 0; r0 < 32; r0 += 8) {
            u32x4 v[8]; int tok[8];
#pragma unroll
            for (int q = 0; q < 8; ++q) { const int ri = F.wave * 32 + r0 + q; tok[q] = ri < n ? rl[r0 + q] : -1; }
#pragma unroll
            for (int q = 0; q < 8; ++q) if (tok[q] >= 0) v[q] = *(const u32x4*)(H8 + (size_t)tok[q] * 1024 + F.lane * 16);
#pragma unroll
            for (int q = 0; q < 8; ++q) if (tok[q] >= 0) *(u32x4*)(XS + ((size_t)blk * 256 + F.wave * 32 + r0 + q) * 1024 + F.lane * 16) = v[q];
        }
    }
}

__device__ __forceinline__ void p_qk_prep(Frame& F) {
    bf16_t* P = (bf16_t*)(F.ws + WS_PBUF); const f32x2* tab = (const f32x2*)(F.ws + WS_TABG); unsigned char* KC8 = (unsigned char*)(F.ws + WS_KC8); unsigned char* VC8 = (unsigned char*)(F.ws + WS_VC8); (void)KC8; (void)VC8;
    const int lane = F.lane, sub = lane >> 4, a = lane & 15, gw = F.bid * 8 + F.wave, NGW = F.G * 8;
    const float* pq = INP(I_GQG); const float* pk = INP(I_GKG);
    float gq[8], gk[8], gqp[8], gkp[8];
#pragma unroll
    for (int j = 0; j < 8; ++j) { gq[j] = pq[8 * a + j]; gk[j] = pk[8 * a + j]; gqp[j] = pq[8 * (a ^ 4) + j]; gkp[j] = pk[8 * (a ^ 4) + j]; }
    const bool isx2 = (a & 4) != 0; const int fi = 8 * (a & 3);
    LAS f32x4* ltab = (LAS f32x4*)F.lds; { const f32x4* gt = (const f32x4*)tab; for (int u = F.tid; u < 64 * 32 / 2; u += 512) ltab[u] = gt[u]; } __syncthreads();
    for (int rp0 = gw; rp0 < NTOK / 2; rp0 += 2 * NGW) {
        u32x4 wl[2][4];
#pragma unroll
        for (int h = 0; h < 2; ++h) { const int rp = rp0 + h * NGW; if (rp < NTOK / 2) {
#pragma unroll
            for (int g = 0; g < ((ATT_KV8IN && ATT_PV_FP8 && GQA_QK_FP8) ? 4 : 3); ++g) { int it = g * 4 + sub, hi6, s;
                if constexpr (ATT_KV8IN && ATT_PV_FP8 && GQA_QK_FP8) { hi6 = it >> 3; s = it & 7; } else { hi6 = it >= 6 ? 1 : 0; s = it - 6 * hi6; }
                wl[h][g] = NT_LD((const u32x4*)(P + (size_t)(rp * 2 + hi6) * 2048 + 1024 + s * 128 + 8 * a)); } } }
        __builtin_amdgcn_sched_barrier(0);
#pragma unroll
        for (int h = 0; h < 2; ++h) { const int rp = rp0 + h * NGW; if (rp < NTOK / 2) {
#pragma unroll
        for (int g = 0; g < ((ATT_KV8IN && ATT_PV_FP8 && GQA_QK_FP8) ? 4 : 3); ++g) {
            int it = g * 4 + sub, hi6, s;
            if constexpr (ATT_KV8IN && ATT_PV_FP8 && GQA_QK_FP8) { hi6 = it >> 3; s = it & 7; } else { hi6 = it >= 6 ? 1 : 0; s = it - 6 * hi6; }
            const int r = rp * 2 + hi6;
            const int b = r / TPB, pos = r - b * TPB; const bool lat = pos >= CTXL; const int t = pos - CTXL;
            bf16_t* ptr = P + (size_t)r * 2048 + 1024 + s * 128 + 8 * a;
            const u32x4 w = wl[h][g]; u32x4 wp;
#pragma unroll
            for (int q = 0; q < 4; ++q) wp[q] = (unsigned)__shfl_xor((int)w[q], 4);
            float x[8], xp[8];
#pragma unroll
            for (int q = 0; q < 4; ++q) { x[2 * q] = bflo(w[q]); x[2 * q + 1] = bfhi(w[q]); xp[2 * q] = bflo(wp[q]); xp[2 * q + 1] = bfhi(wp[q]); }
            float ss = 0.f;
#pragma unroll
            for (int j = 0; j < 8; ++j) ss += x[j] * x[j];
            ss += __shfl_xor(ss, 1); ss += __shfl_xor(ss, 2); ss += __shfl_xor(ss, 4); ss += __shfl_xor(ss, 8);
            const float rstd = rsqrtf(ss * (1.f / 128.f) + EPS); const bool isq = s < 4;
            float o[8];
#pragma unroll
            for (int j = 0; j < 8; ++j) { o[j] = x[j] * rstd * (isq ? gq[j] : gk[j]); xp[j] = xp[j] * rstd * (isq ? gqp[j] : gkp[j]); }
            if (lat) {
                const int pp = (a & 8) ? (t & 63) : (t >> 6); const LAS f32x4* tp = ltab + ((pp * 32 + fi) >> 1);
#pragma unroll
                for (int q = 0; q < 4; ++q) { const f32x4 cs = tp[q];
                    const float s0 = isx2 ? cs.y : -cs.y, s1 = isx2 ? cs.w : -cs.w;
                    o[2 * q] = o[2 * q] * cs.x + xp[2 * q] * s0; o[2 * q + 1] = o[2 * q + 1] * cs.z + xp[2 * q + 1] * s1; }
            }
            if constexpr (ATT_KV8IN && ATT_PV_FP8 && GQA_QK_FP8) {
                if (s < 4) {
                    if constexpr (QC8_FP8 != 0 && ATT_FOLD != 0) { constexpr float QM = att::Cfg<128>::SCALE * 1.4426950408889634f * 32.f; u32x2 w8; w8.x = pk4_fp8(o[0] * QM, o[1] * QM, o[2] * QM, o[3] * QM); w8.y = pk4_fp8(o[4] * QM, o[5] * QM, o[6] * QM, o[7] * QM);
                        *(u32x2*)((unsigned char*)(F.ws + WS_QC8) + (size_t)r * 512 + s * 128 + 8 * a) = w8; }
                    else { u32x4 wo; wo.x = cvtpk(o[0], o[1]); wo.y = cvtpk(o[2], o[3]); wo.z = cvtpk(o[4], o[5]); wo.w = cvtpk(o[6], o[7]); *(u32x4*)ptr = wo; } }
                else if (s < 6) { u32x2 w8; w8.x = pk4_fp8(o[0] * 4.f, o[1] * 4.f, o[2] * 4.f, o[3] * 4.f); w8.y = pk4_fp8(o[4] * 4.f, o[5] * 4.f, o[6] * 4.f, o[7] * 4.f); *(u32x2*)(KC8 + (size_t)r * 256 + (s - 4) * 128 + 8 * a) = w8; }
                else { u32x2 w8; w8.x = pk4_fp8(x[0] * 4.f, x[1] * 4.f, x[2] * 4.f, x[3] * 4.f); w8.y = pk4_fp8(x[4] * 4.f, x[5] * 4.f, x[6] * 4.f, x[7] * 4.f); *(u32x2*)(VC8 + (size_t)r * 256 + (s - 6) * 128 + 8 * a) = w8; }
            } else {
            u32x4 wo; wo.x = cvtpk(o[0], o[1]); wo.y = cvtpk(o[2], o[3]); wo.z = cvtpk(o[4], o[5]); wo.w = cvtpk(o[6], o[7]);
            *(u32x4*)ptr = wo; }
        } } }
    }
}
__device__ __forceinline__ u32x2 fp8x4_to_bf16(unsigned w) { const f32x2 a = __builtin_amdgcn_cvt_pk_f32_fp8(w, false), b = __builtin_amdgcn_cvt_pk_f32_fp8(w, true); return (u32x2){cvtpk(a.x * 0.125f, a.y * 0.125f), cvtpk(b.x * 0.125f, b.y * 0.125f)}; }
__device__ __forceinline__ u32x4 fp8x8_to_bf16(u32x2 w) { const u32x2 l = fp8x4_to_bf16(w.x), h = fp8x4_to_bf16(w.y); return (u32x4){l.x, l.y, h.x, h.y}; }
__device__ __forceinline__ void p_mla_prep(Frame& F) {
    bf16_t* P = (bf16_t*)(F.ws + WS_PBUF); bf16_t* KR = (bf16_t*)(F.ws + WS_KRB); const f32x2* tab = (const f32x2*)(F.ws + WS_TABM);
    const int gw = F.bid * 8 + F.wave, NGW = F.G * 8, lane = F.lane;
    const float* pqg = INP(I_MLAQG); const float* pkg = INP(I_MLAKVG);
    float qg[8], kg[4];
#pragma unroll
    for (int j = 0; j < 8; ++j) qg[j] = pqg[8 * lane + j];
#pragma unroll
    for (int j = 0; j < 4; ++j) kg[j] = pkg[4 * lane + j];
    const int krow = (lane >> 3) & 3, ka = lane & 7; const bool kx2 = (ka & 2) != 0; const int kfi = 8 * (ka & 1);
    LAS f32x4* ltab = (LAS f32x4*)F.lds; { const f32x4* gt = (const f32x4*)tab; for (int u = F.tid; u < 64 * 16 / 2; u += 512) ltab[u] = gt[u]; } __syncthreads();
    for (int r0 = gw * 4; r0 < NTOK; r0 += NGW * 4) {
        const int b = r0 / TPB, pos0 = r0 - b * TPB; const bool lat = pos0 >= CTXL;
        u32x4 wq[4]; u32x2 wk[4];
#pragma unroll
        for (int rr = 0; rr < 4; ++rr) {
            if constexpr (PBUF1_FP8 != 0) { const unsigned char* b8 = (const unsigned char*)P + (size_t)(r0 + rr) * 1024; wk[rr] = fp8x4_to_bf16(NT_LD((const unsigned*)(b8 + 512 + 4 * lane))); if (lat) wq[rr] = fp8x8_to_bf16(NT_LD((const u32x2*)(b8 + 8 * lane))); }
            else { const bf16_t* base = P + (size_t)(r0 + rr) * 1024; wk[rr] = *(const u32x2*)(base + 512 + 4 * lane); if (lat) wq[rr] = *(const u32x4*)(base + 8 * lane); } }
        u32x4 wr = (u32x4){0u, 0u, 0u, 0u};
        if (lane < 32) { if constexpr (PBUF1_FP8 != 0) wr = fp8x8_to_bf16(*(const u32x2*)((const unsigned char*)P + (size_t)(r0 + krow) * 1024 + 768 + 8 * ka)); else wr = *(const u32x4*)(P + (size_t)(r0 + krow) * 1024 + 768 + 8 * ka); }
        if (lat) {
#pragma unroll
            for (int rr = 0; rr < 4; ++rr) { float x[8];
#pragma unroll
                for (int q = 0; q < 4; ++q) { x[2 * q] = bflo(wq[rr][q]); x[2 * q + 1] = bfhi(wq[rr][q]); }
                float ss = 0.f;
#pragma unroll
                for (int j = 0; j < 8; ++j) ss += x[j] * x[j];
                const float rstd = rsqrtf(wave_sum(ss) * (1.f / 512.f) + EPS);
                if constexpr (UPQ_FP8 != 0) { const float s4 = rstd * 4.f; u32x2 w8; w8.x = pk4_fp8(x[0] * s4 * qg[0], x[1] * s4 * qg[1], x[2] * s4 * qg[2], x[3] * s4 * qg[3]); w8.y = pk4_fp8(x[4] * s4 * qg[4], x[5] * s4 * qg[5], x[6] * s4 * qg[6], x[7] * s4 * qg[7]);
                    *(u32x2*)((unsigned char*)(F.ws + WS_CQ8) + (size_t)(r0 + rr) * 512 + 8 * lane) = w8; }
                else { u32x4 w;
#pragma unroll
                    for (int q = 0; q < 4; ++q) w[q] = cvtpk(x[2 * q] * rstd * qg[2 * q], x[2 * q + 1] * rstd * qg[2 * q + 1]);
                    *(u32x4*)(P + (size_t)(r0 + rr) * 1024 + 8 * lane) = w; } }
        }
#pragma unroll
        for (int rr = 0; rr < 4; ++rr) { const float x0 = bflo(wk[rr].x), x1 = bfhi(wk[rr].x), x2 = bflo(wk[rr].y), x3 = bfhi(wk[rr].y);
            const float rstd = rsqrtf(wave_sum((x0 * x0 + x1 * x1) + (x2 * x2 + x3 * x3)) * (1.f / 256.f) + EPS);
            if constexpr (UPKV_FP8 != 0) { const float s4 = rstd * 4.f; *(unsigned*)((unsigned char*)(F.ws + WS_CKV8) + (size_t)(r0 + rr) * 256 + 4 * lane) = pk4_fp8(x0 * s4 * kg[0], x1 * s4 * kg[1], x2 * s4 * kg[2], x3 * s4 * kg[3]); }
            else { u32x2 w; w.x = cvtpk(x0 * rstd * kg[0], x1 * rstd * kg[1]); w.y = cvtpk(x2 * rstd * kg[2], x3 * rstd * kg[3]);
                *(u32x2*)(P + (size_t)(r0 + rr) * 1024 + 512 + 4 * lane) = w; } }
        {
            u32x4 wp;
#pragma unroll
            for (int q = 0; q < 4; ++q) wp[q] = (unsigned)__shfl_xor((int)wr[q], 2);
            float o[8], xp[8];
#pragma unroll
            for (int q = 0; q < 4; ++q) { o[2 * q] = bflo(wr[q]); o[2 * q + 1] = bfhi(wr[q]); xp[2 * q] = bflo(wp[q]); xp[2 * q + 1] = bfhi(wp[q]); }
            if (lat) { const int t = pos0 + krow - CTXL, pp = (ka & 4) ? (t & 63) : (t >> 6); const LAS f32x4* tp = ltab + ((pp * 16 + kfi) >> 1);
#pragma unroll
                for (int q = 0; q < 4; ++q) { const f32x4 cs = tp[q]; const float s0 = kx2 ? cs.y : -cs.y, s1 = kx2 ? cs.w : -cs.w;
                    o[2 * q] = o[2 * q] * cs.x + xp[2 * q] * s0; o[2 * q + 1] = o[2 * q + 1] * cs.z + xp[2 * q + 1] * s1; } }
            u32x4 wo; wo.x = cvtpk(o[0], o[1]); wo.y = cvtpk(o[2], o[3]); wo.z = cvtpk(o[4], o[5]); wo.w = cvtpk(o[6], o[7]);
            if (lane < 32) { if constexpr (ATT_KV8IN && ATT_PV_FP8 && MLA_QK_FP8) { u32x2 w8; w8.x = pk4_fp8(o[0] * 4.f, o[1] * 4.f, o[2] * 4.f, o[3] * 4.f); w8.y = pk4_fp8(o[4] * 4.f, o[5] * 4.f, o[6] * 4.f, o[7] * 4.f); *(u32x2*)((unsigned char*)(F.ws + WS_KR8) + (size_t)(r0 + krow) * 64 + 8 * ka) = w8; }
                else *(u32x4*)(KR + (size_t)(r0 + krow) * 64 + 8 * ka) = wo; }
        }
    }
}
__device__ __forceinline__ void p_sgu(Frame& F) {
    const bf16_t* P = (const bf16_t*)(F.ws + WS_PBUF); bf16_t* MIX = (bf16_t*)(F.ws + WS_MIX0); const bf16_t* SW = (const bf16_t*)(F.ws + WS_SGUW);
    const int tid = F.tid, lane = F.lane, wid = F.wave, hw = wid >> 2, w4 = wid & 3, th = tid & 255, r32 = lane & 31, hi = lane >> 5;
    LAS char* Vl = (LAS char*)F.lds + hw * 32768;
    const int sr = th >> 4, sc = (th & 15) * 8;
    const int vb0 = (int)(unsigned)(uintptr_t)Vl + att::v_rd_base(lane);
    const float* psg = INP(I_SGUNG); const float* psb = INP(I_SGUB);
    for (int U = F.bid; U < (NTOK / 128) * 2; U += F.G) {
        const int chunk = U >> 1, g = (U & 1) * 2 + hw; const size_t row0 = (size_t)chunk * 128;
        float gn[8];
#pragma unroll
        for (int j = 0; j < 8; ++j) gn[j] = psg[g * 128 + sc + j];
        u32x4 zr[8]; LAS char* T = (LAS char*)F.lds + 65536 + wid * 8192;
        if constexpr (SGU_T != 0) {
#pragma unroll
            for (int i = 0; i < 8; ++i) zr[i] = NT_LD((const u32x4*)(P + (row0 + 32 * w4 + 4 * i + (lane >> 4)) * 2048 + g * 128 + (lane & 15) * 8));
        }
        __syncthreads();
#pragma unroll
        for (int i = 0; i < 8; ++i) {
            const int q = sr + 16 * i;
            u32x4 w = NT_LD((const u32x4*)(P + (row0 + q) * 2048 + 512 + g * 128 + sc)); float x[8];
#pragma unroll
            for (int k = 0; k < 4; ++k) { x[2 * k] = bflo(w[k]); x[2 * k + 1] = bfhi(w[k]); }
            float ss = 0.f;
#pragma unroll
            for (int j = 0; j < 8; ++j) ss += x[j] * x[j];
            ss += __shfl_xor(ss, 1); ss += __shfl_xor(ss, 2); ss += __shfl_xor(ss, 4); ss += __shfl_xor(ss, 8);
            const float rstd = rsqrtf(ss * (1.f / 128.f) + EPS);
#pragma unroll
            for (int k = 0; k < 4; ++k) w[k] = cvtpk(x[2 * k] * rstd * gn[2 * k], x[2 * k + 1] * rstd * gn[2 * k + 1]);
            *(LAS u32x4*)(Vl + (q >> 6) * 16384 + att::v_st(q & 63, sc)) = w;
        }
        bf16x8 pa[8];
        const bf16_t* wrow = SW + ((size_t)g * 128 + 32 * w4 + r32) * 128 + 8 * hi;
#pragma unroll
        for (int k = 0; k < 8; ++k) pa[k] = *(const bf16x8*)(wrow + 16 * k);
        __syncthreads();
        f32x16 o[4] = {};
        if constexpr (SGU_T != 0) {
#pragma unroll
            for (int i = 0; i < 8; ++i) { const int R = 4 * i + (lane >> 4); *(LAS u32x4*)(T + R * 256 + (((lane & 15) ^ (R & 15)) << 4)) = zr[i]; }
            att::pv_d0<true>(o, vb0, pa[0], pa[1], pa[2], pa[3]);
            att::pv_d0<true>(o, vb0 + 16384, pa[4], pa[5], pa[6], pa[7]);
            const float bs = psb[g * 128 + 32 * w4 + r32];
            if constexpr (OUT0_FP8 != 0) {
                unsigned ow[4][4];
#pragma unroll
                for (int d0 = 0; d0 < 4; ++d0)
#pragma unroll
                    for (int gq = 0; gq < 4; ++gq) { const u32x2 zz = *(const LAS u32x2*)(T + r32 * 256 + (((d0 * 4 + gq) ^ (r32 & 15)) << 4) + 8 * hi);
                        ow[d0][gq] = pk4_fp8((o[d0][4 * gq] + bs) * bflo(zz.x) * 16.f, (o[d0][4 * gq + 1] + bs) * bfhi(zz.x) * 16.f, (o[d0][4 * gq + 2] + bs) * bflo(zz.y) * 16.f, (o[d0][4 * gq + 3] + bs) * bfhi(zz.y) * 16.f); }
                asm volatile("s_waitcnt lgkmcnt(0)" ::: "memory");
#pragma unroll
                for (int d0 = 0; d0 < 4; ++d0)
#pragma unroll
                    for (int gq = 0; gq < 4; ++gq) *(LAS unsigned*)(T + r32 * 128 + (((d0 * 2 + (gq >> 1)) ^ (r32 & 7)) << 4) + (gq & 1) * 8 + 4 * hi) = ow[d0][gq];
                asm volatile("s_waitcnt lgkmcnt(0)" ::: "memory");
#pragma unroll
                for (int i = 0; i < 4; ++i) { const int R = (lane >> 3) + 8 * i, j = lane & 7; const u32x4 v = *(const LAS u32x4*)(T + R * 128 + ((j ^ (R & 7)) << 4));
                    *(u32x4*)((unsigned char*)MIX + (row0 + 32 * w4 + R) * 1024 + g * 128 + j * 16) = v; }
            } else {
#pragma unroll
            for (int d0 = 0; d0 < 4; ++d0)
#pragma unroll
                for (int gq = 0; gq < 4; ++gq) { LAS u32x2* tp = (LAS u32x2*)(T + r32 * 256 + (((d0 * 4 + gq) ^ (r32 & 15)) << 4) + 8 * hi); const u32x2 zz = *tp;
                    u32x2 wo; wo.x = cvtpk((o[d0][4 * gq] + bs) * bflo(zz.x), (o[d0][4 * gq + 1] + bs) * bfhi(zz.x)); wo.y = cvtpk((o[d0][4 * gq + 2] + bs) * bflo(zz.y), (o[d0][4 * gq + 3] + bs) * bfhi(zz.y)); *tp = wo; }
#pragma unroll
            for (int i = 0; i < 8; ++i) { const int R = 4 * i + (lane >> 4); const u32x4 v = *(const LAS u32x4*)(T + R * 256 + (((lane & 15) ^ (R & 15)) << 4));
                *(u32x4*)(MIX + (row0 + 32 * w4 + R) * 1024 + g * 128 + (lane & 15) * 8) = v; }
            }
        } else {
        att::pv_d0(o, vb0, pa[0], pa[1], pa[2], pa[3]);
        att::pv_d0(o, vb0 + 16384, pa[4], pa[5], pa[6], pa[7]);
#pragma unroll
        for (int r = 0; r < 16; ++r) { const int p = 32 * w4 + att::crow(r, hi); const float bs = psb[g * 128 + p];
#pragma unroll
            for (int d0 = 0; d0 < 4; ++d0) { const int c = d0 * 32 + r32; const float zu = bf2f(P[(row0 + p) * 2048 + g * 128 + c]);
                MIX[(row0 + p) * 1024 + g * 128 + c] = f2bf((o[d0][r] + bs) * zu); } }
        }
    }
    __syncthreads();
}

using pg8::Unit; using pg8::Acc;
struct ProbIn0 {
    static constexpr bool PERM = true, GATHER = false, FP8 = PROJ0_FP8 != 0, P16 = false, MOE = false; static constexpr int KCONST = 0; int K, lda; const bf16_t* A; const bf16_t* Bt; bf16_t* O; pg8::StaticOrder so; int G, c;
    __device__ bool next(int i, Unit& u) const { return so.map((long)i * G + c, u.pm, u.pn); }
    __device__ const void* a_mat() const { return A; } __device__ const void* b_mat() const { return Bt; }
    __device__ unsigned a_off(const Unit& u) const { return (unsigned)u.pm * 256u * (unsigned)lda * 2u; }
    __device__ unsigned b_off(const Unit& u) const { return (unsigned)u.pn * 256u * (unsigned)K * 2u; }
    __device__ void a_voff(const Unit&, unsigned (&)[2][2]) const {}
    __device__ void epi(const Acc& acc, const Unit& u, int wr, int wc, int fr, int fq) const {
        bf16_t* dst = O + (size_t)u.pm * 256 * 2048 + u.pn * 256;
        if (u.pn < 4) pg8::epi_store_bf16<true>(acc, dst, 2048, nullptr, wr, wc, fr, fq, FP8 ? (1.f / 256.f) : 1.f); else pg8::epi_store_bf16<false>(acc, dst, 2048, nullptr, wr, wc, fr, fq, FP8 ? (1.f / 256.f) : 1.f);
    }
};
template <bool LATONLY, bool FP8v = false, int KC = 0, bool O8 = false> struct ProbPlain {
    static constexpr bool PERM = true, GATHER = false, FP8 = FP8v, P16 = O8 && (EPI_P16 != 0), MOE = false; static constexpr int KCONST = KC; int K, lda; const bf16_t* A; const bf16_t* Bt; bf16_t* O; int ldc; pg8::StaticOrder so; int G, c; float osc8 = 4.f;
    __device__ bool next(int i, Unit& u) const { int pm; if (!so.map((long)i * G + c, pm, u.pn)) return false; u.pm = LATONLY ? pm + pm / 8 + 1 : pm; return true; }
    __device__ const void* a_mat() const { return A; } __device__ const void* b_mat() const { return Bt; }
    __device__ unsigned a_off(const Unit& u) const { return (unsigned)u.pm * 256u * (unsigned)lda * 2u; }
    __device__ unsigned b_off(const Unit& u) const { return (unsigned)u.pn * 256u * (unsigned)K * 2u; }
    __device__ void a_voff(const Unit&, unsigned (&)[2][2]) const {}
    __device__ void epi(const Acc& acc, const Unit& u, int wr, int wc, int fr, int fq) const {
        if constexpr (O8) pg8::epi_store_fp8<P16>(acc, (unsigned char*)O + (size_t)u.pm * 256 * ldc + u.pn * 256, ldc, wr, wc, fr, fq, (FP8 ? (1.f / 256.f) : 1.f) * osc8);
        else pg8::epi_store_bf16<false>(acc, O + (size_t)u.pm * 256 * ldc + u.pn * 256, ldc, nullptr, wr, wc, fr, fq, FP8 ? (1.f / 256.f) : 1.f);
    }
};
struct ProbIn1 {
    static constexpr bool PERM = true, GATHER = false, FP8 = PROJ1_FP8 != 0, P16 = (PBUF1_FP8 != 0) && (EPI_P16 != 0), MOE = false; static constexpr int KCONST = 0; int K, lda; const bf16_t* A; const bf16_t* Bt; bf16_t* O; pg8::StaticOrder so; int G, c;
    __device__ bool next(int i, Unit& u) const {
        const long L = (long)i * G + c;
        if (L < 1024) { int pm; so.map(L, pm, u.pn); u.pm = pm + pm / 8 + 1; return true; }
        if (L < 1024 + 64) { const int q = (int)(L - 1024); u.pm = (q >> 1) * 9; u.pn = 2 + (q & 1); return true; }
        return false;
    }
    __device__ const void* a_mat() const { return A; } __device__ const void* b_mat() const { return Bt; }
    __device__ unsigned a_off(const Unit& u) const { return (unsigned)u.pm * 256u * (unsigned)lda * 2u; }
    __device__ unsigned b_off(const Unit& u) const { return (unsigned)u.pn * 256u * (unsigned)K * 2u; }
    __device__ void a_voff(const Unit&, unsigned (&)[2][2]) const {}
    __device__ void epi(const Acc& acc, const Unit& u, int wr, int wc, int fr, int fq) const {
        if constexpr (PBUF1_FP8 != 0) pg8::epi_store_fp8<P16>(acc, (unsigned char*)O + (size_t)u.pm * 256 * 1024 + u.pn * 256, 1024, wr, wc, fr, fq, (FP8 ? (1.f / 256.f) : 1.f) * 8.f);
        else pg8::epi_store_bf16<false>(acc, O + (size_t)u.pm * 256 * 1024 + u.pn * 256, 1024, nullptr, wr, wc, fr, fq, FP8 ? (1.f / 256.f) : 1.f);
    }
};
template <int LAYER> struct ProbOut {
    static constexpr bool PERM = true, GATHER = false, FP8 = (LAYER == 1 ? (OUT1_FP8 != 0) : (OUT0_FP8 != 0)), P16 = false, MOE = false; static constexpr int KCONST = 0; int K, lda; const bf16_t* A; const bf16_t* Bt; bf16_t* XR; const float* MOD; const float* xin; const float* cin; pg8::StaticOrder so; int G, c;
    __device__ __forceinline__ bool next(int i, Unit& u) const { int pm; if (!so.map((long)i * G + c, pm, u.pn)) return false; u.pm = LAYER ? pm + pm / 8 + 1 : pm; return true; }
    __device__ __forceinline__ const void* a_mat() const { return A; } __device__ __forceinline__ const void* b_mat() const { return Bt; }
    __device__ __forceinline__ unsigned a_off(const Unit& u) const { return (unsigned)u.pm * 256u * (unsigned)lda * 2u; }
    __device__ __forceinline__ unsigned b_off(const Unit& u) const { return (unsigned)u.pn * 256u * (unsigned)K * 2u; }
    __device__ __forceinline__ void a_voff(const Unit&, unsigned (&)[2][2]) const {}
    __device__ __forceinline__ void epi(const Acc& acc, const Unit& u, int wr, int wc, int fr, int fq) const {
        const int b = u.pm / 9, jj = u.pm % 9, mj = jj == 0 ? 32 : b;
        const float* basef = jj == 0 ? cin + (size_t)b * CTXL * DM : xin + ((size_t)b * SEQ + (jj - 1) * 256) * DM;
        bf16_t* dst = XR + (size_t)u.pm * 256 * DM; const float* gate = MOD + ((size_t)(LAYER * 33 + mj) * 6 + 2) * 1024;
        const int row0 = wr * 64 + fr, col0 = u.pn * 256 + wc * 32 + 8 * fq;
        f32x4 gv[2][2];
#pragma unroll
        for (int bj = 0; bj < 2; ++bj)
#pragma unroll
            for (int n = 0; n < 2; ++n) gv[bj][n] = *(const f32x4*)(gate + col0 + bj * 128 + 4 * n);
        const unsigned lo = (unsigned)(row0 * DM + col0); constexpr int GD = 4; constexpr float SC = FP8 ? (1.f / 1024.f) : 1.f;
        f32x4 pb0[GD], pb1[GD]; u32x4 pw[GD]; (void)pb0; (void)pb1; (void)pw;
#define PO_LD(slot, g) do { const int ai_ = (g) >> 3, m_ = ((g) >> 1) & 3, bj_ = (g) & 1; const size_t uo_ = (size_t)(ai_ * 128 + m_ * 16) * DM; \
            if constexpr (LAYER == 0) { const char* bp = (const char*)(basef + uo_) + (size_t)(lo + bj_ * 128) * 4u; pb0[slot] = NT_LD((const f32x4*)bp); pb1[slot] = NT_LD((const f32x4*)(bp + 16)); } \
            else pw[slot] = *(const u32x4*)((const char*)(dst + uo_) + (lo + bj_ * 128) * 2u); } while (0)
#pragma unroll
        for (int g = 0; g < GD; ++g) PO_LD(g, g);
#pragma unroll
        for (int g = 0; g < 16; ++g) { const int sl = g % GD, ai = g >> 3, m = (g >> 1) & 3, bj = g & 1; const size_t uo = (size_t)(ai * 128 + m * 16) * DM; f32x4 b0, b1;
            if constexpr (LAYER == 0) { b0 = pb0[sl]; b1 = pb1[sl]; }
            else { const u32x4 w = pw[sl]; b0 = (f32x4){bflo(w.x), bfhi(w.x), bflo(w.y), bfhi(w.y)}; b1 = (f32x4){bflo(w.z), bfhi(w.z), bflo(w.w), bfhi(w.w)}; }
            const f32x4 v0 = b0 + gv[bj][0] * (acc[ai][bj][m][0] * SC), v1 = b1 + gv[bj][1] * (acc[ai][bj][m][1] * SC);
            u32x4 wo; wo.x = cvtpk(v0[0], v0[1]); wo.y = cvtpk(v0[2], v0[3]); wo.z = cvtpk(v1[0], v1[1]); wo.w = cvtpk(v1[2], v1[3]);
            *(u32x4*)((char*)(dst + uo) + (lo + bj * 128) * 2u) = wo;
            if (g + GD < 16) PO_LD(sl, g + GD);
            __builtin_amdgcn_sched_barrier(0); }
#undef PO_LD
    }
};
struct MoeSched {
    const LAS int* pb; const LAS unsigned* bt; int NTN, G, c;
    __device__ bool map(int i, Unit& u) const {
        const int x = c & 7, q = i * (G >> 3) + (c >> 3); const int blk = (q / NTN) * 8 + x; u.pn = q % NTN;
        const unsigned ent = (unsigned)__builtin_amdgcn_readfirstlane((int)bt[blk < BT_N ? blk : BT_N - 1]);
        if (ent == 0xffffffffu) return false;
        u.e = (int)(ent >> 16); u.rb = (int)(ent & 0xffffu); u.pm = blk; return true;
    }
};
struct ProbMoe1 {
    static constexpr bool PERM = true, GATHER = !(MOE_PREGATHER && MOE_FP8), FP8 = MOE_FP8 != 0, P16 = false, MOE = true; static constexpr int KCONST = 0; int K, lda; const bf16_t* H; const bf16_t* W1; const float* B1; bf16_t* ACT; const int* rowl; const LAS int* cnt; MoeSched ms; int wave_s; LAS uchar* stage;
    __device__ bool next(int i, Unit& u) const { return ms.map(i, u); }
    __device__ const void* a_mat() const { return H; } __device__ const void* b_mat() const { return W1; }
    __device__ unsigned a_off(const Unit& u) const { return GATHER ? 0u : (unsigned)u.pm * 256u * 1024u; }
    __device__ unsigned b_off(const Unit& u) const { return ((unsigned)u.e * 2048u + (unsigned)u.pn * 256u) * 1024u * (FP8 ? 1u : 2u); }
    __device__ void a_voff(const Unit& u, unsigned (&vo)[2][2]) const {
        const int n = cnt[u.e]; const int* rl = rowl + (size_t)u.e * ROWCAP + u.rb * 256;
        const int tidg = tid_fresh(wave_s);
#pragma unroll
        for (int i = 0; i < 2; ++i) { int R, C; pg8::stage_rc(tidg * 16 + i * 8192, R, C);
#pragma unroll
            for (int h = 0; h < 2; ++h) { const int ri = h * 128 + R; const int tk = rl[ri]; const int tok = (u.rb * 256 + ri < n) ? tk : 0; vo[h][i] = (unsigned)tok * (FP8 ? 1024u : 2048u) + (unsigned)C * 2u; } }
    }
    __device__ void unit_top(const Unit& cur, const Unit& nx, bool has_next, int wid, int ui) const {
        if (IDX_LDS != 0 && wid == 0 && has_next) { const int ln = tid_fresh(wave_s) & 63;
            __builtin_amdgcn_global_load_lds((const unsigned*)(rowl + (size_t)nx.e * ROWCAP + nx.rb * 256 + ln * 4), (LAS unsigned*)(stage), 16, 0, 0); }
        if (BIAS_LDS != 0 && wid == 1) { const int ln = tid_fresh(wave_s) & 63;
            __builtin_amdgcn_global_load_lds((const unsigned*)(B1 + (size_t)cur.e * 2048 + (ln >> 5) * 1024 + cur.pn * 128 + (ln & 31) * 4), (LAS unsigned*)(stage + 1024 + (ui & 1) * 1024), 16, 0, 0); }
    }
    __device__ void a_voff_next(const Unit& u, unsigned (&vo)[2][2]) const {
        if constexpr (IDX_LDS == 0) { a_voff(u, vo); return; }
        const int n = cnt[u.e]; const volatile LAS int* il = (const volatile LAS int*)stage;
        const int tidg = tid_fresh(wave_s);
#pragma unroll
        for (int i = 0; i < 2; ++i) { int R, C; pg8::stage_rc(tidg * 16 + i * 8192, R, C);
#pragma unroll
            for (int h = 0; h < 2; ++h) { const int ri = h * 128 + R; const int tk = il[ri]; const int tok = (u.rb * 256 + ri < n) ? tk : 0; vo[h][i] = (unsigned)tok * (FP8 ? 1024u : 2048u) + (unsigned)C * 2u; } }
    }
    __device__ void epi(const Acc& acc, const Unit& u, int wr, int wc, int fr, int fq, int ui) const {
        const int row0 = wr * 64 + fr, col0 = u.pn * 128 + wc * 32 + 8 * fq;
        f32x4 bgv[2], blv[2];
        if constexpr (BIAS_LDS != 0) { const LAS float* bb = (const LAS float*)(stage + 1024 + (ui & 1) * 1024) + wc * 32 + 8 * fq;
#pragma unroll
            for (int n = 0; n < 2; ++n) { bgv[n] = *(const LAS f32x4*)(bb + 4 * n); blv[n] = *(const LAS f32x4*)(bb + 128 + 4 * n); } }
        else { const float* bg = B1 + (size_t)u.e * 2048 + col0; const float* bl = bg + 1024;
#pragma unroll
            for (int n = 0; n < 2; ++n) { bgv[n] = *(const f32x4*)(bg + 4 * n); blv[n] = *(const f32x4*)(bl + 4 * n); } }
        constexpr float SC = FP8 ? (1.f / 256.f) : 1.f;
        if constexpr (FP8 && EPI1_PK != 0) { bgv[0] *= 1.702f * 1.4426950408889634f; bgv[1] *= 1.702f * 1.4426950408889634f; }
        bf16_t* dst = ACT + (size_t)u.pm * 256 * 1024; unsigned char* dst8 = (unsigned char*)ACT + (size_t)u.pm * 256 * 1024; const unsigned lane_off = (unsigned)(row0 * 1024 + col0);
        const int tl = tid_fresh(wave_s); const int pc = wc * 4 + fq;
        const unsigned woff = (unsigned)((wr * 64 + fr) * 128 + ((((pc >> 1) ^ (fr & 7)) << 4) | ((pc & 1) << 3)));
        const unsigned roff = (unsigned)((tl >> 3) * 128 + (((tl & 7) ^ ((tl >> 3) & 7)) << 4));
        const unsigned goff = (unsigned)((tl >> 3) * 1024 + (tl & 7) * 16) + (unsigned)(u.pn * 128);
#pragma unroll
        for (int ai = 0; ai < 2; ++ai) {
            if (EPI_LDS1 != 0 && FP8 && ai == 1) { asm volatile("s_waitcnt lgkmcnt(0)" ::: "memory"); __builtin_amdgcn_s_barrier(); }
#pragma unroll
            for (int m = 0; m < 4; ++m) { float a[8];
                if constexpr (FP8 && EPI1_PK != 0) {
                    constexpr float C2 = 1.702f * 1.4426950408889634f, K8 = 8.f / C2;
#pragma unroll
                    for (int n = 0; n < 2; ++n)
#pragma unroll
                        for (int h = 0; h < 2; ++h) { const f32x4 ag = acc[ai][0][m][n], al = acc[ai][1][m][n];
                            f32x2 wv = (f32x2){ag[2 * h], ag[2 * h + 1]} * (SC * C2) + (f32x2){bgv[n][2 * h], bgv[n][2 * h + 1]};
                            wv.x = fminf(wv.x, 7.f * C2); wv.y = fminf(wv.y, 7.f * C2);
                            const f32x2 d = (f32x2){__builtin_amdgcn_exp2f(-wv.x), __builtin_amdgcn_exp2f(-wv.y)} + 1.f;
                            const f32x2 t = wv * (f32x2){__builtin_amdgcn_rcpf(d.x), __builtin_amdgcn_rcpf(d.y)};
                            f32x2 lv = (f32x2){al[2 * h], al[2 * h + 1]} * SC + (f32x2){blv[n][2 * h], blv[n][2 * h + 1]};
                            lv.x = __builtin_amdgcn_fmed3f(lv.x, -7.f, 7.f); lv.y = __builtin_amdgcn_fmed3f(lv.y, -7.f, 7.f);
                            const f32x2 a8 = t * (lv * K8 + K8);
                            a[4 * n + 2 * h] = a8.x; a[4 * n + 2 * h + 1] = a8.y; }
                } else {
#pragma unroll
                for (int n = 0; n < 2; ++n) { const f32x4 g = acc[ai][0][m][n] * SC + bgv[n], l = acc[ai][1][m][n] * SC + blv[n];
#pragma unroll
                    for (int j = 0; j < 4; ++j) { const float gg = fminf(g[j], 7.f), ll = fminf(fmaxf(l[j], -7.f), 7.f);
                        a[4 * n + j] = gg * __builtin_amdgcn_rcpf(1.f + __builtin_amdgcn_exp2f(-1.702f * 1.4426950408889634f * gg)) * (ll + 1.f) * (FP8 ? 8.f : 1.f); } }
                }
                if constexpr (FP8) { u32x2 w; w.x = pk4_fp8_nc(a[0], a[1], a[2], a[3]); w.y = pk4_fp8_nc(a[4], a[5], a[6], a[7]);
                    if constexpr (EPI_LDS1 != 0) *(LAS u32x2*)(stage + woff + m * 2048) = w;
                    else *(u32x2*)(dst8 + (size_t)((ai * 128 + m * 16) * 1024) + lane_off) = w; }
                else { u32x4 w; w.x = cvtpk(a[0], a[1]); w.y = cvtpk(a[2], a[3]); w.z = cvtpk(a[4], a[5]); w.w = cvtpk(a[6], a[7]);
                    *(u32x4*)((char*)dst + (size_t)((ai * 128 + m * 16) * 2048) + lane_off * 2u) = w; } }
            if constexpr (EPI_LDS1 != 0 && FP8) {
                asm volatile("s_waitcnt lgkmcnt(0)" ::: "memory"); __builtin_amdgcn_s_barrier();
                const u32x4 r0 = *(const LAS u32x4*)(stage + roff), r1 = *(const LAS u32x4*)(stage + roff + 64 * 128);
                unsigned char* rowb = (unsigned char*)ACT + (size_t)u.pm * 256 * 1024 + (size_t)(ai * 128) * 1024;
                *(u32x4*)(rowb + goff) = r0; *(u32x4*)(rowb + goff + 64 * 1024) = r1; } }
    }
};
struct ProbMoe2 {
    static constexpr bool PERM = true, GATHER = false, FP8 = MOE_FP8 != 0, P16 = (Y_FP8 != 0) && (EPI_P16 != 0), MOE = true; static constexpr int KCONST = 0; int K, lda; const bf16_t* ACT; const bf16_t* W2; const float* B2; bf16_t* Y; MoeSched ms; int wave_s; LAS uchar* stage;
    __device__ bool next(int i, Unit& u) const { return ms.map(i, u); }
    __device__ const void* a_mat() const { return ACT; } __device__ const void* b_mat() const { return W2; }
    __device__ unsigned a_off(const Unit& u) const { return (unsigned)u.pm * 256u * 1024u * (FP8 ? 1u : 2u); }
    __device__ unsigned b_off(const Unit& u) const { return ((unsigned)u.e * 1024u + (unsigned)u.pn * 256u) * 1024u * (FP8 ? 1u : 2u); }
    __device__ void a_voff(const Unit&, unsigned (&)[2][2]) const {}
    __device__ void unit_top(const Unit& cur, const Unit&, bool, int wid, int ui) const {
        if (BIAS_LDS != 0 && Y_FP8 != 0 && wid == 1) { const int ln = tid_fresh(wave_s) & 63;
            __builtin_amdgcn_global_load_lds((const unsigned*)(B2 + (size_t)cur.e * 1024 + cur.pn * 256 + ln * 4), (LAS unsigned*)(stage + 1024 + (ui & 1) * 1024), 16, 0, 0); }
    }
    __device__ void epi_prefetch(const Unit& nx, bool has_next, int wid) const {
        if (L2PF != 0 && L2PF2 != 0 && FP8 && has_next) { const int ln = tid_fresh(wave_s) & 63;
#pragma unroll
            for (int r = 0; r < 8; ++r)
                __builtin_amdgcn_global_load_lds((const unsigned*)((const unsigned char*)ACT + ((size_t)nx.pm * 256 + nx.pn * 64 + wid * 8 + r) * 1024 + ln * 16), (LAS unsigned*)(stage + 3072 + wid * 1024), 16, 0, 0); }
    }
    __device__ void epi(const Acc& acc, const Unit& u, int wr, int wc, int fr, int fq, int ui) const {
        constexpr float SC = FP8 ? (1.f / 512.f) : 1.f;
#if Y_FP8
        const int row0 = wr * 64 + fr, col0 = P16 ? wc * 64 + 16 * fq : wc * 32 + 8 * fq; const float* bias = B2 + (size_t)u.e * 1024 + u.pn * 256 + col0;
        f32x4 bv[2][2];
#pragma unroll
        for (int bj = 0; bj < 2; ++bj)
#pragma unroll
            for (int n = 0; n < 2; ++n) { if constexpr (BIAS_LDS != 0) bv[bj][n] = *(const LAS f32x4*)((const LAS float*)(stage + 1024 + (ui & 1) * 1024) + col0 + bj * (P16 ? 8 : 128) + 4 * n);
                else bv[bj][n] = *(const f32x4*)(bias + bj * (P16 ? 8 : 128) + 4 * n);
                bv[bj][n] *= 16.f; }
        unsigned char* dst = (unsigned char*)Y + ((size_t)u.pm * 256) * 1024 + u.pn * 256; const unsigned lane_off = (unsigned)(row0 * 1024 + col0);
#pragma unroll
        for (int ai = 0; ai < 2; ++ai)
#pragma unroll
            for (int m = 0; m < 4; ++m) { unsigned char* rowb = dst + (size_t)((ai * 128 + m * 16) * 1024);
                if constexpr (P16) { u32x4 w;
#pragma unroll
                    for (int bj = 0; bj < 2; ++bj) { const f32x4 v0 = acc[ai][bj][m][0] * (SC * 16.f) + bv[bj][0], v1 = acc[ai][bj][m][1] * (SC * 16.f) + bv[bj][1];
                        w[2 * bj] = pk4_fp8(v0[0], v0[1], v0[2], v0[3]); w[2 * bj + 1] = pk4_fp8(v1[0], v1[1], v1[2], v1[3]); }
                    *(u32x4*)(rowb + lane_off) = w; }
                else {
#pragma unroll
                for (int bj = 0; bj < 2; ++bj) { const f32x4 v0 = acc[ai][bj][m][0] * (SC * 16.f) + bv[bj][0], v1 = acc[ai][bj][m][1] * (SC * 16.f) + bv[bj][1];
                    u32x2 w; w.x = pk4_fp8(v0[0], v0[1], v0[2], v0[3]); w.y = pk4_fp8(v1[0], v1[1], v1[2], v1[3]);
                    *(u32x2*)(rowb + lane_off + bj * 128) = w; } } }
#else
        pg8::epi_store_bf16<false>(acc, Y + (size_t)u.pm * 256 * 1024 + u.pn * 256, 1024, B2 + (size_t)u.e * 1024 + u.pn * 256, wr, wc, fr, fq, SC);
#endif
    }
};

__global__ void __launch_bounds__(512, 2) fwd_kernel(Args args) {
    extern __shared__ __attribute__((aligned(16))) uchar lds_raw[];
    const int wave_s = __builtin_amdgcn_readfirstlane((int)threadIdx.x >> 6);
    Frame F; F.lds = (LAS uchar*)lds_raw; F.tid = tid_fresh(wave_s); F.lane = F.tid & 63; F.wave = wave_s; F.G = gridDim.x; F.bid = blockIdx.x;
    F.ws = args.ws; F.out = args.out;
    volatile LAS unsigned* MISC = (volatile LAS unsigned*)(F.lds + MISC_OFF);
    if (F.tid < 64) MISC[F.tid] = 0u;
    __syncthreads();
    unsigned* ctl = (unsigned*)(F.ws + WS_CTL);
    XcdBarrier bar; bar.bar = ctl + CW_BAR; bar.x = 0; bar.st = nullptr;
    const int lo = args.ph_lo, hi = args.ph_hi;
    bar = xcd_barrier_post(ctl + CW_BAR + (lo & 1) * XCD_BAR_WORDS, MISC + 8, F.tid == 0);
#ifndef PHMASK
#define PHMASK 0x7ffff
#endif
#define REFRAME() do { F.tid = tid_fresh(wave_s); F.lane = F.tid & 63; F.wave = wave_s; } while (0)
#define IN(k) (((PHMASK >> (k)) & 1) && lo <= (k) && (k) < hi)
#define SEAM(k) do { if (IN(k) && IN((k) + 1)) { const int t_ = tid_fresh(wave_s); xcd_barrier(bar, t_ == 0); } } while (0)
    uchar* ws = F.ws;
    bf16_t* H = (bf16_t*)(ws + WS_H); bf16_t* XR = (bf16_t*)(ws + WS_XR); const float* MOD = (const float*)(ws + WS_MOD);

#if PROBE_CLK
#define CLK_A(k) do { if ((k) == PROBE_CLK_PH && F.bid == 0 && tid_fresh(wave_s) == 0) { unsigned long long* st_ = (unsigned long long*)(ws + WS_CTL) + (CW_DBG / 2); st_[0] = __builtin_amdgcn_s_memrealtime(); st_[1] = __builtin_amdgcn_s_memtime(); } } while (0)
#define CLK_B(k) do { if ((k) == PROBE_CLK_PH && F.bid == 0 && tid_fresh(wave_s) == 0) { unsigned long long* st_ = (unsigned long long*)(ws + WS_CTL) + (CW_DBG / 2); st_[2] = __builtin_amdgcn_s_memrealtime(); st_[3] = __builtin_amdgcn_s_memtime(); } } while (0)
#else
#define CLK_A(k) do { } while (0)
#define CLK_B(k) do { } while (0)
#endif
    if (IN(0)) { REFRAME(); p0_prologue(F); } SEAM(0);
    if (IN(1)) { REFRAME(); if constexpr (NORM0_V2 != 0) p_norm0_v2(F); else p_norm0(F); } SEAM(1);
    if (IN(2)) { REFRAME(); ProbIn0 p; p.K = PROJ0_FP8 ? 512 : 1024; p.lda = p.K; p.A = H; p.Bt = (const bf16_t*)(ws + WS_WIN0); p.O = (bf16_t*)(ws + WS_PBUF); p.so.init(NPAN, 8); p.G = F.G; p.c = F.bid; pg8::gemm_phase(F.lds, p, wave_s); } SEAM(2);
    if (IN(3)) { REFRAME(); p_qk_prep(F); REFRAME(); p_sgu(F); } SEAM(3);
    if (IN(4)) { REFRAME();
        const bf16_t* P = (const bf16_t*)(ws + WS_PBUF); bf16_t* MIX = (bf16_t*)(ws + WS_MIX0); const unsigned char* KC8 = (const unsigned char*)(ws + WS_KC8); const unsigned char* VC8 = (const unsigned char*)(ws + WS_VC8); (void)KC8; (void)VC8;
        for (int u = F.bid; u < 1024 + 128; u += F.G) {
            if (u < 1024) { const int qb = u & 7, g = (u >> 3) & 1, kvh = (u >> 4) & 1, b = u >> 5, h = kvh * 2 + g; const size_t kr0 = (size_t)b * TPB, qr0 = kr0 + CTXL + qb * 256;
                if constexpr (GQA_QK_FP8 != 0 && ATT_KV8IN && ATT_PV_FP8) att::attn_unit_qk8<128, false, (QC8_FP8 != 0 && ATT_FOLD != 0) ? 512 : 2048, 256, 1024, OUT0_FP8 != 0, (ATT_PV_FP8 != 0), (QC8_FP8 != 0 && ATT_FOLD != 0)>((QC8_FP8 != 0 && ATT_FOLD != 0) ? (const bf16_t*)((const unsigned char*)(ws + WS_QC8) + qr0 * 512 + h * 128) : P + qr0 * 2048 + 1024 + h * 128, (const bf16_t*)(KC8 + kr0 * 256 + kvh * 128), nullptr, (const bf16_t*)(VC8 + kr0 * 256 + kvh * 128), OUT0_FP8 ? (bf16_t*)((unsigned char*)MIX + qr0 * 1024 + 512 + h * 128) : MIX + qr0 * 1024 + 512 + h * 128, TPB, (LAS char*)F.lds, nullptr, 0, wave_s);
                else if constexpr (GQA_QK_FP8 != 0) att::attn_unit_qk8<128, false, 2048, 2048, 1024, false>(P + qr0 * 2048 + 1024 + h * 128, P + kr0 * 2048 + 1536 + kvh * 128, nullptr, P + kr0 * 2048 + 1792 + kvh * 128, MIX + qr0 * 1024 + 512 + h * 128, TPB, (LAS char*)F.lds, nullptr, 0, wave_s);
                else att::attn_unit<128, 2, false, 2048, 2048, 1024>(P + qr0 * 2048 + 1024 + h * 128, P + kr0 * 2048 + 1536 + kvh * 128, nullptr, P + kr0 * 2048 + 1792 + kvh * 128, MIX + qr0 * 1024 + 512 + h * 128, TPB, (LAS char*)F.lds, nullptr, 0, wave_s);
            } else { const int v = u - 1024, h = v & 3, b = v >> 2, kvh = h >> 1; const size_t kr0 = (size_t)b * TPB;
                if constexpr (GQA_QK_FP8 != 0 && ATT_KV8IN && ATT_PV_FP8) att::attn_unit_qk8<128, false, (QC8_FP8 != 0 && ATT_FOLD != 0) ? 512 : 2048, 256, 1024, OUT0_FP8 != 0, (ATT_PV_FP8 != 0), (QC8_FP8 != 0 && ATT_FOLD != 0)>((QC8_FP8 != 0 && ATT_FOLD != 0) ? (const bf16_t*)((const unsigned char*)(ws + WS_QC8) + kr0 * 512 + h * 128) : P + kr0 * 2048 + 1024 + h * 128, (const bf16_t*)(KC8 + kr0 * 256 + kvh * 128), nullptr, (const bf16_t*)(VC8 + kr0 * 256 + kvh * 128), OUT0_FP8 ? (bf16_t*)((unsigned char*)MIX + kr0 * 1024 + 512 + h * 128) : MIX + kr0 * 1024 + 512 + h * 128, CTXL, (LAS char*)F.lds, nullptr, 0, wave_s);
                else if constexpr (GQA_QK_FP8 != 0) att::attn_unit_qk8<128, false, 2048, 2048, 1024, false>(P + kr0 * 2048 + 1024 + h * 128, P + kr0 * 2048 + 1536 + kvh * 128, nullptr, P + kr0 * 2048 + 1792 + kvh * 128, MIX + kr0 * 1024 + 512 + h * 128, CTXL, (LAS char*)F.lds, nullptr, 0, wave_s);
                else att::attn_unit<128, 2, false, 2048, 2048, 1024>(P + kr0 * 2048 + 1024 + h * 128, P + kr0 * 2048 + 1536 + kvh * 128, nullptr, P + kr0 * 2048 + 1792 + kvh * 128, MIX + kr0 * 1024 + 512 + h * 128, CTXL, (LAS char*)F.lds, nullptr, 0, wave_s); }
        }
    } SEAM(4);
    if (IN(5)) { REFRAME(); ProbOut<0> p; p.K = OUT0_FP8 ? 512 : 1024; p.lda = p.K; p.A = (const bf16_t*)(ws + WS_MIX0); p.Bt = (const bf16_t*)(ws + WS_WOUT0); p.XR = XR; p.MOD = MOD; p.xin = INP(I_X); p.cin = INP(I_CTX); p.so.init(NPAN, 4); p.G = F.G; p.c = F.bid; pg8::gemm_phase(F.lds, p, wave_s); } SEAM(5);
    if (IN(6)) { REFRAME(); p_norm_router<0>(F, args.dry); } SEAM(6);
    if (IN(7)) { REFRAME(); CLK_A(7);
#if MOE_PREGATHER && MOE_FP8
        p_moe_gather(F, 0); { const int t_ = tid_fresh(wave_s); xcd_barrier(bar, t_ == 0); } REFRAME();
#endif
        moe_prefix(F, 0); ProbMoe1 p; p.K = MOE_FP8 ? 512 : 1024; p.lda = p.K; p.H = (MOE_PREGATHER && MOE_FP8) ? (const bf16_t*)(ws + WS_XS) : H; p.W1 = (const bf16_t*)(ws + WS_W1); p.B1 = INP(I_B1); p.ACT = (bf16_t*)(ws + WS_ACT); p.rowl = (const int*)(ws + WS_ROWL);
        p.cnt = (const LAS int*)(F.lds + XTRA_OFF + X_CNT); p.stage = F.lds + XTRA_OFF + 1024; p.wave_s = wave_s; p.ms.pb = (const LAS int*)(F.lds + XTRA_OFF + X_PB); p.ms.bt = (const LAS unsigned*)(F.lds + XTRA_OFF + X_BT); p.ms.NTN = 8; p.ms.G = F.G; p.ms.c = F.bid; pg8::gemm_phase(F.lds, p, wave_s); CLK_B(7); } SEAM(7);
    if (IN(8)) { REFRAME(); moe_prefix(F, 0); ProbMoe2 p; p.K = MOE_FP8 ? 512 : 1024; p.lda = p.K; p.ACT = (const bf16_t*)(ws + WS_ACT); p.W2 = (const bf16_t*)(ws + WS_W2); p.B2 = INP(I_B2); p.Y = (bf16_t*)(ws + WS_Y);
        p.wave_s = wave_s; p.stage = F.lds + XTRA_OFF + 1024; p.ms.pb = (const LAS int*)(F.lds + XTRA_OFF + X_PB); p.ms.bt = (const LAS unsigned*)(F.lds + XTRA_OFF + X_BT); p.ms.NTN = 4; p.ms.G = F.G; p.ms.c = F.bid; pg8::gemm_phase(F.lds, p, wave_s); } SEAM(8);
    if (IN(9)) { REFRAME(); if constexpr (COMBINE_V2 != 0 && PROJ1_FP8 != 0 && Y_FP8 != 0) p_combine_v2<false>(F, args.dry); else p_combine_norm(F, args.dry); } SEAM(9);
    if (IN(10)) { REFRAME(); ProbIn1 p; p.K = PROJ1_FP8 ? 512 : 1024; p.lda = p.K; p.A = H; p.Bt = (const bf16_t*)(ws + WS_WIN1); p.O = (bf16_t*)(ws + WS_PBUF); p.so.init(256, 4); p.G = F.G; p.c = F.bid; pg8::gemm_phase(F.lds, p, wave_s); } SEAM(10);
    if (IN(11)) { REFRAME(); p_mla_prep(F); } SEAM(11);
    if (IN(12)) { REFRAME();
        { ProbPlain<true, UPQ_FP8 != 0, 0, (QB_FP8 != 0 && ATT_FOLD != 0 && UPQ_FP8 != 0)> p; p.osc8 = att::Cfg<192>::SCALE * 1.4426950408889634f * 32.f; p.K = UPQ_FP8 ? 256 : 512; p.lda = UPQ_FP8 ? 256 : 1024; p.A = UPQ_FP8 ? (const bf16_t*)(ws + WS_CQ8) : (const bf16_t*)(ws + WS_PBUF); p.Bt = (const bf16_t*)(ws + WS_WUQ); p.O = (bf16_t*)(ws + WS_QB); p.ldc = 1536; p.so.init(256, 6); p.G = F.G; p.c = F.bid; pg8::gemm_phase(F.lds, p, wave_s); }
        { ProbPlain<false, UPKV_FP8 != 0, (UPKV_FP8 ? 128 : 256), (ATT_KV8IN && ATT_PV_FP8 && MLA_QK_FP8)> p; p.K = UPKV_FP8 ? 128 : 256; p.lda = UPKV_FP8 ? 128 : 1024; p.A = UPKV_FP8 ? (const bf16_t*)(ws + WS_CKV8) : (const bf16_t*)(ws + WS_PBUF) + 512; p.Bt = (const bf16_t*)(ws + WS_WUKV); p.O = (bf16_t*)(ws + WS_KVB); p.ldc = 2048; p.so.init(NPAN, 8); p.G = F.G; p.c = F.bid; pg8::gemm_phase(F.lds, p, wave_s); }
    } SEAM(12);
    if (IN(13)) { REFRAME(); CLK_A(13);
        const bf16_t* Q = (const bf16_t*)(ws + WS_QB); const bf16_t* KV = (const bf16_t*)(ws + WS_KVB); const bf16_t* KR = (const bf16_t*)(ws + WS_KRB); bf16_t* MIX = (bf16_t*)(ws + WS_MIX1);
        for (int u = F.bid; u < 2048; u += F.G) { const int qb = u & 7, h = (u >> 3) & 7, b = u >> 6; const size_t kr0 = (size_t)b * TPB, qr0 = kr0 + CTXL + qb * 256;
            att::attn_unit_qk8<192, true, 1536, 2048, 1024, OUT1_FP8 != 0, (ATT_PV_FP8 != 0), (QB_FP8 != 0 && ATT_FOLD != 0 && UPQ_FP8 != 0)>((QB_FP8 != 0 && ATT_FOLD != 0 && UPQ_FP8 != 0) ? (const bf16_t*)((const unsigned char*)Q + qr0 * 1536 + h * 192) : Q + qr0 * 1536 + h * 192, (ATT_KV8IN && ATT_PV_FP8) ? (const bf16_t*)((const unsigned char*)KV + kr0 * 2048 + h * 128) : KV + kr0 * 2048 + h * 128, (ATT_KV8IN && ATT_PV_FP8) ? (const bf16_t*)((const unsigned char*)(ws + WS_KR8) + kr0 * 64) : KR + kr0 * 64, (ATT_KV8IN && ATT_PV_FP8) ? (const bf16_t*)((const unsigned char*)KV + kr0 * 2048 + 1024 + h * 128) : KV + kr0 * 2048 + 1024 + h * 128, OUT1_FP8 ? (bf16_t*)((unsigned char*)MIX + qr0 * 1024 + h * 128) : MIX + qr0 * 1024 + h * 128, TPB, (LAS char*)F.lds, (const f32x2*)(ws + WS_TABM), qb * 256, wave_s); }
    CLK_B(13); } SEAM(13);
    if (IN(14)) { REFRAME(); ProbOut<1> p; p.K = OUT1_FP8 ? 512 : 1024; p.lda = p.K; p.A = (const bf16_t*)(ws + WS_MIX1); p.Bt = (const bf16_t*)(ws + WS_WOUT1); p.XR = XR; p.MOD = MOD; p.xin = nullptr; p.cin = nullptr; p.so.init(256, 4); p.G = F.G; p.c = F.bid; pg8::gemm_phase(F.lds, p, wave_s); } SEAM(14);
    if (IN(15)) { REFRAME(); p_norm_router<1>(F, args.dry); } SEAM(15);
    if (IN(16)) { REFRAME();
#if MOE_PREGATHER && MOE_FP8
        p_moe_gather(F, 1); { const int t_ = tid_fresh(wave_s); xcd_barrier(bar, t_ == 0); } REFRAME();
#endif
        moe_prefix(F, 1); ProbMoe1 p; p.K = MOE_FP8 ? 512 : 1024; p.lda = p.K; p.H = (MOE_PREGATHER && MOE_FP8) ? (const bf16_t*)(ws + WS_XS) : H; p.W1 = (const bf16_t*)(ws + WS_W1 + (size_t)32 * 2048 * 1024 * (MOE_FP8 ? 1 : 2)); p.B1 = INP(I_B1) + 32 * 2048; p.ACT = (bf16_t*)(ws + WS_ACT); p.rowl = (const int*)(ws + WS_ROWL);
        p.cnt = (const LAS int*)(F.lds + XTRA_OFF + X_CNT); p.stage = F.lds + XTRA_OFF + 1024; p.wave_s = wave_s; p.ms.pb = (const LAS int*)(F.lds + XTRA_OFF + X_PB); p.ms.bt = (const LAS unsigned*)(F.lds + XTRA_OFF + X_BT); p.ms.NTN = 8; p.ms.G = F.G; p.ms.c = F.bid; pg8::gemm_phase(F.lds, p, wave_s); } SEAM(16);
    if (IN(17)) { REFRAME(); moe_prefix(F, 1); ProbMoe2 p; p.K = MOE_FP8 ? 512 : 1024; p.lda = p.K; p.ACT = (const bf16_t*)(ws + WS_ACT); p.W2 = (const bf16_t*)(ws + WS_W2 + (size_t)32 * 1024 * 1024 * (MOE_FP8 ? 1 : 2)); p.B2 = INP(I_B2) + 32 * 1024; p.Y = (bf16_t*)(ws + WS_Y);
        p.wave_s = wave_s; p.stage = F.lds + XTRA_OFF + 1024; p.ms.pb = (const LAS int*)(F.lds + XTRA_OFF + X_PB); p.ms.bt = (const LAS unsigned*)(F.lds + XTRA_OFF + X_BT); p.ms.NTN = 4; p.ms.G = F.G; p.ms.c = F.bid; pg8::gemm_phase(F.lds, p, wave_s); } SEAM(17);
    if (IN(18)) { REFRAME(); if constexpr (COMBINE_V2 != 0 && PROJ1_FP8 != 0 && Y_FP8 != 0) p_combine_v2<true>(F, 0); else p_final(F); }
#if PROBE_CLK
    if (F.bid == 0 && hi == NPHASE) { __syncthreads(); const unsigned long long* st_ = (const unsigned long long*)(ws + WS_CTL) + (CW_DBG / 2);
        unsigned long long d = 0;
        if (PROBE_CLK == 1) d = (st_[3] - st_[1]) * 1000ull / (st_[2] - st_[0]);
        if (PROBE_CLK == 2) d = (st_[2] - st_[0]);
        const unsigned long long t0 = __builtin_amdgcn_s_memrealtime(); while (__builtin_amdgcn_s_memrealtime() - t0 < d) __builtin_amdgcn_s_sleep(8); }
#endif
#undef IN
#undef SEAM
}

extern "C" void kernel_launch(void* const* d_in, const int* in_sizes, int n_in, void* d_out, int out_size, void* d_ws, size_t ws_size, hipStream_t stream) {
    static int grid = 0;
    if (grid == 0) {
        if (n_in != 28 || out_size != NBATCH * SEQ * DM || ws_size < WS_END) { fprintf(stderr, "kernel_launch: unexpected shapes (n_in %d out %d ws %zu, need ws >= %zu)\n", n_in, out_size, ws_size, (size_t)WS_END); grid = -1; return; }
        int dev = 0, cus = 0, per_cu = 0;
        if (hipGetDevice(&dev) != hipSuccess || hipDeviceGetAttribute(&cus, hipDeviceAttributeMultiprocessorCount, dev) != hipSuccess) { grid = -1; return; }
        if (hipFuncSetAttribute((const void*)fwd_kernel, hipFuncAttributeMaxDynamicSharedMemorySize, LDS_BYTES) != hipSuccess) { fprintf(stderr, "kernel_launch: hipFuncSetAttribute failed\n"); grid = -1; return; }
        if (hipOccupancyMaxActiveBlocksPerMultiprocessor(&per_cu, (const void*)fwd_kernel, 512, LDS_BYTES) != hipSuccess || per_cu < 1) { fprintf(stderr, "kernel_launch: occupancy query says %d blocks/CU\n", per_cu); }
        (void)hipGetLastError();
        grid = cus;
    }
    if (grid < 0) return;
    (void)hipMemsetAsync((char*)d_ws + WS_CTL, 0, CTL_BYTES, stream);
    Args a{};
    for (int i = 0; i < 28; ++i) a.in[i] = (const float*)d_in[i];
    a.out = (float*)d_out; a.ws = (uchar*)d_ws;
#if MK_ONE_LAUNCH
    a.ph_lo = 0; a.ph_hi = NPHASE;
    hipLaunchKernelGGL(fwd_kernel, dim3(grid), dim3(512), LDS_BYTES, stream, a);
#else
    for (int ph = 0; ph < NPHASE; ++ph) { a.ph_lo = ph; a.ph_hi = ph + 1; const int nrep = 1 + ((REPEAT_MASK >> ph) & 1); for (int rep = 0; rep < nrep; ++rep) { a.dry = (rep + 1 < nrep) ? 1 : 0; hipLaunchKernelGGL(fwd_kernel, dim3(grid), dim3(512), LDS_BYTES, stream, a); } }
#endif
}
```
